# Optimizing an MI355X kernel written in HIP

```python
import math
import jax, jax.numpy as jnp
from jax import lax
import numpy as np

D_MODEL = 1024
BATCH = 1
SEQ = 16384
DEPTH = 1

D_MIX = D_MODEL
POOL_WIDTH = D_MIX // 4
POOL_WINDOWS = (2, 4, 8, 16)
POOL_GROUP = POOL_WIDTH // len(POOL_WINDOWS)
ATT_WIDTH = D_MIX - POOL_WIDTH
HEAD_DIM = 64
N_ATT_HEADS = ATT_WIDTH // HEAD_DIM
DILATED_GROUPS = ((128, 1), (512, 4), (2048, 16))
ATT_BLOCK = 128
N_BUCKETS = 32
MAX_DISTANCE = 2048
N_EXPERTS = 32
TOP_K = 4
D_FF = D_MODEL
SWIGLU_LIMIT = 7.0
SWIGLU_ALPHA = 1.702
MOE_BLOCK = 128
RMS_EPS = 1e-5
NEG_INF = -1e30

kernel_name = 'hybrid_pool_dilated_attn_moe'


def rmsnorm(x, g):
    xf = x.astype(jnp.float32)
    y = xf * lax.rsqrt(jnp.mean(xf * xf, axis=-1, keepdims=True) + RMS_EPS)
    return (y * g.astype(jnp.float32)).astype(x.dtype)


def pool_mixer(u, pool_w, pool_scale):
    B, S, _ = u.shape
    maxw = max(POOL_WINDOWS)
    uf = u.astype(jnp.float32)
    c = jnp.cumsum(uf, axis=1)
    c_pad = jnp.pad(c, ((0, 0), (maxw, 0), (0, 0)))
    t = jnp.arange(S)
    outs = []
    for g, w in enumerate(POOL_WINDOWS):
        lo, hi = g * POOL_GROUP, (g + 1) * POOL_GROUP
        win_sum = c_pad[:, maxw:, lo:hi] - c_pad[:, maxw - w:maxw - w + S, lo:hi]
        cnt = jnp.minimum(t + 1, w).astype(jnp.float32)[None, :, None]
        outs.append(win_sum / cnt - uf[:, :, lo:hi])
    pooled = jnp.stack(outs, axis=2).astype(u.dtype)
    mixed = jnp.einsum('bsgc,gcd->bsgd', pooled, pool_w)
    return mixed.reshape(B, S, POOL_WIDTH) * pool_scale


def t5_bucket(dist):
    max_exact = N_BUCKETS // 2
    is_small = dist < max_exact
    nf = jnp.maximum(dist, 1).astype(jnp.float32)
    large = max_exact + (jnp.log(nf / max_exact) / math.log(MAX_DISTANCE / max_exact)
                         * (N_BUCKETS - max_exact)).astype(jnp.int32)
    large = jnp.minimum(large, N_BUCKETS - 1)
    return jnp.where(is_small, dist, large)


def dilated_branch(q, k, v, rel_bias, window, dil):
    B, S, H, Dh = q.shape
    w_sub = window // dil
    assert w_sub <= ATT_BLOCK
    span = dil * ATT_BLOCK
    S_pad = -(-S // span) * span
    M = S_pad // dil
    nb = M // ATT_BLOCK

    def to_blocks(a):
        a = jnp.pad(a, ((0, 0), (0, S_pad - S), (0, 0), (0, 0)))
        a = a.reshape(B, M, dil, H, Dh).transpose(0, 2, 1, 3, 4)
        return a.reshape(B, dil, nb, ATT_BLOCK, H, Dh)

    def band(a):
        prev = jnp.pad(a[:, :, :-1], ((0, 0), (0, 0), (1, 0), (0, 0), (0, 0), (0, 0)))
        return jnp.concatenate([prev, a], axis=3)

    qb = to_blocks(q)
    kb = band(to_blocks(k))
    vb = band(to_blocks(v))

    qi = jnp.arange(ATT_BLOCK)[:, None]
    kj = jnp.arange(2 * ATT_BLOCK)[None, :]
    dist = qi + ATT_BLOCK - kj
    in_win = (dist >= 0) & (dist <= w_sub)
    bias = rel_bias[t5_bucket(jnp.clip(dist, 0) * dil)]
    bias = bias.transpose(2, 0, 1).astype(jnp.float32)
    has_prev = (jnp.arange(nb)[:, None, None] > 0) | (kj >= ATT_BLOCK)[None]
    mask = in_win[None] & has_prev

    s = jnp.einsum('brnqhd,brnkhd->brnhqk', qb, kb).astype(jnp.float32) * (HEAD_DIM ** -0.5)
    s = jnp.where(mask[None, None, :, None], s + bias[None, None, None], NEG_INF)
    m = jnp.max(s, axis=-1, keepdims=True)
    p = jnp.exp(s - m)
    l = jnp.sum(p, axis=-1, keepdims=True)
    o = jnp.einsum('brnhqk,brnkhd->brnqhd', (p / l).astype(v.dtype), vb)
    lse = (m + jnp.log(l))[..., 0]

    o = o.reshape(B, dil, M, H, Dh).transpose(0, 2, 1, 3, 4).reshape(B, S_pad, H, Dh)[:, :S]
    lse = lse.transpose(0, 1, 2, 4, 3).reshape(B, dil, M, H).transpose(0, 2, 1, 3)
    lse = lse.reshape(B, S_pad, H)[:, :S]
    return o, lse


def dilated_attention(q, k, v, rel_bias):
    outs, lses = [], []
    for window, dil in DILATED_GROUPS:
        o, lse = dilated_branch(q, k, v, rel_bias, window, dil)
        outs.append(o)
        lses.append(lse)
    wts = jax.nn.softmax(jnp.stack(lses, axis=0), axis=0)
    o = jnp.stack(outs, axis=0).astype(jnp.float32)
    return jnp.sum(wts[..., None] * o, axis=0).astype(q.dtype)


def clamped_swiglu(gu):
    gate, up = gu[..., :D_FF], gu[..., D_FF:]
    gate = jnp.minimum(gate, SWIGLU_LIMIT)
    up = jnp.clip(up, -SWIGLU_LIMIT, SWIGLU_LIMIT)
    return (up + 1.0) * (gate * jax.nn.sigmoid(gate * SWIGLU_ALPHA))


def moe(h, router_w, router_b, w_gate_up, b_gate_up, w_down, b_down):
    N, D = h.shape
    logits = (h @ router_w + router_b).astype(jnp.float32)
    top_v, top_i = lax.top_k(logits, TOP_K)
    gates = jax.nn.softmax(top_v, axis=-1)
    A = N * TOP_K
    e_flat = top_i.reshape(A)
    g_flat = gates.reshape(A)
    tok_flat = jnp.arange(A, dtype=jnp.int32) // TOP_K
    order = jnp.argsort(e_flat)
    e_s, tok_s, g_s = e_flat[order], tok_flat[order], g_flat[order]
    counts = jnp.zeros((N_EXPERTS,), jnp.int32).at[e_flat].add(1)
    starts = jnp.cumsum(counts) - counts
    blocks_per = (counts + MOE_BLOCK - 1) // MOE_BLOCK
    block_end = jnp.cumsum(blocks_per)
    pstarts = (block_end - blocks_per) * MOE_BLOCK
    dest = pstarts[e_s] + (jnp.arange(A, dtype=jnp.int32) - starts[e_s])
    nb = -(-A // MOE_BLOCK) + N_EXPERTS
    P = nb * MOE_BLOCK
    slot_tok = jnp.full((P,), N, jnp.int32).at[dest].set(tok_s)
    slot_gate = jnp.zeros((P,), h.dtype).at[dest].set(g_s.astype(h.dtype))
    block_exp = jnp.minimum(jnp.searchsorted(block_end, jnp.arange(nb, dtype=jnp.int32), side='right'),
                            N_EXPERTS - 1)
    h_pad = jnp.concatenate([h, jnp.zeros((1, D), h.dtype)], axis=0)
    xb = h_pad[slot_tok].reshape(nb, MOE_BLOCK, D)

    def expert_block(args):
        xblk, e = args
        act = clamped_swiglu(xblk @ w_gate_up[e] + b_gate_up[e])
        return act @ w_down[e] + b_down[e]

    yb = lax.map(expert_block, (xb, block_exp)).reshape(P, D)
    out = jnp.zeros((N + 1, D), h.dtype).at[slot_tok].add(yb * slot_gate[:, None])
    return out[:N]


def setup_inputs(seed: int = 0) -> dict:
    key = jax.random.key(seed)
    ks = jax.random.split(key, 16)
    f32 = jnp.float32
    n_in = POOL_WIDTH + 3 * ATT_WIDTH
    nrm = lambda k, shape, scale: jax.random.normal(k, shape, f32) * scale
    return {
        'x': jax.random.normal(ks[0], (BATCH, SEQ, D_MODEL), f32),
        'norm1_g': 1.0 + nrm(ks[1], (DEPTH, D_MODEL), 0.05),
        'w_in': nrm(ks[2], (DEPTH, D_MODEL, n_in), D_MODEL ** -0.5),
        'pool_w': nrm(ks[3], (DEPTH, len(POOL_WINDOWS), POOL_GROUP, POOL_GROUP), POOL_GROUP ** -0.5),
        'pool_scale': 1.0 + nrm(ks[4], (DEPTH, POOL_WIDTH), 0.1),
        'rel_bias': nrm(ks[5], (N_BUCKETS, N_ATT_HEADS), 0.5),
        'w_out': nrm(ks[6], (DEPTH, D_MIX, D_MODEL), D_MIX ** -0.5),
        'norm2_g': 1.0 + nrm(ks[7], (DEPTH, D_MODEL), 0.05),
        'router_w': nrm(ks[8], (DEPTH, D_MODEL, N_EXPERTS), D_MODEL ** -0.5),
        'router_b': nrm(ks[9], (DEPTH, N_EXPERTS), 0.01),
        'w_gate_up': nrm(ks[10], (DEPTH, N_EXPERTS, D_MODEL, 2 * D_FF), D_MODEL ** -0.5),
        'b_gate_up': nrm(ks[11], (DEPTH, N_EXPERTS, 2 * D_FF), 0.02),
        'w_down': nrm(ks[12], (DEPTH, N_EXPERTS, D_FF, D_MODEL), D_FF ** -0.5),
        'b_down': nrm(ks[13], (DEPTH, N_EXPERTS, D_MODEL), 0.02),
        'final_g': 1.0 + nrm(ks[14], (D_MODEL,), 0.05),
    }


def reference(x, norm1_g, w_in, pool_w, pool_scale, rel_bias, w_out, norm2_g,
              router_w, router_b, w_gate_up, b_gate_up, w_down, b_down, final_g):
    B, S, D = x.shape
    for l in range(DEPTH):
        h = rmsnorm(x, norm1_g[l])
        proj = h @ w_in[l]
        u = proj[..., :POOL_WIDTH]
        qkv = proj[..., POOL_WIDTH:].reshape(B, S, 3, N_ATT_HEADS, HEAD_DIM)
        q, k, v = qkv[:, :, 0], qkv[:, :, 1], qkv[:, :, 2]
        pool_out = pool_mixer(u, pool_w[l], pool_scale[l])
        att_out = dilated_attention(q, k, v, rel_bias).reshape(B, S, ATT_WIDTH)
        mix = jnp.concatenate([pool_out.astype(x.dtype), att_out], axis=-1)
        x = x + mix @ w_out[l]
        h2 = rmsnorm(x, norm2_g[l]).reshape(B * S, D)
        x = x + moe(h2, router_w[l], router_b[l], w_gate_up[l], b_gate_up[l],
                    w_down[l], b_down[l]).reshape(B, S, D)
    return rmsnorm(x, final_g)
```

```cpp
#include <hip/hip_runtime.h>
#include <math.h>

constexpr int S = 16384, D = 1024, NP = 2560, NH = 12, NE = 32, DFF = 1024;

__global__ __launch_bounds__(256) void rmsnorm_k(const float* __restrict__ x, const float* __restrict__ g, float* __restrict__ out) {
    const int row = blockIdx.x;
    const float4 v = ((const float4*)(x + (size_t)row * D))[threadIdx.x];
    float ss = v.x * v.x + v.y * v.y + v.z * v.z + v.w * v.w;
    __shared__ float red[4];
    for (int o = 32; o >= 1; o >>= 1) ss += __shfl_xor(ss, o);
    if ((threadIdx.x & 63) == 0) red[threadIdx.x >> 6] = ss;
    __syncthreads();
    const float tot = red[0] + red[1] + red[2] + red[3];
    const float rstd = rsqrtf(tot * (1.0f / D) + 1e-5f);
    const float4 gg = ((const float4*)g)[threadIdx.x];
    float4 o; o.x = v.x * rstd * gg.x; o.y = v.y * rstd * gg.y; o.z = v.z * rstd * gg.z; o.w = v.w * rstd * gg.w;
    ((float4*)(out + (size_t)row * D))[threadIdx.x] = o;
}

__global__ __launch_bounds__(256) void final_k(const float* __restrict__ x1, const float* __restrict__ y, const float* __restrict__ g, float* __restrict__ out) {
    const int row = blockIdx.x;
    float4 v = ((const float4*)(x1 + (size_t)row * D))[threadIdx.x];
    for (int k = 0; k < 4; ++k) { const float4 t = ((const float4*)(y + ((size_t)row * 4 + k) * D))[threadIdx.x]; v.x += t.x; v.y += t.y; v.z += t.z; v.w += t.w; }
    float ss = v.x * v.x + v.y * v.y + v.z * v.z + v.w * v.w;
    __shared__ float red[4];
    for (int o = 32; o >= 1; o >>= 1) ss += __shfl_xor(ss, o);
    if ((threadIdx.x & 63) == 0) red[threadIdx.x >> 6] = ss;
    __syncthreads();
    const float tot = red[0] + red[1] + red[2] + red[3];
    const float rstd = rsqrtf(tot * (1.0f / D) + 1e-5f);
    const float4 gg = ((const float4*)g)[threadIdx.x];
    float4 o; o.x = v.x * rstd * gg.x; o.y = v.y * rstd * gg.y; o.z = v.z * rstd * gg.z; o.w = v.w * rstd * gg.w;
    ((float4*)(out + (size_t)row * D))[threadIdx.x] = o;
}

__global__ __launch_bounds__(256) void pool_k(const float* __restrict__ proj, const float* __restrict__ pool_w, const float* __restrict__ pool_scale, float* __restrict__ mix) {
    const int t = blockIdx.x, c = threadIdx.x, g = c >> 6, w = 2 << g;
    __shared__ float sp[256];
    float sum = 0.f;
    for (int i = 0; i < w; ++i) if (t - i >= 0) sum += proj[(size_t)(t - i) * NP + c];
    const int cnt = (t + 1 < w) ? (t + 1) : w;
    sp[c] = sum / (float)cnt - proj[(size_t)t * NP + c];
    __syncthreads();
    const int d = c & 63;
    float acc = 0.f;
    for (int cc = 0; cc < 64; ++cc) acc += sp[g * 64 + cc] * pool_w[g * 4096 + cc * 64 + d];
    mix[(size_t)t * D + c] = acc * pool_scale[c];
}

__device__ __forceinline__ int t5_bucket(int dist) {
    if (dist < 16) return dist;
    const float nf = (float)dist;
    int large = 16 + (int)(logf(nf / 16.0f) / 4.852030263919617f * 16.0f);
    return large < 31 ? large : 31;
}

__global__ __launch_bounds__(64) void attn_k(const float* __restrict__ proj, const float* __restrict__ rel_bias, float* __restrict__ mix) {
    const int t = blockIdx.x, h = blockIdx.y, l = threadIdx.x;
    __shared__ float qs[64];
    __shared__ float ps[192];
    qs[l] = proj[(size_t)t * NP + 256 + h * 64 + l];
    __syncthreads();
    float lse[3], ob[3];
#pragma unroll
    for (int b = 0; b < 3; ++b) {
        const int dil = (b == 0) ? 1 : (b == 1 ? 4 : 16);
        float sc[3]; float mloc = -1e30f;
#pragma unroll
        for (int jj = 0; jj < 3; ++jj) {
            const int j = l + 64 * jj; float s = -1e30f;
            if (j <= 128 && t - dil * j >= 0) {
                const float* kr = proj + (size_t)(t - dil * j) * NP + 256 + 768 + h * 64;
                float dot = 0.f;
                for (int d = 0; d < 64; ++d) dot += qs[d] * kr[d];
                s = dot * 0.125f + rel_bias[t5_bucket(j * dil) * NH + h];
            }
            sc[jj] = s; mloc = fmaxf(mloc, s);
        }
        for (int o = 32; o >= 1; o >>= 1) mloc = fmaxf(mloc, __shfl_xor(mloc, o));
        float lsum = 0.f;
#pragma unroll
        for (int jj = 0; jj < 3; ++jj) {
            const int j = l + 64 * jj;
            const float p = (sc[jj] > -1e29f) ? expf(sc[jj] - mloc) : 0.f;
            lsum += p; ps[j] = p;
        }
        for (int o = 32; o >= 1; o >>= 1) lsum += __shfl_xor(lsum, o);
        __syncthreads();
        float o_ = 0.f;
        for (int j = 0; j <= 128; ++j) {
            const int kp = t - dil * j;
            if (kp < 0) break;
            o_ += ps[j] * proj[(size_t)kp * NP + 256 + 1536 + h * 64 + l];
        }
        ob[b] = o_ / lsum; lse[b] = mloc + logf(lsum);
        __syncthreads();
    }
    const float mx = fmaxf(lse[0], fmaxf(lse[1], lse[2]));
    const float w0 = expf(lse[0] - mx), w1 = expf(lse[1] - mx), w2 = expf(lse[2] - mx);
    mix[(size_t)t * D + 256 + h * 64 + l] = (w0 * ob[0] + w1 * ob[1] + w2 * ob[2]) / (w0 + w1 + w2);
}

__global__ __launch_bounds__(256) void router_k(const float* __restrict__ h2, const float* __restrict__ rw, const float* __restrict__ rb,
                                                float* __restrict__ gates, int* __restrict__ counts, int* __restrict__ rows) {
    const int token = blockIdx.x * 4 + (threadIdx.x >> 6), l = threadIdx.x & 63, e = l & 31, half = l >> 5;
    float acc = 0.f;
    const float* hr = h2 + (size_t)token * D + half * 512;
    const float* wr = rw + (size_t)half * 512 * NE + e;
    for (int k = 0; k < 512; ++k) acc += hr[k] * wr[(size_t)k * NE];
    acc += __shfl_xor(acc, 32);
    acc += rb[e];
    float v = acc; float topv[4]; int topi[4];
#pragma unroll
    for (int r = 0; r < 4; ++r) {
        float bv = v; int bi = e;
        for (int o = 16; o >= 1; o >>= 1) {
            const float ov = __shfl_xor(bv, o); const int oi = __shfl_xor(bi, o);
            if (ov > bv || (ov == bv && oi < bi)) { bv = ov; bi = oi; }
        }
        topv[r] = bv; topi[r] = bi;
        if (e == bi) v = -INFINITY;
    }
    const float e0 = 1.f, e1 = expf(topv[1] - topv[0]), e2 = expf(topv[2] - topv[0]), e3 = expf(topv[3] - topv[0]);
    const float inv = 1.f / (e0 + e1 + e2 + e3);
    const float gv[4] = {e0 * inv, e1 * inv, e2 * inv, e3 * inv};
    if (l == 0) {
    #pragma unroll
    for (int r = 0; r < 4; ++r) {
            const int p = atomicAdd(&counts[topi[r]], 1);
            rows[topi[r] * S + p] = token * 4 + r;
            gates[token * 4 + r] = gv[r];
        }
    }
}

struct GemmP { const float* A; const float* B; float* C; const float* R; const float* gate; const int* counts; const int* rows; int M, N, K, lda, ldb, ldc; };

template <int MODE> __global__ __launch_bounds__(256) void sgemm_k(GemmP p) {
    __shared__ __attribute__((aligned(16))) float As[16][68];
    __shared__ __attribute__((aligned(16))) float Bs[16][64];
    __shared__ __attribute__((aligned(16))) float Bs2[16][64];
    const int tid = threadIdx.x, tx = tid & 15, ty = tid >> 4;
    const int n0 = blockIdx.x * 64, m0 = blockIdx.y * 64, e = blockIdx.z;
    const float* Bp = p.B; int cnt = p.M, base = 0;
    if (MODE >= 2) {
        cnt = p.counts[e]; if (m0 >= cnt) return;
        for (int i = 0; i < e; ++i) base += p.counts[i];
        Bp += (size_t)e * p.K * p.ldb;
    }
    const int lr = tid >> 2, k4 = (tid & 3) * 4;
    const float* arow = p.A; bool avalid = true;
    if (MODE <= 1) arow = p.A + (size_t)(m0 + lr) * p.lda;
    if (MODE == 2) { const int idx = (m0 + lr < cnt) ? p.rows[e * S + m0 + lr] : -1; avalid = idx >= 0; arow = p.A + (size_t)(avalid ? (idx >> 2) : 0) * p.lda; }
    if (MODE == 3) { avalid = (m0 + lr < cnt); arow = p.A + (size_t)(base + (avalid ? m0 + lr : 0)) * p.lda; }
    float acc[4][4], acc2[4][4];
    for (int i = 0; i < 4; ++i) for (int j = 0; j < 4; ++j) { acc[i][j] = 0.f; acc2[i][j] = 0.f; }
    for (int k0 = 0; k0 < p.K; k0 += 16) {
        float4 av = make_float4(0.f, 0.f, 0.f, 0.f);
        if (avalid) av = *(const float4*)(arow + k0 + k4);
        As[k4 + 0][lr] = av.x; As[k4 + 1][lr] = av.y; As[k4 + 2][lr] = av.z; As[k4 + 3][lr] = av.w;
        *(float4*)&Bs[ty][tx * 4] = *(const float4*)(Bp + (size_t)(k0 + ty) * p.ldb + n0 + tx * 4);
        if (MODE == 2) *(float4*)&Bs2[ty][tx * 4] = *(const float4*)(Bp + (size_t)(k0 + ty) * p.ldb + DFF + n0 + tx * 4);
        __syncthreads();
#pragma unroll
        for (int k = 0; k < 16; ++k) {
            const float4 a = *(const float4*)&As[k][ty * 4];
            const float4 b = *(const float4*)&Bs[k][tx * 4];
            const float aa[4] = {a.x, a.y, a.z, a.w}, bb[4] = {b.x, b.y, b.z, b.w};
#pragma unroll
            for (int i = 0; i < 4; ++i)
#pragma unroll
                for (int j = 0; j < 4; ++j) acc[i][j] += aa[i] * bb[j];
            if (MODE == 2) {
                const float4 b2 = *(const float4*)&Bs2[k][tx * 4];
                const float bb2[4] = {b2.x, b2.y, b2.z, b2.w};
#pragma unroll
                for (int i = 0; i < 4; ++i)
#pragma unroll
                    for (int j = 0; j < 4; ++j) acc2[i][j] += aa[i] * bb2[j];
            }
        }
        __syncthreads();
    }
    for (int i = 0; i < 4; ++i) {
        const int row = m0 + ty * 4 + i;
        const int n = n0 + tx * 4;
        if (MODE == 0) { float4 o = make_float4(acc[i][0], acc[i][1], acc[i][2], acc[i][3]); *(float4*)(p.C + (size_t)row * p.ldc + n) = o; }
        if (MODE == 1) { const float4 r = *(const float4*)(p.R + (size_t)row * p.ldc + n);
            float4 o = make_float4(acc[i][0] + r.x, acc[i][1] + r.y, acc[i][2] + r.z, acc[i][3] + r.w); *(float4*)(p.C + (size_t)row * p.ldc + n) = o; }
        if (MODE == 2) { if (row < cnt) { float o[4];
            for (int j = 0; j < 4; ++j) { float gt = acc[i][j] + p.R[(size_t)e * 2 * DFF + n + j]; float up = acc2[i][j] + p.R[(size_t)e * 2 * DFF + DFF + n + j];
                gt = fminf(gt, 7.0f); up = fminf(fmaxf(up, -7.0f), 7.0f);
                o[j] = (up + 1.0f) * (gt * (1.0f / (1.0f + expf(-1.702f * gt)))); }
            *(float4*)(p.C + (size_t)(base + row) * p.ldc + n) = make_float4(o[0], o[1], o[2], o[3]); } }
        if (MODE == 3) { if (row < cnt) { const int idx = p.rows[e * S + row]; const float gv = p.gate[idx];
            float4 o; o.x = (acc[i][0] + p.R[(size_t)e * D + n + 0]) * gv; o.y = (acc[i][1] + p.R[(size_t)e * D + n + 1]) * gv;
            o.z = (acc[i][2] + p.R[(size_t)e * D + n + 2]) * gv; o.w = (acc[i][3] + p.R[(size_t)e * D + n + 3]) * gv;
            *(float4*)(p.C + (size_t)idx * p.ldc + n) = o; } }
    }
}

extern "C" void kernel_launch(void* const* d_in, const int* in_sizes, int n_in, void* d_out, int out_size, void* d_ws, size_t ws_size, hipStream_t stream) {
    const float* x = (const float*)d_in[0]; const float* norm1_g = (const float*)d_in[1]; const float* w_in = (const float*)d_in[2];
    const float* pool_w = (const float*)d_in[3]; const float* pool_scale = (const float*)d_in[4]; const float* rel_bias = (const float*)d_in[5];
    const float* w_out = (const float*)d_in[6]; const float* norm2_g = (const float*)d_in[7]; const float* router_w = (const float*)d_in[8];
    const float* router_b = (const float*)d_in[9]; const float* w_gate_up = (const float*)d_in[10]; const float* b_gate_up = (const float*)d_in[11];
    const float* w_down = (const float*)d_in[12]; const float* b_down = (const float*)d_in[13]; const float* final_g = (const float*)d_in[14];
    float* out = (float*)d_out;
    char* ws = (char*)d_ws;
    const size_t MiB = 1u << 20;
    float* H = (float*)(ws + 0 * MiB);
    float* PROJ = (float*)(ws + 64 * MiB);
    float* MIX = (float*)(ws + 224 * MiB);
    float* X1 = (float*)(ws + 288 * MiB);
    float* ACT = (float*)(ws + 352 * MiB);
    float* Y = (float*)(ws + 608 * MiB);
    float* GATES = (float*)(ws + 864 * MiB);
    int* COUNTS = (int*)(ws + 865 * MiB);
    int* ROWS = (int*)(ws + 866 * MiB);

    hipMemsetAsync(COUNTS, 0, 256, stream);
    rmsnorm_k<<<S, 256, 0, stream>>>(x, norm1_g, H);
    { GemmP p{}; p.A = H; p.B = w_in; p.C = PROJ; p.M = S; p.N = NP; p.K = D; p.lda = D; p.ldb = NP; p.ldc = NP;
      sgemm_k<0><<<dim3(NP / 64, S / 64, 1), 256, 0, stream>>>(p); }
    pool_k<<<S, 256, 0, stream>>>(PROJ, pool_w, pool_scale, MIX);
    attn_k<<<dim3(S, NH), 64, 0, stream>>>(PROJ, rel_bias, MIX);
    { GemmP p{}; p.A = MIX; p.B = w_out; p.C = X1; p.R = x; p.M = S; p.N = D; p.K = D; p.lda = D; p.ldb = D; p.ldc = D;
      sgemm_k<1><<<dim3(D / 64, S / 64, 1), 256, 0, stream>>>(p); }
    rmsnorm_k<<<S, 256, 0, stream>>>(X1, norm2_g, H);
    router_k<<<S / 4, 256, 0, stream>>>(H, router_w, router_b, GATES, COUNTS, ROWS);
    { GemmP p{}; p.A = H; p.B = w_gate_up; p.C = ACT; p.R = b_gate_up; p.counts = COUNTS; p.rows = ROWS; p.M = S; p.N = DFF; p.K = D; p.lda = D; p.ldb = 2 * DFF; p.ldc = DFF;
      sgemm_k<2><<<dim3(DFF / 64, S / 64, NE), 256, 0, stream>>>(p); }
    { GemmP p{}; p.A = ACT; p.B = w_down; p.C = Y; p.R = b_down; p.gate = GATES; p.counts = COUNTS; p.rows = ROWS; p.M = S; p.N = D; p.K = DFF; p.lda = DFF; p.ldb = D; p.ldc = D;
      sgemm_k<3><<<dim3(D / 64, S / 64, NE), 256, 0, stream>>>(p); }
    final_k<<<S, 256, 0, stream>>>(X1, Y, final_g, out);
}
```

```cpp
#define MK_N_LAUNCHES 1
#include <hip/hip_runtime.h>
#include <cstdio>
#include <cstdint>

#define LAS __attribute__((address_space(3)))
#define GAS __attribute__((address_space(1)))
typedef unsigned short bf16_t;
typedef short bf16x8 __attribute__((ext_vector_type(8)));
typedef short s16x4 __attribute__((ext_vector_type(4)));
typedef float f32x4 __attribute__((ext_vector_type(4)));
typedef float f32x2 __attribute__((ext_vector_type(2)));
typedef unsigned u32x4 __attribute__((ext_vector_type(4)));
typedef unsigned u32x2 __attribute__((ext_vector_type(2)));

constexpr int S = 16384, D = 1024, NPROJ = 2560, PW = 256, AW = 768, NH = 12, HD = 64, NE = 32, TOPK = 4, DFF = 1024;
constexpr float RMS_EPS = 1e-5f, LOG2E = 1.4426950408889634f, QSCALE = 0.125f * LOG2E, NEGBIG = -1e30f;
constexpr int BT_N = 400, BT_OFF = 144;

constexpr size_t MiB = 1u << 20;
constexpr size_t WS_CTL = 0, CTL_ZERO_BYTES = 64 * 1024;
constexpr size_t WS_WIN = 2 * MiB;
constexpr size_t WS_WOUT = 8 * MiB;
constexpr size_t WS_GWT = 10 * MiB;
constexpr size_t WS_BT = 10 * MiB + 512 * 1024;
constexpr size_t WS_PWT = 10 * MiB + 768 * 1024;
constexpr size_t WS_RSTD = 11 * MiB;
constexpr size_t WS_GATES = 11 * MiB + 256 * 1024;
constexpr size_t WS_ROWS = 12 * MiB;
constexpr size_t WS_LSE = 14 * MiB;
constexpr size_t WS_WGU = 32 * MiB;
constexpr size_t WS_WD = 160 * MiB;
constexpr size_t WS_H = 224 * MiB;
constexpr size_t WS_U = 256 * MiB;
constexpr size_t WS_Q = 264 * MiB, WS_K = 288 * MiB, WS_V = 312 * MiB;
constexpr size_t WS_OP = 336 * MiB;
constexpr size_t WS_MIX = 408 * MiB;
constexpr size_t WS_X1 = 440 * MiB;
constexpr size_t WS_ACT = 512 * MiB;
constexpr size_t WS_Y = 656 * MiB;
constexpr size_t WS_END = 784 * MiB;
constexpr int ACT_ROWS = 65536 + 32 * 256;
constexpr int CW_COUNTS = 64;
constexpr int CW_BAR = 4096;

constexpr int LDS_BYTES = 147456;
constexpr int LDS_TAB = 131072;
constexpr int LDS_CTL = LDS_BYTES - 1024;
constexpr int MAXU = 9;

__device__ __forceinline__ unsigned cvt_pk_bf16(float lo, float hi) { unsigned r; asm volatile("v_cvt_pk_bf16_f32 %0, %1, %2" : "=v"(r) : "v"(lo), "v"(hi)); return r; }
__device__ __forceinline__ float bf_lo(unsigned w) { return __uint_as_float(w << 16); }
__device__ __forceinline__ float bf_hi(unsigned w) { return __uint_as_float(w & 0xffff0000u); }
__device__ __forceinline__ float wave_sum(float v) {
#pragma unroll
    for (int o = 1; o < 64; o <<= 1) v += __shfl_xor(v, o);
    return v;
}
#define LDS_WAIT() asm volatile("s_waitcnt lgkmcnt(0)" ::: "memory")
#define VM_WAIT() asm volatile("s_waitcnt vmcnt(0)" ::: "memory")

#define XB_TMO      128
#define XB_XCNT(j)  (256  + 64 * (j))
#define XB_XSUB(j)  (1280 + 64 * (j))
#define XB_XGEN(j)  (2304 + 64 * (j))
#define XB_TOP      3328
#define XB_TOPGEN   3392
#define XCD_BAR_WORDS 3456
#define XB_SPIN_CAP (1u << 18)
__device__ __forceinline__ unsigned xb_ld(unsigned* p)              { return __hip_atomic_load(p, __ATOMIC_RELAXED, __HIP_MEMORY_SCOPE_AGENT); }
__device__ __forceinline__ unsigned xb_add(unsigned* p, unsigned v) { return __hip_atomic_fetch_add(p, v, __ATOMIC_RELAXED, __HIP_MEMORY_SCOPE_AGENT); }
__device__ __forceinline__ unsigned xb_xcc_id() { return (unsigned)__builtin_amdgcn_s_getreg((3 << 11) | 20) & 0xFu; }
#define XB_SPIN(cond, bar) do { unsigned _sp = 0; while (cond) { __builtin_amdgcn_s_sleep(1); \
    if ((++_sp & 255u) == 0u) { if (xb_ld(&(bar)[XB_TMO])) break; if (_sp > XB_SPIN_CAP) { atomicAdd(&(bar)[XB_TMO], 1u); break; } } } } while (0)
struct XcdBarrier { unsigned* bar; unsigned x; volatile LAS unsigned* st; };
__device__ __forceinline__ XcdBarrier xcd_barrier_post(unsigned* bar, volatile LAS unsigned* st) {
    XcdBarrier b; b.bar = bar; b.x = xb_xcc_id(); b.st = st;
    if (threadIdx.x == 0) (void)xb_add(&bar[XB_XCNT(b.x)], 1u);
    return b;
}
__device__ __forceinline__ void xcd_barrier_complete(unsigned* bar, unsigned x, unsigned& nloc, unsigned& nx) {
    const unsigned G = gridDim.x * gridDim.y * gridDim.z;
    unsigned sum, cnt, mine, sp = 0u;
    for (;;) {
        sum = 0u; cnt = 0u; mine = 0u;
#pragma unroll
        for (unsigned j = 0; j < 16; ++j) { const unsigned c = xb_ld(&bar[XB_XCNT(j)]); sum += c; cnt += (c > 0u) ? 1u : 0u; mine = (j == x) ? c : mine; }
        if (sum == G) break;
        __builtin_amdgcn_s_sleep(1);
        if ((++sp & 255u) == 0u) { if (xb_ld(&bar[XB_TMO])) break; if (sp > XB_SPIN_CAP) { atomicAdd(&bar[XB_TMO], 1u); break; } }
    }
    nloc = mine > 0u ? mine : 1u; nx = cnt > 0u ? cnt : 1u;
}
__device__ __forceinline__ void xcd_barrier(const XcdBarrier& b) {
    asm volatile("s_waitcnt vmcnt(0)" ::: "memory");
    __syncthreads();
    if (threadIdx.x == 0) {
        unsigned* bar = b.bar;
        __builtin_amdgcn_s_waitcnt(0);
        unsigned nloc = b.st[0], nx = b.st[1];
        if (nloc == 0u) { xcd_barrier_complete(bar, b.x, nloc, nx); b.st[0] = nloc; b.st[1] = nx; }
        const unsigned old = xb_add(&bar[XB_XSUB(b.x)], 1u);
        const unsigned gen = old / nloc;
        if (old + 1u == (gen + 1u) * nloc) {
            __builtin_amdgcn_fence(__ATOMIC_RELEASE, "agent");
            asm volatile("s_waitcnt vmcnt(0)" ::: "memory");
            const unsigned og = xb_add(&bar[XB_TOP], 1u);
            const unsigned tg = og / nx;
            if (og + 1u == (tg + 1u) * nx) xb_add(&bar[XB_TOPGEN], 1u);
            else XB_SPIN(xb_ld(&bar[XB_TOPGEN]) == tg, bar);
            __builtin_amdgcn_fence(__ATOMIC_ACQUIRE, "agent");
            xb_add(&bar[XB_XGEN(b.x)], 1u);
            asm volatile("s_waitcnt vmcnt(0)" ::: "memory");
        } else {
            XB_SPIN(xb_ld(&bar[XB_XGEN(b.x)]) == gen, bar);
            __builtin_amdgcn_fence(__ATOMIC_ACQUIRE, "agent");
            asm volatile("s_waitcnt vmcnt(0)" ::: "memory");
        }
    }
    __syncthreads();
}

namespace pg8 {
constexpr int BM = 256, BK = 64, HALF = 128, HTB = HALF * BK * 2, STAGE_BYTES = 8 * HTB, NXCD = 8, WGM = 8;
__host__ __device__ __forceinline__ int lds_byte(int r, int c) { const int st = (r >> 4) * 2 + (c >> 5), rr = r & 15, cc = c & 31, ob = rr * 64 + cc * 2; return st * 1024 + (ob ^ (((ob >> 9) & 1) << 5)); }
__host__ __device__ __forceinline__ void stage_rc(int b, int& R, int& C) { const int st = b / 1024, sb = b % 1024, swz = sb ^ (((sb >> 9) & 1) << 5); R = (st >> 1) * 16 + swz / 64; C = (st & 1) * 32 + (swz % 64) / 2; }
__host__ __device__ __forceinline__ int perm32(int rho) { const int n = rho >> 4, i = rho & 15; return 8 * (i >> 2) + 4 * n + (i & 3); }

struct Unit { int pm, pn, e, slot; };

template <class Epi, class Prob, bool ALIGN_EPI>
__device__ __forceinline__ void gemm_phase(LAS unsigned char* lds, const Prob& P, const Epi& E) {
    const int tid = threadIdx.x, wid = __builtin_amdgcn_readfirstlane(tid >> 6), lane = tid & 63, wr = wid >> 2, wc = wid & 3, fr = lane & 15, fq = lane >> 4;
    const int K = P.K, nt = K / BK;
    int Rs[2], Cs[2]; unsigned voffB[2];
#pragma unroll
    for (int i = 0; i < 2; ++i) { int R, C; stage_rc(tid * 16 + i * 8192, R, C); const int Rb = Epi::PERM ? ((R & ~31) + perm32(R & 31)) : R;
        Rs[i] = R; Cs[i] = C; voffB[i] = (unsigned)(Rb * K + C) * 2u; }
    const size_t kstep = (size_t)(BK * 2);
    const size_t bhalf = P.b_half;
    const unsigned ldsw = (unsigned)wid * 1024u;
    const int aoff = lds_byte(wr * 64 + fr, fq * 8), boff = lds_byte(wc * 32 + fr, fq * 8);
#define PG8_SA(b, h) (((b) * 2 + (h)) * HTB)
#define PG8_SB(b, h) ((4 + (b) * 2 + (h)) * HTB)
#define PG8_STAGE_B(bufoff, gbase) do { _Pragma("unroll") for (int _i = 0; _i < 2; ++_i) \
        __builtin_amdgcn_global_load_lds((const unsigned*)((const char*)(gbase) + voffB[_i]), (LAS unsigned*)(lds + (bufoff) + ldsw + _i * 8192), 16, 0, 0); } while (0)
#define PG8_STAGE_A(bufoff, kb, o0, o1) do { \
        __builtin_amdgcn_global_load_lds((const unsigned*)(P.A + (size_t)(o0) + (kb)), (LAS unsigned*)(lds + (bufoff) + ldsw), 16, 0, 0); \
        __builtin_amdgcn_global_load_lds((const unsigned*)(P.A + (size_t)(o1) + (kb)), (LAS unsigned*)(lds + (bufoff) + ldsw + 8192), 16, 0, 0); } while (0)
#define PG8_LDA(dst, b, h) do { _Pragma("unroll") for (int m = 0; m < 4; ++m) _Pragma("unroll") for (int k = 0; k < 2; ++k) dst[m][k] = *(const LAS bf16x8*)(lds + PG8_SA(b, h) + aoff + m * 2048 + k * 1024); } while (0)
#define PG8_LDB(dst, b, h) do { _Pragma("unroll") for (int n = 0; n < 2; ++n) _Pragma("unroll") for (int k = 0; k < 2; ++k) dst[n][k] = *(const LAS bf16x8*)(lds + PG8_SB(b, h) + boff + n * 2048 + k * 1024); } while (0)
#define PG8_MMA(ai, bj, At, Bt) do { __builtin_amdgcn_s_setprio(1); _Pragma("unroll") for (int m = 0; m < 4; ++m) _Pragma("unroll") for (int n = 0; n < 2; ++n) _Pragma("unroll") for (int k = 0; k < 2; ++k) \
        acc[ai][bj][m][n] = __builtin_amdgcn_mfma_f32_16x16x32_bf16(Bt[n][k], At[m][k], acc[ai][bj][m][n], 0, 0, 0); __builtin_amdgcn_s_setprio(0); } while (0)
#define PG8_WAIT_V(n) asm volatile("s_waitcnt vmcnt(" #n ")" ::: "memory")
#define PG8_WAIT_L(n) asm volatile("s_waitcnt lgkmcnt(" #n ")" ::: "memory")
#define PG8_BAR __builtin_amdgcn_s_barrier()
#define PG8_SCHED __builtin_amdgcn_sched_barrier(0)
    Unit cur, nxt; int ui = 0;
    if (!P.next(0, cur)) return;
    f32x4 acc[2][2][4][2];
#pragma unroll
    for (int a = 0; a < 2; ++a)
#pragma unroll
        for (int b = 0; b < 2; ++b)
#pragma unroll
            for (int m = 0; m < 4; ++m)
#pragma unroll
                for (int n = 0; n < 2; ++n) acc[a][b][m][n] = (f32x4){0.f, 0.f, 0.f, 0.f};
    bf16x8 At[4][2], B0[2][2], B1[2][2];
    unsigned c00 = P.a_off(cur, Rs[0], Cs[0]), c01 = P.a_off(cur, Rs[1], Cs[1]), c10 = P.a_off(cur, HALF + Rs[0], Cs[0]), c11 = P.a_off(cur, HALF + Rs[1], Cs[1]);
    const char* cB = P.b_base(cur);
    PG8_STAGE_B(PG8_SB(0, 0), cB); PG8_STAGE_B(PG8_SB(0, 1), cB + bhalf); PG8_STAGE_A(PG8_SA(0, 0), 0, c00, c01); PG8_STAGE_A(PG8_SA(0, 1), 0, c10, c11);
    if (wr == 1) PG8_BAR;
    PG8_WAIT_V(2); PG8_BAR;
    PG8_STAGE_B(PG8_SB(1, 0), cB + kstep); PG8_STAGE_A(PG8_SA(1, 0), kstep, c00, c01); PG8_STAGE_B(PG8_SB(1, 1), cB + bhalf + kstep);
    PG8_WAIT_V(6); PG8_BAR;
    for (;;) {
        const bool has_next = P.next(ui + 1, nxt);
        unsigned n00 = c00, n01 = c01, n10 = c10, n11 = c11; const char* nB = cB;
        if (has_next) { n00 = P.a_off(nxt, Rs[0], Cs[0]); n01 = P.a_off(nxt, Rs[1], Cs[1]); n10 = P.a_off(nxt, HALF + Rs[0], Cs[0]); n11 = P.a_off(nxt, HALF + Rs[1], Cs[1]); nB = P.b_base(nxt); }
        for (int t = 0; t < nt; t += 2) {
            const bool last = (t == nt - 2);
            const size_t k1 = (size_t)(t + 1) * kstep;
            const size_t k2 = last ? 0 : (size_t)(t + 2) * kstep, k3 = k2 + kstep;
            const char* b2 = last ? nB : cB + (size_t)(t + 2) * kstep; const char* b3 = b2 + kstep;
            const unsigned x00 = last ? n00 : c00, x01 = last ? n01 : c01, x10 = last ? n10 : c10, x11 = last ? n11 : c11;
            PG8_LDB(B0, 0, 0); PG8_LDB(B1, 0, 1); PG8_SCHED; PG8_LDA(At, 0, 0); PG8_STAGE_A(PG8_SA(1, 1), k1, c10, c11);
            PG8_WAIT_V(8); PG8_WAIT_L(0); PG8_BAR; PG8_MMA(0, 0, At, B0); PG8_MMA(0, 1, At, B1); PG8_BAR; PG8_SCHED;
            PG8_LDA(At, 0, 1); PG8_STAGE_B(PG8_SB(0, 0), b2); PG8_STAGE_B(PG8_SB(0, 1), b2 + bhalf); PG8_STAGE_A(PG8_SA(0, 0), k2, x00, x01);
            PG8_WAIT_V(8); PG8_WAIT_L(0); PG8_BAR; PG8_MMA(1, 0, At, B0); PG8_MMA(1, 1, At, B1); PG8_BAR; PG8_SCHED;
            PG8_LDB(B0, 1, 0); PG8_LDB(B1, 1, 1); PG8_SCHED; PG8_LDA(At, 1, 0); PG8_STAGE_A(PG8_SA(0, 1), k2, x10, x11);
            PG8_WAIT_V(8); PG8_WAIT_L(0); PG8_BAR; PG8_MMA(0, 0, At, B0); PG8_MMA(0, 1, At, B1); PG8_BAR; PG8_SCHED;
            PG8_LDA(At, 1, 1); PG8_STAGE_B(PG8_SB(1, 0), b3); PG8_STAGE_B(PG8_SB(1, 1), b3 + bhalf); PG8_STAGE_A(PG8_SA(1, 0), k3, x00, x01);
            PG8_WAIT_V(8); PG8_WAIT_L(0); PG8_BAR; PG8_MMA(1, 0, At, B0); PG8_MMA(1, 1, At, B1); PG8_BAR; PG8_SCHED;
        }
        if constexpr (ALIGN_EPI) { if (wr == 0) PG8_BAR; }
        E(acc, cur, wr, wc, fr, fq);
        if (!has_next) break;
#pragma unroll
        for (int a = 0; a < 2; ++a)
#pragma unroll
            for (int b = 0; b < 2; ++b)
#pragma unroll
                for (int m = 0; m < 4; ++m)
#pragma unroll
                    for (int n = 0; n < 2; ++n) acc[a][b][m][n] = (f32x4){0.f, 0.f, 0.f, 0.f};
        cur = nxt; cB = nB; c00 = n00; c01 = n01; c10 = n10; c11 = n11; ++ui;
        if constexpr (ALIGN_EPI) { if (wr == 1) PG8_BAR; }
    }
    PG8_WAIT_V(0);
    if constexpr (!ALIGN_EPI) { if (wr == 0) PG8_BAR; }
    PG8_BAR;
#undef PG8_SA
#undef PG8_SB
#undef PG8_STAGE_A
#undef PG8_STAGE_B
#undef PG8_LDA
#undef PG8_LDB
#undef PG8_MMA
#undef PG8_WAIT_V
#undef PG8_WAIT_L
#undef PG8_BAR
#undef PG8_SCHED
}

__device__ __forceinline__ bool static_order(int nM, int nN, int G, int c, int i, int& pm, int& pn) {
    const int nwg = nM * nN; const long L = (long)i * G + c; if (L >= nwg) return false;
    int wgid = (int)L; { const int q = nwg / NXCD, r = nwg % NXCD, xcd = wgid % NXCD, off = wgid / NXCD; wgid = (xcd < r ? xcd * (q + 1) : r * (q + 1) + (xcd - r) * q) + off; }
    const int nig = WGM * nN, gid = wgid / nig, fm = gid * WGM, gsz = (nM - fm) < WGM ? (nM - fm) : WGM;
    pm = fm + ((wgid % nig) % gsz); pn = (wgid % nig) / gsz; return true;
}
struct DenseProb {
    const char* A; const char* Bt; int K, nM, nN, G, c; size_t b_half;
    __device__ __forceinline__ bool next(int i, Unit& u) const { u.e = 0; u.slot = i; return static_order(nM, nN, G, c, i, u.pm, u.pn); }
    __device__ __forceinline__ unsigned a_off(const Unit& u, int row, int col) const { return (unsigned)((u.pm * BM + row) * K + col) * 2u; }
    __device__ __forceinline__ const char* b_base(const Unit& u) const { return Bt + (size_t)u.pn * BM * K * 2; }
};
template <bool GATHER> struct MoeProb {
    const char* A; const char* Bt; int K, nN, G, c; size_t b_half; size_t b_expert; int b_tile_rows;
    const LAS int* tpre; const LAS int* tab;
    __device__ __forceinline__ int tp(int j) const { return __builtin_amdgcn_readfirstlane(tpre[j]); }
    __device__ __forceinline__ bool next(int i, Unit& u) const {
        const int total = tp(NE) * nN; const long L0 = (long)i * G + c; if (L0 >= total) return false;
        int L = (int)L0; { const int q = total / NXCD, r = total % NXCD, xcd = L % NXCD, off = L / NXCD; L = (xcd < r ? xcd * (q + 1) : r * (q + 1) + (xcd - r) * q) + off; }
        int e = 0;
#pragma unroll 1
        for (int j = 1; j < NE; ++j) e += (tp(j) * nN <= L) ? 1 : 0;
        const int first = tp(e) * nN, tiles = tp(e + 1) - tp(e), rem = L - first;
        u.e = e; u.pm = rem % tiles; u.pn = rem / tiles; u.slot = i; return true;
    }
    __device__ __forceinline__ unsigned a_off(const Unit& u, int row, int col) const {
        if (GATHER) { const int idx = tab[u.slot * 256 + row]; const int tok = idx < 0 ? 0 : (idx >> 2); return (unsigned)(tok * K + col) * 2u; }
        return (unsigned)(((tp(u.e) + u.pm) * BM + row) * K + col) * 2u;
    }
    __device__ __forceinline__ const char* b_base(const Unit& u) const { return Bt + (size_t)u.e * b_expert + (size_t)u.pn * b_tile_rows * K * 2; }
};
}

using pg8::Unit;
typedef f32x4 AccT[2][2][4][2];

struct EpiQKVU {
    static constexpr bool PERM = true;
    unsigned char* ws;
    __device__ __forceinline__ void operator()(const AccT& acc, const Unit& u, int wr, int wc, int fr, int fq) const {
        static_assert(WS_K - WS_Q == WS_V - WS_K, "Q, K, V equally spaced");
        const int t = (u.pn - 1) / 3;
        const size_t boff = (u.pn == 0) ? WS_U : (WS_Q + (size_t)t * (WS_K - WS_Q));
        bf16_t* base = (bf16_t*)(ws + boff);
        const int ldc = (u.pn == 0) ? PW : AW, colt = (u.pn == 0) ? 0 : ((u.pn - 1) % 3) * 256;
        const float sc = (u.pn >= 1 && u.pn <= 3) ? QSCALE : 1.f;
        const int row0 = u.pm * 256 + wr * 64 + fr, col0 = colt + wc * 32 + 8 * fq;
#pragma unroll
        for (int ai = 0; ai < 2; ++ai)
#pragma unroll
            for (int m = 0; m < 4; ++m) { bf16_t* rowp = base + (size_t)(row0 + ai * 128 + m * 16) * ldc + col0;
#pragma unroll
                for (int bj = 0; bj < 2; ++bj) { const f32x4 v0 = acc[ai][bj][m][0] * sc, v1 = acc[ai][bj][m][1] * sc;
                    u32x4 w; w.x = cvt_pk_bf16(v0[0], v0[1]); w.y = cvt_pk_bf16(v0[2], v0[3]); w.z = cvt_pk_bf16(v1[0], v1[1]); w.w = cvt_pk_bf16(v1[2], v1[3]);
                    *(u32x4*)(rowp + bj * 128) = w; } }
    }
};
struct EpiResF32 {
    static constexpr bool PERM = false;
    const float* X; float* O;
    __device__ __forceinline__ void operator()(const AccT& acc, const Unit& u, int wr, int wc, int fr, int fq) const {
        const int row0 = u.pm * 256 + wr * 64 + fr, col0 = u.pn * 256 + wc * 32 + 4 * fq;
#pragma unroll
        for (int ai = 0; ai < 2; ++ai)
#pragma unroll
            for (int m = 0; m < 4; ++m) { const size_t off = (size_t)(row0 + ai * 128 + m * 16) * D + col0;
#pragma unroll
                for (int bj = 0; bj < 2; ++bj)
#pragma unroll
                    for (int n = 0; n < 2; ++n) { const f32x4 r = *(const f32x4*)(X + off + bj * 128 + n * 16); *(f32x4*)(O + off + bj * 128 + n * 16) = acc[ai][bj][m][n] + r; } }
    }
};
__device__ __forceinline__ float swiglu1(float g, float u) {
    g = fminf(g, 7.0f); u = fminf(fmaxf(u, -7.0f), 7.0f);
    const float s = __builtin_amdgcn_rcpf(1.0f + __builtin_amdgcn_exp2f(g * (-1.702f * LOG2E)));
    return (u + 1.0f) * (g * s);
}
struct EpiGateUp {
    static constexpr bool PERM = true;
    bf16_t* ACT; const float* bgu; const float* rstd; const LAS int* tab; const LAS int* tpre;
    __device__ __forceinline__ void operator()(const AccT& acc, const Unit& u, int wr, int wc, int fr, int fq) const {
        const int colA = u.pn * 128 + wc * 32 + 8 * fq;
        const float* bp = bgu + (size_t)u.e * 2 * DFF + colA;
        const f32x4 bg0 = *(const f32x4*)(bp), bg1 = *(const f32x4*)(bp + 4), bu0 = *(const f32x4*)(bp + DFF), bu1 = *(const f32x4*)(bp + DFF + 4);
        const int srow0 = (__builtin_amdgcn_readfirstlane(tpre[u.e]) + u.pm) * 256;
#pragma unroll
        for (int ai = 0; ai < 2; ++ai)
#pragma unroll
            for (int m = 0; m < 4; ++m) { const int r = ai * 128 + wr * 64 + m * 16 + fr; const int idx = tab[u.slot * 256 + r]; const float rs = rstd[idx < 0 ? 0 : (idx >> 2)];
                const f32x4 g0 = acc[ai][0][m][0] * rs + bg0, g1 = acc[ai][0][m][1] * rs + bg1, u0 = acc[ai][1][m][0] * rs + bu0, u1 = acc[ai][1][m][1] * rs + bu1;
                u32x4 w; w.x = cvt_pk_bf16(swiglu1(g0[0], u0[0]), swiglu1(g0[1], u0[1])); w.y = cvt_pk_bf16(swiglu1(g0[2], u0[2]), swiglu1(g0[3], u0[3]));
                w.z = cvt_pk_bf16(swiglu1(g1[0], u1[0]), swiglu1(g1[1], u1[1])); w.w = cvt_pk_bf16(swiglu1(g1[2], u1[2]), swiglu1(g1[3], u1[3]));
                *(u32x4*)(ACT + (size_t)(srow0 + r) * DFF + colA) = w; }
    }
};
struct EpiDown {
    static constexpr bool PERM = true;
    bf16_t* Y; const float* bd; const float* gates; const LAS int* tab;
    __device__ __forceinline__ void operator()(const AccT& acc, const Unit& u, int wr, int wc, int fr, int fq) const {
        const int col0 = u.pn * 256 + wc * 32 + 8 * fq;
        const float* bp = bd + (size_t)u.e * D + col0;
        f32x4 bv[2][2];
#pragma unroll
        for (int bj = 0; bj < 2; ++bj) { bv[bj][0] = *(const f32x4*)(bp + bj * 128); bv[bj][1] = *(const f32x4*)(bp + bj * 128 + 4); }
#pragma unroll
        for (int ai = 0; ai < 2; ++ai)
#pragma unroll
            for (int m = 0; m < 4; ++m) { const int r = ai * 128 + wr * 64 + m * 16 + fr; const int idx = tab[u.slot * 256 + r];
                if (idx >= 0) { const float gv = gates[idx]; bf16_t* rowp = Y + (size_t)idx * D + col0;
#pragma unroll
                    for (int bj = 0; bj < 2; ++bj) { const f32x4 v0 = (acc[ai][bj][m][0] + bv[bj][0]) * gv, v1 = (acc[ai][bj][m][1] + bv[bj][1]) * gv;
                        u32x4 w; w.x = cvt_pk_bf16(v0[0], v0[1]); w.y = cvt_pk_bf16(v0[2], v0[3]); w.z = cvt_pk_bf16(v1[0], v1[1]); w.w = cvt_pk_bf16(v1[2], v1[3]);
                        *(u32x4*)(rowp + bj * 128) = w; } } }
    }
};

__device__ __forceinline__ void tr_item(const float* __restrict__ W, int K, int N, bf16_t* __restrict__ WT, LAS float* scr, int kb, int nb, int lane) {
    const int k0 = kb * 64, n0 = nb * 64;
    const float* src = W + (size_t)(k0 + (lane >> 4)) * N + n0 + (lane & 15) * 4;
    f32x4 v[16];
#pragma unroll
    for (int i = 0; i < 16; ++i) v[i] = *(const f32x4*)(src + (size_t)(4 * i) * N);
#pragma unroll
    for (int i = 0; i < 16; ++i) { LAS float* d = scr + (4 * i + (lane >> 4)) * 65 + (lane & 15) * 4; d[0] = v[i][0]; d[1] = v[i][1]; d[2] = v[i][2]; d[3] = v[i][3]; }
    LDS_WAIT();
    const int c = lane & 7;
#pragma unroll
    for (int j = 0; j < 8; ++j) { const int n = 8 * j + (lane >> 3); const LAS float* s = scr + (8 * c) * 65 + n;
        u32x4 o; o.x = cvt_pk_bf16(s[0], s[65]); o.y = cvt_pk_bf16(s[130], s[195]); o.z = cvt_pk_bf16(s[260], s[325]); o.w = cvt_pk_bf16(s[390], s[455]);
        *(u32x4*)(WT + (size_t)(n0 + n) * K + k0 + 8 * c) = o; }
    LDS_WAIT();
}
__device__ __forceinline__ int t5_bucket(int dist) {
    if (dist < 16) return dist;
    const int large = 16 + (int)(logf((float)dist / 16.0f) / 4.852030263919617f * 16.0f);
    return large < 31 ? large : 31;
}
struct In { const float *x, *norm1_g, *w_in, *pool_w, *pool_scale, *rel_bias, *w_out, *norm2_g, *router_w, *router_b, *w_gate_up, *b_gate_up, *w_down, *b_down, *final_g; };

__device__ __forceinline__ void p0_prologue(LAS unsigned char* lds, const In& in, unsigned char* ws, int G, int c) {
    const int tid = threadIdx.x, lane = tid & 63, wave = __builtin_amdgcn_readfirstlane(tid >> 6);
    const int gw = c * 8 + wave, NGW = G * 8;
    LAS float* scr = (LAS float*)(lds + wave * 16640);
    constexpr int I_IN = 16 * 40, I_OUT = 16 * 16, I_GU1 = 16 * 32, I_D1 = 16 * 16;
    constexpr int NITEMS = I_IN + I_OUT + NE * I_GU1 + NE * I_D1;
    for (int it = gw; it < NITEMS; it += NGW) {
        int r = it;
        if (r < I_IN) { tr_item(in.w_in, D, NPROJ, (bf16_t*)(ws + WS_WIN), scr, r / 40, r % 40, lane); continue; } r -= I_IN;
        if (r < I_OUT) { tr_item(in.w_out, D, D, (bf16_t*)(ws + WS_WOUT), scr, r / 16, r % 16, lane); continue; } r -= I_OUT;
        if (r < NE * I_GU1) { const int e = r / I_GU1, q = r % I_GU1; tr_item(in.w_gate_up + (size_t)e * D * 2 * DFF, D, 2 * DFF, (bf16_t*)(ws + WS_WGU) + (size_t)e * 2 * DFF * D, scr, q / 32, q % 32, lane); continue; } r -= NE * I_GU1;
        { const int e = r / I_D1, q = r % I_D1; tr_item(in.w_down + (size_t)e * DFF * D, DFF, D, (bf16_t*)(ws + WS_WD) + (size_t)e * D * DFF, scr, q / 16, q % 16, lane); }
    }
    {
        f32x4 gv[4];
#pragma unroll
        for (int j = 0; j < 4; ++j) gv[j] = *(const f32x4*)(in.norm1_g + 4 * lane + 256 * j);
        bf16_t* H = (bf16_t*)(ws + WS_H);
        for (int m = gw; m < S; m += NGW) {
            const float* xr = in.x + (size_t)m * D + 4 * lane;
            f32x4 v[4]; float s = 0.f;
#pragma unroll
            for (int j = 0; j < 4; ++j) { v[j] = *(const f32x4*)(xr + 256 * j); s += (v[j][0] * v[j][0] + v[j][1] * v[j][1]) + (v[j][2] * v[j][2] + v[j][3] * v[j][3]); }
            const float rstd = rsqrtf(wave_sum(s) * (1.0f / D) + RMS_EPS);
#pragma unroll
            for (int j = 0; j < 4; ++j) { const f32x4 o = v[j] * rstd * gv[j]; u32x2 w; w.x = cvt_pk_bf16(o[0], o[1]); w.y = cvt_pk_bf16(o[2], o[3]); *(u32x2*)(H + (size_t)m * D + 4 * lane + 256 * j) = w; }
        }
    }
    const int gt = c * 512 + tid, NGT = G * 512;
    { float* GWT = (float*)(ws + WS_GWT); for (int i = gt; i < NE * D; i += NGT) { const int e = i >> 10, k = i & 1023; GWT[i] = in.norm2_g[k] * in.router_w[k * NE + e]; } }
    { float* BT = (float*)(ws + WS_BT); for (int i = gt; i < 36 * BT_N; i += NGT) { const int bh = i / BT_N, j = i % BT_N, b = bh / NH, h = bh % NH, dil = (b == 0) ? 1 : (b == 1 ? 4 : 16), d = j - BT_OFF;
        BT[i] = (d >= 0 && d <= 128) ? in.rel_bias[t5_bucket(d * dil) * NH + h] * LOG2E : NEGBIG; } }
    { bf16_t* PWT = (bf16_t*)(ws + WS_PWT); for (int i = gt; i < 4 * 64 * 64; i += NGT) { const int g = i >> 12, d = (i >> 6) & 63, cc = i & 63; PWT[i] = (bf16_t)(cvt_pk_bf16(in.pool_w[g * 4096 + cc * 64 + d], 0.f) & 0xffffu); } }
}

__device__ __forceinline__ s16x4 lds_tr16(const LAS unsigned char* p) { typedef short v4i16_t __attribute__((ext_vector_type(4))); return __builtin_bit_cast(s16x4, __builtin_amdgcn_ds_read_tr16_b64_v4i16((LAS v4i16_t*)p)); }
constexpr int ATT_UNITS = 3 * NH * 128, KV_PITCH = 144, ATT_VOFF = 256 * KV_PITCH, ATT_TOFF = 2 * 256 * KV_PITCH;

__device__ __forceinline__ void attn_decode(int uid, int& b, int& h, int& r, int& j, int& dil) {
    const int bh = uid >> 7, x = uid & 127; b = bh / NH; h = bh % NH; dil = (b == 0) ? 1 : (b == 1 ? 4 : 16);
    const int nb = 128 / dil; r = x / nb; j = x % nb;
}
__device__ __forceinline__ void attn_phase(LAS unsigned char* lds, const bf16_t* __restrict__ Qg, const bf16_t* __restrict__ Kg, const bf16_t* __restrict__ Vg, const float* __restrict__ BT,
                                           bf16_t* __restrict__ OP, float* __restrict__ LSE, int G, int c) {
    const int tid = threadIdx.x, lane = tid & 63, w = __builtin_amdgcn_readfirstlane(tid >> 6), ql = lane & 15, g = lane >> 4;
    LAS unsigned char* Ks = lds; LAS unsigned char* Vs = lds + ATT_VOFF; LAS float* Tb = (LAS float*)(lds + ATT_TOFF);
    u32x4 kpre[4], vpre[4]; bf16x8 qpre0, qpre1; float tpre = 0.f;
#define ATT_PREFETCH(uid_) do { int b_, h_, r_, j_, dil_; attn_decode((uid_), b_, h_, r_, j_, dil_); \
        _Pragma("unroll") for (int cc = 0; cc < 4; ++cc) { const int id = tid + 512 * cc, row = id >> 3, ch = id & 7; int mm = 128 * (j_ - 1) + row; if (mm < 0) mm += 128; \
            const size_t off = (size_t)(r_ + dil_ * mm) * AW + h_ * HD + ch * 8; kpre[cc] = *(const u32x4*)(Kg + off); vpre[cc] = *(const u32x4*)(Vg + off); } \
        { const size_t qo = (size_t)(r_ + dil_ * (128 * j_ + 16 * w + ql)) * AW + h_ * HD + 8 * g; qpre0 = *(const bf16x8*)(Qg + qo); qpre1 = *(const bf16x8*)(Qg + qo + 32); } \
        if (tid < BT_N) tpre = BT[(b_ * NH + h_) * BT_N + tid]; } while (0)
    if (c < ATT_UNITS) ATT_PREFETCH(c);
    for (int uid = c; uid < ATT_UNITS; uid += G) {
        int b, h, r, j, dil; attn_decode(uid, b, h, r, j, dil);
#pragma unroll
        for (int cc = 0; cc < 4; ++cc) { const int id = tid + 512 * cc, row = id >> 3, ch = id & 7; *(LAS u32x4*)(Ks + row * KV_PITCH + ch * 16) = kpre[cc]; *(LAS u32x4*)(Vs + row * KV_PITCH + ch * 16) = vpre[cc]; }
        if (tid < BT_N) Tb[tid] = tpre;
        const bf16x8 qf0 = qpre0, qf1 = qpre1;
        __syncthreads();
        if (uid + G < ATT_UNITS) ATT_PREFETCH(uid + G);
        const int tstart = (j == 0) ? (8 - w) : 0;
        const LAS unsigned char* kb = Ks + (16 * w + ql) * KV_PITCH + g * 16;
        const LAS float* Tq = Tb + (ql + 272 - 4 * g - 3);
        float mx = NEGBIG;
        for (int tt = tstart; tt < 9; ++tt) {
            const bf16x8 kf0 = *(const LAS bf16x8*)(kb + tt * (16 * KV_PITCH)), kf1 = *(const LAS bf16x8*)(kb + tt * (16 * KV_PITCH) + 64);
            f32x4 st = __builtin_amdgcn_mfma_f32_16x16x32_bf16(kf0, qf0, (f32x4){0.f, 0.f, 0.f, 0.f}, 0, 0, 0);
            st = __builtin_amdgcn_mfma_f32_16x16x32_bf16(kf1, qf1, st, 0, 0, 0);
            const LAS float* tp = Tq - 16 * tt;
            mx = fmaxf(mx, fmaxf(fmaxf(st[0] + tp[3], st[1] + tp[2]), fmaxf(st[2] + tp[1], st[3] + tp[0])));
        }
        mx = fmaxf(mx, __shfl_xor(mx, 16)); mx = fmaxf(mx, __shfl_xor(mx, 32));
        const f32x4 negm = (f32x4){-mx, -mx, -mx, -mx};
        f32x4 o0 = (f32x4){0.f, 0.f, 0.f, 0.f}, o1 = o0, o2 = o0, o3 = o0; float ls = 0.f;
        const LAS unsigned char* vb = Vs + (16 * w + 4 * g + (ql >> 2)) * KV_PITCH + (ql & 3) * 8;
        for (int tt = tstart; tt < 9; ++tt) {
            const bf16x8 kf0 = *(const LAS bf16x8*)(kb + tt * (16 * KV_PITCH)), kf1 = *(const LAS bf16x8*)(kb + tt * (16 * KV_PITCH) + 64);
            f32x4 st = __builtin_amdgcn_mfma_f32_16x16x32_bf16(kf0, qf0, negm, 0, 0, 0);
            st = __builtin_amdgcn_mfma_f32_16x16x32_bf16(kf1, qf1, st, 0, 0, 0);
            const LAS float* tp = Tq - 16 * tt;
            const float p0 = __builtin_amdgcn_exp2f(st[0] + tp[3]), p1 = __builtin_amdgcn_exp2f(st[1] + tp[2]), p2 = __builtin_amdgcn_exp2f(st[2] + tp[1]), p3 = __builtin_amdgcn_exp2f(st[3] + tp[0]);
            ls += (p0 + p1) + (p2 + p3);
            u32x2 pw; pw.x = cvt_pk_bf16(p0, p1); pw.y = cvt_pk_bf16(p2, p3);
            const s16x4 pf = __builtin_bit_cast(s16x4, pw);
            const LAS unsigned char* vt = vb + tt * (16 * KV_PITCH);
            const s16x4 v0 = lds_tr16(vt), v1 = lds_tr16(vt + 32), v2 = lds_tr16(vt + 64), v3 = lds_tr16(vt + 96);
            o0 = __builtin_amdgcn_mfma_f32_16x16x16bf16_1k(v0, pf, o0, 0, 0, 0);
            o1 = __builtin_amdgcn_mfma_f32_16x16x16bf16_1k(v1, pf, o1, 0, 0, 0);
            o2 = __builtin_amdgcn_mfma_f32_16x16x16bf16_1k(v2, pf, o2, 0, 0, 0);
            o3 = __builtin_amdgcn_mfma_f32_16x16x16bf16_1k(v3, pf, o3, 0, 0, 0);
        }
        ls += __shfl_xor(ls, 16); ls += __shfl_xor(ls, 32);
        const float inv = 1.0f / ls;
        const int pos = r + dil * (128 * j + 16 * w + ql);
        bf16_t* dst = OP + ((size_t)b * S + pos) * AW + h * HD + 4 * g;
        { u32x2 t; t.x = cvt_pk_bf16(o0[0] * inv, o0[1] * inv); t.y = cvt_pk_bf16(o0[2] * inv, o0[3] * inv); *(u32x2*)(dst) = t; }
        { u32x2 t; t.x = cvt_pk_bf16(o1[0] * inv, o1[1] * inv); t.y = cvt_pk_bf16(o1[2] * inv, o1[3] * inv); *(u32x2*)(dst + 16) = t; }
        { u32x2 t; t.x = cvt_pk_bf16(o2[0] * inv, o2[1] * inv); t.y = cvt_pk_bf16(o2[2] * inv, o2[3] * inv); *(u32x2*)(dst + 32) = t; }
        { u32x2 t; t.x = cvt_pk_bf16(o3[0] * inv, o3[1] * inv); t.y = cvt_pk_bf16(o3[2] * inv, o3[3] * inv); *(u32x2*)(dst + 48) = t; }
        if (g == 0) LSE[((size_t)b * S + pos) * NH + h] = mx + __builtin_amdgcn_logf(ls);
        __syncthreads();
    }
#undef ATT_PREFETCH
}

__device__ __forceinline__ void pool_phase(LAS unsigned char* lds, const bf16_t* __restrict__ U, const bf16_t* __restrict__ PWT, const float* __restrict__ pool_scale, bf16_t* __restrict__ MIX, int G, int c) {
    const int tid = threadIdx.x, lane = tid & 63, w = __builtin_amdgcn_readfirstlane(tid >> 6), ql = lane & 15, g = lane >> 4;
    LAS unsigned char* Us = lds; LAS unsigned char* Pl = lds + 40960;
    for (int pu = c; pu < S / 64; pu += G) {
        const int t0 = pu * 64;
        for (int id = tid; id < 79 * 32; id += 512) { const int row = id >> 5, ch = id & 31, t = t0 - 15 + row;
            u32x4 v = (u32x4){0u, 0u, 0u, 0u}; if (t >= 0) v = *(const u32x4*)(U + (size_t)t * PW + ch * 8);
            *(LAS u32x4*)(Us + row * 512 + ch * 16) = v; }
        __syncthreads();
        { const int cch = tid & 255, th = tid >> 8, gg = cch >> 6, wn = 2 << gg, tl0 = 32 * th;
          const LAS bf16_t* up = (const LAS bf16_t*)Us + cch;
#define UAT(row) __uint_as_float(((unsigned)up[(row) * 256]) << 16)
          float sum = 0.f;
          for (int i = 0; i < wn; ++i) sum += UAT(tl0 + 15 - i);
          for (int tl = tl0; tl < tl0 + 32; ++tl) {
              if (tl > tl0) sum += UAT(tl + 15) - UAT(tl + 15 - wn);
              const int t = t0 + tl; const int cnt = (t + 1 < wn) ? (t + 1) : wn;
              const float val = sum / (float)cnt - UAT(tl + 15);
              ((LAS bf16_t*)(Pl + tl * 528))[cch] = (bf16_t)(cvt_pk_bf16(val, 0.f) & 0xffffu);
          }
#undef UAT
        }
        __syncthreads();
        { const int tt = w & 3, gp = w >> 2;
#pragma unroll
          for (int gi = 0; gi < 2; ++gi) { const int gg = 2 * gp + gi;
              const bf16x8 b0 = *(const LAS bf16x8*)(Pl + (16 * tt + ql) * 528 + (gg * 64 + 8 * g) * 2), b1 = *(const LAS bf16x8*)(Pl + (16 * tt + ql) * 528 + (gg * 64 + 32 + 8 * g) * 2);
#pragma unroll
              for (int nt = 0; nt < 4; ++nt) {
                  const bf16_t* ap = PWT + ((size_t)(gg * 64 + 16 * nt + ql) * 64 + 8 * g);
                  const bf16x8 a0 = *(const bf16x8*)(ap), a1 = *(const bf16x8*)(ap + 32);
                  f32x4 acc = __builtin_amdgcn_mfma_f32_16x16x32_bf16(a0, b0, (f32x4){0.f, 0.f, 0.f, 0.f}, 0, 0, 0);
                  acc = __builtin_amdgcn_mfma_f32_16x16x32_bf16(a1, b1, acc, 0, 0, 0);
                  const f32x4 ps = *(const f32x4*)(pool_scale + gg * 64 + 16 * nt + 4 * g);
                  u32x2 o; o.x = cvt_pk_bf16(acc[0] * ps[0], acc[1] * ps[1]); o.y = cvt_pk_bf16(acc[2] * ps[2], acc[3] * ps[3]);
                  *(u32x2*)(MIX + (size_t)(t0 + 16 * tt + ql) * D + gg * 64 + 16 * nt + 4 * g) = o;
              } }
        }
        __syncthreads();
    }
}

__device__ __forceinline__ void combine_phase(const bf16_t* __restrict__ OP, const float* __restrict__ LSE, bf16_t* __restrict__ MIX, int G, int c) {
    const int gt = c * 512 + threadIdx.x, NGT = G * 512;
    for (int id = gt; id < S * 96; id += NGT) {
        const int t = id / 96, rem = id % 96, h = rem >> 3, c8 = rem & 7;
        const float l0 = LSE[(size_t)t * NH + h], l1 = LSE[((size_t)S + t) * NH + h], l2 = LSE[((size_t)2 * S + t) * NH + h];
        const float mx = fmaxf(l0, fmaxf(l1, l2));
        float w0 = __builtin_amdgcn_exp2f(l0 - mx), w1 = __builtin_amdgcn_exp2f(l1 - mx), w2 = __builtin_amdgcn_exp2f(l2 - mx);
        const float inv = 1.0f / (w0 + w1 + w2); w0 *= inv; w1 *= inv; w2 *= inv;
        const size_t off = (size_t)t * AW + h * HD + c8 * 8;
        const u32x4 a = *(const u32x4*)(OP + off), b = *(const u32x4*)(OP + (size_t)S * AW + off), cc = *(const u32x4*)(OP + (size_t)2 * S * AW + off);
        u32x4 o;
#pragma unroll
        for (int k = 0; k < 4; ++k) { const float lo = w0 * bf_lo(a[k]) + w1 * bf_lo(b[k]) + w2 * bf_lo(cc[k]), hi = w0 * bf_hi(a[k]) + w1 * bf_hi(b[k]) + w2 * bf_hi(cc[k]); o[k] = cvt_pk_bf16(lo, hi); }
        *(u32x4*)(MIX + (size_t)t * D + PW + h * HD + c8 * 8) = o;
    }
}

constexpr int GW_PITCH = 1028;
__device__ __forceinline__ void router_phase(LAS unsigned char* lds, const float* __restrict__ X1, const float* __restrict__ g2, const float* __restrict__ GWT, const float* __restrict__ rb,
                                             bf16_t* __restrict__ H, float* __restrict__ RSTD, float* __restrict__ GATES, int* __restrict__ ROWS, unsigned* __restrict__ COUNTS, int G, int c) {
    const int tid = threadIdx.x, lane = tid & 63, w = __builtin_amdgcn_readfirstlane(tid >> 6), ql = lane & 15, g = lane >> 4;
    LAS float* GW = (LAS float*)lds;
    LAS float* LG = (LAS float*)(lds + 131584) + (w & 3) * (16 * 33);
    LAS float* RS = (LAS float*)(lds + 131584 + 4 * 16 * 33 * 4) + (w & 3) * 16;
    LAS int* LCNT = (LAS int*)(lds + 131584 + 4 * 16 * 33 * 4 + 4 * 16 * 4);
    LAS int* LBASE = LCNT + 32;
    for (int id = tid; id < NE * 256; id += 512) { const int e = id >> 8, k4 = id & 255; *(LAS f32x4*)(GW + e * GW_PITCH + k4 * 4) = *(const f32x4*)(GWT + e * D + k4 * 4); }
    const int nrounds = (S / 16 + 4 * G - 1) / (4 * G);
    for (int rd = 0; rd < nrounds; ++rd) {
        if (tid < 32) LCNT[tid] = 0;
        __syncthreads();
        const int tile = (rd * 4 + w) * G + c;
        int ek[4] = {0, 0, 0, 0}, lp[4] = {0, 0, 0, 0}; float gk[4] = {0.f, 0.f, 0.f, 0.f};
        const bool active = (w < 4) && (tile < S / 16);
        if (active) {
            const int tok = tile * 16 + ql;
            const float* xr = X1 + (size_t)tok * D + 8 * g;
            bf16_t* hr = H + (size_t)tok * D + 8 * g;
            const LAS float* w0p = GW + ql * GW_PITCH + 8 * g; const LAS float* w1p = GW + (16 + ql) * GW_PITCH + 8 * g;
            f32x4 acc0 = (f32x4){0.f, 0.f, 0.f, 0.f}, acc1 = acc0; float ss = 0.f;
#pragma unroll 2
            for (int k0 = 0; k0 < D; k0 += 32) {
                const f32x4 a0 = *(const f32x4*)(xr + k0), a1 = *(const f32x4*)(xr + k0 + 4);
                const f32x4 n0 = *(const f32x4*)(g2 + k0 + 8 * g), n1 = *(const f32x4*)(g2 + k0 + 8 * g + 4);
                const f32x4 b00 = *(const LAS f32x4*)(w0p + k0), b01 = *(const LAS f32x4*)(w0p + k0 + 4), b10 = *(const LAS f32x4*)(w1p + k0), b11 = *(const LAS f32x4*)(w1p + k0 + 4);
                ss += (a0[0] * a0[0] + a0[1] * a0[1]) + (a0[2] * a0[2] + a0[3] * a0[3]) + (a1[0] * a1[0] + a1[1] * a1[1]) + (a1[2] * a1[2] + a1[3] * a1[3]);
                u32x4 hv; hv.x = cvt_pk_bf16(a0[0] * n0[0], a0[1] * n0[1]); hv.y = cvt_pk_bf16(a0[2] * n0[2], a0[3] * n0[3]); hv.z = cvt_pk_bf16(a1[0] * n1[0], a1[1] * n1[1]); hv.w = cvt_pk_bf16(a1[2] * n1[2], a1[3] * n1[3]);
                *(u32x4*)(hr + k0) = hv;
#pragma unroll
                for (int jj = 0; jj < 4; ++jj) { acc0 = __builtin_amdgcn_mfma_f32_16x16x4f32(a0[jj], b00[jj], acc0, 0, 0, 0); acc1 = __builtin_amdgcn_mfma_f32_16x16x4f32(a0[jj], b10[jj], acc1, 0, 0, 0); }
#pragma unroll
                for (int jj = 0; jj < 4; ++jj) { acc0 = __builtin_amdgcn_mfma_f32_16x16x4f32(a1[jj], b01[jj], acc0, 0, 0, 0); acc1 = __builtin_amdgcn_mfma_f32_16x16x4f32(a1[jj], b11[jj], acc1, 0, 0, 0); }
            }
            ss += __shfl_xor(ss, 16); ss += __shfl_xor(ss, 32);
            const float rstd = rsqrtf(ss * (1.0f / D) + RMS_EPS);
            if (g == 0) { RSTD[tok] = rstd; RS[ql] = rstd; }
            LDS_WAIT();
            const float rb0 = rb[ql], rb1 = rb[16 + ql];
#pragma unroll
            for (int rg = 0; rg < 4; ++rg) { const float rr = RS[4 * g + rg]; LG[(4 * g + rg) * 33 + ql] = acc0[rg] * rr + rb0; LG[(4 * g + rg) * 33 + 16 + ql] = acc1[rg] * rr + rb1; }
            LDS_WAIT();
            if (lane < 16) {
                float v[32];
#pragma unroll
                for (int e = 0; e < 32; ++e) v[e] = LG[ql * 33 + e];
                float tv[4];
#pragma unroll
                for (int r = 0; r < 4; ++r) { float best = v[0]; int bi = 0;
#pragma unroll
                    for (int e = 1; e < 32; ++e) { const bool gt = v[e] > best; best = gt ? v[e] : best; bi = gt ? e : bi; }
                    tv[r] = best; ek[r] = bi;
#pragma unroll
                    for (int e = 0; e < 32; ++e) v[e] = (e == bi) ? -INFINITY : v[e]; }
                const float e1 = __expf(tv[1] - tv[0]), e2 = __expf(tv[2] - tv[0]), e3 = __expf(tv[3] - tv[0]); const float inv = 1.0f / (1.0f + e1 + e2 + e3);
                gk[0] = inv; gk[1] = e1 * inv; gk[2] = e2 * inv; gk[3] = e3 * inv;
#pragma unroll
                for (int r = 0; r < 4; ++r) lp[r] = __hip_atomic_fetch_add(LCNT + ek[r], 1, __ATOMIC_RELAXED, __HIP_MEMORY_SCOPE_WORKGROUP);
            }
        }
        __syncthreads();
        if (tid < 32) { const int n = LCNT[tid]; int base = 0; if (n > 0) base = (int)__hip_atomic_fetch_add(COUNTS + tid, (unsigned)n, __ATOMIC_RELAXED, __HIP_MEMORY_SCOPE_AGENT); LBASE[tid] = base; }
        __syncthreads();
        if (active && lane < 16) { const int tok = tile * 16 + ql;
#pragma unroll
            for (int r = 0; r < 4; ++r) { const int pos = LBASE[ek[r]] + lp[r]; ROWS[(size_t)ek[r] * S + pos] = tok * 4 + r; GATES[tok * 4 + r] = gk[r]; } }
        __syncthreads();
    }
}

__device__ __forceinline__ void moe_prefix(LAS int* tpre, LAS int* lcnt, const unsigned* __restrict__ COUNTS) {
    if (threadIdx.x < 32) lcnt[threadIdx.x] = (int)COUNTS[threadIdx.x];
    __syncthreads();
    if (threadIdx.x == 0) { int acc = 0; for (int e = 0; e < NE; ++e) { tpre[e] = acc; acc += (lcnt[e] + 255) >> 8; } tpre[NE] = acc; }
    __syncthreads();
}
template <class Prob> __device__ __forceinline__ void moe_table(const Prob& P, LAS int* tab, const LAS int* lcnt, const int* __restrict__ ROWS) {
    Unit u;
    for (int i = 0; i < MAXU && P.next(i, u); ++i) {
        if (threadIdx.x < 256) { const int rr = u.pm * 256 + (int)threadIdx.x; tab[i * 256 + threadIdx.x] = (rr < lcnt[u.e]) ? ROWS[(size_t)u.e * S + rr] : -1; }
    }
    __syncthreads();
}

__device__ __forceinline__ void final_phase(const float* __restrict__ X1, const bf16_t* __restrict__ Y, const float* __restrict__ fg, float* __restrict__ out, int G, int c) {
    const int tid = threadIdx.x, lane = tid & 63, wave = tid >> 6; const int gw = c * 8 + wave, NGW = G * 8;
    f32x4 gv[4];
#pragma unroll
    for (int j = 0; j < 4; ++j) gv[j] = *(const f32x4*)(fg + 4 * lane + 256 * j);
    for (int m = gw; m < S; m += NGW) {
        const float* xr = X1 + (size_t)m * D + 4 * lane;
        f32x4 v[4];
#pragma unroll
        for (int j = 0; j < 4; ++j) v[j] = *(const f32x4*)(xr + 256 * j);
#pragma unroll
        for (int k = 0; k < 4; ++k) { const bf16_t* yr = Y + ((size_t)m * 4 + k) * D + 4 * lane;
#pragma unroll
            for (int j = 0; j < 4; ++j) { const u32x2 t = *(const u32x2*)(yr + 256 * j); v[j][0] += bf_lo(t.x); v[j][1] += bf_hi(t.x); v[j][2] += bf_lo(t.y); v[j][3] += bf_hi(t.y); } }
        float s = 0.f;
#pragma unroll
        for (int j = 0; j < 4; ++j) s += (v[j][0] * v[j][0] + v[j][1] * v[j][1]) + (v[j][2] * v[j][2] + v[j][3] * v[j][3]);
        const float rstd = rsqrtf(wave_sum(s) * (1.0f / D) + RMS_EPS);
#pragma unroll
        for (int j = 0; j < 4; ++j) *(f32x4*)(out + (size_t)m * D + 4 * lane + 256 * j) = v[j] * rstd * gv[j];
    }
}

constexpr int NPHASE = 9;
struct Args { In in; float* out; unsigned char* ws; int ph_lo, ph_hi; };
__global__ void __launch_bounds__(512, 2) fwd(Args args) {
    extern __shared__ __attribute__((aligned(16))) unsigned char lds_raw[];
    LAS unsigned char* lds = (LAS unsigned char*)lds_raw;
    const int tid = threadIdx.x, G = gridDim.x, c = blockIdx.x;
    unsigned char* ws = args.ws; const In& in = args.in;
    unsigned* ctl = (unsigned*)(ws + WS_CTL);
    LAS int* LCTL = (LAS int*)(lds + LDS_CTL);
    if (tid < 256) LCTL[tid] = 0;
    __syncthreads();
    const int lo = args.ph_lo, hi = args.ph_hi;
    const bool one_launch = (hi - lo) > 1;
    XcdBarrier bar; bar.bar = ctl + CW_BAR; bar.x = 0; bar.st = nullptr;
    if (one_launch) bar = xcd_barrier_post(ctl + CW_BAR, (volatile LAS unsigned*)LCTL);
#define IN(k) (lo <= (k) && (k) < hi)
#define SEAM(k) do { if (IN((k) + 1)) xcd_barrier(bar); } while (0)
    bf16_t* Hb = (bf16_t*)(ws + WS_H); bf16_t* Ub = (bf16_t*)(ws + WS_U); bf16_t* Qb = (bf16_t*)(ws + WS_Q); bf16_t* Kb = (bf16_t*)(ws + WS_K); bf16_t* Vb = (bf16_t*)(ws + WS_V);
    bf16_t* OPb = (bf16_t*)(ws + WS_OP); bf16_t* MIXb = (bf16_t*)(ws + WS_MIX); float* X1 = (float*)(ws + WS_X1); bf16_t* ACTb = (bf16_t*)(ws + WS_ACT); bf16_t* Yb = (bf16_t*)(ws + WS_Y);
    float* LSE = (float*)(ws + WS_LSE); float* RSTD = (float*)(ws + WS_RSTD); float* GATES = (float*)(ws + WS_GATES); int* ROWS = (int*)(ws + WS_ROWS); unsigned* COUNTS = ctl + CW_COUNTS;
    LAS int* TPRE = LCTL + 16; LAS int* LCNT = LCTL + 128; LAS int* TAB = (LAS int*)(lds + LDS_TAB);

    if (IN(0)) { p0_prologue(lds, in, ws, G, c); SEAM(0); }
    if (IN(1)) {
        pg8::DenseProb P{(const char*)Hb, (const char*)(ws + WS_WIN), D, S / 256, NPROJ / 256, G, c, (size_t)128 * D * 2};
        EpiQKVU E{ws};
        pg8::gemm_phase<EpiQKVU, pg8::DenseProb, true>(lds, P, E);
        SEAM(1);
    }
    if (IN(2)) {
        attn_phase(lds, Qb, Kb, Vb, (const float*)(ws + WS_BT), OPb, LSE, G, c);
        pool_phase(lds, Ub, (const bf16_t*)(ws + WS_PWT), in.pool_scale, MIXb, G, c);
        SEAM(2);
    }
    if (IN(3)) { combine_phase(OPb, LSE, MIXb, G, c); SEAM(3); }
    if (IN(4)) {
        pg8::DenseProb P{(const char*)MIXb, (const char*)(ws + WS_WOUT), D, S / 256, D / 256, G, c, (size_t)128 * D * 2};
        EpiResF32 E{in.x, X1};
        pg8::gemm_phase<EpiResF32, pg8::DenseProb, true>(lds, P, E);
        SEAM(4);
    }
    if (IN(5)) { router_phase(lds, X1, in.norm2_g, (const float*)(ws + WS_GWT), in.router_b, Hb, RSTD, GATES, ROWS, COUNTS, G, c); SEAM(5); }
    if (IN(6)) {
        moe_prefix(TPRE, LCNT, COUNTS);
        pg8::MoeProb<true> P{(const char*)Hb, (const char*)(ws + WS_WGU), D, 8, G, c, (size_t)DFF * D * 2, (size_t)2 * DFF * D * 2, 128, TPRE, TAB};
        moe_table(P, TAB, LCNT, ROWS);
        EpiGateUp E{ACTb, in.b_gate_up, RSTD, TAB, TPRE};
        pg8::gemm_phase<EpiGateUp, pg8::MoeProb<true>, true>(lds, P, E);
        SEAM(6);
    }
    if (IN(7)) {
        moe_prefix(TPRE, LCNT, COUNTS);
        pg8::MoeProb<false> P{(const char*)ACTb, (const char*)(ws + WS_WD), DFF, 4, G, c, (size_t)128 * DFF * 2, (size_t)D * DFF * 2, 256, TPRE, TAB};
        moe_table(P, TAB, LCNT, ROWS);
        EpiDown E{Yb, in.b_down, GATES, TAB};
        pg8::gemm_phase<EpiDown, pg8::MoeProb<false>, true>(lds, P, E);
        SEAM(7);
    }
    if (IN(8)) final_phase(X1, Yb, in.final_g, args.out, G, c);
#undef IN
#undef SEAM
}

#ifndef MK_N_LAUNCHES
#define MK_N_LAUNCHES 1
#endif
extern "C" void kernel_launch(void* const* d_in, const int* in_sizes, int n_in, void* d_out, int out_size, void* d_ws, size_t ws_size, hipStream_t stream) {
    static int grid = 0;
    if (grid == 0) {
        if (n_in != 15 || out_size != S * D || ws_size < WS_END) { fprintf(stderr, "kernel_launch: unexpected problem (n_in %d out %d ws %zu)\n", n_in, out_size, ws_size); grid = -1; return; }
        int dev = 0, cus = 0, per_cu = 0;
        if (hipGetDevice(&dev) != hipSuccess || hipDeviceGetAttribute(&cus, hipDeviceAttributeMultiprocessorCount, dev) != hipSuccess) { grid = -1; return; }
        if (hipFuncSetAttribute((const void*)fwd, hipFuncAttributeMaxDynamicSharedMemorySize, LDS_BYTES) != hipSuccess) { fprintf(stderr, "kernel_launch: hipFuncSetAttribute failed\n"); grid = -1; return; }
        if (hipOccupancyMaxActiveBlocksPerMultiprocessor(&per_cu, (const void*)fwd, 512, LDS_BYTES) != hipSuccess || per_cu < 1) { fprintf(stderr, "kernel_launch: occupancy query says %d blocks per CU\n", per_cu); (void)hipGetLastError(); per_cu = 1; }
        grid = cus;
    }
    if (grid < 0) return;
    if (hipMemsetAsync((char*)d_ws + WS_CTL, 0, CTL_ZERO_BYTES, stream) != hipSuccess) { fprintf(stderr, "kernel_launch: memset failed\n"); return; }
    Args a{};
    a.in.x = (const float*)d_in[0]; a.in.norm1_g = (const float*)d_in[1]; a.in.w_in = (const float*)d_in[2]; a.in.pool_w = (const float*)d_in[3]; a.in.pool_scale = (const float*)d_in[4];
    a.in.rel_bias = (const float*)d_in[5]; a.in.w_out = (const float*)d_in[6]; a.in.norm2_g = (const float*)d_in[7]; a.in.router_w = (const float*)d_in[8]; a.in.router_b = (const float*)d_in[9];
    a.in.w_gate_up = (const float*)d_in[10]; a.in.b_gate_up = (const float*)d_in[11]; a.in.w_down = (const float*)d_in[12]; a.in.b_down = (const float*)d_in[13]; a.in.final_g = (const float*)d_in[14];
    a.out = (float*)d_out; a.ws = (unsigned char*)d_ws;
    if (MK_N_LAUNCHES == 1) { a.ph_lo = 0; a.ph_hi = NPHASE; hipLaunchKernelGGL(fwd, dim3(grid), dim3(512), LDS_BYTES, stream, a); }
    else for (int p = 0; p < NPHASE; ++p) { a.ph_lo = p; a.ph_hi = p + 1; hipLaunchKernelGGL(fwd, dim3(grid), dim3(512), LDS_BYTES, stream, a); }
    const hipError_t le = hipPeekAtLastError();
    if (le != hipSuccess) fprintf(stderr, "kernel_launch: launch failed: %s\n", hipGetErrorName(le));
}
```

```cpp
#include <hip/hip_runtime.h>
#include <cstdio>
#include <cstdint>

#define LAS __attribute__((address_space(3)))
#define GAS __attribute__((address_space(1)))
typedef unsigned short bf16_t;
typedef short bf16x8 __attribute__((ext_vector_type(8)));
typedef short s16x4 __attribute__((ext_vector_type(4)));
typedef float f32x4 __attribute__((ext_vector_type(4)));
typedef float f32x2 __attribute__((ext_vector_type(2)));
typedef unsigned u32x4 __attribute__((ext_vector_type(4)));
typedef unsigned u32x2 __attribute__((ext_vector_type(2)));
typedef int i32x4 __attribute__((ext_vector_type(4)));
typedef int i32x8 __attribute__((ext_vector_type(8)));

constexpr int S = 16384, D = 1024, NPROJ = 2560, PW = 256, AW = 768, NH = 12, HD = 64, NE = 32, TOPK = 4, DFF = 1024;
constexpr float RMS_EPS = 1e-5f, LOG2E = 1.4426950408889634f, QSCALE = 0.125f * LOG2E, NEGBIG = -1e30f;
constexpr float WSCALE = 64.0f, HSCALE = 16.0f, ASCALE = 8.0f, FP8MAX = 448.0f;
constexpr int BT_N = 400, BT_OFF = 144;

constexpr size_t MiB = 1u << 20;
constexpr size_t WS_CTL = 0, CTL_ZERO_BYTES = 64 * 1024;
constexpr size_t WS_WIN = 2 * MiB;
constexpr size_t WS_WOUT = 8 * MiB;
constexpr size_t WS_GWT = 10 * MiB;
constexpr size_t WS_BT = 10 * MiB + 512 * 1024;
constexpr size_t WS_PWT = 10 * MiB + 768 * 1024;
constexpr size_t WS_RSTD = 11 * MiB;
constexpr size_t WS_GATES = 11 * MiB + 256 * 1024;
constexpr size_t WS_ROWS = 12 * MiB;
constexpr size_t WS_LSE = 14 * MiB;
constexpr size_t WS_WGU = 32 * MiB;
constexpr size_t WS_WD = 160 * MiB;
constexpr size_t WS_H8 = 200 * MiB;
constexpr size_t WS_H = 224 * MiB;
constexpr size_t WS_U = 256 * MiB;
constexpr size_t WS_Q = 264 * MiB, WS_K = 288 * MiB, WS_V = 312 * MiB;
constexpr size_t WS_OP = 336 * MiB;
constexpr size_t WS_MIX = 408 * MiB;
constexpr size_t WS_X1 = 440 * MiB;
constexpr size_t WS_ACT = 512 * MiB;
constexpr size_t WS_Y = 656 * MiB;
constexpr size_t WS_END = 784 * MiB;
constexpr int ACT_ROWS = 65536 + 32 * 256;
constexpr int CW_COUNTS = 64;
constexpr int CW_BAR = 4096;

constexpr int LDS_BYTES = 147456;
constexpr int LDS_TAB = 131072;
constexpr int LDS_CTL = LDS_BYTES - 1024;
constexpr int MAXU = 9;

__device__ __forceinline__ unsigned cvt_pk_bf16(float lo, float hi) { unsigned r; asm volatile("v_cvt_pk_bf16_f32 %0, %1, %2" : "=v"(r) : "v"(lo), "v"(hi)); return r; }
__device__ __forceinline__ float clamp8(float v) { return fminf(fmaxf(v, -FP8MAX), FP8MAX); }
__device__ __forceinline__ unsigned cvt4_fp8(float a, float b, float c, float d) {
    int p = __builtin_amdgcn_cvt_pk_fp8_f32(clamp8(a), clamp8(b), 0, false); p = __builtin_amdgcn_cvt_pk_fp8_f32(clamp8(c), clamp8(d), p, true); return (unsigned)p; }
__device__ __forceinline__ float bf_lo(unsigned w) { return __uint_as_float(w << 16); }
__device__ __forceinline__ float bf_hi(unsigned w) { return __uint_as_float(w & 0xffff0000u); }
__device__ __forceinline__ float wave_sum(float v) {
#pragma unroll
    for (int o = 1; o < 64; o <<= 1) v += __shfl_xor(v, o);
    return v;
}
#define LDS_WAIT() asm volatile("s_waitcnt lgkmcnt(0)" ::: "memory")
#define VM_WAIT() asm volatile("s_waitcnt vmcnt(0)" ::: "memory")

#define XB_TMO      128
#define XB_XCNT(j)  (256  + 64 * (j))
#define XB_XSUB(j)  (1280 + 64 * (j))
#define XB_XGEN(j)  (2304 + 64 * (j))
#define XB_TOP      3328
#define XB_TOPGEN   3392
#define XCD_BAR_WORDS 3456
#define XB_SPIN_CAP (1u << 18)
__device__ __forceinline__ unsigned xb_ld(unsigned* p)              { return __hip_atomic_load(p, __ATOMIC_RELAXED, __HIP_MEMORY_SCOPE_AGENT); }
__device__ __forceinline__ unsigned xb_add(unsigned* p, unsigned v) { return __hip_atomic_fetch_add(p, v, __ATOMIC_RELAXED, __HIP_MEMORY_SCOPE_AGENT); }
__device__ __forceinline__ unsigned xb_xcc_id() { return (unsigned)__builtin_amdgcn_s_getreg((3 << 11) | 20) & 0xFu; }
#define XB_SPIN(cond, bar) do { unsigned _sp = 0; while (cond) { __builtin_amdgcn_s_sleep(1); \
    if ((++_sp & 255u) == 0u) { if (xb_ld(&(bar)[XB_TMO])) break; if (_sp > XB_SPIN_CAP) { atomicAdd(&(bar)[XB_TMO], 1u); break; } } } } while (0)
struct XcdBarrier { unsigned* bar; unsigned x; volatile LAS unsigned* st; };
__device__ __forceinline__ XcdBarrier xcd_barrier_post(unsigned* bar, volatile LAS unsigned* st) {
    XcdBarrier b; b.bar = bar; b.x = xb_xcc_id(); b.st = st;
    if (threadIdx.x == 0) (void)xb_add(&bar[XB_XCNT(b.x)], 1u);
    return b;
}
__device__ __forceinline__ void xcd_barrier_complete(unsigned* bar, unsigned x, unsigned& nloc, unsigned& nx) {
    const unsigned G = gridDim.x * gridDim.y * gridDim.z;
    unsigned sum, cnt, mine, sp = 0u;
    for (;;) {
        sum = 0u; cnt = 0u; mine = 0u;
#pragma unroll
        for (unsigned j = 0; j < 16; ++j) { const unsigned c = xb_ld(&bar[XB_XCNT(j)]); sum += c; cnt += (c > 0u) ? 1u : 0u; mine = (j == x) ? c : mine; }
        if (sum == G) break;
        __builtin_amdgcn_s_sleep(1);
        if ((++sp & 255u) == 0u) { if (xb_ld(&bar[XB_TMO])) break; if (sp > XB_SPIN_CAP) { atomicAdd(&bar[XB_TMO], 1u); break; } }
    }
    nloc = mine > 0u ? mine : 1u; nx = cnt > 0u ? cnt : 1u;
}
__device__ __forceinline__ void xcd_barrier(const XcdBarrier& b) {
    asm volatile("s_waitcnt vmcnt(0)" ::: "memory");
    __syncthreads();
    if (threadIdx.x == 0) {
        unsigned* bar = b.bar;
        __builtin_amdgcn_s_waitcnt(0);
        unsigned nloc = b.st[0], nx = b.st[1];
        if (nloc == 0u) { xcd_barrier_complete(bar, b.x, nloc, nx); b.st[0] = nloc; b.st[1] = nx; }
        const unsigned old = xb_add(&bar[XB_XSUB(b.x)], 1u);
        const unsigned gen = old / nloc;
        if (old + 1u == (gen + 1u) * nloc) {
            __builtin_amdgcn_fence(__ATOMIC_RELEASE, "agent");
            asm volatile("s_waitcnt vmcnt(0)" ::: "memory");
            const unsigned og = xb_add(&bar[XB_TOP], 1u);
            const unsigned tg = og / nx;
            if (og + 1u == (tg + 1u) * nx) xb_add(&bar[XB_TOPGEN], 1u);
            else XB_SPIN(xb_ld(&bar[XB_TOPGEN]) == tg, bar);
            __builtin_amdgcn_fence(__ATOMIC_ACQUIRE, "agent");
            xb_add(&bar[XB_XGEN(b.x)], 1u);
            asm volatile("s_waitcnt vmcnt(0)" ::: "memory");
        } else {
            XB_SPIN(xb_ld(&bar[XB_XGEN(b.x)]) == gen, bar);
            __builtin_amdgcn_fence(__ATOMIC_ACQUIRE, "agent");
            asm volatile("s_waitcnt vmcnt(0)" ::: "memory");
        }
    }
    __syncthreads();
}

namespace pg8 {
constexpr int BM = 256, BK = 64, HALF = 128, HTB = HALF * BK * 2, STAGE_BYTES = 8 * HTB, NXCD = 8, WGM = 8;
__host__ __device__ __forceinline__ int lds_byte(int r, int c) { const int st = (r >> 4) * 2 + (c >> 5), rr = r & 15, cc = c & 31, ob = rr * 64 + cc * 2; return st * 1024 + (ob ^ (((ob >> 9) & 1) << 5)); }
__host__ __device__ __forceinline__ void stage_rc(int b, int& R, int& C) { const int st = b / 1024, sb = b % 1024, swz = sb ^ (((sb >> 9) & 1) << 5); R = (st >> 1) * 16 + swz / 64; C = (st & 1) * 32 + (swz % 64) / 2; }
__host__ __device__ __forceinline__ int perm32(int rho) { const int n = rho >> 4, i = rho & 15; return 8 * (i >> 2) + 4 * n + (i & 3); }

struct Unit { int pm, pn, e, slot; };

template <class Epi, class Prob, bool ALIGN_EPI, bool FP8>
__device__ __forceinline__ void gemm_phase(LAS unsigned char* lds, const Prob& P, const Epi& E) {
    const int tid = threadIdx.x, wid = __builtin_amdgcn_readfirstlane(tid >> 6), lane = tid & 63, wr = wid >> 2, wc = wid & 3, fr = lane & 15, fq = lane >> 4;
    const int rowb = P.rowb, nt = rowb / 128;
    int Rs[2], Cs[2]; unsigned voffB[2];
#pragma unroll
    for (int i = 0; i < 2; ++i) { int R, C; stage_rc(tid * 16 + i * 8192, R, C); const int Rb = Epi::PERM ? ((R & ~31) + perm32(R & 31)) : R;
        Rs[i] = R; Cs[i] = C * 2; voffB[i] = (unsigned)(Rb * rowb + C * 2); }
    const size_t kstep = (size_t)(BK * 2);
    const size_t bhalf = P.b_half;
    const unsigned ldsw = (unsigned)wid * 1024u;
    const int aoff = lds_byte(wr * 64 + fr, fq * 8), boff = lds_byte(wc * 32 + fr, fq * 8);
#define PG8_SA(b, h) (((b) * 2 + (h)) * HTB)
#define PG8_SB(b, h) ((4 + (b) * 2 + (h)) * HTB)
#define PG8_STAGE_B(bufoff, gbase) do { _Pragma("unroll") for (int _i = 0; _i < 2; ++_i) \
        __builtin_amdgcn_global_load_lds((const unsigned*)((const char*)(gbase) + voffB[_i]), (LAS unsigned*)(lds + (bufoff) + ldsw + _i * 8192), 16, 0, 0); } while (0)
#define PG8_STAGE_A(bufoff, kb, o0, o1) do { \
        __builtin_amdgcn_global_load_lds((const unsigned*)(P.A + (size_t)(o0) + (kb)), (LAS unsigned*)(lds + (bufoff) + ldsw), 16, 0, 0); \
        __builtin_amdgcn_global_load_lds((const unsigned*)(P.A + (size_t)(o1) + (kb)), (LAS unsigned*)(lds + (bufoff) + ldsw + 8192), 16, 0, 0); } while (0)
#define PG8_LDA(dst, b, h) do { _Pragma("unroll") for (int m = 0; m < 4; ++m) _Pragma("unroll") for (int k = 0; k < 2; ++k) dst[m][k] = *(const LAS bf16x8*)(lds + PG8_SA(b, h) + aoff + m * 2048 + k * 1024); } while (0)
#define PG8_LDB(dst, b, h) do { _Pragma("unroll") for (int n = 0; n < 2; ++n) _Pragma("unroll") for (int k = 0; k < 2; ++k) dst[n][k] = *(const LAS bf16x8*)(lds + PG8_SB(b, h) + boff + n * 2048 + k * 1024); } while (0)
#define PG8_MMA(ai, bj, At, Bt) do { __builtin_amdgcn_s_setprio(1); _Pragma("unroll") for (int m = 0; m < 4; ++m) _Pragma("unroll") for (int n = 0; n < 2; ++n) { \
        if constexpr (FP8) { const i32x8 fb_ = __builtin_shufflevector(__builtin_bit_cast(i32x4, Bt[n][0]), __builtin_bit_cast(i32x4, Bt[n][1]), 0, 1, 2, 3, 4, 5, 6, 7); \
            const i32x8 fa_ = __builtin_shufflevector(__builtin_bit_cast(i32x4, At[m][0]), __builtin_bit_cast(i32x4, At[m][1]), 0, 1, 2, 3, 4, 5, 6, 7); \
            acc[ai][bj][m][n] = __builtin_amdgcn_mfma_scale_f32_16x16x128_f8f6f4(fb_, fa_, acc[ai][bj][m][n], 0, 0, 0, 0, 0, 0); } \
        else { _Pragma("unroll") for (int k = 0; k < 2; ++k) acc[ai][bj][m][n] = __builtin_amdgcn_mfma_f32_16x16x32_bf16(Bt[n][k], At[m][k], acc[ai][bj][m][n], 0, 0, 0); } } \
        __builtin_amdgcn_s_setprio(0); } while (0)
#define PG8_WAIT_V(n) asm volatile("s_waitcnt vmcnt(" #n ")" ::: "memory")
#define PG8_WAIT_L(n) asm volatile("s_waitcnt lgkmcnt(" #n ")" ::: "memory")
#define PG8_BAR __builtin_amdgcn_s_barrier()
#define PG8_SCHED __builtin_amdgcn_sched_barrier(0)
    Unit cur, nxt; int ui = 0;
    if (!P.next(0, cur)) return;
    f32x4 acc[2][2][4][2];
#pragma unroll
    for (int a = 0; a < 2; ++a)
#pragma unroll
        for (int b = 0; b < 2; ++b)
#pragma unroll
            for (int m = 0; m < 4; ++m)
#pragma unroll
                for (int n = 0; n < 2; ++n) acc[a][b][m][n] = (f32x4){0.f, 0.f, 0.f, 0.f};
    bf16x8 At[4][2], B0[2][2], B1[2][2];
    unsigned c00 = P.a_off(cur, Rs[0], Cs[0]), c01 = P.a_off(cur, Rs[1], Cs[1]), c10 = P.a_off(cur, HALF + Rs[0], Cs[0]), c11 = P.a_off(cur, HALF + Rs[1], Cs[1]);
    const char* cB = P.b_base(cur);
    PG8_STAGE_B(PG8_SB(0, 0), cB); PG8_STAGE_B(PG8_SB(0, 1), cB + bhalf); PG8_STAGE_A(PG8_SA(0, 0), 0, c00, c01); PG8_STAGE_A(PG8_SA(0, 1), 0, c10, c11);
    if (wr == 1) PG8_BAR;
    PG8_WAIT_V(2); PG8_BAR;
    PG8_STAGE_B(PG8_SB(1, 0), cB + kstep); PG8_STAGE_A(PG8_SA(1, 0), kstep, c00, c01); PG8_STAGE_B(PG8_SB(1, 1), cB + bhalf + kstep);
    PG8_WAIT_V(6); PG8_BAR;
    for (;;) {
        const bool has_next = P.next(ui + 1, nxt);
        const char* nB = has_next ? P.b_base(nxt) : cB;
        for (int t = 0; t < nt; t += 2) {
            const bool last = (t == nt - 2);
            const size_t k1 = (size_t)(t + 1) * kstep;
            const size_t k2 = last ? 0 : (size_t)(t + 2) * kstep, k3 = k2 + kstep;
            const char* b2 = last ? nB : cB + (size_t)(t + 2) * kstep; const char* b3 = b2 + kstep;
            if (last && has_next) { c00 = P.a_off(nxt, Rs[0], Cs[0]); c01 = P.a_off(nxt, Rs[1], Cs[1]); }
            PG8_LDB(B0, 0, 0); PG8_LDB(B1, 0, 1); PG8_SCHED; PG8_LDA(At, 0, 0); PG8_STAGE_A(PG8_SA(1, 1), k1, c10, c11);
            PG8_WAIT_V(8); PG8_WAIT_L(0); PG8_BAR; PG8_MMA(0, 0, At, B0); PG8_MMA(0, 1, At, B1); PG8_BAR; PG8_SCHED;
            if (last && has_next) { c10 = P.a_off(nxt, HALF + Rs[0], Cs[0]); c11 = P.a_off(nxt, HALF + Rs[1], Cs[1]); }
            PG8_LDA(At, 0, 1); PG8_STAGE_B(PG8_SB(0, 0), b2); PG8_STAGE_B(PG8_SB(0, 1), b2 + bhalf); PG8_STAGE_A(PG8_SA(0, 0), k2, c00, c01);
            PG8_WAIT_V(8); PG8_WAIT_L(0); PG8_BAR; PG8_MMA(1, 0, At, B0); PG8_MMA(1, 1, At, B1); PG8_BAR; PG8_SCHED;
            PG8_LDB(B0, 1, 0); PG8_LDB(B1, 1, 1); PG8_SCHED; PG8_LDA(At, 1, 0); PG8_STAGE_A(PG8_SA(0, 1), k2, c10, c11);
            PG8_WAIT_V(8); PG8_WAIT_L(0); PG8_BAR; PG8_MMA(0, 0, At, B0); PG8_MMA(0, 1, At, B1); PG8_BAR; PG8_SCHED;
            PG8_LDA(At, 1, 1); PG8_STAGE_B(PG8_SB(1, 0), b3); PG8_STAGE_B(PG8_SB(1, 1), b3 + bhalf); PG8_STAGE_A(PG8_SA(1, 0), k3, c00, c01);
            PG8_WAIT_V(8); PG8_WAIT_L(0); PG8_BAR; PG8_MMA(1, 0, At, B0); PG8_MMA(1, 1, At, B1); PG8_BAR; PG8_SCHED;
        }
        if constexpr (ALIGN_EPI) { if (wr == 0) PG8_BAR; }
        E(acc, cur, wr, wc, fr, fq);
        if (!has_next) break;
#pragma unroll
        for (int a = 0; a < 2; ++a)
#pragma unroll
            for (int b = 0; b < 2; ++b)
#pragma unroll
                for (int m = 0; m < 4; ++m)
#pragma unroll
                    for (int n = 0; n < 2; ++n) acc[a][b][m][n] = (f32x4){0.f, 0.f, 0.f, 0.f};
        cur = nxt; cB = nB; ++ui;
        if constexpr (ALIGN_EPI) { if (wr == 1) PG8_BAR; }
    }
    PG8_WAIT_V(0);
    if constexpr (!ALIGN_EPI) { if (wr == 0) PG8_BAR; }
    PG8_BAR;
#undef PG8_SA
#undef PG8_SB
#undef PG8_STAGE_A
#undef PG8_STAGE_B
#undef PG8_LDA
#undef PG8_LDB
#undef PG8_MMA
#undef PG8_WAIT_V
#undef PG8_WAIT_L
#undef PG8_BAR
#undef PG8_SCHED
}

__device__ __forceinline__ bool static_order(int nM, int nN, int G, int c, int i, int& pm, int& pn) {
    const int nwg = nM * nN; const long L = (long)i * G + c; if (L >= nwg) return false;
    int wgid = (int)L; { const int q = nwg / NXCD, r = nwg % NXCD, xcd = wgid % NXCD, off = wgid / NXCD; wgid = (xcd < r ? xcd * (q + 1) : r * (q + 1) + (xcd - r) * q) + off; }
    const int nig = WGM * nN, gid = wgid / nig, fm = gid * WGM, gsz = (nM - fm) < WGM ? (nM - fm) : WGM;
    pm = fm + ((wgid % nig) % gsz); pn = (wgid % nig) / gsz; return true;
}
struct DenseProb {
    const char* A; const char* Bt; int rowb, nM, nN, G, c; size_t b_half;
    __device__ __forceinline__ bool next(int i, Unit& u) const { u.e = 0; u.slot = i; return static_order(nM, nN, G, c, i, u.pm, u.pn); }
    __device__ __forceinline__ unsigned a_off(const Unit& u, int row, int colb) const { return (unsigned)((u.pm * BM + row) * rowb + colb); }
    __device__ __forceinline__ const char* b_base(const Unit& u) const { return Bt + (size_t)u.pn * BM * rowb; }
};
template <bool GATHER> struct MoeProb {
    const char* A; const char* Bt; int rowb, nN, G, c; size_t b_half; size_t b_expert; int b_tile_rows;
    const LAS int* tpre; const LAS int* tab;
    __device__ __forceinline__ int tp(int j) const { return __builtin_amdgcn_readfirstlane(tpre[j]); }
    __device__ __forceinline__ bool next(int i, Unit& u) const {
        const int total = tp(NE) * nN; const long L0 = (long)i * G + c; if (L0 >= total) return false;
        int L = (int)L0; { const int q = total / NXCD, r = total % NXCD, xcd = L % NXCD, off = L / NXCD; L = (xcd < r ? xcd * (q + 1) : r * (q + 1) + (xcd - r) * q) + off; }
        int e = 0;
#pragma unroll 1
        for (int j = 1; j < NE; ++j) e += (tp(j) * nN <= L) ? 1 : 0;
        const int first = tp(e) * nN, tiles = tp(e + 1) - tp(e), rem = L - first;
        u.e = e; u.pm = rem % tiles; u.pn = rem / tiles; u.slot = i; return true;
    }
    __device__ __forceinline__ unsigned a_off(const Unit& u, int row, int colb) const {
        if (GATHER) { const int idx = tab[u.slot * 256 + row]; const int tok = idx < 0 ? 0 : (idx >> 2); return (unsigned)(tok * rowb + colb); }
        return (unsigned)(((tp(u.e) + u.pm) * BM + row) * rowb + colb);
    }
    __device__ __forceinline__ const char* b_base(const Unit& u) const { return Bt + (size_t)u.e * b_expert + (size_t)u.pn * b_tile_rows * rowb; }
};
}

using pg8::Unit;
typedef f32x4 AccT[2][2][4][2];

struct EpiQKVU {
    static constexpr bool PERM = true;
    unsigned char* ws;
    __device__ __forceinline__ void operator()(const AccT& acc, const Unit& u, int wr, int wc, int fr, int fq) const {
        static_assert(WS_K - WS_Q == WS_V - WS_K, "Q, K, V equally spaced");
        const int t = (u.pn - 1) / 3;
        const size_t boff = (u.pn == 0) ? WS_U : (WS_Q + (size_t)t * (WS_K - WS_Q));
        bf16_t* base = (bf16_t*)(ws + boff);
        const int ldc = (u.pn == 0) ? PW : AW, colt = (u.pn == 0) ? 0 : ((u.pn - 1) % 3) * 256;
        const float sc = (u.pn >= 1 && u.pn <= 3) ? QSCALE : 1.f;
        const int row0 = u.pm * 256 + wr * 64 + fr, col0 = colt + wc * 32 + 8 * fq;
#pragma unroll
        for (int ai = 0; ai < 2; ++ai)
#pragma unroll
            for (int m = 0; m < 4; ++m) { bf16_t* rowp = base + (size_t)(row0 + ai * 128 + m * 16) * ldc + col0;
#pragma unroll
                for (int bj = 0; bj < 2; ++bj) { const f32x4 v0 = acc[ai][bj][m][0] * sc, v1 = acc[ai][bj][m][1] * sc;
                    u32x4 w; w.x = cvt_pk_bf16(v0[0], v0[1]); w.y = cvt_pk_bf16(v0[2], v0[3]); w.z = cvt_pk_bf16(v1[0], v1[1]); w.w = cvt_pk_bf16(v1[2], v1[3]);
                    *(u32x4*)(rowp + bj * 128) = w; } }
    }
};
struct EpiResF32 {
    static constexpr bool PERM = false;
    const float* X; float* O;
    __device__ __forceinline__ void operator()(const AccT& acc, const Unit& u, int wr, int wc, int fr, int fq) const {
        const int row0 = u.pm * 256 + wr * 64 + fr, col0 = u.pn * 256 + wc * 32 + 4 * fq;
#pragma unroll
        for (int ai = 0; ai < 2; ++ai)
#pragma unroll
            for (int m = 0; m < 4; ++m) { const size_t off = (size_t)(row0 + ai * 128 + m * 16) * D + col0;
#pragma unroll
                for (int bj = 0; bj < 2; ++bj)
#pragma unroll
                    for (int n = 0; n < 2; ++n) { const f32x4 r = *(const f32x4*)(X + off + bj * 128 + n * 16); *(f32x4*)(O + off + bj * 128 + n * 16) = acc[ai][bj][m][n] + r; } }
    }
};
__device__ __forceinline__ float swiglu1(float g, float u) {
    g = fminf(g, 7.0f); u = fminf(fmaxf(u, -7.0f), 7.0f);
    const float s = __builtin_amdgcn_rcpf(1.0f + __builtin_amdgcn_exp2f(g * (-1.702f * LOG2E)));
    return (u + 1.0f) * (g * s);
}
struct EpiGateUp {
    static constexpr bool PERM = true;
    unsigned char* ACT; const float* bgu; const float* rstd; const LAS int* tab; const LAS int* tpre;
    __device__ __forceinline__ void operator()(const AccT& acc, const Unit& u, int wr, int wc, int fr, int fq) const {
        const int colA = u.pn * 128 + wc * 32 + 8 * fq;
        const float* bp = bgu + (size_t)u.e * 2 * DFF + colA;
        const f32x4 bg0 = *(const f32x4*)(bp), bg1 = *(const f32x4*)(bp + 4), bu0 = *(const f32x4*)(bp + DFF), bu1 = *(const f32x4*)(bp + DFF + 4);
        const int srow0 = (__builtin_amdgcn_readfirstlane(tpre[u.e]) + u.pm) * 256;
#pragma unroll
        for (int ai = 0; ai < 2; ++ai)
#pragma unroll
            for (int m = 0; m < 4; ++m) { const int r = ai * 128 + wr * 64 + m * 16 + fr; const int idx = tab[u.slot * 256 + r]; const float rs = rstd[idx < 0 ? 0 : (idx >> 2)] * (1.0f / (HSCALE * WSCALE));
                const f32x4 g0 = acc[ai][0][m][0] * rs + bg0, g1 = acc[ai][0][m][1] * rs + bg1, u0 = acc[ai][1][m][0] * rs + bu0, u1 = acc[ai][1][m][1] * rs + bu1;
                u32x2 w; w.x = cvt4_fp8(swiglu1(g0[0], u0[0]) * ASCALE, swiglu1(g0[1], u0[1]) * ASCALE, swiglu1(g0[2], u0[2]) * ASCALE, swiglu1(g0[3], u0[3]) * ASCALE);
                w.y = cvt4_fp8(swiglu1(g1[0], u1[0]) * ASCALE, swiglu1(g1[1], u1[1]) * ASCALE, swiglu1(g1[2], u1[2]) * ASCALE, swiglu1(g1[3], u1[3]) * ASCALE);
                *(u32x2*)(ACT + (size_t)(srow0 + r) * DFF + colA) = w; }
    }
};
struct EpiDown {
    static constexpr bool PERM = true;
    bf16_t* Y; const float* bd; const float* gates; const LAS int* tab;
    __device__ __forceinline__ void operator()(const AccT& acc, const Unit& u, int wr, int wc, int fr, int fq) const {
        const int col0 = u.pn * 256 + wc * 32 + 8 * fq;
        const float* bp = bd + (size_t)u.e * D + col0;
        f32x4 bv[2][2];
#pragma unroll
        for (int bj = 0; bj < 2; ++bj) { bv[bj][0] = *(const f32x4*)(bp + bj * 128); bv[bj][1] = *(const f32x4*)(bp + bj * 128 + 4); }
#pragma unroll
        for (int ai = 0; ai < 2; ++ai)
#pragma unroll
            for (int m = 0; m < 4; ++m) { const int r = ai * 128 + wr * 64 + m * 16 + fr; const int idx = tab[u.slot * 256 + r];
                if (idx >= 0) { const float gv = gates[idx]; bf16_t* rowp = Y + (size_t)idx * D + col0;
#pragma unroll
                    for (int bj = 0; bj < 2; ++bj) { const f32x4 v0 = (acc[ai][bj][m][0] * (1.0f / (ASCALE * WSCALE)) + bv[bj][0]) * gv, v1 = (acc[ai][bj][m][1] * (1.0f / (ASCALE * WSCALE)) + bv[bj][1]) * gv;
                        u32x4 w; w.x = cvt_pk_bf16(v0[0], v0[1]); w.y = cvt_pk_bf16(v0[2], v0[3]); w.z = cvt_pk_bf16(v1[0], v1[1]); w.w = cvt_pk_bf16(v1[2], v1[3]);
                        *(u32x4*)(rowp + bj * 128) = w; } } }
    }
};

__device__ __forceinline__ void tr_item(const float* __restrict__ W, int K, int N, bf16_t* __restrict__ WT, LAS float* scr, int kb, int nb, int lane) {
    const int k0 = kb * 64, n0 = nb * 64;
    const float* src = W + (size_t)(k0 + (lane >> 4)) * N + n0 + (lane & 15) * 4;
    f32x4 v[16];
#pragma unroll
    for (int i = 0; i < 16; ++i) v[i] = *(const f32x4*)(src + (size_t)(4 * i) * N);
#pragma unroll
    for (int i = 0; i < 16; ++i) { LAS float* d = scr + (4 * i + (lane >> 4)) * 65 + (lane & 15) * 4; d[0] = v[i][0]; d[1] = v[i][1]; d[2] = v[i][2]; d[3] = v[i][3]; }
    LDS_WAIT();
    const int c = lane & 7;
#pragma unroll
    for (int j = 0; j < 8; ++j) { const int n = 8 * j + (lane >> 3); const LAS float* s = scr + (8 * c) * 65 + n;
        u32x4 o; o.x = cvt_pk_bf16(s[0], s[65]); o.y = cvt_pk_bf16(s[130], s[195]); o.z = cvt_pk_bf16(s[260], s[325]); o.w = cvt_pk_bf16(s[390], s[455]);
        *(u32x4*)(WT + (size_t)(n0 + n) * K + k0 + 8 * c) = o; }
    LDS_WAIT();
}
__device__ __forceinline__ void tr_item8(const float* __restrict__ W, int K, int N, unsigned char* __restrict__ WT, LAS float* scr, int kb, int nb, int lane) {
    const int k0 = kb * 64, n0 = nb * 64;
    const float* src = W + (size_t)(k0 + (lane >> 4)) * N + n0 + (lane & 15) * 4;
    f32x4 v[16];
#pragma unroll
    for (int i = 0; i < 16; ++i) v[i] = *(const f32x4*)(src + (size_t)(4 * i) * N);
#pragma unroll
    for (int i = 0; i < 16; ++i) { LAS float* d = scr + (4 * i + (lane >> 4)) * 65 + (lane & 15) * 4; d[0] = v[i][0]; d[1] = v[i][1]; d[2] = v[i][2]; d[3] = v[i][3]; }
    LDS_WAIT();
    const int c = lane & 3;
#pragma unroll
    for (int j = 0; j < 4; ++j) { const int n = 16 * j + (lane >> 2); const LAS float* s = scr + (16 * c) * 65 + n;
        u32x4 o;
#pragma unroll
        for (int q = 0; q < 4; ++q) o[q] = cvt4_fp8(s[(4 * q) * 65] * WSCALE, s[(4 * q + 1) * 65] * WSCALE, s[(4 * q + 2) * 65] * WSCALE, s[(4 * q + 3) * 65] * WSCALE);
        *(u32x4*)(WT + (size_t)(n0 + n) * K + k0 + 16 * c) = o; }
    LDS_WAIT();
}
__device__ __forceinline__ int t5_bucket(int dist) {
    if (dist < 16) return dist;
    const int large = 16 + (int)(logf((float)dist / 16.0f) / 4.852030263919617f * 16.0f);
    return large < 31 ? large : 31;
}
struct In { const float *x, *norm1_g, *w_in, *pool_w, *pool_scale, *rel_bias, *w_out, *norm2_g, *router_w, *router_b, *w_gate_up, *b_gate_up, *w_down, *b_down, *final_g; };

__device__ __forceinline__ void p0_prologue(LAS unsigned char* lds, const In& in, unsigned char* ws, int G, int c) {
    const int tid = threadIdx.x, lane = tid & 63, wave = __builtin_amdgcn_readfirstlane(tid >> 6);
    const int gw = c * 8 + wave, NGW = G * 8;
    LAS float* scr = (LAS float*)(lds + wave * 16640);
    constexpr int I_IN = 16 * 40, I_OUT = 16 * 16, I_GU1 = 16 * 32, I_D1 = 16 * 16;
    constexpr int NITEMS = I_IN + I_OUT + NE * I_GU1 + NE * I_D1;
    for (int it = gw; it < NITEMS; it += NGW) {
        int r = it;
        if (r < I_IN) { tr_item(in.w_in, D, NPROJ, (bf16_t*)(ws + WS_WIN), scr, r / 40, r % 40, lane); continue; } r -= I_IN;
        if (r < I_OUT) { tr_item(in.w_out, D, D, (bf16_t*)(ws + WS_WOUT), scr, r / 16, r % 16, lane); continue; } r -= I_OUT;
        if (r < NE * I_GU1) { const int e = r / I_GU1, q = r % I_GU1; tr_item8(in.w_gate_up + (size_t)e * D * 2 * DFF, D, 2 * DFF, ws + WS_WGU + (size_t)e * 2 * DFF * D, scr, q / 32, q % 32, lane); continue; } r -= NE * I_GU1;
        { const int e = r / I_D1, q = r % I_D1; tr_item8(in.w_down + (size_t)e * DFF * D, DFF, D, ws + WS_WD + (size_t)e * D * DFF, scr, q / 16, q % 16, lane); }
    }
    {
        f32x4 gv[4];
#pragma unroll
        for (int j = 0; j < 4; ++j) gv[j] = *(const f32x4*)(in.norm1_g + 4 * lane + 256 * j);
        bf16_t* H = (bf16_t*)(ws + WS_H);
        for (int m = gw; m < S; m += NGW) {
            const float* xr = in.x + (size_t)m * D + 4 * lane;
            f32x4 v[4]; float s = 0.f;
#pragma unroll
            for (int j = 0; j < 4; ++j) { v[j] = *(const f32x4*)(xr + 256 * j); s += (v[j][0] * v[j][0] + v[j][1] * v[j][1]) + (v[j][2] * v[j][2] + v[j][3] * v[j][3]); }
            const float rstd = rsqrtf(wave_sum(s) * (1.0f / D) + RMS_EPS);
#pragma unroll
            for (int j = 0; j < 4; ++j) { const f32x4 o = v[j] * rstd * gv[j]; u32x2 w; w.x = cvt_pk_bf16(o[0], o[1]); w.y = cvt_pk_bf16(o[2], o[3]); *(u32x2*)(H + (size_t)m * D + 4 * lane + 256 * j) = w; }
        }
    }
    const int gt = c * 512 + tid, NGT = G * 512;
    { float* GWT = (float*)(ws + WS_GWT); for (int i = gt; i < NE * D; i += NGT) { const int e = i >> 10, k = i & 1023; GWT[i] = in.norm2_g[k] * in.router_w[k * NE + e]; } }
    { float* BT = (float*)(ws + WS_BT); for (int i = gt; i < 36 * BT_N; i += NGT) { const int bh = i / BT_N, j = i % BT_N, b = bh / NH, h = bh % NH, dil = (b == 0) ? 1 : (b == 1 ? 4 : 16), d = j - BT_OFF;
        BT[i] = (d >= 0 && d <= 128) ? in.rel_bias[t5_bucket(d * dil) * NH + h] * LOG2E : NEGBIG; } }
    { bf16_t* PWT = (bf16_t*)(ws + WS_PWT); for (int i = gt; i < 4 * 64 * 64; i += NGT) { const int g = i >> 12, d = (i >> 6) & 63, cc = i & 63; PWT[i] = (bf16_t)(cvt_pk_bf16(in.pool_w[g * 4096 + cc * 64 + d], 0.f) & 0xffffu); } }
}

__device__ __forceinline__ s16x4 lds_tr16(const LAS unsigned char* p) { typedef short v4i16_t __attribute__((ext_vector_type(4))); return __builtin_bit_cast(s16x4, __builtin_amdgcn_ds_read_tr16_b64_v4i16((LAS v4i16_t*)p)); }
constexpr int ATT_UNITS = 3 * NH * 128, KV_PITCH = 144, ATT_VOFF = 256 * KV_PITCH, ATT_TOFF = 2 * 256 * KV_PITCH;

__device__ __forceinline__ void attn_decode(int uid, int& b, int& h, int& r, int& j, int& dil) {
    const int bh = uid >> 7, x = uid & 127; b = bh / NH; h = bh % NH; dil = (b == 0) ? 1 : (b == 1 ? 4 : 16);
    const int nb = 128 / dil; r = x / nb; j = x % nb;
}
__device__ __forceinline__ void attn_phase(LAS unsigned char* lds, const bf16_t* __restrict__ Qg, const bf16_t* __restrict__ Kg, const bf16_t* __restrict__ Vg, const float* __restrict__ BT,
                                           bf16_t* __restrict__ OP, float* __restrict__ LSE, int G, int c) {
    const int tid = threadIdx.x, lane = tid & 63, w = __builtin_amdgcn_readfirstlane(tid >> 6), ql = lane & 15, g = lane >> 4;
    LAS unsigned char* Ks = lds; LAS unsigned char* Vs = lds + ATT_VOFF; LAS float* Tb = (LAS float*)(lds + ATT_TOFF);
    u32x4 kpre[4], vpre[4]; bf16x8 qpre0, qpre1; float tpre = 0.f;
#define ATT_PREFETCH(uid_) do { int b_, h_, r_, j_, dil_; attn_decode((uid_), b_, h_, r_, j_, dil_); \
        _Pragma("unroll") for (int cc = 0; cc < 4; ++cc) { const int id = tid + 512 * cc, row = id >> 3, ch = id & 7; int mm = 128 * (j_ - 1) + row; if (mm < 0) mm += 128; \
            const size_t off = (size_t)(r_ + dil_ * mm) * AW + h_ * HD + ch * 8; kpre[cc] = *(const u32x4*)(Kg + off); vpre[cc] = *(const u32x4*)(Vg + off); } \
        { const size_t qo = (size_t)(r_ + dil_ * (128 * j_ + 16 * w + ql)) * AW + h_ * HD + 8 * g; qpre0 = *(const bf16x8*)(Qg + qo); qpre1 = *(const bf16x8*)(Qg + qo + 32); } \
        if (tid < BT_N) tpre = BT[(b_ * NH + h_) * BT_N + tid]; } while (0)
    if (c < ATT_UNITS) ATT_PREFETCH(c);
    for (int uid = c; uid < ATT_UNITS; uid += G) {
        int b, h, r, j, dil; attn_decode(uid, b, h, r, j, dil);
#pragma unroll
        for (int cc = 0; cc < 4; ++cc) { const int id = tid + 512 * cc, row = id >> 3, ch = id & 7; *(LAS u32x4*)(Ks + row * KV_PITCH + ch * 16) = kpre[cc]; *(LAS u32x4*)(Vs + row * KV_PITCH + ch * 16) = vpre[cc]; }
        if (tid < BT_N) Tb[tid] = tpre;
        const bf16x8 qf0 = qpre0, qf1 = qpre1;
        __syncthreads();
        if (uid + G < ATT_UNITS) ATT_PREFETCH(uid + G);
        const int tstart = (j == 0) ? (8 - w) : 0;
        const LAS unsigned char* kb = Ks + (16 * w + ql) * KV_PITCH + g * 16;
        const LAS float* Tq = Tb + (ql + 272 - 4 * g - 3);
        float mx = NEGBIG;
        for (int tt = tstart; tt < 9; ++tt) {
            const bf16x8 kf0 = *(const LAS bf16x8*)(kb + tt * (16 * KV_PITCH)), kf1 = *(const LAS bf16x8*)(kb + tt * (16 * KV_PITCH) + 64);
            f32x4 st = __builtin_amdgcn_mfma_f32_16x16x32_bf16(kf0, qf0, (f32x4){0.f, 0.f, 0.f, 0.f}, 0, 0, 0);
            st = __builtin_amdgcn_mfma_f32_16x16x32_bf16(kf1, qf1, st, 0, 0, 0);
            const LAS float* tp = Tq - 16 * tt;
            mx = fmaxf(mx, fmaxf(fmaxf(st[0] + tp[3], st[1] + tp[2]), fmaxf(st[2] + tp[1], st[3] + tp[0])));
        }
        mx = fmaxf(mx, __shfl_xor(mx, 16)); mx = fmaxf(mx, __shfl_xor(mx, 32));
        const f32x4 negm = (f32x4){-mx, -mx, -mx, -mx};
        f32x4 o0 = (f32x4){0.f, 0.f, 0.f, 0.f}, o1 = o0, o2 = o0, o3 = o0; float ls = 0.f;
        const LAS unsigned char* vb = Vs + (16 * w + 4 * g + (ql >> 2)) * KV_PITCH + (ql & 3) * 8;
        for (int tt = tstart; tt < 9; ++tt) {
            const bf16x8 kf0 = *(const LAS bf16x8*)(kb + tt * (16 * KV_PITCH)), kf1 = *(const LAS bf16x8*)(kb + tt * (16 * KV_PITCH) + 64);
            f32x4 st = __builtin_amdgcn_mfma_f32_16x16x32_bf16(kf0, qf0, negm, 0, 0, 0);
            st = __builtin_amdgcn_mfma_f32_16x16x32_bf16(kf1, qf1, st, 0, 0, 0);
            const LAS float* tp = Tq - 16 * tt;
            const float p0 = __builtin_amdgcn_exp2f(st[0] + tp[3]), p1 = __builtin_amdgcn_exp2f(st[1] + tp[2]), p2 = __builtin_amdgcn_exp2f(st[2] + tp[1]), p3 = __builtin_amdgcn_exp2f(st[3] + tp[0]);
            ls += (p0 + p1) + (p2 + p3);
            u32x2 pw; pw.x = cvt_pk_bf16(p0, p1); pw.y = cvt_pk_bf16(p2, p3);
            const s16x4 pf = __builtin_bit_cast(s16x4, pw);
            const LAS unsigned char* vt = vb + tt * (16 * KV_PITCH);
            const s16x4 v0 = lds_tr16(vt), v1 = lds_tr16(vt + 32), v2 = lds_tr16(vt + 64), v3 = lds_tr16(vt + 96);
            o0 = __builtin_amdgcn_mfma_f32_16x16x16bf16_1k(v0, pf, o0, 0, 0, 0);
            o1 = __builtin_amdgcn_mfma_f32_16x16x16bf16_1k(v1, pf, o1, 0, 0, 0);
            o2 = __builtin_amdgcn_mfma_f32_16x16x16bf16_1k(v2, pf, o2, 0, 0, 0);
            o3 = __builtin_amdgcn_mfma_f32_16x16x16bf16_1k(v3, pf, o3, 0, 0, 0);
        }
        ls += __shfl_xor(ls, 16); ls += __shfl_xor(ls, 32);
        const float inv = 1.0f / ls;
        const int pos = r + dil * (128 * j + 16 * w + ql);
        bf16_t* dst = OP + ((size_t)b * S + pos) * AW + h * HD + 4 * g;
        { u32x2 t; t.x = cvt_pk_bf16(o0[0] * inv, o0[1] * inv); t.y = cvt_pk_bf16(o0[2] * inv, o0[3] * inv); *(u32x2*)(dst) = t; }
        { u32x2 t; t.x = cvt_pk_bf16(o1[0] * inv, o1[1] * inv); t.y = cvt_pk_bf16(o1[2] * inv, o1[3] * inv); *(u32x2*)(dst + 16) = t; }
        { u32x2 t; t.x = cvt_pk_bf16(o2[0] * inv, o2[1] * inv); t.y = cvt_pk_bf16(o2[2] * inv, o2[3] * inv); *(u32x2*)(dst + 32) = t; }
        { u32x2 t; t.x = cvt_pk_bf16(o3[0] * inv, o3[1] * inv); t.y = cvt_pk_bf16(o3[2] * inv, o3[3] * inv); *(u32x2*)(dst + 48) = t; }
        if (g == 0) LSE[((size_t)b * S + pos) * NH + h] = mx + __builtin_amdgcn_logf(ls);
        __syncthreads();
    }
#undef ATT_PREFETCH
}

__device__ __forceinline__ void pool_phase(LAS unsigned char* lds, const bf16_t* __restrict__ U, const bf16_t* __restrict__ PWT, const float* __restrict__ pool_scale, bf16_t* __restrict__ MIX, int G, int c) {
    const int tid = threadIdx.x, lane = tid & 63, w = __builtin_amdgcn_readfirstlane(tid >> 6), ql = lane & 15, g = lane >> 4;
    LAS unsigned char* Us = lds; LAS unsigned char* Pl = lds + 40960;
    for (int pu = c; pu < S / 64; pu += G) {
        const int t0 = pu * 64;
        for (int id = tid; id < 79 * 32; id += 512) { const int row = id >> 5, ch = id & 31, t = t0 - 15 + row;
            u32x4 v = (u32x4){0u, 0u, 0u, 0u}; if (t >= 0) v = *(const u32x4*)(U + (size_t)t * PW + ch * 8);
            *(LAS u32x4*)(Us + row * 512 + ch * 16) = v; }
        __syncthreads();
        { const int cch = tid & 255, th = tid >> 8, gg = cch >> 6, wn = 2 << gg, tl0 = 32 * th;
          const LAS bf16_t* up = (const LAS bf16_t*)Us + cch;
#define UAT(row) __uint_as_float(((unsigned)up[(row) * 256]) << 16)
          float sum = 0.f;
          for (int i = 0; i < wn; ++i) sum += UAT(tl0 + 15 - i);
          for (int tl = tl0; tl < tl0 + 32; ++tl) {
              if (tl > tl0) sum += UAT(tl + 15) - UAT(tl + 15 - wn);
              const int t = t0 + tl; const int cnt = (t + 1 < wn) ? (t + 1) : wn;
              const float val = sum / (float)cnt - UAT(tl + 15);
              ((LAS bf16_t*)(Pl + tl * 528))[cch] = (bf16_t)(cvt_pk_bf16(val, 0.f) & 0xffffu);
          }
#undef UAT
        }
        __syncthreads();
        { const int tt = w & 3, gp = w >> 2;
#pragma unroll
          for (int gi = 0; gi < 2; ++gi) { const int gg = 2 * gp + gi;
              const bf16x8 b0 = *(const LAS bf16x8*)(Pl + (16 * tt + ql) * 528 + (gg * 64 + 8 * g) * 2), b1 = *(const LAS bf16x8*)(Pl + (16 * tt + ql) * 528 + (gg * 64 + 32 + 8 * g) * 2);
#pragma unroll
              for (int nt = 0; nt < 4; ++nt) {
                  const bf16_t* ap = PWT + ((size_t)(gg * 64 + 16 * nt + ql) * 64 + 8 * g);
                  const bf16x8 a0 = *(const bf16x8*)(ap), a1 = *(const bf16x8*)(ap + 32);
                  f32x4 acc = __builtin_amdgcn_mfma_f32_16x16x32_bf16(a0, b0, (f32x4){0.f, 0.f, 0.f, 0.f}, 0, 0, 0);
                  acc = __builtin_amdgcn_mfma_f32_16x16x32_bf16(a1, b1, acc, 0, 0, 0);
                  const f32x4 ps = *(const f32x4*)(pool_scale + gg * 64 + 16 * nt + 4 * g);
                  u32x2 o; o.x = cvt_pk_bf16(acc[0] * ps[0], acc[1] * ps[1]); o.y = cvt_pk_bf16(acc[2] * ps[2], acc[3] * ps[3]);
                  *(u32x2*)(MIX + (size_t)(t0 + 16 * tt + ql) * D + gg * 64 + 16 * nt + 4 * g) = o;
              } }
        }
        __syncthreads();
    }
}

__device__ __forceinline__ void combine_phase(const bf16_t* __restrict__ OP, const float* __restrict__ LSE, bf16_t* __restrict__ MIX, int G, int c) {
    const int gt = c * 512 + threadIdx.x, NGT = G * 512;
    for (int id = gt; id < S * 96; id += NGT) {
        const int t = id / 96, rem = id % 96, h = rem >> 3, c8 = rem & 7;
        const float l0 = LSE[(size_t)t * NH + h], l1 = LSE[((size_t)S + t) * NH + h], l2 = LSE[((size_t)2 * S + t) * NH + h];
        const float mx = fmaxf(l0, fmaxf(l1, l2));
        float w0 = __builtin_amdgcn_exp2f(l0 - mx), w1 = __builtin_amdgcn_exp2f(l1 - mx), w2 = __builtin_amdgcn_exp2f(l2 - mx);
        const float inv = 1.0f / (w0 + w1 + w2); w0 *= inv; w1 *= inv; w2 *= inv;
        const size_t off = (size_t)t * AW + h * HD + c8 * 8;
        const u32x4 a = *(const u32x4*)(OP + off), b = *(const u32x4*)(OP + (size_t)S * AW + off), cc = *(const u32x4*)(OP + (size_t)2 * S * AW + off);
        u32x4 o;
#pragma unroll
        for (int k = 0; k < 4; ++k) { const float lo = w0 * bf_lo(a[k]) + w1 * bf_lo(b[k]) + w2 * bf_lo(cc[k]), hi = w0 * bf_hi(a[k]) + w1 * bf_hi(b[k]) + w2 * bf_hi(cc[k]); o[k] = cvt_pk_bf16(lo, hi); }
        *(u32x4*)(MIX + (size_t)t * D + PW + h * HD + c8 * 8) = o;
    }
}

constexpr int GW_PITCH = 1028;
__device__ __forceinline__ void router_phase(LAS unsigned char* lds, const float* __restrict__ X1, const float* __restrict__ g2, const float* __restrict__ GWT, const float* __restrict__ rb,
                                             unsigned char* __restrict__ H, float* __restrict__ RSTD, float* __restrict__ GATES, int* __restrict__ ROWS, unsigned* __restrict__ COUNTS, int G, int c) {
    const int tid = threadIdx.x, lane = tid & 63, w = __builtin_amdgcn_readfirstlane(tid >> 6), ql = lane & 15, g = lane >> 4;
    LAS float* GW = (LAS float*)lds;
    LAS float* LG = (LAS float*)(lds + 131584) + (w & 3) * (16 * 33);
    LAS float* RS = (LAS float*)(lds + 131584 + 4 * 16 * 33 * 4) + (w & 3) * 16;
    LAS int* LCNT = (LAS int*)(lds + 131584 + 4 * 16 * 33 * 4 + 4 * 16 * 4);
    LAS int* LBASE = LCNT + 32;
    for (int id = tid; id < NE * 256; id += 512) { const int e = id >> 8, k4 = id & 255; *(LAS f32x4*)(GW + e * GW_PITCH + k4 * 4) = *(const f32x4*)(GWT + e * D + k4 * 4); }
    const int nrounds = (S / 16 + 4 * G - 1) / (4 * G);
    for (int rd = 0; rd < nrounds; ++rd) {
        if (tid < 32) LCNT[tid] = 0;
        __syncthreads();
        const int tile = (rd * 4 + w) * G + c;
        int ek[4] = {0, 0, 0, 0}, lp[4] = {0, 0, 0, 0}; float gk[4] = {0.f, 0.f, 0.f, 0.f};
        const bool active = (w < 4) && (tile < S / 16);
        if (active) {
            const int tok = tile * 16 + ql;
            const float* xr = X1 + (size_t)tok * D + 8 * g;
            unsigned char* hr = H + (size_t)tok * D + 8 * g;
            const LAS float* w0p = GW + ql * GW_PITCH + 8 * g; const LAS float* w1p = GW + (16 + ql) * GW_PITCH + 8 * g;
            f32x4 acc0 = (f32x4){0.f, 0.f, 0.f, 0.f}, acc1 = acc0; float ss = 0.f;
#pragma unroll 2
            for (int k0 = 0; k0 < D; k0 += 32) {
                const f32x4 a0 = *(const f32x4*)(xr + k0), a1 = *(const f32x4*)(xr + k0 + 4);
                const f32x4 n0 = *(const f32x4*)(g2 + k0 + 8 * g), n1 = *(const f32x4*)(g2 + k0 + 8 * g + 4);
                const f32x4 b00 = *(const LAS f32x4*)(w0p + k0), b01 = *(const LAS f32x4*)(w0p + k0 + 4), b10 = *(const LAS f32x4*)(w1p + k0), b11 = *(const LAS f32x4*)(w1p + k0 + 4);
                ss += (a0[0] * a0[0] + a0[1] * a0[1]) + (a0[2] * a0[2] + a0[3] * a0[3]) + (a1[0] * a1[0] + a1[1] * a1[1]) + (a1[2] * a1[2] + a1[3] * a1[3]);
                u32x2 hv; hv.x = cvt4_fp8(a0[0] * n0[0] * HSCALE, a0[1] * n0[1] * HSCALE, a0[2] * n0[2] * HSCALE, a0[3] * n0[3] * HSCALE);
                hv.y = cvt4_fp8(a1[0] * n1[0] * HSCALE, a1[1] * n1[1] * HSCALE, a1[2] * n1[2] * HSCALE, a1[3] * n1[3] * HSCALE);
                *(u32x2*)(hr + k0) = hv;
#pragma unroll
                for (int jj = 0; jj < 4; ++jj) { acc0 = __builtin_amdgcn_mfma_f32_16x16x4f32(a0[jj], b00[jj], acc0, 0, 0, 0); acc1 = __builtin_amdgcn_mfma_f32_16x16x4f32(a0[jj], b10[jj], acc1, 0, 0, 0); }
#pragma unroll
                for (int jj = 0; jj < 4; ++jj) { acc0 = __builtin_amdgcn_mfma_f32_16x16x4f32(a1[jj], b01[jj], acc0, 0, 0, 0); acc1 = __builtin_amdgcn_mfma_f32_16x16x4f32(a1[jj], b11[jj], acc1, 0, 0, 0); }
            }
            ss += __shfl_xor(ss, 16); ss += __shfl_xor(ss, 32);
            const float rstd = rsqrtf(ss * (1.0f / D) + RMS_EPS);
            if (g == 0) { RSTD[tok] = rstd; RS[ql] = rstd; }
            LDS_WAIT();
            const float rb0 = rb[ql], rb1 = rb[16 + ql];
#pragma unroll
            for (int rg = 0; rg < 4; ++rg) { const float rr = RS[4 * g + rg]; LG[(4 * g + rg) * 33 + ql] = acc0[rg] * rr + rb0; LG[(4 * g + rg) * 33 + 16 + ql] = acc1[rg] * rr + rb1; }
            LDS_WAIT();
            if (lane < 16) {
                float v[32];
#pragma unroll
                for (int e = 0; e < 32; ++e) v[e] = LG[ql * 33 + e];
                float tv[4];
#pragma unroll
                for (int r = 0; r < 4; ++r) { float best = v[0]; int bi = 0;
#pragma unroll
                    for (int e = 1; e < 32; ++e) { const bool gt = v[e] > best; best = gt ? v[e] : best; bi = gt ? e : bi; }
                    tv[r] = best; ek[r] = bi;
#pragma unroll
                    for (int e = 0; e < 32; ++e) v[e] = (e == bi) ? -INFINITY : v[e]; }
                const float e1 = __expf(tv[1] - tv[0]), e2 = __expf(tv[2] - tv[0]), e3 = __expf(tv[3] - tv[0]); const float inv = 1.0f / (1.0f + e1 + e2 + e3);
                gk[0] = inv; gk[1] = e1 * inv; gk[2] = e2 * inv; gk[3] = e3 * inv;
#pragma unroll
                for (int r = 0; r < 4; ++r) lp[r] = __hip_atomic_fetch_add(LCNT + ek[r], 1, __ATOMIC_RELAXED, __HIP_MEMORY_SCOPE_WORKGROUP);
            }
        }
        __syncthreads();
        if (tid < 32) { const int n = LCNT[tid]; int base = 0; if (n > 0) base = (int)__hip_atomic_fetch_add(COUNTS + tid, (unsigned)n, __ATOMIC_RELAXED, __HIP_MEMORY_SCOPE_AGENT); LBASE[tid] = base; }
        __syncthreads();
        if (active && lane < 16) { const int tok = tile * 16 + ql;
#pragma unroll
            for (int r = 0; r < 4; ++r) { const int pos = LBASE[ek[r]] + lp[r]; ROWS[(size_t)ek[r] * S + pos] = tok * 4 + r; GATES[tok * 4 + r] = gk[r]; } }
        __syncthreads();
    }
}

__device__ __forceinline__ void moe_prefix(LAS int* tpre, LAS int* lcnt, const unsigned* __restrict__ COUNTS) {
    if (threadIdx.x < 32) lcnt[threadIdx.x] = (int)COUNTS[threadIdx.x];
    __syncthreads();
    if (threadIdx.x == 0) { int acc = 0; for (int e = 0; e < NE; ++e) { tpre[e] = acc; acc += (lcnt[e] + 255) >> 8; } tpre[NE] = acc; }
    __syncthreads();
}
template <class Prob> __device__ __forceinline__ void moe_table(const Prob& P, LAS int* tab, const LAS int* lcnt, const int* __restrict__ ROWS) {
    Unit u;
#pragma unroll 1
    for (int i = 0; i < MAXU && P.next(i, u); ++i) {
        if (threadIdx.x < 256) { const int rr = u.pm * 256 + (int)threadIdx.x; tab[i * 256 + threadIdx.x] = (rr < lcnt[u.e]) ? ROWS[(size_t)u.e * S + rr] : -1; }
    }
    __syncthreads();
}

__device__ __forceinline__ void final_phase(const float* __restrict__ X1, const bf16_t* __restrict__ Y, const float* __restrict__ fg, float* __restrict__ out, int G, int c) {
    const int tid = threadIdx.x, lane = tid & 63, wave = tid >> 6; const int gw = c * 8 + wave, NGW = G * 8;
    f32x4 gv[4];
#pragma unroll
    for (int j = 0; j < 4; ++j) gv[j] = *(const f32x4*)(fg + 4 * lane + 256 * j);
    for (int m = gw; m < S; m += NGW) {
        const float* xr = X1 + (size_t)m * D + 4 * lane;
        f32x4 v[4];
#pragma unroll
        for (int j = 0; j < 4; ++j) v[j] = *(const f32x4*)(xr + 256 * j);
#pragma unroll
        for (int k = 0; k < 4; ++k) { const bf16_t* yr = Y + ((size_t)m * 4 + k) * D + 4 * lane;
#pragma unroll
            for (int j = 0; j < 4; ++j) { const u32x2 t = *(const u32x2*)(yr + 256 * j); v[j][0] += bf_lo(t.x); v[j][1] += bf_hi(t.x); v[j][2] += bf_lo(t.y); v[j][3] += bf_hi(t.y); } }
        float s = 0.f;
#pragma unroll
        for (int j = 0; j < 4; ++j) s += (v[j][0] * v[j][0] + v[j][1] * v[j][1]) + (v[j][2] * v[j][2] + v[j][3] * v[j][3]);
        const float rstd = rsqrtf(wave_sum(s) * (1.0f / D) + RMS_EPS);
#pragma unroll
        for (int j = 0; j < 4; ++j) *(f32x4*)(out + (size_t)m * D + 4 * lane + 256 * j) = v[j] * rstd * gv[j];
    }
}

constexpr int NPHASE = 9;
struct Args { In in; float* out; unsigned char* ws; int ph_lo, ph_hi; };
__global__ void __launch_bounds__(512, 2) fwd(Args args) {
    extern __shared__ __attribute__((aligned(16))) unsigned char lds_raw[];
    LAS unsigned char* lds = (LAS unsigned char*)lds_raw;
    const int tid = threadIdx.x, G = gridDim.x, c = blockIdx.x;
    unsigned char* ws = args.ws; const In& in = args.in;
    unsigned* ctl = (unsigned*)(ws + WS_CTL);
    LAS int* LCTL = (LAS int*)(lds + LDS_CTL);
    if (tid < 256) LCTL[tid] = 0;
    __syncthreads();
    const int lo = args.ph_lo, hi = args.ph_hi;
    const bool one_launch = (hi - lo) > 1;
    XcdBarrier bar; bar.bar = ctl + CW_BAR; bar.x = 0; bar.st = nullptr;
    if (one_launch) bar = xcd_barrier_post(ctl + CW_BAR, (volatile LAS unsigned*)LCTL);
#define IN(k) (lo <= (k) && (k) < hi)
#ifndef MK_DOUBLE
#define MK_DOUBLE 0
#endif
#define REP(k) for (int rep_ = 0; rep_ < ((((MK_DOUBLE) >> (k)) & 1) ? 2 : 1); ++rep_)
#define SEAM(k) do { if (IN((k) + 1)) xcd_barrier(bar); } while (0)
    bf16_t* Hb = (bf16_t*)(ws + WS_H); bf16_t* Ub = (bf16_t*)(ws + WS_U); bf16_t* Qb = (bf16_t*)(ws + WS_Q); bf16_t* Kb = (bf16_t*)(ws + WS_K); bf16_t* Vb = (bf16_t*)(ws + WS_V);
    bf16_t* OPb = (bf16_t*)(ws + WS_OP); bf16_t* MIXb = (bf16_t*)(ws + WS_MIX); float* X1 = (float*)(ws + WS_X1); unsigned char* ACTb = ws + WS_ACT; bf16_t* Yb = (bf16_t*)(ws + WS_Y); unsigned char* H8 = ws + WS_H8;
    float* LSE = (float*)(ws + WS_LSE); float* RSTD = (float*)(ws + WS_RSTD); float* GATES = (float*)(ws + WS_GATES); int* ROWS = (int*)(ws + WS_ROWS); unsigned* COUNTS = ctl + CW_COUNTS;
    LAS int* TPRE = LCTL + 16; LAS int* LCNT = LCTL + 128; LAS int* TAB = (LAS int*)(lds + LDS_TAB);

    if (IN(0)) { REP(0) p0_prologue(lds, in, ws, G, c); SEAM(0); }
    if (IN(1)) {
        pg8::DenseProb P{(const char*)Hb, (const char*)(ws + WS_WIN), D * 2, S / 256, NPROJ / 256, G, c, (size_t)128 * D * 2};
        EpiQKVU E{ws};
        REP(1) pg8::gemm_phase<EpiQKVU, pg8::DenseProb, true, false>(lds, P, E);
        SEAM(1);
    }
    if (IN(2)) {
        REP(2) attn_phase(lds, Qb, Kb, Vb, (const float*)(ws + WS_BT), OPb, LSE, G, c);
        REP(9) pool_phase(lds, Ub, (const bf16_t*)(ws + WS_PWT), in.pool_scale, MIXb, G, c);
        SEAM(2);
    }
    if (IN(3)) { REP(3) combine_phase(OPb, LSE, MIXb, G, c); SEAM(3); }
    if (IN(4)) {
        pg8::DenseProb P{(const char*)MIXb, (const char*)(ws + WS_WOUT), D * 2, S / 256, D / 256, G, c, (size_t)128 * D * 2};
        EpiResF32 E{in.x, X1};
        REP(4) pg8::gemm_phase<EpiResF32, pg8::DenseProb, true, false>(lds, P, E);
        SEAM(4);
    }
    if (IN(5)) { router_phase(lds, X1, in.norm2_g, (const float*)(ws + WS_GWT), in.router_b, H8, RSTD, GATES, ROWS, COUNTS, G, c); SEAM(5); }
    if (IN(6)) {
        moe_prefix(TPRE, LCNT, COUNTS);
        pg8::MoeProb<true> P{(const char*)H8, (const char*)(ws + WS_WGU), D, 8, G, c, (size_t)DFF * D, (size_t)2 * DFF * D, 128, TPRE, TAB};
        moe_table(P, TAB, LCNT, ROWS);
        EpiGateUp E{ACTb, in.b_gate_up, RSTD, TAB, TPRE};
        REP(6) pg8::gemm_phase<EpiGateUp, pg8::MoeProb<true>, true, true>(lds, P, E);
        SEAM(6);
    }
    if (IN(7)) {
        moe_prefix(TPRE, LCNT, COUNTS);
        pg8::MoeProb<false> P{(const char*)ACTb, (const char*)(ws + WS_WD), DFF, 4, G, c, (size_t)128 * DFF, (size_t)D * DFF, 256, TPRE, TAB};
        moe_table(P, TAB, LCNT, ROWS);
        EpiDown E{Yb, in.b_down, GATES, TAB};
        REP(7) pg8::gemm_phase<EpiDown, pg8::MoeProb<false>, true, true>(lds, P, E);
        SEAM(7);
    }
    if (IN(8)) REP(8) final_phase(X1, Yb, in.final_g, args.out, G, c);
#undef IN
#undef SEAM
}

#ifndef MK_N_LAUNCHES
#define MK_N_LAUNCHES 1
#endif
extern "C" void kernel_launch(void* const* d_in, const int* in_sizes, int n_in, void* d_out, int out_size, void* d_ws, size_t ws_size, hipStream_t stream) {
    static int grid = 0;
    if (grid == 0) {
        if (n_in != 15 || out_size != S * D || ws_size < WS_END) { fprintf(stderr, "kernel_launch: unexpected problem (n_in %d out %d ws %zu)\n", n_in, out_size, ws_size); grid = -1; return; }
        int dev = 0, cus = 0, per_cu = 0;
        if (hipGetDevice(&dev) != hipSuccess || hipDeviceGetAttribute(&cus, hipDeviceAttributeMultiprocessorCount, dev) != hipSuccess) { grid = -1; return; }
        if (hipFuncSetAttribute((const void*)fwd, hipFuncAttributeMaxDynamicSharedMemorySize, LDS_BYTES) != hipSuccess) { fprintf(stderr, "kernel_launch: hipFuncSetAttribute failed\n"); grid = -1; return; }
        if (hipOccupancyMaxActiveBlocksPerMultiprocessor(&per_cu, (const void*)fwd, 512, LDS_BYTES) != hipSuccess || per_cu < 1) { fprintf(stderr, "kernel_launch: occupancy query says %d blocks per CU\n", per_cu); (void)hipGetLastError(); per_cu = 1; }
        grid = cus;
    }
    if (grid < 0) return;
    if (hipMemsetAsync((char*)d_ws + WS_CTL, 0, CTL_ZERO_BYTES, stream) != hipSuccess) { fprintf(stderr, "kernel_launch: memset failed\n"); return; }
    Args a{};
    a.in.x = (const float*)d_in[0]; a.in.norm1_g = (const float*)d_in[1]; a.in.w_in = (const float*)d_in[2]; a.in.pool_w = (const float*)d_in[3]; a.in.pool_scale = (const float*)d_in[4];
    a.in.rel_bias = (const float*)d_in[5]; a.in.w_out = (const float*)d_in[6]; a.in.norm2_g = (const float*)d_in[7]; a.in.router_w = (const float*)d_in[8]; a.in.router_b = (const float*)d_in[9];
    a.in.w_gate_up = (const float*)d_in[10]; a.in.b_gate_up = (const float*)d_in[11]; a.in.w_down = (const float*)d_in[12]; a.in.b_down = (const float*)d_in[13]; a.in.final_g = (const float*)d_in[14];
    a.out = (float*)d_out; a.ws = (unsigned char*)d_ws;
    if (MK_N_LAUNCHES == 1) { a.ph_lo = 0; a.ph_hi = NPHASE; hipLaunchKernelGGL(fwd, dim3(grid), dim3(512), LDS_BYTES, stream, a); }
    else for (int p = 0; p < NPHASE; ++p) { a.ph_lo = p; a.ph_hi = p + 1; hipLaunchKernelGGL(fwd, dim3(grid), dim3(512), LDS_BYTES, stream, a); }
    const hipError_t le = hipPeekAtLastError();
    if (le != hipSuccess) fprintf(stderr, "kernel_launch: launch failed: %s\n", hipGetErrorName(le));
}
```

```cpp
#include <hip/hip_runtime.h>
#include <cstdio>
#include <cstdint>

#define LAS __attribute__((address_space(3)))
#define GAS __attribute__((address_space(1)))
typedef unsigned short bf16_t;
typedef short bf16x8 __attribute__((ext_vector_type(8)));
typedef short s16x4 __attribute__((ext_vector_type(4)));
typedef float f32x4 __attribute__((ext_vector_type(4)));
typedef float f32x2 __attribute__((ext_vector_type(2)));
typedef unsigned u32x4 __attribute__((ext_vector_type(4)));
typedef unsigned u32x2 __attribute__((ext_vector_type(2)));
typedef int i32x4 __attribute__((ext_vector_type(4)));
typedef int i32x8 __attribute__((ext_vector_type(8)));

constexpr int S = 16384, D = 1024, NPROJ = 2560, PW = 256, AW = 768, NH = 12, HD = 64, NE = 32, TOPK = 4, DFF = 1024;
constexpr float RMS_EPS = 1e-5f, LOG2E = 1.4426950408889634f, QSCALE = 0.125f * LOG2E, NEGBIG = -1e30f;
constexpr float WSCALE = 64.0f, HSCALE = 16.0f, ASCALE = 8.0f, FP8MAX = 448.0f;
constexpr int BT_N = 400, BT_OFF = 144;

constexpr size_t MiB = 1u << 20;
constexpr size_t WS_CTL = 0, CTL_ZERO_BYTES = 64 * 1024;
constexpr size_t WS_WIN = 2 * MiB;
constexpr size_t WS_WOUT = 8 * MiB;
constexpr size_t WS_GWT = 10 * MiB;
constexpr size_t WS_BT = 10 * MiB + 512 * 1024;
constexpr size_t WS_PWT = 10 * MiB + 768 * 1024;
constexpr size_t WS_RSTD = 11 * MiB;
constexpr size_t WS_GATES = 11 * MiB + 256 * 1024;
constexpr size_t WS_ROWS = 12 * MiB;
constexpr size_t WS_LSE = 14 * MiB;
constexpr size_t WS_WGU = 32 * MiB;
constexpr size_t WS_WD = 160 * MiB;
constexpr size_t WS_H8 = 200 * MiB;
constexpr size_t WS_H = 224 * MiB;
constexpr size_t WS_U = 256 * MiB;
constexpr size_t WS_Q = 264 * MiB, WS_K = 288 * MiB, WS_V = 312 * MiB;
constexpr size_t WS_OP = 336 * MiB;
constexpr size_t WS_MIX = 408 * MiB;
constexpr size_t WS_X1 = 440 * MiB;
constexpr size_t WS_ACT = 512 * MiB;
constexpr size_t WS_Y = 656 * MiB;
constexpr size_t WS_END = 784 * MiB;
constexpr int ACT_ROWS = 65536 + 32 * 256;
constexpr int CW_COUNTS = 64;
constexpr int CW_BAR = 4096;

constexpr int LDS_BYTES = 163840;
constexpr int LDS_TAB = 131072;
constexpr int LDS_CTL = LDS_BYTES - 1024;
constexpr int MAXU = 9;

typedef __bf16 bf16x2_t __attribute__((ext_vector_type(2)));
__device__ __forceinline__ unsigned cvt_pk_bf16(float lo, float hi) { const f32x2 v = {lo, hi}; const bf16x2_t b = __builtin_convertvector(v, bf16x2_t); return __builtin_bit_cast(unsigned, b); }
__device__ __forceinline__ float clamp8(float v) { return fminf(fmaxf(v, -FP8MAX), FP8MAX); }
__device__ __forceinline__ unsigned cvt4_fp8(float a, float b, float c, float d) {
    int p = __builtin_amdgcn_cvt_pk_fp8_f32(clamp8(a), clamp8(b), 0, false); p = __builtin_amdgcn_cvt_pk_fp8_f32(clamp8(c), clamp8(d), p, true); return (unsigned)p; }
__device__ __forceinline__ float bf_lo(unsigned w) { return __uint_as_float(w << 16); }
__device__ __forceinline__ float bf_hi(unsigned w) { return __uint_as_float(w & 0xffff0000u); }
__device__ __forceinline__ float wave_sum(float v) {
#pragma unroll
    for (int o = 1; o < 64; o <<= 1) v += __shfl_xor(v, o);
    return v;
}
#define LDS_WAIT() asm volatile("s_waitcnt lgkmcnt(0)" ::: "memory")
#define VM_WAIT() asm volatile("s_waitcnt vmcnt(0)" ::: "memory")

#define XB_TMO      128
#define XB_XCNT(j)  (256  + 64 * (j))
#define XB_XSUB(j)  (1280 + 64 * (j))
#define XB_XGEN(j)  (2304 + 64 * (j))
#define XB_TOP      3328
#define XB_TOPGEN   3392
#define XCD_BAR_WORDS 3456
#define XB_SPIN_CAP (1u << 18)
__device__ __forceinline__ unsigned xb_ld(unsigned* p)              { return __hip_atomic_load(p, __ATOMIC_RELAXED, __HIP_MEMORY_SCOPE_AGENT); }
__device__ __forceinline__ unsigned xb_add(unsigned* p, unsigned v) { return __hip_atomic_fetch_add(p, v, __ATOMIC_RELAXED, __HIP_MEMORY_SCOPE_AGENT); }
__device__ __forceinline__ unsigned xb_xcc_id() { return (unsigned)__builtin_amdgcn_s_getreg((3 << 11) | 20) & 0xFu; }
#define XB_SPIN(cond, bar) do { unsigned _sp = 0; while (cond) { __builtin_amdgcn_s_sleep(1); \
    if ((++_sp & 255u) == 0u) { if (xb_ld(&(bar)[XB_TMO])) break; if (_sp > XB_SPIN_CAP) { atomicAdd(&(bar)[XB_TMO], 1u); break; } } } } while (0)
struct XcdBarrier { unsigned* bar; unsigned x; volatile LAS unsigned* st; };
__device__ __forceinline__ XcdBarrier xcd_barrier_post(unsigned* bar, volatile LAS unsigned* st) {
    XcdBarrier b; b.bar = bar; b.x = xb_xcc_id(); b.st = st;
    if (threadIdx.x == 0) (void)xb_add(&bar[XB_XCNT(b.x)], 1u);
    return b;
}
__device__ __forceinline__ void xcd_barrier_complete(unsigned* bar, unsigned x, unsigned& nloc, unsigned& nx) {
    const unsigned G = gridDim.x * gridDim.y * gridDim.z;
    unsigned sum, cnt, mine, sp = 0u;
    for (;;) {
        sum = 0u; cnt = 0u; mine = 0u;
#pragma unroll
        for (unsigned j = 0; j < 16; ++j) { const unsigned c = xb_ld(&bar[XB_XCNT(j)]); sum += c; cnt += (c > 0u) ? 1u : 0u; mine = (j == x) ? c : mine; }
        if (sum == G) break;
        __builtin_amdgcn_s_sleep(1);
        if ((++sp & 255u) == 0u) { if (xb_ld(&bar[XB_TMO])) break; if (sp > XB_SPIN_CAP) { atomicAdd(&bar[XB_TMO], 1u); break; } }
    }
    nloc = mine > 0u ? mine : 1u; nx = cnt > 0u ? cnt : 1u;
}
__device__ __forceinline__ void xcd_barrier(const XcdBarrier& b) {
    asm volatile("s_waitcnt vmcnt(0)" ::: "memory");
    __syncthreads();
    if (threadIdx.x == 0) {
        unsigned* bar = b.bar;
        __builtin_amdgcn_s_waitcnt(0);
        unsigned nloc = b.st[0], nx = b.st[1];
        if (nloc == 0u) { xcd_barrier_complete(bar, b.x, nloc, nx); b.st[0] = nloc; b.st[1] = nx; }
        const unsigned old = xb_add(&bar[XB_XSUB(b.x)], 1u);
        const unsigned gen = old / nloc;
        if (old + 1u == (gen + 1u) * nloc) {
            __builtin_amdgcn_fence(__ATOMIC_RELEASE, "agent");
            asm volatile("s_waitcnt vmcnt(0)" ::: "memory");
            const unsigned og = xb_add(&bar[XB_TOP], 1u);
            const unsigned tg = og / nx;
            if (og + 1u == (tg + 1u) * nx) xb_add(&bar[XB_TOPGEN], 1u);
            else XB_SPIN(xb_ld(&bar[XB_TOPGEN]) == tg, bar);
            __builtin_amdgcn_fence(__ATOMIC_ACQUIRE, "agent");
            xb_add(&bar[XB_XGEN(b.x)], 1u);
            asm volatile("s_waitcnt vmcnt(0)" ::: "memory");
        } else {
            XB_SPIN(xb_ld(&bar[XB_XGEN(b.x)]) == gen, bar);
            __builtin_amdgcn_fence(__ATOMIC_ACQUIRE, "agent");
            asm volatile("s_waitcnt vmcnt(0)" ::: "memory");
        }
    }
    __syncthreads();
}

namespace pg8 {
constexpr int BM = 256, BK = 64, HALF = 128, HTB = HALF * BK * 2, STAGE_BYTES = 8 * HTB, NXCD = 8, WGM = 8;
__host__ __device__ __forceinline__ int lds_byte(int r, int c) { const int st = (r >> 4) * 2 + (c >> 5), rr = r & 15, cc = c & 31, ob = rr * 64 + cc * 2; return st * 1024 + (ob ^ (((ob >> 9) & 1) << 5)); }
__host__ __device__ __forceinline__ void stage_rc(int b, int& R, int& C) { const int st = b / 1024, sb = b % 1024, swz = sb ^ (((sb >> 9) & 1) << 5); R = (st >> 1) * 16 + swz / 64; C = (st & 1) * 32 + (swz % 64) / 2; }
__host__ __device__ __forceinline__ int perm32(int rho) { const int n = rho >> 4, i = rho & 15; return 8 * (i >> 2) + 4 * n + (i & 3); }

struct Unit { int pm, pn, e, slot; };

template <class Epi, class Prob, bool ALIGN_EPI, bool FP8>
__device__ __forceinline__ void gemm_phase(LAS unsigned char* lds, const Prob& P, const Epi& E) {
    const int tid = threadIdx.x, wid = __builtin_amdgcn_readfirstlane(tid >> 6), lane = tid & 63, wr = wid >> 2, wc = wid & 3, fr = lane & 15, fq = lane >> 4;
    const int rowb = P.rowb, nt = rowb / 128;
    int Rs[2], Cs[2]; unsigned voffB[2];
#pragma unroll
    for (int i = 0; i < 2; ++i) { int R, C; stage_rc(tid * 16 + i * 8192, R, C); const int Rb = Epi::PERM ? ((R & ~31) + perm32(R & 31)) : R;
        Rs[i] = R; Cs[i] = C * 2; voffB[i] = (unsigned)(Rb * rowb + C * 2); }
    const size_t kstep = (size_t)(BK * 2);
    const size_t bhalf = P.b_half;
    const unsigned ldsw = (unsigned)wid * 1024u;
    const int aoff = lds_byte(wr * 64 + fr, fq * 8), boff = lds_byte(wc * 32 + fr, fq * 8);
#define PG8_SA(b, h) (((b) * 2 + (h)) * HTB)
#define PG8_SB(b, h) ((4 + (b) * 2 + (h)) * HTB)
#define PG8_STAGE_B(bufoff, gbase) do { _Pragma("unroll") for (int _i = 0; _i < 2; ++_i) \
        __builtin_amdgcn_global_load_lds((const unsigned*)((const char*)(gbase) + voffB[_i]), (LAS unsigned*)(lds + (bufoff) + ldsw + _i * 8192), 16, 0, 0); } while (0)
#define PG8_STAGE_A(bufoff, kb, o0, o1) do { \
        __builtin_amdgcn_global_load_lds((const unsigned*)(P.A + (size_t)(o0) + (kb)), (LAS unsigned*)(lds + (bufoff) + ldsw), 16, 0, 0); \
        __builtin_amdgcn_global_load_lds((const unsigned*)(P.A + (size_t)(o1) + (kb)), (LAS unsigned*)(lds + (bufoff) + ldsw + 8192), 16, 0, 0); } while (0)
#define PG8_LDA(dst, b, h) do { _Pragma("unroll") for (int m = 0; m < 4; ++m) _Pragma("unroll") for (int k = 0; k < 2; ++k) dst[m][k] = *(const LAS bf16x8*)(lds + PG8_SA(b, h) + aoff + m * 2048 + k * 1024); } while (0)
#define PG8_LDB(dst, b, h) do { _Pragma("unroll") for (int n = 0; n < 2; ++n) _Pragma("unroll") for (int k = 0; k < 2; ++k) dst[n][k] = *(const LAS bf16x8*)(lds + PG8_SB(b, h) + boff + n * 2048 + k * 1024); } while (0)
#define PG8_MMA(ai, bj, At, Bt) do { __builtin_amdgcn_s_setprio(1); _Pragma("unroll") for (int m = 0; m < 4; ++m) _Pragma("unroll") for (int n = 0; n < 2; ++n) { \
        if constexpr (FP8) { const i32x8 fb_ = __builtin_shufflevector(__builtin_bit_cast(i32x4, Bt[n][0]), __builtin_bit_cast(i32x4, Bt[n][1]), 0, 1, 2, 3, 4, 5, 6, 7); \
            const i32x8 fa_ = __builtin_shufflevector(__builtin_bit_cast(i32x4, At[m][0]), __builtin_bit_cast(i32x4, At[m][1]), 0, 1, 2, 3, 4, 5, 6, 7); \
            acc[ai][bj][m][n] = __builtin_amdgcn_mfma_scale_f32_16x16x128_f8f6f4(fb_, fa_, acc[ai][bj][m][n], 0, 0, 0, 0, 0, 0); } \
        else { _Pragma("unroll") for (int k = 0; k < 2; ++k) acc[ai][bj][m][n] = __builtin_amdgcn_mfma_f32_16x16x32_bf16(Bt[n][k], At[m][k], acc[ai][bj][m][n], 0, 0, 0); } } \
        __builtin_amdgcn_s_setprio(0); } while (0)
#define PG8_WAIT_V(n) asm volatile("s_waitcnt vmcnt(" #n ")" ::: "memory")
#define PG8_WAIT_L(n) asm volatile("s_waitcnt lgkmcnt(" #n ")" ::: "memory")
#define PG8_BAR __builtin_amdgcn_s_barrier()
#define PG8_SCHED __builtin_amdgcn_sched_barrier(0)
    Unit cur, nxt; int ui = 0;
    if (!P.next(0, cur)) return;
    f32x4 acc[2][2][4][2];
#pragma unroll
    for (int a = 0; a < 2; ++a)
#pragma unroll
        for (int b = 0; b < 2; ++b)
#pragma unroll
            for (int m = 0; m < 4; ++m)
#pragma unroll
                for (int n = 0; n < 2; ++n) acc[a][b][m][n] = (f32x4){0.f, 0.f, 0.f, 0.f};
    bf16x8 At[4][2], B0[2][2], B1[2][2];
    unsigned c00 = P.a_off(cur, Rs[0], Cs[0]), c01 = P.a_off(cur, Rs[1], Cs[1]), c10 = P.a_off(cur, HALF + Rs[0], Cs[0]), c11 = P.a_off(cur, HALF + Rs[1], Cs[1]);
    const char* cB = P.b_base(cur);
    PG8_STAGE_B(PG8_SB(0, 0), cB); PG8_STAGE_B(PG8_SB(0, 1), cB + bhalf); PG8_STAGE_A(PG8_SA(0, 0), 0, c00, c01); PG8_STAGE_A(PG8_SA(0, 1), 0, c10, c11);
    if (wr == 1) PG8_BAR;
    PG8_WAIT_V(2); PG8_BAR;
    PG8_STAGE_B(PG8_SB(1, 0), cB + kstep); PG8_STAGE_A(PG8_SA(1, 0), kstep, c00, c01); PG8_STAGE_B(PG8_SB(1, 1), cB + bhalf + kstep);
    PG8_WAIT_V(6); PG8_BAR;
    for (;;) {
        const bool has_next = P.next(ui + 1, nxt);
        const char* nB = has_next ? P.b_base(nxt) : cB;
        for (int t = 0; t < nt; t += 2) {
            const bool last = (t == nt - 2);
            const size_t k1 = (size_t)(t + 1) * kstep;
            const size_t k2 = last ? 0 : (size_t)(t + 2) * kstep, k3 = k2 + kstep;
            const char* b2 = last ? nB : cB + (size_t)(t + 2) * kstep; const char* b3 = b2 + kstep;
            if (last && has_next) { c00 = P.a_off(nxt, Rs[0], Cs[0]); c01 = P.a_off(nxt, Rs[1], Cs[1]); }
            PG8_LDB(B0, 0, 0); PG8_LDB(B1, 0, 1); PG8_SCHED; PG8_LDA(At, 0, 0); PG8_STAGE_A(PG8_SA(1, 1), k1, c10, c11);
            PG8_WAIT_V(8); PG8_WAIT_L(0); PG8_BAR; PG8_MMA(0, 0, At, B0); PG8_MMA(0, 1, At, B1); PG8_BAR; PG8_SCHED;
            if (last && has_next) { c10 = P.a_off(nxt, HALF + Rs[0], Cs[0]); c11 = P.a_off(nxt, HALF + Rs[1], Cs[1]); }
            PG8_LDA(At, 0, 1); PG8_STAGE_B(PG8_SB(0, 0), b2); PG8_STAGE_B(PG8_SB(0, 1), b2 + bhalf); PG8_STAGE_A(PG8_SA(0, 0), k2, c00, c01);
            PG8_WAIT_V(8); PG8_WAIT_L(0); PG8_BAR; PG8_MMA(1, 0, At, B0); PG8_MMA(1, 1, At, B1); PG8_BAR; PG8_SCHED;
            PG8_LDB(B0, 1, 0); PG8_LDB(B1, 1, 1); PG8_SCHED; PG8_LDA(At, 1, 0); PG8_STAGE_A(PG8_SA(0, 1), k2, c10, c11);
            PG8_WAIT_V(8); PG8_WAIT_L(0); PG8_BAR; PG8_MMA(0, 0, At, B0); PG8_MMA(0, 1, At, B1); PG8_BAR; PG8_SCHED;
            PG8_LDA(At, 1, 1); PG8_STAGE_B(PG8_SB(1, 0), b3); PG8_STAGE_B(PG8_SB(1, 1), b3 + bhalf); PG8_STAGE_A(PG8_SA(1, 0), k3, c00, c01);
            PG8_WAIT_V(8); PG8_WAIT_L(0); PG8_BAR; PG8_MMA(1, 0, At, B0); PG8_MMA(1, 1, At, B1); PG8_BAR; PG8_SCHED;
        }
        if constexpr (ALIGN_EPI) { if (wr == 0) PG8_BAR; }
        E(acc, cur, wr, wc, fr, fq);
#if defined(MK_DOUBLE)
        if constexpr (FP8) { if ((MK_DOUBLE >> 12) & 1) { asm volatile("" ::: "memory"); E(acc, cur, wr, wc, fr, fq); } }
#endif
        if (!has_next) break;
#pragma unroll
        for (int a = 0; a < 2; ++a)
#pragma unroll
            for (int b = 0; b < 2; ++b)
#pragma unroll
                for (int m = 0; m < 4; ++m)
#pragma unroll
                    for (int n = 0; n < 2; ++n) acc[a][b][m][n] = (f32x4){0.f, 0.f, 0.f, 0.f};
        cur = nxt; cB = nB; ++ui;
        if constexpr (ALIGN_EPI) { if (wr == 1) PG8_BAR; }
    }
    PG8_WAIT_V(0);
    if constexpr (!ALIGN_EPI) { if (wr == 0) PG8_BAR; }
    PG8_BAR;
#undef PG8_SA
#undef PG8_SB
#undef PG8_STAGE_A
#undef PG8_STAGE_B
#undef PG8_LDA
#undef PG8_LDB
#undef PG8_MMA
#undef PG8_WAIT_V
#undef PG8_WAIT_L
#undef PG8_BAR
#undef PG8_SCHED
}

__device__ __forceinline__ bool static_order(int nM, int nN, int G, int c, int i, int& pm, int& pn) {
    const int nwg = nM * nN; const long L = (long)i * G + c; if (L >= nwg) return false;
    int wgid = (int)L; { const int q = nwg / NXCD, r = nwg % NXCD, xcd = wgid % NXCD, off = wgid / NXCD; wgid = (xcd < r ? xcd * (q + 1) : r * (q + 1) + (xcd - r) * q) + off; }
    const int nig = WGM * nN, gid = wgid / nig, fm = gid * WGM, gsz = (nM - fm) < WGM ? (nM - fm) : WGM;
    pm = fm + ((wgid % nig) % gsz); pn = (wgid % nig) / gsz; return true;
}
struct DenseProb {
    const char* A; const char* Bt; int rowb, nM, nN, G, c; size_t b_half;
    __device__ __forceinline__ bool next(int i, Unit& u) const { u.e = 0; u.slot = i; return static_order(nM, nN, G, c, i, u.pm, u.pn); }
    __device__ __forceinline__ unsigned a_off(const Unit& u, int row, int colb) const { return (unsigned)((u.pm * BM + row) * rowb + colb); }
    __device__ __forceinline__ const char* b_base(const Unit& u) const { return Bt + (size_t)u.pn * BM * rowb; }
};
template <bool GATHER> struct MoeProb {
    const char* A; const char* Bt; int rowb, nN, G, c; size_t b_half; size_t b_expert; int b_tile_rows;
    const LAS int* tpre; const LAS int* tab;
    __device__ __forceinline__ int tp(int j) const { return __builtin_amdgcn_readfirstlane(tpre[j]); }
    __device__ __forceinline__ bool next(int i, Unit& u) const {
        const int total = tp(NE) * nN; const long L0 = (long)i * G + c; if (L0 >= total) return false;
        int L = (int)L0; { const int q = total / NXCD, r = total % NXCD, xcd = L % NXCD, off = L / NXCD; L = (xcd < r ? xcd * (q + 1) : r * (q + 1) + (xcd - r) * q) + off; }
        int e = 0;
#pragma unroll 1
        for (int j = 1; j < NE; ++j) e += (tp(j) * nN <= L) ? 1 : 0;
        const int first = tp(e) * nN, tiles = tp(e + 1) - tp(e), rem = L - first;
        u.e = e; u.pm = rem % tiles; u.pn = rem / tiles; u.slot = i; return true;
    }
    __device__ __forceinline__ unsigned a_off(const Unit& u, int row, int colb) const {
        if (GATHER) { const int idx = tab[u.slot * 256 + row]; const int tok = idx < 0 ? 0 : (idx >> 2); return (unsigned)(tok * rowb + colb); }
        return (unsigned)(((tp(u.e) + u.pm) * BM + row) * rowb + colb);
    }
    __device__ __forceinline__ const char* b_base(const Unit& u) const { return Bt + (size_t)u.e * b_expert + (size_t)u.pn * b_tile_rows * rowb; }
};
}

using pg8::Unit;
typedef f32x4 AccT[2][2][4][2];

struct EpiQKVU {
    static constexpr bool PERM = true;
    unsigned char* ws;
    __device__ __forceinline__ void operator()(const AccT& acc, const Unit& u, int wr, int wc, int fr, int fq) const {
        static_assert(WS_K - WS_Q == WS_V - WS_K, "Q, K, V equally spaced");
        const int t = (u.pn - 1) / 3;
        const size_t boff = (u.pn == 0) ? WS_U : (WS_Q + (size_t)t * (WS_K - WS_Q));
        bf16_t* base = (bf16_t*)(ws + boff);
        const int ldc = (u.pn == 0) ? PW : AW, colt = (u.pn == 0) ? 0 : ((u.pn - 1) % 3) * 256;
        const float sc = (u.pn >= 1 && u.pn <= 3) ? QSCALE : 1.f;
        const int row0 = u.pm * 256 + wr * 64 + fr, col0 = colt + wc * 32 + 8 * fq;
#pragma unroll
        for (int ai = 0; ai < 2; ++ai)
#pragma unroll
            for (int m = 0; m < 4; ++m) { bf16_t* rowp = base + (size_t)(row0 + ai * 128 + m * 16) * ldc + col0;
#pragma unroll
                for (int bj = 0; bj < 2; ++bj) { const f32x4 v0 = acc[ai][bj][m][0] * sc, v1 = acc[ai][bj][m][1] * sc;
                    u32x4 w; w.x = cvt_pk_bf16(v0[0], v0[1]); w.y = cvt_pk_bf16(v0[2], v0[3]); w.z = cvt_pk_bf16(v1[0], v1[1]); w.w = cvt_pk_bf16(v1[2], v1[3]);
                    *(u32x4*)(rowp + bj * 128) = w; } }
    }
};
struct EpiResF32 {
    static constexpr bool PERM = false;
    const float* X; float* O;
    __device__ __forceinline__ void operator()(const AccT& acc, const Unit& u, int wr, int wc, int fr, int fq) const {
        const int row0 = u.pm * 256 + wr * 64 + fr, col0 = u.pn * 256 + wc * 32 + 4 * fq;
#pragma unroll
        for (int ai = 0; ai < 2; ++ai)
#pragma unroll
            for (int m = 0; m < 4; ++m) { const size_t off = (size_t)(row0 + ai * 128 + m * 16) * D + col0;
#pragma unroll
                for (int bj = 0; bj < 2; ++bj)
#pragma unroll
                    for (int n = 0; n < 2; ++n) { const f32x4 r = *(const f32x4*)(X + off + bj * 128 + n * 16); *(f32x4*)(O + off + bj * 128 + n * 16) = acc[ai][bj][m][n] + r; } }
    }
};
__device__ __forceinline__ float swiglu1(float g, float u) {
    g = fminf(g, 7.0f); u = fminf(fmaxf(u, -7.0f), 7.0f);
    const float s = __builtin_amdgcn_rcpf(1.0f + __builtin_amdgcn_exp2f(g * (-1.702f * LOG2E)));
    return (u + 1.0f) * (g * s);
}
struct EpiGateUp {
    static constexpr bool PERM = true;
    unsigned char* ACT; const LAS int* tpre; const LAS float* tabf; const LAS float* tabb;
    __device__ __forceinline__ void operator()(const AccT& acc, const Unit& u, int wr, int wc, int fr, int fq) const {
        const int cl = wc * 32 + 8 * fq, colA = u.pn * 128 + cl;
        const LAS float* bp = tabb + u.slot * 256 + cl;
        const f32x4 bg0 = *(const LAS f32x4*)(bp), bg1 = *(const LAS f32x4*)(bp + 4), bu0 = *(const LAS f32x4*)(bp + 128), bu1 = *(const LAS f32x4*)(bp + 132);
        const int srow0 = (__builtin_amdgcn_readfirstlane(tpre[u.e]) + u.pm) * 256;
#pragma unroll
        for (int ai = 0; ai < 2; ++ai)
#pragma unroll
            for (int m = 0; m < 4; ++m) { const int r = ai * 128 + wr * 64 + m * 16 + fr; const float rs = tabf[u.slot * 256 + r];
                const f32x4 g0 = acc[ai][0][m][0] * rs + bg0, g1 = acc[ai][0][m][1] * rs + bg1, u0 = acc[ai][1][m][0] * rs + bu0, u1 = acc[ai][1][m][1] * rs + bu1;
                u32x2 w; w.x = cvt4_fp8(swiglu1(g0[0], u0[0]) * ASCALE, swiglu1(g0[1], u0[1]) * ASCALE, swiglu1(g0[2], u0[2]) * ASCALE, swiglu1(g0[3], u0[3]) * ASCALE);
                w.y = cvt4_fp8(swiglu1(g1[0], u1[0]) * ASCALE, swiglu1(g1[1], u1[1]) * ASCALE, swiglu1(g1[2], u1[2]) * ASCALE, swiglu1(g1[3], u1[3]) * ASCALE);
                *(u32x2*)(ACT + (size_t)(srow0 + r) * DFF + colA) = w; }
    }
};
struct EpiDown {
    static constexpr bool PERM = true;
    bf16_t* Y; const LAS int* tab; const LAS float* tabf; const LAS float* tabb;
    __device__ __forceinline__ void operator()(const AccT& acc, const Unit& u, int wr, int wc, int fr, int fq) const {
        const int cl = wc * 32 + 8 * fq, col0 = u.pn * 256 + cl;
        const LAS float* bp = tabb + u.slot * 256 + cl;
        f32x4 bv[2][2];
#pragma unroll
        for (int bj = 0; bj < 2; ++bj) { bv[bj][0] = *(const LAS f32x4*)(bp + bj * 128); bv[bj][1] = *(const LAS f32x4*)(bp + bj * 128 + 4); }
#pragma unroll
        for (int ai = 0; ai < 2; ++ai)
#pragma unroll
            for (int m = 0; m < 4; ++m) { const int r = ai * 128 + wr * 64 + m * 16 + fr; const int idx = tab[u.slot * 256 + r];
                if (idx >= 0) { const float gv = tabf[u.slot * 256 + r]; bf16_t* rowp = Y + (size_t)idx * D + col0;
#pragma unroll
                    for (int bj = 0; bj < 2; ++bj) { const f32x4 v0 = (acc[ai][bj][m][0] * (1.0f / (ASCALE * WSCALE)) + bv[bj][0]) * gv, v1 = (acc[ai][bj][m][1] * (1.0f / (ASCALE * WSCALE)) + bv[bj][1]) * gv;
                        u32x4 w; w.x = cvt_pk_bf16(v0[0], v0[1]); w.y = cvt_pk_bf16(v0[2], v0[3]); w.z = cvt_pk_bf16(v1[0], v1[1]); w.w = cvt_pk_bf16(v1[2], v1[3]);
                        *(u32x4*)(rowp + bj * 128) = w; } } }
    }
};

__device__ __forceinline__ void tr_item(const float* __restrict__ W, int K, int N, bf16_t* __restrict__ WT, LAS float* scr, int kb, int nb, int lane) {
    const int k0 = kb * 64, n0 = nb * 64;
    const float* src = W + (size_t)(k0 + (lane >> 4)) * N + n0 + (lane & 15) * 4;
    f32x4 v[16];
#pragma unroll
    for (int i = 0; i < 16; ++i) v[i] = *(const f32x4*)(src + (size_t)(4 * i) * N);
#pragma unroll
    for (int i = 0; i < 16; ++i) { LAS float* d = scr + (4 * i + (lane >> 4)) * 65 + (lane & 15) * 4; d[0] = v[i][0]; d[1] = v[i][1]; d[2] = v[i][2]; d[3] = v[i][3]; }
    LDS_WAIT();
    const int c = lane & 7;
#pragma unroll
    for (int j = 0; j < 8; ++j) { const int n = 8 * j + (lane >> 3); const LAS float* s = scr + (8 * c) * 65 + n;
        u32x4 o; o.x = cvt_pk_bf16(s[0], s[65]); o.y = cvt_pk_bf16(s[130], s[195]); o.z = cvt_pk_bf16(s[260], s[325]); o.w = cvt_pk_bf16(s[390], s[455]);
        *(u32x4*)(WT + (size_t)(n0 + n) * K + k0 + 8 * c) = o; }
    LDS_WAIT();
}
struct Item8 { const float* src; unsigned char* dst; int N; };
__device__ __forceinline__ void item8_load(const Item8& d, f32x4 (&v)[16], int lane) {
    const float* src = d.src + (size_t)(lane >> 4) * d.N + (lane & 15) * 4;
#pragma unroll
    for (int i = 0; i < 16; ++i) v[i] = *(const f32x4*)(src + (size_t)(4 * i) * d.N);
}
__device__ __forceinline__ void item8_store(const Item8& d, const f32x4 (&v)[16], LAS float* scr, int lane) {
#pragma unroll
    for (int i = 0; i < 16; ++i) { LAS float* p = scr + (4 * i + (lane >> 4)) * 65 + (lane & 15) * 4; p[0] = v[i][0]; p[1] = v[i][1]; p[2] = v[i][2]; p[3] = v[i][3]; }
    LDS_WAIT();
    const int c = lane & 3;
#pragma unroll
    for (int j = 0; j < 4; ++j) { const int n = 16 * j + (lane >> 2); const LAS float* s = scr + (16 * c) * 65 + n;
        u32x4 o;
#pragma unroll
        for (int q = 0; q < 4; ++q) o[q] = cvt4_fp8(s[(4 * q) * 65] * WSCALE, s[(4 * q + 1) * 65] * WSCALE, s[(4 * q + 2) * 65] * WSCALE, s[(4 * q + 3) * 65] * WSCALE);
        *(u32x4*)(d.dst + (size_t)n * D + 16 * c) = o; }
    LDS_WAIT();
}
__device__ __forceinline__ int t5_bucket(int dist) {
    if (dist < 16) return dist;
    const int large = 16 + (int)(logf((float)dist / 16.0f) / 4.852030263919617f * 16.0f);
    return large < 31 ? large : 31;
}
struct In { const float *x, *norm1_g, *w_in, *pool_w, *pool_scale, *rel_bias, *w_out, *norm2_g, *router_w, *router_b, *w_gate_up, *b_gate_up, *w_down, *b_down, *final_g; };

__device__ __forceinline__ void p0_prologue(LAS unsigned char* lds, const In& in, unsigned char* ws, int G, int c) {
    const int tid = threadIdx.x, lane = tid & 63, wave = __builtin_amdgcn_readfirstlane(tid >> 6);
    const int gw = c * 8 + wave, NGW = G * 8;
    LAS float* scr = (LAS float*)(lds + wave * 16640);
    constexpr int I_IN = 16 * 40, I_OUT = 16 * 16, I_GU1 = 16 * 32, I_D1 = 16 * 16;
    for (int it = gw; it < I_IN + I_OUT; it += NGW) {
        if (it < I_IN) tr_item(in.w_in, D, NPROJ, (bf16_t*)(ws + WS_WIN), scr, it / 40, it % 40, lane);
        else { const int r = it - I_IN; tr_item(in.w_out, D, D, (bf16_t*)(ws + WS_WOUT), scr, r / 16, r % 16, lane); }
    }
#ifndef MK_DOUBLE
#define MK_DOUBLE 0
#endif
    for (int rep8_ = 0; rep8_ < (((MK_DOUBLE >> 10) & 1) ? 2 : 1); ++rep8_) {
        constexpr int N8 = NE * I_GU1 + NE * I_D1;
        auto desc = [&](int r) -> Item8 { Item8 d;
            if (r < NE * I_GU1) { const int e = r / I_GU1, q = r % I_GU1, kb = q / 32, nb = q % 32;
                d.src = in.w_gate_up + (size_t)e * D * 2 * DFF + (size_t)(kb * 64) * (2 * DFF) + nb * 64; d.N = 2 * DFF; d.dst = ws + WS_WGU + (size_t)e * 2 * DFF * D + (size_t)(nb * 64) * D + kb * 64; }
            else { const int r2 = r - NE * I_GU1, e = r2 / I_D1, q = r2 % I_D1, kb = q / 16, nb = q % 16;
                d.src = in.w_down + (size_t)e * DFF * D + (size_t)(kb * 64) * D + nb * 64; d.N = D; d.dst = ws + WS_WD + (size_t)e * D * DFF + (size_t)(nb * 64) * DFF + kb * 64; }
            return d; };
        f32x4 va[16], vb[16];
        int it = gw;
        if (it < N8) { Item8 d0 = desc(it); item8_load(d0, va, lane); }
        while (it < N8) {
            const Item8 d0 = desc(it); const int it1 = it + NGW; Item8 d1 = d0;
            if (it1 < N8) { d1 = desc(it1); item8_load(d1, vb, lane); }
            item8_store(d0, va, scr, lane);
            if (it1 >= N8) break;
            const int it2 = it1 + NGW;
            if (it2 < N8) { const Item8 d2 = desc(it2); item8_load(d2, va, lane); }
            item8_store(d1, vb, scr, lane);
            it = it2;
        }
    }
    for (int repr_ = 0; repr_ < (((MK_DOUBLE >> 11) & 1) ? 2 : 1); ++repr_) {
        f32x4 gv[4];
#pragma unroll
        for (int j = 0; j < 4; ++j) gv[j] = *(const f32x4*)(in.norm1_g + 4 * lane + 256 * j);
        bf16_t* H = (bf16_t*)(ws + WS_H);
        f32x4 v[4], vn[4];
        int m = gw;
        if (m < S) {
#pragma unroll
            for (int j = 0; j < 4; ++j) v[j] = *(const f32x4*)(in.x + (size_t)m * D + 4 * lane + 256 * j); }
        for (; m < S; m += NGW) {
            const int mn = m + NGW;
            if (mn < S) {
#pragma unroll
                for (int j = 0; j < 4; ++j) vn[j] = *(const f32x4*)(in.x + (size_t)mn * D + 4 * lane + 256 * j); }
            float s = 0.f;
#pragma unroll
            for (int j = 0; j < 4; ++j) s += (v[j][0] * v[j][0] + v[j][1] * v[j][1]) + (v[j][2] * v[j][2] + v[j][3] * v[j][3]);
            const float rstd = rsqrtf(wave_sum(s) * (1.0f / D) + RMS_EPS);
#pragma unroll
            for (int j = 0; j < 4; ++j) { const f32x4 o = v[j] * rstd * gv[j]; u32x2 w; w.x = cvt_pk_bf16(o[0], o[1]); w.y = cvt_pk_bf16(o[2], o[3]); *(u32x2*)(H + (size_t)m * D + 4 * lane + 256 * j) = w; }
#pragma unroll
            for (int j = 0; j < 4; ++j) v[j] = vn[j];
        }
    }
    const int gt = c * 512 + tid, NGT = G * 512;
    { float* GWT = (float*)(ws + WS_GWT); for (int i = gt; i < NE * D; i += NGT) { const int e = i >> 10, k = i & 1023; GWT[i] = in.norm2_g[k] * in.router_w[k * NE + e]; } }
    { float* BT = (float*)(ws + WS_BT); for (int i = gt; i < 36 * BT_N; i += NGT) { const int bh = i / BT_N, j = i % BT_N, b = bh / NH, h = bh % NH, dil = (b == 0) ? 1 : (b == 1 ? 4 : 16), d = j - BT_OFF;
        BT[i] = (d >= 0 && d <= 128) ? in.rel_bias[t5_bucket(d * dil) * NH + h] * LOG2E : NEGBIG; } }
    { bf16_t* PWT = (bf16_t*)(ws + WS_PWT); for (int i = gt; i < 4 * 64 * 64; i += NGT) { const int g = i >> 12, d = (i >> 6) & 63, cc = i & 63; PWT[i] = (bf16_t)(cvt_pk_bf16(in.pool_w[g * 4096 + cc * 64 + d], 0.f) & 0xffffu); } }
}

__device__ __forceinline__ s16x4 lds_tr16(const LAS unsigned char* p) { typedef short v4i16_t __attribute__((ext_vector_type(4))); return __builtin_bit_cast(s16x4, __builtin_amdgcn_ds_read_tr16_b64_v4i16((LAS v4i16_t*)p)); }
constexpr int ATT_UNITS = 3 * NH * 64, KV_PITCH = 144, KV_ROWS = 384, ATT_VOFF = KV_ROWS * KV_PITCH, ATT_TOFF = 2 * KV_ROWS * KV_PITCH, ATT_NEGOFF = ATT_TOFF + BT_N * 4;
__device__ __forceinline__ void attn_decode(int uid, int& b, int& h, int& r, int& j, int& dil) {
    const int bh = uid >> 6, x = uid & 63; b = bh / NH; h = bh % NH; dil = (b == 0) ? 1 : (b == 1 ? 4 : 16);
    const int nb = 64 / dil; r = x / nb; j = x % nb;
}
__device__ __forceinline__ void attn_phase(LAS unsigned char* lds, const bf16_t* __restrict__ Qg, const bf16_t* __restrict__ Kg, const bf16_t* __restrict__ Vg, const float* __restrict__ BT,
                                           bf16_t* __restrict__ OP, float* __restrict__ LSE, int G, int c) {
    const int tid = threadIdx.x, lane = tid & 63, w = __builtin_amdgcn_readfirstlane(tid >> 6), ql = lane & 15, g = lane >> 4;
    LAS unsigned char* Ks = lds; LAS unsigned char* Vs = lds + ATT_VOFF; LAS float* Tb = (LAS float*)(lds + ATT_TOFF); LAS float* Tneg = (LAS float*)(lds + ATT_NEGOFF);
    if (tid < 16) Tneg[tid] = NEGBIG;
    u32x4 kpre[6], vpre[6]; bf16x8 qa0, qa1, qb0, qb1; float tpre = 0.f;
#define ATT_PREFETCH(uid_) do { int b_, h_, r_, j_, dil_; attn_decode((uid_), b_, h_, r_, j_, dil_); \
        _Pragma("unroll") for (int cc = 0; cc < 6; ++cc) { const int id = tid + 512 * cc, row = id >> 3, ch = id & 7; int mm = 256 * j_ - 128 + row; if (mm < 0) mm += 128; \
            const size_t off = (size_t)(r_ + dil_ * mm) * AW + h_ * HD + ch * 8; kpre[cc] = *(const u32x4*)(Kg + off); vpre[cc] = *(const u32x4*)(Vg + off); } \
        { const size_t qo = (size_t)(r_ + dil_ * (256 * j_ + 32 * w + ql)) * AW + h_ * HD + 8 * g; const size_t qs = (size_t)16 * dil_ * AW; \
          qa0 = *(const bf16x8*)(Qg + qo); qa1 = *(const bf16x8*)(Qg + qo + 32); qb0 = *(const bf16x8*)(Qg + qo + qs); qb1 = *(const bf16x8*)(Qg + qo + qs + 32); } \
        if (tid < BT_N) tpre = BT[(b_ * NH + h_) * BT_N + tid]; } while (0)
#ifndef ATT_SYNC_LOAD
    if (c < ATT_UNITS) ATT_PREFETCH(c);
#endif
    for (int uid = c; uid < ATT_UNITS; uid += G) {
        int b, h, r, j, dil; attn_decode(uid, b, h, r, j, dil);
#ifdef ATT_SYNC_LOAD
        ATT_PREFETCH(uid);
#endif
#pragma unroll
        for (int cc = 0; cc < 6; ++cc) { const int id = tid + 512 * cc, row = id >> 3, ch = id & 7; *(LAS u32x4*)(Ks + row * KV_PITCH + ch * 16) = kpre[cc]; *(LAS u32x4*)(Vs + row * KV_PITCH + ch * 16) = vpre[cc]; }
        if (tid < BT_N) Tb[tid] = tpre;
        const bf16x8 fa0 = qa0, fa1 = qa1, fb0 = qb0, fb1 = qb1;
        __syncthreads();
#ifndef ATT_SYNC_LOAD
        if (uid + G < ATT_UNITS) ATT_PREFETCH(uid + G);
#endif
        const int kkmin = (j == 0) ? 128 : 0;
        const LAS unsigned char* kb = Ks + (32 * w + ql) * KV_PITCH + g * 16;
        const LAS float* Tq = Tb + (ql + 272 - 4 * g - 3);
        const f32x4 zero4 = (f32x4){0.f, 0.f, 0.f, 0.f};
        f32x4 sA[9], sB[9];
#pragma unroll
        for (int i = 0; i < 10; ++i) {
            const bf16x8 kf0 = *(const LAS bf16x8*)(kb + i * (16 * KV_PITCH)), kf1 = *(const LAS bf16x8*)(kb + i * (16 * KV_PITCH) + 64);
            const bool msk = (32 * w + 16 * i) < kkmin;
            if (i <= 8) { f32x4 st = __builtin_amdgcn_mfma_f32_16x16x32_bf16(kf0, fa0, zero4, 0, 0, 0); st = __builtin_amdgcn_mfma_f32_16x16x32_bf16(kf1, fa1, st, 0, 0, 0);
                const LAS float* tp = msk ? Tneg : (Tq - 16 * i); sA[i] = (f32x4){st[0] + tp[3], st[1] + tp[2], st[2] + tp[1], st[3] + tp[0]}; }
            if (i >= 1) { f32x4 st = __builtin_amdgcn_mfma_f32_16x16x32_bf16(kf0, fb0, zero4, 0, 0, 0); st = __builtin_amdgcn_mfma_f32_16x16x32_bf16(kf1, fb1, st, 0, 0, 0);
                const LAS float* tp = msk ? Tneg : (Tq - 16 * (i - 1)); sB[i - 1] = (f32x4){st[0] + tp[3], st[1] + tp[2], st[2] + tp[1], st[3] + tp[0]}; }
        }
        float mA = NEGBIG, mB = NEGBIG;
#pragma unroll
        for (int i = 0; i < 9; ++i) { mA = fmaxf(mA, fmaxf(fmaxf(sA[i][0], sA[i][1]), fmaxf(sA[i][2], sA[i][3]))); mB = fmaxf(mB, fmaxf(fmaxf(sB[i][0], sB[i][1]), fmaxf(sB[i][2], sB[i][3]))); }
        mA = fmaxf(mA, __shfl_xor(mA, 16)); mA = fmaxf(mA, __shfl_xor(mA, 32)); mB = fmaxf(mB, __shfl_xor(mB, 16)); mB = fmaxf(mB, __shfl_xor(mB, 32));
        f32x4 oA[4], oB[4];
#pragma unroll
        for (int dt = 0; dt < 4; ++dt) { oA[dt] = zero4; oB[dt] = zero4; }
        float lA = 0.f, lB = 0.f;
        const LAS unsigned char* vb = Vs + (32 * w + 4 * g + (ql >> 2)) * KV_PITCH + (ql & 3) * 8;
#pragma unroll
        for (int i = 0; i < 10; ++i) {
            const LAS unsigned char* vt = vb + i * (16 * KV_PITCH);
            const s16x4 v0 = lds_tr16(vt), v1 = lds_tr16(vt + 32), v2 = lds_tr16(vt + 64), v3 = lds_tr16(vt + 96);
            if (i <= 8) { const float p0 = __builtin_amdgcn_exp2f(sA[i][0] - mA), p1 = __builtin_amdgcn_exp2f(sA[i][1] - mA), p2 = __builtin_amdgcn_exp2f(sA[i][2] - mA), p3 = __builtin_amdgcn_exp2f(sA[i][3] - mA);
                lA += (p0 + p1) + (p2 + p3); u32x2 pw; pw.x = cvt_pk_bf16(p0, p1); pw.y = cvt_pk_bf16(p2, p3); const s16x4 pf = __builtin_bit_cast(s16x4, pw);
                oA[0] = __builtin_amdgcn_mfma_f32_16x16x16bf16_1k(v0, pf, oA[0], 0, 0, 0); oA[1] = __builtin_amdgcn_mfma_f32_16x16x16bf16_1k(v1, pf, oA[1], 0, 0, 0);
                oA[2] = __builtin_amdgcn_mfma_f32_16x16x16bf16_1k(v2, pf, oA[2], 0, 0, 0); oA[3] = __builtin_amdgcn_mfma_f32_16x16x16bf16_1k(v3, pf, oA[3], 0, 0, 0); }
            if (i >= 1) { const float p0 = __builtin_amdgcn_exp2f(sB[i - 1][0] - mB), p1 = __builtin_amdgcn_exp2f(sB[i - 1][1] - mB), p2 = __builtin_amdgcn_exp2f(sB[i - 1][2] - mB), p3 = __builtin_amdgcn_exp2f(sB[i - 1][3] - mB);
                lB += (p0 + p1) + (p2 + p3); u32x2 pw; pw.x = cvt_pk_bf16(p0, p1); pw.y = cvt_pk_bf16(p2, p3); const s16x4 pf = __builtin_bit_cast(s16x4, pw);
                oB[0] = __builtin_amdgcn_mfma_f32_16x16x16bf16_1k(v0, pf, oB[0], 0, 0, 0); oB[1] = __builtin_amdgcn_mfma_f32_16x16x16bf16_1k(v1, pf, oB[1], 0, 0, 0);
                oB[2] = __builtin_amdgcn_mfma_f32_16x16x16bf16_1k(v2, pf, oB[2], 0, 0, 0); oB[3] = __builtin_amdgcn_mfma_f32_16x16x16bf16_1k(v3, pf, oB[3], 0, 0, 0); }
        }
        lA += __shfl_xor(lA, 16); lA += __shfl_xor(lA, 32); lB += __shfl_xor(lB, 16); lB += __shfl_xor(lB, 32);
#ifdef ATT_EXP1
        lA = 1.0f; lB = 1.0f; mA = 0.f; mB = 0.f;
#pragma unroll
        for (int dt = 0; dt < 4; ++dt) { oA[dt] = zero4; oB[dt] = zero4; }
#endif
#ifdef ATT_EXP2
        lA = 1.0f; lB = 1.0f;
#pragma unroll
        for (int dt = 0; dt < 4; ++dt) { oA[dt] = zero4; oB[dt] = zero4; }
#endif
        const float iA = 1.0f / lA, iB = 1.0f / lB;
        const int posA = r + dil * (256 * j + 32 * w + ql), posB = posA + 16 * dil;
        bf16_t* dA = OP + ((size_t)b * S + posA) * AW + h * HD + 4 * g; bf16_t* dB = OP + ((size_t)b * S + posB) * AW + h * HD + 4 * g;
#pragma unroll
        for (int dt = 0; dt < 4; ++dt) { u32x2 t; t.x = cvt_pk_bf16(oA[dt][0] * iA, oA[dt][1] * iA); t.y = cvt_pk_bf16(oA[dt][2] * iA, oA[dt][3] * iA); *(u32x2*)(dA + 16 * dt) = t;
            u32x2 t2; t2.x = cvt_pk_bf16(oB[dt][0] * iB, oB[dt][1] * iB); t2.y = cvt_pk_bf16(oB[dt][2] * iB, oB[dt][3] * iB); *(u32x2*)(dB + 16 * dt) = t2; }
        if (g == 0) { LSE[((size_t)b * S + posA) * NH + h] = mA + __builtin_amdgcn_logf(lA); LSE[((size_t)b * S + posB) * NH + h] = mB + __builtin_amdgcn_logf(lB); }
        __syncthreads();
    }
#undef ATT_PREFETCH
}

__device__ __forceinline__ void pool_phase(LAS unsigned char* lds, const bf16_t* __restrict__ U, const bf16_t* __restrict__ PWT, const float* __restrict__ pool_scale, bf16_t* __restrict__ MIX, int G, int c) {
    const int tid = threadIdx.x, lane = tid & 63, w = __builtin_amdgcn_readfirstlane(tid >> 6), ql = lane & 15, g = lane >> 4;
    LAS unsigned char* Us = lds; LAS unsigned char* Pl = lds + 40960;
    for (int pu = c; pu < S / 64; pu += G) {
        const int t0 = pu * 64;
        for (int id = tid; id < 79 * 32; id += 512) { const int row = id >> 5, ch = id & 31, t = t0 - 15 + row;
            u32x4 v = (u32x4){0u, 0u, 0u, 0u}; if (t >= 0) v = *(const u32x4*)(U + (size_t)t * PW + ch * 8);
            *(LAS u32x4*)(Us + row * 512 + ch * 16) = v; }
        __syncthreads();
        { const int cch = tid & 255, th = tid >> 8, gg = cch >> 6, wn = 2 << gg, tl0 = 32 * th;
          const LAS bf16_t* up = (const LAS bf16_t*)Us + cch;
#define UAT(row) __uint_as_float(((unsigned)up[(row) * 256]) << 16)
          float sum = 0.f;
          for (int i = 0; i < wn; ++i) sum += UAT(tl0 + 15 - i);
          for (int tl = tl0; tl < tl0 + 32; ++tl) {
              if (tl > tl0) sum += UAT(tl + 15) - UAT(tl + 15 - wn);
              const int t = t0 + tl; const int cnt = (t + 1 < wn) ? (t + 1) : wn;
              const float val = sum / (float)cnt - UAT(tl + 15);
              ((LAS bf16_t*)(Pl + tl * 528))[cch] = (bf16_t)(cvt_pk_bf16(val, 0.f) & 0xffffu);
          }
#undef UAT
        }
        __syncthreads();
        { const int tt = w & 3, gp = w >> 2;
#pragma unroll
          for (int gi = 0; gi < 2; ++gi) { const int gg = 2 * gp + gi;
              const bf16x8 b0 = *(const LAS bf16x8*)(Pl + (16 * tt + ql) * 528 + (gg * 64 + 8 * g) * 2), b1 = *(const LAS bf16x8*)(Pl + (16 * tt + ql) * 528 + (gg * 64 + 32 + 8 * g) * 2);
#pragma unroll
              for (int nt = 0; nt < 4; ++nt) {
                  const bf16_t* ap = PWT + ((size_t)(gg * 64 + 16 * nt + ql) * 64 + 8 * g);
                  const bf16x8 a0 = *(const bf16x8*)(ap), a1 = *(const bf16x8*)(ap + 32);
                  f32x4 acc = __builtin_amdgcn_mfma_f32_16x16x32_bf16(a0, b0, (f32x4){0.f, 0.f, 0.f, 0.f}, 0, 0, 0);
                  acc = __builtin_amdgcn_mfma_f32_16x16x32_bf16(a1, b1, acc, 0, 0, 0);
                  const f32x4 ps = *(const f32x4*)(pool_scale + gg * 64 + 16 * nt + 4 * g);
                  u32x2 o; o.x = cvt_pk_bf16(acc[0] * ps[0], acc[1] * ps[1]); o.y = cvt_pk_bf16(acc[2] * ps[2], acc[3] * ps[3]);
                  *(u32x2*)(MIX + (size_t)(t0 + 16 * tt + ql) * D + gg * 64 + 16 * nt + 4 * g) = o;
              } }
        }
        __syncthreads();
    }
}

__device__ __forceinline__ void combine_phase(const bf16_t* __restrict__ OP, const float* __restrict__ LSE, bf16_t* __restrict__ MIX, int G, int c) {
    const int gt = c * 512 + threadIdx.x, NGT = G * 512;
    for (int id = gt; id < S * 96; id += NGT) {
        const int t = id / 96, rem = id % 96, h = rem >> 3, c8 = rem & 7;
        const float l0 = LSE[(size_t)t * NH + h], l1 = LSE[((size_t)S + t) * NH + h], l2 = LSE[((size_t)2 * S + t) * NH + h];
        const float mx = fmaxf(l0, fmaxf(l1, l2));
        float w0 = __builtin_amdgcn_exp2f(l0 - mx), w1 = __builtin_amdgcn_exp2f(l1 - mx), w2 = __builtin_amdgcn_exp2f(l2 - mx);
        const float inv = 1.0f / (w0 + w1 + w2); w0 *= inv; w1 *= inv; w2 *= inv;
        const size_t off = (size_t)t * AW + h * HD + c8 * 8;
        const u32x4 a = *(const u32x4*)(OP + off), b = *(const u32x4*)(OP + (size_t)S * AW + off), cc = *(const u32x4*)(OP + (size_t)2 * S * AW + off);
        u32x4 o;
#pragma unroll
        for (int k = 0; k < 4; ++k) { const float lo = w0 * bf_lo(a[k]) + w1 * bf_lo(b[k]) + w2 * bf_lo(cc[k]), hi = w0 * bf_hi(a[k]) + w1 * bf_hi(b[k]) + w2 * bf_hi(cc[k]); o[k] = cvt_pk_bf16(lo, hi); }
        *(u32x4*)(MIX + (size_t)t * D + PW + h * HD + c8 * 8) = o;
    }
}

constexpr int GW_PITCH = 1028;
constexpr int RT_G2 = 131584, RT_LG = RT_G2 + 4096, RT_RS = RT_LG + 4 * 16 * 33 * 4, RT_CNT = RT_RS + 256, RT_PART = RT_CNT + 256, RT_END = RT_PART + 4 * 64 * 9 * 4;
static_assert(RT_END <= LDS_CTL, "router LDS map");
__device__ __forceinline__ void router_phase(LAS unsigned char* lds, const float* __restrict__ X1, const float* __restrict__ g2, const float* __restrict__ GWT, const float* __restrict__ rb,
                                             unsigned char* __restrict__ H, float* __restrict__ RSTD, float* __restrict__ GATES, int* __restrict__ ROWS, unsigned* __restrict__ COUNTS, int G, int c) {
    const int tid = threadIdx.x, lane = tid & 63, w = __builtin_amdgcn_readfirstlane(tid >> 6), ql = lane & 15, g = lane >> 4;
    const int ts = w & 3, kh = w >> 2;
    LAS float* GW = (LAS float*)lds;
    LAS float* G2 = (LAS float*)(lds + RT_G2);
    LAS float* LG = (LAS float*)(lds + RT_LG) + ts * (16 * 33);
    LAS float* RS = (LAS float*)(lds + RT_RS) + ts * 16;
    LAS int* LCNT = (LAS int*)(lds + RT_CNT);
    LAS int* LBASE = LCNT + 32;
    LAS float* PART = (LAS float*)(lds + RT_PART) + ts * (64 * 9);
    for (int id = tid; id < NE * 256; id += 512) { const int e = id >> 8, k4 = id & 255; *(LAS f32x4*)(GW + e * GW_PITCH + k4 * 4) = *(const f32x4*)(GWT + e * D + k4 * 4); }
    if (tid < 256) *(LAS f32x4*)(G2 + tid * 4) = *(const f32x4*)(g2 + tid * 4);
    const int nrounds = (S / 16 + 4 * G - 1) / (4 * G);
    for (int rd = 0; rd < nrounds; ++rd) {
        if (tid < 32) LCNT[tid] = 0;
        __syncthreads();
        const int tile = (rd * 4 + ts) * G + c;
        int ek[4] = {0, 0, 0, 0}, lp[4] = {0, 0, 0, 0}; float gk[4] = {0.f, 0.f, 0.f, 0.f};
        const bool active = tile < S / 16;
        f32x4 acc0 = (f32x4){0.f, 0.f, 0.f, 0.f}, acc1 = acc0; float ss = 0.f;
        const int tok = (active ? tile : 0) * 16 + ql;
        if (active) {
            const float* xr = X1 + (size_t)tok * D + kh * 512 + 8 * g;
            unsigned char* hr = H + (size_t)tok * D + kh * 512 + 8 * g;
            const LAS float* w0p = GW + ql * GW_PITCH + kh * 512 + 8 * g; const LAS float* w1p = GW + (16 + ql) * GW_PITCH + kh * 512 + 8 * g;
            const LAS float* gp = G2 + kh * 512 + 8 * g;
#pragma unroll 1
            for (int kb = 0; kb < 512; kb += 256) {
                f32x4 av[16];
#pragma unroll
                for (int i = 0; i < 8; ++i) { av[2 * i] = *(const f32x4*)(xr + kb + 32 * i); av[2 * i + 1] = *(const f32x4*)(xr + kb + 32 * i + 4); }
#pragma unroll
                for (int i = 0; i < 8; ++i) {
                    const int k0 = kb + 32 * i; const f32x4 a0 = av[2 * i], a1 = av[2 * i + 1];
                    const f32x4 n0 = *(const LAS f32x4*)(gp + k0), n1 = *(const LAS f32x4*)(gp + k0 + 4);
                    const f32x4 b00 = *(const LAS f32x4*)(w0p + k0), b01 = *(const LAS f32x4*)(w0p + k0 + 4), b10 = *(const LAS f32x4*)(w1p + k0), b11 = *(const LAS f32x4*)(w1p + k0 + 4);
                    ss += (a0[0] * a0[0] + a0[1] * a0[1]) + (a0[2] * a0[2] + a0[3] * a0[3]) + (a1[0] * a1[0] + a1[1] * a1[1]) + (a1[2] * a1[2] + a1[3] * a1[3]);
                    u32x2 hv; hv.x = cvt4_fp8(a0[0] * n0[0] * HSCALE, a0[1] * n0[1] * HSCALE, a0[2] * n0[2] * HSCALE, a0[3] * n0[3] * HSCALE);
                    hv.y = cvt4_fp8(a1[0] * n1[0] * HSCALE, a1[1] * n1[1] * HSCALE, a1[2] * n1[2] * HSCALE, a1[3] * n1[3] * HSCALE);
                    *(u32x2*)(hr + k0) = hv;
#pragma unroll
                    for (int jj = 0; jj < 4; ++jj) { acc0 = __builtin_amdgcn_mfma_f32_16x16x4f32(a0[jj], b00[jj], acc0, 0, 0, 0); acc1 = __builtin_amdgcn_mfma_f32_16x16x4f32(a0[jj], b10[jj], acc1, 0, 0, 0); }
#pragma unroll
                    for (int jj = 0; jj < 4; ++jj) { acc0 = __builtin_amdgcn_mfma_f32_16x16x4f32(a1[jj], b01[jj], acc0, 0, 0, 0); acc1 = __builtin_amdgcn_mfma_f32_16x16x4f32(a1[jj], b11[jj], acc1, 0, 0, 0); }
                }
            }
            if (kh == 1) { LAS float* pp = PART + lane * 9;
#pragma unroll
                for (int i = 0; i < 4; ++i) { pp[i] = acc0[i]; pp[4 + i] = acc1[i]; } pp[8] = ss; }
        }
        __syncthreads();
        if (active && kh == 0) {
            { const LAS float* pp = PART + lane * 9;
#pragma unroll
              for (int i = 0; i < 4; ++i) { acc0[i] += pp[i]; acc1[i] += pp[4 + i]; } ss += pp[8]; }
            ss += __shfl_xor(ss, 16); ss += __shfl_xor(ss, 32);
            const float rstd = rsqrtf(ss * (1.0f / D) + RMS_EPS);
            if (g == 0) { RSTD[tok] = rstd; RS[ql] = rstd; }
            LDS_WAIT();
            const float rb0 = rb[ql], rb1 = rb[16 + ql];
#pragma unroll
            for (int rg = 0; rg < 4; ++rg) { const float rr = RS[4 * g + rg]; LG[(4 * g + rg) * 33 + ql] = acc0[rg] * rr + rb0; LG[(4 * g + rg) * 33 + 16 + ql] = acc1[rg] * rr + rb1; }
            LDS_WAIT();
            if (lane < 16) {
                float v[32];
#pragma unroll
                for (int e = 0; e < 32; ++e) v[e] = LG[ql * 33 + e];
                float tv[4];
#pragma unroll
                for (int r = 0; r < 4; ++r) { float best = v[0]; int bi = 0;
#pragma unroll
                    for (int e = 1; e < 32; ++e) { const bool gt = v[e] > best; best = gt ? v[e] : best; bi = gt ? e : bi; }
                    tv[r] = best; ek[r] = bi;
#pragma unroll
                    for (int e = 0; e < 32; ++e) v[e] = (e == bi) ? -INFINITY : v[e]; }
                const float e1 = __expf(tv[1] - tv[0]), e2 = __expf(tv[2] - tv[0]), e3 = __expf(tv[3] - tv[0]); const float inv = 1.0f / (1.0f + e1 + e2 + e3);
                gk[0] = inv; gk[1] = e1 * inv; gk[2] = e2 * inv; gk[3] = e3 * inv;
#pragma unroll
                for (int r = 0; r < 4; ++r) lp[r] = __hip_atomic_fetch_add(LCNT + ek[r], 1, __ATOMIC_RELAXED, __HIP_MEMORY_SCOPE_WORKGROUP);
            }
        }
        __syncthreads();
        if (tid < 32) { const int n = LCNT[tid]; int base = 0; if (n > 0) base = (int)__hip_atomic_fetch_add(COUNTS + tid, (unsigned)n, __ATOMIC_RELAXED, __HIP_MEMORY_SCOPE_AGENT); LBASE[tid] = base; }
        __syncthreads();
        if (active && kh == 0 && lane < 16) {
#pragma unroll
            for (int r = 0; r < 4; ++r) { const int pos = LBASE[ek[r]] + lp[r]; ROWS[(size_t)ek[r] * S + pos] = tok * 4 + r; GATES[tok * 4 + r] = gk[r]; } }
        __syncthreads();
    }
}

__device__ __forceinline__ void moe_prefix(LAS int* tpre, LAS int* lcnt, const unsigned* __restrict__ COUNTS) {
    if (threadIdx.x < 32) lcnt[threadIdx.x] = (int)COUNTS[threadIdx.x];
    __syncthreads();
    if (threadIdx.x == 0) { int acc = 0; for (int e = 0; e < NE; ++e) { tpre[e] = acc; acc += (lcnt[e] + 255) >> 8; } tpre[NE] = acc; }
    __syncthreads();
}
template <bool GU, class Prob> __device__ __forceinline__ void moe_table(const Prob& P, LAS int* tab, LAS float* tabf, LAS float* tabb, const LAS int* lcnt, const int* __restrict__ ROWS,
                                                                         const float* __restrict__ rowf, const float* __restrict__ bias) {
    Unit u;
#pragma unroll 1
    for (int i = 0; i < MAXU && P.next(i, u); ++i) {
        if (threadIdx.x < 256) { const int rr = u.pm * 256 + (int)threadIdx.x; const int idx = (rr < lcnt[u.e]) ? ROWS[(size_t)u.e * S + rr] : -1; tab[i * 256 + threadIdx.x] = idx;
            tabf[i * 256 + threadIdx.x] = GU ? rowf[idx < 0 ? 0 : (idx >> 2)] * (1.0f / (HSCALE * WSCALE)) : (idx < 0 ? 0.f : rowf[idx]); }
        else { const int j = (int)threadIdx.x - 256;
            tabb[i * 256 + j] = GU ? bias[(size_t)u.e * 2 * DFF + (j >> 7) * DFF + u.pn * 128 + (j & 127)] : bias[(size_t)u.e * D + u.pn * 256 + j]; }
    }
    __syncthreads();
}

__device__ __forceinline__ void final_phase(const float* __restrict__ X1, const bf16_t* __restrict__ Y, const float* __restrict__ fg, float* __restrict__ out, int G, int c) {
    const int tid = threadIdx.x, lane = tid & 63, wave = tid >> 6; const int gw = c * 8 + wave, NGW = G * 8;
    f32x4 gv[4];
#pragma unroll
    for (int j = 0; j < 4; ++j) gv[j] = *(const f32x4*)(fg + 4 * lane + 256 * j);
    for (int m = gw; m < S; m += NGW) {
        const float* xr = X1 + (size_t)m * D + 4 * lane;
        f32x4 v[4];
#pragma unroll
        for (int j = 0; j < 4; ++j) v[j] = *(const f32x4*)(xr + 256 * j);
#pragma unroll
        for (int k = 0; k < 4; ++k) { const bf16_t* yr = Y + ((size_t)m * 4 + k) * D + 4 * lane;
#pragma unroll
            for (int j = 0; j < 4; ++j) { const u32x2 t = *(const u32x2*)(yr + 256 * j); v[j][0] += bf_lo(t.x); v[j][1] += bf_hi(t.x); v[j][2] += bf_lo(t.y); v[j][3] += bf_hi(t.y); } }
        float s = 0.f;
#pragma unroll
        for (int j = 0; j < 4; ++j) s += (v[j][0] * v[j][0] + v[j][1] * v[j][1]) + (v[j][2] * v[j][2] + v[j][3] * v[j][3]);
        const float rstd = rsqrtf(wave_sum(s) * (1.0f / D) + RMS_EPS);
#pragma unroll
        for (int j = 0; j < 4; ++j) *(f32x4*)(out + (size_t)m * D + 4 * lane + 256 * j) = v[j] * rstd * gv[j];
    }
}

constexpr int NPHASE = 9;
struct Args { In in; float* out; unsigned char* ws; int ph_lo, ph_hi; };
__global__ void __launch_bounds__(512, 2) fwd(Args args) {
    extern __shared__ __attribute__((aligned(16))) unsigned char lds_raw[];
    LAS unsigned char* lds = (LAS unsigned char*)lds_raw;
    const int tid = threadIdx.x, G = gridDim.x, c = blockIdx.x;
    unsigned char* ws = args.ws; const In& in = args.in;
    unsigned* ctl = (unsigned*)(ws + WS_CTL);
    LAS int* LCTL = (LAS int*)(lds + LDS_CTL);
    if (tid < 256) LCTL[tid] = 0;
    __syncthreads();
    const int lo = args.ph_lo, hi = args.ph_hi;
    const bool one_launch = (hi - lo) > 1;
    XcdBarrier bar; bar.bar = ctl + CW_BAR; bar.x = 0; bar.st = nullptr;
    if (one_launch) bar = xcd_barrier_post(ctl + CW_BAR, (volatile LAS unsigned*)LCTL);
#define IN(k) (lo <= (k) && (k) < hi)
#ifndef MK_DOUBLE
#define MK_DOUBLE 0
#endif
#define REP(k) for (int rep_ = 0; rep_ < ((((MK_DOUBLE) >> (k)) & 1) ? 2 : 1); ++rep_)
#define SEAM(k) do { if (IN((k) + 1)) xcd_barrier(bar); } while (0)
    bf16_t* Hb = (bf16_t*)(ws + WS_H); bf16_t* Ub = (bf16_t*)(ws + WS_U); bf16_t* Qb = (bf16_t*)(ws + WS_Q); bf16_t* Kb = (bf16_t*)(ws + WS_K); bf16_t* Vb = (bf16_t*)(ws + WS_V);
    bf16_t* OPb = (bf16_t*)(ws + WS_OP); bf16_t* MIXb = (bf16_t*)(ws + WS_MIX); float* X1 = (float*)(ws + WS_X1); unsigned char* ACTb = ws + WS_ACT; bf16_t* Yb = (bf16_t*)(ws + WS_Y); unsigned char* H8 = ws + WS_H8;
    float* LSE = (float*)(ws + WS_LSE); float* RSTD = (float*)(ws + WS_RSTD); float* GATES = (float*)(ws + WS_GATES); int* ROWS = (int*)(ws + WS_ROWS); unsigned* COUNTS = ctl + CW_COUNTS;
    LAS int* TPRE = LCTL + 16; LAS int* LCNT = LCTL + 128; LAS int* TAB = (LAS int*)(lds + LDS_TAB); LAS float* TABF = (LAS float*)(lds + LDS_TAB + MAXU * 1024); LAS float* TABB = (LAS float*)(lds + LDS_TAB + 2 * MAXU * 1024);
    static_assert(LDS_TAB + 3 * MAXU * 1024 <= LDS_CTL, "MoE LDS tables");

    if (IN(0)) { REP(0) p0_prologue(lds, in, ws, G, c); SEAM(0); }
    if (IN(1)) {
        pg8::DenseProb P{(const char*)Hb, (const char*)(ws + WS_WIN), D * 2, S / 256, NPROJ / 256, G, c, (size_t)128 * D * 2};
        EpiQKVU E{ws};
        REP(1) pg8::gemm_phase<EpiQKVU, pg8::DenseProb, true, false>(lds, P, E);
        SEAM(1);
    }
    if (IN(2)) {
        REP(2) attn_phase(lds, Qb, Kb, Vb, (const float*)(ws + WS_BT), OPb, LSE, G, c);
        REP(9) pool_phase(lds, Ub, (const bf16_t*)(ws + WS_PWT), in.pool_scale, MIXb, G, c);
        SEAM(2);
    }
    if (IN(3)) { REP(3) combine_phase(OPb, LSE, MIXb, G, c); SEAM(3); }
    if (IN(4)) {
        pg8::DenseProb P{(const char*)MIXb, (const char*)(ws + WS_WOUT), D * 2, S / 256, D / 256, G, c, (size_t)128 * D * 2};
        EpiResF32 E{in.x, X1};
        REP(4) pg8::gemm_phase<EpiResF32, pg8::DenseProb, true, false>(lds, P, E);
        SEAM(4);
    }
    if (IN(5)) { router_phase(lds, X1, in.norm2_g, (const float*)(ws + WS_GWT), in.router_b, H8, RSTD, GATES, ROWS, COUNTS, G, c); SEAM(5); }
    if (IN(6)) {
        moe_prefix(TPRE, LCNT, COUNTS);
        pg8::MoeProb<true> P{(const char*)H8, (const char*)(ws + WS_WGU), D, 8, G, c, (size_t)DFF * D, (size_t)2 * DFF * D, 128, TPRE, TAB};
        moe_table<true>(P, TAB, TABF, TABB, LCNT, ROWS, RSTD, in.b_gate_up);
        EpiGateUp E{ACTb, TPRE, TABF, TABB};
        REP(6) pg8::gemm_phase<EpiGateUp, pg8::MoeProb<true>, true, true>(lds, P, E);
        SEAM(6);
    }
    if (IN(7)) {
        moe_prefix(TPRE, LCNT, COUNTS);
        pg8::MoeProb<false> P{(const char*)ACTb, (const char*)(ws + WS_WD), DFF, 4, G, c, (size_t)128 * DFF, (size_t)D * DFF, 256, TPRE, TAB};
        moe_table<false>(P, TAB, TABF, TABB, LCNT, ROWS, GATES, in.b_down);
        EpiDown E{Yb, TAB, TABF, TABB};
        REP(7) pg8::gemm_phase<EpiDown, pg8::MoeProb<false>, true, true>(lds, P, E);
        SEAM(7);
    }
    if (IN(8)) REP(8) final_phase(X1, Yb, in.final_g, args.out, G, c);
#undef IN
#undef SEAM
}

#ifndef MK_N_LAUNCHES
#define MK_N_LAUNCHES 1
#endif
#ifndef MK_SEQ
#define MK_SEQ "012345678"
#endif
extern "C" void kernel_launch(void* const* d_in, const int* in_sizes, int n_in, void* d_out, int out_size, void* d_ws, size_t ws_size, hipStream_t stream) {
    static int grid = 0;
    if (grid == 0) {
        if (n_in != 15 || out_size != S * D || ws_size < WS_END) { fprintf(stderr, "kernel_launch: unexpected problem (n_in %d out %d ws %zu)\n", n_in, out_size, ws_size); grid = -1; return; }
        int dev = 0, cus = 0, per_cu = 0;
        if (hipGetDevice(&dev) != hipSuccess || hipDeviceGetAttribute(&cus, hipDeviceAttributeMultiprocessorCount, dev) != hipSuccess) { grid = -1; return; }
        if (hipFuncSetAttribute((const void*)fwd, hipFuncAttributeMaxDynamicSharedMemorySize, LDS_BYTES) != hipSuccess) { fprintf(stderr, "kernel_launch: hipFuncSetAttribute failed\n"); grid = -1; return; }
        if (hipOccupancyMaxActiveBlocksPerMultiprocessor(&per_cu, (const void*)fwd, 512, LDS_BYTES) != hipSuccess || per_cu < 1) { fprintf(stderr, "kernel_launch: occupancy query says %d blocks per CU\n", per_cu); (void)hipGetLastError(); per_cu = 1; }
        grid = cus;
    }
    if (grid < 0) return;
    if (hipMemsetAsync((char*)d_ws + WS_CTL, 0, CTL_ZERO_BYTES, stream) != hipSuccess) { fprintf(stderr, "kernel_launch: memset failed\n"); return; }
    Args a{};
    a.in.x = (const float*)d_in[0]; a.in.norm1_g = (const float*)d_in[1]; a.in.w_in = (const float*)d_in[2]; a.in.pool_w = (const float*)d_in[3]; a.in.pool_scale = (const float*)d_in[4];
    a.in.rel_bias = (const float*)d_in[5]; a.in.w_out = (const float*)d_in[6]; a.in.norm2_g = (const float*)d_in[7]; a.in.router_w = (const float*)d_in[8]; a.in.router_b = (const float*)d_in[9];
    a.in.w_gate_up = (const float*)d_in[10]; a.in.b_gate_up = (const float*)d_in[11]; a.in.w_down = (const float*)d_in[12]; a.in.b_down = (const float*)d_in[13]; a.in.final_g = (const float*)d_in[14];
    a.out = (float*)d_out; a.ws = (unsigned char*)d_ws;
    if (MK_N_LAUNCHES == 1) { a.ph_lo = 0; a.ph_hi = NPHASE; hipLaunchKernelGGL(fwd, dim3(grid), dim3(512), LDS_BYTES, stream, a); }
    else { const char* seq = MK_SEQ; for (int i = 0; seq[i]; ++i) { const int p = seq[i] - '0'; a.ph_lo = p; a.ph_hi = p + 1; if (p == 5) (void)hipMemsetAsync((char*)d_ws + WS_CTL + CW_COUNTS * 4, 0, 128, stream); hipLaunchKernelGGL(fwd, dim3(grid), dim3(512), LDS_BYTES, stream, a); } }
    const hipError_t le = hipPeekAtLastError();
    if (le != hipSuccess) fprintf(stderr, "kernel_launch: launch failed: %s\n", hipGetErrorName(le));
}
```

```cpp
#include <hip/hip_runtime.h>
#include <cstdio>
#include <cstdint>

#define LAS __attribute__((address_space(3)))
#define GAS __attribute__((address_space(1)))
typedef unsigned short bf16_t;
typedef short bf16x8 __attribute__((ext_vector_type(8)));
typedef short s16x4 __attribute__((ext_vector_type(4)));
typedef float f32x4 __attribute__((ext_vector_type(4)));
typedef float f32x2 __attribute__((ext_vector_type(2)));
typedef unsigned u32x4 __attribute__((ext_vector_type(4)));
typedef unsigned u32x2 __attribute__((ext_vector_type(2)));
typedef int i32x4 __attribute__((ext_vector_type(4)));
typedef int i32x8 __attribute__((ext_vector_type(8)));

constexpr int S = 16384, D = 1024, NPROJ = 2560, PW = 256, AW = 768, NH = 12, HD = 64, NE = 32, TOPK = 4, DFF = 1024;
constexpr float RMS_EPS = 1e-5f, LOG2E = 1.4426950408889634f, QSCALE = 0.125f * LOG2E, NEGBIG = -1e30f;
constexpr float WSCALE = 64.0f, HSCALE = 16.0f, ASCALE = 8.0f, YSCALE = 64.0f, FP8MAX = 448.0f;
constexpr int BT_N = 400, BT_OFF = 144;

constexpr size_t MiB = 1u << 20;
constexpr size_t WS_CTL = 0, CTL_ZERO_BYTES = 64 * 1024;
constexpr size_t WS_WIN = 2 * MiB;
constexpr size_t WS_WOUT = 8 * MiB;
constexpr size_t WS_GWT = 10 * MiB;
constexpr size_t WS_BT = 10 * MiB + 512 * 1024;
constexpr size_t WS_PWT = 10 * MiB + 768 * 1024;
constexpr size_t WS_RSTD = 11 * MiB;
constexpr size_t WS_GATES = 11 * MiB + 256 * 1024;
constexpr size_t WS_ROWS = 12 * MiB;
constexpr size_t WS_LSE = 14 * MiB;
constexpr size_t WS_WGU = 32 * MiB;
constexpr size_t WS_WD = 160 * MiB;
constexpr size_t WS_H8 = 200 * MiB;
constexpr size_t WS_H = 224 * MiB;
constexpr size_t WS_U = 256 * MiB;
constexpr size_t WS_Q = 264 * MiB, WS_K = 288 * MiB, WS_V = 312 * MiB;
constexpr size_t WS_OP = 336 * MiB;
constexpr size_t WS_MIX = 408 * MiB;
constexpr size_t WS_X1 = 440 * MiB;
constexpr size_t WS_ACT = 512 * MiB;
constexpr size_t WS_Y = 656 * MiB;
constexpr size_t WS_END = 784 * MiB;
constexpr int ACT_ROWS = 65536 + 32 * 256;
constexpr int CW_COUNTS = 64;
constexpr int CW_BAR = 4096;

constexpr int LDS_BYTES = 163840;
constexpr int LDS_TAB = 131072;
constexpr int LDS_CTL = LDS_BYTES - 1024;
constexpr int MAXU = 9;

typedef __bf16 bf16x2_t __attribute__((ext_vector_type(2)));
__device__ __forceinline__ unsigned cvt_pk_bf16(float lo, float hi) { const f32x2 v = {lo, hi}; const bf16x2_t b = __builtin_convertvector(v, bf16x2_t); return __builtin_bit_cast(unsigned, b); }
__device__ __forceinline__ float clamp8(float v) { return __builtin_amdgcn_fmed3f(v, -FP8MAX, FP8MAX); }
__device__ __forceinline__ unsigned cvt4_fp8(float a, float b, float c, float d) {
    int p = __builtin_amdgcn_cvt_pk_fp8_f32(clamp8(a), clamp8(b), 0, false); p = __builtin_amdgcn_cvt_pk_fp8_f32(clamp8(c), clamp8(d), p, true); return (unsigned)p; }
__device__ __forceinline__ float bf_lo(unsigned w) { return __uint_as_float(w << 16); }
__device__ __forceinline__ float bf_hi(unsigned w) { return __uint_as_float(w & 0xffff0000u); }
__device__ __forceinline__ float wave_sum(float v) {
#pragma unroll
    for (int o = 1; o < 64; o <<= 1) v += __shfl_xor(v, o);
    return v;
}
#define LDS_WAIT() asm volatile("s_waitcnt lgkmcnt(0)" ::: "memory")
#define VM_WAIT() asm volatile("s_waitcnt vmcnt(0)" ::: "memory")

#define XB_TMO      128
#define XB_XCNT(j)  (256  + 64 * (j))
#define XB_XSUB(j)  (1280 + 64 * (j))
#define XB_XGEN(j)  (2304 + 64 * (j))
#define XB_TOP      3328
#define XB_TOPGEN   3392
#define XCD_BAR_WORDS 3456
#define XB_SPIN_CAP (1u << 18)
__device__ __forceinline__ unsigned xb_ld(unsigned* p)              { return __hip_atomic_load(p, __ATOMIC_RELAXED, __HIP_MEMORY_SCOPE_AGENT); }
__device__ __forceinline__ unsigned xb_add(unsigned* p, unsigned v) { return __hip_atomic_fetch_add(p, v, __ATOMIC_RELAXED, __HIP_MEMORY_SCOPE_AGENT); }
__device__ __forceinline__ unsigned xb_xcc_id() { return (unsigned)__builtin_amdgcn_s_getreg((3 << 11) | 20) & 0xFu; }
#define XB_SPIN(cond, bar) do { unsigned _sp = 0; while (cond) { __builtin_amdgcn_s_sleep(1); \
    if ((++_sp & 255u) == 0u) { if (xb_ld(&(bar)[XB_TMO])) break; if (_sp > XB_SPIN_CAP) { atomicAdd(&(bar)[XB_TMO], 1u); break; } } } } while (0)
struct XcdBarrier { unsigned* bar; unsigned x; volatile LAS unsigned* st; };
__device__ __forceinline__ XcdBarrier xcd_barrier_post(unsigned* bar, volatile LAS unsigned* st) {
    XcdBarrier b; b.bar = bar; b.x = xb_xcc_id(); b.st = st;
    if (threadIdx.x == 0) (void)xb_add(&bar[XB_XCNT(b.x)], 1u);
    return b;
}
__device__ __forceinline__ void xcd_barrier_complete(unsigned* bar, unsigned x, unsigned& nloc, unsigned& nx) {
    const unsigned G = gridDim.x * gridDim.y * gridDim.z;
    unsigned sum, cnt, mine, sp = 0u;
    for (;;) {
        sum = 0u; cnt = 0u; mine = 0u;
#pragma unroll
        for (unsigned j = 0; j < 16; ++j) { const unsigned c = xb_ld(&bar[XB_XCNT(j)]); sum += c; cnt += (c > 0u) ? 1u : 0u; mine = (j == x) ? c : mine; }
        if (sum == G) break;
        __builtin_amdgcn_s_sleep(1);
        if ((++sp & 255u) == 0u) { if (xb_ld(&bar[XB_TMO])) break; if (sp > XB_SPIN_CAP) { atomicAdd(&bar[XB_TMO], 1u); break; } }
    }
    nloc = mine > 0u ? mine : 1u; nx = cnt > 0u ? cnt : 1u;
}
__device__ __forceinline__ void xcd_barrier(const XcdBarrier& b) {
    asm volatile("s_waitcnt vmcnt(0)" ::: "memory");
    __syncthreads();
    if (threadIdx.x == 0) {
        unsigned* bar = b.bar;
        __builtin_amdgcn_s_waitcnt(0);
        unsigned nloc = b.st[0], nx = b.st[1];
        if (nloc == 0u) { xcd_barrier_complete(bar, b.x, nloc, nx); b.st[0] = nloc; b.st[1] = nx; }
        const unsigned old = xb_add(&bar[XB_XSUB(b.x)], 1u);
        const unsigned gen = old / nloc;
        if (old + 1u == (gen + 1u) * nloc) {
            __builtin_amdgcn_fence(__ATOMIC_RELEASE, "agent");
            asm volatile("s_waitcnt vmcnt(0)" ::: "memory");
            const unsigned og = xb_add(&bar[XB_TOP], 1u);
            const unsigned tg = og / nx;
            if (og + 1u == (tg + 1u) * nx) xb_add(&bar[XB_TOPGEN], 1u);
            else XB_SPIN(xb_ld(&bar[XB_TOPGEN]) == tg, bar);
            __builtin_amdgcn_fence(__ATOMIC_ACQUIRE, "agent");
            xb_add(&bar[XB_XGEN(b.x)], 1u);
            asm volatile("s_waitcnt vmcnt(0)" ::: "memory");
        } else {
            XB_SPIN(xb_ld(&bar[XB_XGEN(b.x)]) == gen, bar);
            __builtin_amdgcn_fence(__ATOMIC_ACQUIRE, "agent");
            asm volatile("s_waitcnt vmcnt(0)" ::: "memory");
        }
    }
    __syncthreads();
}

namespace pg8 {
constexpr int BM = 256, BK = 64, HALF = 128, HTB = HALF * BK * 2, STAGE_BYTES = 8 * HTB, NXCD = 8, WGM = 8;
__host__ __device__ __forceinline__ int lds_byte(int r, int c) { const int st = (r >> 4) * 2 + (c >> 5), rr = r & 15, cc = c & 31, ob = rr * 64 + cc * 2; return st * 1024 + (ob ^ (((ob >> 9) & 1) << 5)); }
__host__ __device__ __forceinline__ void stage_rc(int b, int& R, int& C) { const int st = b / 1024, sb = b % 1024, swz = sb ^ (((sb >> 9) & 1) << 5); R = (st >> 1) * 16 + swz / 64; C = (st & 1) * 32 + (swz % 64) / 2; }
__host__ __device__ __forceinline__ int perm32(int rho) { const int n = rho >> 4, i = rho & 15; return 8 * (i >> 2) + 4 * n + (i & 3); }

struct Unit { int pm, pn, e, slot; };

template <class Epi, class Prob, bool ALIGN_EPI, bool FP8>
__device__ __forceinline__ void gemm_phase(LAS unsigned char* lds, const Prob& P, const Epi& E) {
    const int tid = threadIdx.x, wid = __builtin_amdgcn_readfirstlane(tid >> 6), lane = tid & 63, wr = wid >> 2, wc = wid & 3, fr = lane & 15, fq = lane >> 4;
    const int rowb = P.rowb, nt = rowb / 128;
    int Rs[2], Cs[2]; unsigned voffB[2];
#pragma unroll
    for (int i = 0; i < 2; ++i) { int R, C; stage_rc(tid * 16 + i * 8192, R, C); const int Rb = Epi::PERM ? ((R & ~31) + perm32(R & 31)) : R;
        Rs[i] = R; Cs[i] = C * 2; voffB[i] = (unsigned)(Rb * rowb + C * 2); }
    const size_t kstep = (size_t)(BK * 2);
    const size_t bhalf = P.b_half;
    const unsigned ldsw = (unsigned)wid * 1024u;
    const int aoff = lds_byte(wr * 64 + fr, fq * 8), boff = lds_byte(wc * 32 + fr, fq * 8);
#define PG8_SA(b, h) (((b) * 2 + (h)) * HTB)
#define PG8_SB(b, h) ((4 + (b) * 2 + (h)) * HTB)
#define PG8_STAGE_B(bufoff, gbase) do { _Pragma("unroll") for (int _i = 0; _i < 2; ++_i) \
        __builtin_amdgcn_global_load_lds((const unsigned*)((const char*)(gbase) + voffB[_i]), (LAS unsigned*)(lds + (bufoff) + ldsw + _i * 8192), 16, 0, 0); } while (0)
#define PG8_STAGE_A(bufoff, kb, o0, o1) do { \
        __builtin_amdgcn_global_load_lds((const unsigned*)(P.A + (size_t)(o0) + (kb)), (LAS unsigned*)(lds + (bufoff) + ldsw), 16, 0, 0); \
        __builtin_amdgcn_global_load_lds((const unsigned*)(P.A + (size_t)(o1) + (kb)), (LAS unsigned*)(lds + (bufoff) + ldsw + 8192), 16, 0, 0); } while (0)
#define PG8_LDA(dst, b, h) do { _Pragma("unroll") for (int m = 0; m < 4; ++m) _Pragma("unroll") for (int k = 0; k < 2; ++k) dst[m][k] = *(const LAS bf16x8*)(lds + PG8_SA(b, h) + aoff + m * 2048 + k * 1024); } while (0)
#define PG8_LDB(dst, b, h) do { _Pragma("unroll") for (int n = 0; n < 2; ++n) _Pragma("unroll") for (int k = 0; k < 2; ++k) dst[n][k] = *(const LAS bf16x8*)(lds + PG8_SB(b, h) + boff + n * 2048 + k * 1024); } while (0)
#define PG8_MMA(ai, bj, At, Bt) do { __builtin_amdgcn_s_setprio(1); _Pragma("unroll") for (int m = 0; m < 4; ++m) _Pragma("unroll") for (int n = 0; n < 2; ++n) { \
        if constexpr (FP8) { const i32x8 fb_ = __builtin_shufflevector(__builtin_bit_cast(i32x4, Bt[n][0]), __builtin_bit_cast(i32x4, Bt[n][1]), 0, 1, 2, 3, 4, 5, 6, 7); \
            const i32x8 fa_ = __builtin_shufflevector(__builtin_bit_cast(i32x4, At[m][0]), __builtin_bit_cast(i32x4, At[m][1]), 0, 1, 2, 3, 4, 5, 6, 7); \
            acc[ai][bj][m][n] = __builtin_amdgcn_mfma_scale_f32_16x16x128_f8f6f4(fb_, fa_, acc[ai][bj][m][n], 0, 0, 0, 0, 0, 0); } \
        else { _Pragma("unroll") for (int k = 0; k < 2; ++k) acc[ai][bj][m][n] = __builtin_amdgcn_mfma_f32_16x16x32_bf16(Bt[n][k], At[m][k], acc[ai][bj][m][n], 0, 0, 0); } } \
        __builtin_amdgcn_s_setprio(0); } while (0)
#define PG8_WAIT_V(n) asm volatile("s_waitcnt vmcnt(" #n ")" ::: "memory")
#define PG8_WAIT_L(n) asm volatile("s_waitcnt lgkmcnt(" #n ")" ::: "memory")
#define PG8_BAR __builtin_amdgcn_s_barrier()
#define PG8_SCHED __builtin_amdgcn_sched_barrier(0)
    Unit cur, nxt; int ui = 0;
    if (!P.next(0, cur)) return;
    f32x4 acc[2][2][4][2];
#pragma unroll
    for (int a = 0; a < 2; ++a)
#pragma unroll
        for (int b = 0; b < 2; ++b)
#pragma unroll
            for (int m = 0; m < 4; ++m)
#pragma unroll
                for (int n = 0; n < 2; ++n) acc[a][b][m][n] = (f32x4){0.f, 0.f, 0.f, 0.f};
    bf16x8 At[4][2], B0[2][2], B1[2][2];
    unsigned c00 = P.a_off(cur, Rs[0], Cs[0]), c01 = P.a_off(cur, Rs[1], Cs[1]), c10 = P.a_off(cur, HALF + Rs[0], Cs[0]), c11 = P.a_off(cur, HALF + Rs[1], Cs[1]);
    const char* cB = P.b_base(cur);
    PG8_STAGE_B(PG8_SB(0, 0), cB); PG8_STAGE_B(PG8_SB(0, 1), cB + bhalf); PG8_STAGE_A(PG8_SA(0, 0), 0, c00, c01); PG8_STAGE_A(PG8_SA(0, 1), 0, c10, c11);
    if (wr == 1) PG8_BAR;
    PG8_WAIT_V(2); PG8_BAR;
    PG8_STAGE_B(PG8_SB(1, 0), cB + kstep); PG8_STAGE_A(PG8_SA(1, 0), kstep, c00, c01); PG8_STAGE_B(PG8_SB(1, 1), cB + bhalf + kstep);
    PG8_WAIT_V(6); PG8_BAR;
    for (;;) {
        const bool has_next = P.next(ui + 1, nxt);
        const char* nB = has_next ? P.b_base(nxt) : cB;
        for (int t = 0; t < nt; t += 2) {
            const bool last = (t == nt - 2);
            const size_t k1 = (size_t)(t + 1) * kstep;
            const size_t k2 = last ? 0 : (size_t)(t + 2) * kstep, k3 = k2 + kstep;
            const char* b2 = last ? nB : cB + (size_t)(t + 2) * kstep; const char* b3 = b2 + kstep;
            if (last && has_next) { c00 = P.a_off(nxt, Rs[0], Cs[0]); c01 = P.a_off(nxt, Rs[1], Cs[1]); }
            PG8_LDB(B0, 0, 0); PG8_LDB(B1, 0, 1); PG8_SCHED; PG8_LDA(At, 0, 0); PG8_STAGE_A(PG8_SA(1, 1), k1, c10, c11);
            PG8_WAIT_V(8); PG8_WAIT_L(0); PG8_BAR; PG8_MMA(0, 0, At, B0); PG8_MMA(0, 1, At, B1); PG8_BAR; PG8_SCHED;
            if (last && has_next) { c10 = P.a_off(nxt, HALF + Rs[0], Cs[0]); c11 = P.a_off(nxt, HALF + Rs[1], Cs[1]); }
            PG8_LDA(At, 0, 1); PG8_STAGE_B(PG8_SB(0, 0), b2); PG8_STAGE_B(PG8_SB(0, 1), b2 + bhalf); PG8_STAGE_A(PG8_SA(0, 0), k2, c00, c01);
            PG8_WAIT_V(8); PG8_WAIT_L(0); PG8_BAR; PG8_MMA(1, 0, At, B0); PG8_MMA(1, 1, At, B1); PG8_BAR; PG8_SCHED;
            PG8_LDB(B0, 1, 0); PG8_LDB(B1, 1, 1); PG8_SCHED; PG8_LDA(At, 1, 0); PG8_STAGE_A(PG8_SA(0, 1), k2, c10, c11);
            PG8_WAIT_V(8); PG8_WAIT_L(0); PG8_BAR; PG8_MMA(0, 0, At, B0); PG8_MMA(0, 1, At, B1); PG8_BAR; PG8_SCHED;
            PG8_LDA(At, 1, 1); PG8_STAGE_B(PG8_SB(1, 0), b3); PG8_STAGE_B(PG8_SB(1, 1), b3 + bhalf); PG8_STAGE_A(PG8_SA(1, 0), k3, c00, c01);
            PG8_WAIT_V(8); PG8_WAIT_L(0); PG8_BAR; PG8_MMA(1, 0, At, B0); PG8_MMA(1, 1, At, B1); PG8_BAR; PG8_SCHED;
        }
        if constexpr (ALIGN_EPI) { if (wr == 0) PG8_BAR; }
        E(acc, cur, wr, wc, fr, fq);
#if defined(MK_DOUBLE)
        if constexpr (FP8) { if ((MK_DOUBLE >> 12) & 1) { asm volatile("" ::: "memory"); E(acc, cur, wr, wc, fr, fq); } }
#endif
        if (!has_next) break;
#pragma unroll
        for (int a = 0; a < 2; ++a)
#pragma unroll
            for (int b = 0; b < 2; ++b)
#pragma unroll
                for (int m = 0; m < 4; ++m)
#pragma unroll
                    for (int n = 0; n < 2; ++n) acc[a][b][m][n] = (f32x4){0.f, 0.f, 0.f, 0.f};
        cur = nxt; cB = nB; ++ui;
        if constexpr (ALIGN_EPI) { if (wr == 1) PG8_BAR; }
    }
    PG8_WAIT_V(0);
    if constexpr (!ALIGN_EPI) { if (wr == 0) PG8_BAR; }
    PG8_BAR;
#undef PG8_SA
#undef PG8_SB
#undef PG8_STAGE_A
#undef PG8_STAGE_B
#undef PG8_LDA
#undef PG8_LDB
#undef PG8_MMA
#undef PG8_WAIT_V
#undef PG8_WAIT_L
#undef PG8_BAR
#undef PG8_SCHED
}

__device__ __forceinline__ bool static_order(int nM, int nN, int G, int c, int i, int& pm, int& pn) {
    const int nwg = nM * nN; const long L = (long)i * G + c; if (L >= nwg) return false;
    int wgid = (int)L; { const int q = nwg / NXCD, r = nwg % NXCD, xcd = wgid % NXCD, off = wgid / NXCD; wgid = (xcd < r ? xcd * (q + 1) : r * (q + 1) + (xcd - r) * q) + off; }
    const int nig = WGM * nN, gid = wgid / nig, fm = gid * WGM, gsz = (nM - fm) < WGM ? (nM - fm) : WGM;
    pm = fm + ((wgid % nig) % gsz); pn = (wgid % nig) / gsz; return true;
}
struct DenseProb {
    const char* A; const char* Bt; int rowb, nM, nN, G, c; size_t b_half;
    __device__ __forceinline__ bool next(int i, Unit& u) const { u.e = 0; u.slot = i; return static_order(nM, nN, G, c, i, u.pm, u.pn); }
    __device__ __forceinline__ unsigned a_off(const Unit& u, int row, int colb) const { return (unsigned)((u.pm * BM + row) * rowb + colb); }
    __device__ __forceinline__ const char* b_base(const Unit& u) const { return Bt + (size_t)u.pn * BM * rowb; }
};
template <bool GATHER> struct MoeProb {
    const char* A; const char* Bt; int rowb, nN, G, c; size_t b_half; size_t b_expert; int b_tile_rows;
    const LAS int* tpre; const LAS int* tab;
    __device__ __forceinline__ int tp(int j) const { return __builtin_amdgcn_readfirstlane(tpre[j]); }
    __device__ __forceinline__ bool next(int i, Unit& u) const {
        const int total = tp(NE) * nN; const long L0 = (long)i * G + c; if (L0 >= total) return false;
        int L = (int)L0; { const int q = total / NXCD, r = total % NXCD, xcd = L % NXCD, off = L / NXCD; L = (xcd < r ? xcd * (q + 1) : r * (q + 1) + (xcd - r) * q) + off; }
        int e = 0;
#pragma unroll 1
        for (int j = 1; j < NE; ++j) e += (tp(j) * nN <= L) ? 1 : 0;
        const int first = tp(e) * nN, tiles = tp(e + 1) - tp(e), rem = L - first;
        u.e = e; u.pm = rem % tiles; u.pn = rem / tiles; u.slot = i; return true;
    }
    __device__ __forceinline__ unsigned a_off(const Unit& u, int row, int colb) const {
        if (GATHER) { const int idx = tab[u.slot * 256 + row]; const int tok = idx < 0 ? 0 : (idx >> 2); return (unsigned)(tok * rowb + colb); }
        return (unsigned)(((tp(u.e) + u.pm) * BM + row) * rowb + colb);
    }
    __device__ __forceinline__ const char* b_base(const Unit& u) const { return Bt + (size_t)u.e * b_expert + (size_t)u.pn * b_tile_rows * rowb; }
};
}

using pg8::Unit;
typedef f32x4 AccT[2][2][4][2];

struct EpiQKVU {
    static constexpr bool PERM = true;
    unsigned char* ws;
    __device__ __forceinline__ void operator()(const AccT& acc, const Unit& u, int wr, int wc, int fr, int fq) const {
        static_assert(WS_K - WS_Q == WS_V - WS_K, "Q, K, V equally spaced");
        const int t = (u.pn - 1) / 3;
        const size_t boff = (u.pn == 0) ? WS_U : (WS_Q + (size_t)t * (WS_K - WS_Q));
        bf16_t* base = (bf16_t*)(ws + boff);
        const int ldc = (u.pn == 0) ? PW : AW, colt = (u.pn == 0) ? 0 : ((u.pn - 1) % 3) * 256;
        const float sc = (u.pn >= 1 && u.pn <= 3) ? QSCALE : 1.f;
        const int row0 = u.pm * 256 + wr * 64 + fr, col0 = colt + wc * 32 + 8 * fq;
#pragma unroll
        for (int ai = 0; ai < 2; ++ai)
#pragma unroll
            for (int m = 0; m < 4; ++m) { bf16_t* rowp = base + (size_t)(row0 + ai * 128 + m * 16) * ldc + col0;
#pragma unroll
                for (int bj = 0; bj < 2; ++bj) { const f32x4 v0 = acc[ai][bj][m][0] * sc, v1 = acc[ai][bj][m][1] * sc;
                    u32x4 w; w.x = cvt_pk_bf16(v0[0], v0[1]); w.y = cvt_pk_bf16(v0[2], v0[3]); w.z = cvt_pk_bf16(v1[0], v1[1]); w.w = cvt_pk_bf16(v1[2], v1[3]);
                    *(u32x4*)(rowp + bj * 128) = w; } }
    }
};
struct EpiResF32 {
    static constexpr bool PERM = false;
    const float* X; float* O;
    __device__ __forceinline__ void operator()(const AccT& acc, const Unit& u, int wr, int wc, int fr, int fq) const {
        const int row0 = u.pm * 256 + wr * 64 + fr, col0 = u.pn * 256 + wc * 32 + 4 * fq;
#pragma unroll
        for (int ai = 0; ai < 2; ++ai)
#pragma unroll
            for (int m = 0; m < 4; ++m) { const size_t off = (size_t)(row0 + ai * 128 + m * 16) * D + col0;
#pragma unroll
                for (int bj = 0; bj < 2; ++bj)
#pragma unroll
                    for (int n = 0; n < 2; ++n) { const f32x4 r = __builtin_nontemporal_load((const f32x4*)(X + off + bj * 128 + n * 16)); *(f32x4*)(O + off + bj * 128 + n * 16) = acc[ai][bj][m][n] + r; } }
    }
};
__device__ __forceinline__ float swiglu1(float g, float u) {
    g = fminf(g, 7.0f); u = fminf(fmaxf(u, -7.0f), 7.0f);
    const float s = __builtin_amdgcn_rcpf(1.0f + __builtin_amdgcn_exp2f(g * (-1.702f * LOG2E)));
    return (u + 1.0f) * (g * s);
}
struct EpiGateUp {
    static constexpr bool PERM = true;
    unsigned char* ACT; const LAS int* tpre; const LAS float* tabf; const LAS float* tabb;
    __device__ __forceinline__ void operator()(const AccT& acc, const Unit& u, int wr, int wc, int fr, int fq) const {
        const int cl = wc * 32 + 8 * fq, colA = u.pn * 128 + cl;
        const LAS float* bp = tabb + u.slot * 256 + cl;
        const f32x4 bg0 = *(const LAS f32x4*)(bp), bg1 = *(const LAS f32x4*)(bp + 4), bu0 = *(const LAS f32x4*)(bp + 128), bu1 = *(const LAS f32x4*)(bp + 132);
        const int srow0 = (__builtin_amdgcn_readfirstlane(tpre[u.e]) + u.pm) * 256;
#pragma unroll
        for (int ai = 0; ai < 2; ++ai)
#pragma unroll
            for (int m = 0; m < 4; ++m) { const int r = ai * 128 + wr * 64 + m * 16 + fr; const float rs = tabf[u.slot * 256 + r];
                const f32x4 g0 = acc[ai][0][m][0] * rs + bg0, g1 = acc[ai][0][m][1] * rs + bg1, u0 = acc[ai][1][m][0] * rs + bu0, u1 = acc[ai][1][m][1] * rs + bu1;
                u32x2 w; w.x = cvt4_fp8(swiglu1(g0[0], u0[0]) * ASCALE, swiglu1(g0[1], u0[1]) * ASCALE, swiglu1(g0[2], u0[2]) * ASCALE, swiglu1(g0[3], u0[3]) * ASCALE);
                w.y = cvt4_fp8(swiglu1(g1[0], u1[0]) * ASCALE, swiglu1(g1[1], u1[1]) * ASCALE, swiglu1(g1[2], u1[2]) * ASCALE, swiglu1(g1[3], u1[3]) * ASCALE);
                *(u32x2*)(ACT + (size_t)(srow0 + r) * DFF + colA) = w; }
    }
};
struct EpiDown {
    static constexpr bool PERM = true;
    unsigned char* Y; const LAS int* tab; const LAS float* tabf; const LAS float* tabb;
    __device__ __forceinline__ void operator()(const AccT& acc, const Unit& u, int wr, int wc, int fr, int fq) const {
        const int cl = wc * 32 + 8 * fq, col0 = u.pn * 256 + cl;
        const LAS float* bp = tabb + u.slot * 256 + cl;
        f32x4 bv[2][2];
#pragma unroll
        for (int bj = 0; bj < 2; ++bj) { bv[bj][0] = *(const LAS f32x4*)(bp + bj * 128); bv[bj][1] = *(const LAS f32x4*)(bp + bj * 128 + 4); }
#pragma unroll
        for (int ai = 0; ai < 2; ++ai)
#pragma unroll
            for (int m = 0; m < 4; ++m) { const int r = ai * 128 + wr * 64 + m * 16 + fr; const int idx = tab[u.slot * 256 + r];
                if (idx >= 0) { const float gv = tabf[u.slot * 256 + r] * YSCALE; unsigned char* rowp = Y + (size_t)idx * D + col0;
#pragma unroll
                    for (int bj = 0; bj < 2; ++bj) { const f32x4 v0 = (acc[ai][bj][m][0] * (1.0f / (ASCALE * WSCALE)) + bv[bj][0]) * gv, v1 = (acc[ai][bj][m][1] * (1.0f / (ASCALE * WSCALE)) + bv[bj][1]) * gv;
                        u32x2 w; w.x = cvt4_fp8(v0[0], v0[1], v0[2], v0[3]); w.y = cvt4_fp8(v1[0], v1[1], v1[2], v1[3]);
                        *(u32x2*)(rowp + bj * 128) = w; } } }
    }
};

__device__ __forceinline__ void tr_item(const float* __restrict__ W, int K, int N, bf16_t* __restrict__ WT, LAS float* scr, int kb, int nb, int lane) {
    const int k0 = kb * 64, n0 = nb * 64;
    const float* src = W + (size_t)(k0 + (lane >> 4)) * N + n0 + (lane & 15) * 4;
    f32x4 v[16];
#pragma unroll
    for (int i = 0; i < 16; ++i) v[i] = *(const f32x4*)(src + (size_t)(4 * i) * N);
#pragma unroll
    for (int i = 0; i < 16; ++i) { LAS float* d = scr + (4 * i + (lane >> 4)) * 65 + (lane & 15) * 4; d[0] = v[i][0]; d[1] = v[i][1]; d[2] = v[i][2]; d[3] = v[i][3]; }
    LDS_WAIT();
    const int c = lane & 7;
#pragma unroll
    for (int j = 0; j < 8; ++j) { const int n = 8 * j + (lane >> 3); const LAS float* s = scr + (8 * c) * 65 + n;
        u32x4 o; o.x = cvt_pk_bf16(s[0], s[65]); o.y = cvt_pk_bf16(s[130], s[195]); o.z = cvt_pk_bf16(s[260], s[325]); o.w = cvt_pk_bf16(s[390], s[455]);
        *(u32x4*)(WT + (size_t)(n0 + n) * K + k0 + 8 * c) = o; }
    LDS_WAIT();
}
struct Item8 { const float* src; unsigned char* dst; int N; };
__device__ __forceinline__ void chunk8_load(const Item8& d, int ch, f32x4 (&v)[16], int lane) {
    const float* base = d.src + (size_t)(32 * ch + 4 * (lane >> 5)) * d.N + (lane & 31) * 4;
#pragma unroll
    for (int sl = 0; sl < 4; ++sl)
#pragma unroll
        for (int j = 0; j < 4; ++j) v[4 * sl + j] = __builtin_nontemporal_load((const f32x4*)(base + (size_t)(8 * sl + j) * d.N));
}
__device__ __forceinline__ void chunk8_cvt(int ch, const f32x4 (&v)[16], LAS unsigned* scr, int lane) {
    const int nq = lane & 31, kq0 = lane >> 5, sw = (nq & 7) << 2;
#pragma unroll
    for (int sl = 0; sl < 4; ++sl) { const int kw = 8 * ch + kq0 + 2 * sl;
#pragma unroll
        for (int i = 0; i < 4; ++i) scr[(4 * nq + i) * 32 + (kw ^ sw)] = cvt4_fp8(v[4 * sl][i] * WSCALE, v[4 * sl + 1][i] * WSCALE, v[4 * sl + 2][i] * WSCALE, v[4 * sl + 3][i] * WSCALE); }
}
__device__ __forceinline__ void item8_flush(const Item8& d, const LAS unsigned* scr, int lane) {
    LDS_WAIT();
    const int c16 = lane & 7;
#pragma unroll
    for (int jj = 0; jj < 16; ++jj) { const int n = (lane >> 3) + 8 * jj;
        const u32x4 o = *(const LAS u32x4*)(scr + n * 32 + ((c16 ^ ((n >> 2) & 7)) << 2));
        __builtin_nontemporal_store(o, (u32x4*)(d.dst + (size_t)n * D + 16 * c16)); }
    LDS_WAIT();
}
__device__ __forceinline__ int t5_bucket(int dist) {
    if (dist < 16) return dist;
    const int large = 16 + (int)(logf((float)dist / 16.0f) / 4.852030263919617f * 16.0f);
    return large < 31 ? large : 31;
}
struct In { const float *x, *norm1_g, *w_in, *pool_w, *pool_scale, *rel_bias, *w_out, *norm2_g, *router_w, *router_b, *w_gate_up, *b_gate_up, *w_down, *b_down, *final_g; };

__device__ __forceinline__ void p0_prologue(LAS unsigned char* lds, const In& in, unsigned char* ws, int G, int c) {
    const int tid = threadIdx.x, lane = tid & 63, wave = __builtin_amdgcn_readfirstlane(tid >> 6);
    const int gw = c * 8 + wave, NGW = G * 8;
    LAS float* scr = (LAS float*)(lds + wave * 16640);
    constexpr int I_IN = 16 * 40, I_OUT = 16 * 16, I_GU1 = 16 * 32, I_D1 = 16 * 16;
    for (int it = gw; it < I_IN + I_OUT; it += NGW) {
        if (it < I_IN) tr_item(in.w_in, D, NPROJ, (bf16_t*)(ws + WS_WIN), scr, it / 40, it % 40, lane);
        else { const int r = it - I_IN; tr_item(in.w_out, D, D, (bf16_t*)(ws + WS_WOUT), scr, r / 16, r % 16, lane); }
    }
#ifndef MK_DOUBLE
#define MK_DOUBLE 0
#endif
    for (int rep8_ = 0; rep8_ < (((MK_DOUBLE >> 10) & 1) ? 2 : 1); ++rep8_) {
        constexpr int IG = 8 * 16, ID = 8 * 8, N8 = NE * IG + NE * ID;
        auto desc = [&](int r) -> Item8 { Item8 d;
            if (r < NE * IG) { const int e = r / IG, q = r % IG, kb = q / 16, nb = q % 16;
                d.src = in.w_gate_up + (size_t)e * D * 2 * DFF + (size_t)(kb * 128) * (2 * DFF) + nb * 128; d.N = 2 * DFF; d.dst = ws + WS_WGU + (size_t)e * 2 * DFF * D + (size_t)(nb * 128) * D + kb * 128; }
            else { const int r2 = r - NE * IG, e = r2 / ID, q = r2 % ID, kb = q / 8, nb = q % 8;
                d.src = in.w_down + (size_t)e * DFF * D + (size_t)(kb * 128) * D + nb * 128; d.N = D; d.dst = ws + WS_WD + (size_t)e * D * DFF + (size_t)(nb * 128) * DFF + kb * 128; }
            return d; };
        LAS unsigned* scr8 = (LAS unsigned*)(lds + wave * 16384);
        f32x4 va[16], vb[16];
        if (gw < N8) { const Item8 d0 = desc(gw); chunk8_load(d0, 0, va, lane); }
        for (int it = gw; it < N8; it += NGW) {
            const Item8 d = desc(it); const bool more = (it + NGW) < N8;
            chunk8_load(d, 1, vb, lane); chunk8_cvt(0, va, scr8, lane);
            chunk8_load(d, 2, va, lane); chunk8_cvt(1, vb, scr8, lane);
            chunk8_load(d, 3, vb, lane); chunk8_cvt(2, va, scr8, lane);
            if (more) { const Item8 dn = desc(it + NGW); chunk8_load(dn, 0, va, lane); }
            chunk8_cvt(3, vb, scr8, lane);
            item8_flush(d, scr8, lane);
        }
    }
    for (int repr_ = 0; repr_ < (((MK_DOUBLE >> 11) & 1) ? 2 : 1); ++repr_) {
        f32x4 gv[4];
#pragma unroll
        for (int j = 0; j < 4; ++j) gv[j] = *(const f32x4*)(in.norm1_g + 4 * lane + 256 * j);
        bf16_t* H = (bf16_t*)(ws + WS_H);
        f32x4 v[4], vn[4];
        int m = gw;
        if (m < S) {
#pragma unroll
            for (int j = 0; j < 4; ++j) v[j] = __builtin_nontemporal_load((const f32x4*)(in.x + (size_t)m * D + 4 * lane + 256 * j)); }
        for (; m < S; m += NGW) {
            const int mn = m + NGW;
            if (mn < S) {
#pragma unroll
                for (int j = 0; j < 4; ++j) vn[j] = __builtin_nontemporal_load((const f32x4*)(in.x + (size_t)mn * D + 4 * lane + 256 * j)); }
            float s = 0.f;
#pragma unroll
            for (int j = 0; j < 4; ++j) s += (v[j][0] * v[j][0] + v[j][1] * v[j][1]) + (v[j][2] * v[j][2] + v[j][3] * v[j][3]);
            const float rstd = rsqrtf(wave_sum(s) * (1.0f / D) + RMS_EPS);
#pragma unroll
            for (int j = 0; j < 4; ++j) { const f32x4 o = v[j] * rstd * gv[j]; u32x2 w; w.x = cvt_pk_bf16(o[0], o[1]); w.y = cvt_pk_bf16(o[2], o[3]); *(u32x2*)(H + (size_t)m * D + 4 * lane + 256 * j) = w; }
#pragma unroll
            for (int j = 0; j < 4; ++j) v[j] = vn[j];
        }
    }
    const int gt = c * 512 + tid, NGT = G * 512;
    { float* GWT = (float*)(ws + WS_GWT); for (int i = gt; i < NE * D; i += NGT) { const int e = i >> 10, k = i & 1023; GWT[i] = in.norm2_g[k] * in.router_w[k * NE + e]; } }
    { float* BT = (float*)(ws + WS_BT); for (int i = gt; i < 36 * BT_N; i += NGT) { const int bh = i / BT_N, j = i % BT_N, b = bh / NH, h = bh % NH, dil = (b == 0) ? 1 : (b == 1 ? 4 : 16), d = j - BT_OFF;
        BT[i] = (d >= 0 && d <= 128) ? in.rel_bias[t5_bucket(d * dil) * NH + h] * LOG2E : NEGBIG; } }
    { bf16_t* PWT = (bf16_t*)(ws + WS_PWT); for (int i = gt; i < 4 * 64 * 64; i += NGT) { const int g = i >> 12, d = (i >> 6) & 63, cc = i & 63; PWT[i] = (bf16_t)(cvt_pk_bf16(in.pool_w[g * 4096 + cc * 64 + d], 0.f) & 0xffffu); } }
}

__device__ __forceinline__ s16x4 lds_tr16(const LAS unsigned char* p) { typedef short v4i16_t __attribute__((ext_vector_type(4))); return __builtin_bit_cast(s16x4, __builtin_amdgcn_ds_read_tr16_b64_v4i16((LAS v4i16_t*)p)); }
constexpr int ATT_UNITS = 3 * NH * 64, KV_PITCH = 144, KV_ROWS = 384, ATT_VOFF = KV_ROWS * KV_PITCH, ATT_TOFF = 2 * KV_ROWS * KV_PITCH, ATT_NEGOFF = ATT_TOFF + BT_N * 4;
__device__ __forceinline__ void attn_decode(int uid, int& b, int& h, int& r, int& j, int& dil) {
    const int bh = uid >> 6, x = uid & 63; b = bh / NH; h = bh % NH; dil = (b == 0) ? 1 : (b == 1 ? 4 : 16);
    const int nb = 64 / dil; r = x / nb; j = x % nb;
}
__device__ __forceinline__ void attn_phase(LAS unsigned char* lds, const bf16_t* __restrict__ Qg, const bf16_t* __restrict__ Kg, const bf16_t* __restrict__ Vg, const float* __restrict__ BT,
                                           bf16_t* __restrict__ OP, float* __restrict__ LSE, int G, int c) {
    const int tid = threadIdx.x, lane = tid & 63, w = __builtin_amdgcn_readfirstlane(tid >> 6), ql = lane & 15, g = lane >> 4;
    LAS unsigned char* Ks = lds; LAS unsigned char* Vs = lds + ATT_VOFF; LAS float* Tb = (LAS float*)(lds + ATT_TOFF); LAS float* Tneg = (LAS float*)(lds + ATT_NEGOFF);
    if (tid < 16) Tneg[tid] = NEGBIG;
    u32x4 kpre[6], vpre[6]; bf16x8 qa0, qa1, qb0, qb1; float tpre = 0.f;
#define ATT_PREFETCH(uid_) do { int b_, h_, r_, j_, dil_; attn_decode((uid_), b_, h_, r_, j_, dil_); \
        _Pragma("unroll") for (int cc = 0; cc < 6; ++cc) { const int id = tid + 512 * cc, row = id >> 3, ch = id & 7; int mm = 256 * j_ - 128 + row; if (mm < 0) mm += 128; \
            const size_t off = (size_t)(r_ + dil_ * mm) * AW + h_ * HD + ch * 8; kpre[cc] = *(const u32x4*)(Kg + off); vpre[cc] = *(const u32x4*)(Vg + off); } \
        { const size_t qo = (size_t)(r_ + dil_ * (256 * j_ + 32 * w + ql)) * AW + h_ * HD + 8 * g; const size_t qs = (size_t)16 * dil_ * AW; \
          qa0 = *(const bf16x8*)(Qg + qo); qa1 = *(const bf16x8*)(Qg + qo + 32); qb0 = *(const bf16x8*)(Qg + qo + qs); qb1 = *(const bf16x8*)(Qg + qo + qs + 32); } \
        if (tid < BT_N) tpre = BT[(b_ * NH + h_) * BT_N + tid]; } while (0)
#ifndef ATT_SYNC_LOAD
    if (c < ATT_UNITS) ATT_PREFETCH(c);
#endif
    for (int uid = c; uid < ATT_UNITS; uid += G) {
        int b, h, r, j, dil; attn_decode(uid, b, h, r, j, dil);
#ifdef ATT_SYNC_LOAD
        ATT_PREFETCH(uid);
#endif
#pragma unroll
        for (int cc = 0; cc < 6; ++cc) { const int id = tid + 512 * cc, row = id >> 3, ch = id & 7; *(LAS u32x4*)(Ks + row * KV_PITCH + ch * 16) = kpre[cc]; *(LAS u32x4*)(Vs + row * KV_PITCH + ch * 16) = vpre[cc]; }
        if (tid < BT_N) Tb[tid] = tpre;
        const bf16x8 fa0 = qa0, fa1 = qa1, fb0 = qb0, fb1 = qb1;
        __syncthreads();
#ifndef ATT_SYNC_LOAD
        if (uid + G < ATT_UNITS) ATT_PREFETCH(uid + G);
#endif
        const int kkmin = (j == 0) ? 128 : 0;
        const LAS unsigned char* kb = Ks + (32 * w + ql) * KV_PITCH + g * 16;
        const LAS float* Tq = Tb + (ql + 272 - 4 * g - 3);
        const f32x4 zero4 = (f32x4){0.f, 0.f, 0.f, 0.f};
        f32x4 sA[9], sB[9];
#pragma unroll
        for (int i = 0; i < 10; ++i) {
            const bf16x8 kf0 = *(const LAS bf16x8*)(kb + i * (16 * KV_PITCH)), kf1 = *(const LAS bf16x8*)(kb + i * (16 * KV_PITCH) + 64);
            const bool msk = (32 * w + 16 * i) < kkmin;
            if (i <= 8) { f32x4 st = __builtin_amdgcn_mfma_f32_16x16x32_bf16(kf0, fa0, zero4, 0, 0, 0); st = __builtin_amdgcn_mfma_f32_16x16x32_bf16(kf1, fa1, st, 0, 0, 0);
                const LAS float* tp = msk ? Tneg : (Tq - 16 * i); sA[i] = (f32x4){st[0] + tp[3], st[1] + tp[2], st[2] + tp[1], st[3] + tp[0]}; }
            if (i >= 1) { f32x4 st = __builtin_amdgcn_mfma_f32_16x16x32_bf16(kf0, fb0, zero4, 0, 0, 0); st = __builtin_amdgcn_mfma_f32_16x16x32_bf16(kf1, fb1, st, 0, 0, 0);
                const LAS float* tp = msk ? Tneg : (Tq - 16 * (i - 1)); sB[i - 1] = (f32x4){st[0] + tp[3], st[1] + tp[2], st[2] + tp[1], st[3] + tp[0]}; }
        }
        float mA = NEGBIG, mB = NEGBIG;
#pragma unroll
        for (int i = 0; i < 9; ++i) { mA = fmaxf(mA, fmaxf(fmaxf(sA[i][0], sA[i][1]), fmaxf(sA[i][2], sA[i][3]))); mB = fmaxf(mB, fmaxf(fmaxf(sB[i][0], sB[i][1]), fmaxf(sB[i][2], sB[i][3]))); }
        mA = fmaxf(mA, __shfl_xor(mA, 16)); mA = fmaxf(mA, __shfl_xor(mA, 32)); mB = fmaxf(mB, __shfl_xor(mB, 16)); mB = fmaxf(mB, __shfl_xor(mB, 32));
        f32x4 oA[4], oB[4];
#pragma unroll
        for (int dt = 0; dt < 4; ++dt) { oA[dt] = zero4; oB[dt] = zero4; }
        float lA = 0.f, lB = 0.f;
        const LAS unsigned char* vb = Vs + (32 * w + 4 * g + (ql >> 2)) * KV_PITCH + (ql & 3) * 8;
#pragma unroll
        for (int i = 0; i < 10; ++i) {
            const LAS unsigned char* vt = vb + i * (16 * KV_PITCH);
            const s16x4 v0 = lds_tr16(vt), v1 = lds_tr16(vt + 32), v2 = lds_tr16(vt + 64), v3 = lds_tr16(vt + 96);
            if (i <= 8) { const float p0 = __builtin_amdgcn_exp2f(sA[i][0] - mA), p1 = __builtin_amdgcn_exp2f(sA[i][1] - mA), p2 = __builtin_amdgcn_exp2f(sA[i][2] - mA), p3 = __builtin_amdgcn_exp2f(sA[i][3] - mA);
                lA += (p0 + p1) + (p2 + p3); u32x2 pw; pw.x = cvt_pk_bf16(p0, p1); pw.y = cvt_pk_bf16(p2, p3); const s16x4 pf = __builtin_bit_cast(s16x4, pw);
                oA[0] = __builtin_amdgcn_mfma_f32_16x16x16bf16_1k(v0, pf, oA[0], 0, 0, 0); oA[1] = __builtin_amdgcn_mfma_f32_16x16x16bf16_1k(v1, pf, oA[1], 0, 0, 0);
                oA[2] = __builtin_amdgcn_mfma_f32_16x16x16bf16_1k(v2, pf, oA[2], 0, 0, 0); oA[3] = __builtin_amdgcn_mfma_f32_16x16x16bf16_1k(v3, pf, oA[3], 0, 0, 0); }
            if (i >= 1) { const float p0 = __builtin_amdgcn_exp2f(sB[i - 1][0] - mB), p1 = __builtin_amdgcn_exp2f(sB[i - 1][1] - mB), p2 = __builtin_amdgcn_exp2f(sB[i - 1][2] - mB), p3 = __builtin_amdgcn_exp2f(sB[i - 1][3] - mB);
                lB += (p0 + p1) + (p2 + p3); u32x2 pw; pw.x = cvt_pk_bf16(p0, p1); pw.y = cvt_pk_bf16(p2, p3); const s16x4 pf = __builtin_bit_cast(s16x4, pw);
                oB[0] = __builtin_amdgcn_mfma_f32_16x16x16bf16_1k(v0, pf, oB[0], 0, 0, 0); oB[1] = __builtin_amdgcn_mfma_f32_16x16x16bf16_1k(v1, pf, oB[1], 0, 0, 0);
                oB[2] = __builtin_amdgcn_mfma_f32_16x16x16bf16_1k(v2, pf, oB[2], 0, 0, 0); oB[3] = __builtin_amdgcn_mfma_f32_16x16x16bf16_1k(v3, pf, oB[3], 0, 0, 0); }
        }
        lA += __shfl_xor(lA, 16); lA += __shfl_xor(lA, 32); lB += __shfl_xor(lB, 16); lB += __shfl_xor(lB, 32);
#ifdef ATT_EXP1
        lA = 1.0f; lB = 1.0f; mA = 0.f; mB = 0.f;
#pragma unroll
        for (int dt = 0; dt < 4; ++dt) { oA[dt] = zero4; oB[dt] = zero4; }
#endif
#ifdef ATT_EXP2
        lA = 1.0f; lB = 1.0f;
#pragma unroll
        for (int dt = 0; dt < 4; ++dt) { oA[dt] = zero4; oB[dt] = zero4; }
#endif
        const float iA = 1.0f / lA, iB = 1.0f / lB;
        const int posA = r + dil * (256 * j + 32 * w + ql), posB = posA + 16 * dil;
        bf16_t* dA = OP + ((size_t)b * S + posA) * AW + h * HD + 4 * g; bf16_t* dB = OP + ((size_t)b * S + posB) * AW + h * HD + 4 * g;
#pragma unroll
        for (int dt = 0; dt < 4; ++dt) { u32x2 t; t.x = cvt_pk_bf16(oA[dt][0] * iA, oA[dt][1] * iA); t.y = cvt_pk_bf16(oA[dt][2] * iA, oA[dt][3] * iA); *(u32x2*)(dA + 16 * dt) = t;
            u32x2 t2; t2.x = cvt_pk_bf16(oB[dt][0] * iB, oB[dt][1] * iB); t2.y = cvt_pk_bf16(oB[dt][2] * iB, oB[dt][3] * iB); *(u32x2*)(dB + 16 * dt) = t2; }
        if (g == 0) { LSE[((size_t)b * S + posA) * NH + h] = mA + __builtin_amdgcn_logf(lA); LSE[((size_t)b * S + posB) * NH + h] = mB + __builtin_amdgcn_logf(lB); }
        __syncthreads();
    }
#undef ATT_PREFETCH
}

__device__ __forceinline__ void pool_phase(LAS unsigned char* lds, const bf16_t* __restrict__ U, const bf16_t* __restrict__ PWT, const float* __restrict__ pool_scale, bf16_t* __restrict__ MIX, int G, int c) {
    const int tid = threadIdx.x, lane = tid & 63, w = __builtin_amdgcn_readfirstlane(tid >> 6), ql = lane & 15, g = lane >> 4;
    LAS unsigned char* Us = lds; LAS unsigned char* Pl = lds + 40960;
    for (int pu = c; pu < S / 64; pu += G) {
        const int t0 = pu * 64;
        for (int id = tid; id < 79 * 32; id += 512) { const int row = id >> 5, ch = id & 31, t = t0 - 15 + row;
            u32x4 v = (u32x4){0u, 0u, 0u, 0u}; if (t >= 0) v = *(const u32x4*)(U + (size_t)t * PW + ch * 8);
            *(LAS u32x4*)(Us + row * 512 + ch * 16) = v; }
        __syncthreads();
        { const int cch = tid & 255, th = tid >> 8, gg = cch >> 6, wn = 2 << gg, tl0 = 32 * th;
          const LAS bf16_t* up = (const LAS bf16_t*)Us + cch;
#define UAT(row) __uint_as_float(((unsigned)up[(row) * 256]) << 16)
          float sum = 0.f;
          for (int i = 0; i < wn; ++i) sum += UAT(tl0 + 15 - i);
          for (int tl = tl0; tl < tl0 + 32; ++tl) {
              if (tl > tl0) sum += UAT(tl + 15) - UAT(tl + 15 - wn);
              const int t = t0 + tl; const int cnt = (t + 1 < wn) ? (t + 1) : wn;
              const float val = sum / (float)cnt - UAT(tl + 15);
              ((LAS bf16_t*)(Pl + tl * 528))[cch] = (bf16_t)(cvt_pk_bf16(val, 0.f) & 0xffffu);
          }
#undef UAT
        }
        __syncthreads();
        { const int tt = w & 3, gp = w >> 2;
#pragma unroll
          for (int gi = 0; gi < 2; ++gi) { const int gg = 2 * gp + gi;
              const bf16x8 b0 = *(const LAS bf16x8*)(Pl + (16 * tt + ql) * 528 + (gg * 64 + 8 * g) * 2), b1 = *(const LAS bf16x8*)(Pl + (16 * tt + ql) * 528 + (gg * 64 + 32 + 8 * g) * 2);
#pragma unroll
              for (int nt = 0; nt < 4; ++nt) {
                  const bf16_t* ap = PWT + ((size_t)(gg * 64 + 16 * nt + ql) * 64 + 8 * g);
                  const bf16x8 a0 = *(const bf16x8*)(ap), a1 = *(const bf16x8*)(ap + 32);
                  f32x4 acc = __builtin_amdgcn_mfma_f32_16x16x32_bf16(a0, b0, (f32x4){0.f, 0.f, 0.f, 0.f}, 0, 0, 0);
                  acc = __builtin_amdgcn_mfma_f32_16x16x32_bf16(a1, b1, acc, 0, 0, 0);
                  const f32x4 ps = *(const f32x4*)(pool_scale + gg * 64 + 16 * nt + 4 * g);
                  u32x2 o; o.x = cvt_pk_bf16(acc[0] * ps[0], acc[1] * ps[1]); o.y = cvt_pk_bf16(acc[2] * ps[2], acc[3] * ps[3]);
                  *(u32x2*)(MIX + (size_t)(t0 + 16 * tt + ql) * D + gg * 64 + 16 * nt + 4 * g) = o;
              } }
        }
        __syncthreads();
    }
}

__device__ __forceinline__ void combine_phase(const bf16_t* __restrict__ OP, const float* __restrict__ LSE, bf16_t* __restrict__ MIX, int G, int c) {
    const int gt = c * 512 + threadIdx.x, NGT = G * 512;
    for (int id = gt; id < S * 96; id += NGT) {
        const int t = id / 96, rem = id % 96, h = rem >> 3, c8 = rem & 7;
        const float l0 = LSE[(size_t)t * NH + h], l1 = LSE[((size_t)S + t) * NH + h], l2 = LSE[((size_t)2 * S + t) * NH + h];
        const float mx = fmaxf(l0, fmaxf(l1, l2));
        float w0 = __builtin_amdgcn_exp2f(l0 - mx), w1 = __builtin_amdgcn_exp2f(l1 - mx), w2 = __builtin_amdgcn_exp2f(l2 - mx);
        const float inv = 1.0f / (w0 + w1 + w2); w0 *= inv; w1 *= inv; w2 *= inv;
        const size_t off = (size_t)t * AW + h * HD + c8 * 8;
        const u32x4 a = __builtin_nontemporal_load((const u32x4*)(OP + off)), b = __builtin_nontemporal_load((const u32x4*)(OP + (size_t)S * AW + off)), cc = __builtin_nontemporal_load((const u32x4*)(OP + (size_t)2 * S * AW + off));
        u32x4 o;
#pragma unroll
        for (int k = 0; k < 4; ++k) { const float lo = w0 * bf_lo(a[k]) + w1 * bf_lo(b[k]) + w2 * bf_lo(cc[k]), hi = w0 * bf_hi(a[k]) + w1 * bf_hi(b[k]) + w2 * bf_hi(cc[k]); o[k] = cvt_pk_bf16(lo, hi); }
        *(u32x4*)(MIX + (size_t)t * D + PW + h * HD + c8 * 8) = o;
    }
}

constexpr int GW_PITCH = 1028;
constexpr int RT_G2 = 131584, RT_LG = RT_G2 + 4096, RT_RS = RT_LG + 4 * 16 * 33 * 4, RT_CNT = RT_RS + 256, RT_PART = RT_CNT + 256, RT_END = RT_PART + 4 * 64 * 9 * 4;
static_assert(RT_END <= LDS_CTL, "router LDS map");
__device__ __forceinline__ void router_phase(LAS unsigned char* lds, const float* __restrict__ X1, const float* __restrict__ g2, const float* __restrict__ GWT, const float* __restrict__ rb,
                                             unsigned char* __restrict__ H, float* __restrict__ RSTD, float* __restrict__ GATES, int* __restrict__ ROWS, unsigned* __restrict__ COUNTS, int G, int c) {
    const int tid = threadIdx.x, lane = tid & 63, w = __builtin_amdgcn_readfirstlane(tid >> 6), ql = lane & 15, g = lane >> 4;
    const int ts = w & 3, kh = w >> 2;
    LAS float* GW = (LAS float*)lds;
    LAS float* G2 = (LAS float*)(lds + RT_G2);
    LAS float* LG = (LAS float*)(lds + RT_LG) + ts * (16 * 33);
    LAS float* RS = (LAS float*)(lds + RT_RS) + ts * 16;
    LAS int* LCNT = (LAS int*)(lds + RT_CNT);
    LAS int* LBASE = LCNT + 32;
    LAS float* PART = (LAS float*)(lds + RT_PART) + ts * (64 * 9);
    for (int id = tid; id < NE * 256; id += 512) { const int e = id >> 8, k4 = id & 255; *(LAS f32x4*)(GW + e * GW_PITCH + k4 * 4) = *(const f32x4*)(GWT + e * D + k4 * 4); }
    if (tid < 256) *(LAS f32x4*)(G2 + tid * 4) = *(const f32x4*)(g2 + tid * 4);
    const int nrounds = (S / 16 + 4 * G - 1) / (4 * G);
    for (int rd = 0; rd < nrounds; ++rd) {
        if (tid < 32) LCNT[tid] = 0;
        __syncthreads();
        const int tile = (rd * 4 + ts) * G + c;
        int ek[4] = {0, 0, 0, 0}, lp[4] = {0, 0, 0, 0}; float gk[4] = {0.f, 0.f, 0.f, 0.f};
        const bool active = tile < S / 16;
        f32x4 acc0 = (f32x4){0.f, 0.f, 0.f, 0.f}, acc1 = acc0; float ss = 0.f;
        const int tok = (active ? tile : 0) * 16 + ql;
        if (active) {
            const float* xr = X1 + (size_t)tok * D + kh * 512 + 8 * g;
            unsigned char* hr = H + (size_t)tok * D + kh * 512 + 8 * g;
            const LAS float* w0p = GW + ql * GW_PITCH + kh * 512 + 8 * g; const LAS float* w1p = GW + (16 + ql) * GW_PITCH + kh * 512 + 8 * g;
            const LAS float* gp = G2 + kh * 512 + 8 * g;
#pragma unroll 1
            for (int kb = 0; kb < 512; kb += 256) {
                f32x4 av[16];
#pragma unroll
                for (int i = 0; i < 8; ++i) { av[2 * i] = __builtin_nontemporal_load((const f32x4*)(xr + kb + 32 * i)); av[2 * i + 1] = __builtin_nontemporal_load((const f32x4*)(xr + kb + 32 * i + 4)); }
#pragma unroll
                for (int i = 0; i < 8; ++i) {
                    const int k0 = kb + 32 * i; const f32x4 a0 = av[2 * i], a1 = av[2 * i + 1];
                    const f32x4 n0 = *(const LAS f32x4*)(gp + k0), n1 = *(const LAS f32x4*)(gp + k0 + 4);
                    const f32x4 b00 = *(const LAS f32x4*)(w0p + k0), b01 = *(const LAS f32x4*)(w0p + k0 + 4), b10 = *(const LAS f32x4*)(w1p + k0), b11 = *(const LAS f32x4*)(w1p + k0 + 4);
                    ss += (a0[0] * a0[0] + a0[1] * a0[1]) + (a0[2] * a0[2] + a0[3] * a0[3]) + (a1[0] * a1[0] + a1[1] * a1[1]) + (a1[2] * a1[2] + a1[3] * a1[3]);
                    u32x2 hv; hv.x = cvt4_fp8(a0[0] * n0[0] * HSCALE, a0[1] * n0[1] * HSCALE, a0[2] * n0[2] * HSCALE, a0[3] * n0[3] * HSCALE);
                    hv.y = cvt4_fp8(a1[0] * n1[0] * HSCALE, a1[1] * n1[1] * HSCALE, a1[2] * n1[2] * HSCALE, a1[3] * n1[3] * HSCALE);
                    *(u32x2*)(hr + k0) = hv;
#pragma unroll
                    for (int jj = 0; jj < 4; ++jj) { acc0 = __builtin_amdgcn_mfma_f32_16x16x4f32(a0[jj], b00[jj], acc0, 0, 0, 0); acc1 = __builtin_amdgcn_mfma_f32_16x16x4f32(a0[jj], b10[jj], acc1, 0, 0, 0); }
#pragma unroll
                    for (int jj = 0; jj < 4; ++jj) { acc0 = __builtin_amdgcn_mfma_f32_16x16x4f32(a1[jj], b01[jj], acc0, 0, 0, 0); acc1 = __builtin_amdgcn_mfma_f32_16x16x4f32(a1[jj], b11[jj], acc1, 0, 0, 0); }
                }
            }
            if (kh == 1) { LAS float* pp = PART + lane * 9;
#pragma unroll
                for (int i = 0; i < 4; ++i) { pp[i] = acc0[i]; pp[4 + i] = acc1[i]; } pp[8] = ss; }
        }
        __syncthreads();
        if (active && kh == 0) {
            { const LAS float* pp = PART + lane * 9;
#pragma unroll
              for (int i = 0; i < 4; ++i) { acc0[i] += pp[i]; acc1[i] += pp[4 + i]; } ss += pp[8]; }
            ss += __shfl_xor(ss, 16); ss += __shfl_xor(ss, 32);
            const float rstd = rsqrtf(ss * (1.0f / D) + RMS_EPS);
            if (g == 0) { RSTD[tok] = rstd; RS[ql] = rstd; }
            LDS_WAIT();
            const float rb0 = rb[ql], rb1 = rb[16 + ql];
#pragma unroll
            for (int rg = 0; rg < 4; ++rg) { const float rr = RS[4 * g + rg]; LG[(4 * g + rg) * 33 + ql] = acc0[rg] * rr + rb0; LG[(4 * g + rg) * 33 + 16 + ql] = acc1[rg] * rr + rb1; }
            LDS_WAIT();
            if (lane < 16) {
                float v[32];
#pragma unroll
                for (int e = 0; e < 32; ++e) v[e] = LG[ql * 33 + e];
                float tv[4];
#pragma unroll
                for (int r = 0; r < 4; ++r) { float best = v[0]; int bi = 0;
#pragma unroll
                    for (int e = 1; e < 32; ++e) { const bool gt = v[e] > best; best = gt ? v[e] : best; bi = gt ? e : bi; }
                    tv[r] = best; ek[r] = bi;
#pragma unroll
                    for (int e = 0; e < 32; ++e) v[e] = (e == bi) ? -INFINITY : v[e]; }
                const float e1 = __expf(tv[1] - tv[0]), e2 = __expf(tv[2] - tv[0]), e3 = __expf(tv[3] - tv[0]); const float inv = 1.0f / (1.0f + e1 + e2 + e3);
                gk[0] = inv; gk[1] = e1 * inv; gk[2] = e2 * inv; gk[3] = e3 * inv;
#pragma unroll
                for (int r = 0; r < 4; ++r) lp[r] = __hip_atomic_fetch_add(LCNT + ek[r], 1, __ATOMIC_RELAXED, __HIP_MEMORY_SCOPE_WORKGROUP);
            }
        }
        __syncthreads();
        if (tid < 32) { const int n = LCNT[tid]; int base = 0; if (n > 0) base = (int)__hip_atomic_fetch_add(COUNTS + tid, (unsigned)n, __ATOMIC_RELAXED, __HIP_MEMORY_SCOPE_AGENT); LBASE[tid] = base; }
        __syncthreads();
        if (active && kh == 0 && lane < 16) {
#pragma unroll
            for (int r = 0; r < 4; ++r) { const int pos = LBASE[ek[r]] + lp[r]; ROWS[(size_t)ek[r] * S + pos] = tok * 4 + r; GATES[tok * 4 + r] = gk[r]; } }
        __syncthreads();
    }
}

__device__ __forceinline__ void moe_prefix(LAS int* tpre, LAS int* lcnt, const unsigned* __restrict__ COUNTS) {
    if (threadIdx.x < 32) lcnt[threadIdx.x] = (int)COUNTS[threadIdx.x];
    __syncthreads();
    if (threadIdx.x == 0) { int acc = 0; for (int e = 0; e < NE; ++e) { tpre[e] = acc; acc += (lcnt[e] + 255) >> 8; } tpre[NE] = acc; }
    __syncthreads();
}
template <bool GU, class Prob> __device__ __forceinline__ void moe_table(const Prob& P, LAS int* tab, LAS float* tabf, LAS float* tabb, const LAS int* lcnt, const int* __restrict__ ROWS,
                                                                         const float* __restrict__ rowf, const float* __restrict__ bias) {
    Unit u;
#pragma unroll 1
    for (int i = 0; i < MAXU && P.next(i, u); ++i) {
        if (threadIdx.x < 256) { const int rr = u.pm * 256 + (int)threadIdx.x; const int idx = (rr < lcnt[u.e]) ? ROWS[(size_t)u.e * S + rr] : -1; tab[i * 256 + threadIdx.x] = idx;
            tabf[i * 256 + threadIdx.x] = GU ? rowf[idx < 0 ? 0 : (idx >> 2)] * (1.0f / (HSCALE * WSCALE)) : (idx < 0 ? 0.f : rowf[idx]); }
        else { const int j = (int)threadIdx.x - 256;
            tabb[i * 256 + j] = GU ? bias[(size_t)u.e * 2 * DFF + (j >> 7) * DFF + u.pn * 128 + (j & 127)] : bias[(size_t)u.e * D + u.pn * 256 + j]; }
    }
    __syncthreads();
}

__device__ __forceinline__ void final_phase(const float* __restrict__ X1, const unsigned char* __restrict__ Y, const float* __restrict__ fg, float* __restrict__ out, int G, int c) {
    const int tid = threadIdx.x, lane = tid & 63, wave = tid >> 6; const int gw = c * 8 + wave, NGW = G * 8;
    f32x4 gv[4];
#pragma unroll
    for (int j = 0; j < 4; ++j) gv[j] = *(const f32x4*)(fg + 4 * lane + 256 * j);
    for (int m = gw; m < S; m += NGW) {
        const float* xr = X1 + (size_t)m * D + 4 * lane;
        f32x4 v[4];
#pragma unroll
        for (int j = 0; j < 4; ++j) v[j] = __builtin_nontemporal_load((const f32x4*)(xr + 256 * j));
#pragma unroll
        for (int k = 0; k < 4; ++k) { const unsigned char* yr = Y + ((size_t)m * 4 + k) * D + 4 * lane;
#pragma unroll
            for (int j = 0; j < 4; ++j) { const int t = __builtin_nontemporal_load((const int*)(yr + 256 * j)); const f32x2 lo = __builtin_amdgcn_cvt_pk_f32_fp8(t, false), hi = __builtin_amdgcn_cvt_pk_f32_fp8(t, true);
                v[j][0] += lo[0] * (1.0f / YSCALE); v[j][1] += lo[1] * (1.0f / YSCALE); v[j][2] += hi[0] * (1.0f / YSCALE); v[j][3] += hi[1] * (1.0f / YSCALE); } }
        float s = 0.f;
#pragma unroll
        for (int j = 0; j < 4; ++j) s += (v[j][0] * v[j][0] + v[j][1] * v[j][1]) + (v[j][2] * v[j][2] + v[j][3] * v[j][3]);
        const float rstd = rsqrtf(wave_sum(s) * (1.0f / D) + RMS_EPS);
#pragma unroll
        for (int j = 0; j < 4; ++j) __builtin_nontemporal_store(v[j] * rstd * gv[j], (f32x4*)(out + (size_t)m * D + 4 * lane + 256 * j));
    }
}

constexpr int NPHASE = 9;
struct Args { In in; float* out; unsigned char* ws; int ph_lo, ph_hi; };
__global__ void __launch_bounds__(512, 2) fwd(Args args) {
    extern __shared__ __attribute__((aligned(16))) unsigned char lds_raw[];
    LAS unsigned char* lds = (LAS unsigned char*)lds_raw;
    const int tid = threadIdx.x, G = gridDim.x, c = blockIdx.x;
    unsigned char* ws = args.ws; const In& in = args.in;
    unsigned* ctl = (unsigned*)(ws + WS_CTL);
    LAS int* LCTL = (LAS int*)(lds + LDS_CTL);
    if (tid < 256) LCTL[tid] = 0;
    __syncthreads();
    const int lo = args.ph_lo, hi = args.ph_hi;
    const bool one_launch = (hi - lo) > 1;
    XcdBarrier bar; bar.bar = ctl + CW_BAR; bar.x = 0; bar.st = nullptr;
    if (one_launch) bar = xcd_barrier_post(ctl + CW_BAR, (volatile LAS unsigned*)LCTL);
#define IN(k) (lo <= (k) && (k) < hi)
#ifndef MK_DOUBLE
#define MK_DOUBLE 0
#endif
#define REP(k) for (int rep_ = 0; rep_ < ((((MK_DOUBLE) >> (k)) & 1) ? 2 : 1); ++rep_)
#define SEAM(k) do { if (IN((k) + 1)) xcd_barrier(bar); } while (0)
    bf16_t* Hb = (bf16_t*)(ws + WS_H); bf16_t* Ub = (bf16_t*)(ws + WS_U); bf16_t* Qb = (bf16_t*)(ws + WS_Q); bf16_t* Kb = (bf16_t*)(ws + WS_K); bf16_t* Vb = (bf16_t*)(ws + WS_V);
    bf16_t* OPb = (bf16_t*)(ws + WS_OP); bf16_t* MIXb = (bf16_t*)(ws + WS_MIX); float* X1 = (float*)(ws + WS_X1); unsigned char* ACTb = ws + WS_ACT; unsigned char* Yb = ws + WS_Y; unsigned char* H8 = ws + WS_H8;
    float* LSE = (float*)(ws + WS_LSE); float* RSTD = (float*)(ws + WS_RSTD); float* GATES = (float*)(ws + WS_GATES); int* ROWS = (int*)(ws + WS_ROWS); unsigned* COUNTS = ctl + CW_COUNTS;
    LAS int* TPRE = LCTL + 16; LAS int* LCNT = LCTL + 128; LAS int* TAB = (LAS int*)(lds + LDS_TAB); LAS float* TABF = (LAS float*)(lds + LDS_TAB + MAXU * 1024); LAS float* TABB = (LAS float*)(lds + LDS_TAB + 2 * MAXU * 1024);
    static_assert(LDS_TAB + 3 * MAXU * 1024 <= LDS_CTL, "MoE LDS tables");

    if (IN(0)) { REP(0) p0_prologue(lds, in, ws, G, c); SEAM(0); }
    if (IN(1)) {
        pg8::DenseProb P{(const char*)Hb, (const char*)(ws + WS_WIN), D * 2, S / 256, NPROJ / 256, G, c, (size_t)128 * D * 2};
        EpiQKVU E{ws};
        REP(1) pg8::gemm_phase<EpiQKVU, pg8::DenseProb, true, false>(lds, P, E);
        SEAM(1);
    }
    if (IN(2)) {
        REP(2) attn_phase(lds, Qb, Kb, Vb, (const float*)(ws + WS_BT), OPb, LSE, G, c);
        REP(9) pool_phase(lds, Ub, (const bf16_t*)(ws + WS_PWT), in.pool_scale, MIXb, G, c);
        SEAM(2);
    }
    if (IN(3)) { REP(3) combine_phase(OPb, LSE, MIXb, G, c); SEAM(3); }
    if (IN(4)) {
        pg8::DenseProb P{(const char*)MIXb, (const char*)(ws + WS_WOUT), D * 2, S / 256, D / 256, G, c, (size_t)128 * D * 2};
        EpiResF32 E{in.x, X1};
        REP(4) pg8::gemm_phase<EpiResF32, pg8::DenseProb, true, false>(lds, P, E);
        SEAM(4);
    }
    if (IN(5)) { router_phase(lds, X1, in.norm2_g, (const float*)(ws + WS_GWT), in.router_b, H8, RSTD, GATES, ROWS, COUNTS, G, c); SEAM(5); }
    if (IN(6)) {
        moe_prefix(TPRE, LCNT, COUNTS);
        pg8::MoeProb<true> P{(const char*)H8, (const char*)(ws + WS_WGU), D, 8, G, c, (size_t)DFF * D, (size_t)2 * DFF * D, 128, TPRE, TAB};
        moe_table<true>(P, TAB, TABF, TABB, LCNT, ROWS, RSTD, in.b_gate_up);
        EpiGateUp E{ACTb, TPRE, TABF, TABB};
        REP(6) pg8::gemm_phase<EpiGateUp, pg8::MoeProb<true>, true, true>(lds, P, E);
        SEAM(6);
    }
    if (IN(7)) {
        moe_prefix(TPRE, LCNT, COUNTS);
        pg8::MoeProb<false> P{(const char*)ACTb, (const char*)(ws + WS_WD), DFF, 4, G, c, (size_t)128 * DFF, (size_t)D * DFF, 256, TPRE, TAB};
        moe_table<false>(P, TAB, TABF, TABB, LCNT, ROWS, GATES, in.b_down);
        EpiDown E{Yb, TAB, TABF, TABB};
        REP(7) pg8::gemm_phase<EpiDown, pg8::MoeProb<false>, true, true>(lds, P, E);
        SEAM(7);
    }
    if (IN(8)) REP(8) final_phase(X1, Yb, in.final_g, args.out, G, c);
#undef IN
#undef SEAM
}

#ifndef MK_N_LAUNCHES
#define MK_N_LAUNCHES 1
#endif
#ifndef MK_SEQ
#define MK_SEQ "012345678"
#endif
extern "C" void kernel_launch(void* const* d_in, const int* in_sizes, int n_in, void* d_out, int out_size, void* d_ws, size_t ws_size, hipStream_t stream) {
    static int grid = 0;
    if (grid == 0) {
        if (n_in != 15 || out_size != S * D || ws_size < WS_END) { fprintf(stderr, "kernel_launch: unexpected problem (n_in %d out %d ws %zu)\n", n_in, out_size, ws_size); grid = -1; return; }
        int dev = 0, cus = 0, per_cu = 0;
        if (hipGetDevice(&dev) != hipSuccess || hipDeviceGetAttribute(&cus, hipDeviceAttributeMultiprocessorCount, dev) != hipSuccess) { grid = -1; return; }
        if (hipFuncSetAttribute((const void*)fwd, hipFuncAttributeMaxDynamicSharedMemorySize, LDS_BYTES) != hipSuccess) { fprintf(stderr, "kernel_launch: hipFuncSetAttribute failed\n"); grid = -1; return; }
        if (hipOccupancyMaxActiveBlocksPerMultiprocessor(&per_cu, (const void*)fwd, 512, LDS_BYTES) != hipSuccess || per_cu < 1) { fprintf(stderr, "kernel_launch: occupancy query says %d blocks per CU\n", per_cu); (void)hipGetLastError(); per_cu = 1; }
        grid = cus;
    }
    if (grid < 0) return;
    if (hipMemsetAsync((char*)d_ws + WS_CTL, 0, CTL_ZERO_BYTES, stream) != hipSuccess) { fprintf(stderr, "kernel_launch: memset failed\n"); return; }
    Args a{};
    a.in.x = (const float*)d_in[0]; a.in.norm1_g = (const float*)d_in[1]; a.in.w_in = (const float*)d_in[2]; a.in.pool_w = (const float*)d_in[3]; a.in.pool_scale = (const float*)d_in[4];
    a.in.rel_bias = (const float*)d_in[5]; a.in.w_out = (const float*)d_in[6]; a.in.norm2_g = (const float*)d_in[7]; a.in.router_w = (const float*)d_in[8]; a.in.router_b = (const float*)d_in[9];
    a.in.w_gate_up = (const float*)d_in[10]; a.in.b_gate_up = (const float*)d_in[11]; a.in.w_down = (const float*)d_in[12]; a.in.b_down = (const float*)d_in[13]; a.in.final_g = (const float*)d_in[14];
    a.out = (float*)d_out; a.ws = (unsigned char*)d_ws;
    if (MK_N_LAUNCHES == 1) { a.ph_lo = 0; a.ph_hi = NPHASE; hipLaunchKernelGGL(fwd, dim3(grid), dim3(512), LDS_BYTES, stream, a); }
    else { const char* seq = MK_SEQ; for (int i = 0; seq[i]; ++i) { const int p = seq[i] - '0'; a.ph_lo = p; a.ph_hi = p + 1; if (p == 5) (void)hipMemsetAsync((char*)d_ws + WS_CTL + CW_COUNTS * 4, 0, 128, stream); hipLaunchKernelGGL(fwd, dim3(grid), dim3(512), LDS_BYTES, stream, a); } }
    const hipError_t le = hipPeekAtLastError();
    if (le != hipSuccess) fprintf(stderr, "kernel_launch: launch failed: %s\n", hipGetErrorName(le));
}
```

```cpp
#include <hip/hip_runtime.h>
#include <cstdio>
#include <cstdint>

#define LAS __attribute__((address_space(3)))
#define GAS __attribute__((address_space(1)))
typedef unsigned short bf16_t;
typedef short bf16x8 __attribute__((ext_vector_type(8)));
typedef short s16x4 __attribute__((ext_vector_type(4)));
typedef float f32x4 __attribute__((ext_vector_type(4)));
typedef float f32x2 __attribute__((ext_vector_type(2)));
typedef unsigned u32x4 __attribute__((ext_vector_type(4)));
typedef unsigned u32x2 __attribute__((ext_vector_type(2)));
typedef int i32x4 __attribute__((ext_vector_type(4)));
typedef int i32x8 __attribute__((ext_vector_type(8)));

constexpr int S = 16384, D = 1024, NPROJ = 2560, PW = 256, AW = 768, NH = 12, HD = 64, NE = 32, TOPK = 4, DFF = 1024;
constexpr float RMS_EPS = 1e-5f, LOG2E = 1.4426950408889634f, QSCALE = 0.125f * LOG2E, NEGBIG = -1e30f;
constexpr float WSCALE = 64.0f, HSCALE = 16.0f, ASCALE = 8.0f, YSCALE = 64.0f, FP8MAX = 448.0f;
constexpr int BT_N = 400, BT_OFF = 144;

constexpr size_t MiB = 1u << 20;
constexpr size_t WS_CTL = 0, CTL_ZERO_BYTES = 64 * 1024;
constexpr size_t WS_WIN = 2 * MiB;
constexpr size_t WS_WOUT = 8 * MiB;
constexpr size_t WS_GWT = 10 * MiB;
constexpr size_t WS_BT = 10 * MiB + 512 * 1024;
constexpr size_t WS_PWT = 10 * MiB + 768 * 1024;
constexpr size_t WS_RSTD = 11 * MiB;
constexpr size_t WS_GATES = 11 * MiB + 256 * 1024;
constexpr size_t WS_ROWS = 12 * MiB;
constexpr size_t WS_LSE = 14 * MiB;
constexpr size_t WS_WGU = 32 * MiB;
constexpr size_t WS_WD = 160 * MiB;
constexpr size_t WS_H8 = 200 * MiB;
constexpr size_t WS_H = 224 * MiB;
constexpr size_t WS_U = 256 * MiB;
constexpr size_t WS_Q = 264 * MiB, WS_K = 288 * MiB, WS_V = 312 * MiB;
constexpr size_t WS_OP = 336 * MiB;
constexpr size_t WS_MIX = 408 * MiB;
constexpr size_t WS_X1 = 440 * MiB;
constexpr size_t WS_ACT = 512 * MiB;
constexpr size_t WS_Y = 656 * MiB;
constexpr size_t WS_END = 784 * MiB;
constexpr int ACT_ROWS = 65536 + 32 * 256;
constexpr int CW_COUNTS = 64;
constexpr int CW_BAR = 4096;

constexpr int LDS_BYTES = 163840;
constexpr int LDS_TAB = 131072;
constexpr int LDS_CTL = LDS_BYTES - 1024;
constexpr int MAXU = 9;

typedef __bf16 bf16x2_t __attribute__((ext_vector_type(2)));
__device__ __forceinline__ unsigned cvt_pk_bf16(float lo, float hi) { const f32x2 v = {lo, hi}; const bf16x2_t b = __builtin_convertvector(v, bf16x2_t); return __builtin_bit_cast(unsigned, b); }
__device__ __forceinline__ float clamp8(float v) { return __builtin_amdgcn_fmed3f(v, -FP8MAX, FP8MAX); }
__device__ __forceinline__ unsigned cvt4_fp8(float a, float b, float c, float d) {
    int p = __builtin_amdgcn_cvt_pk_fp8_f32(clamp8(a), clamp8(b), 0, false); p = __builtin_amdgcn_cvt_pk_fp8_f32(clamp8(c), clamp8(d), p, true); return (unsigned)p; }
__device__ __forceinline__ float bf_lo(unsigned w) { return __uint_as_float(w << 16); }
__device__ __forceinline__ float bf_hi(unsigned w) { return __uint_as_float(w & 0xffff0000u); }
__device__ __forceinline__ float wave_sum(float v) {
#pragma unroll
    for (int o = 1; o < 64; o <<= 1) v += __shfl_xor(v, o);
    return v;
}
#define LDS_WAIT() asm volatile("s_waitcnt lgkmcnt(0)" ::: "memory")
#define VM_WAIT() asm volatile("s_waitcnt vmcnt(0)" ::: "memory")

#define XB_TMO      128
#define XB_XCNT(j)  (256  + 64 * (j))
#define XB_XSUB(j)  (1280 + 64 * (j))
#define XB_XGEN(j)  (2304 + 64 * (j))
#define XB_TOP      3328
#define XB_TOPGEN   3392
#define XCD_BAR_WORDS 3456
#define XB_SPIN_CAP (1u << 18)
__device__ __forceinline__ unsigned xb_ld(unsigned* p)              { return __hip_atomic_load(p, __ATOMIC_RELAXED, __HIP_MEMORY_SCOPE_AGENT); }
__device__ __forceinline__ unsigned xb_add(unsigned* p, unsigned v) { return __hip_atomic_fetch_add(p, v, __ATOMIC_RELAXED, __HIP_MEMORY_SCOPE_AGENT); }
__device__ __forceinline__ unsigned xb_xcc_id() { return (unsigned)__builtin_amdgcn_s_getreg((3 << 11) | 20) & 0xFu; }
#define XB_SPIN(cond, bar) do { unsigned _sp = 0; while (cond) { __builtin_amdgcn_s_sleep(1); \
    if ((++_sp & 255u) == 0u) { if (xb_ld(&(bar)[XB_TMO])) break; if (_sp > XB_SPIN_CAP) { atomicAdd(&(bar)[XB_TMO], 1u); break; } } } } while (0)
struct XcdBarrier { unsigned* bar; unsigned x; volatile LAS unsigned* st; };
__device__ __forceinline__ XcdBarrier xcd_barrier_post(unsigned* bar, volatile LAS unsigned* st) {
    XcdBarrier b; b.bar = bar; b.x = xb_xcc_id(); b.st = st;
    if (threadIdx.x == 0) (void)xb_add(&bar[XB_XCNT(b.x)], 1u);
    return b;
}
__device__ __forceinline__ void xcd_barrier_complete(unsigned* bar, unsigned x, unsigned& nloc, unsigned& nx) {
    const unsigned G = gridDim.x * gridDim.y * gridDim.z;
    unsigned sum, cnt, mine, sp = 0u;
    for (;;) {
        sum = 0u; cnt = 0u; mine = 0u;
#pragma unroll
        for (unsigned j = 0; j < 16; ++j) { const unsigned c = xb_ld(&bar[XB_XCNT(j)]); sum += c; cnt += (c > 0u) ? 1u : 0u; mine = (j == x) ? c : mine; }
        if (sum == G) break;
        __builtin_amdgcn_s_sleep(1);
        if ((++sp & 255u) == 0u) { if (xb_ld(&bar[XB_TMO])) break; if (sp > XB_SPIN_CAP) { atomicAdd(&bar[XB_TMO], 1u); break; } }
    }
    nloc = mine > 0u ? mine : 1u; nx = cnt > 0u ? cnt : 1u;
}
__device__ __forceinline__ void xcd_barrier(const XcdBarrier& b) {
    asm volatile("s_waitcnt vmcnt(0)" ::: "memory");
    __syncthreads();
    if (threadIdx.x == 0) {
        unsigned* bar = b.bar;
        __builtin_amdgcn_s_waitcnt(0);
        unsigned nloc = b.st[0], nx = b.st[1];
        if (nloc == 0u) { xcd_barrier_complete(bar, b.x, nloc, nx); b.st[0] = nloc; b.st[1] = nx; }
        const unsigned old = xb_add(&bar[XB_XSUB(b.x)], 1u);
        const unsigned gen = old / nloc;
        if (old + 1u == (gen + 1u) * nloc) {
            __builtin_amdgcn_fence(__ATOMIC_RELEASE, "agent");
            asm volatile("s_waitcnt vmcnt(0)" ::: "memory");
            const unsigned og = xb_add(&bar[XB_TOP], 1u);
            const unsigned tg = og / nx;
            if (og + 1u == (tg + 1u) * nx) xb_add(&bar[XB_TOPGEN], 1u);
            else XB_SPIN(xb_ld(&bar[XB_TOPGEN]) == tg, bar);
            __builtin_amdgcn_fence(__ATOMIC_ACQUIRE, "agent");
            xb_add(&bar[XB_XGEN(b.x)], 1u);
            asm volatile("s_waitcnt vmcnt(0)" ::: "memory");
        } else {
            XB_SPIN(xb_ld(&bar[XB_XGEN(b.x)]) == gen, bar);
            __builtin_amdgcn_fence(__ATOMIC_ACQUIRE, "agent");
            asm volatile("s_waitcnt vmcnt(0)" ::: "memory");
        }
    }
    __syncthreads();
}

namespace pg8 {
constexpr int BM = 256, BK = 64, HALF = 128, HTB = HALF * BK * 2, STAGE_BYTES = 8 * HTB, NXCD = 8, WGM = 8;
__host__ __device__ __forceinline__ int lds_byte(int r, int c) { const int st = (r >> 4) * 2 + (c >> 5), rr = r & 15, cc = c & 31, ob = rr * 64 + cc * 2; return st * 1024 + (ob ^ (((ob >> 9) & 1) << 5)); }
__host__ __device__ __forceinline__ void stage_rc(int b, int& R, int& C) { const int st = b / 1024, sb = b % 1024, swz = sb ^ (((sb >> 9) & 1) << 5); R = (st >> 1) * 16 + swz / 64; C = (st & 1) * 32 + (swz % 64) / 2; }
__host__ __device__ __forceinline__ int perm32(int rho) { const int n = rho >> 4, i = rho & 15; return 8 * (i >> 2) + 4 * n + (i & 3); }

struct Unit { int pm, pn, e, slot; };

template <class Epi, class Prob, bool ALIGN_EPI, bool FP8>
__device__ __forceinline__ void gemm_phase(LAS unsigned char* lds, const Prob& P, const Epi& E) {
    const int tid = threadIdx.x, wid = __builtin_amdgcn_readfirstlane(tid >> 6), lane = tid & 63, wr = wid >> 2, wc = wid & 3, fr = lane & 15, fq = lane >> 4;
    const int rowb = P.rowb, nt = rowb / 128;
    int Rs[2], Cs[2]; unsigned voffB[2];
#pragma unroll
    for (int i = 0; i < 2; ++i) { int R, C; stage_rc(tid * 16 + i * 8192, R, C); const int Rb = Epi::PERM ? ((R & ~31) + perm32(R & 31)) : R;
        Rs[i] = R; Cs[i] = C * 2; voffB[i] = (unsigned)(Rb * rowb + C * 2); }
    const size_t kstep = (size_t)(BK * 2);
    const size_t bhalf = P.b_half;
    const unsigned ldsw = (unsigned)wid * 1024u;
    const int aoff = lds_byte(wr * 64 + fr, fq * 8), boff = lds_byte(wc * 32 + fr, fq * 8);
#define PG8_SA(b, h) (((b) * 2 + (h)) * HTB)
#define PG8_SB(b, h) ((4 + (b) * 2 + (h)) * HTB)
#define PG8_STAGE_B(bufoff, gbase) do { _Pragma("unroll") for (int _i = 0; _i < 2; ++_i) \
        __builtin_amdgcn_global_load_lds((const unsigned*)((const char*)(gbase) + voffB[_i]), (LAS unsigned*)(lds + (bufoff) + ldsw + _i * 8192), 16, 0, 0); } while (0)
#define PG8_STAGE_A(bufoff, kb, o0, o1) do { \
        __builtin_amdgcn_global_load_lds((const unsigned*)(P.A + (size_t)(o0) + (kb)), (LAS unsigned*)(lds + (bufoff) + ldsw), 16, 0, 0); \
        __builtin_amdgcn_global_load_lds((const unsigned*)(P.A + (size_t)(o1) + (kb)), (LAS unsigned*)(lds + (bufoff) + ldsw + 8192), 16, 0, 0); } while (0)
#define PG8_LDA(dst, b, h) do { _Pragma("unroll") for (int m = 0; m < 4; ++m) _Pragma("unroll") for (int k = 0; k < 2; ++k) dst[m][k] = *(const LAS bf16x8*)(lds + PG8_SA(b, h) + aoff + m * 2048 + k * 1024); } while (0)
#define PG8_LDB(dst, b, h) do { _Pragma("unroll") for (int n = 0; n < 2; ++n) _Pragma("unroll") for (int k = 0; k < 2; ++k) dst[n][k] = *(const LAS bf16x8*)(lds + PG8_SB(b, h) + boff + n * 2048 + k * 1024); } while (0)
#define PG8_MMA(ai, bj, At, Bt) do { __builtin_amdgcn_s_setprio(1); _Pragma("unroll") for (int m = 0; m < 4; ++m) _Pragma("unroll") for (int n = 0; n < 2; ++n) { \
        if constexpr (FP8) { const i32x8 fb_ = __builtin_shufflevector(__builtin_bit_cast(i32x4, Bt[n][0]), __builtin_bit_cast(i32x4, Bt[n][1]), 0, 1, 2, 3, 4, 5, 6, 7); \
            const i32x8 fa_ = __builtin_shufflevector(__builtin_bit_cast(i32x4, At[m][0]), __builtin_bit_cast(i32x4, At[m][1]), 0, 1, 2, 3, 4, 5, 6, 7); \
            acc[ai][bj][m][n] = __builtin_amdgcn_mfma_scale_f32_16x16x128_f8f6f4(fb_, fa_, acc[ai][bj][m][n], 0, 0, 0, 0, 0, 0); } \
        else { _Pragma("unroll") for (int k = 0; k < 2; ++k) acc[ai][bj][m][n] = __builtin_amdgcn_mfma_f32_16x16x32_bf16(Bt[n][k], At[m][k], acc[ai][bj][m][n], 0, 0, 0); } } \
        __builtin_amdgcn_s_setprio(0); } while (0)
#define PG8_WAIT_V(n) asm volatile("s_waitcnt vmcnt(" #n ")" ::: "memory")
#define PG8_WAIT_L(n) asm volatile("s_waitcnt lgkmcnt(" #n ")" ::: "memory")
#define PG8_BAR __builtin_amdgcn_s_barrier()
#define PG8_SCHED __builtin_amdgcn_sched_barrier(0)
    Unit cur, nxt; int ui = 0;
    if (!P.next(0, cur)) return;
    f32x4 acc[2][2][4][2];
#pragma unroll
    for (int a = 0; a < 2; ++a)
#pragma unroll
        for (int b = 0; b < 2; ++b)
#pragma unroll
            for (int m = 0; m < 4; ++m)
#pragma unroll
                for (int n = 0; n < 2; ++n) acc[a][b][m][n] = (f32x4){0.f, 0.f, 0.f, 0.f};
    bf16x8 At[4][2], B0[2][2], B1[2][2];
    unsigned c00 = P.a_off(cur, Rs[0], Cs[0]), c01 = P.a_off(cur, Rs[1], Cs[1]), c10 = P.a_off(cur, HALF + Rs[0], Cs[0]), c11 = P.a_off(cur, HALF + Rs[1], Cs[1]);
    const char* cB = P.b_base(cur);
    PG8_STAGE_B(PG8_SB(0, 0), cB); PG8_STAGE_B(PG8_SB(0, 1), cB + bhalf); PG8_STAGE_A(PG8_SA(0, 0), 0, c00, c01); PG8_STAGE_A(PG8_SA(0, 1), 0, c10, c11);
    if (wr == 1) PG8_BAR;
    PG8_WAIT_V(2); PG8_BAR;
    PG8_STAGE_B(PG8_SB(1, 0), cB + kstep); PG8_STAGE_A(PG8_SA(1, 0), kstep, c00, c01); PG8_STAGE_B(PG8_SB(1, 1), cB + bhalf + kstep);
    PG8_WAIT_V(6); PG8_BAR;
    for (;;) {
        const bool has_next = P.next(ui + 1, nxt);
        const char* nB = has_next ? P.b_base(nxt) : cB;
        for (int t = 0; t < nt; t += 2) {
            const bool last = (t == nt - 2);
            const size_t k1 = (size_t)(t + 1) * kstep;
            const size_t k2 = last ? 0 : (size_t)(t + 2) * kstep, k3 = k2 + kstep;
            const char* b2 = last ? nB : cB + (size_t)(t + 2) * kstep; const char* b3 = b2 + kstep;
            if (last && has_next) { c00 = P.a_off(nxt, Rs[0], Cs[0]); c01 = P.a_off(nxt, Rs[1], Cs[1]); }
            PG8_LDB(B0, 0, 0); PG8_LDB(B1, 0, 1); PG8_SCHED; PG8_LDA(At, 0, 0); PG8_STAGE_A(PG8_SA(1, 1), k1, c10, c11);
            PG8_WAIT_V(8); PG8_WAIT_L(0); PG8_BAR; PG8_MMA(0, 0, At, B0); PG8_MMA(0, 1, At, B1); PG8_BAR; PG8_SCHED;
            if (last && has_next) { c10 = P.a_off(nxt, HALF + Rs[0], Cs[0]); c11 = P.a_off(nxt, HALF + Rs[1], Cs[1]); }
            PG8_LDA(At, 0, 1); PG8_STAGE_B(PG8_SB(0, 0), b2); PG8_STAGE_B(PG8_SB(0, 1), b2 + bhalf); PG8_STAGE_A(PG8_SA(0, 0), k2, c00, c01);
            PG8_WAIT_V(8); PG8_WAIT_L(0); PG8_BAR; PG8_MMA(1, 0, At, B0); PG8_MMA(1, 1, At, B1); PG8_BAR; PG8_SCHED;
            PG8_LDB(B0, 1, 0); PG8_LDB(B1, 1, 1); PG8_SCHED; PG8_LDA(At, 1, 0); PG8_STAGE_A(PG8_SA(0, 1), k2, c10, c11);
            PG8_WAIT_V(8); PG8_WAIT_L(0); PG8_BAR; PG8_MMA(0, 0, At, B0); PG8_MMA(0, 1, At, B1); PG8_BAR; PG8_SCHED;
            PG8_LDA(At, 1, 1); PG8_STAGE_B(PG8_SB(1, 0), b3); PG8_STAGE_B(PG8_SB(1, 1), b3 + bhalf); PG8_STAGE_A(PG8_SA(1, 0), k3, c00, c01);
            PG8_WAIT_V(8); PG8_WAIT_L(0); PG8_BAR; PG8_MMA(1, 0, At, B0); PG8_MMA(1, 1, At, B1); PG8_BAR; PG8_SCHED;
        }
        if constexpr (ALIGN_EPI) { if (wr == 0) PG8_BAR; }
        E(acc, cur, wr, wc, fr, fq);
#if defined(MK_DOUBLE)
        if constexpr (FP8) { if ((MK_DOUBLE >> 12) & 1) { asm volatile("" ::: "memory"); E(acc, cur, wr, wc, fr, fq); } }
#endif
        if (!has_next) break;
#pragma unroll
        for (int a = 0; a < 2; ++a)
#pragma unroll
            for (int b = 0; b < 2; ++b)
#pragma unroll
                for (int m = 0; m < 4; ++m)
#pragma unroll
                    for (int n = 0; n < 2; ++n) acc[a][b][m][n] = (f32x4){0.f, 0.f, 0.f, 0.f};
        cur = nxt; cB = nB; ++ui;
        if constexpr (ALIGN_EPI) { if (wr == 1) PG8_BAR; }
    }
    PG8_WAIT_V(0);
    if constexpr (!ALIGN_EPI) { if (wr == 0) PG8_BAR; }
    PG8_BAR;
#undef PG8_SA
#undef PG8_SB
#undef PG8_STAGE_A
#undef PG8_STAGE_B
#undef PG8_LDA
#undef PG8_LDB
#undef PG8_MMA
#undef PG8_WAIT_V
#undef PG8_WAIT_L
#undef PG8_BAR
#undef PG8_SCHED
}

__device__ __forceinline__ bool static_order(int nM, int nN, int G, int c, int i, int& pm, int& pn) {
    const int nwg = nM * nN; const long L = (long)i * G + c; if (L >= nwg) return false;
    int wgid = (int)L; { const int q = nwg / NXCD, r = nwg % NXCD, xcd = wgid % NXCD, off = wgid / NXCD; wgid = (xcd < r ? xcd * (q + 1) : r * (q + 1) + (xcd - r) * q) + off; }
    const int nig = WGM * nN, gid = wgid / nig, fm = gid * WGM, gsz = (nM - fm) < WGM ? (nM - fm) : WGM;
    pm = fm + ((wgid % nig) % gsz); pn = (wgid % nig) / gsz; return true;
}
struct DenseProb {
    const char* A; const char* Bt; int rowb, nM, nN, G, c; size_t b_half;
    __device__ __forceinline__ bool next(int i, Unit& u) const { u.e = 0; u.slot = i; return static_order(nM, nN, G, c, i, u.pm, u.pn); }
    __device__ __forceinline__ unsigned a_off(const Unit& u, int row, int colb) const { return (unsigned)((u.pm * BM + row) * rowb + colb); }
    __device__ __forceinline__ const char* b_base(const Unit& u) const { return Bt + (size_t)u.pn * BM * rowb; }
};
template <bool GATHER> struct MoeProb {
    const char* A; const char* Bt; int rowb, nN, G, c; size_t b_half; size_t b_expert; int b_tile_rows;
    const LAS int* tpre; const LAS int* tab;
    __device__ __forceinline__ int tp(int j) const { return __builtin_amdgcn_readfirstlane(tpre[j]); }
    __device__ __forceinline__ bool next(int i, Unit& u) const {
        const int total = tp(NE) * nN; const long L0 = (long)i * G + c; if (L0 >= total) return false;
        int L = (int)L0; { const int q = total / NXCD, r = total % NXCD, xcd = L % NXCD, off = L / NXCD; L = (xcd < r ? xcd * (q + 1) : r * (q + 1) + (xcd - r) * q) + off; }
        int e = 0;
#pragma unroll 1
        for (int j = 1; j < NE; ++j) e += (tp(j) * nN <= L) ? 1 : 0;
        const int first = tp(e) * nN, tiles = tp(e + 1) - tp(e), rem = L - first;
        u.e = e; u.pm = rem % tiles; u.pn = rem / tiles; u.slot = i; return true;
    }
    __device__ __forceinline__ unsigned a_off(const Unit& u, int row, int colb) const {
        if (GATHER) { const int idx = tab[u.slot * 256 + row]; const int tok = idx < 0 ? 0 : (idx >> 2); return (unsigned)(tok * rowb + colb); }
        return (unsigned)(((tp(u.e) + u.pm) * BM + row) * rowb + colb);
    }
    __device__ __forceinline__ const char* b_base(const Unit& u) const { return Bt + (size_t)u.e * b_expert + (size_t)u.pn * b_tile_rows * rowb; }
};
}

using pg8::Unit;
typedef f32x4 AccT[2][2][4][2];

struct EpiQKVU {
    static constexpr bool PERM = true;
    unsigned char* ws;
    __device__ __forceinline__ void operator()(const AccT& acc, const Unit& u, int wr, int wc, int fr, int fq) const {
        static_assert(WS_K - WS_Q == WS_V - WS_K, "Q, K, V equally spaced");
        const int t = (u.pn - 1) / 3;
        const size_t boff = (u.pn == 0) ? WS_U : (WS_Q + (size_t)t * (WS_K - WS_Q));
        bf16_t* base = (bf16_t*)(ws + boff);
        const int ldc = (u.pn == 0) ? PW : AW, colt = (u.pn == 0) ? 0 : ((u.pn - 1) % 3) * 256;
        const float sc = (u.pn >= 1 && u.pn <= 3) ? QSCALE : 1.f;
        const int row0 = u.pm * 256 + wr * 64 + fr, col0 = colt + wc * 32 + 8 * fq;
#pragma unroll
        for (int ai = 0; ai < 2; ++ai)
#pragma unroll
            for (int m = 0; m < 4; ++m) { bf16_t* rowp = base + (size_t)(row0 + ai * 128 + m * 16) * ldc + col0;
#pragma unroll
                for (int bj = 0; bj < 2; ++bj) { const f32x4 v0 = acc[ai][bj][m][0] * sc, v1 = acc[ai][bj][m][1] * sc;
                    u32x4 w; w.x = cvt_pk_bf16(v0[0], v0[1]); w.y = cvt_pk_bf16(v0[2], v0[3]); w.z = cvt_pk_bf16(v1[0], v1[1]); w.w = cvt_pk_bf16(v1[2], v1[3]);
                    *(u32x4*)(rowp + bj * 128) = w; } }
    }
};
struct EpiResF32 {
    static constexpr bool PERM = false;
    const float* X; float* O;
    __device__ __forceinline__ void operator()(const AccT& acc, const Unit& u, int wr, int wc, int fr, int fq) const {
        const int row0 = u.pm * 256 + wr * 64 + fr, col0 = u.pn * 256 + wc * 32 + 4 * fq;
#pragma unroll
        for (int ai = 0; ai < 2; ++ai)
#pragma unroll
            for (int m = 0; m < 4; ++m) { const size_t off = (size_t)(row0 + ai * 128 + m * 16) * D + col0;
#pragma unroll
                for (int bj = 0; bj < 2; ++bj)
#pragma unroll
                    for (int n = 0; n < 2; ++n) { const f32x4 r = __builtin_nontemporal_load((const f32x4*)(X + off + bj * 128 + n * 16)); *(f32x4*)(O + off + bj * 128 + n * 16) = acc[ai][bj][m][n] + r; } }
    }
};
__device__ __forceinline__ float swiglu1(float g, float u) {
    g = fminf(g, 7.0f); u = fminf(fmaxf(u, -7.0f), 7.0f);
    const float s = __builtin_amdgcn_rcpf(1.0f + __builtin_amdgcn_exp2f(g * (-1.702f * LOG2E)));
    return (u + 1.0f) * (g * s);
}
struct EpiGateUp {
    static constexpr bool PERM = true;
    unsigned char* ACT; const LAS int* tpre; const LAS float* tabf; const LAS float* tabb;
    __device__ __forceinline__ void operator()(const AccT& acc, const Unit& u, int wr, int wc, int fr, int fq) const {
        const int cl = wc * 32 + 8 * fq, colA = u.pn * 128 + cl;
        const LAS float* bp = tabb + u.slot * 256 + cl;
        const f32x4 bg0 = *(const LAS f32x4*)(bp), bg1 = *(const LAS f32x4*)(bp + 4), bu0 = *(const LAS f32x4*)(bp + 128), bu1 = *(const LAS f32x4*)(bp + 132);
        const int srow0 = (__builtin_amdgcn_readfirstlane(tpre[u.e]) + u.pm) * 256;
#pragma unroll
        for (int ai = 0; ai < 2; ++ai)
#pragma unroll
            for (int m = 0; m < 4; ++m) { const int r = ai * 128 + wr * 64 + m * 16 + fr; const float rs = tabf[u.slot * 256 + r];
                const f32x4 g0 = acc[ai][0][m][0] * rs + bg0, g1 = acc[ai][0][m][1] * rs + bg1, u0 = acc[ai][1][m][0] * rs + bu0, u1 = acc[ai][1][m][1] * rs + bu1;
                u32x2 w; w.x = cvt4_fp8(swiglu1(g0[0], u0[0]) * ASCALE, swiglu1(g0[1], u0[1]) * ASCALE, swiglu1(g0[2], u0[2]) * ASCALE, swiglu1(g0[3], u0[3]) * ASCALE);
                w.y = cvt4_fp8(swiglu1(g1[0], u1[0]) * ASCALE, swiglu1(g1[1], u1[1]) * ASCALE, swiglu1(g1[2], u1[2]) * ASCALE, swiglu1(g1[3], u1[3]) * ASCALE);
                *(u32x2*)(ACT + (size_t)(srow0 + r) * DFF + colA) = w; }
    }
};
struct EpiDown {
    static constexpr bool PERM = true;
    unsigned char* Y; const LAS int* tab; const LAS float* tabf; const LAS float* tabb;
    __device__ __forceinline__ void operator()(const AccT& acc, const Unit& u, int wr, int wc, int fr, int fq) const {
        const int cl = wc * 32 + 8 * fq, col0 = u.pn * 256 + cl;
        const LAS float* bp = tabb + u.slot * 256 + cl;
        f32x4 bv[2][2];
#pragma unroll
        for (int bj = 0; bj < 2; ++bj) { bv[bj][0] = *(const LAS f32x4*)(bp + bj * 128); bv[bj][1] = *(const LAS f32x4*)(bp + bj * 128 + 4); }
#pragma unroll
        for (int ai = 0; ai < 2; ++ai)
#pragma unroll
            for (int m = 0; m < 4; ++m) { const int r = ai * 128 + wr * 64 + m * 16 + fr; const int idx = tab[u.slot * 256 + r];
                if (idx >= 0) { const float gv = tabf[u.slot * 256 + r] * YSCALE; unsigned char* rowp = Y + (size_t)idx * D + col0;
#pragma unroll
                    for (int bj = 0; bj < 2; ++bj) { const f32x4 v0 = (acc[ai][bj][m][0] * (1.0f / (ASCALE * WSCALE)) + bv[bj][0]) * gv, v1 = (acc[ai][bj][m][1] * (1.0f / (ASCALE * WSCALE)) + bv[bj][1]) * gv;
                        u32x2 w; w.x = cvt4_fp8(v0[0], v0[1], v0[2], v0[3]); w.y = cvt4_fp8(v1[0], v1[1], v1[2], v1[3]);
                        *(u32x2*)(rowp + bj * 128) = w; } } }
    }
};

__device__ __forceinline__ void tr_item(const float* __restrict__ W, int K, int N, bf16_t* __restrict__ WT, LAS float* scr, int kb, int nb, int lane) {
    const int k0 = kb * 64, n0 = nb * 64;
    const float* src = W + (size_t)(k0 + (lane >> 4)) * N + n0 + (lane & 15) * 4;
    f32x4 v[16];
#pragma unroll
    for (int i = 0; i < 16; ++i) v[i] = *(const f32x4*)(src + (size_t)(4 * i) * N);
#pragma unroll
    for (int i = 0; i < 16; ++i) { LAS float* d = scr + (4 * i + (lane >> 4)) * 65 + (lane & 15) * 4; d[0] = v[i][0]; d[1] = v[i][1]; d[2] = v[i][2]; d[3] = v[i][3]; }
    LDS_WAIT();
    const int c = lane & 7;
#pragma unroll
    for (int j = 0; j < 8; ++j) { const int n = 8 * j + (lane >> 3); const LAS float* s = scr + (8 * c) * 65 + n;
        u32x4 o; o.x = cvt_pk_bf16(s[0], s[65]); o.y = cvt_pk_bf16(s[130], s[195]); o.z = cvt_pk_bf16(s[260], s[325]); o.w = cvt_pk_bf16(s[390], s[455]);
        *(u32x4*)(WT + (size_t)(n0 + n) * K + k0 + 8 * c) = o; }
    LDS_WAIT();
}
struct Item8 { const float* src; unsigned char* dst; int N; };
__device__ __forceinline__ void chunk8_load(const Item8& d, int ch, f32x4 (&v)[16], int lane) {
    const float* base = d.src + (size_t)(32 * ch + 4 * (lane >> 5)) * d.N + (lane & 31) * 4;
#pragma unroll
    for (int sl = 0; sl < 4; ++sl)
#pragma unroll
        for (int j = 0; j < 4; ++j) v[4 * sl + j] = __builtin_nontemporal_load((const f32x4*)(base + (size_t)(8 * sl + j) * d.N));
}
__device__ __forceinline__ void chunk8_cvt(int ch, const f32x4 (&v)[16], LAS unsigned* scr, int lane) {
    const int nq = lane & 31, kq0 = lane >> 5, sw = (nq & 7) << 2;
#pragma unroll
    for (int sl = 0; sl < 4; ++sl) { const int kw = 8 * ch + kq0 + 2 * sl;
#pragma unroll
        for (int i = 0; i < 4; ++i) scr[(4 * nq + i) * 32 + (kw ^ sw)] = cvt4_fp8(v[4 * sl][i] * WSCALE, v[4 * sl + 1][i] * WSCALE, v[4 * sl + 2][i] * WSCALE, v[4 * sl + 3][i] * WSCALE); }
}
__device__ __forceinline__ void item8_flush(const Item8& d, const LAS unsigned* scr, int lane) {
    LDS_WAIT();
    const int c16 = lane & 7;
#pragma unroll
    for (int jj = 0; jj < 16; ++jj) { const int n = (lane >> 3) + 8 * jj;
        const u32x4 o = *(const LAS u32x4*)(scr + n * 32 + ((c16 ^ ((n >> 2) & 7)) << 2));
        __builtin_nontemporal_store(o, (u32x4*)(d.dst + (size_t)n * D + 16 * c16)); }
    LDS_WAIT();
}
__device__ __forceinline__ int t5_bucket(int dist) {
    if (dist < 16) return dist;
    const int large = 16 + (int)(logf((float)dist / 16.0f) / 4.852030263919617f * 16.0f);
    return large < 31 ? large : 31;
}
struct In { const float *x, *norm1_g, *w_in, *pool_w, *pool_scale, *rel_bias, *w_out, *norm2_g, *router_w, *router_b, *w_gate_up, *b_gate_up, *w_down, *b_down, *final_g; };

constexpr int N8_ALL = NE * 128 + NE * 64, N8_P0 = 4096;
__device__ __forceinline__ void convert8_items(LAS unsigned char* lds, const In& in, unsigned char* ws, int first, int nwaves, int lo, int hi) {
    const int lane = threadIdx.x & 63, wave = __builtin_amdgcn_readfirstlane((int)threadIdx.x >> 6);
    constexpr int IG = 8 * 16, ID = 8 * 8;
    auto desc = [&](int r) -> Item8 { Item8 d;
        if (r < NE * IG) { const int e = r / IG, q = r % IG, kb = q / 16, nb = q % 16;
            d.src = in.w_gate_up + (size_t)e * D * 2 * DFF + (size_t)(kb * 128) * (2 * DFF) + nb * 128; d.N = 2 * DFF; d.dst = ws + WS_WGU + (size_t)e * 2 * DFF * D + (size_t)(nb * 128) * D + kb * 128; }
        else { const int r2 = r - NE * IG, e = r2 / ID, q = r2 % ID, kb = q / 8, nb = q % 8;
            d.src = in.w_down + (size_t)e * DFF * D + (size_t)(kb * 128) * D + nb * 128; d.N = D; d.dst = ws + WS_WD + (size_t)e * D * DFF + (size_t)(nb * 128) * DFF + kb * 128; }
        return d; };
    LAS unsigned* scr8 = (LAS unsigned*)(lds + wave * 16384);
    f32x4 va[16], vb[16];
    const int it0 = lo + first;
    if (it0 < hi) { const Item8 d0 = desc(it0); chunk8_load(d0, 0, va, lane); }
    for (int it = it0; it < hi; it += nwaves) {
        const Item8 d = desc(it); const bool more = (it + nwaves) < hi;
        chunk8_load(d, 1, vb, lane); chunk8_cvt(0, va, scr8, lane);
        chunk8_load(d, 2, va, lane); chunk8_cvt(1, vb, scr8, lane);
        chunk8_load(d, 3, vb, lane); chunk8_cvt(2, va, scr8, lane);
        if (more) { const Item8 dn = desc(it + nwaves); chunk8_load(dn, 0, va, lane); }
        chunk8_cvt(3, vb, scr8, lane);
        item8_flush(d, scr8, lane);
    }
}
__device__ __forceinline__ void p0_prologue(LAS unsigned char* lds, const In& in, unsigned char* ws, int G, int c) {
    const int tid = threadIdx.x, lane = tid & 63, wave = __builtin_amdgcn_readfirstlane(tid >> 6);
    const int gw = c * 8 + wave, NGW = G * 8;
    LAS float* scr = (LAS float*)(lds + wave * 16640);
    constexpr int I_IN = 16 * 40, I_OUT = 16 * 16, I_GU1 = 16 * 32, I_D1 = 16 * 16;
    for (int it = gw; it < I_IN + I_OUT; it += NGW) {
        if (it < I_IN) tr_item(in.w_in, D, NPROJ, (bf16_t*)(ws + WS_WIN), scr, it / 40, it % 40, lane);
        else { const int r = it - I_IN; tr_item(in.w_out, D, D, (bf16_t*)(ws + WS_WOUT), scr, r / 16, r % 16, lane); }
    }
#ifndef MK_DOUBLE
#define MK_DOUBLE 0
#endif
    for (int rep8_ = 0; rep8_ < (((MK_DOUBLE >> 10) & 1) ? 2 : 1); ++rep8_) convert8_items(lds, in, ws, gw, NGW, 0, N8_P0);
    for (int repr_ = 0; repr_ < (((MK_DOUBLE >> 11) & 1) ? 2 : 1); ++repr_) {
        f32x4 gv[4];
#pragma unroll
        for (int j = 0; j < 4; ++j) gv[j] = *(const f32x4*)(in.norm1_g + 4 * lane + 256 * j);
        bf16_t* H = (bf16_t*)(ws + WS_H);
        f32x4 v[4], vn[4];
        int m = gw;
        if (m < S) {
#pragma unroll
            for (int j = 0; j < 4; ++j) v[j] = __builtin_nontemporal_load((const f32x4*)(in.x + (size_t)m * D + 4 * lane + 256 * j)); }
        for (; m < S; m += NGW) {
            const int mn = m + NGW;
            if (mn < S) {
#pragma unroll
                for (int j = 0; j < 4; ++j) vn[j] = __builtin_nontemporal_load((const f32x4*)(in.x + (size_t)mn * D + 4 * lane + 256 * j)); }
            float s = 0.f;
#pragma unroll
            for (int j = 0; j < 4; ++j) s += (v[j][0] * v[j][0] + v[j][1] * v[j][1]) + (v[j][2] * v[j][2] + v[j][3] * v[j][3]);
            const float rstd = rsqrtf(wave_sum(s) * (1.0f / D) + RMS_EPS);
#pragma unroll
            for (int j = 0; j < 4; ++j) { const f32x4 o = v[j] * rstd * gv[j]; u32x2 w; w.x = cvt_pk_bf16(o[0], o[1]); w.y = cvt_pk_bf16(o[2], o[3]); *(u32x2*)(H + (size_t)m * D + 4 * lane + 256 * j) = w; }
#pragma unroll
            for (int j = 0; j < 4; ++j) v[j] = vn[j];
        }
    }
    const int gt = c * 512 + tid, NGT = G * 512;
    { float* GWT = (float*)(ws + WS_GWT); for (int i = gt; i < NE * D; i += NGT) { const int e = i >> 10, k = i & 1023; GWT[i] = in.norm2_g[k] * in.router_w[k * NE + e]; } }
    { float* BT = (float*)(ws + WS_BT); for (int i = gt; i < 36 * BT_N; i += NGT) { const int bh = i / BT_N, j = i % BT_N, b = bh / NH, h = bh % NH, dil = (b == 0) ? 1 : (b == 1 ? 4 : 16), d = j - BT_OFF;
        BT[i] = (d >= 0 && d <= 128) ? in.rel_bias[t5_bucket(d * dil) * NH + h] * LOG2E : NEGBIG; } }
    { bf16_t* PWT = (bf16_t*)(ws + WS_PWT); for (int i = gt; i < 4 * 64 * 64; i += NGT) { const int g = i >> 12, d = (i >> 6) & 63, cc = i & 63; PWT[i] = (bf16_t)(cvt_pk_bf16(in.pool_w[g * 4096 + cc * 64 + d], 0.f) & 0xffffu); } }
}

__device__ __forceinline__ s16x4 lds_tr16(const LAS unsigned char* p) { typedef short v4i16_t __attribute__((ext_vector_type(4))); return __builtin_bit_cast(s16x4, __builtin_amdgcn_ds_read_tr16_b64_v4i16((LAS v4i16_t*)p)); }
constexpr int ATT_UNITS = 3 * NH * 64, KV_PITCH = 144, KV_ROWS = 384, ATT_VOFF = KV_ROWS * KV_PITCH, ATT_TOFF = 2 * KV_ROWS * KV_PITCH, ATT_NEGOFF = ATT_TOFF + BT_N * 4;
__device__ __forceinline__ void attn_decode(int uid, int& b, int& h, int& r, int& j, int& dil) {
    const int bh = uid >> 6, x = uid & 63; b = bh / NH; h = bh % NH; dil = (b == 0) ? 1 : (b == 1 ? 4 : 16);
    const int nb = 64 / dil; r = x / nb; j = x % nb;
}
__device__ __forceinline__ void attn_phase(LAS unsigned char* lds, const bf16_t* __restrict__ Qg, const bf16_t* __restrict__ Kg, const bf16_t* __restrict__ Vg, const float* __restrict__ BT,
                                           bf16_t* __restrict__ OP, float* __restrict__ LSE, int G, int c) {
    const int tid = threadIdx.x, lane = tid & 63, w = __builtin_amdgcn_readfirstlane(tid >> 6), ql = lane & 15, g = lane >> 4;
    LAS unsigned char* Ks = lds; LAS unsigned char* Vs = lds + ATT_VOFF; LAS float* Tb = (LAS float*)(lds + ATT_TOFF); LAS float* Tneg = (LAS float*)(lds + ATT_NEGOFF);
    if (tid < 16) Tneg[tid] = NEGBIG;
    u32x4 kpre[6], vpre[6]; bf16x8 qa0, qa1, qb0, qb1; float tpre = 0.f;
#define ATT_PREFETCH(uid_) do { int b_, h_, r_, j_, dil_; attn_decode((uid_), b_, h_, r_, j_, dil_); \
        _Pragma("unroll") for (int cc = 0; cc < 6; ++cc) { const int id = tid + 512 * cc, row = id >> 3, ch = id & 7; int mm = 256 * j_ - 128 + row; if (mm < 0) mm += 128; \
            const size_t off = (size_t)(r_ + dil_ * mm) * AW + h_ * HD + ch * 8; kpre[cc] = *(const u32x4*)(Kg + off); vpre[cc] = *(const u32x4*)(Vg + off); } \
        { const size_t qo = (size_t)(r_ + dil_ * (256 * j_ + 32 * w + ql)) * AW + h_ * HD + 8 * g; const size_t qs = (size_t)16 * dil_ * AW; \
          qa0 = *(const bf16x8*)(Qg + qo); qa1 = *(const bf16x8*)(Qg + qo + 32); qb0 = *(const bf16x8*)(Qg + qo + qs); qb1 = *(const bf16x8*)(Qg + qo + qs + 32); } \
        if (tid < BT_N) tpre = BT[(b_ * NH + h_) * BT_N + tid]; } while (0)
#ifndef ATT_SYNC_LOAD
    if (c < ATT_UNITS) ATT_PREFETCH(c);
#endif
    for (int uid = c; uid < ATT_UNITS; uid += G) {
        int b, h, r, j, dil; attn_decode(uid, b, h, r, j, dil);
#ifdef ATT_SYNC_LOAD
        ATT_PREFETCH(uid);
#endif
#pragma unroll
        for (int cc = 0; cc < 6; ++cc) { const int id = tid + 512 * cc, row = id >> 3, ch = id & 7; *(LAS u32x4*)(Ks + row * KV_PITCH + ch * 16) = kpre[cc]; *(LAS u32x4*)(Vs + row * KV_PITCH + ch * 16) = vpre[cc]; }
        if (tid < BT_N) Tb[tid] = tpre;
        const bf16x8 fa0 = qa0, fa1 = qa1, fb0 = qb0, fb1 = qb1;
        __syncthreads();
#ifndef ATT_SYNC_LOAD
        if (uid + G < ATT_UNITS) ATT_PREFETCH(uid + G);
#endif
        const int kkmin = (j == 0) ? 128 : 0;
        const LAS unsigned char* kb = Ks + (32 * w + ql) * KV_PITCH + g * 16;
        const LAS float* Tq = Tb + (ql + 272 - 4 * g - 3);
        const f32x4 zero4 = (f32x4){0.f, 0.f, 0.f, 0.f};
        f32x4 sA[9], sB[9];
#pragma unroll
        for (int i = 0; i < 10; ++i) {
            const bf16x8 kf0 = *(const LAS bf16x8*)(kb + i * (16 * KV_PITCH)), kf1 = *(const LAS bf16x8*)(kb + i * (16 * KV_PITCH) + 64);
            const bool msk = (32 * w + 16 * i) < kkmin;
            if (i <= 8) { f32x4 st = __builtin_amdgcn_mfma_f32_16x16x32_bf16(kf0, fa0, zero4, 0, 0, 0); st = __builtin_amdgcn_mfma_f32_16x16x32_bf16(kf1, fa1, st, 0, 0, 0);
                const LAS float* tp = msk ? Tneg : (Tq - 16 * i); sA[i] = (f32x4){st[0] + tp[3], st[1] + tp[2], st[2] + tp[1], st[3] + tp[0]}; }
            if (i >= 1) { f32x4 st = __builtin_amdgcn_mfma_f32_16x16x32_bf16(kf0, fb0, zero4, 0, 0, 0); st = __builtin_amdgcn_mfma_f32_16x16x32_bf16(kf1, fb1, st, 0, 0, 0);
                const LAS float* tp = msk ? Tneg : (Tq - 16 * (i - 1)); sB[i - 1] = (f32x4){st[0] + tp[3], st[1] + tp[2], st[2] + tp[1], st[3] + tp[0]}; }
        }
        float mA = NEGBIG, mB = NEGBIG;
#pragma unroll
        for (int i = 0; i < 9; ++i) { mA = fmaxf(mA, fmaxf(fmaxf(sA[i][0], sA[i][1]), fmaxf(sA[i][2], sA[i][3]))); mB = fmaxf(mB, fmaxf(fmaxf(sB[i][0], sB[i][1]), fmaxf(sB[i][2], sB[i][3]))); }
        mA = fmaxf(mA, __shfl_xor(mA, 16)); mA = fmaxf(mA, __shfl_xor(mA, 32)); mB = fmaxf(mB, __shfl_xor(mB, 16)); mB = fmaxf(mB, __shfl_xor(mB, 32));
        f32x4 oA[4], oB[4];
#pragma unroll
        for (int dt = 0; dt < 4; ++dt) { oA[dt] = zero4; oB[dt] = zero4; }
        float lA = 0.f, lB = 0.f;
        const LAS unsigned char* vb = Vs + (32 * w + 4 * g + (ql >> 2)) * KV_PITCH + (ql & 3) * 8;
#pragma unroll
        for (int i = 0; i < 10; ++i) {
            const LAS unsigned char* vt = vb + i * (16 * KV_PITCH);
            const s16x4 v0 = lds_tr16(vt), v1 = lds_tr16(vt + 32), v2 = lds_tr16(vt + 64), v3 = lds_tr16(vt + 96);
            if (i <= 8) { const float p0 = __builtin_amdgcn_exp2f(sA[i][0] - mA), p1 = __builtin_amdgcn_exp2f(sA[i][1] - mA), p2 = __builtin_amdgcn_exp2f(sA[i][2] - mA), p3 = __builtin_amdgcn_exp2f(sA[i][3] - mA);
                lA += (p0 + p1) + (p2 + p3); u32x2 pw; pw.x = cvt_pk_bf16(p0, p1); pw.y = cvt_pk_bf16(p2, p3); const s16x4 pf = __builtin_bit_cast(s16x4, pw);
                oA[0] = __builtin_amdgcn_mfma_f32_16x16x16bf16_1k(v0, pf, oA[0], 0, 0, 0); oA[1] = __builtin_amdgcn_mfma_f32_16x16x16bf16_1k(v1, pf, oA[1], 0, 0, 0);
                oA[2] = __builtin_amdgcn_mfma_f32_16x16x16bf16_1k(v2, pf, oA[2], 0, 0, 0); oA[3] = __builtin_amdgcn_mfma_f32_16x16x16bf16_1k(v3, pf, oA[3], 0, 0, 0); }
            if (i >= 1) { const float p0 = __builtin_amdgcn_exp2f(sB[i - 1][0] - mB), p1 = __builtin_amdgcn_exp2f(sB[i - 1][1] - mB), p2 = __builtin_amdgcn_exp2f(sB[i - 1][2] - mB), p3 = __builtin_amdgcn_exp2f(sB[i - 1][3] - mB);
                lB += (p0 + p1) + (p2 + p3); u32x2 pw; pw.x = cvt_pk_bf16(p0, p1); pw.y = cvt_pk_bf16(p2, p3); const s16x4 pf = __builtin_bit_cast(s16x4, pw);
                oB[0] = __builtin_amdgcn_mfma_f32_16x16x16bf16_1k(v0, pf, oB[0], 0, 0, 0); oB[1] = __builtin_amdgcn_mfma_f32_16x16x16bf16_1k(v1, pf, oB[1], 0, 0, 0);
                oB[2] = __builtin_amdgcn_mfma_f32_16x16x16bf16_1k(v2, pf, oB[2], 0, 0, 0); oB[3] = __builtin_amdgcn_mfma_f32_16x16x16bf16_1k(v3, pf, oB[3], 0, 0, 0); }
        }
        lA += __shfl_xor(lA, 16); lA += __shfl_xor(lA, 32); lB += __shfl_xor(lB, 16); lB += __shfl_xor(lB, 32);
#ifdef ATT_EXP1
        lA = 1.0f; lB = 1.0f; mA = 0.f; mB = 0.f;
#pragma unroll
        for (int dt = 0; dt < 4; ++dt) { oA[dt] = zero4; oB[dt] = zero4; }
#endif
#ifdef ATT_EXP2
        lA = 1.0f; lB = 1.0f;
#pragma unroll
        for (int dt = 0; dt < 4; ++dt) { oA[dt] = zero4; oB[dt] = zero4; }
#endif
        const float iA = 1.0f / lA, iB = 1.0f / lB;
        const int posA = r + dil * (256 * j + 32 * w + ql), posB = posA + 16 * dil;
        bf16_t* dA = OP + ((size_t)b * S + posA) * AW + h * HD + 4 * g; bf16_t* dB = OP + ((size_t)b * S + posB) * AW + h * HD + 4 * g;
#pragma unroll
        for (int dt = 0; dt < 4; ++dt) { u32x2 t; t.x = cvt_pk_bf16(oA[dt][0] * iA, oA[dt][1] * iA); t.y = cvt_pk_bf16(oA[dt][2] * iA, oA[dt][3] * iA); *(u32x2*)(dA + 16 * dt) = t;
            u32x2 t2; t2.x = cvt_pk_bf16(oB[dt][0] * iB, oB[dt][1] * iB); t2.y = cvt_pk_bf16(oB[dt][2] * iB, oB[dt][3] * iB); *(u32x2*)(dB + 16 * dt) = t2; }
        if (g == 0) { LSE[((size_t)b * S + posA) * NH + h] = mA + __builtin_amdgcn_logf(lA); LSE[((size_t)b * S + posB) * NH + h] = mB + __builtin_amdgcn_logf(lB); }
        __syncthreads();
    }
#undef ATT_PREFETCH
}

__device__ __forceinline__ void pool_phase(LAS unsigned char* lds, const bf16_t* __restrict__ U, const bf16_t* __restrict__ PWT, const float* __restrict__ pool_scale, bf16_t* __restrict__ MIX, int G, int c) {
    const int tid = threadIdx.x, lane = tid & 63, w = __builtin_amdgcn_readfirstlane(tid >> 6), ql = lane & 15, g = lane >> 4;
    LAS unsigned char* Us = lds; LAS unsigned char* Pl = lds + 40960;
    for (int pu = c; pu < S / 64; pu += G) {
        const int t0 = pu * 64;
        for (int id = tid; id < 79 * 32; id += 512) { const int row = id >> 5, ch = id & 31, t = t0 - 15 + row;
            u32x4 v = (u32x4){0u, 0u, 0u, 0u}; if (t >= 0) v = *(const u32x4*)(U + (size_t)t * PW + ch * 8);
            *(LAS u32x4*)(Us + row * 512 + ch * 16) = v; }
        __syncthreads();
        { const int cch = tid & 255, th = tid >> 8, gg = cch >> 6, wn = 2 << gg, tl0 = 32 * th;
          const LAS bf16_t* up = (const LAS bf16_t*)Us + cch;
#define UAT(row) __uint_as_float(((unsigned)up[(row) * 256]) << 16)
          float sum = 0.f;
          for (int i = 0; i < wn; ++i) sum += UAT(tl0 + 15 - i);
          for (int tl = tl0; tl < tl0 + 32; ++tl) {
              if (tl > tl0) sum += UAT(tl + 15) - UAT(tl + 15 - wn);
              const int t = t0 + tl; const int cnt = (t + 1 < wn) ? (t + 1) : wn;
              const float val = sum / (float)cnt - UAT(tl + 15);
              ((LAS bf16_t*)(Pl + tl * 528))[cch] = (bf16_t)(cvt_pk_bf16(val, 0.f) & 0xffffu);
          }
#undef UAT
        }
        __syncthreads();
        { const int tt = w & 3, gp = w >> 2;
#pragma unroll
          for (int gi = 0; gi < 2; ++gi) { const int gg = 2 * gp + gi;
              const bf16x8 b0 = *(const LAS bf16x8*)(Pl + (16 * tt + ql) * 528 + (gg * 64 + 8 * g) * 2), b1 = *(const LAS bf16x8*)(Pl + (16 * tt + ql) * 528 + (gg * 64 + 32 + 8 * g) * 2);
#pragma unroll
              for (int nt = 0; nt < 4; ++nt) {
                  const bf16_t* ap = PWT + ((size_t)(gg * 64 + 16 * nt + ql) * 64 + 8 * g);
                  const bf16x8 a0 = *(const bf16x8*)(ap), a1 = *(const bf16x8*)(ap + 32);
                  f32x4 acc = __builtin_amdgcn_mfma_f32_16x16x32_bf16(a0, b0, (f32x4){0.f, 0.f, 0.f, 0.f}, 0, 0, 0);
                  acc = __builtin_amdgcn_mfma_f32_16x16x32_bf16(a1, b1, acc, 0, 0, 0);
                  const f32x4 ps = *(const f32x4*)(pool_scale + gg * 64 + 16 * nt + 4 * g);
                  u32x2 o; o.x = cvt_pk_bf16(acc[0] * ps[0], acc[1] * ps[1]); o.y = cvt_pk_bf16(acc[2] * ps[2], acc[3] * ps[3]);
                  *(u32x2*)(MIX + (size_t)(t0 + 16 * tt + ql) * D + gg * 64 + 16 * nt + 4 * g) = o;
              } }
        }
        __syncthreads();
    }
}

__device__ __forceinline__ void combine_phase(const bf16_t* __restrict__ OP, const float* __restrict__ LSE, bf16_t* __restrict__ MIX, int G, int c) {
    const int gt = c * 512 + threadIdx.x, NGT = G * 512;
    for (int id = gt; id < S * 96; id += NGT) {
        const int t = id / 96, rem = id % 96, h = rem >> 3, c8 = rem & 7;
        const float l0 = LSE[(size_t)t * NH + h], l1 = LSE[((size_t)S + t) * NH + h], l2 = LSE[((size_t)2 * S + t) * NH + h];
        const float mx = fmaxf(l0, fmaxf(l1, l2));
        float w0 = __builtin_amdgcn_exp2f(l0 - mx), w1 = __builtin_amdgcn_exp2f(l1 - mx), w2 = __builtin_amdgcn_exp2f(l2 - mx);
        const float inv = 1.0f / (w0 + w1 + w2); w0 *= inv; w1 *= inv; w2 *= inv;
        const size_t off = (size_t)t * AW + h * HD + c8 * 8;
        const u32x4 a = __builtin_nontemporal_load((const u32x4*)(OP + off)), b = __builtin_nontemporal_load((const u32x4*)(OP + (size_t)S * AW + off)), cc = __builtin_nontemporal_load((const u32x4*)(OP + (size_t)2 * S * AW + off));
        u32x4 o;
#pragma unroll
        for (int k = 0; k < 4; ++k) { const float lo = w0 * bf_lo(a[k]) + w1 * bf_lo(b[k]) + w2 * bf_lo(cc[k]), hi = w0 * bf_hi(a[k]) + w1 * bf_hi(b[k]) + w2 * bf_hi(cc[k]); o[k] = cvt_pk_bf16(lo, hi); }
        *(u32x4*)(MIX + (size_t)t * D + PW + h * HD + c8 * 8) = o;
    }
}

constexpr int GWB_PITCH = 2064;
constexpr int RT_GWL = NE * GWB_PITCH, RT_G2 = 2 * NE * GWB_PITCH, RT_LG = RT_G2 + 4096, RT_RS = RT_LG + 4 * 16 * 33 * 4, RT_CNT = RT_RS + 256, RT_PART = RT_CNT + 256, RT_END = RT_PART + 4 * 64 * 9 * 4;
static_assert(RT_END <= LDS_CTL, "router LDS map");
__device__ __forceinline__ void split_bf16(const f32x4& a0, const f32x4& a1, bf16x8& hi, bf16x8& lo) {
    u32x4 h, l;
    h.x = cvt_pk_bf16(a0[0], a0[1]); h.y = cvt_pk_bf16(a0[2], a0[3]); h.z = cvt_pk_bf16(a1[0], a1[1]); h.w = cvt_pk_bf16(a1[2], a1[3]);
    l.x = cvt_pk_bf16(a0[0] - bf_lo(h.x), a0[1] - bf_hi(h.x)); l.y = cvt_pk_bf16(a0[2] - bf_lo(h.y), a0[3] - bf_hi(h.y));
    l.z = cvt_pk_bf16(a1[0] - bf_lo(h.z), a1[1] - bf_hi(h.z)); l.w = cvt_pk_bf16(a1[2] - bf_lo(h.w), a1[3] - bf_hi(h.w));
    hi = __builtin_bit_cast(bf16x8, h); lo = __builtin_bit_cast(bf16x8, l);
}
__device__ __forceinline__ unsigned trunc_pk(float lo, float hi) { return (__float_as_uint(lo) >> 16) | (__float_as_uint(hi) & 0xffff0000u); }
__device__ __forceinline__ float trunc_res(float x) { return x - __uint_as_float(__float_as_uint(x) & 0xffff0000u); }
__device__ __forceinline__ void split_trunc(const f32x4& a0, const f32x4& a1, bf16x8& hi, bf16x8& lo) {
    u32x4 h, l;
    h.x = trunc_pk(a0[0], a0[1]); h.y = trunc_pk(a0[2], a0[3]); h.z = trunc_pk(a1[0], a1[1]); h.w = trunc_pk(a1[2], a1[3]);
    l.x = trunc_pk(trunc_res(a0[0]), trunc_res(a0[1])); l.y = trunc_pk(trunc_res(a0[2]), trunc_res(a0[3])); l.z = trunc_pk(trunc_res(a1[0]), trunc_res(a1[1])); l.w = trunc_pk(trunc_res(a1[2]), trunc_res(a1[3]));
    hi = __builtin_bit_cast(bf16x8, h); lo = __builtin_bit_cast(bf16x8, l);
}
__device__ __forceinline__ void router_phase(LAS unsigned char* lds, const float* __restrict__ X1, const float* __restrict__ g2, const float* __restrict__ GWT, const float* __restrict__ rb,
                                             unsigned char* __restrict__ H, float* __restrict__ RSTD, float* __restrict__ GATES, int* __restrict__ ROWS, unsigned* __restrict__ COUNTS, int G, int c) {
    const int tid = threadIdx.x, lane = tid & 63, w = __builtin_amdgcn_readfirstlane(tid >> 6), ql = lane & 15, g = lane >> 4;
    const int ts = w & 3, kh = w >> 2;
    LAS unsigned char* GWH = lds; LAS unsigned char* GWL = lds + RT_GWL;
    LAS float* G2 = (LAS float*)(lds + RT_G2);
    LAS float* LG = (LAS float*)(lds + RT_LG) + ts * (16 * 33);
    LAS float* RS = (LAS float*)(lds + RT_RS) + ts * 16;
    LAS int* LCNT = (LAS int*)(lds + RT_CNT);
    LAS int* LBASE = LCNT + 32;
    LAS float* PART = (LAS float*)(lds + RT_PART) + ts * (64 * 9);
    const int nrounds = (S / 16 + 4 * G - 1) / (4 * G);
    for (int rd = 0; rd < nrounds; ++rd) {
        const int tile = (rd * 4 + ts) * G + c;
        const bool active = tile < S / 16;
        const int tok = (active ? tile : 0) * 16 + ql;
        const float* xr = X1 + (size_t)tok * D + kh * 512 + 8 * g;
        f32x4 av[16];
        if (active) {
#pragma unroll
            for (int i = 0; i < 8; ++i) { av[2 * i] = __builtin_nontemporal_load((const f32x4*)(xr + 32 * i)); av[2 * i + 1] = __builtin_nontemporal_load((const f32x4*)(xr + 32 * i + 4)); } }
        if (rd == 0) {
            for (int id = tid; id < NE * 128; id += 512) { const int e = id >> 7, k8 = id & 127; const f32x4 x0 = *(const f32x4*)(GWT + e * D + k8 * 8), x1v = *(const f32x4*)(GWT + e * D + k8 * 8 + 4);
                bf16x8 hi, lo; split_bf16(x0, x1v, hi, lo); *(LAS bf16x8*)(GWH + e * GWB_PITCH + k8 * 16) = hi; *(LAS bf16x8*)(GWL + e * GWB_PITCH + k8 * 16) = lo; }
            if (tid < 256) *(LAS f32x4*)(G2 + tid * 4) = *(const f32x4*)(g2 + tid * 4);
        }
        if (tid < 32) LCNT[tid] = 0;
        __syncthreads();
        int ek[4] = {0, 0, 0, 0}, lp[4] = {0, 0, 0, 0}; float gk[4] = {0.f, 0.f, 0.f, 0.f};
        f32x4 acc0 = (f32x4){0.f, 0.f, 0.f, 0.f}, acc1 = acc0; float ss = 0.f;
        if (active) {
            f32x4 accA[6], accB[6];
#pragma unroll
            for (int t = 0; t < 6; ++t) { accA[t] = (f32x4){0.f, 0.f, 0.f, 0.f}; accB[t] = accA[t]; }

            unsigned char* hr = H + (size_t)tok * D + kh * 512 + 8 * g;
            const LAS unsigned char* bh0 = GWH + ql * GWB_PITCH + (kh * 512 + 8 * g) * 2; const LAS unsigned char* bh1 = bh0 + 16 * GWB_PITCH;
            const LAS unsigned char* bl0 = GWL + ql * GWB_PITCH + (kh * 512 + 8 * g) * 2; const LAS unsigned char* bl1 = bl0 + 16 * GWB_PITCH;
            const LAS float* gp = G2 + kh * 512 + 8 * g;
#pragma unroll
            for (int kb = 0; kb < 512; kb += 256) {
                if (kb > 0) {
#pragma unroll
                    for (int i = 0; i < 8; ++i) { av[2 * i] = __builtin_nontemporal_load((const f32x4*)(xr + kb + 32 * i)); av[2 * i + 1] = __builtin_nontemporal_load((const f32x4*)(xr + kb + 32 * i + 4)); } }
#pragma unroll
                for (int i = 0; i < 8; ++i) {
                    const int k0 = kb + 32 * i; const f32x4 a0 = av[2 * i], a1 = av[2 * i + 1];
                    const f32x4 n0 = *(const LAS f32x4*)(gp + k0), n1 = *(const LAS f32x4*)(gp + k0 + 4);
                    const bf16x8 wh0 = *(const LAS bf16x8*)(bh0 + k0 * 2), wh1 = *(const LAS bf16x8*)(bh1 + k0 * 2), wl0 = *(const LAS bf16x8*)(bl0 + k0 * 2), wl1 = *(const LAS bf16x8*)(bl1 + k0 * 2);
                    ss += (a0[0] * a0[0] + a0[1] * a0[1]) + (a0[2] * a0[2] + a0[3] * a0[3]) + (a1[0] * a1[0] + a1[1] * a1[1]) + (a1[2] * a1[2] + a1[3] * a1[3]);
                    u32x2 hv; hv.x = cvt4_fp8(a0[0] * n0[0] * HSCALE, a0[1] * n0[1] * HSCALE, a0[2] * n0[2] * HSCALE, a0[3] * n0[3] * HSCALE);
                    hv.y = cvt4_fp8(a1[0] * n1[0] * HSCALE, a1[1] * n1[1] * HSCALE, a1[2] * n1[2] * HSCALE, a1[3] * n1[3] * HSCALE);
                    *(u32x2*)(hr + k0) = hv;
                    bf16x8 ah, al; split_bf16(a0, a1, ah, al);


                    __builtin_amdgcn_sched_barrier(0); asm volatile("s_nop 7" ::: "memory"); __builtin_amdgcn_sched_barrier(0);
                    f32x4 (&q)[6] = (i & 1) ? accB : accA;
                    q[0] = __builtin_amdgcn_mfma_f32_16x16x32_bf16(ah, wh0, q[0], 0, 0, 0); q[1] = __builtin_amdgcn_mfma_f32_16x16x32_bf16(ah, wh1, q[1], 0, 0, 0);
                    q[2] = __builtin_amdgcn_mfma_f32_16x16x32_bf16(ah, wl0, q[2], 0, 0, 0); q[3] = __builtin_amdgcn_mfma_f32_16x16x32_bf16(ah, wl1, q[3], 0, 0, 0);
                    q[4] = __builtin_amdgcn_mfma_f32_16x16x32_bf16(al, wh0, q[4], 0, 0, 0); q[5] = __builtin_amdgcn_mfma_f32_16x16x32_bf16(al, wh1, q[5], 0, 0, 0);

                    __builtin_amdgcn_sched_barrier(0); asm volatile("s_nop 15\n\ts_nop 15" ::: "memory"); __builtin_amdgcn_sched_barrier(0);

                }
            }

            acc0 = ((accA[0] + accB[0]) + (accA[2] + accB[2])) + (accA[4] + accB[4]); acc1 = ((accA[1] + accB[1]) + (accA[3] + accB[3])) + (accA[5] + accB[5]);


            if (kh == 1) { LAS float* pp = PART + lane * 9;
#pragma unroll
                for (int i = 0; i < 4; ++i) { pp[i] = acc0[i]; pp[4 + i] = acc1[i]; } pp[8] = ss; }
        }
        __syncthreads();
        if (active && kh == 0) {
            { const LAS float* pp = PART + lane * 9;
#pragma unroll
              for (int i = 0; i < 4; ++i) { acc0[i] += pp[i]; acc1[i] += pp[4 + i]; } ss += pp[8]; }
            ss += __shfl_xor(ss, 16); ss += __shfl_xor(ss, 32);
            const float rstd = rsqrtf(ss * (1.0f / D) + RMS_EPS);
            if (g == 0) { RSTD[tok] = rstd; RS[ql] = rstd; }
            LDS_WAIT();
            const float rb0 = rb[ql], rb1 = rb[16 + ql];
#pragma unroll
            for (int rg = 0; rg < 4; ++rg) { const float rr = RS[4 * g + rg]; LG[(4 * g + rg) * 33 + ql] = acc0[rg] * rr + rb0; LG[(4 * g + rg) * 33 + 16 + ql] = acc1[rg] * rr + rb1; }
            LDS_WAIT();
            if (lane < 16) {
                float v[32];
#pragma unroll
                for (int e = 0; e < 32; ++e) v[e] = LG[ql * 33 + e];
                float tv[4];
#pragma unroll
                for (int r = 0; r < 4; ++r) { float best = v[0]; int bi = 0;
#pragma unroll
                    for (int e = 1; e < 32; ++e) { const bool gt = v[e] > best; best = gt ? v[e] : best; bi = gt ? e : bi; }
                    tv[r] = best; ek[r] = bi;
#pragma unroll
                    for (int e = 0; e < 32; ++e) v[e] = (e == bi) ? -INFINITY : v[e]; }
                const float e1 = __expf(tv[1] - tv[0]), e2 = __expf(tv[2] - tv[0]), e3 = __expf(tv[3] - tv[0]); const float inv = 1.0f / (1.0f + e1 + e2 + e3);
                gk[0] = inv; gk[1] = e1 * inv; gk[2] = e2 * inv; gk[3] = e3 * inv;
#pragma unroll
                for (int r = 0; r < 4; ++r) lp[r] = __hip_atomic_fetch_add(LCNT + ek[r], 1, __ATOMIC_RELAXED, __HIP_MEMORY_SCOPE_WORKGROUP);
            }
        }
        __syncthreads();
        if (tid < 32) { const int n = LCNT[tid]; int base = 0; if (n > 0) base = (int)__hip_atomic_fetch_add(COUNTS + tid, (unsigned)n, __ATOMIC_RELAXED, __HIP_MEMORY_SCOPE_AGENT); LBASE[tid] = base; }
        __syncthreads();
        if (active && kh == 0 && lane < 16) {
#pragma unroll
            for (int r = 0; r < 4; ++r) { const int pos = LBASE[ek[r]] + lp[r]; ROWS[(size_t)ek[r] * S + pos] = tok * 4 + r; GATES[tok * 4 + r] = gk[r]; }

        }
        __syncthreads();
    }
}

__device__ __forceinline__ void moe_prefix(LAS int* tpre, LAS int* lcnt, const unsigned* __restrict__ COUNTS) {
    if (threadIdx.x < 32) lcnt[threadIdx.x] = (int)COUNTS[threadIdx.x];
    __syncthreads();
    if (threadIdx.x == 0) { int acc = 0; for (int e = 0; e < NE; ++e) { tpre[e] = acc; acc += (lcnt[e] + 255) >> 8; } tpre[NE] = acc; }
    __syncthreads();
}
template <bool GU, class Prob> __device__ __forceinline__ void moe_table(const Prob& P, LAS int* tab, LAS float* tabf, LAS float* tabb, const LAS int* lcnt, const int* __restrict__ ROWS,
                                                                         const float* __restrict__ rowf, const float* __restrict__ bias) {
    Unit u;
#pragma unroll 1
    for (int i = 0; i < MAXU && P.next(i, u); ++i) {
        if (threadIdx.x < 256) { const int rr = u.pm * 256 + (int)threadIdx.x; const int idx = (rr < lcnt[u.e]) ? ROWS[(size_t)u.e * S + rr] : -1; tab[i * 256 + threadIdx.x] = idx;
            tabf[i * 256 + threadIdx.x] = GU ? rowf[idx < 0 ? 0 : (idx >> 2)] * (1.0f / (HSCALE * WSCALE)) : (idx < 0 ? 0.f : rowf[idx]); }
        else { const int j = (int)threadIdx.x - 256;
            tabb[i * 256 + j] = GU ? bias[(size_t)u.e * 2 * DFF + (j >> 7) * DFF + u.pn * 128 + (j & 127)] : bias[(size_t)u.e * D + u.pn * 256 + j]; }
    }
    __syncthreads();
}

__device__ __forceinline__ void final_phase(const float* __restrict__ X1, const unsigned char* __restrict__ Y, const float* __restrict__ fg, float* __restrict__ out, int G, int c) {
    const int tid = threadIdx.x, lane = tid & 63, wave = tid >> 6; const int gw = c * 8 + wave, NGW = G * 8;
    f32x4 gv[4];
#pragma unroll
    for (int j = 0; j < 4; ++j) gv[j] = *(const f32x4*)(fg + 4 * lane + 256 * j);
    for (int m = gw; m < S; m += NGW) {
        const float* xr = X1 + (size_t)m * D + 4 * lane;
        f32x4 v[4];
#pragma unroll
        for (int j = 0; j < 4; ++j) v[j] = __builtin_nontemporal_load((const f32x4*)(xr + 256 * j));

#pragma unroll
        for (int k = 0; k < 4; ++k) { const unsigned char* yr = Y + ((size_t)m * 4 + k) * D + 4 * lane;
#pragma unroll
            for (int j = 0; j < 4; ++j) { const int t = __builtin_nontemporal_load((const int*)(yr + 256 * j)); const f32x2 lo = __builtin_amdgcn_cvt_pk_f32_fp8(t, false), hi = __builtin_amdgcn_cvt_pk_f32_fp8(t, true);
                v[j][0] += lo[0] * (1.0f / YSCALE); v[j][1] += lo[1] * (1.0f / YSCALE); v[j][2] += hi[0] * (1.0f / YSCALE); v[j][3] += hi[1] * (1.0f / YSCALE); } }
        float s = 0.f;
#pragma unroll
        for (int j = 0; j < 4; ++j) s += (v[j][0] * v[j][0] + v[j][1] * v[j][1]) + (v[j][2] * v[j][2] + v[j][3] * v[j][3]);
        const float rstd = rsqrtf(wave_sum(s) * (1.0f / D) + RMS_EPS);
#pragma unroll
        for (int j = 0; j < 4; ++j) __builtin_nontemporal_store(v[j] * rstd * gv[j], (f32x4*)(out + (size_t)m * D + 4 * lane + 256 * j));
    }
}

constexpr int NPHASE = 9;
struct Args { In in; float* out; unsigned char* ws; int ph_lo, ph_hi; };
__global__ void __launch_bounds__(512, 2) fwd(Args args) {
    extern __shared__ __attribute__((aligned(16))) unsigned char lds_raw[];
    LAS unsigned char* lds = (LAS unsigned char*)lds_raw;
    const int tid = threadIdx.x, G = gridDim.x, c = blockIdx.x;
    unsigned char* ws = args.ws; const In& in = args.in;
    unsigned* ctl = (unsigned*)(ws + WS_CTL);
    LAS int* LCTL = (LAS int*)(lds + LDS_CTL);
    if (tid < 256) LCTL[tid] = 0;
    __syncthreads();
    const int lo = args.ph_lo, hi = args.ph_hi;
    const bool one_launch = (hi - lo) > 1;
    XcdBarrier bar; bar.bar = ctl + CW_BAR; bar.x = 0; bar.st = nullptr;
    if (one_launch) bar = xcd_barrier_post(ctl + CW_BAR, (volatile LAS unsigned*)LCTL);
#define IN(k) (lo <= (k) && (k) < hi)
#ifndef MK_DOUBLE
#define MK_DOUBLE 0
#endif
#define REP(k) for (int rep_ = 0; rep_ < ((((MK_DOUBLE) >> (k)) & 1) ? 2 : 1); ++rep_)
#define SEAM(k) do { if (IN((k) + 1)) xcd_barrier(bar); } while (0)
    bf16_t* Hb = (bf16_t*)(ws + WS_H); bf16_t* Ub = (bf16_t*)(ws + WS_U); bf16_t* Qb = (bf16_t*)(ws + WS_Q); bf16_t* Kb = (bf16_t*)(ws + WS_K); bf16_t* Vb = (bf16_t*)(ws + WS_V);
    bf16_t* OPb = (bf16_t*)(ws + WS_OP); bf16_t* MIXb = (bf16_t*)(ws + WS_MIX); float* X1 = (float*)(ws + WS_X1); unsigned char* ACTb = ws + WS_ACT; unsigned char* Yb = ws + WS_Y; unsigned char* H8 = ws + WS_H8;
    float* LSE = (float*)(ws + WS_LSE); float* RSTD = (float*)(ws + WS_RSTD); float* GATES = (float*)(ws + WS_GATES); int* ROWS = (int*)(ws + WS_ROWS); unsigned* COUNTS = ctl + CW_COUNTS;
    LAS int* TPRE = LCTL + 16; LAS int* LCNT = LCTL + 128; LAS int* TAB = (LAS int*)(lds + LDS_TAB); LAS float* TABF = (LAS float*)(lds + LDS_TAB + MAXU * 1024); LAS float* TABB = (LAS float*)(lds + LDS_TAB + 2 * MAXU * 1024);
    static_assert(LDS_TAB + 3 * MAXU * 1024 <= LDS_CTL, "MoE LDS tables");

    if (IN(0)) { REP(0) p0_prologue(lds, in, ws, G, c); SEAM(0); }
    if (IN(1)) {
        pg8::DenseProb P{(const char*)Hb, (const char*)(ws + WS_WIN), D * 2, S / 256, NPROJ / 256, G, c, (size_t)128 * D * 2};
        EpiQKVU E{ws};
        REP(1) pg8::gemm_phase<EpiQKVU, pg8::DenseProb, true, false>(lds, P, E);
        { const int nun = (S / 256) * (NPROJ / 256), rem = nun % G, nidle = (rem == 0) ? 0 : (G - rem);
          if (nidle > 0 && c >= rem) convert8_items(lds, in, ws, (c - rem) * 8 + (tid >> 6), nidle * 8, N8_P0, N8_ALL);
          else if (nidle == 0) convert8_items(lds, in, ws, c * 8 + (tid >> 6), G * 8, N8_P0, N8_ALL); }
        SEAM(1);
    }
    if (IN(2)) {
        REP(2) attn_phase(lds, Qb, Kb, Vb, (const float*)(ws + WS_BT), OPb, LSE, G, c);
        REP(9) pool_phase(lds, Ub, (const bf16_t*)(ws + WS_PWT), in.pool_scale, MIXb, G, c);
        SEAM(2);
    }
    if (IN(3)) { REP(3) combine_phase(OPb, LSE, MIXb, G, c); SEAM(3); }
    if (IN(4)) {
        pg8::DenseProb P{(const char*)MIXb, (const char*)(ws + WS_WOUT), D * 2, S / 256, D / 256, G, c, (size_t)128 * D * 2};
        EpiResF32 E{in.x, X1};
        REP(4) pg8::gemm_phase<EpiResF32, pg8::DenseProb, true, false>(lds, P, E);
        SEAM(4);
    }
    if (IN(5)) { router_phase(lds, X1, in.norm2_g, (const float*)(ws + WS_GWT), in.router_b, H8, RSTD, GATES, ROWS, COUNTS, G, c); SEAM(5); }
    if (IN(6)) {
        moe_prefix(TPRE, LCNT, COUNTS);
        pg8::MoeProb<true> P{(const char*)H8, (const char*)(ws + WS_WGU), D, 8, G, c, (size_t)DFF * D, (size_t)2 * DFF * D, 128, TPRE, TAB};
        moe_table<true>(P, TAB, TABF, TABB, LCNT, ROWS, RSTD, in.b_gate_up);
        EpiGateUp E{ACTb, TPRE, TABF, TABB};
        REP(6) pg8::gemm_phase<EpiGateUp, pg8::MoeProb<true>, true, true>(lds, P, E);
        SEAM(6);
    }
    if (IN(7)) {
        moe_prefix(TPRE, LCNT, COUNTS);
        pg8::MoeProb<false> P{(const char*)ACTb, (const char*)(ws + WS_WD), DFF, 4, G, c, (size_t)128 * DFF, (size_t)D * DFF, 256, TPRE, TAB};
        moe_table<false>(P, TAB, TABF, TABB, LCNT, ROWS, GATES, in.b_down);
        EpiDown E{Yb, TAB, TABF, TABB};
        REP(7) pg8::gemm_phase<EpiDown, pg8::MoeProb<false>, true, true>(lds, P, E);
        SEAM(7);
    }

    if (IN(8)) REP(8) final_phase(X1, Yb, in.final_g, args.out, G, c);

#undef IN
#undef SEAM
}

#ifndef MK_N_LAUNCHES
#define MK_N_LAUNCHES 1
#endif
#ifndef MK_SEQ
#define MK_SEQ "012345678"
#endif
extern "C" void kernel_launch(void* const* d_in, const int* in_sizes, int n_in, void* d_out, int out_size, void* d_ws, size_t ws_size, hipStream_t stream) {
    static int grid = 0;
    if (grid == 0) {
        if (n_in != 15 || out_size != S * D || ws_size < WS_END) { fprintf(stderr, "kernel_launch: unexpected problem (n_in %d out %d ws %zu)\n", n_in, out_size, ws_size); grid = -1; return; }
        int dev = 0, cus = 0, per_cu = 0;
        if (hipGetDevice(&dev) != hipSuccess || hipDeviceGetAttribute(&cus, hipDeviceAttributeMultiprocessorCount, dev) != hipSuccess) { grid = -1; return; }
        if (hipFuncSetAttribute((const void*)fwd, hipFuncAttributeMaxDynamicSharedMemorySize, LDS_BYTES) != hipSuccess) { fprintf(stderr, "kernel_launch: hipFuncSetAttribute failed\n"); grid = -1; return; }
        if (hipOccupancyMaxActiveBlocksPerMultiprocessor(&per_cu, (const void*)fwd, 512, LDS_BYTES) != hipSuccess || per_cu < 1) { fprintf(stderr, "kernel_launch: occupancy query says %d blocks per CU\n", per_cu); (void)hipGetLastError(); per_cu = 1; }
        grid = cus;
    }
    if (grid < 0) return;
    if (hipMemsetAsync((char*)d_ws + WS_CTL, 0, CTL_ZERO_BYTES, stream) != hipSuccess) { fprintf(stderr, "kernel_launch: memset failed\n"); return; }
    Args a{};
    a.in.x = (const float*)d_in[0]; a.in.norm1_g = (const float*)d_in[1]; a.in.w_in = (const float*)d_in[2]; a.in.pool_w = (const float*)d_in[3]; a.in.pool_scale = (const float*)d_in[4];
    a.in.rel_bias = (const float*)d_in[5]; a.in.w_out = (const float*)d_in[6]; a.in.norm2_g = (const float*)d_in[7]; a.in.router_w = (const float*)d_in[8]; a.in.router_b = (const float*)d_in[9];
    a.in.w_gate_up = (const float*)d_in[10]; a.in.b_gate_up = (const float*)d_in[11]; a.in.w_down = (const float*)d_in[12]; a.in.b_down = (const float*)d_in[13]; a.in.final_g = (const float*)d_in[14];
    a.out = (float*)d_out; a.ws = (unsigned char*)d_ws;
    if (MK_N_LAUNCHES == 1) { a.ph_lo = 0; a.ph_hi = NPHASE; hipLaunchKernelGGL(fwd, dim3(grid), dim3(512), LDS_BYTES, stream, a); }
    else { const char* seq = MK_SEQ; for (int i = 0; seq[i]; ++i) { const int p = seq[i] - '0'; a.ph_lo = p; a.ph_hi = p + 1; if (p == 5) (void)hipMemsetAsync((char*)d_ws + WS_CTL + CW_COUNTS * 4, 0, 128, stream); hipLaunchKernelGGL(fwd, dim3(grid), dim3(512), LDS_BYTES, stream, a); } }
    const hipError_t le = hipPeekAtLastError();
    if (le != hipSuccess) fprintf(stderr, "kernel_launch: launch failed: %s\n", hipGetErrorName(le));
}
```

```cpp
#include <hip/hip_runtime.h>
#include <cstdio>
#include <cstdint>

#define LAS __attribute__((address_space(3)))
#define GAS __attribute__((address_space(1)))
typedef unsigned short bf16_t;
typedef short bf16x8 __attribute__((ext_vector_type(8)));
typedef short s16x4 __attribute__((ext_vector_type(4)));
typedef float f32x4 __attribute__((ext_vector_type(4)));
typedef float f32x2 __attribute__((ext_vector_type(2)));
typedef unsigned u32x4 __attribute__((ext_vector_type(4)));
typedef unsigned u32x2 __attribute__((ext_vector_type(2)));
typedef int i32x4 __attribute__((ext_vector_type(4)));
typedef int i32x8 __attribute__((ext_vector_type(8)));

constexpr int S = 16384, D = 1024, NPROJ = 2560, PW = 256, AW = 768, NH = 12, HD = 64, NE = 32, TOPK = 4, DFF = 1024;
constexpr float RMS_EPS = 1e-5f, LOG2E = 1.4426950408889634f, QSCALE = 0.125f * LOG2E, NEGBIG = -1e30f;
constexpr float WSCALE = 64.0f, HSCALE = 16.0f, ASCALE = 8.0f, YSCALE = 64.0f, FP8MAX = 448.0f;
constexpr int BT_N = 400, BT_OFF = 144;

constexpr size_t MiB = 1u << 20;
constexpr size_t WS_CTL = 0, CTL_ZERO_BYTES = 64 * 1024;
constexpr size_t WS_WIN = 2 * MiB;
constexpr size_t WS_WOUT = 8 * MiB;
constexpr size_t WS_GWT = 10 * MiB;
constexpr size_t WS_BT = 10 * MiB + 512 * 1024;
constexpr size_t WS_PWT = 10 * MiB + 768 * 1024;
constexpr size_t WS_RSTD = 11 * MiB;
constexpr size_t WS_GATES = 11 * MiB + 256 * 1024;
constexpr size_t WS_ROWS = 12 * MiB;
constexpr size_t WS_LSE = 14 * MiB;
constexpr size_t WS_WGU = 32 * MiB;
constexpr size_t WS_WD = 160 * MiB;
constexpr size_t WS_H8 = 200 * MiB;
constexpr size_t WS_H = 224 * MiB;
constexpr size_t WS_U = 256 * MiB;
constexpr size_t WS_Q = 264 * MiB, WS_K = 288 * MiB, WS_V = 312 * MiB;
constexpr size_t WS_OP = 336 * MiB;
constexpr size_t WS_MIX = 408 * MiB;
constexpr size_t WS_X1 = 440 * MiB;
constexpr size_t WS_ACT = 512 * MiB;
constexpr size_t WS_Y = 656 * MiB;
constexpr size_t WS_END = 784 * MiB;
constexpr int ACT_ROWS = 65536 + 32 * 256;
constexpr int CW_COUNTS = 64;
constexpr int CW_QUEUE = 256;
constexpr int CW_BAR = 4096;

constexpr int LDS_BYTES = 163840;
constexpr int LDS_TAB = 131072;
constexpr int LDS_CTL = LDS_BYTES - 1024;
constexpr int MAXU = 9;

typedef __bf16 bf16x2_t __attribute__((ext_vector_type(2)));
__device__ __forceinline__ unsigned cvt_pk_bf16(float lo, float hi) { const f32x2 v = {lo, hi}; const bf16x2_t b = __builtin_convertvector(v, bf16x2_t); return __builtin_bit_cast(unsigned, b); }
__device__ __forceinline__ float clamp8(float v) { return __builtin_amdgcn_fmed3f(v, -FP8MAX, FP8MAX); }
__device__ __forceinline__ unsigned cvt4_fp8(float a, float b, float c, float d) {
    int p = __builtin_amdgcn_cvt_pk_fp8_f32(clamp8(a), clamp8(b), 0, false); p = __builtin_amdgcn_cvt_pk_fp8_f32(clamp8(c), clamp8(d), p, true); return (unsigned)p; }
__device__ __forceinline__ float bf_lo(unsigned w) { return __uint_as_float(w << 16); }
__device__ __forceinline__ float bf_hi(unsigned w) { return __uint_as_float(w & 0xffff0000u); }
__device__ __forceinline__ float wave_sum(float v) {
#pragma unroll
    for (int o = 1; o < 64; o <<= 1) v += __shfl_xor(v, o);
    return v;
}
#define LDS_WAIT() asm volatile("s_waitcnt lgkmcnt(0)" ::: "memory")
#define VM_WAIT() asm volatile("s_waitcnt vmcnt(0)" ::: "memory")

#define XB_TMO      128
#define XB_XCNT(j)  (256  + 64 * (j))
#define XB_XSUB(j)  (1280 + 64 * (j))
#define XB_XGEN(j)  (2304 + 64 * (j))
#define XB_TOP      3328
#define XB_TOPGEN   3392
#define XCD_BAR_WORDS 3456
#define XB_SPIN_CAP (1u << 18)
__device__ __forceinline__ unsigned xb_ld(unsigned* p)              { return __hip_atomic_load(p, __ATOMIC_RELAXED, __HIP_MEMORY_SCOPE_AGENT); }
__device__ __forceinline__ unsigned xb_add(unsigned* p, unsigned v) { return __hip_atomic_fetch_add(p, v, __ATOMIC_RELAXED, __HIP_MEMORY_SCOPE_AGENT); }
__device__ __forceinline__ unsigned xb_xcc_id() { return (unsigned)__builtin_amdgcn_s_getreg((3 << 11) | 20) & 0xFu; }
#define XB_SPIN(cond, bar) do { unsigned _sp = 0; while (cond) { __builtin_amdgcn_s_sleep(1); \
    if ((++_sp & 255u) == 0u) { if (xb_ld(&(bar)[XB_TMO])) break; if (_sp > XB_SPIN_CAP) { atomicAdd(&(bar)[XB_TMO], 1u); break; } } } } while (0)
struct XcdBarrier { unsigned* bar; unsigned x; volatile LAS unsigned* st; };
__device__ __forceinline__ XcdBarrier xcd_barrier_post(unsigned* bar, volatile LAS unsigned* st) {
    XcdBarrier b; b.bar = bar; b.x = xb_xcc_id(); b.st = st;
    if (threadIdx.x == 0) (void)xb_add(&bar[XB_XCNT(b.x)], 1u);
    return b;
}
__device__ __forceinline__ void xcd_barrier_complete(unsigned* bar, unsigned x, unsigned& nloc, unsigned& nx) {
    const unsigned G = gridDim.x * gridDim.y * gridDim.z;
    unsigned sum, cnt, mine, sp = 0u;
    for (;;) {
        sum = 0u; cnt = 0u; mine = 0u;
#pragma unroll
        for (unsigned j = 0; j < 16; ++j) { const unsigned c = xb_ld(&bar[XB_XCNT(j)]); sum += c; cnt += (c > 0u) ? 1u : 0u; mine = (j == x) ? c : mine; }
        if (sum == G) break;
        __builtin_amdgcn_s_sleep(1);
        if ((++sp & 255u) == 0u) { if (xb_ld(&bar[XB_TMO])) break; if (sp > XB_SPIN_CAP) { atomicAdd(&bar[XB_TMO], 1u); break; } }
    }
    nloc = mine > 0u ? mine : 1u; nx = cnt > 0u ? cnt : 1u;
}
__device__ __forceinline__ void xcd_barrier(const XcdBarrier& b) {
    asm volatile("s_waitcnt vmcnt(0)" ::: "memory");
    __syncthreads();
    if (threadIdx.x == 0) {
        unsigned* bar = b.bar;
        __builtin_amdgcn_s_waitcnt(0);
        unsigned nloc = b.st[0], nx = b.st[1];
        if (nloc == 0u) { xcd_barrier_complete(bar, b.x, nloc, nx); b.st[0] = nloc; b.st[1] = nx; }
        const unsigned old = xb_add(&bar[XB_XSUB(b.x)], 1u);
        const unsigned gen = old / nloc;
        if (old + 1u == (gen + 1u) * nloc) {
            __builtin_amdgcn_fence(__ATOMIC_RELEASE, "agent");
            asm volatile("s_waitcnt vmcnt(0)" ::: "memory");
            const unsigned og = xb_add(&bar[XB_TOP], 1u);
            const unsigned tg = og / nx;
            if (og + 1u == (tg + 1u) * nx) xb_add(&bar[XB_TOPGEN], 1u);
            else XB_SPIN(xb_ld(&bar[XB_TOPGEN]) == tg, bar);
            __builtin_amdgcn_fence(__ATOMIC_ACQUIRE, "agent");
            xb_add(&bar[XB_XGEN(b.x)], 1u);
            asm volatile("s_waitcnt vmcnt(0)" ::: "memory");
        } else {
            XB_SPIN(xb_ld(&bar[XB_XGEN(b.x)]) == gen, bar);
            __builtin_amdgcn_fence(__ATOMIC_ACQUIRE, "agent");
            asm volatile("s_waitcnt vmcnt(0)" ::: "memory");
        }
    }
    __syncthreads();
}

namespace pg8 {
constexpr int BM = 256, BK = 64, HALF = 128, HTB = HALF * BK * 2, STAGE_BYTES = 8 * HTB, NXCD = 8, WGM = 8;
__host__ __device__ __forceinline__ int lds_byte(int r, int c) { const int st = (r >> 4) * 2 + (c >> 5), rr = r & 15, cc = c & 31, ob = rr * 64 + cc * 2; return st * 1024 + (ob ^ (((ob >> 9) & 1) << 5)); }
__host__ __device__ __forceinline__ void stage_rc(int b, int& R, int& C) { const int st = b / 1024, sb = b % 1024, swz = sb ^ (((sb >> 9) & 1) << 5); R = (st >> 1) * 16 + swz / 64; C = (st & 1) * 32 + (swz % 64) / 2; }
__host__ __device__ __forceinline__ int perm32(int rho) { const int n = rho >> 4, i = rho & 15; return 8 * (i >> 2) + 4 * n + (i & 3); }

struct Unit { int pm, pn, e, slot; };

template <class Epi, class Prob, bool ALIGN_EPI, bool FP8>
__device__ __forceinline__ void gemm_phase(LAS unsigned char* lds, const Prob& P, const Epi& E) {
    const int tid = threadIdx.x, wid = __builtin_amdgcn_readfirstlane(tid >> 6), lane = tid & 63, wr = wid >> 2, wc = wid & 3, fr = lane & 15, fq = lane >> 4;
    const int rowb = P.rowb, nt = rowb / 128;
    int Rs[2], Cs[2]; unsigned voffB[2];
#pragma unroll
    for (int i = 0; i < 2; ++i) { int R, C; stage_rc(tid * 16 + i * 8192, R, C); const int Rb = Epi::PERM ? ((R & ~31) + perm32(R & 31)) : R;
        Rs[i] = R; Cs[i] = C * 2; voffB[i] = (unsigned)(Rb * rowb + C * 2); }
    const size_t kstep = (size_t)(BK * 2);
    const size_t bhalf = P.b_half;
    const unsigned ldsw = (unsigned)wid * 1024u;
    const int aoff = lds_byte(wr * 64 + fr, fq * 8), boff = lds_byte(wc * 32 + fr, fq * 8);
#define PG8_SA(b, h) (((b) * 2 + (h)) * HTB)
#define PG8_SB(b, h) ((4 + (b) * 2 + (h)) * HTB)
#define PG8_STAGE_B(bufoff, gbase) do { _Pragma("unroll") for (int _i = 0; _i < 2; ++_i) \
        __builtin_amdgcn_global_load_lds((const unsigned*)((const char*)(gbase) + voffB[_i]), (LAS unsigned*)(lds + (bufoff) + ldsw + _i * 8192), 16, 0, 0); } while (0)
#define PG8_STAGE_A(bufoff, kb, o0, o1) do { \
        __builtin_amdgcn_global_load_lds((const unsigned*)(P.A + (size_t)(o0) + (kb)), (LAS unsigned*)(lds + (bufoff) + ldsw), 16, 0, 0); \
        __builtin_amdgcn_global_load_lds((const unsigned*)(P.A + (size_t)(o1) + (kb)), (LAS unsigned*)(lds + (bufoff) + ldsw + 8192), 16, 0, 0); } while (0)
#define PG8_LDA(dst, b, h) do { _Pragma("unroll") for (int m = 0; m < 4; ++m) _Pragma("unroll") for (int k = 0; k < 2; ++k) dst[m][k] = *(const LAS bf16x8*)(lds + PG8_SA(b, h) + aoff + m * 2048 + k * 1024); } while (0)
#define PG8_LDB(dst, b, h) do { _Pragma("unroll") for (int n = 0; n < 2; ++n) _Pragma("unroll") for (int k = 0; k < 2; ++k) dst[n][k] = *(const LAS bf16x8*)(lds + PG8_SB(b, h) + boff + n * 2048 + k * 1024); } while (0)
#define PG8_MMA(ai, bj, At, Bt) do { __builtin_amdgcn_s_setprio(1); _Pragma("unroll") for (int m = 0; m < 4; ++m) _Pragma("unroll") for (int n = 0; n < 2; ++n) { \
        if constexpr (FP8) { const i32x8 fb_ = __builtin_shufflevector(__builtin_bit_cast(i32x4, Bt[n][0]), __builtin_bit_cast(i32x4, Bt[n][1]), 0, 1, 2, 3, 4, 5, 6, 7); \
            const i32x8 fa_ = __builtin_shufflevector(__builtin_bit_cast(i32x4, At[m][0]), __builtin_bit_cast(i32x4, At[m][1]), 0, 1, 2, 3, 4, 5, 6, 7); \
            acc[ai][bj][m][n] = __builtin_amdgcn_mfma_scale_f32_16x16x128_f8f6f4(fb_, fa_, acc[ai][bj][m][n], 0, 0, 0, 0, 0, 0); } \
        else { _Pragma("unroll") for (int k = 0; k < 2; ++k) acc[ai][bj][m][n] = __builtin_amdgcn_mfma_f32_16x16x32_bf16(Bt[n][k], At[m][k], acc[ai][bj][m][n], 0, 0, 0); } } \
        __builtin_amdgcn_s_setprio(0); } while (0)
#define PG8_WAIT_V(n) asm volatile("s_waitcnt vmcnt(" #n ")" ::: "memory")
#define PG8_WAIT_L(n) asm volatile("s_waitcnt lgkmcnt(" #n ")" ::: "memory")
#define PG8_BAR __builtin_amdgcn_s_barrier()
#define PG8_SCHED __builtin_amdgcn_sched_barrier(0)
    Unit cur, nxt; int ui = 0;
    if (!P.next(0, cur)) return;
    f32x4 acc[2][2][4][2];
#pragma unroll
    for (int a = 0; a < 2; ++a)
#pragma unroll
        for (int b = 0; b < 2; ++b)
#pragma unroll
            for (int m = 0; m < 4; ++m)
#pragma unroll
                for (int n = 0; n < 2; ++n) acc[a][b][m][n] = (f32x4){0.f, 0.f, 0.f, 0.f};
    bf16x8 At[4][2], B0[2][2], B1[2][2];
    unsigned c00 = P.a_off(cur, Rs[0], Cs[0]), c01 = P.a_off(cur, Rs[1], Cs[1]), c10 = P.a_off(cur, HALF + Rs[0], Cs[0]), c11 = P.a_off(cur, HALF + Rs[1], Cs[1]);
    const char* cB = P.b_base(cur);
    PG8_STAGE_B(PG8_SB(0, 0), cB); PG8_STAGE_B(PG8_SB(0, 1), cB + bhalf); PG8_STAGE_A(PG8_SA(0, 0), 0, c00, c01); PG8_STAGE_A(PG8_SA(0, 1), 0, c10, c11);
    if (wr == 1) PG8_BAR;
    PG8_WAIT_V(2); PG8_BAR;
    PG8_STAGE_B(PG8_SB(1, 0), cB + kstep); PG8_STAGE_A(PG8_SA(1, 0), kstep, c00, c01); PG8_STAGE_B(PG8_SB(1, 1), cB + bhalf + kstep);
    PG8_WAIT_V(6); PG8_BAR;
    for (;;) {
        const bool has_next = P.next(ui + 1, nxt);
        const char* nB = has_next ? P.b_base(nxt) : cB;
        for (int t = 0; t < nt; t += 2) {
            const bool last = (t == nt - 2);
            const size_t k1 = (size_t)(t + 1) * kstep;
            const size_t k2 = last ? 0 : (size_t)(t + 2) * kstep, k3 = k2 + kstep;
            const char* b2 = last ? nB : cB + (size_t)(t + 2) * kstep; const char* b3 = b2 + kstep;
            if (last && has_next) { c00 = P.a_off(nxt, Rs[0], Cs[0]); c01 = P.a_off(nxt, Rs[1], Cs[1]); }
            PG8_LDB(B0, 0, 0); PG8_LDB(B1, 0, 1); PG8_SCHED; PG8_LDA(At, 0, 0); PG8_STAGE_A(PG8_SA(1, 1), k1, c10, c11);
            PG8_WAIT_V(8); PG8_WAIT_L(0); PG8_BAR; PG8_MMA(0, 0, At, B0); PG8_MMA(0, 1, At, B1); PG8_BAR; PG8_SCHED;
            if (last && has_next) { c10 = P.a_off(nxt, HALF + Rs[0], Cs[0]); c11 = P.a_off(nxt, HALF + Rs[1], Cs[1]); }
            PG8_LDA(At, 0, 1); PG8_STAGE_B(PG8_SB(0, 0), b2); PG8_STAGE_B(PG8_SB(0, 1), b2 + bhalf); PG8_STAGE_A(PG8_SA(0, 0), k2, c00, c01);
            PG8_WAIT_V(8); PG8_WAIT_L(0); PG8_BAR; PG8_MMA(1, 0, At, B0); PG8_MMA(1, 1, At, B1); PG8_BAR; PG8_SCHED;
            PG8_LDB(B0, 1, 0); PG8_LDB(B1, 1, 1); PG8_SCHED; PG8_LDA(At, 1, 0); PG8_STAGE_A(PG8_SA(0, 1), k2, c10, c11);
            PG8_WAIT_V(8); PG8_WAIT_L(0); PG8_BAR; PG8_MMA(0, 0, At, B0); PG8_MMA(0, 1, At, B1); PG8_BAR; PG8_SCHED;
            PG8_LDA(At, 1, 1); PG8_STAGE_B(PG8_SB(1, 0), b3); PG8_STAGE_B(PG8_SB(1, 1), b3 + bhalf); PG8_STAGE_A(PG8_SA(1, 0), k3, c00, c01);
            PG8_WAIT_V(8); PG8_WAIT_L(0); PG8_BAR; PG8_MMA(1, 0, At, B0); PG8_MMA(1, 1, At, B1); PG8_BAR; PG8_SCHED;
        }
        if constexpr (ALIGN_EPI) { if (wr == 0) PG8_BAR; }
        E(acc, cur, wr, wc, fr, fq);
#if defined(MK_DOUBLE)
        if constexpr (FP8) { if ((MK_DOUBLE >> 12) & 1) { asm volatile("" ::: "memory"); E(acc, cur, wr, wc, fr, fq); } }
#endif
        if (!has_next) break;
#pragma unroll
        for (int a = 0; a < 2; ++a)
#pragma unroll
            for (int b = 0; b < 2; ++b)
#pragma unroll
                for (int m = 0; m < 4; ++m)
#pragma unroll
                    for (int n = 0; n < 2; ++n) acc[a][b][m][n] = (f32x4){0.f, 0.f, 0.f, 0.f};
        cur = nxt; cB = nB; ++ui;
        if constexpr (ALIGN_EPI) { if (wr == 1) PG8_BAR; }
    }
    PG8_WAIT_V(0);
    if constexpr (!ALIGN_EPI) { if (wr == 0) PG8_BAR; }
    PG8_BAR;
#undef PG8_SA
#undef PG8_SB
#undef PG8_STAGE_A
#undef PG8_STAGE_B
#undef PG8_LDA
#undef PG8_LDB
#undef PG8_MMA
#undef PG8_WAIT_V
#undef PG8_WAIT_L
#undef PG8_BAR
#undef PG8_SCHED
}

__device__ __forceinline__ bool static_order(int nM, int nN, int G, int c, int i, int& pm, int& pn) {
    const int nwg = nM * nN; const long L = (long)i * G + c; if (L >= nwg) return false;
    int wgid = (int)L; { const int q = nwg / NXCD, r = nwg % NXCD, xcd = wgid % NXCD, off = wgid / NXCD; wgid = (xcd < r ? xcd * (q + 1) : r * (q + 1) + (xcd - r) * q) + off; }
    const int nig = WGM * nN, gid = wgid / nig, fm = gid * WGM, gsz = (nM - fm) < WGM ? (nM - fm) : WGM;
    pm = fm + ((wgid % nig) % gsz); pn = (wgid % nig) / gsz; return true;
}
struct DenseProb {
    const char* A; const char* Bt; int rowb, nM, nN, G, c; size_t b_half;
    __device__ __forceinline__ bool next(int i, Unit& u) const { u.e = 0; u.slot = i; return static_order(nM, nN, G, c, i, u.pm, u.pn); }
    __device__ __forceinline__ unsigned a_off(const Unit& u, int row, int colb) const { return (unsigned)((u.pm * BM + row) * rowb + colb); }
    __device__ __forceinline__ const char* b_base(const Unit& u) const { return Bt + (size_t)u.pn * BM * rowb; }
};
template <bool GATHER> struct MoeProb {
    const char* A; const char* Bt; int rowb, nN, G, c; size_t b_half; size_t b_expert; int b_tile_rows;
    const LAS int* tpre; const LAS int* tab;
    __device__ __forceinline__ int tp(int j) const { return __builtin_amdgcn_readfirstlane(tpre[j]); }
    __device__ __forceinline__ bool next(int i, Unit& u) const {
        const int total = tp(NE) * nN; const long L0 = (long)i * G + c; if (L0 >= total) return false;
        int L = (int)L0; { const int q = total / NXCD, r = total % NXCD, xcd = L % NXCD, off = L / NXCD; L = (xcd < r ? xcd * (q + 1) : r * (q + 1) + (xcd - r) * q) + off; }
        int e = 0;
#pragma unroll 1
        for (int j = 1; j < NE; ++j) e += (tp(j) * nN <= L) ? 1 : 0;
        const int first = tp(e) * nN, tiles = tp(e + 1) - tp(e), rem = L - first;
        u.e = e; u.pm = rem % tiles; u.pn = rem / tiles; u.slot = i; return true;
    }
    __device__ __forceinline__ unsigned a_off(const Unit& u, int row, int colb) const {
        if (GATHER) { const int idx = tab[u.slot * 256 + row]; const int tok = idx < 0 ? 0 : (idx >> 2); return (unsigned)(tok * rowb + colb); }
        return (unsigned)(((tp(u.e) + u.pm) * BM + row) * rowb + colb);
    }
    __device__ __forceinline__ const char* b_base(const Unit& u) const { return Bt + (size_t)u.e * b_expert + (size_t)u.pn * b_tile_rows * rowb; }
};
}

using pg8::Unit;
typedef f32x4 AccT[2][2][4][2];

struct EpiQKVU {
    static constexpr bool PERM = true;
    unsigned char* ws;
    __device__ __forceinline__ void operator()(const AccT& acc, const Unit& u, int wr, int wc, int fr, int fq) const {
        static_assert(WS_K - WS_Q == WS_V - WS_K, "Q, K, V equally spaced");
        const int t = (u.pn - 1) / 3;
        const size_t boff = (u.pn == 0) ? WS_U : (WS_Q + (size_t)t * (WS_K - WS_Q));
        bf16_t* base = (bf16_t*)(ws + boff);
        const int ldc = (u.pn == 0) ? PW : AW, colt = (u.pn == 0) ? 0 : ((u.pn - 1) % 3) * 256;
        const float sc = (u.pn >= 1 && u.pn <= 3) ? QSCALE : 1.f;
        const int row0 = u.pm * 256 + wr * 64 + fr, col0 = colt + wc * 32 + 8 * fq;
#pragma unroll
        for (int ai = 0; ai < 2; ++ai)
#pragma unroll
            for (int m = 0; m < 4; ++m) { bf16_t* rowp = base + (size_t)(row0 + ai * 128 + m * 16) * ldc + col0;
#pragma unroll
                for (int bj = 0; bj < 2; ++bj) { const f32x4 v0 = acc[ai][bj][m][0] * sc, v1 = acc[ai][bj][m][1] * sc;
                    u32x4 w; w.x = cvt_pk_bf16(v0[0], v0[1]); w.y = cvt_pk_bf16(v0[2], v0[3]); w.z = cvt_pk_bf16(v1[0], v1[1]); w.w = cvt_pk_bf16(v1[2], v1[3]);
                    *(u32x4*)(rowp + bj * 128) = w; } }
    }
};
struct EpiResF32 {
    static constexpr bool PERM = false;
    const float* X; float* O;
    __device__ __forceinline__ void operator()(const AccT& acc, const Unit& u, int wr, int wc, int fr, int fq) const {
        const int row0 = u.pm * 256 + wr * 64 + fr, col0 = u.pn * 256 + wc * 32 + 4 * fq;
#pragma unroll
        for (int ai = 0; ai < 2; ++ai)
#pragma unroll
            for (int m = 0; m < 4; ++m) { const size_t off = (size_t)(row0 + ai * 128 + m * 16) * D + col0;
#pragma unroll
                for (int bj = 0; bj < 2; ++bj)
#pragma unroll
                    for (int n = 0; n < 2; ++n) { const f32x4 r = __builtin_nontemporal_load((const f32x4*)(X + off + bj * 128 + n * 16)); *(f32x4*)(O + off + bj * 128 + n * 16) = acc[ai][bj][m][n] + r; } }
    }
};
__device__ __forceinline__ float swiglu1(float g, float u) {
    g = fminf(g, 7.0f); u = fminf(fmaxf(u, -7.0f), 7.0f);
    const float s = __builtin_amdgcn_rcpf(1.0f + __builtin_amdgcn_exp2f(g * (-1.702f * LOG2E)));
    return (u + 1.0f) * (g * s);
}
__device__ __forceinline__ f32x4 swiglu4(f32x4 g, f32x4 u) {
    g = __builtin_elementwise_min(g, (f32x4){7.0f, 7.0f, 7.0f, 7.0f});
    u = __builtin_elementwise_min(__builtin_elementwise_max(u, (f32x4){-7.0f, -7.0f, -7.0f, -7.0f}), (f32x4){7.0f, 7.0f, 7.0f, 7.0f});
    const f32x4 t = g * (-1.702f * LOG2E);
    f32x4 e; e[0] = __builtin_amdgcn_exp2f(t[0]); e[1] = __builtin_amdgcn_exp2f(t[1]); e[2] = __builtin_amdgcn_exp2f(t[2]); e[3] = __builtin_amdgcn_exp2f(t[3]);
    const f32x4 d = e + 1.0f;
    f32x4 r; r[0] = __builtin_amdgcn_rcpf(d[0]); r[1] = __builtin_amdgcn_rcpf(d[1]); r[2] = __builtin_amdgcn_rcpf(d[2]); r[3] = __builtin_amdgcn_rcpf(d[3]);
    return (u * ASCALE + ASCALE) * (g * r);
}
__device__ __forceinline__ unsigned cvt4_fp8_nc(const f32x4& v) {
    int p = __builtin_amdgcn_cvt_pk_fp8_f32(v[0], v[1], 0, false); p = __builtin_amdgcn_cvt_pk_fp8_f32(v[2], v[3], p, true); return (unsigned)p; }
struct EpiGateUp {
    static constexpr bool PERM = true;
    unsigned char* ACT; const LAS int* tpre; const LAS float* tabf; const LAS float* tabb;
    __device__ __forceinline__ void operator()(const AccT& acc, const Unit& u, int wr, int wc, int fr, int fq) const {
        const int cl = wc * 32 + 8 * fq, colA = u.pn * 128 + cl;
        const LAS float* bp = tabb + u.slot * 256 + cl;
        const f32x4 bg0 = *(const LAS f32x4*)(bp), bg1 = *(const LAS f32x4*)(bp + 4), bu0 = *(const LAS f32x4*)(bp + 128), bu1 = *(const LAS f32x4*)(bp + 132);
        const int srow0 = (__builtin_amdgcn_readfirstlane(tpre[u.e]) + u.pm) * 256;
#pragma unroll
        for (int ai = 0; ai < 2; ++ai)
#pragma unroll
            for (int m = 0; m < 4; ++m) { const int r = ai * 128 + wr * 64 + m * 16 + fr; const float rs = tabf[u.slot * 256 + r];
                const f32x4 g0 = acc[ai][0][m][0] * rs + bg0, g1 = acc[ai][0][m][1] * rs + bg1, u0 = acc[ai][1][m][0] * rs + bu0, u1 = acc[ai][1][m][1] * rs + bu1;
                u32x2 w; w.x = cvt4_fp8_nc(swiglu4(g0, u0)); w.y = cvt4_fp8_nc(swiglu4(g1, u1));
                *(u32x2*)(ACT + (size_t)(srow0 + r) * DFF + colA) = w; }
    }
};
struct EpiDown {
    static constexpr bool PERM = true;
    unsigned char* Y; const LAS int* tab; const LAS float* tabf; const LAS float* tabb;
    __device__ __forceinline__ void operator()(const AccT& acc, const Unit& u, int wr, int wc, int fr, int fq) const {
        const int cl = wc * 32 + 8 * fq, col0 = u.pn * 256 + cl;
        const LAS float* bp = tabb + u.slot * 256 + cl;
        f32x4 bv[2][2];
#pragma unroll
        for (int bj = 0; bj < 2; ++bj) { bv[bj][0] = *(const LAS f32x4*)(bp + bj * 128); bv[bj][1] = *(const LAS f32x4*)(bp + bj * 128 + 4); }
#pragma unroll
        for (int ai = 0; ai < 2; ++ai)
#pragma unroll
            for (int m = 0; m < 4; ++m) { const int r = ai * 128 + wr * 64 + m * 16 + fr; const int idx = tab[u.slot * 256 + r];
                if (idx >= 0) { const float gv = tabf[u.slot * 256 + r] * YSCALE; unsigned char* rowp = Y + (size_t)idx * D + col0;
#pragma unroll
                    for (int bj = 0; bj < 2; ++bj) { const f32x4 v0 = (acc[ai][bj][m][0] * (1.0f / (ASCALE * WSCALE)) + bv[bj][0]) * gv, v1 = (acc[ai][bj][m][1] * (1.0f / (ASCALE * WSCALE)) + bv[bj][1]) * gv;
                        u32x2 w; w.x = cvt4_fp8(v0[0], v0[1], v0[2], v0[3]); w.y = cvt4_fp8(v1[0], v1[1], v1[2], v1[3]);
                        *(u32x2*)(rowp + bj * 128) = w; } } }
    }
};

__device__ __forceinline__ void tr_item(const float* __restrict__ W, int K, int N, bf16_t* __restrict__ WT, LAS float* scr, int kb, int nb, int lane) {
    const int k0 = kb * 64, n0 = nb * 64;
    const float* src = W + (size_t)(k0 + (lane >> 4)) * N + n0 + (lane & 15) * 4;
    f32x4 v[16];
#pragma unroll
    for (int i = 0; i < 16; ++i) v[i] = *(const f32x4*)(src + (size_t)(4 * i) * N);
#pragma unroll
    for (int i = 0; i < 16; ++i) { LAS float* d = scr + (4 * i + (lane >> 4)) * 65 + (lane & 15) * 4; d[0] = v[i][0]; d[1] = v[i][1]; d[2] = v[i][2]; d[3] = v[i][3]; }
    LDS_WAIT();
    const int c = lane & 7;
#pragma unroll
    for (int j = 0; j < 8; ++j) { const int n = 8 * j + (lane >> 3); const LAS float* s = scr + (8 * c) * 65 + n;
        u32x4 o; o.x = cvt_pk_bf16(s[0], s[65]); o.y = cvt_pk_bf16(s[130], s[195]); o.z = cvt_pk_bf16(s[260], s[325]); o.w = cvt_pk_bf16(s[390], s[455]);
        *(u32x4*)(WT + (size_t)(n0 + n) * K + k0 + 8 * c) = o; }
    LDS_WAIT();
}
struct Item8 { const float* src; unsigned char* dst; int N; };
__device__ __forceinline__ void chunk8_load(const Item8& d, int ch, f32x4 (&v)[16], int lane) {
    const float* base = d.src + (size_t)(32 * ch + 4 * (lane >> 5)) * d.N + (lane & 31) * 4;
#pragma unroll
    for (int sl = 0; sl < 4; ++sl)
#pragma unroll
        for (int j = 0; j < 4; ++j) v[4 * sl + j] = __builtin_nontemporal_load((const f32x4*)(base + (size_t)(8 * sl + j) * d.N));
}
__device__ __forceinline__ void chunk8_cvt(int ch, const f32x4 (&v)[16], LAS unsigned* scr, int lane) {
    const int nq = lane & 31, kq0 = lane >> 5, sw = (nq & 7) << 2;
#pragma unroll
    for (int sl = 0; sl < 4; ++sl) { const int kw = 8 * ch + kq0 + 2 * sl;
#pragma unroll
        for (int i = 0; i < 4; ++i) scr[(4 * nq + i) * 32 + (kw ^ sw)] = cvt4_fp8(v[4 * sl][i] * WSCALE, v[4 * sl + 1][i] * WSCALE, v[4 * sl + 2][i] * WSCALE, v[4 * sl + 3][i] * WSCALE); }
}
__device__ __forceinline__ void item8_flush(const Item8& d, const LAS unsigned* scr, int lane) {
    LDS_WAIT();
    const int c16 = lane & 7;
#pragma unroll
    for (int jj = 0; jj < 16; ++jj) { const int n = (lane >> 3) + 8 * jj;
        const u32x4 o = *(const LAS u32x4*)(scr + n * 32 + ((c16 ^ ((n >> 2) & 7)) << 2));
        __builtin_nontemporal_store(o, (u32x4*)(d.dst + (size_t)n * D + 16 * c16)); }
    LDS_WAIT();
}
__device__ __forceinline__ int t5_bucket(int dist) {
    if (dist < 16) return dist;
    const int large = 16 + (int)(logf((float)dist / 16.0f) / 4.852030263919617f * 16.0f);
    return large < 31 ? large : 31;
}
struct In { const float *x, *norm1_g, *w_in, *pool_w, *pool_scale, *rel_bias, *w_out, *norm2_g, *router_w, *router_b, *w_gate_up, *b_gate_up, *w_down, *b_down, *final_g; };

constexpr int N8_ALL = NE * 128 + NE * 64;
__device__ __forceinline__ void convert8_queue(LAS unsigned char* lds, const In& in, unsigned char* ws, unsigned* qword) {
    const int lane = threadIdx.x & 63, wave = __builtin_amdgcn_readfirstlane((int)threadIdx.x >> 6);
    constexpr int IG = 8 * 16, ID = 8 * 8;
    auto desc = [&](int r) -> Item8 { Item8 d;
        if (r < NE * IG) { const int e = r / IG, q = r % IG, kb = q / 16, nb = q % 16;
            d.src = in.w_gate_up + (size_t)e * D * 2 * DFF + (size_t)(kb * 128) * (2 * DFF) + nb * 128; d.N = 2 * DFF; d.dst = ws + WS_WGU + (size_t)e * 2 * DFF * D + (size_t)(nb * 128) * D + kb * 128; }
        else { const int r2 = r - NE * IG, e = r2 / ID, q = r2 % ID, kb = q / 8, nb = q % 8;
            d.src = in.w_down + (size_t)e * DFF * D + (size_t)(kb * 128) * D + nb * 128; d.N = D; d.dst = ws + WS_WD + (size_t)e * D * DFF + (size_t)(nb * 128) * DFF + kb * 128; }
        return d; };
    auto claim = [&]() -> int { unsigned v = 0; if (lane == 0) v = __hip_atomic_fetch_add(qword, 1u, __ATOMIC_RELAXED, __HIP_MEMORY_SCOPE_AGENT); return __builtin_amdgcn_readfirstlane((int)v); };
    LAS unsigned* scr8 = (LAS unsigned*)(lds + wave * 16384);
    f32x4 va[16], vb[16];
    int it = claim();
    if (it < N8_ALL) { const Item8 d0 = desc(it); chunk8_load(d0, 0, va, lane); }
    while (it < N8_ALL) {
        const Item8 d = desc(it);
        const int nx = claim();
        chunk8_load(d, 1, vb, lane); chunk8_cvt(0, va, scr8, lane);
        chunk8_load(d, 2, va, lane); chunk8_cvt(1, vb, scr8, lane);
        chunk8_load(d, 3, vb, lane); chunk8_cvt(2, va, scr8, lane);
        if (nx < N8_ALL) { const Item8 dn = desc(nx); chunk8_load(dn, 0, va, lane); }
        chunk8_cvt(3, vb, scr8, lane);
        item8_flush(d, scr8, lane);
        it = nx;
    }
}
__device__ __forceinline__ void p0_prologue(LAS unsigned char* lds, const In& in, unsigned char* ws, int G, int c) {
    const int tid = threadIdx.x, lane = tid & 63, wave = __builtin_amdgcn_readfirstlane(tid >> 6);
    const int gw = c * 8 + wave, NGW = G * 8;
    LAS float* scr = (LAS float*)(lds + wave * 16640);
    constexpr int I_IN = 16 * 40, I_OUT = 16 * 16, I_GU1 = 16 * 32, I_D1 = 16 * 16;
    for (int it = gw; it < I_IN; it += NGW) tr_item(in.w_in, D, NPROJ, (bf16_t*)(ws + WS_WIN), scr, it / 40, it % 40, lane);
#ifndef MK_DOUBLE
#define MK_DOUBLE 0
#endif
    for (int repr_ = 0; repr_ < (((MK_DOUBLE >> 11) & 1) ? 2 : 1); ++repr_) {
        f32x4 gv[4];
#pragma unroll
        for (int j = 0; j < 4; ++j) gv[j] = *(const f32x4*)(in.norm1_g + 4 * lane + 256 * j);
        bf16_t* H = (bf16_t*)(ws + WS_H);
        f32x4 v[4], vn[4];
        int m = gw;
        if (m < S) {
#pragma unroll
            for (int j = 0; j < 4; ++j) v[j] = __builtin_nontemporal_load((const f32x4*)(in.x + (size_t)m * D + 4 * lane + 256 * j)); }
        for (; m < S; m += NGW) {
            const int mn = m + NGW;
            if (mn < S) {
#pragma unroll
                for (int j = 0; j < 4; ++j) vn[j] = __builtin_nontemporal_load((const f32x4*)(in.x + (size_t)mn * D + 4 * lane + 256 * j)); }
            float s = 0.f;
#pragma unroll
            for (int j = 0; j < 4; ++j) s += (v[j][0] * v[j][0] + v[j][1] * v[j][1]) + (v[j][2] * v[j][2] + v[j][3] * v[j][3]);
            const float rstd = rsqrtf(wave_sum(s) * (1.0f / D) + RMS_EPS);
#pragma unroll
            for (int j = 0; j < 4; ++j) { const f32x4 o = v[j] * rstd * gv[j]; u32x2 w; w.x = cvt_pk_bf16(o[0], o[1]); w.y = cvt_pk_bf16(o[2], o[3]); *(u32x2*)(H + (size_t)m * D + 4 * lane + 256 * j) = w; }
#pragma unroll
            for (int j = 0; j < 4; ++j) v[j] = vn[j];
        }
    }
}
__device__ __forceinline__ void p0_side(LAS unsigned char* lds, const In& in, unsigned char* ws, int n0, int c0) {
    const int tid = threadIdx.x, lane = tid & 63, wave = __builtin_amdgcn_readfirstlane(tid >> 6);
    LAS float* scr = (LAS float*)(lds + wave * 16640);
    for (int it = c0 * 8 + wave; it < 16 * 16; it += n0 * 8) tr_item(in.w_out, D, D, (bf16_t*)(ws + WS_WOUT), scr, it / 16, it % 16, lane);
    const int gt = c0 * 512 + tid, NGT = n0 * 512;
    { float* GWT = (float*)(ws + WS_GWT); for (int i = gt; i < NE * D; i += NGT) { const int e = i >> 10, k = i & 1023; GWT[i] = in.norm2_g[k] * in.router_w[k * NE + e]; } }
    { float* BT = (float*)(ws + WS_BT); for (int i = gt; i < 36 * BT_N; i += NGT) { const int bh = i / BT_N, j = i % BT_N, b = bh / NH, h = bh % NH, dil = (b == 0) ? 1 : (b == 1 ? 4 : 16), d = j - BT_OFF;
        BT[i] = (d >= 0 && d <= 128) ? in.rel_bias[t5_bucket(d * dil) * NH + h] * LOG2E : NEGBIG; } }
    { bf16_t* PWT = (bf16_t*)(ws + WS_PWT); for (int i = gt; i < 4 * 64 * 64; i += NGT) { const int g = i >> 12, d = (i >> 6) & 63, cc = i & 63; PWT[i] = (bf16_t)(cvt_pk_bf16(in.pool_w[g * 4096 + cc * 64 + d], 0.f) & 0xffffu); } }
}

__device__ __forceinline__ s16x4 lds_tr16(const LAS unsigned char* p) { typedef short v4i16_t __attribute__((ext_vector_type(4))); return __builtin_bit_cast(s16x4, __builtin_amdgcn_ds_read_tr16_b64_v4i16((LAS v4i16_t*)p)); }
constexpr int ATT_UNITS = 3 * NH * 64, KV_PITCH = 144, KV_ROWS = 384, ATT_VOFF = KV_ROWS * KV_PITCH, ATT_TOFF = 2 * KV_ROWS * KV_PITCH, ATT_NEGOFF = ATT_TOFF + BT_N * 4;
__device__ __forceinline__ void attn_decode(int uid, int& b, int& h, int& r, int& j, int& dil) {
    const int bh = uid >> 6, x = uid & 63; b = bh / NH; h = bh % NH; dil = (b == 0) ? 1 : (b == 1 ? 4 : 16);
    const int nb = 64 / dil; r = x / nb; j = x % nb;
}
__device__ __forceinline__ void attn_phase(LAS unsigned char* lds, const bf16_t* __restrict__ Qg, const bf16_t* __restrict__ Kg, const bf16_t* __restrict__ Vg, const float* __restrict__ BT,
                                           bf16_t* __restrict__ OP, float* __restrict__ LSE, int G, int c) {
    const int tid = threadIdx.x, lane = tid & 63, w = __builtin_amdgcn_readfirstlane(tid >> 6), ql = lane & 15, g = lane >> 4;
    LAS unsigned char* Ks = lds; LAS unsigned char* Vs = lds + ATT_VOFF; LAS float* Tb = (LAS float*)(lds + ATT_TOFF); LAS float* Tneg = (LAS float*)(lds + ATT_NEGOFF);
    if (tid < 16) Tneg[tid] = NEGBIG;
    u32x4 kpre[6], vpre[6]; bf16x8 qa0, qa1, qb0, qb1; float tpre = 0.f;
#define ATT_PREFETCH(uid_) do { int b_, h_, r_, j_, dil_; attn_decode((uid_), b_, h_, r_, j_, dil_); \
        _Pragma("unroll") for (int cc = 0; cc < 6; ++cc) { const int id = tid + 512 * cc, row = id >> 3, ch = id & 7; int mm = 256 * j_ - 128 + row; if (mm < 0) mm += 128; \
            const size_t off = (size_t)(r_ + dil_ * mm) * AW + h_ * HD + ch * 8; kpre[cc] = *(const u32x4*)(Kg + off); vpre[cc] = *(const u32x4*)(Vg + off); } \
        { const size_t qo = (size_t)(r_ + dil_ * (256 * j_ + 32 * w + ql)) * AW + h_ * HD + 8 * g; const size_t qs = (size_t)16 * dil_ * AW; \
          qa0 = *(const bf16x8*)(Qg + qo); qa1 = *(const bf16x8*)(Qg + qo + 32); qb0 = *(const bf16x8*)(Qg + qo + qs); qb1 = *(const bf16x8*)(Qg + qo + qs + 32); } \
        if (tid < BT_N) tpre = BT[(b_ * NH + h_) * BT_N + tid]; } while (0)
#ifndef ATT_SYNC_LOAD
    if (c < ATT_UNITS) ATT_PREFETCH(c);
#endif
    for (int uid = c; uid < ATT_UNITS; uid += G) {
        int b, h, r, j, dil; attn_decode(uid, b, h, r, j, dil);
#ifdef ATT_SYNC_LOAD
        ATT_PREFETCH(uid);
#endif
#pragma unroll
        for (int cc = 0; cc < 6; ++cc) { const int id = tid + 512 * cc, row = id >> 3, ch = id & 7; *(LAS u32x4*)(Ks + row * KV_PITCH + ch * 16) = kpre[cc]; *(LAS u32x4*)(Vs + row * KV_PITCH + ch * 16) = vpre[cc]; }
        if (tid < BT_N) Tb[tid] = tpre;
        const bf16x8 fa0 = qa0, fa1 = qa1, fb0 = qb0, fb1 = qb1;
        __syncthreads();
#ifndef ATT_SYNC_LOAD
        if (uid + G < ATT_UNITS) ATT_PREFETCH(uid + G);
#endif
        const int kkmin = (j == 0) ? 128 : 0;
        const LAS unsigned char* kb = Ks + (32 * w + ql) * KV_PITCH + g * 16;
        const LAS float* Tq = Tb + (ql + 272 - 4 * g - 3);
        const f32x4 zero4 = (f32x4){0.f, 0.f, 0.f, 0.f};
        f32x4 sA[9], sB[9];
#pragma unroll
        for (int i = 0; i < 10; ++i) {
            const bf16x8 kf0 = *(const LAS bf16x8*)(kb + i * (16 * KV_PITCH)), kf1 = *(const LAS bf16x8*)(kb + i * (16 * KV_PITCH) + 64);
            const bool msk = (32 * w + 16 * i) < kkmin;
            if (i <= 8) { f32x4 st = __builtin_amdgcn_mfma_f32_16x16x32_bf16(kf0, fa0, zero4, 0, 0, 0); st = __builtin_amdgcn_mfma_f32_16x16x32_bf16(kf1, fa1, st, 0, 0, 0);
                const LAS float* tp = msk ? Tneg : (Tq - 16 * i); sA[i] = (f32x4){st[0] + tp[3], st[1] + tp[2], st[2] + tp[1], st[3] + tp[0]}; }
            if (i >= 1) { f32x4 st = __builtin_amdgcn_mfma_f32_16x16x32_bf16(kf0, fb0, zero4, 0, 0, 0); st = __builtin_amdgcn_mfma_f32_16x16x32_bf16(kf1, fb1, st, 0, 0, 0);
                const LAS float* tp = msk ? Tneg : (Tq - 16 * (i - 1)); sB[i - 1] = (f32x4){st[0] + tp[3], st[1] + tp[2], st[2] + tp[1], st[3] + tp[0]}; }
        }
        float mA = NEGBIG, mB = NEGBIG;
#pragma unroll
        for (int i = 0; i < 9; ++i) { mA = fmaxf(mA, fmaxf(fmaxf(sA[i][0], sA[i][1]), fmaxf(sA[i][2], sA[i][3]))); mB = fmaxf(mB, fmaxf(fmaxf(sB[i][0], sB[i][1]), fmaxf(sB[i][2], sB[i][3]))); }
        mA = fmaxf(mA, __shfl_xor(mA, 16)); mA = fmaxf(mA, __shfl_xor(mA, 32)); mB = fmaxf(mB, __shfl_xor(mB, 16)); mB = fmaxf(mB, __shfl_xor(mB, 32));
        f32x4 oA[4], oB[4];
#pragma unroll
        for (int dt = 0; dt < 4; ++dt) { oA[dt] = zero4; oB[dt] = zero4; }
        float lA = 0.f, lB = 0.f;
        const LAS unsigned char* vb = Vs + (32 * w + 4 * g + (ql >> 2)) * KV_PITCH + (ql & 3) * 8;
#pragma unroll
        for (int i = 0; i < 10; ++i) {
            const LAS unsigned char* vt = vb + i * (16 * KV_PITCH);
            const s16x4 v0 = lds_tr16(vt), v1 = lds_tr16(vt + 32), v2 = lds_tr16(vt + 64), v3 = lds_tr16(vt + 96);
            if (i <= 8) { const float p0 = __builtin_amdgcn_exp2f(sA[i][0] - mA), p1 = __builtin_amdgcn_exp2f(sA[i][1] - mA), p2 = __builtin_amdgcn_exp2f(sA[i][2] - mA), p3 = __builtin_amdgcn_exp2f(sA[i][3] - mA);
                lA += (p0 + p1) + (p2 + p3); u32x2 pw; pw.x = cvt_pk_bf16(p0, p1); pw.y = cvt_pk_bf16(p2, p3); const s16x4 pf = __builtin_bit_cast(s16x4, pw);
                oA[0] = __builtin_amdgcn_mfma_f32_16x16x16bf16_1k(v0, pf, oA[0], 0, 0, 0); oA[1] = __builtin_amdgcn_mfma_f32_16x16x16bf16_1k(v1, pf, oA[1], 0, 0, 0);
                oA[2] = __builtin_amdgcn_mfma_f32_16x16x16bf16_1k(v2, pf, oA[2], 0, 0, 0); oA[3] = __builtin_amdgcn_mfma_f32_16x16x16bf16_1k(v3, pf, oA[3], 0, 0, 0); }
            if (i >= 1) { const float p0 = __builtin_amdgcn_exp2f(sB[i - 1][0] - mB), p1 = __builtin_amdgcn_exp2f(sB[i - 1][1] - mB), p2 = __builtin_amdgcn_exp2f(sB[i - 1][2] - mB), p3 = __builtin_amdgcn_exp2f(sB[i - 1][3] - mB);
                lB += (p0 + p1) + (p2 + p3); u32x2 pw; pw.x = cvt_pk_bf16(p0, p1); pw.y = cvt_pk_bf16(p2, p3); const s16x4 pf = __builtin_bit_cast(s16x4, pw);
                oB[0] = __builtin_amdgcn_mfma_f32_16x16x16bf16_1k(v0, pf, oB[0], 0, 0, 0); oB[1] = __builtin_amdgcn_mfma_f32_16x16x16bf16_1k(v1, pf, oB[1], 0, 0, 0);
                oB[2] = __builtin_amdgcn_mfma_f32_16x16x16bf16_1k(v2, pf, oB[2], 0, 0, 0); oB[3] = __builtin_amdgcn_mfma_f32_16x16x16bf16_1k(v3, pf, oB[3], 0, 0, 0); }
        }
        lA += __shfl_xor(lA, 16); lA += __shfl_xor(lA, 32); lB += __shfl_xor(lB, 16); lB += __shfl_xor(lB, 32);
#ifdef ATT_EXP1
        lA = 1.0f; lB = 1.0f; mA = 0.f; mB = 0.f;
#pragma unroll
        for (int dt = 0; dt < 4; ++dt) { oA[dt] = zero4; oB[dt] = zero4; }
#endif
#ifdef ATT_EXP2
        lA = 1.0f; lB = 1.0f;
#pragma unroll
        for (int dt = 0; dt < 4; ++dt) { oA[dt] = zero4; oB[dt] = zero4; }
#endif
        const float iA = 1.0f / lA, iB = 1.0f / lB;
        const int posA = r + dil * (256 * j + 32 * w + ql), posB = posA + 16 * dil;
        bf16_t* dA = OP + ((size_t)b * S + posA) * AW + h * HD + 4 * g; bf16_t* dB = OP + ((size_t)b * S + posB) * AW + h * HD + 4 * g;
#pragma unroll
        for (int dt = 0; dt < 4; ++dt) { u32x2 t; t.x = cvt_pk_bf16(oA[dt][0] * iA, oA[dt][1] * iA); t.y = cvt_pk_bf16(oA[dt][2] * iA, oA[dt][3] * iA); *(u32x2*)(dA + 16 * dt) = t;
            u32x2 t2; t2.x = cvt_pk_bf16(oB[dt][0] * iB, oB[dt][1] * iB); t2.y = cvt_pk_bf16(oB[dt][2] * iB, oB[dt][3] * iB); *(u32x2*)(dB + 16 * dt) = t2; }
        if (g == 0) { LSE[((size_t)b * S + posA) * NH + h] = mA + __builtin_amdgcn_logf(lA); LSE[((size_t)b * S + posB) * NH + h] = mB + __builtin_amdgcn_logf(lB); }
        __syncthreads();
    }
#undef ATT_PREFETCH
}

__device__ __forceinline__ void pool_phase(LAS unsigned char* lds, const bf16_t* __restrict__ U, const bf16_t* __restrict__ PWT, const float* __restrict__ pool_scale, bf16_t* __restrict__ MIX, int G, int c) {
    const int tid = threadIdx.x, lane = tid & 63, w = __builtin_amdgcn_readfirstlane(tid >> 6), ql = lane & 15, g = lane >> 4;
    LAS unsigned char* Us = lds; LAS unsigned char* Pl = lds + 40960;
    for (int pu = c; pu < S / 64; pu += G) {
        const int t0 = pu * 64;
        for (int id = tid; id < 79 * 32; id += 512) { const int row = id >> 5, ch = id & 31, t = t0 - 15 + row;
            u32x4 v = (u32x4){0u, 0u, 0u, 0u}; if (t >= 0) v = *(const u32x4*)(U + (size_t)t * PW + ch * 8);
            *(LAS u32x4*)(Us + row * 512 + ch * 16) = v; }
        __syncthreads();
        { const int cch = tid & 255, th = tid >> 8, gg = cch >> 6, wn = 2 << gg, tl0 = 32 * th;
          const LAS bf16_t* up = (const LAS bf16_t*)Us + cch;
#define UAT(row) __uint_as_float(((unsigned)up[(row) * 256]) << 16)
          float sum = 0.f;
          for (int i = 0; i < wn; ++i) sum += UAT(tl0 + 15 - i);
          for (int tl = tl0; tl < tl0 + 32; ++tl) {
              if (tl > tl0) sum += UAT(tl + 15) - UAT(tl + 15 - wn);
              const int t = t0 + tl; const int cnt = (t + 1 < wn) ? (t + 1) : wn;
              const float val = sum / (float)cnt - UAT(tl + 15);
              ((LAS bf16_t*)(Pl + tl * 528))[cch] = (bf16_t)(cvt_pk_bf16(val, 0.f) & 0xffffu);
          }
#undef UAT
        }
        __syncthreads();
        { const int tt = w & 3, gp = w >> 2;
#pragma unroll
          for (int gi = 0; gi < 2; ++gi) { const int gg = 2 * gp + gi;
              const bf16x8 b0 = *(const LAS bf16x8*)(Pl + (16 * tt + ql) * 528 + (gg * 64 + 8 * g) * 2), b1 = *(const LAS bf16x8*)(Pl + (16 * tt + ql) * 528 + (gg * 64 + 32 + 8 * g) * 2);
#pragma unroll
              for (int nt = 0; nt < 4; ++nt) {
                  const bf16_t* ap = PWT + ((size_t)(gg * 64 + 16 * nt + ql) * 64 + 8 * g);
                  const bf16x8 a0 = *(const bf16x8*)(ap), a1 = *(const bf16x8*)(ap + 32);
                  f32x4 acc = __builtin_amdgcn_mfma_f32_16x16x32_bf16(a0, b0, (f32x4){0.f, 0.f, 0.f, 0.f}, 0, 0, 0);
                  acc = __builtin_amdgcn_mfma_f32_16x16x32_bf16(a1, b1, acc, 0, 0, 0);
                  const f32x4 ps = *(const f32x4*)(pool_scale + gg * 64 + 16 * nt + 4 * g);
                  u32x2 o; o.x = cvt_pk_bf16(acc[0] * ps[0], acc[1] * ps[1]); o.y = cvt_pk_bf16(acc[2] * ps[2], acc[3] * ps[3]);
                  *(u32x2*)(MIX + (size_t)(t0 + 16 * tt + ql) * D + gg * 64 + 16 * nt + 4 * g) = o;
              } }
        }
        __syncthreads();
    }
}

__device__ __forceinline__ void combine_phase(const bf16_t* __restrict__ OP, const float* __restrict__ LSE, bf16_t* __restrict__ MIX, int G, int c) {
    const int gt = c * 512 + threadIdx.x, NGT = G * 512;
    for (int id = gt; id < S * 96; id += NGT) {
        const int t = id / 96, rem = id % 96, h = rem >> 3, c8 = rem & 7;
        const float l0 = LSE[(size_t)t * NH + h], l1 = LSE[((size_t)S + t) * NH + h], l2 = LSE[((size_t)2 * S + t) * NH + h];
        const float mx = fmaxf(l0, fmaxf(l1, l2));
        float w0 = __builtin_amdgcn_exp2f(l0 - mx), w1 = __builtin_amdgcn_exp2f(l1 - mx), w2 = __builtin_amdgcn_exp2f(l2 - mx);
        const float inv = 1.0f / (w0 + w1 + w2); w0 *= inv; w1 *= inv; w2 *= inv;
        const size_t off = (size_t)t * AW + h * HD + c8 * 8;
        const u32x4 a = __builtin_nontemporal_load((const u32x4*)(OP + off)), b = __builtin_nontemporal_load((const u32x4*)(OP + (size_t)S * AW + off)), cc = __builtin_nontemporal_load((const u32x4*)(OP + (size_t)2 * S * AW + off));
        u32x4 o;
#pragma unroll
        for (int k = 0; k < 4; ++k) { const float lo = w0 * bf_lo(a[k]) + w1 * bf_lo(b[k]) + w2 * bf_lo(cc[k]), hi = w0 * bf_hi(a[k]) + w1 * bf_hi(b[k]) + w2 * bf_hi(cc[k]); o[k] = cvt_pk_bf16(lo, hi); }
        *(u32x4*)(MIX + (size_t)t * D + PW + h * HD + c8 * 8) = o;
    }
}

constexpr int GWB_PITCH = 2064;
constexpr int RT_GWL = NE * GWB_PITCH, RT_G2 = 2 * NE * GWB_PITCH, RT_LG = RT_G2 + 4096, RT_RS = RT_LG + 4 * 16 * 33 * 4, RT_CNT = RT_RS + 256, RT_PART = RT_CNT + 256, RT_END = RT_PART + 4 * 64 * 9 * 4;
static_assert(RT_END <= LDS_CTL, "router LDS map");
__device__ __forceinline__ void split_bf16(const f32x4& a0, const f32x4& a1, bf16x8& hi, bf16x8& lo) {
    u32x4 h, l;
    h.x = cvt_pk_bf16(a0[0], a0[1]); h.y = cvt_pk_bf16(a0[2], a0[3]); h.z = cvt_pk_bf16(a1[0], a1[1]); h.w = cvt_pk_bf16(a1[2], a1[3]);
    l.x = cvt_pk_bf16(a0[0] - bf_lo(h.x), a0[1] - bf_hi(h.x)); l.y = cvt_pk_bf16(a0[2] - bf_lo(h.y), a0[3] - bf_hi(h.y));
    l.z = cvt_pk_bf16(a1[0] - bf_lo(h.z), a1[1] - bf_hi(h.z)); l.w = cvt_pk_bf16(a1[2] - bf_lo(h.w), a1[3] - bf_hi(h.w));
    hi = __builtin_bit_cast(bf16x8, h); lo = __builtin_bit_cast(bf16x8, l);
}
__device__ __forceinline__ unsigned trunc_pk(float lo, float hi) { return (__float_as_uint(lo) >> 16) | (__float_as_uint(hi) & 0xffff0000u); }
__device__ __forceinline__ float trunc_res(float x) { return x - __uint_as_float(__float_as_uint(x) & 0xffff0000u); }
__device__ __forceinline__ void split_trunc(const f32x4& a0, const f32x4& a1, bf16x8& hi, bf16x8& lo) {
    u32x4 h, l;
    h.x = trunc_pk(a0[0], a0[1]); h.y = trunc_pk(a0[2], a0[3]); h.z = trunc_pk(a1[0], a1[1]); h.w = trunc_pk(a1[2], a1[3]);
    l.x = trunc_pk(trunc_res(a0[0]), trunc_res(a0[1])); l.y = trunc_pk(trunc_res(a0[2]), trunc_res(a0[3])); l.z = trunc_pk(trunc_res(a1[0]), trunc_res(a1[1])); l.w = trunc_pk(trunc_res(a1[2]), trunc_res(a1[3]));
    hi = __builtin_bit_cast(bf16x8, h); lo = __builtin_bit_cast(bf16x8, l);
}
__device__ __forceinline__ void router_phase(LAS unsigned char* lds, const float* __restrict__ X1, const float* __restrict__ g2, const float* __restrict__ GWT, const float* __restrict__ rb,
                                             unsigned char* __restrict__ H, float* __restrict__ RSTD, float* __restrict__ GATES, int* __restrict__ ROWS, unsigned* __restrict__ COUNTS, int G, int c) {
    const int tid = threadIdx.x, lane = tid & 63, w = __builtin_amdgcn_readfirstlane(tid >> 6), ql = lane & 15, g = lane >> 4;
    const int ts = w & 3, kh = w >> 2;
    LAS unsigned char* GWH = lds; LAS unsigned char* GWL = lds + RT_GWL;
    LAS float* G2 = (LAS float*)(lds + RT_G2);
    LAS float* LG = (LAS float*)(lds + RT_LG) + ts * (16 * 33);
    LAS float* RS = (LAS float*)(lds + RT_RS) + ts * 16;
    LAS int* LCNT = (LAS int*)(lds + RT_CNT);
    LAS int* LBASE = LCNT + 32;
    LAS float* PART = (LAS float*)(lds + RT_PART) + ts * (64 * 9);
    const int nrounds = (S / 16 + 4 * G - 1) / (4 * G);
    for (int rd = 0; rd < nrounds; ++rd) {
        const int tile = (rd * 4 + ts) * G + c;
        const bool active = tile < S / 16;
        const int tok = (active ? tile : 0) * 16 + ql;
        const float* xr = X1 + (size_t)tok * D + kh * 512 + 8 * g;
        f32x4 av[16];
        if (active) {
#pragma unroll
            for (int i = 0; i < 8; ++i) { av[2 * i] = __builtin_nontemporal_load((const f32x4*)(xr + 32 * i)); av[2 * i + 1] = __builtin_nontemporal_load((const f32x4*)(xr + 32 * i + 4)); } }
        if (rd == 0) {
            for (int id = tid; id < NE * 128; id += 512) { const int e = id >> 7, k8 = id & 127; const f32x4 x0 = *(const f32x4*)(GWT + e * D + k8 * 8), x1v = *(const f32x4*)(GWT + e * D + k8 * 8 + 4);
                bf16x8 hi, lo; split_bf16(x0, x1v, hi, lo); *(LAS bf16x8*)(GWH + e * GWB_PITCH + k8 * 16) = hi; *(LAS bf16x8*)(GWL + e * GWB_PITCH + k8 * 16) = lo; }
            if (tid < 256) *(LAS f32x4*)(G2 + tid * 4) = *(const f32x4*)(g2 + tid * 4);
        }
        if (tid < 32) LCNT[tid] = 0;
        __syncthreads();
        int ek[4] = {0, 0, 0, 0}, lp[4] = {0, 0, 0, 0}; float gk[4] = {0.f, 0.f, 0.f, 0.f};
        f32x4 acc0 = (f32x4){0.f, 0.f, 0.f, 0.f}, acc1 = acc0; float ss = 0.f;
        if (active) {
            f32x4 accA[6], accB[6];
#pragma unroll
            for (int t = 0; t < 6; ++t) { accA[t] = (f32x4){0.f, 0.f, 0.f, 0.f}; accB[t] = accA[t]; }

            unsigned char* hr = H + (size_t)tok * D + kh * 512 + 8 * g;
            const LAS unsigned char* bh0 = GWH + ql * GWB_PITCH + (kh * 512 + 8 * g) * 2; const LAS unsigned char* bh1 = bh0 + 16 * GWB_PITCH;
            const LAS unsigned char* bl0 = GWL + ql * GWB_PITCH + (kh * 512 + 8 * g) * 2; const LAS unsigned char* bl1 = bl0 + 16 * GWB_PITCH;
            const LAS float* gp = G2 + kh * 512 + 8 * g;
#pragma unroll
            for (int kb = 0; kb < 512; kb += 256) {
                if (kb > 0) {
#pragma unroll
                    for (int i = 0; i < 8; ++i) { av[2 * i] = __builtin_nontemporal_load((const f32x4*)(xr + kb + 32 * i)); av[2 * i + 1] = __builtin_nontemporal_load((const f32x4*)(xr + kb + 32 * i + 4)); } }
#pragma unroll
                for (int i = 0; i < 8; ++i) {
                    const int k0 = kb + 32 * i; const f32x4 a0 = av[2 * i], a1 = av[2 * i + 1];
                    const f32x4 n0 = *(const LAS f32x4*)(gp + k0), n1 = *(const LAS f32x4*)(gp + k0 + 4);
                    const bf16x8 wh0 = *(const LAS bf16x8*)(bh0 + k0 * 2), wh1 = *(const LAS bf16x8*)(bh1 + k0 * 2), wl0 = *(const LAS bf16x8*)(bl0 + k0 * 2), wl1 = *(const LAS bf16x8*)(bl1 + k0 * 2);
                    ss += (a0[0] * a0[0] + a0[1] * a0[1]) + (a0[2] * a0[2] + a0[3] * a0[3]) + (a1[0] * a1[0] + a1[1] * a1[1]) + (a1[2] * a1[2] + a1[3] * a1[3]);
                    u32x2 hv; hv.x = cvt4_fp8(a0[0] * n0[0] * HSCALE, a0[1] * n0[1] * HSCALE, a0[2] * n0[2] * HSCALE, a0[3] * n0[3] * HSCALE);
                    hv.y = cvt4_fp8(a1[0] * n1[0] * HSCALE, a1[1] * n1[1] * HSCALE, a1[2] * n1[2] * HSCALE, a1[3] * n1[3] * HSCALE);
                    *(u32x2*)(hr + k0) = hv;
                    bf16x8 ah, al; split_bf16(a0, a1, ah, al);


                    __builtin_amdgcn_sched_barrier(0); asm volatile("s_nop 7" ::: "memory"); __builtin_amdgcn_sched_barrier(0);
                    f32x4 (&q)[6] = (i & 1) ? accB : accA;
                    q[0] = __builtin_amdgcn_mfma_f32_16x16x32_bf16(ah, wh0, q[0], 0, 0, 0); q[1] = __builtin_amdgcn_mfma_f32_16x16x32_bf16(ah, wh1, q[1], 0, 0, 0);
                    q[2] = __builtin_amdgcn_mfma_f32_16x16x32_bf16(ah, wl0, q[2], 0, 0, 0); q[3] = __builtin_amdgcn_mfma_f32_16x16x32_bf16(ah, wl1, q[3], 0, 0, 0);
                    q[4] = __builtin_amdgcn_mfma_f32_16x16x32_bf16(al, wh0, q[4], 0, 0, 0); q[5] = __builtin_amdgcn_mfma_f32_16x16x32_bf16(al, wh1, q[5], 0, 0, 0);

                    __builtin_amdgcn_sched_barrier(0); asm volatile("s_nop 15\n\ts_nop 15" ::: "memory"); __builtin_amdgcn_sched_barrier(0);

                }
            }

            acc0 = ((accA[0] + accB[0]) + (accA[2] + accB[2])) + (accA[4] + accB[4]); acc1 = ((accA[1] + accB[1]) + (accA[3] + accB[3])) + (accA[5] + accB[5]);


            if (kh == 1) { LAS float* pp = PART + lane * 9;
#pragma unroll
                for (int i = 0; i < 4; ++i) { pp[i] = acc0[i]; pp[4 + i] = acc1[i]; } pp[8] = ss; }
        }
        __syncthreads();
        if (active && kh == 0) {
            { const LAS float* pp = PART + lane * 9;
#pragma unroll
              for (int i = 0; i < 4; ++i) { acc0[i] += pp[i]; acc1[i] += pp[4 + i]; } ss += pp[8]; }
            ss += __shfl_xor(ss, 16); ss += __shfl_xor(ss, 32);
            const float rstd = rsqrtf(ss * (1.0f / D) + RMS_EPS);
            if (g == 0) { RSTD[tok] = rstd; RS[ql] = rstd; }
            LDS_WAIT();
            const float rb0 = rb[ql], rb1 = rb[16 + ql];
#pragma unroll
            for (int rg = 0; rg < 4; ++rg) { const float rr = RS[4 * g + rg]; LG[(4 * g + rg) * 33 + ql] = acc0[rg] * rr + rb0; LG[(4 * g + rg) * 33 + 16 + ql] = acc1[rg] * rr + rb1; }
            LDS_WAIT();
            if (lane < 16) {
                float v[32];
#pragma unroll
                for (int e = 0; e < 32; ++e) v[e] = LG[ql * 33 + e];
                float tv[4];
#pragma unroll
                for (int r = 0; r < 4; ++r) { float best = v[0]; int bi = 0;
#pragma unroll
                    for (int e = 1; e < 32; ++e) { const bool gt = v[e] > best; best = gt ? v[e] : best; bi = gt ? e : bi; }
                    tv[r] = best; ek[r] = bi;
#pragma unroll
                    for (int e = 0; e < 32; ++e) v[e] = (e == bi) ? -INFINITY : v[e]; }
                const float e1 = __expf(tv[1] - tv[0]), e2 = __expf(tv[2] - tv[0]), e3 = __expf(tv[3] - tv[0]); const float inv = 1.0f / (1.0f + e1 + e2 + e3);
                gk[0] = inv; gk[1] = e1 * inv; gk[2] = e2 * inv; gk[3] = e3 * inv;
#pragma unroll
                for (int r = 0; r < 4; ++r) lp[r] = __hip_atomic_fetch_add(LCNT + ek[r], 1, __ATOMIC_RELAXED, __HIP_MEMORY_SCOPE_WORKGROUP);
            }
        }
        __syncthreads();
        if (tid < 32) { const int n = LCNT[tid]; int base = 0; if (n > 0) base = (int)__hip_atomic_fetch_add(COUNTS + tid, (unsigned)n, __ATOMIC_RELAXED, __HIP_MEMORY_SCOPE_AGENT); LBASE[tid] = base; }
        __syncthreads();
        if (active && kh == 0 && lane < 16) {
#pragma unroll
            for (int r = 0; r < 4; ++r) { const int pos = LBASE[ek[r]] + lp[r]; ROWS[(size_t)ek[r] * S + pos] = tok * 4 + r; GATES[tok * 4 + r] = gk[r]; }

        }
        __syncthreads();
    }
}

__device__ __forceinline__ void moe_prefix(LAS int* tpre, LAS int* lcnt, const unsigned* __restrict__ COUNTS) {
    if (threadIdx.x < 32) lcnt[threadIdx.x] = (int)COUNTS[threadIdx.x];
    __syncthreads();
    if (threadIdx.x == 0) { int acc = 0; for (int e = 0; e < NE; ++e) { tpre[e] = acc; acc += (lcnt[e] + 255) >> 8; } tpre[NE] = acc; }
    __syncthreads();
}
template <bool GU, class Prob> __device__ __forceinline__ void moe_table(const Prob& P, LAS int* tab, LAS float* tabf, LAS float* tabb, const LAS int* lcnt, const int* __restrict__ ROWS,
                                                                         const float* __restrict__ rowf, const float* __restrict__ bias) {
    Unit u;
#pragma unroll 1
    for (int i = 0; i < MAXU && P.next(i, u); ++i) {
        if (threadIdx.x < 256) { const int rr = u.pm * 256 + (int)threadIdx.x; const int idx = (rr < lcnt[u.e]) ? ROWS[(size_t)u.e * S + rr] : -1; tab[i * 256 + threadIdx.x] = idx;
            tabf[i * 256 + threadIdx.x] = GU ? rowf[idx < 0 ? 0 : (idx >> 2)] * (1.0f / (HSCALE * WSCALE)) : (idx < 0 ? 0.f : rowf[idx]); }
        else { const int j = (int)threadIdx.x - 256;
            tabb[i * 256 + j] = GU ? bias[(size_t)u.e * 2 * DFF + (j >> 7) * DFF + u.pn * 128 + (j & 127)] : bias[(size_t)u.e * D + u.pn * 256 + j]; }
    }
    __syncthreads();
}

__device__ __forceinline__ void final_phase(const float* __restrict__ X1, const unsigned char* __restrict__ Y, const float* __restrict__ fg, float* __restrict__ out, int G, int c) {
    const int tid = threadIdx.x, lane = tid & 63, wave = tid >> 6; const int gw = c * 8 + wave, NGW = G * 8;
    f32x4 gv[4];
#pragma unroll
    for (int j = 0; j < 4; ++j) gv[j] = *(const f32x4*)(fg + 4 * lane + 256 * j);
    for (int m = gw; m < S; m += NGW) {
        const float* xr = X1 + (size_t)m * D + 4 * lane;
        f32x4 v[4];
#pragma unroll
        for (int j = 0; j < 4; ++j) v[j] = __builtin_nontemporal_load((const f32x4*)(xr + 256 * j));

#pragma unroll
        for (int k = 0; k < 4; ++k) { const unsigned char* yr = Y + ((size_t)m * 4 + k) * D + 4 * lane;
#pragma unroll
            for (int j = 0; j < 4; ++j) { const int t = __builtin_nontemporal_load((const int*)(yr + 256 * j)); const f32x2 lo = __builtin_amdgcn_cvt_pk_f32_fp8(t, false), hi = __builtin_amdgcn_cvt_pk_f32_fp8(t, true);
                v[j][0] += lo[0] * (1.0f / YSCALE); v[j][1] += lo[1] * (1.0f / YSCALE); v[j][2] += hi[0] * (1.0f / YSCALE); v[j][3] += hi[1] * (1.0f / YSCALE); } }
        float s = 0.f;
#pragma unroll
        for (int j = 0; j < 4; ++j) s += (v[j][0] * v[j][0] + v[j][1] * v[j][1]) + (v[j][2] * v[j][2] + v[j][3] * v[j][3]);
        const float rstd = rsqrtf(wave_sum(s) * (1.0f / D) + RMS_EPS);
#pragma unroll
        for (int j = 0; j < 4; ++j) __builtin_nontemporal_store(v[j] * rstd * gv[j], (f32x4*)(out + (size_t)m * D + 4 * lane + 256 * j));
    }
}

constexpr int NPHASE = 9;
struct Args { In in; float* out; unsigned char* ws; int ph_lo, ph_hi; };
__global__ void __launch_bounds__(512, 2) fwd(Args args) {
    extern __shared__ __attribute__((aligned(16))) unsigned char lds_raw[];
    LAS unsigned char* lds = (LAS unsigned char*)lds_raw;
    const int tid = threadIdx.x, G = gridDim.x, c = blockIdx.x;
    unsigned char* ws = args.ws; const In& in = args.in;
    unsigned* ctl = (unsigned*)(ws + WS_CTL);
    LAS int* LCTL = (LAS int*)(lds + LDS_CTL);
    if (tid < 256) LCTL[tid] = 0;
    __syncthreads();
    const int lo = args.ph_lo, hi = args.ph_hi;
    const bool one_launch = (hi - lo) > 1;
    XcdBarrier bar; bar.bar = ctl + CW_BAR; bar.x = 0; bar.st = nullptr;
    if (one_launch) bar = xcd_barrier_post(ctl + CW_BAR, (volatile LAS unsigned*)LCTL);
#define IN(k) (lo <= (k) && (k) < hi)
#ifndef MK_DOUBLE
#define MK_DOUBLE 0
#endif
#define REP(k) for (int rep_ = 0; rep_ < ((((MK_DOUBLE) >> (k)) & 1) ? 2 : 1); ++rep_)
#define SEAM(k) do { if (IN((k) + 1)) xcd_barrier(bar); } while (0)
    bf16_t* Hb = (bf16_t*)(ws + WS_H); bf16_t* Ub = (bf16_t*)(ws + WS_U); bf16_t* Qb = (bf16_t*)(ws + WS_Q); bf16_t* Kb = (bf16_t*)(ws + WS_K); bf16_t* Vb = (bf16_t*)(ws + WS_V);
    bf16_t* OPb = (bf16_t*)(ws + WS_OP); bf16_t* MIXb = (bf16_t*)(ws + WS_MIX); float* X1 = (float*)(ws + WS_X1); unsigned char* ACTb = ws + WS_ACT; unsigned char* Yb = ws + WS_Y; unsigned char* H8 = ws + WS_H8;
    float* LSE = (float*)(ws + WS_LSE); float* RSTD = (float*)(ws + WS_RSTD); float* GATES = (float*)(ws + WS_GATES); int* ROWS = (int*)(ws + WS_ROWS); unsigned* COUNTS = ctl + CW_COUNTS;
    LAS int* TPRE = LCTL + 16; LAS int* LCNT = LCTL + 128; LAS int* TAB = (LAS int*)(lds + LDS_TAB); LAS float* TABF = (LAS float*)(lds + LDS_TAB + MAXU * 1024); LAS float* TABB = (LAS float*)(lds + LDS_TAB + 2 * MAXU * 1024);
    static_assert(LDS_TAB + 3 * MAXU * 1024 <= LDS_CTL, "MoE LDS tables");

    if (IN(0)) { REP(0) p0_prologue(lds, in, ws, G, c); SEAM(0); }
    if (IN(1)) {
        const int NG = (G >= 256) ? 160 : G;
        if (c < NG) {
            pg8::DenseProb P{(const char*)Hb, (const char*)(ws + WS_WIN), D * 2, S / 256, NPROJ / 256, NG, c, (size_t)128 * D * 2};
            EpiQKVU E{ws};
            REP(1) pg8::gemm_phase<EpiQKVU, pg8::DenseProb, true, false>(lds, P, E);
        }
        else p0_side(lds, in, ws, G - NG, c - NG);
        if (NG == G) p0_side(lds, in, ws, G, c);
        convert8_queue(lds, in, ws, ctl + CW_QUEUE);
        SEAM(1);
    }
    if (IN(2)) {
        REP(2) attn_phase(lds, Qb, Kb, Vb, (const float*)(ws + WS_BT), OPb, LSE, G, c);
        REP(9) pool_phase(lds, Ub, (const bf16_t*)(ws + WS_PWT), in.pool_scale, MIXb, G, c);
        SEAM(2);
    }
    if (IN(3)) { REP(3) combine_phase(OPb, LSE, MIXb, G, c); SEAM(3); }
    if (IN(4)) {
        pg8::DenseProb P{(const char*)MIXb, (const char*)(ws + WS_WOUT), D * 2, S / 256, D / 256, G, c, (size_t)128 * D * 2};
        EpiResF32 E{in.x, X1};
        REP(4) pg8::gemm_phase<EpiResF32, pg8::DenseProb, true, false>(lds, P, E);
        SEAM(4);
    }
    if (IN(5)) { router_phase(lds, X1, in.norm2_g, (const float*)(ws + WS_GWT), in.router_b, H8, RSTD, GATES, ROWS, COUNTS, G, c); SEAM(5); }
    if (IN(6)) {
        moe_prefix(TPRE, LCNT, COUNTS);
        pg8::MoeProb<true> P{(const char*)H8, (const char*)(ws + WS_WGU), D, 8, G, c, (size_t)DFF * D, (size_t)2 * DFF * D, 128, TPRE, TAB};
        moe_table<true>(P, TAB, TABF, TABB, LCNT, ROWS, RSTD, in.b_gate_up);
        EpiGateUp E{ACTb, TPRE, TABF, TABB};
        REP(6) pg8::gemm_phase<EpiGateUp, pg8::MoeProb<true>, true, true>(lds, P, E);
        SEAM(6);
    }
    if (IN(7)) {
        moe_prefix(TPRE, LCNT, COUNTS);
        pg8::MoeProb<false> P{(const char*)ACTb, (const char*)(ws + WS_WD), DFF, 4, G, c, (size_t)128 * DFF, (size_t)D * DFF, 256, TPRE, TAB};
        moe_table<false>(P, TAB, TABF, TABB, LCNT, ROWS, GATES, in.b_down);
        EpiDown E{Yb, TAB, TABF, TABB};
        REP(7) pg8::gemm_phase<EpiDown, pg8::MoeProb<false>, true, true>(lds, P, E);
        SEAM(7);
    }

    if (IN(8)) REP(8) final_phase(X1, Yb, in.final_g, args.out, G, c);

#undef IN
#undef SEAM
}

#ifndef MK_N_LAUNCHES
#define MK_N_LAUNCHES 1
#endif
#ifndef MK_SEQ
#define MK_SEQ "012345678"
#endif
extern "C" void kernel_launch(void* const* d_in, const int* in_sizes, int n_in, void* d_out, int out_size, void* d_ws, size_t ws_size, hipStream_t stream) {
    static int grid = 0;
    if (grid == 0) {
        if (n_in != 15 || out_size != S * D || ws_size < WS_END) { fprintf(stderr, "kernel_launch: unexpected problem (n_in %d out %d ws %zu)\n", n_in, out_size, ws_size); grid = -1; return; }
        int dev = 0, cus = 0, per_cu = 0;
        if (hipGetDevice(&dev) != hipSuccess || hipDeviceGetAttribute(&cus, hipDeviceAttributeMultiprocessorCount, dev) != hipSuccess) { grid = -1; return; }
        if (hipFuncSetAttribute((const void*)fwd, hipFuncAttributeMaxDynamicSharedMemorySize, LDS_BYTES) != hipSuccess) { fprintf(stderr, "kernel_launch: hipFuncSetAttribute failed\n"); grid = -1; return; }
        if (hipOccupancyMaxActiveBlocksPerMultiprocessor(&per_cu, (const void*)fwd, 512, LDS_BYTES) != hipSuccess || per_cu < 1) { fprintf(stderr, "kernel_launch: occupancy query says %d blocks per CU\n", per_cu); (void)hipGetLastError(); per_cu = 1; }
        grid = cus;
    }
    if (grid < 0) return;
    if (hipMemsetAsync((char*)d_ws + WS_CTL, 0, CTL_ZERO_BYTES, stream) != hipSuccess) { fprintf(stderr, "kernel_launch: memset failed\n"); return; }
    Args a{};
    a.in.x = (const float*)d_in[0]; a.in.norm1_g = (const float*)d_in[1]; a.in.w_in = (const float*)d_in[2]; a.in.pool_w = (const float*)d_in[3]; a.in.pool_scale = (const float*)d_in[4];
    a.in.rel_bias = (const float*)d_in[5]; a.in.w_out = (const float*)d_in[6]; a.in.norm2_g = (const float*)d_in[7]; a.in.router_w = (const float*)d_in[8]; a.in.router_b = (const float*)d_in[9];
    a.in.w_gate_up = (const float*)d_in[10]; a.in.b_gate_up = (const float*)d_in[11]; a.in.w_down = (const float*)d_in[12]; a.in.b_down = (const float*)d_in[13]; a.in.final_g = (const float*)d_in[14];
    a.out = (float*)d_out; a.ws = (unsigned char*)d_ws;
    if (MK_N_LAUNCHES == 1) { a.ph_lo = 0; a.ph_hi = NPHASE; hipLaunchKernelGGL(fwd, dim3(grid), dim3(512), LDS_BYTES, stream, a); }
    else { const char* seq = MK_SEQ; for (int i = 0; seq[i]; ++i) { const int p = seq[i] - '0'; a.ph_lo = p; a.ph_hi = p + 1; if (p == 5) (void)hipMemsetAsync((char*)d_ws + WS_CTL + CW_COUNTS * 4, 0, 128, stream); hipLaunchKernelGGL(fwd, dim3(grid), dim3(512), LDS_BYTES, stream, a); } }
    const hipError_t le = hipPeekAtLastError();
    if (le != hipSuccess) fprintf(stderr, "kernel_launch: launch failed: %s\n", hipGetErrorName(le));
}
```

```cpp
#include <hip/hip_runtime.h>
#include <cstdio>
#include <cstdint>

#define LAS __attribute__((address_space(3)))
#define GAS __attribute__((address_space(1)))
typedef unsigned short bf16_t;
typedef short bf16x8 __attribute__((ext_vector_type(8)));
typedef short s16x4 __attribute__((ext_vector_type(4)));
typedef float f32x4 __attribute__((ext_vector_type(4)));
typedef float f32x2 __attribute__((ext_vector_type(2)));
typedef unsigned u32x4 __attribute__((ext_vector_type(4)));
typedef unsigned u32x2 __attribute__((ext_vector_type(2)));
typedef int i32x4 __attribute__((ext_vector_type(4)));
typedef int i32x8 __attribute__((ext_vector_type(8)));

constexpr int S = 16384, D = 1024, NPROJ = 2560, PW = 256, AW = 768, NH = 12, HD = 64, NE = 32, TOPK = 4, DFF = 1024;
constexpr float RMS_EPS = 1e-5f, LOG2E = 1.4426950408889634f, QSCALE = 0.125f * LOG2E, NEGBIG = -1e30f;
constexpr float WSCALE = 64.0f, HSCALE = 16.0f, ASCALE = 8.0f, YSCALE = 64.0f, FP8MAX = 448.0f;
constexpr int BT_N = 400, BT_OFF = 144;

constexpr size_t MiB = 1u << 20;
constexpr size_t WS_CTL = 0, CTL_ZERO_BYTES = 64 * 1024;
constexpr size_t WS_WIN = 2 * MiB;
constexpr size_t WS_WOUT = 8 * MiB;
constexpr size_t WS_GWT = 10 * MiB;
constexpr size_t WS_BT = 10 * MiB + 512 * 1024;
constexpr size_t WS_PWT = 10 * MiB + 768 * 1024;
constexpr size_t WS_RSTD = 11 * MiB;
constexpr size_t WS_GATES = 11 * MiB + 256 * 1024;
constexpr size_t WS_ROWS = 12 * MiB;
constexpr size_t WS_LSE = 14 * MiB;
constexpr size_t WS_WGU = 32 * MiB;
constexpr size_t WS_WD = 160 * MiB;
constexpr size_t WS_H8 = 200 * MiB;
constexpr size_t WS_H = 224 * MiB;
constexpr size_t WS_U = 256 * MiB;
constexpr size_t WS_Q = 264 * MiB, WS_K = 288 * MiB, WS_V = 312 * MiB;
constexpr size_t WS_OP = 336 * MiB;
constexpr size_t WS_MIX = 408 * MiB;
constexpr size_t WS_X1 = 440 * MiB;
constexpr size_t WS_ACT = 512 * MiB;
constexpr size_t WS_Y = 656 * MiB;
constexpr size_t WS_END = 784 * MiB;
constexpr int ACT_ROWS = 65536 + 32 * 256;
constexpr int CW_COUNTS = 64;
constexpr int CW_QUEUE = 256;
constexpr int CW_BAR = 4096;

constexpr int LDS_BYTES = 163840;
constexpr int LDS_TAB = 131072;
constexpr int LDS_CTL = LDS_BYTES - 1024;
constexpr int MAXU = 9;

typedef __bf16 bf16x2_t __attribute__((ext_vector_type(2)));
__device__ __forceinline__ unsigned cvt_pk_bf16(float lo, float hi) { const f32x2 v = {lo, hi}; const bf16x2_t b = __builtin_convertvector(v, bf16x2_t); return __builtin_bit_cast(unsigned, b); }
__device__ __forceinline__ float clamp8(float v) { return __builtin_amdgcn_fmed3f(v, -FP8MAX, FP8MAX); }
__device__ __forceinline__ unsigned cvt4_fp8(float a, float b, float c, float d) {
    int p = __builtin_amdgcn_cvt_pk_fp8_f32(clamp8(a), clamp8(b), 0, false); p = __builtin_amdgcn_cvt_pk_fp8_f32(clamp8(c), clamp8(d), p, true); return (unsigned)p; }
__device__ __forceinline__ float bf_lo(unsigned w) { return __uint_as_float(w << 16); }
__device__ __forceinline__ float bf_hi(unsigned w) { return __uint_as_float(w & 0xffff0000u); }
__device__ __forceinline__ float wave_sum(float v) {
#pragma unroll
    for (int o = 1; o < 64; o <<= 1) v += __shfl_xor(v, o);
    return v;
}
#define LDS_WAIT() asm volatile("s_waitcnt lgkmcnt(0)" ::: "memory")
#define VM_WAIT() asm volatile("s_waitcnt vmcnt(0)" ::: "memory")

#define XB_TMO      128
#define XB_XCNT(j)  (256  + 64 * (j))
#define XB_XSUB(j)  (1280 + 64 * (j))
#define XB_XGEN(j)  (2304 + 64 * (j))
#define XB_TOP      3328
#define XB_TOPGEN   3392
#define XCD_BAR_WORDS 3456
#define XB_SPIN_CAP (1u << 18)
__device__ __forceinline__ unsigned xb_ld(unsigned* p)              { return __hip_atomic_load(p, __ATOMIC_RELAXED, __HIP_MEMORY_SCOPE_AGENT); }
__device__ __forceinline__ unsigned xb_add(unsigned* p, unsigned v) { return __hip_atomic_fetch_add(p, v, __ATOMIC_RELAXED, __HIP_MEMORY_SCOPE_AGENT); }
__device__ __forceinline__ unsigned xb_xcc_id() { return (unsigned)__builtin_amdgcn_s_getreg((3 << 11) | 20) & 0xFu; }
#define XB_SPIN(cond, bar) do { unsigned _sp = 0; while (cond) { __builtin_amdgcn_s_sleep(1); \
    if ((++_sp & 255u) == 0u) { if (xb_ld(&(bar)[XB_TMO])) break; if (_sp > XB_SPIN_CAP) { atomicAdd(&(bar)[XB_TMO], 1u); break; } } } } while (0)
struct XcdBarrier { unsigned* bar; unsigned x; volatile LAS unsigned* st; };
__device__ __forceinline__ XcdBarrier xcd_barrier_post(unsigned* bar, volatile LAS unsigned* st) {
    XcdBarrier b; b.bar = bar; b.x = xb_xcc_id(); b.st = st;
    if (threadIdx.x == 0) (void)xb_add(&bar[XB_XCNT(b.x)], 1u);
    return b;
}
__device__ __forceinline__ void xcd_barrier_complete(unsigned* bar, unsigned x, unsigned& nloc, unsigned& nx) {
    const unsigned G = gridDim.x * gridDim.y * gridDim.z;
    unsigned sum, cnt, mine, sp = 0u;
    for (;;) {
        sum = 0u; cnt = 0u; mine = 0u;
#pragma unroll
        for (unsigned j = 0; j < 16; ++j) { const unsigned c = xb_ld(&bar[XB_XCNT(j)]); sum += c; cnt += (c > 0u) ? 1u : 0u; mine = (j == x) ? c : mine; }
        if (sum == G) break;
        __builtin_amdgcn_s_sleep(1);
        if ((++sp & 255u) == 0u) { if (xb_ld(&bar[XB_TMO])) break; if (sp > XB_SPIN_CAP) { atomicAdd(&bar[XB_TMO], 1u); break; } }
    }
    nloc = mine > 0u ? mine : 1u; nx = cnt > 0u ? cnt : 1u;
}
__device__ __forceinline__ void xcd_barrier(const XcdBarrier& b) {
    asm volatile("s_waitcnt vmcnt(0)" ::: "memory");
    __syncthreads();
    if (threadIdx.x == 0) {
        unsigned* bar = b.bar;
        __builtin_amdgcn_s_waitcnt(0);
        unsigned nloc = b.st[0], nx = b.st[1];
        if (nloc == 0u) { xcd_barrier_complete(bar, b.x, nloc, nx); b.st[0] = nloc; b.st[1] = nx; }
        const unsigned old = xb_add(&bar[XB_XSUB(b.x)], 1u);
        const unsigned gen = old / nloc;
        if (old + 1u == (gen + 1u) * nloc) {
            __builtin_amdgcn_fence(__ATOMIC_RELEASE, "agent");
            asm volatile("s_waitcnt vmcnt(0)" ::: "memory");
            const unsigned og = xb_add(&bar[XB_TOP], 1u);
            const unsigned tg = og / nx;
            if (og + 1u == (tg + 1u) * nx) xb_add(&bar[XB_TOPGEN], 1u);
            else XB_SPIN(xb_ld(&bar[XB_TOPGEN]) == tg, bar);
            __builtin_amdgcn_fence(__ATOMIC_ACQUIRE, "agent");
            xb_add(&bar[XB_XGEN(b.x)], 1u);
            asm volatile("s_waitcnt vmcnt(0)" ::: "memory");
        } else {
            XB_SPIN(xb_ld(&bar[XB_XGEN(b.x)]) == gen, bar);
            __builtin_amdgcn_fence(__ATOMIC_ACQUIRE, "agent");
            asm volatile("s_waitcnt vmcnt(0)" ::: "memory");
        }
    }
    __syncthreads();
}

namespace pg8 {
constexpr int BM = 256, BK = 64, HALF = 128, HTB = HALF * BK * 2, STAGE_BYTES = 8 * HTB, NXCD = 8, WGM = 8;
__host__ __device__ __forceinline__ int lds_byte(int r, int c) { const int st = (r >> 4) * 2 + (c >> 5), rr = r & 15, cc = c & 31, ob = rr * 64 + cc * 2; return st * 1024 + (ob ^ (((ob >> 9) & 1) << 5)); }
__host__ __device__ __forceinline__ void stage_rc(int b, int& R, int& C) { const int st = b / 1024, sb = b % 1024, swz = sb ^ (((sb >> 9) & 1) << 5); R = (st >> 1) * 16 + swz / 64; C = (st & 1) * 32 + (swz % 64) / 2; }
__host__ __device__ __forceinline__ int perm32(int rho) { const int n = rho >> 4, i = rho & 15; return 8 * (i >> 2) + 4 * n + (i & 3); }

struct Unit { int pm, pn, e, slot; };

template <class Epi, class Prob, bool ALIGN_EPI, bool FP8>
__device__ __forceinline__ void gemm_phase(LAS unsigned char* lds, const Prob& P, const Epi& E) {
    const int tid = threadIdx.x, wid = __builtin_amdgcn_readfirstlane(tid >> 6), lane = tid & 63, wr = wid >> 2, wc = wid & 3, fr = lane & 15, fq = lane >> 4;
    const int rowb = P.rowb, nt = rowb / 128;
    int Rs[2], Cs[2]; unsigned voffB[2];
#pragma unroll
    for (int i = 0; i < 2; ++i) { int R, C; stage_rc(tid * 16 + i * 8192, R, C); const int Rb = Epi::PERM ? ((R & ~31) + perm32(R & 31)) : R;
        Rs[i] = R; Cs[i] = C * 2; voffB[i] = (unsigned)(Rb * rowb + C * 2); }
    const size_t kstep = (size_t)(BK * 2);
    const size_t bhalf = P.b_half;
    const unsigned ldsw = (unsigned)wid * 1024u;
    const int aoff = lds_byte(wr * 64 + fr, fq * 8), boff = lds_byte(wc * 32 + fr, fq * 8);
#define PG8_SA(b, h) (((b) * 2 + (h)) * HTB)
#define PG8_SB(b, h) ((4 + (b) * 2 + (h)) * HTB)
#define PG8_STAGE_B(bufoff, gbase) do { _Pragma("unroll") for (int _i = 0; _i < 2; ++_i) \
        __builtin_amdgcn_global_load_lds((const unsigned*)((const char*)(gbase) + voffB[_i]), (LAS unsigned*)(lds + (bufoff) + ldsw + _i * 8192), 16, 0, 0); } while (0)
#define PG8_STAGE_A(bufoff, kb, o0, o1) do { \
        __builtin_amdgcn_global_load_lds((const unsigned*)(P.A + (size_t)(o0) + (kb)), (LAS unsigned*)(lds + (bufoff) + ldsw), 16, 0, 0); \
        __builtin_amdgcn_global_load_lds((const unsigned*)(P.A + (size_t)(o1) + (kb)), (LAS unsigned*)(lds + (bufoff) + ldsw + 8192), 16, 0, 0); } while (0)
#define PG8_LDA(dst, b, h) do { _Pragma("unroll") for (int m = 0; m < 4; ++m) _Pragma("unroll") for (int k = 0; k < 2; ++k) dst[m][k] = *(const LAS bf16x8*)(lds + PG8_SA(b, h) + aoff + m * 2048 + k * 1024); } while (0)
#define PG8_LDB(dst, b, h) do { _Pragma("unroll") for (int n = 0; n < 2; ++n) _Pragma("unroll") for (int k = 0; k < 2; ++k) dst[n][k] = *(const LAS bf16x8*)(lds + PG8_SB(b, h) + boff + n * 2048 + k * 1024); } while (0)
#define PG8_MMA(ai, bj, At, Bt) do { __builtin_amdgcn_s_setprio(1); _Pragma("unroll") for (int m = 0; m < 4; ++m) _Pragma("unroll") for (int n = 0; n < 2; ++n) { \
        if constexpr (FP8) { const i32x8 fb_ = __builtin_shufflevector(__builtin_bit_cast(i32x4, Bt[n][0]), __builtin_bit_cast(i32x4, Bt[n][1]), 0, 1, 2, 3, 4, 5, 6, 7); \
            const i32x8 fa_ = __builtin_shufflevector(__builtin_bit_cast(i32x4, At[m][0]), __builtin_bit_cast(i32x4, At[m][1]), 0, 1, 2, 3, 4, 5, 6, 7); \
            acc[ai][bj][m][n] = __builtin_amdgcn_mfma_scale_f32_16x16x128_f8f6f4(fb_, fa_, acc[ai][bj][m][n], 0, 0, 0, 0, 0, 0); } \
        else { _Pragma("unroll") for (int k = 0; k < 2; ++k) acc[ai][bj][m][n] = __builtin_amdgcn_mfma_f32_16x16x32_bf16(Bt[n][k], At[m][k], acc[ai][bj][m][n], 0, 0, 0); } } \
        __builtin_amdgcn_s_setprio(0); } while (0)
#define PG8_WAIT_V(n) asm volatile("s_waitcnt vmcnt(" #n ")" ::: "memory")
#define PG8_WAIT_L(n) asm volatile("s_waitcnt lgkmcnt(" #n ")" ::: "memory")
#define PG8_BAR __builtin_amdgcn_s_barrier()
#define PG8_SCHED __builtin_amdgcn_sched_barrier(0)
    Unit cur, nxt; int ui = 0;
    if (!P.next(0, cur)) return;
    f32x4 acc[2][2][4][2];
#pragma unroll
    for (int a = 0; a < 2; ++a)
#pragma unroll
        for (int b = 0; b < 2; ++b)
#pragma unroll
            for (int m = 0; m < 4; ++m)
#pragma unroll
                for (int n = 0; n < 2; ++n) acc[a][b][m][n] = (f32x4){0.f, 0.f, 0.f, 0.f};
    bf16x8 At[4][2], B0[2][2], B1[2][2];
    unsigned c00 = P.a_off(cur, Rs[0], Cs[0]), c01 = P.a_off(cur, Rs[1], Cs[1]), c10 = P.a_off(cur, HALF + Rs[0], Cs[0]), c11 = P.a_off(cur, HALF + Rs[1], Cs[1]);
    const char* cB = P.b_base(cur);
    PG8_STAGE_B(PG8_SB(0, 0), cB); PG8_STAGE_B(PG8_SB(0, 1), cB + bhalf); PG8_STAGE_A(PG8_SA(0, 0), 0, c00, c01); PG8_STAGE_A(PG8_SA(0, 1), 0, c10, c11);
    if (wr == 1) PG8_BAR;
    PG8_WAIT_V(2); PG8_BAR;
    PG8_STAGE_B(PG8_SB(1, 0), cB + kstep); PG8_STAGE_A(PG8_SA(1, 0), kstep, c00, c01); PG8_STAGE_B(PG8_SB(1, 1), cB + bhalf + kstep);
    PG8_WAIT_V(6); PG8_BAR;
    for (;;) {
        const bool has_next = P.next(ui + 1, nxt);
        const char* nB = has_next ? P.b_base(nxt) : cB;
        for (int t = 0; t < nt; t += 2) {
            const bool last = (t == nt - 2);
            const size_t k1 = (size_t)(t + 1) * kstep;
            const size_t k2 = last ? 0 : (size_t)(t + 2) * kstep, k3 = k2 + kstep;
            const char* b2 = last ? nB : cB + (size_t)(t + 2) * kstep; const char* b3 = b2 + kstep;
            if (last && has_next) { c00 = P.a_off(nxt, Rs[0], Cs[0]); c01 = P.a_off(nxt, Rs[1], Cs[1]); }
            PG8_LDB(B0, 0, 0); PG8_LDB(B1, 0, 1); PG8_SCHED; PG8_LDA(At, 0, 0); PG8_STAGE_A(PG8_SA(1, 1), k1, c10, c11);
            PG8_WAIT_V(8); PG8_WAIT_L(0); PG8_BAR; PG8_MMA(0, 0, At, B0); PG8_MMA(0, 1, At, B1); PG8_BAR; PG8_SCHED;
            if (last && has_next) { c10 = P.a_off(nxt, HALF + Rs[0], Cs[0]); c11 = P.a_off(nxt, HALF + Rs[1], Cs[1]); }
            PG8_LDA(At, 0, 1); PG8_STAGE_B(PG8_SB(0, 0), b2); PG8_STAGE_B(PG8_SB(0, 1), b2 + bhalf); PG8_STAGE_A(PG8_SA(0, 0), k2, c00, c01);
            PG8_WAIT_V(8); PG8_WAIT_L(0); PG8_BAR; PG8_MMA(1, 0, At, B0); PG8_MMA(1, 1, At, B1); PG8_BAR; PG8_SCHED;
            PG8_LDB(B0, 1, 0); PG8_LDB(B1, 1, 1); PG8_SCHED; PG8_LDA(At, 1, 0); PG8_STAGE_A(PG8_SA(0, 1), k2, c10, c11);
            PG8_WAIT_V(8); PG8_WAIT_L(0); PG8_BAR; PG8_MMA(0, 0, At, B0); PG8_MMA(0, 1, At, B1); PG8_BAR; PG8_SCHED;
            PG8_LDA(At, 1, 1); PG8_STAGE_B(PG8_SB(1, 0), b3); PG8_STAGE_B(PG8_SB(1, 1), b3 + bhalf); PG8_STAGE_A(PG8_SA(1, 0), k3, c00, c01);
            PG8_WAIT_V(8); PG8_WAIT_L(0); PG8_BAR; PG8_MMA(1, 0, At, B0); PG8_MMA(1, 1, At, B1); PG8_BAR; PG8_SCHED;
        }
        if constexpr (ALIGN_EPI) { if (wr == 0) PG8_BAR; }
        E(acc, cur, wr, wc, fr, fq);
#if defined(MK_DOUBLE)
        if constexpr (FP8) { if ((MK_DOUBLE >> 12) & 1) { asm volatile("" ::: "memory"); E(acc, cur, wr, wc, fr, fq); } }
#endif
        if (!has_next) break;
#pragma unroll
        for (int a = 0; a < 2; ++a)
#pragma unroll
            for (int b = 0; b < 2; ++b)
#pragma unroll
                for (int m = 0; m < 4; ++m)
#pragma unroll
                    for (int n = 0; n < 2; ++n) acc[a][b][m][n] = (f32x4){0.f, 0.f, 0.f, 0.f};
        cur = nxt; cB = nB; ++ui;
        if constexpr (ALIGN_EPI) { if (wr == 1) PG8_BAR; }
    }
    PG8_WAIT_V(0);
    if constexpr (!ALIGN_EPI) { if (wr == 0) PG8_BAR; }
    PG8_BAR;
#undef PG8_SA
#undef PG8_SB
#undef PG8_STAGE_A
#undef PG8_STAGE_B
#undef PG8_LDA
#undef PG8_LDB
#undef PG8_MMA
#undef PG8_WAIT_V
#undef PG8_WAIT_L
#undef PG8_BAR
#undef PG8_SCHED
}

__device__ __forceinline__ bool static_order(int nM, int nN, int G, int c, int i, int& pm, int& pn) {
    const int nwg = nM * nN; const long L = (long)i * G + c; if (L >= nwg) return false;
    int wgid = (int)L; { const int q = nwg / NXCD, r = nwg % NXCD, xcd = wgid % NXCD, off = wgid / NXCD; wgid = (xcd < r ? xcd * (q + 1) : r * (q + 1) + (xcd - r) * q) + off; }
    const int nig = WGM * nN, gid = wgid / nig, fm = gid * WGM, gsz = (nM - fm) < WGM ? (nM - fm) : WGM;
    pm = fm + ((wgid % nig) % gsz); pn = (wgid % nig) / gsz; return true;
}
struct DenseProb {
    const char* A; const char* Bt; int rowb, nM, nN, G, c; size_t b_half;
    __device__ __forceinline__ bool next(int i, Unit& u) const { u.e = 0; u.slot = i; return static_order(nM, nN, G, c, i, u.pm, u.pn); }
    __device__ __forceinline__ unsigned a_off(const Unit& u, int row, int colb) const { return (unsigned)((u.pm * BM + row) * rowb + colb); }
    __device__ __forceinline__ const char* b_base(const Unit& u) const { return Bt + (size_t)u.pn * BM * rowb; }
};
template <bool GATHER> struct MoeProb {
    const char* A; const char* Bt; int rowb, nN, G, c; size_t b_half; size_t b_expert; int b_tile_rows;
    const LAS int* tpre; const LAS int* tab; const LAS int* udesc;
    __device__ __forceinline__ int tp(int j) const { return __builtin_amdgcn_readfirstlane(tpre[j]); }
    __device__ __forceinline__ bool search(int i, Unit& u) const {
        const int total = tpre[NE] * nN; const long L0 = (long)i * G + c; if (L0 >= total) return false;
        int L = (int)L0; { const int q = total / NXCD, r = total % NXCD, xcd = L % NXCD, off = L / NXCD; L = (xcd < r ? xcd * (q + 1) : r * (q + 1) + (xcd - r) * q) + off; }
        int e = 0;
        for (int j = 1; j < NE; ++j) e += (tpre[j] * nN <= L) ? 1 : 0;
        const int first = tpre[e] * nN, tiles = tpre[e + 1] - tpre[e], rem = L - first;
        u.e = e; u.pm = rem % tiles; u.pn = rem / tiles; u.slot = i; return true;
    }
    __device__ __forceinline__ bool next(int i, Unit& u) const {
        if (i >= MAXU) return false;
        const int v = __builtin_amdgcn_readfirstlane(udesc[4 * i + 3]); if (!v) return false;
        u.e = __builtin_amdgcn_readfirstlane(udesc[4 * i]); u.pm = __builtin_amdgcn_readfirstlane(udesc[4 * i + 1]); u.pn = __builtin_amdgcn_readfirstlane(udesc[4 * i + 2]); u.slot = i; return true;
    }
    __device__ __forceinline__ unsigned a_off(const Unit& u, int row, int colb) const {
        if (GATHER) { const int idx = tab[u.slot * 256 + row]; const int tok = idx < 0 ? 0 : (idx >> 2); return (unsigned)(tok * rowb + colb); }
        return (unsigned)(((tp(u.e) + u.pm) * BM + row) * rowb + colb);
    }
    __device__ __forceinline__ const char* b_base(const Unit& u) const { return Bt + (size_t)u.e * b_expert + (size_t)u.pn * b_tile_rows * rowb; }
};
}

using pg8::Unit;
typedef f32x4 AccT[2][2][4][2];

struct EpiQKVU {
    static constexpr bool PERM = true;
    unsigned char* ws;
    __device__ __forceinline__ void operator()(const AccT& acc, const Unit& u, int wr, int wc, int fr, int fq) const {
        static_assert(WS_K - WS_Q == WS_V - WS_K, "Q, K, V equally spaced");
        const int t = (u.pn - 1) / 3;
        const size_t boff = (u.pn == 0) ? WS_U : (WS_Q + (size_t)t * (WS_K - WS_Q));
        bf16_t* base = (bf16_t*)(ws + boff);
        const int ldc = (u.pn == 0) ? PW : AW, colt = (u.pn == 0) ? 0 : ((u.pn - 1) % 3) * 256;
        const float sc = (u.pn >= 1 && u.pn <= 3) ? QSCALE : 1.f;
        const int row0 = u.pm * 256 + wr * 64 + fr, col0 = colt + wc * 32 + 8 * fq;
#pragma unroll
        for (int ai = 0; ai < 2; ++ai)
#pragma unroll
            for (int m = 0; m < 4; ++m) { bf16_t* rowp = base + (size_t)(row0 + ai * 128 + m * 16) * ldc + col0;
#pragma unroll
                for (int bj = 0; bj < 2; ++bj) { const f32x4 v0 = acc[ai][bj][m][0] * sc, v1 = acc[ai][bj][m][1] * sc;
                    u32x4 w; w.x = cvt_pk_bf16(v0[0], v0[1]); w.y = cvt_pk_bf16(v0[2], v0[3]); w.z = cvt_pk_bf16(v1[0], v1[1]); w.w = cvt_pk_bf16(v1[2], v1[3]);
                    *(u32x4*)(rowp + bj * 128) = w; } }
    }
};
struct EpiResF32 {
    static constexpr bool PERM = false;
    const float* X; float* O;
    __device__ __forceinline__ void operator()(const AccT& acc, const Unit& u, int wr, int wc, int fr, int fq) const {
        const int row0 = u.pm * 256 + wr * 64 + fr, col0 = u.pn * 256 + wc * 32 + 4 * fq;
#pragma unroll
        for (int ai = 0; ai < 2; ++ai)
#pragma unroll
            for (int m = 0; m < 4; ++m) { const size_t off = (size_t)(row0 + ai * 128 + m * 16) * D + col0;
#pragma unroll
                for (int bj = 0; bj < 2; ++bj)
#pragma unroll
                    for (int n = 0; n < 2; ++n) { const f32x4 r = __builtin_nontemporal_load((const f32x4*)(X + off + bj * 128 + n * 16)); *(f32x4*)(O + off + bj * 128 + n * 16) = acc[ai][bj][m][n] + r; } }
    }
};
__device__ __forceinline__ float swiglu1(float g, float u) {
    g = fminf(g, 7.0f); u = fminf(fmaxf(u, -7.0f), 7.0f);
    const float s = __builtin_amdgcn_rcpf(1.0f + __builtin_amdgcn_exp2f(g * (-1.702f * LOG2E)));
    return (u + 1.0f) * (g * s);
}
__device__ __forceinline__ f32x4 swiglu4(f32x4 g, f32x4 u) {
    g = __builtin_elementwise_min(g, (f32x4){7.0f, 7.0f, 7.0f, 7.0f});
    u = __builtin_elementwise_min(__builtin_elementwise_max(u, (f32x4){-7.0f, -7.0f, -7.0f, -7.0f}), (f32x4){7.0f, 7.0f, 7.0f, 7.0f});
    const f32x4 t = g * (-1.702f * LOG2E);
    f32x4 e; e[0] = __builtin_amdgcn_exp2f(t[0]); e[1] = __builtin_amdgcn_exp2f(t[1]); e[2] = __builtin_amdgcn_exp2f(t[2]); e[3] = __builtin_amdgcn_exp2f(t[3]);
    const f32x4 d = e + 1.0f;
    f32x4 r; r[0] = __builtin_amdgcn_rcpf(d[0]); r[1] = __builtin_amdgcn_rcpf(d[1]); r[2] = __builtin_amdgcn_rcpf(d[2]); r[3] = __builtin_amdgcn_rcpf(d[3]);
    return (u * ASCALE + ASCALE) * (g * r);
}
__device__ __forceinline__ unsigned cvt4_fp8_nc(const f32x4& v) {
    int p = __builtin_amdgcn_cvt_pk_fp8_f32(v[0], v[1], 0, false); p = __builtin_amdgcn_cvt_pk_fp8_f32(v[2], v[3], p, true); return (unsigned)p; }
struct EpiGateUp {
    static constexpr bool PERM = true;
    unsigned char* ACT; const LAS int* tpre; const LAS float* tabf; const LAS float* tabb;
    __device__ __forceinline__ void operator()(const AccT& acc, const Unit& u, int wr, int wc, int fr, int fq) const {
        const int cl = wc * 32 + 8 * fq, colA = u.pn * 128 + cl;
        const LAS float* bp = tabb + u.slot * 256 + cl;
        const f32x4 bg0 = *(const LAS f32x4*)(bp), bg1 = *(const LAS f32x4*)(bp + 4), bu0 = *(const LAS f32x4*)(bp + 128), bu1 = *(const LAS f32x4*)(bp + 132);
        const int srow0 = (__builtin_amdgcn_readfirstlane(tpre[u.e]) + u.pm) * 256;
#pragma unroll
        for (int ai = 0; ai < 2; ++ai)
#pragma unroll
            for (int m = 0; m < 4; ++m) { const int r = ai * 128 + wr * 64 + m * 16 + fr; const float rs = tabf[u.slot * 256 + r];
                const f32x4 g0 = acc[ai][0][m][0] * rs + bg0, g1 = acc[ai][0][m][1] * rs + bg1, u0 = acc[ai][1][m][0] * rs + bu0, u1 = acc[ai][1][m][1] * rs + bu1;
                u32x2 w; w.x = cvt4_fp8_nc(swiglu4(g0, u0)); w.y = cvt4_fp8_nc(swiglu4(g1, u1));
                *(u32x2*)(ACT + (size_t)(srow0 + r) * DFF + colA) = w; }
    }
};
struct EpiDown {
    static constexpr bool PERM = true;
    unsigned char* Y; const LAS int* tab; const LAS float* tabf; const LAS float* tabb;
    __device__ __forceinline__ void operator()(const AccT& acc, const Unit& u, int wr, int wc, int fr, int fq) const {
        const int cl = wc * 32 + 8 * fq, col0 = u.pn * 256 + cl;
        const LAS float* bp = tabb + u.slot * 256 + cl;
        f32x4 bv[2][2];
#pragma unroll
        for (int bj = 0; bj < 2; ++bj) { bv[bj][0] = *(const LAS f32x4*)(bp + bj * 128); bv[bj][1] = *(const LAS f32x4*)(bp + bj * 128 + 4); }
#pragma unroll
        for (int ai = 0; ai < 2; ++ai)
#pragma unroll
            for (int m = 0; m < 4; ++m) { const int r = ai * 128 + wr * 64 + m * 16 + fr; const int idx = tab[u.slot * 256 + r];
                if (idx >= 0) { const float gv = tabf[u.slot * 256 + r] * YSCALE; unsigned char* rowp = Y + (size_t)idx * D + col0;
#pragma unroll
                    for (int bj = 0; bj < 2; ++bj) { const f32x4 v0 = (acc[ai][bj][m][0] * (1.0f / (ASCALE * WSCALE)) + bv[bj][0]) * gv, v1 = (acc[ai][bj][m][1] * (1.0f / (ASCALE * WSCALE)) + bv[bj][1]) * gv;
                        u32x2 w; w.x = cvt4_fp8(v0[0], v0[1], v0[2], v0[3]); w.y = cvt4_fp8(v1[0], v1[1], v1[2], v1[3]);
                        *(u32x2*)(rowp + bj * 128) = w; } } }
    }
};

__device__ __forceinline__ void tr_item(const float* __restrict__ W, int K, int N, bf16_t* __restrict__ WT, LAS float* scr, int kb, int nb, int lane) {
    const int k0 = kb * 64, n0 = nb * 64;
    const float* src = W + (size_t)(k0 + (lane >> 4)) * N + n0 + (lane & 15) * 4;
    f32x4 v[16];
#pragma unroll
    for (int i = 0; i < 16; ++i) v[i] = *(const f32x4*)(src + (size_t)(4 * i) * N);
#pragma unroll
    for (int i = 0; i < 16; ++i) { LAS float* d = scr + (4 * i + (lane >> 4)) * 65 + (lane & 15) * 4; d[0] = v[i][0]; d[1] = v[i][1]; d[2] = v[i][2]; d[3] = v[i][3]; }
    LDS_WAIT();
    const int c = lane & 7;
#pragma unroll
    for (int j = 0; j < 8; ++j) { const int n = 8 * j + (lane >> 3); const LAS float* s = scr + (8 * c) * 65 + n;
        u32x4 o; o.x = cvt_pk_bf16(s[0], s[65]); o.y = cvt_pk_bf16(s[130], s[195]); o.z = cvt_pk_bf16(s[260], s[325]); o.w = cvt_pk_bf16(s[390], s[455]);
        *(u32x4*)(WT + (size_t)(n0 + n) * K + k0 + 8 * c) = o; }
    LDS_WAIT();
}
struct Item8 { const float* src; unsigned char* dst; int N; };
__device__ __forceinline__ void chunk8_load(const Item8& d, int ch, f32x4 (&v)[16], int lane) {
    const float* base = d.src + (size_t)(32 * ch + 4 * (lane >> 5)) * d.N + (lane & 31) * 4;
#pragma unroll
    for (int sl = 0; sl < 4; ++sl)
#pragma unroll
        for (int j = 0; j < 4; ++j) v[4 * sl + j] = __builtin_nontemporal_load((const f32x4*)(base + (size_t)(8 * sl + j) * d.N));
}
__device__ __forceinline__ void chunk8_cvt(int ch, const f32x4 (&v)[16], LAS unsigned* scr, int lane) {
    const int nq = lane & 31, kq0 = lane >> 5, sw = (nq & 7) << 2;
#pragma unroll
    for (int sl = 0; sl < 4; ++sl) { const int kw = 8 * ch + kq0 + 2 * sl;
#pragma unroll
        for (int i = 0; i < 4; ++i) scr[(4 * nq + i) * 32 + (kw ^ sw)] = cvt4_fp8(v[4 * sl][i] * WSCALE, v[4 * sl + 1][i] * WSCALE, v[4 * sl + 2][i] * WSCALE, v[4 * sl + 3][i] * WSCALE); }
}
__device__ __forceinline__ void item8_flush(const Item8& d, const LAS unsigned* scr, int lane) {
    LDS_WAIT();
    const int c16 = lane & 7;
#pragma unroll
    for (int jj = 0; jj < 16; ++jj) { const int n = (lane >> 3) + 8 * jj;
        const u32x4 o = *(const LAS u32x4*)(scr + n * 32 + ((c16 ^ ((n >> 2) & 7)) << 2));
        __builtin_nontemporal_store(o, (u32x4*)(d.dst + (size_t)n * D + 16 * c16)); }
    LDS_WAIT();
}
__device__ __forceinline__ int t5_bucket(int dist) {
    if (dist < 16) return dist;
    const int large = 16 + (int)(logf((float)dist / 16.0f) / 4.852030263919617f * 16.0f);
    return large < 31 ? large : 31;
}
struct In { const float *x, *norm1_g, *w_in, *pool_w, *pool_scale, *rel_bias, *w_out, *norm2_g, *router_w, *router_b, *w_gate_up, *b_gate_up, *w_down, *b_down, *final_g; };

constexpr int N8_ALL = NE * 128 + NE * 64;
__device__ __forceinline__ void convert8_queue(LAS unsigned char* lds, const In& in, unsigned char* ws, unsigned* qword) {
    const int lane = threadIdx.x & 63, wave = __builtin_amdgcn_readfirstlane((int)threadIdx.x >> 6);
    constexpr int IG = 8 * 16, ID = 8 * 8;
    auto desc = [&](int r) -> Item8 { Item8 d;
        if (r < NE * IG) { const int e = r / IG, q = r % IG, kb = q / 16, nb = q % 16;
            d.src = in.w_gate_up + (size_t)e * D * 2 * DFF + (size_t)(kb * 128) * (2 * DFF) + nb * 128; d.N = 2 * DFF; d.dst = ws + WS_WGU + (size_t)e * 2 * DFF * D + (size_t)(nb * 128) * D + kb * 128; }
        else { const int r2 = r - NE * IG, e = r2 / ID, q = r2 % ID, kb = q / 8, nb = q % 8;
            d.src = in.w_down + (size_t)e * DFF * D + (size_t)(kb * 128) * D + nb * 128; d.N = D; d.dst = ws + WS_WD + (size_t)e * D * DFF + (size_t)(nb * 128) * DFF + kb * 128; }
        return d; };
    auto claim = [&]() -> int { unsigned v = 0; if (lane == 0) v = __hip_atomic_fetch_add(qword, 1u, __ATOMIC_RELAXED, __HIP_MEMORY_SCOPE_AGENT); return __builtin_amdgcn_readfirstlane((int)v); };
    LAS unsigned* scr8 = (LAS unsigned*)(lds + wave * 16384);
    f32x4 va[16], vb[16];
    int it = claim();
    if (it < N8_ALL) { const Item8 d0 = desc(it); chunk8_load(d0, 0, va, lane); }
    while (it < N8_ALL) {
        const Item8 d = desc(it);
        const int nx = claim();
        chunk8_load(d, 1, vb, lane); chunk8_cvt(0, va, scr8, lane);
        chunk8_load(d, 2, va, lane); chunk8_cvt(1, vb, scr8, lane);
        chunk8_load(d, 3, vb, lane); chunk8_cvt(2, va, scr8, lane);
        if (nx < N8_ALL) { const Item8 dn = desc(nx); chunk8_load(dn, 0, va, lane); }
        chunk8_cvt(3, vb, scr8, lane);
        item8_flush(d, scr8, lane);
        it = nx;
    }
}
__device__ __forceinline__ void p0_prologue(LAS unsigned char* lds, const In& in, unsigned char* ws, int G, int c) {
    const int tid = threadIdx.x, lane = tid & 63, wave = __builtin_amdgcn_readfirstlane(tid >> 6);
    const int gw = c * 8 + wave, NGW = G * 8;
    LAS float* scr = (LAS float*)(lds + wave * 16640);
    constexpr int I_IN = 16 * 40, I_OUT = 16 * 16, I_GU1 = 16 * 32, I_D1 = 16 * 16;
    for (int it = gw; it < I_IN; it += NGW) tr_item(in.w_in, D, NPROJ, (bf16_t*)(ws + WS_WIN), scr, it / 40, it % 40, lane);
#ifndef MK_DOUBLE
#define MK_DOUBLE 0
#endif
    for (int repr_ = 0; repr_ < (((MK_DOUBLE >> 11) & 1) ? 2 : 1); ++repr_) {
        f32x4 gv[4];
#pragma unroll
        for (int j = 0; j < 4; ++j) gv[j] = *(const f32x4*)(in.norm1_g + 4 * lane + 256 * j);
        bf16_t* H = (bf16_t*)(ws + WS_H);
        f32x4 v[4], vn[4];
        int m = gw;
        if (m < S) {
#pragma unroll
            for (int j = 0; j < 4; ++j) v[j] = __builtin_nontemporal_load((const f32x4*)(in.x + (size_t)m * D + 4 * lane + 256 * j)); }
        for (; m < S; m += NGW) {
            const int mn = m + NGW;
            if (mn < S) {
#pragma unroll
                for (int j = 0; j < 4; ++j) vn[j] = __builtin_nontemporal_load((const f32x4*)(in.x + (size_t)mn * D + 4 * lane + 256 * j)); }
            float s = 0.f;
#pragma unroll
            for (int j = 0; j < 4; ++j) s += (v[j][0] * v[j][0] + v[j][1] * v[j][1]) + (v[j][2] * v[j][2] + v[j][3] * v[j][3]);
            const float rstd = rsqrtf(wave_sum(s) * (1.0f / D) + RMS_EPS);
#pragma unroll
            for (int j = 0; j < 4; ++j) { const f32x4 o = v[j] * rstd * gv[j]; u32x2 w; w.x = cvt_pk_bf16(o[0], o[1]); w.y = cvt_pk_bf16(o[2], o[3]); *(u32x2*)(H + (size_t)m * D + 4 * lane + 256 * j) = w; }
#pragma unroll
            for (int j = 0; j < 4; ++j) v[j] = vn[j];
        }
    }
}
__device__ __forceinline__ void p0_side(LAS unsigned char* lds, const In& in, unsigned char* ws, int n0, int c0) {
    const int tid = threadIdx.x, lane = tid & 63, wave = __builtin_amdgcn_readfirstlane(tid >> 6);
    LAS float* scr = (LAS float*)(lds + wave * 16640);
    for (int it = c0 * 8 + wave; it < 16 * 16; it += n0 * 8) tr_item(in.w_out, D, D, (bf16_t*)(ws + WS_WOUT), scr, it / 16, it % 16, lane);
    const int gt = c0 * 512 + tid, NGT = n0 * 512;
    { float* GWT = (float*)(ws + WS_GWT); for (int i = gt; i < NE * D; i += NGT) { const int e = i >> 10, k = i & 1023; GWT[i] = in.norm2_g[k] * in.router_w[k * NE + e]; } }
    { float* BT = (float*)(ws + WS_BT); for (int i = gt; i < 36 * BT_N; i += NGT) { const int bh = i / BT_N, j = i % BT_N, b = bh / NH, h = bh % NH, dil = (b == 0) ? 1 : (b == 1 ? 4 : 16), d = j - BT_OFF;
        BT[i] = (d >= 0 && d <= 128) ? in.rel_bias[t5_bucket(d * dil) * NH + h] * LOG2E : NEGBIG; } }
    { bf16_t* PWT = (bf16_t*)(ws + WS_PWT); for (int i = gt; i < 4 * 64 * 64; i += NGT) { const int g = i >> 12, d = (i >> 6) & 63, cc = i & 63; PWT[i] = (bf16_t)(cvt_pk_bf16(in.pool_w[g * 4096 + cc * 64 + d], 0.f) & 0xffffu); } }
}

__device__ __forceinline__ s16x4 lds_tr16(const LAS unsigned char* p) { typedef short v4i16_t __attribute__((ext_vector_type(4))); return __builtin_bit_cast(s16x4, __builtin_amdgcn_ds_read_tr16_b64_v4i16((LAS v4i16_t*)p)); }
constexpr int ATT_UNITS = 3 * NH * 64, KV_PITCH = 144, KV_ROWS = 384, ATT_VOFF = KV_ROWS * KV_PITCH, ATT_TOFF = 2 * KV_ROWS * KV_PITCH, ATT_NEGOFF = ATT_TOFF + BT_N * 4;
__device__ __forceinline__ void attn_decode(int uid, int& b, int& h, int& r, int& j, int& dil) {
    const int bh = uid >> 6, x = uid & 63; b = bh / NH; h = bh % NH; dil = (b == 0) ? 1 : (b == 1 ? 4 : 16);
    const int nb = 64 / dil; r = x / nb; j = x % nb;
}
__device__ __forceinline__ void attn_phase(LAS unsigned char* lds, const bf16_t* __restrict__ Qg, const bf16_t* __restrict__ Kg, const bf16_t* __restrict__ Vg, const float* __restrict__ BT,
                                           bf16_t* __restrict__ OP, float* __restrict__ LSE, int G, int c) {
    const int tid = threadIdx.x, lane = tid & 63, w = __builtin_amdgcn_readfirstlane(tid >> 6), ql = lane & 15, g = lane >> 4;
    LAS unsigned char* Ks = lds; LAS unsigned char* Vs = lds + ATT_VOFF; LAS float* Tb = (LAS float*)(lds + ATT_TOFF); LAS float* Tneg = (LAS float*)(lds + ATT_NEGOFF);
    if (tid < 16) Tneg[tid] = NEGBIG;
    u32x4 kpre[6], vpre[6]; bf16x8 qa0, qa1, qb0, qb1; float tpre = 0.f;
#define ATT_PREFETCH(uid_) do { int b_, h_, r_, j_, dil_; attn_decode((uid_), b_, h_, r_, j_, dil_); \
        _Pragma("unroll") for (int cc = 0; cc < 6; ++cc) { const int id = tid + 512 * cc, row = id >> 3, ch = id & 7; int mm = 256 * j_ - 128 + row; if (mm < 0) mm += 128; \
            const size_t off = (size_t)(r_ + dil_ * mm) * AW + h_ * HD + ch * 8; kpre[cc] = *(const u32x4*)(Kg + off); vpre[cc] = *(const u32x4*)(Vg + off); } \
        { const size_t qo = (size_t)(r_ + dil_ * (256 * j_ + 32 * w + ql)) * AW + h_ * HD + 8 * g; const size_t qs = (size_t)16 * dil_ * AW; \
          qa0 = *(const bf16x8*)(Qg + qo); qa1 = *(const bf16x8*)(Qg + qo + 32); qb0 = *(const bf16x8*)(Qg + qo + qs); qb1 = *(const bf16x8*)(Qg + qo + qs + 32); } \
        if (tid < BT_N) tpre = BT[(b_ * NH + h_) * BT_N + tid]; } while (0)
#ifndef ATT_SYNC_LOAD
    if (c < ATT_UNITS) ATT_PREFETCH(c);
#endif
    for (int uid = c; uid < ATT_UNITS; uid += G) {
        int b, h, r, j, dil; attn_decode(uid, b, h, r, j, dil);
#ifdef ATT_SYNC_LOAD
        ATT_PREFETCH(uid);
#endif
#pragma unroll
        for (int cc = 0; cc < 6; ++cc) { const int id = tid + 512 * cc, row = id >> 3, ch = id & 7; *(LAS u32x4*)(Ks + row * KV_PITCH + ch * 16) = kpre[cc]; *(LAS u32x4*)(Vs + row * KV_PITCH + ch * 16) = vpre[cc]; }
        if (tid < BT_N) Tb[tid] = tpre;
        const bf16x8 fa0 = qa0, fa1 = qa1, fb0 = qb0, fb1 = qb1;
        __syncthreads();
#ifndef ATT_SYNC_LOAD
        if (uid + G < ATT_UNITS) ATT_PREFETCH(uid + G);
#endif
        const int kkmin = (j == 0) ? 128 : 0;
        const LAS unsigned char* kb = Ks + (32 * w + ql) * KV_PITCH + g * 16;
        const LAS float* Tq = Tb + (ql + 272 - 4 * g - 3);
        const f32x4 zero4 = (f32x4){0.f, 0.f, 0.f, 0.f};
        f32x4 sA[9], sB[9];
#pragma unroll
        for (int i = 0; i < 10; ++i) {
            const bf16x8 kf0 = *(const LAS bf16x8*)(kb + i * (16 * KV_PITCH)), kf1 = *(const LAS bf16x8*)(kb + i * (16 * KV_PITCH) + 64);
            const bool msk = (32 * w + 16 * i) < kkmin;
            if (i <= 8) { f32x4 st = __builtin_amdgcn_mfma_f32_16x16x32_bf16(kf0, fa0, zero4, 0, 0, 0); st = __builtin_amdgcn_mfma_f32_16x16x32_bf16(kf1, fa1, st, 0, 0, 0);
                const LAS float* tp = msk ? Tneg : (Tq - 16 * i); sA[i] = (f32x4){st[0] + tp[3], st[1] + tp[2], st[2] + tp[1], st[3] + tp[0]}; }
            if (i >= 1) { f32x4 st = __builtin_amdgcn_mfma_f32_16x16x32_bf16(kf0, fb0, zero4, 0, 0, 0); st = __builtin_amdgcn_mfma_f32_16x16x32_bf16(kf1, fb1, st, 0, 0, 0);
                const LAS float* tp = msk ? Tneg : (Tq - 16 * (i - 1)); sB[i - 1] = (f32x4){st[0] + tp[3], st[1] + tp[2], st[2] + tp[1], st[3] + tp[0]}; }
        }
        float mA = NEGBIG, mB = NEGBIG;
#pragma unroll
        for (int i = 0; i < 9; ++i) { mA = fmaxf(mA, fmaxf(fmaxf(sA[i][0], sA[i][1]), fmaxf(sA[i][2], sA[i][3]))); mB = fmaxf(mB, fmaxf(fmaxf(sB[i][0], sB[i][1]), fmaxf(sB[i][2], sB[i][3]))); }
        mA = fmaxf(mA, __shfl_xor(mA, 16)); mA = fmaxf(mA, __shfl_xor(mA, 32)); mB = fmaxf(mB, __shfl_xor(mB, 16)); mB = fmaxf(mB, __shfl_xor(mB, 32));
        f32x4 oA[4], oB[4];
#pragma unroll
        for (int dt = 0; dt < 4; ++dt) { oA[dt] = zero4; oB[dt] = zero4; }
        float lA = 0.f, lB = 0.f;
        const LAS unsigned char* vb = Vs + (32 * w + 4 * g + (ql >> 2)) * KV_PITCH + (ql & 3) * 8;
#pragma unroll
        for (int i = 0; i < 10; ++i) {
            const LAS unsigned char* vt = vb + i * (16 * KV_PITCH);
            const s16x4 v0 = lds_tr16(vt), v1 = lds_tr16(vt + 32), v2 = lds_tr16(vt + 64), v3 = lds_tr16(vt + 96);
            if (i <= 8) { const float p0 = __builtin_amdgcn_exp2f(sA[i][0] - mA), p1 = __builtin_amdgcn_exp2f(sA[i][1] - mA), p2 = __builtin_amdgcn_exp2f(sA[i][2] - mA), p3 = __builtin_amdgcn_exp2f(sA[i][3] - mA);
                lA += (p0 + p1) + (p2 + p3); u32x2 pw; pw.x = cvt_pk_bf16(p0, p1); pw.y = cvt_pk_bf16(p2, p3); const s16x4 pf = __builtin_bit_cast(s16x4, pw);
                oA[0] = __builtin_amdgcn_mfma_f32_16x16x16bf16_1k(v0, pf, oA[0], 0, 0, 0); oA[1] = __builtin_amdgcn_mfma_f32_16x16x16bf16_1k(v1, pf, oA[1], 0, 0, 0);
                oA[2] = __builtin_amdgcn_mfma_f32_16x16x16bf16_1k(v2, pf, oA[2], 0, 0, 0); oA[3] = __builtin_amdgcn_mfma_f32_16x16x16bf16_1k(v3, pf, oA[3], 0, 0, 0); }
            if (i >= 1) { const float p0 = __builtin_amdgcn_exp2f(sB[i - 1][0] - mB), p1 = __builtin_amdgcn_exp2f(sB[i - 1][1] - mB), p2 = __builtin_amdgcn_exp2f(sB[i - 1][2] - mB), p3 = __builtin_amdgcn_exp2f(sB[i - 1][3] - mB);
                lB += (p0 + p1) + (p2 + p3); u32x2 pw; pw.x = cvt_pk_bf16(p0, p1); pw.y = cvt_pk_bf16(p2, p3); const s16x4 pf = __builtin_bit_cast(s16x4, pw);
                oB[0] = __builtin_amdgcn_mfma_f32_16x16x16bf16_1k(v0, pf, oB[0], 0, 0, 0); oB[1] = __builtin_amdgcn_mfma_f32_16x16x16bf16_1k(v1, pf, oB[1], 0, 0, 0);
                oB[2] = __builtin_amdgcn_mfma_f32_16x16x16bf16_1k(v2, pf, oB[2], 0, 0, 0); oB[3] = __builtin_amdgcn_mfma_f32_16x16x16bf16_1k(v3, pf, oB[3], 0, 0, 0); }
        }
        lA += __shfl_xor(lA, 16); lA += __shfl_xor(lA, 32); lB += __shfl_xor(lB, 16); lB += __shfl_xor(lB, 32);
#ifdef ATT_EXP1
        lA = 1.0f; lB = 1.0f; mA = 0.f; mB = 0.f;
#pragma unroll
        for (int dt = 0; dt < 4; ++dt) { oA[dt] = zero4; oB[dt] = zero4; }
#endif
#ifdef ATT_EXP2
        lA = 1.0f; lB = 1.0f;
#pragma unroll
        for (int dt = 0; dt < 4; ++dt) { oA[dt] = zero4; oB[dt] = zero4; }
#endif
        const float iA = 1.0f / lA, iB = 1.0f / lB;
        const int posA = r + dil * (256 * j + 32 * w + ql), posB = posA + 16 * dil;
        bf16_t* dA = OP + ((size_t)b * S + posA) * AW + h * HD + 4 * g; bf16_t* dB = OP + ((size_t)b * S + posB) * AW + h * HD + 4 * g;
#pragma unroll
        for (int dt = 0; dt < 4; ++dt) { u32x2 t; t.x = cvt_pk_bf16(oA[dt][0] * iA, oA[dt][1] * iA); t.y = cvt_pk_bf16(oA[dt][2] * iA, oA[dt][3] * iA); *(u32x2*)(dA + 16 * dt) = t;
            u32x2 t2; t2.x = cvt_pk_bf16(oB[dt][0] * iB, oB[dt][1] * iB); t2.y = cvt_pk_bf16(oB[dt][2] * iB, oB[dt][3] * iB); *(u32x2*)(dB + 16 * dt) = t2; }
        if (g == 0) { LSE[((size_t)b * S + posA) * NH + h] = mA + __builtin_amdgcn_logf(lA); LSE[((size_t)b * S + posB) * NH + h] = mB + __builtin_amdgcn_logf(lB); }
        __syncthreads();
    }
#undef ATT_PREFETCH
}

__device__ __forceinline__ void pool_phase(LAS unsigned char* lds, const bf16_t* __restrict__ U, const bf16_t* __restrict__ PWT, const float* __restrict__ pool_scale, bf16_t* __restrict__ MIX, int G, int c) {
    const int tid = threadIdx.x, lane = tid & 63, w = __builtin_amdgcn_readfirstlane(tid >> 6), ql = lane & 15, g = lane >> 4;
    LAS unsigned char* Us = lds; LAS unsigned char* Pl = lds + 40960;
    for (int pu = c; pu < S / 64; pu += G) {
        const int t0 = pu * 64;
        for (int id = tid; id < 79 * 32; id += 512) { const int row = id >> 5, ch = id & 31, t = t0 - 15 + row;
            u32x4 v = (u32x4){0u, 0u, 0u, 0u}; if (t >= 0) v = *(const u32x4*)(U + (size_t)t * PW + ch * 8);
            *(LAS u32x4*)(Us + row * 512 + ch * 16) = v; }
        __syncthreads();
        { const int cch = tid & 255, th = tid >> 8, gg = cch >> 6, wn = 2 << gg, tl0 = 32 * th;
          const LAS bf16_t* up = (const LAS bf16_t*)Us + cch;
#define UAT(row) __uint_as_float(((unsigned)up[(row) * 256]) << 16)
          float sum = 0.f;
          for (int i = 0; i < wn; ++i) sum += UAT(tl0 + 15 - i);
          for (int tl = tl0; tl < tl0 + 32; ++tl) {
              if (tl > tl0) sum += UAT(tl + 15) - UAT(tl + 15 - wn);
              const int t = t0 + tl; const int cnt = (t + 1 < wn) ? (t + 1) : wn;
              const float val = sum / (float)cnt - UAT(tl + 15);
              ((LAS bf16_t*)(Pl + tl * 528))[cch] = (bf16_t)(cvt_pk_bf16(val, 0.f) & 0xffffu);
          }
#undef UAT
        }
        __syncthreads();
        { const int tt = w & 3, gp = w >> 2;
#pragma unroll
          for (int gi = 0; gi < 2; ++gi) { const int gg = 2 * gp + gi;
              const bf16x8 b0 = *(const LAS bf16x8*)(Pl + (16 * tt + ql) * 528 + (gg * 64 + 8 * g) * 2), b1 = *(const LAS bf16x8*)(Pl + (16 * tt + ql) * 528 + (gg * 64 + 32 + 8 * g) * 2);
#pragma unroll
              for (int nt = 0; nt < 4; ++nt) {
                  const bf16_t* ap = PWT + ((size_t)(gg * 64 + 16 * nt + ql) * 64 + 8 * g);
                  const bf16x8 a0 = *(const bf16x8*)(ap), a1 = *(const bf16x8*)(ap + 32);
                  f32x4 acc = __builtin_amdgcn_mfma_f32_16x16x32_bf16(a0, b0, (f32x4){0.f, 0.f, 0.f, 0.f}, 0, 0, 0);
                  acc = __builtin_amdgcn_mfma_f32_16x16x32_bf16(a1, b1, acc, 0, 0, 0);
                  const f32x4 ps = *(const f32x4*)(pool_scale + gg * 64 + 16 * nt + 4 * g);
                  u32x2 o; o.x = cvt_pk_bf16(acc[0] * ps[0], acc[1] * ps[1]); o.y = cvt_pk_bf16(acc[2] * ps[2], acc[3] * ps[3]);
                  *(u32x2*)(MIX + (size_t)(t0 + 16 * tt + ql) * D + gg * 64 + 16 * nt + 4 * g) = o;
              } }
        }
        __syncthreads();
    }
}

__device__ __forceinline__ void combine_phase(const bf16_t* __restrict__ OP, const float* __restrict__ LSE, bf16_t* __restrict__ MIX, int G, int c) {
    const int gt = c * 512 + threadIdx.x, NGT = G * 512;
    for (int id = gt; id < S * 96; id += NGT) {
        const int t = id / 96, rem = id % 96, h = rem >> 3, c8 = rem & 7;
        const float l0 = LSE[(size_t)t * NH + h], l1 = LSE[((size_t)S + t) * NH + h], l2 = LSE[((size_t)2 * S + t) * NH + h];
        const float mx = fmaxf(l0, fmaxf(l1, l2));
        float w0 = __builtin_amdgcn_exp2f(l0 - mx), w1 = __builtin_amdgcn_exp2f(l1 - mx), w2 = __builtin_amdgcn_exp2f(l2 - mx);
        const float inv = 1.0f / (w0 + w1 + w2); w0 *= inv; w1 *= inv; w2 *= inv;
        const size_t off = (size_t)t * AW + h * HD + c8 * 8;
        const u32x4 a = __builtin_nontemporal_load((const u32x4*)(OP + off)), b = __builtin_nontemporal_load((const u32x4*)(OP + (size_t)S * AW + off)), cc = __builtin_nontemporal_load((const u32x4*)(OP + (size_t)2 * S * AW + off));
        u32x4 o;
#pragma unroll
        for (int k = 0; k < 4; ++k) { const float lo = w0 * bf_lo(a[k]) + w1 * bf_lo(b[k]) + w2 * bf_lo(cc[k]), hi = w0 * bf_hi(a[k]) + w1 * bf_hi(b[k]) + w2 * bf_hi(cc[k]); o[k] = cvt_pk_bf16(lo, hi); }
        *(u32x4*)(MIX + (size_t)t * D + PW + h * HD + c8 * 8) = o;
    }
}

constexpr int GWB_PITCH = 2064;
constexpr int RT_GWL = NE * GWB_PITCH, RT_G2 = 2 * NE * GWB_PITCH, RT_LG = RT_G2 + 4096, RT_RS = RT_LG + 4 * 16 * 33 * 4, RT_CNT = RT_RS + 256, RT_PART = RT_CNT + 256, RT_END = RT_PART + 4 * 64 * 9 * 4;
static_assert(RT_END <= LDS_CTL, "router LDS map");
__device__ __forceinline__ void split_bf16(const f32x4& a0, const f32x4& a1, bf16x8& hi, bf16x8& lo) {
    u32x4 h, l;
    h.x = cvt_pk_bf16(a0[0], a0[1]); h.y = cvt_pk_bf16(a0[2], a0[3]); h.z = cvt_pk_bf16(a1[0], a1[1]); h.w = cvt_pk_bf16(a1[2], a1[3]);
    l.x = cvt_pk_bf16(a0[0] - bf_lo(h.x), a0[1] - bf_hi(h.x)); l.y = cvt_pk_bf16(a0[2] - bf_lo(h.y), a0[3] - bf_hi(h.y));
    l.z = cvt_pk_bf16(a1[0] - bf_lo(h.z), a1[1] - bf_hi(h.z)); l.w = cvt_pk_bf16(a1[2] - bf_lo(h.w), a1[3] - bf_hi(h.w));
    hi = __builtin_bit_cast(bf16x8, h); lo = __builtin_bit_cast(bf16x8, l);
}
__device__ __forceinline__ unsigned trunc_pk(float lo, float hi) { return (__float_as_uint(lo) >> 16) | (__float_as_uint(hi) & 0xffff0000u); }
__device__ __forceinline__ float trunc_res(float x) { return x - __uint_as_float(__float_as_uint(x) & 0xffff0000u); }
__device__ __forceinline__ void split_trunc(const f32x4& a0, const f32x4& a1, bf16x8& hi, bf16x8& lo) {
    u32x4 h, l;
    h.x = trunc_pk(a0[0], a0[1]); h.y = trunc_pk(a0[2], a0[3]); h.z = trunc_pk(a1[0], a1[1]); h.w = trunc_pk(a1[2], a1[3]);
    l.x = trunc_pk(trunc_res(a0[0]), trunc_res(a0[1])); l.y = trunc_pk(trunc_res(a0[2]), trunc_res(a0[3])); l.z = trunc_pk(trunc_res(a1[0]), trunc_res(a1[1])); l.w = trunc_pk(trunc_res(a1[2]), trunc_res(a1[3]));
    hi = __builtin_bit_cast(bf16x8, h); lo = __builtin_bit_cast(bf16x8, l);
}
__device__ __forceinline__ void router_phase(LAS unsigned char* lds, const float* __restrict__ X1, const float* __restrict__ g2, const float* __restrict__ GWT, const float* __restrict__ rb,
                                             unsigned char* __restrict__ H, float* __restrict__ RSTD, float* __restrict__ GATES, int* __restrict__ ROWS, unsigned* __restrict__ COUNTS, int G, int c) {
    const int tid = threadIdx.x, lane = tid & 63, w = __builtin_amdgcn_readfirstlane(tid >> 6), ql = lane & 15, g = lane >> 4;
    const int ts = w & 3, kh = w >> 2;
    LAS unsigned char* GWH = lds; LAS unsigned char* GWL = lds + RT_GWL;
    LAS float* G2 = (LAS float*)(lds + RT_G2);
    LAS float* LG = (LAS float*)(lds + RT_LG) + ts * (16 * 33);
    LAS float* RS = (LAS float*)(lds + RT_RS) + ts * 16;
    LAS int* LCNT = (LAS int*)(lds + RT_CNT);
    LAS int* LBASE = LCNT + 32;
    LAS float* PART = (LAS float*)(lds + RT_PART) + ts * (64 * 9);
    const int nrounds = (S / 16 + 4 * G - 1) / (4 * G);
    for (int rd = 0; rd < nrounds; ++rd) {
        const int tile = (rd * 4 + ts) * G + c;
        const bool active = tile < S / 16;
        const int tok = (active ? tile : 0) * 16 + ql;
        const float* xr = X1 + (size_t)tok * D + kh * 512 + 8 * g;
        f32x4 av[16];
        if (active) {
#pragma unroll
            for (int i = 0; i < 8; ++i) { av[2 * i] = __builtin_nontemporal_load((const f32x4*)(xr + 32 * i)); av[2 * i + 1] = __builtin_nontemporal_load((const f32x4*)(xr + 32 * i + 4)); } }
        if (rd == 0) {
            for (int id = tid; id < NE * 128; id += 512) { const int e = id >> 7, k8 = id & 127; const f32x4 x0 = *(const f32x4*)(GWT + e * D + k8 * 8), x1v = *(const f32x4*)(GWT + e * D + k8 * 8 + 4);
                bf16x8 hi, lo; split_bf16(x0, x1v, hi, lo); *(LAS bf16x8*)(GWH + e * GWB_PITCH + k8 * 16) = hi; *(LAS bf16x8*)(GWL + e * GWB_PITCH + k8 * 16) = lo; }
            if (tid < 256) *(LAS f32x4*)(G2 + tid * 4) = *(const f32x4*)(g2 + tid * 4);
        }
        if (tid < 32) LCNT[tid] = 0;
        __syncthreads();
        int ek[4] = {0, 0, 0, 0}, lp[4] = {0, 0, 0, 0}; float gk[4] = {0.f, 0.f, 0.f, 0.f};
        f32x4 acc0 = (f32x4){0.f, 0.f, 0.f, 0.f}, acc1 = acc0; float ss = 0.f;
        if (active) {
            f32x4 accA[6], accB[6];
#pragma unroll
            for (int t = 0; t < 6; ++t) { accA[t] = (f32x4){0.f, 0.f, 0.f, 0.f}; accB[t] = accA[t]; }

            unsigned char* hr = H + (size_t)tok * D + kh * 512 + 8 * g;
            const LAS unsigned char* bh0 = GWH + ql * GWB_PITCH + (kh * 512 + 8 * g) * 2; const LAS unsigned char* bh1 = bh0 + 16 * GWB_PITCH;
            const LAS unsigned char* bl0 = GWL + ql * GWB_PITCH + (kh * 512 + 8 * g) * 2; const LAS unsigned char* bl1 = bl0 + 16 * GWB_PITCH;
            const LAS float* gp = G2 + kh * 512 + 8 * g;
#pragma unroll
            for (int kb = 0; kb < 512; kb += 256) {
                if (kb > 0) {
#pragma unroll
                    for (int i = 0; i < 8; ++i) { av[2 * i] = __builtin_nontemporal_load((const f32x4*)(xr + kb + 32 * i)); av[2 * i + 1] = __builtin_nontemporal_load((const f32x4*)(xr + kb + 32 * i + 4)); } }
#pragma unroll
                for (int i = 0; i < 8; ++i) {
                    const int k0 = kb + 32 * i; const f32x4 a0 = av[2 * i], a1 = av[2 * i + 1];
                    const f32x4 n0 = *(const LAS f32x4*)(gp + k0), n1 = *(const LAS f32x4*)(gp + k0 + 4);
                    const bf16x8 wh0 = *(const LAS bf16x8*)(bh0 + k0 * 2), wh1 = *(const LAS bf16x8*)(bh1 + k0 * 2), wl0 = *(const LAS bf16x8*)(bl0 + k0 * 2), wl1 = *(const LAS bf16x8*)(bl1 + k0 * 2);
                    ss += (a0[0] * a0[0] + a0[1] * a0[1]) + (a0[2] * a0[2] + a0[3] * a0[3]) + (a1[0] * a1[0] + a1[1] * a1[1]) + (a1[2] * a1[2] + a1[3] * a1[3]);
                    u32x2 hv; hv.x = cvt4_fp8(a0[0] * n0[0] * HSCALE, a0[1] * n0[1] * HSCALE, a0[2] * n0[2] * HSCALE, a0[3] * n0[3] * HSCALE);
                    hv.y = cvt4_fp8(a1[0] * n1[0] * HSCALE, a1[1] * n1[1] * HSCALE, a1[2] * n1[2] * HSCALE, a1[3] * n1[3] * HSCALE);
                    *(u32x2*)(hr + k0) = hv;
                    bf16x8 ah, al; split_bf16(a0, a1, ah, al);


                    __builtin_amdgcn_sched_barrier(0); asm volatile("s_nop 7" ::: "memory"); __builtin_amdgcn_sched_barrier(0);
                    f32x4 (&q)[6] = (i & 1) ? accB : accA;
                    q[0] = __builtin_amdgcn_mfma_f32_16x16x32_bf16(ah, wh0, q[0], 0, 0, 0); q[1] = __builtin_amdgcn_mfma_f32_16x16x32_bf16(ah, wh1, q[1], 0, 0, 0);
                    q[2] = __builtin_amdgcn_mfma_f32_16x16x32_bf16(ah, wl0, q[2], 0, 0, 0); q[3] = __builtin_amdgcn_mfma_f32_16x16x32_bf16(ah, wl1, q[3], 0, 0, 0);
                    q[4] = __builtin_amdgcn_mfma_f32_16x16x32_bf16(al, wh0, q[4], 0, 0, 0); q[5] = __builtin_amdgcn_mfma_f32_16x16x32_bf16(al, wh1, q[5], 0, 0, 0);

                    __builtin_amdgcn_sched_barrier(0); asm volatile("s_nop 15\n\ts_nop 15" ::: "memory"); __builtin_amdgcn_sched_barrier(0);

                }
            }

            acc0 = ((accA[0] + accB[0]) + (accA[2] + accB[2])) + (accA[4] + accB[4]); acc1 = ((accA[1] + accB[1]) + (accA[3] + accB[3])) + (accA[5] + accB[5]);


            if (kh == 1) { LAS float* pp = PART + lane * 9;
#pragma unroll
                for (int i = 0; i < 4; ++i) { pp[i] = acc0[i]; pp[4 + i] = acc1[i]; } pp[8] = ss; }
        }
        __syncthreads();
        if (active && kh == 0) {
            { const LAS float* pp = PART + lane * 9;
#pragma unroll
              for (int i = 0; i < 4; ++i) { acc0[i] += pp[i]; acc1[i] += pp[4 + i]; } ss += pp[8]; }
            ss += __shfl_xor(ss, 16); ss += __shfl_xor(ss, 32);
            const float rstd = rsqrtf(ss * (1.0f / D) + RMS_EPS);
            if (g == 0) { RSTD[tok] = rstd; RS[ql] = rstd; }
            LDS_WAIT();
            const float rb0 = rb[ql], rb1 = rb[16 + ql];
#pragma unroll
            for (int rg = 0; rg < 4; ++rg) { const float rr = RS[4 * g + rg]; LG[(4 * g + rg) * 33 + ql] = acc0[rg] * rr + rb0; LG[(4 * g + rg) * 33 + 16 + ql] = acc1[rg] * rr + rb1; }
            LDS_WAIT();
            if (lane < 16) {
                float v[32];
#pragma unroll
                for (int e = 0; e < 32; ++e) v[e] = LG[ql * 33 + e];
                float tv[4];
#pragma unroll
                for (int r = 0; r < 4; ++r) { float best = v[0]; int bi = 0;
#pragma unroll
                    for (int e = 1; e < 32; ++e) { const bool gt = v[e] > best; best = gt ? v[e] : best; bi = gt ? e : bi; }
                    tv[r] = best; ek[r] = bi;
#pragma unroll
                    for (int e = 0; e < 32; ++e) v[e] = (e == bi) ? -INFINITY : v[e]; }
                const float e1 = __expf(tv[1] - tv[0]), e2 = __expf(tv[2] - tv[0]), e3 = __expf(tv[3] - tv[0]); const float inv = 1.0f / (1.0f + e1 + e2 + e3);
                gk[0] = inv; gk[1] = e1 * inv; gk[2] = e2 * inv; gk[3] = e3 * inv;
#pragma unroll
                for (int r = 0; r < 4; ++r) lp[r] = __hip_atomic_fetch_add(LCNT + ek[r], 1, __ATOMIC_RELAXED, __HIP_MEMORY_SCOPE_WORKGROUP);
            }
        }
        __syncthreads();
        if (tid < 32) { const int n = LCNT[tid]; int base = 0; if (n > 0) base = (int)__hip_atomic_fetch_add(COUNTS + tid, (unsigned)n, __ATOMIC_RELAXED, __HIP_MEMORY_SCOPE_AGENT); LBASE[tid] = base; }
        __syncthreads();
        if (active && kh == 0 && lane < 16) {
#pragma unroll
            for (int r = 0; r < 4; ++r) { const int pos = LBASE[ek[r]] + lp[r]; ROWS[(size_t)ek[r] * S + pos] = tok * 4 + r; GATES[tok * 4 + r] = gk[r]; }

        }
        __syncthreads();
    }
}

__device__ __forceinline__ void moe_prefix(LAS int* tpre, LAS int* lcnt, const unsigned* __restrict__ COUNTS) {
    if (threadIdx.x < 32) lcnt[threadIdx.x] = (int)COUNTS[threadIdx.x];
    __syncthreads();
    if (threadIdx.x == 0) { int acc = 0; for (int e = 0; e < NE; ++e) { tpre[e] = acc; acc += (lcnt[e] + 255) >> 8; } tpre[NE] = acc; }
    __syncthreads();
}
template <bool GU, class Prob> __device__ __forceinline__ void moe_table(const Prob& P, LAS int* udesc, LAS int* tab, LAS float* tabf, LAS float* tabb, const LAS int* lcnt, const int* __restrict__ ROWS,
                                                                         const float* __restrict__ rowf, const float* __restrict__ bias) {
    if (threadIdx.x < MAXU) { Unit u0; u0.e = 0; u0.pm = 0; u0.pn = 0; u0.slot = 0; const bool ok = P.search((int)threadIdx.x, u0);
        udesc[4 * threadIdx.x] = u0.e; udesc[4 * threadIdx.x + 1] = u0.pm; udesc[4 * threadIdx.x + 2] = u0.pn; udesc[4 * threadIdx.x + 3] = ok ? 1 : 0; }
    __syncthreads();
    Unit u;
#pragma unroll 1
    for (int i = 0; i < MAXU && P.next(i, u); ++i) {
        if (threadIdx.x < 256) { const int rr = u.pm * 256 + (int)threadIdx.x; const int idx = (rr < lcnt[u.e]) ? ROWS[(size_t)u.e * S + rr] : -1; tab[i * 256 + threadIdx.x] = idx;
            tabf[i * 256 + threadIdx.x] = GU ? rowf[idx < 0 ? 0 : (idx >> 2)] * (1.0f / (HSCALE * WSCALE)) : (idx < 0 ? 0.f : rowf[idx]); }
        else { const int j = (int)threadIdx.x - 256;
            tabb[i * 256 + j] = GU ? bias[(size_t)u.e * 2 * DFF + (j >> 7) * DFF + u.pn * 128 + (j & 127)] : bias[(size_t)u.e * D + u.pn * 256 + j]; }
    }
    __syncthreads();
}

__device__ __forceinline__ void final_phase(const float* __restrict__ X1, const unsigned char* __restrict__ Y, const float* __restrict__ fg, float* __restrict__ out, int G, int c) {
    const int tid = threadIdx.x, lane = tid & 63, wave = tid >> 6; const int gw = c * 8 + wave, NGW = G * 8;
    f32x4 gv[4];
#pragma unroll
    for (int j = 0; j < 4; ++j) gv[j] = *(const f32x4*)(fg + 4 * lane + 256 * j);
    for (int m = gw; m < S; m += NGW) {
        const float* xr = X1 + (size_t)m * D + 4 * lane;
        f32x4 v[4];
#pragma unroll
        for (int j = 0; j < 4; ++j) v[j] = __builtin_nontemporal_load((const f32x4*)(xr + 256 * j));

#pragma unroll
        for (int k = 0; k < 4; ++k) { const unsigned char* yr = Y + ((size_t)m * 4 + k) * D + 4 * lane;
#pragma unroll
            for (int j = 0; j < 4; ++j) { const int t = __builtin_nontemporal_load((const int*)(yr + 256 * j)); const f32x2 lo = __builtin_amdgcn_cvt_pk_f32_fp8(t, false), hi = __builtin_amdgcn_cvt_pk_f32_fp8(t, true);
                v[j][0] += lo[0] * (1.0f / YSCALE); v[j][1] += lo[1] * (1.0f / YSCALE); v[j][2] += hi[0] * (1.0f / YSCALE); v[j][3] += hi[1] * (1.0f / YSCALE); } }
        float s = 0.f;
#pragma unroll
        for (int j = 0; j < 4; ++j) s += (v[j][0] * v[j][0] + v[j][1] * v[j][1]) + (v[j][2] * v[j][2] + v[j][3] * v[j][3]);
        const float rstd = rsqrtf(wave_sum(s) * (1.0f / D) + RMS_EPS);
#pragma unroll
        for (int j = 0; j < 4; ++j) __builtin_nontemporal_store(v[j] * rstd * gv[j], (f32x4*)(out + (size_t)m * D + 4 * lane + 256 * j));
    }
}

constexpr int NPHASE = 9;
struct Args { In in; float* out; unsigned char* ws; int ph_lo, ph_hi; };
__global__ void __launch_bounds__(512, 2) fwd(Args args) {
    extern __shared__ __attribute__((aligned(16))) unsigned char lds_raw[];
    LAS unsigned char* lds = (LAS unsigned char*)lds_raw;
    const int tid = threadIdx.x, G = gridDim.x, c = blockIdx.x;
    unsigned char* ws = args.ws; const In& in = args.in;
    unsigned* ctl = (unsigned*)(ws + WS_CTL);
    LAS int* LCTL = (LAS int*)(lds + LDS_CTL);
    if (tid < 256) LCTL[tid] = 0;
    __syncthreads();
    const int lo = args.ph_lo, hi = args.ph_hi;
    const bool one_launch = (hi - lo) > 1;
    XcdBarrier bar; bar.bar = ctl + CW_BAR; bar.x = 0; bar.st = nullptr;
    if (one_launch) bar = xcd_barrier_post(ctl + CW_BAR, (volatile LAS unsigned*)LCTL);
#define IN(k) (lo <= (k) && (k) < hi)
#ifndef MK_DOUBLE
#define MK_DOUBLE 0
#endif
#define REP(k) for (int rep_ = 0; rep_ < ((((MK_DOUBLE) >> (k)) & 1) ? 2 : 1); ++rep_)
#define SEAM(k) do { if (IN((k) + 1)) xcd_barrier(bar); } while (0)
    bf16_t* Hb = (bf16_t*)(ws + WS_H); bf16_t* Ub = (bf16_t*)(ws + WS_U); bf16_t* Qb = (bf16_t*)(ws + WS_Q); bf16_t* Kb = (bf16_t*)(ws + WS_K); bf16_t* Vb = (bf16_t*)(ws + WS_V);
    bf16_t* OPb = (bf16_t*)(ws + WS_OP); bf16_t* MIXb = (bf16_t*)(ws + WS_MIX); float* X1 = (float*)(ws + WS_X1); unsigned char* ACTb = ws + WS_ACT; unsigned char* Yb = ws + WS_Y; unsigned char* H8 = ws + WS_H8;
    float* LSE = (float*)(ws + WS_LSE); float* RSTD = (float*)(ws + WS_RSTD); float* GATES = (float*)(ws + WS_GATES); int* ROWS = (int*)(ws + WS_ROWS); unsigned* COUNTS = ctl + CW_COUNTS;
    LAS int* TPRE = LCTL + 16; LAS int* LCNT = LCTL + 128; LAS int* UDESC = LCTL + 192; LAS int* TAB = (LAS int*)(lds + LDS_TAB); LAS float* TABF = (LAS float*)(lds + LDS_TAB + MAXU * 1024); LAS float* TABB = (LAS float*)(lds + LDS_TAB + 2 * MAXU * 1024);
    static_assert(LDS_TAB + 3 * MAXU * 1024 <= LDS_CTL, "MoE LDS tables");

    if (IN(0)) { REP(0) p0_prologue(lds, in, ws, G, c); SEAM(0); }
    if (IN(1)) {
        const int NG = (G >= 256) ? 160 : G;
        if (c < NG) {
            pg8::DenseProb P{(const char*)Hb, (const char*)(ws + WS_WIN), D * 2, S / 256, NPROJ / 256, NG, c, (size_t)128 * D * 2};
            EpiQKVU E{ws};
            REP(1) pg8::gemm_phase<EpiQKVU, pg8::DenseProb, true, false>(lds, P, E);
        }
        else p0_side(lds, in, ws, G - NG, c - NG);
        if (NG == G) p0_side(lds, in, ws, G, c);
        convert8_queue(lds, in, ws, ctl + CW_QUEUE);
        SEAM(1);
    }
    if (IN(2)) {
        REP(2) attn_phase(lds, Qb, Kb, Vb, (const float*)(ws + WS_BT), OPb, LSE, G, c);
        REP(9) pool_phase(lds, Ub, (const bf16_t*)(ws + WS_PWT), in.pool_scale, MIXb, G, c);
        SEAM(2);
    }
    if (IN(3)) { REP(3) combine_phase(OPb, LSE, MIXb, G, c); SEAM(3); }
    if (IN(4)) {
        pg8::DenseProb P{(const char*)MIXb, (const char*)(ws + WS_WOUT), D * 2, S / 256, D / 256, G, c, (size_t)128 * D * 2};
        EpiResF32 E{in.x, X1};
        REP(4) pg8::gemm_phase<EpiResF32, pg8::DenseProb, true, false>(lds, P, E);
        SEAM(4);
    }
    if (IN(5)) { router_phase(lds, X1, in.norm2_g, (const float*)(ws + WS_GWT), in.router_b, H8, RSTD, GATES, ROWS, COUNTS, G, c); SEAM(5); }
    if (IN(6)) {
        moe_prefix(TPRE, LCNT, COUNTS);
        pg8::MoeProb<true> P{(const char*)H8, (const char*)(ws + WS_WGU), D, 8, G, c, (size_t)DFF * D, (size_t)2 * DFF * D, 128, TPRE, TAB, UDESC};
        moe_table<true>(P, UDESC, TAB, TABF, TABB, LCNT, ROWS, RSTD, in.b_gate_up);
        EpiGateUp E{ACTb, TPRE, TABF, TABB};
        REP(6) pg8::gemm_phase<EpiGateUp, pg8::MoeProb<true>, true, true>(lds, P, E);
        SEAM(6);
    }
    if (IN(7)) {
        moe_prefix(TPRE, LCNT, COUNTS);
        pg8::MoeProb<false> P{(const char*)ACTb, (const char*)(ws + WS_WD), DFF, 4, G, c, (size_t)128 * DFF, (size_t)D * DFF, 256, TPRE, TAB, UDESC};
        moe_table<false>(P, UDESC, TAB, TABF, TABB, LCNT, ROWS, GATES, in.b_down);
        EpiDown E{Yb, TAB, TABF, TABB};
        REP(7) pg8::gemm_phase<EpiDown, pg8::MoeProb<false>, true, true>(lds, P, E);
        SEAM(7);
    }

    if (IN(8)) REP(8) final_phase(X1, Yb, in.final_g, args.out, G, c);

#undef IN
#undef SEAM
}

#ifndef MK_N_LAUNCHES
#define MK_N_LAUNCHES 1
#endif
#ifndef MK_SEQ
#define MK_SEQ "012345678"
#endif
extern "C" void kernel_launch(void* const* d_in, const int* in_sizes, int n_in, void* d_out, int out_size, void* d_ws, size_t ws_size, hipStream_t stream) {
    static int grid = 0;
    if (grid == 0) {
        if (n_in != 15 || out_size != S * D || ws_size < WS_END) { fprintf(stderr, "kernel_launch: unexpected problem (n_in %d out %d ws %zu)\n", n_in, out_size, ws_size); grid = -1; return; }
        int dev = 0, cus = 0, per_cu = 0;
        if (hipGetDevice(&dev) != hipSuccess || hipDeviceGetAttribute(&cus, hipDeviceAttributeMultiprocessorCount, dev) != hipSuccess) { grid = -1; return; }
        if (hipFuncSetAttribute((const void*)fwd, hipFuncAttributeMaxDynamicSharedMemorySize, LDS_BYTES) != hipSuccess) { fprintf(stderr, "kernel_launch: hipFuncSetAttribute failed\n"); grid = -1; return; }
        if (hipOccupancyMaxActiveBlocksPerMultiprocessor(&per_cu, (const void*)fwd, 512, LDS_BYTES) != hipSuccess || per_cu < 1) { fprintf(stderr, "kernel_launch: occupancy query says %d blocks per CU\n", per_cu); (void)hipGetLastError(); per_cu = 1; }
        grid = cus;
    }
    if (grid < 0) return;
    if (hipMemsetAsync((char*)d_ws + WS_CTL, 0, CTL_ZERO_BYTES, stream) != hipSuccess) { fprintf(stderr, "kernel_launch: memset failed\n"); return; }
    Args a{};
    a.in.x = (const float*)d_in[0]; a.in.norm1_g = (const float*)d_in[1]; a.in.w_in = (const float*)d_in[2]; a.in.pool_w = (const float*)d_in[3]; a.in.pool_scale = (const float*)d_in[4];
    a.in.rel_bias = (const float*)d_in[5]; a.in.w_out = (const float*)d_in[6]; a.in.norm2_g = (const float*)d_in[7]; a.in.router_w = (const float*)d_in[8]; a.in.router_b = (const float*)d_in[9];
    a.in.w_gate_up = (const float*)d_in[10]; a.in.b_gate_up = (const float*)d_in[11]; a.in.w_down = (const float*)d_in[12]; a.in.b_down = (const float*)d_in[13]; a.in.final_g = (const float*)d_in[14];
    a.out = (float*)d_out; a.ws = (unsigned char*)d_ws;
    if (MK_N_LAUNCHES == 1) { a.ph_lo = 0; a.ph_hi = NPHASE; hipLaunchKernelGGL(fwd, dim3(grid), dim3(512), LDS_BYTES, stream, a); }
    else { const char* seq = MK_SEQ; for (int i = 0; seq[i]; ++i) { const int p = seq[i] - '0'; a.ph_lo = p; a.ph_hi = p + 1; if (p == 5) (void)hipMemsetAsync((char*)d_ws + WS_CTL + CW_COUNTS * 4, 0, 128, stream); hipLaunchKernelGGL(fwd, dim3(grid), dim3(512), LDS_BYTES, stream, a); } }
    const hipError_t le = hipPeekAtLastError();
    if (le != hipSuccess) fprintf(stderr, "kernel_launch: launch failed: %s\n", hipGetErrorName(le));
}
```

```cpp
#include <hip/hip_runtime.h>
#include <cstdio>
#include <cstdint>

#define LAS __attribute__((address_space(3)))
#define GAS __attribute__((address_space(1)))
typedef unsigned short bf16_t;
typedef short bf16x8 __attribute__((ext_vector_type(8)));
typedef short s16x4 __attribute__((ext_vector_type(4)));
typedef float f32x4 __attribute__((ext_vector_type(4)));
typedef float f32x2 __attribute__((ext_vector_type(2)));
typedef unsigned u32x4 __attribute__((ext_vector_type(4)));
typedef unsigned u32x2 __attribute__((ext_vector_type(2)));
typedef int i32x4 __attribute__((ext_vector_type(4)));
typedef int i32x8 __attribute__((ext_vector_type(8)));

constexpr int S = 16384, D = 1024, NPROJ = 2560, PW = 256, AW = 768, NH = 12, HD = 64, NE = 32, TOPK = 4, DFF = 1024;
constexpr float RMS_EPS = 1e-5f, LOG2E = 1.4426950408889634f, QSCALE = 0.125f * LOG2E, NEGBIG = -1e30f;
constexpr float WSCALE = 64.0f, HSCALE = 16.0f, ASCALE = 8.0f, YSCALE = 64.0f, FP8MAX = 448.0f;
constexpr int BT_N = 400, BT_OFF = 144;

constexpr size_t MiB = 1u << 20;
constexpr size_t WS_CTL = 0, CTL_ZERO_BYTES = 64 * 1024;
constexpr size_t WS_WIN = 2 * MiB;
constexpr size_t WS_WOUT = 8 * MiB;
constexpr size_t WS_GWT = 10 * MiB;
constexpr size_t WS_BT = 10 * MiB + 512 * 1024;
constexpr size_t WS_PWT = 10 * MiB + 768 * 1024;
constexpr size_t WS_RSTD = 11 * MiB;
constexpr size_t WS_GATES = 11 * MiB + 256 * 1024;
constexpr size_t WS_ROWS = 12 * MiB;
constexpr size_t WS_LSE = 14 * MiB;
constexpr size_t WS_WGU = 32 * MiB;
constexpr size_t WS_WD = 160 * MiB;
constexpr size_t WS_H8 = 200 * MiB;
constexpr size_t WS_H = 224 * MiB;
constexpr size_t WS_U = 256 * MiB;
constexpr size_t WS_Q = 264 * MiB, WS_K = 288 * MiB, WS_V = 312 * MiB;
constexpr size_t WS_OP = 336 * MiB;
constexpr size_t WS_MIX = 408 * MiB;
constexpr size_t WS_X1 = 440 * MiB;
constexpr size_t WS_ACT = 512 * MiB;
constexpr size_t WS_Y = 656 * MiB;
constexpr size_t WS_END = 784 * MiB;
constexpr int ACT_ROWS = 65536 + 32 * 256;
constexpr int CW_COUNTS = 64;
constexpr int CW_QUEUE = 256;
constexpr int CW_BAR = 4096;

constexpr int LDS_BYTES = 163840;
constexpr int LDS_TAB = 131072;
constexpr int LDS_CTL = LDS_BYTES - 1024;
constexpr int MAXU = 9;

typedef __bf16 bf16x2_t __attribute__((ext_vector_type(2)));
__device__ __forceinline__ unsigned cvt_pk_bf16(float lo, float hi) { const f32x2 v = {lo, hi}; const bf16x2_t b = __builtin_convertvector(v, bf16x2_t); return __builtin_bit_cast(unsigned, b); }
__device__ __forceinline__ float clamp8(float v) { return __builtin_amdgcn_fmed3f(v, -FP8MAX, FP8MAX); }
__device__ __forceinline__ unsigned cvt4_fp8(float a, float b, float c, float d) {
    int p = __builtin_amdgcn_cvt_pk_fp8_f32(clamp8(a), clamp8(b), 0, false); p = __builtin_amdgcn_cvt_pk_fp8_f32(clamp8(c), clamp8(d), p, true); return (unsigned)p; }
__device__ __forceinline__ float bf_lo(unsigned w) { return __uint_as_float(w << 16); }
__device__ __forceinline__ float bf_hi(unsigned w) { return __uint_as_float(w & 0xffff0000u); }
__device__ __forceinline__ float wave_sum(float v) {
#pragma unroll
    for (int o = 1; o < 64; o <<= 1) v += __shfl_xor(v, o);
    return v;
}
#define LDS_WAIT() asm volatile("s_waitcnt lgkmcnt(0)" ::: "memory")
#define VM_WAIT() asm volatile("s_waitcnt vmcnt(0)" ::: "memory")

#define XB_TMO      128
#define XB_XCNT(j)  (256  + 64 * (j))
#define XB_XSUB(j)  (1280 + 64 * (j))
#define XB_XGEN(j)  (2304 + 64 * (j))
#define XB_TOP      3328
#define XB_TOPGEN   3392
#define XCD_BAR_WORDS 3456
#define XB_SPIN_CAP (1u << 18)
__device__ __forceinline__ unsigned xb_ld(unsigned* p)              { return __hip_atomic_load(p, __ATOMIC_RELAXED, __HIP_MEMORY_SCOPE_AGENT); }
__device__ __forceinline__ unsigned xb_add(unsigned* p, unsigned v) { return __hip_atomic_fetch_add(p, v, __ATOMIC_RELAXED, __HIP_MEMORY_SCOPE_AGENT); }
__device__ __forceinline__ unsigned xb_xcc_id() { return (unsigned)__builtin_amdgcn_s_getreg((3 << 11) | 20) & 0xFu; }
#define XB_SPIN(cond, bar) do { unsigned _sp = 0; while (cond) { __builtin_amdgcn_s_sleep(1); \
    if ((++_sp & 255u) == 0u) { if (xb_ld(&(bar)[XB_TMO])) break; if (_sp > XB_SPIN_CAP) { atomicAdd(&(bar)[XB_TMO], 1u); break; } } } } while (0)
struct XcdBarrier { unsigned* bar; unsigned x; volatile LAS unsigned* st; };
__device__ __forceinline__ XcdBarrier xcd_barrier_post(unsigned* bar, volatile LAS unsigned* st) {
    XcdBarrier b; b.bar = bar; b.x = xb_xcc_id(); b.st = st;
    if (threadIdx.x == 0) (void)xb_add(&bar[XB_XCNT(b.x)], 1u);
    return b;
}
__device__ __forceinline__ void xcd_barrier_complete(unsigned* bar, unsigned x, unsigned& nloc, unsigned& nx) {
    const unsigned G = gridDim.x * gridDim.y * gridDim.z;
    unsigned sum, cnt, mine, sp = 0u;
    for (;;) {
        sum = 0u; cnt = 0u; mine = 0u;
#pragma unroll
        for (unsigned j = 0; j < 16; ++j) { const unsigned c = xb_ld(&bar[XB_XCNT(j)]); sum += c; cnt += (c > 0u) ? 1u : 0u; mine = (j == x) ? c : mine; }
        if (sum == G) break;
        __builtin_amdgcn_s_sleep(1);
        if ((++sp & 255u) == 0u) { if (xb_ld(&bar[XB_TMO])) break; if (sp > XB_SPIN_CAP) { atomicAdd(&bar[XB_TMO], 1u); break; } }
    }
    nloc = mine > 0u ? mine : 1u; nx = cnt > 0u ? cnt : 1u;
}
__device__ __forceinline__ void xcd_barrier(const XcdBarrier& b) {
    asm volatile("s_waitcnt vmcnt(0)" ::: "memory");
    __syncthreads();
    if (threadIdx.x == 0) {
        unsigned* bar = b.bar;
        __builtin_amdgcn_s_waitcnt(0);
        unsigned nloc = b.st[0], nx = b.st[1];
        if (nloc == 0u) { xcd_barrier_complete(bar, b.x, nloc, nx); b.st[0] = nloc; b.st[1] = nx; }
        const unsigned old = xb_add(&bar[XB_XSUB(b.x)], 1u);
        const unsigned gen = old / nloc;
        if (old + 1u == (gen + 1u) * nloc) {
            __builtin_amdgcn_fence(__ATOMIC_RELEASE, "agent");
            asm volatile("s_waitcnt vmcnt(0)" ::: "memory");
            const unsigned og = xb_add(&bar[XB_TOP], 1u);
            const unsigned tg = og / nx;
            if (og + 1u == (tg + 1u) * nx) xb_add(&bar[XB_TOPGEN], 1u);
            else XB_SPIN(xb_ld(&bar[XB_TOPGEN]) == tg, bar);
            __builtin_amdgcn_fence(__ATOMIC_ACQUIRE, "agent");
            xb_add(&bar[XB_XGEN(b.x)], 1u);
            asm volatile("s_waitcnt vmcnt(0)" ::: "memory");
        } else {
            XB_SPIN(xb_ld(&bar[XB_XGEN(b.x)]) == gen, bar);
            __builtin_amdgcn_fence(__ATOMIC_ACQUIRE, "agent");
            asm volatile("s_waitcnt vmcnt(0)" ::: "memory");
        }
    }
    __syncthreads();
}

namespace pg8 {
constexpr int BM = 256, BK = 64, HALF = 128, HTB = HALF * BK * 2, STAGE_BYTES = 8 * HTB, NXCD = 8, WGM = 8;
__host__ __device__ __forceinline__ int lds_byte(int r, int c) { const int st = (r >> 4) * 2 + (c >> 5), rr = r & 15, cc = c & 31, ob = rr * 64 + cc * 2; return st * 1024 + (ob ^ (((ob >> 9) & 1) << 5)); }
__host__ __device__ __forceinline__ void stage_rc(int b, int& R, int& C) { const int st = b / 1024, sb = b % 1024, swz = sb ^ (((sb >> 9) & 1) << 5); R = (st >> 1) * 16 + swz / 64; C = (st & 1) * 32 + (swz % 64) / 2; }
__host__ __device__ __forceinline__ int perm32(int rho) { const int n = rho >> 4, i = rho & 15; return 8 * (i >> 2) + 4 * n + (i & 3); }

struct Unit { int pm, pn, e, slot; };

template <class Epi, class Prob, bool ALIGN_EPI, bool FP8>
__device__ __forceinline__ void gemm_phase(LAS unsigned char* lds, const Prob& P, const Epi& E) {
    const int tid = threadIdx.x, wid = __builtin_amdgcn_readfirstlane(tid >> 6), lane = tid & 63, wr = wid >> 2, wc = wid & 3, fr = lane & 15, fq = lane >> 4;
    const int rowb = P.rowb, nt = rowb / 128;
    int Rs[2], Cs[2]; unsigned voffB[2];
#pragma unroll
    for (int i = 0; i < 2; ++i) { int R, C; stage_rc(tid * 16 + i * 8192, R, C); const int Rb = Epi::PERM ? ((R & ~31) + perm32(R & 31)) : R;
        Rs[i] = R; Cs[i] = C * 2; voffB[i] = (unsigned)(Rb * rowb + C * 2); }
    const size_t kstep = (size_t)(BK * 2);
    const size_t bhalf = P.b_half;
    const unsigned ldsw = (unsigned)wid * 1024u;
    const int aoff = lds_byte(wr * 64 + fr, fq * 8), boff = lds_byte(wc * 32 + fr, fq * 8);
#define PG8_SA(b, h) (((b) * 2 + (h)) * HTB)
#define PG8_SB(b, h) ((4 + (b) * 2 + (h)) * HTB)
#define PG8_STAGE_B(bufoff, gbase) do { _Pragma("unroll") for (int _i = 0; _i < 2; ++_i) \
        __builtin_amdgcn_global_load_lds((const unsigned*)((const char*)(gbase) + voffB[_i]), (LAS unsigned*)(lds + (bufoff) + ldsw + _i * 8192), 16, 0, 0); } while (0)
#define PG8_STAGE_A(bufoff, kb, o0, o1) do { \
        __builtin_amdgcn_global_load_lds((const unsigned*)(P.A + (size_t)(o0) + (kb)), (LAS unsigned*)(lds + (bufoff) + ldsw), 16, 0, 0); \
        __builtin_amdgcn_global_load_lds((const unsigned*)(P.A + (size_t)(o1) + (kb)), (LAS unsigned*)(lds + (bufoff) + ldsw + 8192), 16, 0, 0); } while (0)
#define PG8_LDA(dst, b, h) do { _Pragma("unroll") for (int m = 0; m < 4; ++m) _Pragma("unroll") for (int k = 0; k < 2; ++k) dst[m][k] = *(const LAS bf16x8*)(lds + PG8_SA(b, h) + aoff + m * 2048 + k * 1024); } while (0)
#define PG8_LDB(dst, b, h) do { _Pragma("unroll") for (int n = 0; n < 2; ++n) _Pragma("unroll") for (int k = 0; k < 2; ++k) dst[n][k] = *(const LAS bf16x8*)(lds + PG8_SB(b, h) + boff + n * 2048 + k * 1024); } while (0)
#define PG8_MMA(ai, bj, At, Bt) do { __builtin_amdgcn_s_setprio(1); _Pragma("unroll") for (int m = 0; m < 4; ++m) _Pragma("unroll") for (int n = 0; n < 2; ++n) { \
        if constexpr (FP8) { const i32x8 fb_ = __builtin_shufflevector(__builtin_bit_cast(i32x4, Bt[n][0]), __builtin_bit_cast(i32x4, Bt[n][1]), 0, 1, 2, 3, 4, 5, 6, 7); \
            const i32x8 fa_ = __builtin_shufflevector(__builtin_bit_cast(i32x4, At[m][0]), __builtin_bit_cast(i32x4, At[m][1]), 0, 1, 2, 3, 4, 5, 6, 7); \
            acc[ai][bj][m][n] = __builtin_amdgcn_mfma_scale_f32_16x16x128_f8f6f4(fb_, fa_, acc[ai][bj][m][n], 0, 0, 0, 0, 0, 0); } \
        else { _Pragma("unroll") for (int k = 0; k < 2; ++k) acc[ai][bj][m][n] = __builtin_amdgcn_mfma_f32_16x16x32_bf16(Bt[n][k], At[m][k], acc[ai][bj][m][n], 0, 0, 0); } } \
        __builtin_amdgcn_s_setprio(0); } while (0)
#define PG8_WAIT_V(n) asm volatile("s_waitcnt vmcnt(" #n ")" ::: "memory")
#define PG8_WAIT_L(n) asm volatile("s_waitcnt lgkmcnt(" #n ")" ::: "memory")
#define PG8_BAR __builtin_amdgcn_s_barrier()
#define PG8_SCHED __builtin_amdgcn_sched_barrier(0)
    Unit cur, nxt; int ui = 0;
    if (!P.next(0, cur)) return;
    f32x4 acc[2][2][4][2];
    E.init(acc, cur, wr, wc, fr, fq);
    bf16x8 At[4][2], B0[2][2], B1[2][2];
    unsigned c00 = P.a_off(cur, Rs[0], Cs[0]), c01 = P.a_off(cur, Rs[1], Cs[1]), c10 = P.a_off(cur, HALF + Rs[0], Cs[0]), c11 = P.a_off(cur, HALF + Rs[1], Cs[1]);
    const char* cB = P.b_base(cur);
    PG8_STAGE_B(PG8_SB(0, 0), cB); PG8_STAGE_B(PG8_SB(0, 1), cB + bhalf); PG8_STAGE_A(PG8_SA(0, 0), 0, c00, c01); PG8_STAGE_A(PG8_SA(0, 1), 0, c10, c11);
    if (wr == 1) PG8_BAR;
    PG8_WAIT_V(2); PG8_BAR;
    PG8_STAGE_B(PG8_SB(1, 0), cB + kstep); PG8_STAGE_A(PG8_SA(1, 0), kstep, c00, c01); PG8_STAGE_B(PG8_SB(1, 1), cB + bhalf + kstep);
    PG8_WAIT_V(6); PG8_BAR;
    for (;;) {
        const bool has_next = P.next(ui + 1, nxt);
        const char* nB = has_next ? P.b_base(nxt) : cB;
        for (int t = 0; t < nt; t += 2) {
            const bool last = (t == nt - 2);
            const size_t k1 = (size_t)(t + 1) * kstep;
            const size_t k2 = last ? 0 : (size_t)(t + 2) * kstep, k3 = k2 + kstep;
            const char* b2 = last ? nB : cB + (size_t)(t + 2) * kstep; const char* b3 = b2 + kstep;
            if (last && has_next) { c00 = P.a_off(nxt, Rs[0], Cs[0]); c01 = P.a_off(nxt, Rs[1], Cs[1]); }
            PG8_LDB(B0, 0, 0); PG8_LDB(B1, 0, 1); PG8_SCHED; PG8_LDA(At, 0, 0); PG8_STAGE_A(PG8_SA(1, 1), k1, c10, c11);
            PG8_WAIT_V(8); PG8_WAIT_L(0); PG8_BAR; PG8_MMA(0, 0, At, B0); PG8_MMA(0, 1, At, B1); PG8_BAR; PG8_SCHED;
            if (last && has_next) { c10 = P.a_off(nxt, HALF + Rs[0], Cs[0]); c11 = P.a_off(nxt, HALF + Rs[1], Cs[1]); }
            PG8_LDA(At, 0, 1); PG8_STAGE_B(PG8_SB(0, 0), b2); PG8_STAGE_B(PG8_SB(0, 1), b2 + bhalf); PG8_STAGE_A(PG8_SA(0, 0), k2, c00, c01);
            PG8_WAIT_V(8); PG8_WAIT_L(0); PG8_BAR; PG8_MMA(1, 0, At, B0); PG8_MMA(1, 1, At, B1); PG8_BAR; PG8_SCHED;
            PG8_LDB(B0, 1, 0); PG8_LDB(B1, 1, 1); PG8_SCHED; PG8_LDA(At, 1, 0); PG8_STAGE_A(PG8_SA(0, 1), k2, c10, c11);
            PG8_WAIT_V(8); PG8_WAIT_L(0); PG8_BAR; PG8_MMA(0, 0, At, B0); PG8_MMA(0, 1, At, B1); PG8_BAR; PG8_SCHED;
            PG8_LDA(At, 1, 1); PG8_STAGE_B(PG8_SB(1, 0), b3); PG8_STAGE_B(PG8_SB(1, 1), b3 + bhalf); PG8_STAGE_A(PG8_SA(1, 0), k3, c00, c01);
            PG8_WAIT_V(8); PG8_WAIT_L(0); PG8_BAR; PG8_MMA(1, 0, At, B0); PG8_MMA(1, 1, At, B1); PG8_BAR; PG8_SCHED;
        }
        if constexpr (ALIGN_EPI) { if (wr == 0) PG8_BAR; }
        E(acc, cur, wr, wc, fr, fq);
#if defined(MK_DOUBLE)
        if constexpr (FP8) { if ((MK_DOUBLE >> 12) & 1) { asm volatile("" ::: "memory"); E(acc, cur, wr, wc, fr, fq); } }
#endif
        if (!has_next) break;
        cur = nxt; cB = nB; ++ui;
        E.init(acc, cur, wr, wc, fr, fq);
        if constexpr (ALIGN_EPI) { if (wr == 1) PG8_BAR; }
    }
    PG8_WAIT_V(0);
    if constexpr (!ALIGN_EPI) { if (wr == 0) PG8_BAR; }
    PG8_BAR;
#undef PG8_SA
#undef PG8_SB
#undef PG8_STAGE_A
#undef PG8_STAGE_B
#undef PG8_LDA
#undef PG8_LDB
#undef PG8_MMA
#undef PG8_WAIT_V
#undef PG8_WAIT_L
#undef PG8_BAR
#undef PG8_SCHED
}

__device__ __forceinline__ bool static_order(int nM, int nN, int G, int c, int i, int& pm, int& pn) {
    const int nwg = nM * nN; const long L = (long)i * G + c; if (L >= nwg) return false;
    int wgid = (int)L; { const int q = nwg / NXCD, r = nwg % NXCD, xcd = wgid % NXCD, off = wgid / NXCD; wgid = (xcd < r ? xcd * (q + 1) : r * (q + 1) + (xcd - r) * q) + off; }
    const int nig = WGM * nN, gid = wgid / nig, fm = gid * WGM, gsz = (nM - fm) < WGM ? (nM - fm) : WGM;
    pm = fm + ((wgid % nig) % gsz); pn = (wgid % nig) / gsz; return true;
}
struct DenseProb {
    const char* A; const char* Bt; int rowb, nM, nN, G, c; size_t b_half;
    __device__ __forceinline__ bool next(int i, Unit& u) const { u.e = 0; u.slot = i; return static_order(nM, nN, G, c, i, u.pm, u.pn); }
    __device__ __forceinline__ unsigned a_off(const Unit& u, int row, int colb) const { return (unsigned)((u.pm * BM + row) * rowb + colb); }
    __device__ __forceinline__ const char* b_base(const Unit& u) const { return Bt + (size_t)u.pn * BM * rowb; }
};
template <bool GATHER> struct MoeProb {
    const char* A; const char* Bt; int rowb, nN, G, c; size_t b_half; size_t b_expert; int b_tile_rows;
    const LAS int* tpre; const LAS int* tab; const LAS int* udesc;
    __device__ __forceinline__ int tp(int j) const { return __builtin_amdgcn_readfirstlane(tpre[j]); }
    __device__ __forceinline__ bool search(int i, Unit& u) const {
        const int total = tpre[NE] * nN; const long L0 = (long)i * G + c; if (L0 >= total) return false;
        int L = (int)L0; { const int q = total / NXCD, r = total % NXCD, xcd = L % NXCD, off = L / NXCD; L = (xcd < r ? xcd * (q + 1) : r * (q + 1) + (xcd - r) * q) + off; }
        int e = 0;
        for (int j = 1; j < NE; ++j) e += (tpre[j] * nN <= L) ? 1 : 0;
        const int first = tpre[e] * nN, tiles = tpre[e + 1] - tpre[e], rem = L - first;
        u.e = e; u.pm = rem % tiles; u.pn = rem / tiles; u.slot = i; return true;
    }
    __device__ __forceinline__ bool next(int i, Unit& u) const {
        if (i >= MAXU) return false;
        const int v = __builtin_amdgcn_readfirstlane(udesc[4 * i + 3]); if (!v) return false;
        u.e = __builtin_amdgcn_readfirstlane(udesc[4 * i]); u.pm = __builtin_amdgcn_readfirstlane(udesc[4 * i + 1]); u.pn = __builtin_amdgcn_readfirstlane(udesc[4 * i + 2]); u.slot = i; return true;
    }
    __device__ __forceinline__ unsigned a_off(const Unit& u, int row, int colb) const {
        if (GATHER) { const int idx = tab[u.slot * 256 + row]; const int tok = idx < 0 ? 0 : (idx >> 2); return (unsigned)(tok * rowb + colb); }
        return (unsigned)(((tp(u.e) + u.pm) * BM + row) * rowb + colb);
    }
    __device__ __forceinline__ const char* b_base(const Unit& u) const { return Bt + (size_t)u.e * b_expert + (size_t)u.pn * b_tile_rows * rowb; }
};
}

using pg8::Unit;
typedef f32x4 AccT[2][2][4][2];
__device__ __forceinline__ void acc_zero(AccT& acc) {
#pragma unroll
    for (int a = 0; a < 2; ++a)
#pragma unroll
        for (int b = 0; b < 2; ++b)
#pragma unroll
            for (int m = 0; m < 4; ++m)
#pragma unroll
                for (int n = 0; n < 2; ++n) acc[a][b][m][n] = (f32x4){0.f, 0.f, 0.f, 0.f};
}

struct EpiQKVU {
    static constexpr bool PERM = true;
    unsigned char* ws;
    __device__ __forceinline__ void init(AccT& acc, const Unit&, int, int, int, int) const { acc_zero(acc); }
    __device__ __forceinline__ void operator()(const AccT& acc, const Unit& u, int wr, int wc, int fr, int fq) const {
        static_assert(WS_K - WS_Q == WS_V - WS_K, "Q, K, V equally spaced");
        const int t = (u.pn - 1) / 3;
        const size_t boff = (u.pn == 0) ? WS_U : (WS_Q + (size_t)t * (WS_K - WS_Q));
        bf16_t* base = (bf16_t*)(ws + boff);
        const int ldc = (u.pn == 0) ? PW : AW, colt = (u.pn == 0) ? 0 : ((u.pn - 1) % 3) * 256;
        const float sc = (u.pn >= 1 && u.pn <= 3) ? QSCALE : 1.f;
        const int row0 = u.pm * 256 + wr * 64 + fr, col0 = colt + wc * 32 + 8 * fq;
#pragma unroll
        for (int ai = 0; ai < 2; ++ai)
#pragma unroll
            for (int m = 0; m < 4; ++m) { bf16_t* rowp = base + (size_t)(row0 + ai * 128 + m * 16) * ldc + col0;
#pragma unroll
                for (int bj = 0; bj < 2; ++bj) { const f32x4 v0 = acc[ai][bj][m][0] * sc, v1 = acc[ai][bj][m][1] * sc;
                    u32x4 w; w.x = cvt_pk_bf16(v0[0], v0[1]); w.y = cvt_pk_bf16(v0[2], v0[3]); w.z = cvt_pk_bf16(v1[0], v1[1]); w.w = cvt_pk_bf16(v1[2], v1[3]);
                    *(u32x4*)(rowp + bj * 128) = w; } }
    }
};
struct EpiResF32 {
    static constexpr bool PERM = false;
    const float* X; float* O;
    __device__ __forceinline__ void init(AccT& acc, const Unit& u, int wr, int wc, int fr, int fq) const {
        const int row0 = u.pm * 256 + wr * 64 + fr, col0 = u.pn * 256 + wc * 32 + 4 * fq;
#pragma unroll
        for (int ai = 0; ai < 2; ++ai)
#pragma unroll
            for (int m = 0; m < 4; ++m) { const size_t off = (size_t)(row0 + ai * 128 + m * 16) * D + col0;
#pragma unroll
                for (int bj = 0; bj < 2; ++bj)
#pragma unroll
                    for (int n = 0; n < 2; ++n) acc[ai][bj][m][n] = __builtin_nontemporal_load((const f32x4*)(X + off + bj * 128 + n * 16)); }
    }
    __device__ __forceinline__ void operator()(const AccT& acc, const Unit& u, int wr, int wc, int fr, int fq) const {
        const int row0 = u.pm * 256 + wr * 64 + fr, col0 = u.pn * 256 + wc * 32 + 4 * fq;
#pragma unroll
        for (int ai = 0; ai < 2; ++ai)
#pragma unroll
            for (int m = 0; m < 4; ++m) { const size_t off = (size_t)(row0 + ai * 128 + m * 16) * D + col0;
#pragma unroll
                for (int bj = 0; bj < 2; ++bj)
#pragma unroll
                    for (int n = 0; n < 2; ++n) *(f32x4*)(O + off + bj * 128 + n * 16) = acc[ai][bj][m][n]; }
    }
};
__device__ __forceinline__ float swiglu1(float g, float u) {
    g = fminf(g, 7.0f); u = fminf(fmaxf(u, -7.0f), 7.0f);
    const float s = __builtin_amdgcn_rcpf(1.0f + __builtin_amdgcn_exp2f(g * (-1.702f * LOG2E)));
    return (u + 1.0f) * (g * s);
}
__device__ __forceinline__ f32x4 swiglu4(f32x4 g, f32x4 u) {
    g = __builtin_elementwise_min(g, (f32x4){7.0f, 7.0f, 7.0f, 7.0f});
    u = __builtin_elementwise_min(__builtin_elementwise_max(u, (f32x4){-7.0f, -7.0f, -7.0f, -7.0f}), (f32x4){7.0f, 7.0f, 7.0f, 7.0f});
    const f32x4 t = g * (-1.702f * LOG2E);
    f32x4 e; e[0] = __builtin_amdgcn_exp2f(t[0]); e[1] = __builtin_amdgcn_exp2f(t[1]); e[2] = __builtin_amdgcn_exp2f(t[2]); e[3] = __builtin_amdgcn_exp2f(t[3]);
    const f32x4 d = e + 1.0f;
    f32x4 r; r[0] = __builtin_amdgcn_rcpf(d[0]); r[1] = __builtin_amdgcn_rcpf(d[1]); r[2] = __builtin_amdgcn_rcpf(d[2]); r[3] = __builtin_amdgcn_rcpf(d[3]);
    return (u * ASCALE + ASCALE) * (g * r);
}
__device__ __forceinline__ unsigned cvt4_fp8_nc(const f32x4& v) {
    int p = __builtin_amdgcn_cvt_pk_fp8_f32(v[0], v[1], 0, false); p = __builtin_amdgcn_cvt_pk_fp8_f32(v[2], v[3], p, true); return (unsigned)p; }
struct EpiGateUp {
    static constexpr bool PERM = true;
    __device__ __forceinline__ void init(AccT& acc, const Unit&, int, int, int, int) const { acc_zero(acc); }
    unsigned char* ACT; const LAS int* tpre; const LAS float* tabf; const LAS float* tabb;
    __device__ __forceinline__ void operator()(const AccT& acc, const Unit& u, int wr, int wc, int fr, int fq) const {
        const int cl = wc * 32 + 8 * fq, colA = u.pn * 128 + cl;
        const LAS float* bp = tabb + u.slot * 256 + cl;
        const f32x4 bg0 = *(const LAS f32x4*)(bp), bg1 = *(const LAS f32x4*)(bp + 4), bu0 = *(const LAS f32x4*)(bp + 128), bu1 = *(const LAS f32x4*)(bp + 132);
        const int srow0 = (__builtin_amdgcn_readfirstlane(tpre[u.e]) + u.pm) * 256;
#pragma unroll
        for (int ai = 0; ai < 2; ++ai)
#pragma unroll
            for (int m = 0; m < 4; ++m) { const int r = ai * 128 + wr * 64 + m * 16 + fr; const float rs = tabf[u.slot * 256 + r];
                const f32x4 g0 = acc[ai][0][m][0] * rs + bg0, g1 = acc[ai][0][m][1] * rs + bg1, u0 = acc[ai][1][m][0] * rs + bu0, u1 = acc[ai][1][m][1] * rs + bu1;
                u32x2 w; w.x = cvt4_fp8_nc(swiglu4(g0, u0)); w.y = cvt4_fp8_nc(swiglu4(g1, u1));
                *(u32x2*)(ACT + (size_t)(srow0 + r) * DFF + colA) = w; }
    }
};
struct EpiDown {
    static constexpr bool PERM = true;
    __device__ __forceinline__ void init(AccT& acc, const Unit&, int, int, int, int) const { acc_zero(acc); }
    unsigned char* Y; const LAS int* tab; const LAS float* tabf; const LAS float* tabb;
    __device__ __forceinline__ void operator()(const AccT& acc, const Unit& u, int wr, int wc, int fr, int fq) const {
        const int cl = wc * 32 + 8 * fq, col0 = u.pn * 256 + cl;
        const LAS float* bp = tabb + u.slot * 256 + cl;
        f32x4 bv[2][2];
#pragma unroll
        for (int bj = 0; bj < 2; ++bj) { bv[bj][0] = *(const LAS f32x4*)(bp + bj * 128); bv[bj][1] = *(const LAS f32x4*)(bp + bj * 128 + 4); }
#pragma unroll
        for (int ai = 0; ai < 2; ++ai)
#pragma unroll
            for (int m = 0; m < 4; ++m) { const int r = ai * 128 + wr * 64 + m * 16 + fr; const int idx = tab[u.slot * 256 + r];
                if (idx >= 0) { const float gv = tabf[u.slot * 256 + r] * YSCALE; unsigned char* rowp = Y + (size_t)idx * D + col0;
#pragma unroll
                    for (int bj = 0; bj < 2; ++bj) { const f32x4 v0 = (acc[ai][bj][m][0] * (1.0f / (ASCALE * WSCALE)) + bv[bj][0]) * gv, v1 = (acc[ai][bj][m][1] * (1.0f / (ASCALE * WSCALE)) + bv[bj][1]) * gv;
                        u32x2 w; w.x = cvt4_fp8(v0[0], v0[1], v0[2], v0[3]); w.y = cvt4_fp8(v1[0], v1[1], v1[2], v1[3]);
                        *(u32x2*)(rowp + bj * 128) = w; } } }
    }
};

__device__ __forceinline__ void tr_item(const float* __restrict__ W, int K, int N, bf16_t* __restrict__ WT, LAS float* scr, int kb, int nb, int lane) {
    const int k0 = kb * 64, n0 = nb * 64;
    const float* src = W + (size_t)(k0 + (lane >> 4)) * N + n0 + (lane & 15) * 4;
    f32x4 v[16];
#pragma unroll
    for (int i = 0; i < 16; ++i) v[i] = *(const f32x4*)(src + (size_t)(4 * i) * N);
#pragma unroll
    for (int i = 0; i < 16; ++i) { LAS float* d = scr + (4 * i + (lane >> 4)) * 65 + (lane & 15) * 4; d[0] = v[i][0]; d[1] = v[i][1]; d[2] = v[i][2]; d[3] = v[i][3]; }
    LDS_WAIT();
    const int c = lane & 7;
#pragma unroll
    for (int j = 0; j < 8; ++j) { const int n = 8 * j + (lane >> 3); const LAS float* s = scr + (8 * c) * 65 + n;
        u32x4 o; o.x = cvt_pk_bf16(s[0], s[65]); o.y = cvt_pk_bf16(s[130], s[195]); o.z = cvt_pk_bf16(s[260], s[325]); o.w = cvt_pk_bf16(s[390], s[455]);
        *(u32x4*)(WT + (size_t)(n0 + n) * K + k0 + 8 * c) = o; }
    LDS_WAIT();
}
struct Item8 { const float* src; unsigned char* dst; int N; };
__device__ __forceinline__ void chunk8_load(const Item8& d, int ch, f32x4 (&v)[16], int lane) {
    const float* base = d.src + (size_t)(32 * ch + 4 * (lane >> 5)) * d.N + (lane & 31) * 4;
#pragma unroll
    for (int sl = 0; sl < 4; ++sl)
#pragma unroll
        for (int j = 0; j < 4; ++j) v[4 * sl + j] = __builtin_nontemporal_load((const f32x4*)(base + (size_t)(8 * sl + j) * d.N));
}
__device__ __forceinline__ void chunk8_cvt(int ch, const f32x4 (&v)[16], LAS unsigned* scr, int lane) {
    const int nq = lane & 31, kq0 = lane >> 5, sw = (nq & 7) << 2;
#pragma unroll
    for (int sl = 0; sl < 4; ++sl) { const int kw = 8 * ch + kq0 + 2 * sl;
#pragma unroll
        for (int i = 0; i < 4; ++i) scr[(4 * nq + i) * 32 + (kw ^ sw)] = cvt4_fp8(v[4 * sl][i] * WSCALE, v[4 * sl + 1][i] * WSCALE, v[4 * sl + 2][i] * WSCALE, v[4 * sl + 3][i] * WSCALE); }
}
__device__ __forceinline__ void item8_flush(const Item8& d, const LAS unsigned* scr, int lane) {
    LDS_WAIT();
    const int c16 = lane & 7;
#pragma unroll
    for (int jj = 0; jj < 16; ++jj) { const int n = (lane >> 3) + 8 * jj;
        const u32x4 o = *(const LAS u32x4*)(scr + n * 32 + ((c16 ^ ((n >> 2) & 7)) << 2));
        __builtin_nontemporal_store(o, (u32x4*)(d.dst + (size_t)n * D + 16 * c16)); }
    LDS_WAIT();
}
__device__ __forceinline__ int t5_bucket(int dist) {
    if (dist < 16) return dist;
    const int large = 16 + (int)(logf((float)dist / 16.0f) / 4.852030263919617f * 16.0f);
    return large < 31 ? large : 31;
}
struct In { const float *x, *norm1_g, *w_in, *pool_w, *pool_scale, *rel_bias, *w_out, *norm2_g, *router_w, *router_b, *w_gate_up, *b_gate_up, *w_down, *b_down, *final_g; };

constexpr int N8_ALL = NE * 128 + NE * 64;
__device__ __forceinline__ void convert8_queue(LAS unsigned char* lds, const In& in, unsigned char* ws, unsigned* qword) {
    const int lane = threadIdx.x & 63, wave = __builtin_amdgcn_readfirstlane((int)threadIdx.x >> 6);
    constexpr int IG = 8 * 16, ID = 8 * 8;
    auto desc = [&](int r) -> Item8 { Item8 d;
        if (r < NE * IG) { const int e = r / IG, q = r % IG, kb = q / 16, nb = q % 16;
            d.src = in.w_gate_up + (size_t)e * D * 2 * DFF + (size_t)(kb * 128) * (2 * DFF) + nb * 128; d.N = 2 * DFF; d.dst = ws + WS_WGU + (size_t)e * 2 * DFF * D + (size_t)(nb * 128) * D + kb * 128; }
        else { const int r2 = r - NE * IG, e = r2 / ID, q = r2 % ID, kb = q / 8, nb = q % 8;
            d.src = in.w_down + (size_t)e * DFF * D + (size_t)(kb * 128) * D + nb * 128; d.N = D; d.dst = ws + WS_WD + (size_t)e * D * DFF + (size_t)(nb * 128) * DFF + kb * 128; }
        return d; };
    auto claim = [&]() -> int { unsigned v = 0; if (lane == 0) v = __hip_atomic_fetch_add(qword, 1u, __ATOMIC_RELAXED, __HIP_MEMORY_SCOPE_AGENT); return __builtin_amdgcn_readfirstlane((int)v); };
    LAS unsigned* scr8 = (LAS unsigned*)(lds + wave * 16384);
    f32x4 va[16], vb[16];
    int it = claim();
    if (it < N8_ALL) { const Item8 d0 = desc(it); chunk8_load(d0, 0, va, lane); }
    while (it < N8_ALL) {
        const Item8 d = desc(it);
        const int nx = claim();
        chunk8_load(d, 1, vb, lane); chunk8_cvt(0, va, scr8, lane);
        chunk8_load(d, 2, va, lane); chunk8_cvt(1, vb, scr8, lane);
        chunk8_load(d, 3, vb, lane); chunk8_cvt(2, va, scr8, lane);
        if (nx < N8_ALL) { const Item8 dn = desc(nx); chunk8_load(dn, 0, va, lane); }
        chunk8_cvt(3, vb, scr8, lane);
        item8_flush(d, scr8, lane);
        it = nx;
    }
}
__device__ __forceinline__ void p0_prologue(LAS unsigned char* lds, const In& in, unsigned char* ws, int G, int c) {
    const int tid = threadIdx.x, lane = tid & 63, wave = __builtin_amdgcn_readfirstlane(tid >> 6);
    const int gw = c * 8 + wave, NGW = G * 8;
    LAS float* scr = (LAS float*)(lds + wave * 16640);
    constexpr int I_IN = 16 * 40, I_OUT = 16 * 16, I_GU1 = 16 * 32, I_D1 = 16 * 16;
    for (int it = gw; it < I_IN; it += NGW) tr_item(in.w_in, D, NPROJ, (bf16_t*)(ws + WS_WIN), scr, it / 40, it % 40, lane);
#ifndef MK_DOUBLE
#define MK_DOUBLE 0
#endif
    for (int repr_ = 0; repr_ < (((MK_DOUBLE >> 11) & 1) ? 2 : 1); ++repr_) {
        f32x4 gv[4];
#pragma unroll
        for (int j = 0; j < 4; ++j) gv[j] = *(const f32x4*)(in.norm1_g + 4 * lane + 256 * j);
        bf16_t* H = (bf16_t*)(ws + WS_H);
        f32x4 v[4], vn[4];
        int m = gw;
        if (m < S) {
#pragma unroll
            for (int j = 0; j < 4; ++j) v[j] = __builtin_nontemporal_load((const f32x4*)(in.x + (size_t)m * D + 4 * lane + 256 * j)); }
        for (; m < S; m += NGW) {
            const int mn = m + NGW;
            if (mn < S) {
#pragma unroll
                for (int j = 0; j < 4; ++j) vn[j] = __builtin_nontemporal_load((const f32x4*)(in.x + (size_t)mn * D + 4 * lane + 256 * j)); }
            float s = 0.f;
#pragma unroll
            for (int j = 0; j < 4; ++j) s += (v[j][0] * v[j][0] + v[j][1] * v[j][1]) + (v[j][2] * v[j][2] + v[j][3] * v[j][3]);
            const float rstd = rsqrtf(wave_sum(s) * (1.0f / D) + RMS_EPS);
#pragma unroll
            for (int j = 0; j < 4; ++j) { const f32x4 o = v[j] * rstd * gv[j]; u32x2 w; w.x = cvt_pk_bf16(o[0], o[1]); w.y = cvt_pk_bf16(o[2], o[3]); *(u32x2*)(H + (size_t)m * D + 4 * lane + 256 * j) = w; }
#pragma unroll
            for (int j = 0; j < 4; ++j) v[j] = vn[j];
        }
    }
}
__device__ __forceinline__ void p0_side(LAS unsigned char* lds, const In& in, unsigned char* ws, int n0, int c0) {
    const int tid = threadIdx.x, lane = tid & 63, wave = __builtin_amdgcn_readfirstlane(tid >> 6);
    LAS float* scr = (LAS float*)(lds + wave * 16640);
    for (int it = c0 * 8 + wave; it < 16 * 16; it += n0 * 8) tr_item(in.w_out, D, D, (bf16_t*)(ws + WS_WOUT), scr, it / 16, it % 16, lane);
    const int gt = c0 * 512 + tid, NGT = n0 * 512;
    { float* GWT = (float*)(ws + WS_GWT); for (int i = gt; i < NE * D; i += NGT) { const int e = i >> 10, k = i & 1023; GWT[i] = in.norm2_g[k] * in.router_w[k * NE + e]; } }
    { float* BT = (float*)(ws + WS_BT); for (int i = gt; i < 36 * BT_N; i += NGT) { const int bh = i / BT_N, j = i % BT_N, b = bh / NH, h = bh % NH, dil = (b == 0) ? 1 : (b == 1 ? 4 : 16), d = j - BT_OFF;
        BT[i] = (d >= 0 && d <= 128) ? in.rel_bias[t5_bucket(d * dil) * NH + h] * LOG2E : NEGBIG; } }
    { bf16_t* PWT = (bf16_t*)(ws + WS_PWT); for (int i = gt; i < 4 * 64 * 64; i += NGT) { const int g = i >> 12, d = (i >> 6) & 63, cc = i & 63; PWT[i] = (bf16_t)(cvt_pk_bf16(in.pool_w[g * 4096 + cc * 64 + d], 0.f) & 0xffffu); } }
}

__device__ __forceinline__ s16x4 lds_tr16(const LAS unsigned char* p) { typedef short v4i16_t __attribute__((ext_vector_type(4))); return __builtin_bit_cast(s16x4, __builtin_amdgcn_ds_read_tr16_b64_v4i16((LAS v4i16_t*)p)); }
constexpr int ATT_UNITS = 3 * NH * 64, KV_PITCH = 144, KV_ROWS = 384, ATT_VOFF = KV_ROWS * KV_PITCH, ATT_TOFF = 2 * KV_ROWS * KV_PITCH, ATT_NEGOFF = ATT_TOFF + BT_N * 4;
__device__ __forceinline__ void attn_decode(int uid, int& b, int& h, int& r, int& j, int& dil) {
    const int bh = uid >> 6, x = uid & 63; b = bh / NH; h = bh % NH; dil = (b == 0) ? 1 : (b == 1 ? 4 : 16);
    const int nb = 64 / dil; r = x / nb; j = x % nb;
}
__device__ __forceinline__ void attn_phase(LAS unsigned char* lds, const bf16_t* __restrict__ Qg, const bf16_t* __restrict__ Kg, const bf16_t* __restrict__ Vg, const float* __restrict__ BT,
                                           bf16_t* __restrict__ OP, float* __restrict__ LSE, int G, int c) {
    const int tid = threadIdx.x, lane = tid & 63, w = __builtin_amdgcn_readfirstlane(tid >> 6), ql = lane & 15, g = lane >> 4;
    LAS unsigned char* Ks = lds; LAS unsigned char* Vs = lds + ATT_VOFF; LAS float* Tb = (LAS float*)(lds + ATT_TOFF); LAS float* Tneg = (LAS float*)(lds + ATT_NEGOFF);
    if (tid < 16) Tneg[tid] = NEGBIG;
    u32x4 kpre[6], vpre[6]; bf16x8 qa0, qa1, qb0, qb1; float tpre = 0.f;
#define ATT_PREFETCH(uid_) do { int b_, h_, r_, j_, dil_; attn_decode((uid_), b_, h_, r_, j_, dil_); \
        _Pragma("unroll") for (int cc = 0; cc < 6; ++cc) { const int id = tid + 512 * cc, row = id >> 3, ch = id & 7; int mm = 256 * j_ - 128 + row; if (mm < 0) mm += 128; \
            const size_t off = (size_t)(r_ + dil_ * mm) * AW + h_ * HD + ch * 8; kpre[cc] = *(const u32x4*)(Kg + off); vpre[cc] = *(const u32x4*)(Vg + off); } \
        { const size_t qo = (size_t)(r_ + dil_ * (256 * j_ + 32 * w + ql)) * AW + h_ * HD + 8 * g; const size_t qs = (size_t)16 * dil_ * AW; \
          qa0 = *(const bf16x8*)(Qg + qo); qa1 = *(const bf16x8*)(Qg + qo + 32); qb0 = *(const bf16x8*)(Qg + qo + qs); qb1 = *(const bf16x8*)(Qg + qo + qs + 32); } \
        if (tid < BT_N) tpre = BT[(b_ * NH + h_) * BT_N + tid]; } while (0)
#ifndef ATT_SYNC_LOAD
    if (c < ATT_UNITS) ATT_PREFETCH(c);
#endif
    for (int uid = c; uid < ATT_UNITS; uid += G) {
        int b, h, r, j, dil; attn_decode(uid, b, h, r, j, dil);
#ifdef ATT_SYNC_LOAD
        ATT_PREFETCH(uid);
#endif
#pragma unroll
        for (int cc = 0; cc < 6; ++cc) { const int id = tid + 512 * cc, row = id >> 3, ch = id & 7; *(LAS u32x4*)(Ks + row * KV_PITCH + ch * 16) = kpre[cc]; *(LAS u32x4*)(Vs + row * KV_PITCH + ch * 16) = vpre[cc]; }
        if (tid < BT_N) Tb[tid] = tpre;
        const bf16x8 fa0 = qa0, fa1 = qa1, fb0 = qb0, fb1 = qb1;
        __syncthreads();
#ifndef ATT_SYNC_LOAD
        if (uid + G < ATT_UNITS) ATT_PREFETCH(uid + G);
#endif
        const int kkmin = (j == 0) ? 128 : 0;
        const LAS unsigned char* kb = Ks + (32 * w + ql) * KV_PITCH + g * 16;
        const LAS float* Tq = Tb + (ql + 272 - 4 * g - 3);
        const f32x4 zero4 = (f32x4){0.f, 0.f, 0.f, 0.f};
        f32x4 sA[9], sB[9];
#pragma unroll
        for (int i = 0; i < 10; ++i) {
            const bf16x8 kf0 = *(const LAS bf16x8*)(kb + i * (16 * KV_PITCH)), kf1 = *(const LAS bf16x8*)(kb + i * (16 * KV_PITCH) + 64);
            const bool msk = (32 * w + 16 * i) < kkmin;
            if (i <= 8) { f32x4 st = __builtin_amdgcn_mfma_f32_16x16x32_bf16(kf0, fa0, zero4, 0, 0, 0); st = __builtin_amdgcn_mfma_f32_16x16x32_bf16(kf1, fa1, st, 0, 0, 0);
                const LAS float* tp = msk ? Tneg : (Tq - 16 * i); sA[i] = (f32x4){st[0] + tp[3], st[1] + tp[2], st[2] + tp[1], st[3] + tp[0]}; }
            if (i >= 1) { f32x4 st = __builtin_amdgcn_mfma_f32_16x16x32_bf16(kf0, fb0, zero4, 0, 0, 0); st = __builtin_amdgcn_mfma_f32_16x16x32_bf16(kf1, fb1, st, 0, 0, 0);
                const LAS float* tp = msk ? Tneg : (Tq - 16 * (i - 1)); sB[i - 1] = (f32x4){st[0] + tp[3], st[1] + tp[2], st[2] + tp[1], st[3] + tp[0]}; }
        }
        float mA = NEGBIG, mB = NEGBIG;
#pragma unroll
        for (int i = 0; i < 9; ++i) { mA = fmaxf(mA, fmaxf(fmaxf(sA[i][0], sA[i][1]), fmaxf(sA[i][2], sA[i][3]))); mB = fmaxf(mB, fmaxf(fmaxf(sB[i][0], sB[i][1]), fmaxf(sB[i][2], sB[i][3]))); }
        mA = fmaxf(mA, __shfl_xor(mA, 16)); mA = fmaxf(mA, __shfl_xor(mA, 32)); mB = fmaxf(mB, __shfl_xor(mB, 16)); mB = fmaxf(mB, __shfl_xor(mB, 32));
        f32x4 oA[4], oB[4];
#pragma unroll
        for (int dt = 0; dt < 4; ++dt) { oA[dt] = zero4; oB[dt] = zero4; }
        float lA = 0.f, lB = 0.f;
        const LAS unsigned char* vb = Vs + (32 * w + 4 * g + (ql >> 2)) * KV_PITCH + (ql & 3) * 8;
#pragma unroll
        for (int i = 0; i < 10; ++i) {
            const LAS unsigned char* vt = vb + i * (16 * KV_PITCH);
            const s16x4 v0 = lds_tr16(vt), v1 = lds_tr16(vt + 32), v2 = lds_tr16(vt + 64), v3 = lds_tr16(vt + 96);
            if (i <= 8) { const float p0 = __builtin_amdgcn_exp2f(sA[i][0] - mA), p1 = __builtin_amdgcn_exp2f(sA[i][1] - mA), p2 = __builtin_amdgcn_exp2f(sA[i][2] - mA), p3 = __builtin_amdgcn_exp2f(sA[i][3] - mA);
                lA += (p0 + p1) + (p2 + p3); u32x2 pw; pw.x = cvt_pk_bf16(p0, p1); pw.y = cvt_pk_bf16(p2, p3); const s16x4 pf = __builtin_bit_cast(s16x4, pw);
                oA[0] = __builtin_amdgcn_mfma_f32_16x16x16bf16_1k(v0, pf, oA[0], 0, 0, 0); oA[1] = __builtin_amdgcn_mfma_f32_16x16x16bf16_1k(v1, pf, oA[1], 0, 0, 0);
                oA[2] = __builtin_amdgcn_mfma_f32_16x16x16bf16_1k(v2, pf, oA[2], 0, 0, 0); oA[3] = __builtin_amdgcn_mfma_f32_16x16x16bf16_1k(v3, pf, oA[3], 0, 0, 0); }
            if (i >= 1) { const float p0 = __builtin_amdgcn_exp2f(sB[i - 1][0] - mB), p1 = __builtin_amdgcn_exp2f(sB[i - 1][1] - mB), p2 = __builtin_amdgcn_exp2f(sB[i - 1][2] - mB), p3 = __builtin_amdgcn_exp2f(sB[i - 1][3] - mB);
                lB += (p0 + p1) + (p2 + p3); u32x2 pw; pw.x = cvt_pk_bf16(p0, p1); pw.y = cvt_pk_bf16(p2, p3); const s16x4 pf = __builtin_bit_cast(s16x4, pw);
                oB[0] = __builtin_amdgcn_mfma_f32_16x16x16bf16_1k(v0, pf, oB[0], 0, 0, 0); oB[1] = __builtin_amdgcn_mfma_f32_16x16x16bf16_1k(v1, pf, oB[1], 0, 0, 0);
                oB[2] = __builtin_amdgcn_mfma_f32_16x16x16bf16_1k(v2, pf, oB[2], 0, 0, 0); oB[3] = __builtin_amdgcn_mfma_f32_16x16x16bf16_1k(v3, pf, oB[3], 0, 0, 0); }
        }
        lA += __shfl_xor(lA, 16); lA += __shfl_xor(lA, 32); lB += __shfl_xor(lB, 16); lB += __shfl_xor(lB, 32);
#ifdef ATT_EXP1
        lA = 1.0f; lB = 1.0f; mA = 0.f; mB = 0.f;
#pragma unroll
        for (int dt = 0; dt < 4; ++dt) { oA[dt] = zero4; oB[dt] = zero4; }
#endif
#ifdef ATT_EXP2
        lA = 1.0f; lB = 1.0f;
#pragma unroll
        for (int dt = 0; dt < 4; ++dt) { oA[dt] = zero4; oB[dt] = zero4; }
#endif
        const float iA = 1.0f / lA, iB = 1.0f / lB;
        const int posA = r + dil * (256 * j + 32 * w + ql), posB = posA + 16 * dil;
        bf16_t* dA = OP + ((size_t)b * S + posA) * AW + h * HD + 4 * g; bf16_t* dB = OP + ((size_t)b * S + posB) * AW + h * HD + 4 * g;
#pragma unroll
        for (int dt = 0; dt < 4; ++dt) { u32x2 t; t.x = cvt_pk_bf16(oA[dt][0] * iA, oA[dt][1] * iA); t.y = cvt_pk_bf16(oA[dt][2] * iA, oA[dt][3] * iA); *(u32x2*)(dA + 16 * dt) = t;
            u32x2 t2; t2.x = cvt_pk_bf16(oB[dt][0] * iB, oB[dt][1] * iB); t2.y = cvt_pk_bf16(oB[dt][2] * iB, oB[dt][3] * iB); *(u32x2*)(dB + 16 * dt) = t2; }
        if (g == 0) { LSE[((size_t)b * S + posA) * NH + h] = mA + __builtin_amdgcn_logf(lA); LSE[((size_t)b * S + posB) * NH + h] = mB + __builtin_amdgcn_logf(lB); }
        __syncthreads();
    }
#undef ATT_PREFETCH
}

__device__ __forceinline__ void pool_phase(LAS unsigned char* lds, const bf16_t* __restrict__ U, const bf16_t* __restrict__ PWT, const float* __restrict__ pool_scale, bf16_t* __restrict__ MIX, int G, int c) {
    const int tid = threadIdx.x, lane = tid & 63, w = __builtin_amdgcn_readfirstlane(tid >> 6), ql = lane & 15, g = lane >> 4;
    LAS unsigned char* Us = lds; LAS unsigned char* Pl = lds + 40960;
    for (int pu = c; pu < S / 64; pu += G) {
        const int t0 = pu * 64;
        for (int id = tid; id < 79 * 32; id += 512) { const int row = id >> 5, ch = id & 31, t = t0 - 15 + row;
            u32x4 v = (u32x4){0u, 0u, 0u, 0u}; if (t >= 0) v = *(const u32x4*)(U + (size_t)t * PW + ch * 8);
            *(LAS u32x4*)(Us + row * 512 + ch * 16) = v; }
        __syncthreads();
        { const int cch = tid & 255, th = tid >> 8, gg = cch >> 6, wn = 2 << gg, tl0 = 32 * th;
          const LAS bf16_t* up = (const LAS bf16_t*)Us + cch;
#define UAT(row) __uint_as_float(((unsigned)up[(row) * 256]) << 16)
          float sum = 0.f;
          for (int i = 0; i < wn; ++i) sum += UAT(tl0 + 15 - i);
          for (int tl = tl0; tl < tl0 + 32; ++tl) {
              if (tl > tl0) sum += UAT(tl + 15) - UAT(tl + 15 - wn);
              const int t = t0 + tl; const int cnt = (t + 1 < wn) ? (t + 1) : wn;
              const float val = sum / (float)cnt - UAT(tl + 15);
              ((LAS bf16_t*)(Pl + tl * 528))[cch] = (bf16_t)(cvt_pk_bf16(val, 0.f) & 0xffffu);
          }
#undef UAT
        }
        __syncthreads();
        { const int tt = w & 3, gp = w >> 2;
#pragma unroll
          for (int gi = 0; gi < 2; ++gi) { const int gg = 2 * gp + gi;
              const bf16x8 b0 = *(const LAS bf16x8*)(Pl + (16 * tt + ql) * 528 + (gg * 64 + 8 * g) * 2), b1 = *(const LAS bf16x8*)(Pl + (16 * tt + ql) * 528 + (gg * 64 + 32 + 8 * g) * 2);
#pragma unroll
              for (int nt = 0; nt < 4; ++nt) {
                  const bf16_t* ap = PWT + ((size_t)(gg * 64 + 16 * nt + ql) * 64 + 8 * g);
                  const bf16x8 a0 = *(const bf16x8*)(ap), a1 = *(const bf16x8*)(ap + 32);
                  f32x4 acc = __builtin_amdgcn_mfma_f32_16x16x32_bf16(a0, b0, (f32x4){0.f, 0.f, 0.f, 0.f}, 0, 0, 0);
                  acc = __builtin_amdgcn_mfma_f32_16x16x32_bf16(a1, b1, acc, 0, 0, 0);
                  const f32x4 ps = *(const f32x4*)(pool_scale + gg * 64 + 16 * nt + 4 * g);
                  u32x2 o; o.x = cvt_pk_bf16(acc[0] * ps[0], acc[1] * ps[1]); o.y = cvt_pk_bf16(acc[2] * ps[2], acc[3] * ps[3]);
                  *(u32x2*)(MIX + (size_t)(t0 + 16 * tt + ql) * D + gg * 64 + 16 * nt + 4 * g) = o;
              } }
        }
        __syncthreads();
    }
}

__device__ __forceinline__ void combine_phase(const bf16_t* __restrict__ OP, const float* __restrict__ LSE, bf16_t* __restrict__ MIX, int G, int c) {
    const int gt = c * 512 + threadIdx.x, NGT = G * 512;
    for (int id = gt; id < S * 96; id += NGT) {
        const int t = id / 96, rem = id % 96, h = rem >> 3, c8 = rem & 7;
        const float l0 = LSE[(size_t)t * NH + h], l1 = LSE[((size_t)S + t) * NH + h], l2 = LSE[((size_t)2 * S + t) * NH + h];
        const float mx = fmaxf(l0, fmaxf(l1, l2));
        float w0 = __builtin_amdgcn_exp2f(l0 - mx), w1 = __builtin_amdgcn_exp2f(l1 - mx), w2 = __builtin_amdgcn_exp2f(l2 - mx);
        const float inv = 1.0f / (w0 + w1 + w2); w0 *= inv; w1 *= inv; w2 *= inv;
        const size_t off = (size_t)t * AW + h * HD + c8 * 8;
        const u32x4 a = __builtin_nontemporal_load((const u32x4*)(OP + off)), b = __builtin_nontemporal_load((const u32x4*)(OP + (size_t)S * AW + off)), cc = __builtin_nontemporal_load((const u32x4*)(OP + (size_t)2 * S * AW + off));
        u32x4 o;
#pragma unroll
        for (int k = 0; k < 4; ++k) { const float lo = w0 * bf_lo(a[k]) + w1 * bf_lo(b[k]) + w2 * bf_lo(cc[k]), hi = w0 * bf_hi(a[k]) + w1 * bf_hi(b[k]) + w2 * bf_hi(cc[k]); o[k] = cvt_pk_bf16(lo, hi); }
        *(u32x4*)(MIX + (size_t)t * D + PW + h * HD + c8 * 8) = o;
    }
}

constexpr int GWB_PITCH = 2064;
constexpr int RT_GWL = NE * GWB_PITCH, RT_G2 = 2 * NE * GWB_PITCH, RT_LG = RT_G2 + 4096, RT_RS = RT_LG + 4 * 16 * 33 * 4, RT_CNT = RT_RS + 256, RT_PART = RT_CNT + 256, RT_END = RT_PART + 4 * 64 * 9 * 4;
static_assert(RT_END <= LDS_CTL, "router LDS map");
__device__ __forceinline__ void split_bf16(const f32x4& a0, const f32x4& a1, bf16x8& hi, bf16x8& lo) {
    u32x4 h, l;
    h.x = cvt_pk_bf16(a0[0], a0[1]); h.y = cvt_pk_bf16(a0[2], a0[3]); h.z = cvt_pk_bf16(a1[0], a1[1]); h.w = cvt_pk_bf16(a1[2], a1[3]);
    l.x = cvt_pk_bf16(a0[0] - bf_lo(h.x), a0[1] - bf_hi(h.x)); l.y = cvt_pk_bf16(a0[2] - bf_lo(h.y), a0[3] - bf_hi(h.y));
    l.z = cvt_pk_bf16(a1[0] - bf_lo(h.z), a1[1] - bf_hi(h.z)); l.w = cvt_pk_bf16(a1[2] - bf_lo(h.w), a1[3] - bf_hi(h.w));
    hi = __builtin_bit_cast(bf16x8, h); lo = __builtin_bit_cast(bf16x8, l);
}
__device__ __forceinline__ unsigned trunc_pk(float lo, float hi) { return (__float_as_uint(lo) >> 16) | (__float_as_uint(hi) & 0xffff0000u); }
__device__ __forceinline__ float trunc_res(float x) { return x - __uint_as_float(__float_as_uint(x) & 0xffff0000u); }
__device__ __forceinline__ void split_trunc(const f32x4& a0, const f32x4& a1, bf16x8& hi, bf16x8& lo) {
    u32x4 h, l;
    h.x = trunc_pk(a0[0], a0[1]); h.y = trunc_pk(a0[2], a0[3]); h.z = trunc_pk(a1[0], a1[1]); h.w = trunc_pk(a1[2], a1[3]);
    l.x = trunc_pk(trunc_res(a0[0]), trunc_res(a0[1])); l.y = trunc_pk(trunc_res(a0[2]), trunc_res(a0[3])); l.z = trunc_pk(trunc_res(a1[0]), trunc_res(a1[1])); l.w = trunc_pk(trunc_res(a1[2]), trunc_res(a1[3]));
    hi = __builtin_bit_cast(bf16x8, h); lo = __builtin_bit_cast(bf16x8, l);
}
__device__ __forceinline__ void router_phase(LAS unsigned char* lds, const float* __restrict__ X1, const float* __restrict__ g2, const float* __restrict__ GWT, const float* __restrict__ rb,
                                             unsigned char* __restrict__ H, float* __restrict__ RSTD, float* __restrict__ GATES, int* __restrict__ ROWS, unsigned* __restrict__ COUNTS, int G, int c) {
    const int tid = threadIdx.x, lane = tid & 63, w = __builtin_amdgcn_readfirstlane(tid >> 6), ql = lane & 15, g = lane >> 4;
    const int ts = w & 3, kh = w >> 2;
    LAS unsigned char* GWH = lds; LAS unsigned char* GWL = lds + RT_GWL;
    LAS float* G2 = (LAS float*)(lds + RT_G2);
    LAS float* LG = (LAS float*)(lds + RT_LG) + ts * (16 * 33);
    LAS float* RS = (LAS float*)(lds + RT_RS) + ts * 16;
    LAS int* LCNT = (LAS int*)(lds + RT_CNT);
    LAS int* LBASE = LCNT + 32;
    LAS float* PART = (LAS float*)(lds + RT_PART) + ts * (64 * 9);
    const int nrounds = (S / 16 + 4 * G - 1) / (4 * G);
    for (int rd = 0; rd < nrounds; ++rd) {
        const int tile = (rd * 4 + ts) * G + c;
        const bool active = tile < S / 16;
        const int tok = (active ? tile : 0) * 16 + ql;
        const float* xr = X1 + (size_t)tok * D + kh * 512 + 8 * g;
        f32x4 av[16];
        if (active) {
#pragma unroll
            for (int i = 0; i < 8; ++i) { av[2 * i] = __builtin_nontemporal_load((const f32x4*)(xr + 32 * i)); av[2 * i + 1] = __builtin_nontemporal_load((const f32x4*)(xr + 32 * i + 4)); } }
        if (rd == 0) {
            for (int id = tid; id < NE * 128; id += 512) { const int e = id >> 7, k8 = id & 127; const f32x4 x0 = *(const f32x4*)(GWT + e * D + k8 * 8), x1v = *(const f32x4*)(GWT + e * D + k8 * 8 + 4);
                bf16x8 hi, lo; split_bf16(x0, x1v, hi, lo); *(LAS bf16x8*)(GWH + e * GWB_PITCH + k8 * 16) = hi; *(LAS bf16x8*)(GWL + e * GWB_PITCH + k8 * 16) = lo; }
            if (tid < 256) *(LAS f32x4*)(G2 + tid * 4) = *(const f32x4*)(g2 + tid * 4);
        }
        if (tid < 32) LCNT[tid] = 0;
        __syncthreads();
        int ek[4] = {0, 0, 0, 0}, lp[4] = {0, 0, 0, 0}; float gk[4] = {0.f, 0.f, 0.f, 0.f};
        f32x4 acc0 = (f32x4){0.f, 0.f, 0.f, 0.f}, acc1 = acc0; float ss = 0.f;
        if (active) {
            f32x4 accA[6], accB[6];
#pragma unroll
            for (int t = 0; t < 6; ++t) { accA[t] = (f32x4){0.f, 0.f, 0.f, 0.f}; accB[t] = accA[t]; }

            unsigned char* hr = H + (size_t)tok * D + kh * 512 + 8 * g;
            const LAS unsigned char* bh0 = GWH + ql * GWB_PITCH + (kh * 512 + 8 * g) * 2; const LAS unsigned char* bh1 = bh0 + 16 * GWB_PITCH;
            const LAS unsigned char* bl0 = GWL + ql * GWB_PITCH + (kh * 512 + 8 * g) * 2; const LAS unsigned char* bl1 = bl0 + 16 * GWB_PITCH;
            const LAS float* gp = G2 + kh * 512 + 8 * g;
#pragma unroll
            for (int kb = 0; kb < 512; kb += 256) {
                if (kb > 0) {
#pragma unroll
                    for (int i = 0; i < 8; ++i) { av[2 * i] = __builtin_nontemporal_load((const f32x4*)(xr + kb + 32 * i)); av[2 * i + 1] = __builtin_nontemporal_load((const f32x4*)(xr + kb + 32 * i + 4)); } }
#pragma unroll
                for (int i = 0; i < 8; ++i) {
                    const int k0 = kb + 32 * i; const f32x4 a0 = av[2 * i], a1 = av[2 * i + 1];
                    const f32x4 n0 = *(const LAS f32x4*)(gp + k0), n1 = *(const LAS f32x4*)(gp + k0 + 4);
                    const bf16x8 wh0 = *(const LAS bf16x8*)(bh0 + k0 * 2), wh1 = *(const LAS bf16x8*)(bh1 + k0 * 2), wl0 = *(const LAS bf16x8*)(bl0 + k0 * 2), wl1 = *(const LAS bf16x8*)(bl1 + k0 * 2);
                    ss += (a0[0] * a0[0] + a0[1] * a0[1]) + (a0[2] * a0[2] + a0[3] * a0[3]) + (a1[0] * a1[0] + a1[1] * a1[1]) + (a1[2] * a1[2] + a1[3] * a1[3]);
                    u32x2 hv; hv.x = cvt4_fp8(a0[0] * n0[0] * HSCALE, a0[1] * n0[1] * HSCALE, a0[2] * n0[2] * HSCALE, a0[3] * n0[3] * HSCALE);
                    hv.y = cvt4_fp8(a1[0] * n1[0] * HSCALE, a1[1] * n1[1] * HSCALE, a1[2] * n1[2] * HSCALE, a1[3] * n1[3] * HSCALE);
                    *(u32x2*)(hr + k0) = hv;
                    bf16x8 ah, al; split_bf16(a0, a1, ah, al);


                    __builtin_amdgcn_sched_barrier(0); asm volatile("s_nop 7" ::: "memory"); __builtin_amdgcn_sched_barrier(0);
                    f32x4 (&q)[6] = (i & 1) ? accB : accA;
                    q[0] = __builtin_amdgcn_mfma_f32_16x16x32_bf16(ah, wh0, q[0], 0, 0, 0); q[1] = __builtin_amdgcn_mfma_f32_16x16x32_bf16(ah, wh1, q[1], 0, 0, 0);
                    q[2] = __builtin_amdgcn_mfma_f32_16x16x32_bf16(ah, wl0, q[2], 0, 0, 0); q[3] = __builtin_amdgcn_mfma_f32_16x16x32_bf16(ah, wl1, q[3], 0, 0, 0);
                    q[4] = __builtin_amdgcn_mfma_f32_16x16x32_bf16(al, wh0, q[4], 0, 0, 0); q[5] = __builtin_amdgcn_mfma_f32_16x16x32_bf16(al, wh1, q[5], 0, 0, 0);

                    __builtin_amdgcn_sched_barrier(0); asm volatile("s_nop 15\n\ts_nop 15" ::: "memory"); __builtin_amdgcn_sched_barrier(0);

                }
            }

            acc0 = ((accA[0] + accB[0]) + (accA[2] + accB[2])) + (accA[4] + accB[4]); acc1 = ((accA[1] + accB[1]) + (accA[3] + accB[3])) + (accA[5] + accB[5]);


            if (kh == 1) { LAS float* pp = PART + lane * 9;
#pragma unroll
                for (int i = 0; i < 4; ++i) { pp[i] = acc0[i]; pp[4 + i] = acc1[i]; } pp[8] = ss; }
        }
        __syncthreads();
        if (active && kh == 0) {
            { const LAS float* pp = PART + lane * 9;
#pragma unroll
              for (int i = 0; i < 4; ++i) { acc0[i] += pp[i]; acc1[i] += pp[4 + i]; } ss += pp[8]; }
            ss += __shfl_xor(ss, 16); ss += __shfl_xor(ss, 32);
            const float rstd = rsqrtf(ss * (1.0f / D) + RMS_EPS);
            if (g == 0) { RSTD[tok] = rstd; RS[ql] = rstd; }
            LDS_WAIT();
            const float rb0 = rb[ql], rb1 = rb[16 + ql];
#pragma unroll
            for (int rg = 0; rg < 4; ++rg) { const float rr = RS[4 * g + rg]; LG[(4 * g + rg) * 33 + ql] = acc0[rg] * rr + rb0; LG[(4 * g + rg) * 33 + 16 + ql] = acc1[rg] * rr + rb1; }
            LDS_WAIT();
            if (lane < 16) {
                float v[32];
#pragma unroll
                for (int e = 0; e < 32; ++e) v[e] = LG[ql * 33 + e];
                float tv[4];
#pragma unroll
                for (int r = 0; r < 4; ++r) { float best = v[0]; int bi = 0;
#pragma unroll
                    for (int e = 1; e < 32; ++e) { const bool gt = v[e] > best; best = gt ? v[e] : best; bi = gt ? e : bi; }
                    tv[r] = best; ek[r] = bi;
#pragma unroll
                    for (int e = 0; e < 32; ++e) v[e] = (e == bi) ? -INFINITY : v[e]; }
                const float e1 = __expf(tv[1] - tv[0]), e2 = __expf(tv[2] - tv[0]), e3 = __expf(tv[3] - tv[0]); const float inv = 1.0f / (1.0f + e1 + e2 + e3);
                gk[0] = inv; gk[1] = e1 * inv; gk[2] = e2 * inv; gk[3] = e3 * inv;
#pragma unroll
                for (int r = 0; r < 4; ++r) lp[r] = __hip_atomic_fetch_add(LCNT + ek[r], 1, __ATOMIC_RELAXED, __HIP_MEMORY_SCOPE_WORKGROUP);
            }
        }
        __syncthreads();
        if (tid < 32) { const int n = LCNT[tid]; int base = 0; if (n > 0) base = (int)__hip_atomic_fetch_add(COUNTS + tid, (unsigned)n, __ATOMIC_RELAXED, __HIP_MEMORY_SCOPE_AGENT); LBASE[tid] = base; }
        __syncthreads();
        if (active && kh == 0 && lane < 16) {
#pragma unroll
            for (int r = 0; r < 4; ++r) { const int pos = LBASE[ek[r]] + lp[r]; ROWS[(size_t)ek[r] * S + pos] = tok * 4 + r; GATES[tok * 4 + r] = gk[r]; }

        }
        __syncthreads();
    }
}

__device__ __forceinline__ void moe_prefix(LAS int* tpre, LAS int* lcnt, const unsigned* __restrict__ COUNTS) {
    if (threadIdx.x < 32) lcnt[threadIdx.x] = (int)COUNTS[threadIdx.x];
    __syncthreads();
    if (threadIdx.x == 0) { int acc = 0; for (int e = 0; e < NE; ++e) { tpre[e] = acc; acc += (lcnt[e] + 255) >> 8; } tpre[NE] = acc; }
    __syncthreads();
}
template <bool GU, class Prob> __device__ __forceinline__ void moe_table(const Prob& P, LAS int* udesc, LAS int* tab, LAS float* tabf, LAS float* tabb, const LAS int* lcnt, const int* __restrict__ ROWS,
                                                                         const float* __restrict__ rowf, const float* __restrict__ bias) {
    if (threadIdx.x < MAXU) { Unit u0; u0.e = 0; u0.pm = 0; u0.pn = 0; u0.slot = 0; const bool ok = P.search((int)threadIdx.x, u0);
        udesc[4 * threadIdx.x] = u0.e; udesc[4 * threadIdx.x + 1] = u0.pm; udesc[4 * threadIdx.x + 2] = u0.pn; udesc[4 * threadIdx.x + 3] = ok ? 1 : 0; }
    __syncthreads();
    Unit u;
#pragma unroll 1
    for (int i = 0; i < MAXU && P.next(i, u); ++i) {
        if (threadIdx.x < 256) { const int rr = u.pm * 256 + (int)threadIdx.x; const int idx = (rr < lcnt[u.e]) ? ROWS[(size_t)u.e * S + rr] : -1; tab[i * 256 + threadIdx.x] = idx;
            tabf[i * 256 + threadIdx.x] = GU ? rowf[idx < 0 ? 0 : (idx >> 2)] * (1.0f / (HSCALE * WSCALE)) : (idx < 0 ? 0.f : rowf[idx]); }
        else { const int j = (int)threadIdx.x - 256;
            tabb[i * 256 + j] = GU ? bias[(size_t)u.e * 2 * DFF + (j >> 7) * DFF + u.pn * 128 + (j & 127)] : bias[(size_t)u.e * D + u.pn * 256 + j]; }
    }
    __syncthreads();
}

__device__ __forceinline__ void final_phase(const float* __restrict__ X1, const unsigned char* __restrict__ Y, const float* __restrict__ fg, float* __restrict__ out, int G, int c) {
    const int tid = threadIdx.x, lane = tid & 63, wave = tid >> 6; const int gw = c * 8 + wave, NGW = G * 8;
    f32x4 gv[4];
#pragma unroll
    for (int j = 0; j < 4; ++j) gv[j] = *(const f32x4*)(fg + 4 * lane + 256 * j);
    for (int m = gw; m < S; m += NGW) {
        const float* xr = X1 + (size_t)m * D + 4 * lane;
        f32x4 v[4];
#pragma unroll
        for (int j = 0; j < 4; ++j) v[j] = __builtin_nontemporal_load((const f32x4*)(xr + 256 * j));

#pragma unroll
        for (int k = 0; k < 4; ++k) { const unsigned char* yr = Y + ((size_t)m * 4 + k) * D + 4 * lane;
#pragma unroll
            for (int j = 0; j < 4; ++j) { const int t = __builtin_nontemporal_load((const int*)(yr + 256 * j)); const f32x2 lo = __builtin_amdgcn_cvt_pk_f32_fp8(t, false), hi = __builtin_amdgcn_cvt_pk_f32_fp8(t, true);
                v[j][0] += lo[0] * (1.0f / YSCALE); v[j][1] += lo[1] * (1.0f / YSCALE); v[j][2] += hi[0] * (1.0f / YSCALE); v[j][3] += hi[1] * (1.0f / YSCALE); } }
        float s = 0.f;
#pragma unroll
        for (int j = 0; j < 4; ++j) s += (v[j][0] * v[j][0] + v[j][1] * v[j][1]) + (v[j][2] * v[j][2] + v[j][3] * v[j][3]);
        const float rstd = rsqrtf(wave_sum(s) * (1.0f / D) + RMS_EPS);
#pragma unroll
        for (int j = 0; j < 4; ++j) __builtin_nontemporal_store(v[j] * rstd * gv[j], (f32x4*)(out + (size_t)m * D + 4 * lane + 256 * j));
    }
}

constexpr int NPHASE = 9;
struct Args { In in; float* out; unsigned char* ws; int ph_lo, ph_hi; };
__global__ void __launch_bounds__(512, 2) fwd(Args args) {
    extern __shared__ __attribute__((aligned(16))) unsigned char lds_raw[];
    LAS unsigned char* lds = (LAS unsigned char*)lds_raw;
    const int tid = threadIdx.x, G = gridDim.x, c = blockIdx.x;
    unsigned char* ws = args.ws; const In& in = args.in;
    unsigned* ctl = (unsigned*)(ws + WS_CTL);
    LAS int* LCTL = (LAS int*)(lds + LDS_CTL);
    if (tid < 256) LCTL[tid] = 0;
    __syncthreads();
    const int lo = args.ph_lo, hi = args.ph_hi;
    const bool one_launch = (hi - lo) > 1;
    XcdBarrier bar; bar.bar = ctl + CW_BAR; bar.x = 0; bar.st = nullptr;
    if (one_launch) bar = xcd_barrier_post(ctl + CW_BAR, (volatile LAS unsigned*)LCTL);
#define IN(k) (lo <= (k) && (k) < hi)
#ifndef MK_DOUBLE
#define MK_DOUBLE 0
#endif
#define REP(k) for (int rep_ = 0; rep_ < ((((MK_DOUBLE) >> (k)) & 1) ? 2 : 1); ++rep_)
#define SEAM(k) do { if (IN((k) + 1)) xcd_barrier(bar); } while (0)
    bf16_t* Hb = (bf16_t*)(ws + WS_H); bf16_t* Ub = (bf16_t*)(ws + WS_U); bf16_t* Qb = (bf16_t*)(ws + WS_Q); bf16_t* Kb = (bf16_t*)(ws + WS_K); bf16_t* Vb = (bf16_t*)(ws + WS_V);
    bf16_t* OPb = (bf16_t*)(ws + WS_OP); bf16_t* MIXb = (bf16_t*)(ws + WS_MIX); float* X1 = (float*)(ws + WS_X1); unsigned char* ACTb = ws + WS_ACT; unsigned char* Yb = ws + WS_Y; unsigned char* H8 = ws + WS_H8;
    float* LSE = (float*)(ws + WS_LSE); float* RSTD = (float*)(ws + WS_RSTD); float* GATES = (float*)(ws + WS_GATES); int* ROWS = (int*)(ws + WS_ROWS); unsigned* COUNTS = ctl + CW_COUNTS;
    LAS int* TPRE = LCTL + 16; LAS int* LCNT = LCTL + 128; LAS int* UDESC = LCTL + 192; LAS int* TAB = (LAS int*)(lds + LDS_TAB); LAS float* TABF = (LAS float*)(lds + LDS_TAB + MAXU * 1024); LAS float* TABB = (LAS float*)(lds + LDS_TAB + 2 * MAXU * 1024);
    static_assert(LDS_TAB + 3 * MAXU * 1024 <= LDS_CTL, "MoE LDS tables");

    if (IN(0)) { REP(0) p0_prologue(lds, in, ws, G, c); SEAM(0); }
    if (IN(1)) {
        const int NG = (G >= 256) ? 160 : G;
        if (c < NG) {
            pg8::DenseProb P{(const char*)Hb, (const char*)(ws + WS_WIN), D * 2, S / 256, NPROJ / 256, NG, c, (size_t)128 * D * 2};
            EpiQKVU E{ws};
            REP(1) pg8::gemm_phase<EpiQKVU, pg8::DenseProb, true, false>(lds, P, E);
        }
        else p0_side(lds, in, ws, G - NG, c - NG);
        if (NG == G) p0_side(lds, in, ws, G, c);
        convert8_queue(lds, in, ws, ctl + CW_QUEUE);
        SEAM(1);
    }
    if (IN(2)) {
        REP(2) attn_phase(lds, Qb, Kb, Vb, (const float*)(ws + WS_BT), OPb, LSE, G, c);
        REP(9) pool_phase(lds, Ub, (const bf16_t*)(ws + WS_PWT), in.pool_scale, MIXb, G, c);
        SEAM(2);
    }
    if (IN(3)) { REP(3) combine_phase(OPb, LSE, MIXb, G, c); SEAM(3); }
    if (IN(4)) {
        pg8::DenseProb P{(const char*)MIXb, (const char*)(ws + WS_WOUT), D * 2, S / 256, D / 256, G, c, (size_t)128 * D * 2};
        EpiResF32 E{in.x, X1};
        REP(4) pg8::gemm_phase<EpiResF32, pg8::DenseProb, true, false>(lds, P, E);
        SEAM(4);
    }
    if (IN(5)) { router_phase(lds, X1, in.norm2_g, (const float*)(ws + WS_GWT), in.router_b, H8, RSTD, GATES, ROWS, COUNTS, G, c); SEAM(5); }
    if (IN(6)) {
        moe_prefix(TPRE, LCNT, COUNTS);
        pg8::MoeProb<true> P{(const char*)H8, (const char*)(ws + WS_WGU), D, 8, G, c, (size_t)DFF * D, (size_t)2 * DFF * D, 128, TPRE, TAB, UDESC};
        moe_table<true>(P, UDESC, TAB, TABF, TABB, LCNT, ROWS, RSTD, in.b_gate_up);
        EpiGateUp E{ACTb, TPRE, TABF, TABB};
        REP(6) pg8::gemm_phase<EpiGateUp, pg8::MoeProb<true>, true, true>(lds, P, E);
        SEAM(6);
    }
    if (IN(7)) {
        moe_prefix(TPRE, LCNT, COUNTS);
        pg8::MoeProb<false> P{(const char*)ACTb, (const char*)(ws + WS_WD), DFF, 4, G, c, (size_t)128 * DFF, (size_t)D * DFF, 256, TPRE, TAB, UDESC};
        moe_table<false>(P, UDESC, TAB, TABF, TABB, LCNT, ROWS, GATES, in.b_down);
        EpiDown E{Yb, TAB, TABF, TABB};
        REP(7) pg8::gemm_phase<EpiDown, pg8::MoeProb<false>, true, true>(lds, P, E);
        SEAM(7);
    }

    if (IN(8)) REP(8) final_phase(X1, Yb, in.final_g, args.out, G, c);

#undef IN
#undef SEAM
}

#ifndef MK_N_LAUNCHES
#define MK_N_LAUNCHES 1
#endif
#ifndef MK_SEQ
#define MK_SEQ "012345678"
#endif
extern "C" void kernel_launch(void* const* d_in, const int* in_sizes, int n_in, void* d_out, int out_size, void* d_ws, size_t ws_size, hipStream_t stream) {
    static int grid = 0;
    if (grid == 0) {
        if (n_in != 15 || out_size != S * D || ws_size < WS_END) { fprintf(stderr, "kernel_launch: unexpected problem (n_in %d out %d ws %zu)\n", n_in, out_size, ws_size); grid = -1; return; }
        int dev = 0, cus = 0, per_cu = 0;
        if (hipGetDevice(&dev) != hipSuccess || hipDeviceGetAttribute(&cus, hipDeviceAttributeMultiprocessorCount, dev) != hipSuccess) { grid = -1; return; }
        if (hipFuncSetAttribute((const void*)fwd, hipFuncAttributeMaxDynamicSharedMemorySize, LDS_BYTES) != hipSuccess) { fprintf(stderr, "kernel_launch: hipFuncSetAttribute failed\n"); grid = -1; return; }
        if (hipOccupancyMaxActiveBlocksPerMultiprocessor(&per_cu, (const void*)fwd, 512, LDS_BYTES) != hipSuccess || per_cu < 1) { fprintf(stderr, "kernel_launch: occupancy query says %d blocks per CU\n", per_cu); (void)hipGetLastError(); per_cu = 1; }
        grid = cus;
    }
    if (grid < 0) return;
    if (hipMemsetAsync((char*)d_ws + WS_CTL, 0, CTL_ZERO_BYTES, stream) != hipSuccess) { fprintf(stderr, "kernel_launch: memset failed\n"); return; }
    Args a{};
    a.in.x = (const float*)d_in[0]; a.in.norm1_g = (const float*)d_in[1]; a.in.w_in = (const float*)d_in[2]; a.in.pool_w = (const float*)d_in[3]; a.in.pool_scale = (const float*)d_in[4];
    a.in.rel_bias = (const float*)d_in[5]; a.in.w_out = (const float*)d_in[6]; a.in.norm2_g = (const float*)d_in[7]; a.in.router_w = (const float*)d_in[8]; a.in.router_b = (const float*)d_in[9];
    a.in.w_gate_up = (const float*)d_in[10]; a.in.b_gate_up = (const float*)d_in[11]; a.in.w_down = (const float*)d_in[12]; a.in.b_down = (const float*)d_in[13]; a.in.final_g = (const float*)d_in[14];
    a.out = (float*)d_out; a.ws = (unsigned char*)d_ws;
    if (MK_N_LAUNCHES == 1) { a.ph_lo = 0; a.ph_hi = NPHASE; hipLaunchKernelGGL(fwd, dim3(grid), dim3(512), LDS_BYTES, stream, a); }
    else { const char* seq = MK_SEQ; for (int i = 0; seq[i]; ++i) { const int p = seq[i] - '0'; a.ph_lo = p; a.ph_hi = p + 1; if (p == 5) (void)hipMemsetAsync((char*)d_ws + WS_CTL + CW_COUNTS * 4, 0, 128, stream); hipLaunchKernelGGL(fwd, dim3(grid), dim3(512), LDS_BYTES, stream, a); } }
    const hipError_t le = hipPeekAtLastError();
    if (le != hipSuccess) fprintf(stderr, "kernel_launch: launch failed: %s\n", hipGetErrorName(le));
}
```

```cpp
#include <hip/hip_runtime.h>
#include <cstdio>
#include <cstdint>

#define LAS __attribute__((address_space(3)))
#define GAS __attribute__((address_space(1)))
typedef unsigned short bf16_t;
typedef short bf16x8 __attribute__((ext_vector_type(8)));
typedef short s16x4 __attribute__((ext_vector_type(4)));
typedef float f32x4 __attribute__((ext_vector_type(4)));
typedef float f32x2 __attribute__((ext_vector_type(2)));
typedef unsigned u32x4 __attribute__((ext_vector_type(4)));
typedef unsigned u32x2 __attribute__((ext_vector_type(2)));
typedef int i32x4 __attribute__((ext_vector_type(4)));
typedef int i32x8 __attribute__((ext_vector_type(8)));

constexpr int S = 16384, D = 1024, NPROJ = 2560, PW = 256, AW = 768, NH = 12, HD = 64, NE = 32, TOPK = 4, DFF = 1024;
constexpr float RMS_EPS = 1e-5f, LOG2E = 1.4426950408889634f, QSCALE = 0.125f * LOG2E, NEGBIG = -1e30f;
constexpr float WSCALE = 64.0f, HSCALE = 16.0f, ASCALE = 8.0f, YSCALE = 64.0f, FP8MAX = 448.0f;
constexpr int BT_N = 400, BT_OFF = 144;

constexpr size_t MiB = 1u << 20;
constexpr size_t WS_CTL = 0, CTL_ZERO_BYTES = 32 * 1024;
constexpr size_t WS_WIN = 2 * MiB;
constexpr size_t WS_WOUT = 8 * MiB;
constexpr size_t WS_GWT = 10 * MiB;
constexpr size_t WS_BT = 10 * MiB + 512 * 1024;
constexpr size_t WS_PWT = 10 * MiB + 768 * 1024;
constexpr size_t WS_RSTD = 11 * MiB;
constexpr size_t WS_GATES = 11 * MiB + 256 * 1024;
constexpr size_t WS_ROWS = 12 * MiB;
constexpr size_t WS_LSE = 14 * MiB;
constexpr size_t WS_WGU = 32 * MiB;
constexpr size_t WS_WD = 160 * MiB;
constexpr size_t WS_H8 = 200 * MiB;
constexpr size_t WS_H = 224 * MiB;
constexpr size_t WS_U = 256 * MiB;
constexpr size_t WS_Q = 264 * MiB, WS_K = 288 * MiB, WS_V = 312 * MiB;
constexpr size_t WS_OP = 336 * MiB;
constexpr size_t WS_MIX = 408 * MiB;
constexpr size_t WS_X1 = 440 * MiB;
constexpr size_t WS_ACT = 512 * MiB;
constexpr size_t WS_Y = 656 * MiB;
constexpr size_t WS_END = 784 * MiB;
constexpr int ACT_ROWS = 65536 + 32 * 256;
constexpr int CW_COUNTS = 64;
constexpr int CW_QUEUE = 256;
constexpr int CW_BAR = 4096;

constexpr int LDS_BYTES = 163840;
constexpr int LDS_TAB = 131072;
constexpr int LDS_CTL = LDS_BYTES - 1024;
constexpr int MAXU = 9;

typedef __bf16 bf16x2_t __attribute__((ext_vector_type(2)));
__device__ __forceinline__ unsigned cvt_pk_bf16(float lo, float hi) { const f32x2 v = {lo, hi}; const bf16x2_t b = __builtin_convertvector(v, bf16x2_t); return __builtin_bit_cast(unsigned, b); }
__device__ __forceinline__ float clamp8(float v) { return __builtin_amdgcn_fmed3f(v, -FP8MAX, FP8MAX); }
__device__ __forceinline__ unsigned cvt4_fp8(float a, float b, float c, float d) {
    int p = __builtin_amdgcn_cvt_pk_fp8_f32(clamp8(a), clamp8(b), 0, false); p = __builtin_amdgcn_cvt_pk_fp8_f32(clamp8(c), clamp8(d), p, true); return (unsigned)p; }
__device__ __forceinline__ float bf_lo(unsigned w) { return __uint_as_float(w << 16); }
__device__ __forceinline__ float bf_hi(unsigned w) { return __uint_as_float(w & 0xffff0000u); }
__device__ __forceinline__ float wave_sum(float v) {
#pragma unroll
    for (int o = 1; o < 64; o <<= 1) v += __shfl_xor(v, o);
    return v;
}
#define LDS_WAIT() asm volatile("s_waitcnt lgkmcnt(0)" ::: "memory")
#define VM_WAIT() asm volatile("s_waitcnt vmcnt(0)" ::: "memory")

#define XB_TMO      128
#define XB_XCNT(j)  (256  + 64 * (j))
#define XB_XSUB(j)  (1280 + 64 * (j))
#define XB_XGEN(j)  (2304 + 64 * (j))
#define XB_TOP      3328
#define XB_TOPGEN   3392
#define XCD_BAR_WORDS 3456
#define XB_SPIN_CAP (1u << 18)
__device__ __forceinline__ unsigned xb_ld(unsigned* p)              { return __hip_atomic_load(p, __ATOMIC_RELAXED, __HIP_MEMORY_SCOPE_AGENT); }
__device__ __forceinline__ unsigned xb_add(unsigned* p, unsigned v) { return __hip_atomic_fetch_add(p, v, __ATOMIC_RELAXED, __HIP_MEMORY_SCOPE_AGENT); }
__device__ __forceinline__ unsigned xb_xcc_id() { return (unsigned)__builtin_amdgcn_s_getreg((3 << 11) | 20) & 0xFu; }
#define XB_SPIN(cond, bar) do { unsigned _sp = 0; while (cond) { __builtin_amdgcn_s_sleep(1); \
    if ((++_sp & 255u) == 0u) { if (xb_ld(&(bar)[XB_TMO])) break; if (_sp > XB_SPIN_CAP) { atomicAdd(&(bar)[XB_TMO], 1u); break; } } } } while (0)
struct XcdBarrier { unsigned* bar; unsigned x; volatile LAS unsigned* st; };
__device__ __forceinline__ XcdBarrier xcd_barrier_post(unsigned* bar, volatile LAS unsigned* st) {
    XcdBarrier b; b.bar = bar; b.x = xb_xcc_id(); b.st = st;
    if (threadIdx.x == 0) (void)xb_add(&bar[XB_XCNT(b.x)], 1u);
    return b;
}
__device__ __forceinline__ void xcd_barrier_complete(unsigned* bar, unsigned x, unsigned& nloc, unsigned& nx) {
    const unsigned G = gridDim.x * gridDim.y * gridDim.z;
    unsigned sum, cnt, mine, sp = 0u;
    for (;;) {
        sum = 0u; cnt = 0u; mine = 0u;
#pragma unroll
        for (unsigned j = 0; j < 16; ++j) { const unsigned c = xb_ld(&bar[XB_XCNT(j)]); sum += c; cnt += (c > 0u) ? 1u : 0u; mine = (j == x) ? c : mine; }
        if (sum == G) break;
        __builtin_amdgcn_s_sleep(1);
        if ((++sp & 255u) == 0u) { if (xb_ld(&bar[XB_TMO])) break; if (sp > XB_SPIN_CAP) { atomicAdd(&bar[XB_TMO], 1u); break; } }
    }
    nloc = mine > 0u ? mine : 1u; nx = cnt > 0u ? cnt : 1u;
}
__device__ __forceinline__ void xcd_barrier(const XcdBarrier& b) {
    asm volatile("s_waitcnt vmcnt(0)" ::: "memory");
    __syncthreads();
    if (threadIdx.x == 0) {
        unsigned* bar = b.bar;
        __builtin_amdgcn_s_waitcnt(0);
        unsigned nloc = b.st[0], nx = b.st[1];
        if (nloc == 0u) { xcd_barrier_complete(bar, b.x, nloc, nx); b.st[0] = nloc; b.st[1] = nx; }
        const unsigned old = xb_add(&bar[XB_XSUB(b.x)], 1u);
        const unsigned gen = old / nloc;
        if (old + 1u == (gen + 1u) * nloc) {
            __builtin_amdgcn_fence(__ATOMIC_RELEASE, "agent");
            asm volatile("s_waitcnt vmcnt(0)" ::: "memory");
            const unsigned og = xb_add(&bar[XB_TOP], 1u);
            const unsigned tg = og / nx;
            if (og + 1u == (tg + 1u) * nx) xb_add(&bar[XB_TOPGEN], 1u);
            else XB_SPIN(xb_ld(&bar[XB_TOPGEN]) == tg, bar);
            __builtin_amdgcn_fence(__ATOMIC_ACQUIRE, "agent");
            xb_add(&bar[XB_XGEN(b.x)], 1u);
            asm volatile("s_waitcnt vmcnt(0)" ::: "memory");
        } else {
            XB_SPIN(xb_ld(&bar[XB_XGEN(b.x)]) == gen, bar);
            __builtin_amdgcn_fence(__ATOMIC_ACQUIRE, "agent");
            asm volatile("s_waitcnt vmcnt(0)" ::: "memory");
        }
    }
    __syncthreads();
}

namespace pg8 {
constexpr int BM = 256, BK = 64, HALF = 128, HTB = HALF * BK * 2, STAGE_BYTES = 8 * HTB, NXCD = 8, WGM = 8;
__host__ __device__ __forceinline__ int lds_byte(int r, int c) { const int st = (r >> 4) * 2 + (c >> 5), rr = r & 15, cc = c & 31, ob = rr * 64 + cc * 2; return st * 1024 + (ob ^ (((ob >> 9) & 1) << 5)); }
__host__ __device__ __forceinline__ void stage_rc(int b, int& R, int& C) { const int st = b / 1024, sb = b % 1024, swz = sb ^ (((sb >> 9) & 1) << 5); R = (st >> 1) * 16 + swz / 64; C = (st & 1) * 32 + (swz % 64) / 2; }
__host__ __device__ __forceinline__ int perm32(int rho) { const int n = rho >> 4, i = rho & 15; return 8 * (i >> 2) + 4 * n + (i & 3); }

struct Unit { int pm, pn, e, slot; };

template <class Epi, class Prob, bool ALIGN_EPI, bool FP8>
__device__ __forceinline__ void gemm_phase(LAS unsigned char* lds, const Prob& P, const Epi& E) {
    const int tid = threadIdx.x, wid = __builtin_amdgcn_readfirstlane(tid >> 6), lane = tid & 63, wr = wid >> 2, wc = wid & 3, fr = lane & 15, fq = lane >> 4;
    const int rowb = P.rowb, nt = rowb / 128;
    int Rs[2], Cs[2]; unsigned voffB[2];
#pragma unroll
    for (int i = 0; i < 2; ++i) { int R, C; stage_rc(tid * 16 + i * 8192, R, C); const int Rb = Epi::PERM ? ((R & ~31) + perm32(R & 31)) : R;
        Rs[i] = R; Cs[i] = C * 2; voffB[i] = (unsigned)(Rb * rowb + C * 2); }
    const size_t kstep = (size_t)(BK * 2);
    const size_t bhalf = P.b_half;
    const unsigned ldsw = (unsigned)wid * 1024u;
    const int aoff = lds_byte(wr * 64 + fr, fq * 8), boff = lds_byte(wc * 32 + fr, fq * 8);
#define PG8_SA(b, h) (((b) * 2 + (h)) * HTB)
#define PG8_SB(b, h) ((4 + (b) * 2 + (h)) * HTB)
#define PG8_STAGE_B(bufoff, gbase) do { _Pragma("unroll") for (int _i = 0; _i < 2; ++_i) \
        __builtin_amdgcn_global_load_lds((const unsigned*)((const char*)(gbase) + voffB[_i]), (LAS unsigned*)(lds + (bufoff) + ldsw + _i * 8192), 16, 0, 0); } while (0)
#define PG8_STAGE_A(bufoff, kb, o0, o1) do { \
        __builtin_amdgcn_global_load_lds((const unsigned*)(P.A + (size_t)(o0) + (kb)), (LAS unsigned*)(lds + (bufoff) + ldsw), 16, 0, 0); \
        __builtin_amdgcn_global_load_lds((const unsigned*)(P.A + (size_t)(o1) + (kb)), (LAS unsigned*)(lds + (bufoff) + ldsw + 8192), 16, 0, 0); } while (0)
#define PG8_LDA(dst, b, h) do { _Pragma("unroll") for (int m = 0; m < 4; ++m) _Pragma("unroll") for (int k = 0; k < 2; ++k) dst[m][k] = *(const LAS bf16x8*)(lds + PG8_SA(b, h) + aoff + m * 2048 + k * 1024); } while (0)
#define PG8_LDB(dst, b, h) do { _Pragma("unroll") for (int n = 0; n < 2; ++n) _Pragma("unroll") for (int k = 0; k < 2; ++k) dst[n][k] = *(const LAS bf16x8*)(lds + PG8_SB(b, h) + boff + n * 2048 + k * 1024); } while (0)
#define PG8_MMA(ai, bj, At, Bt) do { __builtin_amdgcn_s_setprio(1); _Pragma("unroll") for (int m = 0; m < 4; ++m) _Pragma("unroll") for (int n = 0; n < 2; ++n) { \
        if constexpr (FP8) { const i32x8 fb_ = __builtin_shufflevector(__builtin_bit_cast(i32x4, Bt[n][0]), __builtin_bit_cast(i32x4, Bt[n][1]), 0, 1, 2, 3, 4, 5, 6, 7); \
            const i32x8 fa_ = __builtin_shufflevector(__builtin_bit_cast(i32x4, At[m][0]), __builtin_bit_cast(i32x4, At[m][1]), 0, 1, 2, 3, 4, 5, 6, 7); \
            acc[ai][bj][m][n] = __builtin_amdgcn_mfma_scale_f32_16x16x128_f8f6f4(fb_, fa_, acc[ai][bj][m][n], 0, 0, 0, 0, 0, 0); } \
        else { _Pragma("unroll") for (int k = 0; k < 2; ++k) acc[ai][bj][m][n] = __builtin_amdgcn_mfma_f32_16x16x32_bf16(Bt[n][k], At[m][k], acc[ai][bj][m][n], 0, 0, 0); } } \
        __builtin_amdgcn_s_setprio(0); } while (0)
#define PG8_WAIT_V(n) asm volatile("s_waitcnt vmcnt(" #n ")" ::: "memory")
#define PG8_WAIT_L(n) asm volatile("s_waitcnt lgkmcnt(" #n ")" ::: "memory")
#define PG8_BAR __builtin_amdgcn_s_barrier()
#define PG8_SCHED __builtin_amdgcn_sched_barrier(0)
    Unit cur, nxt; int ui = 0;
    if (!P.next(0, cur)) return;
    f32x4 acc[2][2][4][2];
    E.init(acc, cur, wr, wc, fr, fq);
    bf16x8 At[4][2], B0[2][2], B1[2][2];
    unsigned c00 = P.a_off(cur, Rs[0], Cs[0]), c01 = P.a_off(cur, Rs[1], Cs[1]), c10 = P.a_off(cur, HALF + Rs[0], Cs[0]), c11 = P.a_off(cur, HALF + Rs[1], Cs[1]);
    const char* cB = P.b_base(cur);
    PG8_STAGE_B(PG8_SB(0, 0), cB); PG8_STAGE_B(PG8_SB(0, 1), cB + bhalf); PG8_STAGE_A(PG8_SA(0, 0), 0, c00, c01); PG8_STAGE_A(PG8_SA(0, 1), 0, c10, c11);
    if (wr == 1) PG8_BAR;
    PG8_WAIT_V(2); PG8_BAR;
    PG8_STAGE_B(PG8_SB(1, 0), cB + kstep); PG8_STAGE_A(PG8_SA(1, 0), kstep, c00, c01); PG8_STAGE_B(PG8_SB(1, 1), cB + bhalf + kstep);
    PG8_WAIT_V(6); PG8_BAR;
    for (;;) {
        const bool has_next = P.next(ui + 1, nxt);
        const char* nB = has_next ? P.b_base(nxt) : cB;
        for (int t = 0; t < nt; t += 2) {
            const bool last = (t == nt - 2);
            const size_t k1 = (size_t)(t + 1) * kstep;
            const size_t k2 = last ? 0 : (size_t)(t + 2) * kstep, k3 = k2 + kstep;
            const char* b2 = last ? nB : cB + (size_t)(t + 2) * kstep; const char* b3 = b2 + kstep;
            if (last && has_next) { c00 = P.a_off(nxt, Rs[0], Cs[0]); c01 = P.a_off(nxt, Rs[1], Cs[1]); }
            PG8_LDB(B0, 0, 0); PG8_LDB(B1, 0, 1); PG8_SCHED; PG8_LDA(At, 0, 0); PG8_STAGE_A(PG8_SA(1, 1), k1, c10, c11);
            PG8_WAIT_V(8); PG8_WAIT_L(0); PG8_BAR; PG8_MMA(0, 0, At, B0); PG8_MMA(0, 1, At, B1); PG8_BAR; PG8_SCHED;
            if (last && has_next) { c10 = P.a_off(nxt, HALF + Rs[0], Cs[0]); c11 = P.a_off(nxt, HALF + Rs[1], Cs[1]); }
            PG8_LDA(At, 0, 1); PG8_STAGE_B(PG8_SB(0, 0), b2); PG8_STAGE_B(PG8_SB(0, 1), b2 + bhalf); PG8_STAGE_A(PG8_SA(0, 0), k2, c00, c01);
            PG8_WAIT_V(8); PG8_WAIT_L(0); PG8_BAR; PG8_MMA(1, 0, At, B0); PG8_MMA(1, 1, At, B1); PG8_BAR; PG8_SCHED;
            PG8_LDB(B0, 1, 0); PG8_LDB(B1, 1, 1); PG8_SCHED; PG8_LDA(At, 1, 0); PG8_STAGE_A(PG8_SA(0, 1), k2, c10, c11);
            PG8_WAIT_V(8); PG8_WAIT_L(0); PG8_BAR; PG8_MMA(0, 0, At, B0); PG8_MMA(0, 1, At, B1); PG8_BAR; PG8_SCHED;
            PG8_LDA(At, 1, 1); PG8_STAGE_B(PG8_SB(1, 0), b3); PG8_STAGE_B(PG8_SB(1, 1), b3 + bhalf); PG8_STAGE_A(PG8_SA(1, 0), k3, c00, c01);
            PG8_WAIT_V(8); PG8_WAIT_L(0); PG8_BAR; PG8_MMA(1, 0, At, B0); PG8_MMA(1, 1, At, B1); PG8_BAR; PG8_SCHED;
        }
        if constexpr (ALIGN_EPI) { if (wr == 0) PG8_BAR; }
        E(acc, cur, wr, wc, fr, fq);
#if defined(MK_DOUBLE)
        if constexpr (FP8) { if ((MK_DOUBLE >> 12) & 1) { asm volatile("" ::: "memory"); E(acc, cur, wr, wc, fr, fq); } }
#endif
        if (!has_next) break;
        cur = nxt; cB = nB; ++ui;
        E.init(acc, cur, wr, wc, fr, fq);
        if constexpr (ALIGN_EPI) { if (wr == 1) PG8_BAR; }
    }
    PG8_WAIT_V(0);
    if constexpr (!ALIGN_EPI) { if (wr == 0) PG8_BAR; }
    PG8_BAR;
#undef PG8_SA
#undef PG8_SB
#undef PG8_STAGE_A
#undef PG8_STAGE_B
#undef PG8_LDA
#undef PG8_LDB
#undef PG8_MMA
#undef PG8_WAIT_V
#undef PG8_WAIT_L
#undef PG8_BAR
#undef PG8_SCHED
}

__device__ __forceinline__ bool static_order(int nM, int nN, int G, int c, int i, int& pm, int& pn) {
    const int nwg = nM * nN; const long L = (long)i * G + c; if (L >= nwg) return false;
    int wgid = (int)L; { const int q = nwg / NXCD, r = nwg % NXCD, xcd = wgid % NXCD, off = wgid / NXCD; wgid = (xcd < r ? xcd * (q + 1) : r * (q + 1) + (xcd - r) * q) + off; }
    const int nig = WGM * nN, gid = wgid / nig, fm = gid * WGM, gsz = (nM - fm) < WGM ? (nM - fm) : WGM;
    pm = fm + ((wgid % nig) % gsz); pn = (wgid % nig) / gsz; return true;
}
struct DenseProb {
    const char* A; const char* Bt; int rowb, nM, nN, G, c; size_t b_half;
    __device__ __forceinline__ bool next(int i, Unit& u) const { u.e = 0; u.slot = i; return static_order(nM, nN, G, c, i, u.pm, u.pn); }
    __device__ __forceinline__ unsigned a_off(const Unit& u, int row, int colb) const { return (unsigned)((u.pm * BM + row) * rowb + colb); }
    __device__ __forceinline__ const char* b_base(const Unit& u) const { return Bt + (size_t)u.pn * BM * rowb; }
};
template <bool GATHER> struct MoeProb {
    const char* A; const char* Bt; int rowb, nN, G, c; size_t b_half; size_t b_expert; int b_tile_rows;
    const LAS int* tpre; const LAS int* tab; const LAS int* udesc;
    __device__ __forceinline__ int tp(int j) const { return __builtin_amdgcn_readfirstlane(tpre[j]); }
    __device__ __forceinline__ bool search(int i, Unit& u) const {
        const int total = tpre[NE] * nN; const long L0 = (long)i * G + c; if (L0 >= total) return false;
        int L = (int)L0; { const int q = total / NXCD, r = total % NXCD, xcd = L % NXCD, off = L / NXCD; L = (xcd < r ? xcd * (q + 1) : r * (q + 1) + (xcd - r) * q) + off; }
        int e = 0;
        for (int j = 1; j < NE; ++j) e += (tpre[j] * nN <= L) ? 1 : 0;
        const int first = tpre[e] * nN, tiles = tpre[e + 1] - tpre[e], rem = L - first;
        u.e = e; u.pm = rem % tiles; u.pn = rem / tiles; u.slot = i; return true;
    }
    __device__ __forceinline__ bool next(int i, Unit& u) const {
        if (i >= MAXU) return false;
        const int v = __builtin_amdgcn_readfirstlane(udesc[4 * i + 3]); if (!v) return false;
        u.e = __builtin_amdgcn_readfirstlane(udesc[4 * i]); u.pm = __builtin_amdgcn_readfirstlane(udesc[4 * i + 1]); u.pn = __builtin_amdgcn_readfirstlane(udesc[4 * i + 2]); u.slot = i; return true;
    }
    __device__ __forceinline__ unsigned a_off(const Unit& u, int row, int colb) const {
        if (GATHER) { const int idx = tab[u.slot * 256 + row]; const int tok = idx < 0 ? 0 : (idx >> 2); return (unsigned)(tok * rowb + colb); }
        return (unsigned)(((tp(u.e) + u.pm) * BM + row) * rowb + colb);
    }
    __device__ __forceinline__ const char* b_base(const Unit& u) const { return Bt + (size_t)u.e * b_expert + (size_t)u.pn * b_tile_rows * rowb; }
};
}

using pg8::Unit;
typedef f32x4 AccT[2][2][4][2];
__device__ __forceinline__ void acc_zero(AccT& acc) {
#pragma unroll
    for (int a = 0; a < 2; ++a)
#pragma unroll
        for (int b = 0; b < 2; ++b)
#pragma unroll
            for (int m = 0; m < 4; ++m)
#pragma unroll
                for (int n = 0; n < 2; ++n) acc[a][b][m][n] = (f32x4){0.f, 0.f, 0.f, 0.f};
}

struct EpiQKVU {
    static constexpr bool PERM = true;
    unsigned char* ws;
    __device__ __forceinline__ void init(AccT& acc, const Unit&, int, int, int, int) const { acc_zero(acc); }
    __device__ __forceinline__ void operator()(const AccT& acc, const Unit& u, int wr, int wc, int fr, int fq) const {
        static_assert(WS_K - WS_Q == WS_V - WS_K, "Q, K, V equally spaced");
        const int t = (u.pn - 1) / 3;
        const size_t boff = (u.pn == 0) ? WS_U : (WS_Q + (size_t)t * (WS_K - WS_Q));
        bf16_t* base = (bf16_t*)(ws + boff);
        const int ldc = (u.pn == 0) ? PW : AW, colt = (u.pn == 0) ? 0 : ((u.pn - 1) % 3) * 256;
        const float sc = (u.pn >= 1 && u.pn <= 3) ? QSCALE : 1.f;
        const int row0 = u.pm * 256 + wr * 64 + fr, col0 = colt + wc * 32 + 8 * fq;
#pragma unroll
        for (int ai = 0; ai < 2; ++ai)
#pragma unroll
            for (int m = 0; m < 4; ++m) { bf16_t* rowp = base + (size_t)(row0 + ai * 128 + m * 16) * ldc + col0;
#pragma unroll
                for (int bj = 0; bj < 2; ++bj) { const f32x4 v0 = acc[ai][bj][m][0] * sc, v1 = acc[ai][bj][m][1] * sc;
                    u32x4 w; w.x = cvt_pk_bf16(v0[0], v0[1]); w.y = cvt_pk_bf16(v0[2], v0[3]); w.z = cvt_pk_bf16(v1[0], v1[1]); w.w = cvt_pk_bf16(v1[2], v1[3]);
                    *(u32x4*)(rowp + bj * 128) = w; } }
    }
};
struct EpiResF32 {
    static constexpr bool PERM = false;
    const float* X; float* O;
    __device__ __forceinline__ void init(AccT& acc, const Unit& u, int wr, int wc, int fr, int fq) const {
        const int row0 = u.pm * 256 + wr * 64 + fr, col0 = u.pn * 256 + wc * 32 + 4 * fq;
#pragma unroll
        for (int ai = 0; ai < 2; ++ai)
#pragma unroll
            for (int m = 0; m < 4; ++m) { const size_t off = (size_t)(row0 + ai * 128 + m * 16) * D + col0;
#pragma unroll
                for (int bj = 0; bj < 2; ++bj)
#pragma unroll
                    for (int n = 0; n < 2; ++n) acc[ai][bj][m][n] = __builtin_nontemporal_load((const f32x4*)(X + off + bj * 128 + n * 16)); }
    }
    __device__ __forceinline__ void operator()(const AccT& acc, const Unit& u, int wr, int wc, int fr, int fq) const {
        const int row0 = u.pm * 256 + wr * 64 + fr, col0 = u.pn * 256 + wc * 32 + 4 * fq;
#pragma unroll
        for (int ai = 0; ai < 2; ++ai)
#pragma unroll
            for (int m = 0; m < 4; ++m) { const size_t off = (size_t)(row0 + ai * 128 + m * 16) * D + col0;
#pragma unroll
                for (int bj = 0; bj < 2; ++bj)
#pragma unroll
                    for (int n = 0; n < 2; ++n) *(f32x4*)(O + off + bj * 128 + n * 16) = acc[ai][bj][m][n]; }
    }
};
__device__ __forceinline__ float swiglu1(float g, float u) {
    g = fminf(g, 7.0f); u = fminf(fmaxf(u, -7.0f), 7.0f);
    const float s = __builtin_amdgcn_rcpf(1.0f + __builtin_amdgcn_exp2f(g * (-1.702f * LOG2E)));
    return (u + 1.0f) * (g * s);
}
__device__ __forceinline__ f32x4 swiglu4(f32x4 g, f32x4 u) {
    g = __builtin_elementwise_min(g, (f32x4){7.0f, 7.0f, 7.0f, 7.0f});
    u = __builtin_elementwise_min(__builtin_elementwise_max(u, (f32x4){-7.0f, -7.0f, -7.0f, -7.0f}), (f32x4){7.0f, 7.0f, 7.0f, 7.0f});
    const f32x4 t = g * (-1.702f * LOG2E);
    f32x4 e; e[0] = __builtin_amdgcn_exp2f(t[0]); e[1] = __builtin_amdgcn_exp2f(t[1]); e[2] = __builtin_amdgcn_exp2f(t[2]); e[3] = __builtin_amdgcn_exp2f(t[3]);
    const f32x4 d = e + 1.0f;
    f32x4 r; r[0] = __builtin_amdgcn_rcpf(d[0]); r[1] = __builtin_amdgcn_rcpf(d[1]); r[2] = __builtin_amdgcn_rcpf(d[2]); r[3] = __builtin_amdgcn_rcpf(d[3]);
    return (u * ASCALE + ASCALE) * (g * r);
}
__device__ __forceinline__ unsigned cvt4_fp8_nc(const f32x4& v) {
    int p = __builtin_amdgcn_cvt_pk_fp8_f32(v[0], v[1], 0, false); p = __builtin_amdgcn_cvt_pk_fp8_f32(v[2], v[3], p, true); return (unsigned)p; }
struct EpiGateUp {
    static constexpr bool PERM = true;
    __device__ __forceinline__ void init(AccT& acc, const Unit&, int, int, int, int) const { acc_zero(acc); }
    unsigned char* ACT; const LAS int* tpre; const LAS float* tabf; const LAS float* tabb;
    __device__ __forceinline__ void operator()(const AccT& acc, const Unit& u, int wr, int wc, int fr, int fq) const {
        const int cl = wc * 32 + 8 * fq, colA = u.pn * 128 + cl;
        const LAS float* bp = tabb + u.slot * 256 + cl;
        const f32x4 bg0 = *(const LAS f32x4*)(bp), bg1 = *(const LAS f32x4*)(bp + 4), bu0 = *(const LAS f32x4*)(bp + 128), bu1 = *(const LAS f32x4*)(bp + 132);
        const int srow0 = (__builtin_amdgcn_readfirstlane(tpre[u.e]) + u.pm) * 256;
#pragma unroll
        for (int ai = 0; ai < 2; ++ai)
#pragma unroll
            for (int m = 0; m < 4; ++m) { const int r = ai * 128 + wr * 64 + m * 16 + fr; const float rs = tabf[u.slot * 256 + r];
                const f32x4 g0 = acc[ai][0][m][0] * rs + bg0, g1 = acc[ai][0][m][1] * rs + bg1, u0 = acc[ai][1][m][0] * rs + bu0, u1 = acc[ai][1][m][1] * rs + bu1;
                u32x2 w; w.x = cvt4_fp8_nc(swiglu4(g0, u0)); w.y = cvt4_fp8_nc(swiglu4(g1, u1));
                *(u32x2*)(ACT + (size_t)(srow0 + r) * DFF + colA) = w; }
    }
};
struct EpiDown {
    static constexpr bool PERM = true;
    __device__ __forceinline__ void init(AccT& acc, const Unit&, int, int, int, int) const { acc_zero(acc); }
    unsigned char* Y; const LAS int* tab; const LAS float* tabf; const LAS float* tabb;
    __device__ __forceinline__ void operator()(const AccT& acc, const Unit& u, int wr, int wc, int fr, int fq) const {
        const int cl = wc * 32 + 8 * fq, col0 = u.pn * 256 + cl;
        const LAS float* bp = tabb + u.slot * 256 + cl;
        f32x4 bv[2][2];
#pragma unroll
        for (int bj = 0; bj < 2; ++bj) { bv[bj][0] = *(const LAS f32x4*)(bp + bj * 128); bv[bj][1] = *(const LAS f32x4*)(bp + bj * 128 + 4); }
#pragma unroll
        for (int ai = 0; ai < 2; ++ai)
#pragma unroll
            for (int m = 0; m < 4; ++m) { const int r = ai * 128 + wr * 64 + m * 16 + fr; const int idx = tab[u.slot * 256 + r];
                if (idx >= 0) { const float gv = tabf[u.slot * 256 + r] * YSCALE; unsigned char* rowp = Y + (size_t)idx * D + col0;
#pragma unroll
                    for (int bj = 0; bj < 2; ++bj) { const f32x4 v0 = (acc[ai][bj][m][0] * (1.0f / (ASCALE * WSCALE)) + bv[bj][0]) * gv, v1 = (acc[ai][bj][m][1] * (1.0f / (ASCALE * WSCALE)) + bv[bj][1]) * gv;
                        u32x2 w; w.x = cvt4_fp8(v0[0], v0[1], v0[2], v0[3]); w.y = cvt4_fp8(v1[0], v1[1], v1[2], v1[3]);
                        *(u32x2*)(rowp + bj * 128) = w; } } }
    }
};

__device__ __forceinline__ void tr_item(const float* __restrict__ W, int K, int N, bf16_t* __restrict__ WT, LAS float* scr, int kb, int nb, int lane) {
    const int k0 = kb * 64, n0 = nb * 64;
    const float* src = W + (size_t)(k0 + (lane >> 4)) * N + n0 + (lane & 15) * 4;
    f32x4 v[16];
#pragma unroll
    for (int i = 0; i < 16; ++i) v[i] = *(const f32x4*)(src + (size_t)(4 * i) * N);
#pragma unroll
    for (int i = 0; i < 16; ++i) { LAS float* d = scr + (4 * i + (lane >> 4)) * 65 + (lane & 15) * 4; d[0] = v[i][0]; d[1] = v[i][1]; d[2] = v[i][2]; d[3] = v[i][3]; }
    LDS_WAIT();
    const int c = lane & 7;
#pragma unroll
    for (int j = 0; j < 8; ++j) { const int n = 8 * j + (lane >> 3); const LAS float* s = scr + (8 * c) * 65 + n;
        u32x4 o; o.x = cvt_pk_bf16(s[0], s[65]); o.y = cvt_pk_bf16(s[130], s[195]); o.z = cvt_pk_bf16(s[260], s[325]); o.w = cvt_pk_bf16(s[390], s[455]);
        *(u32x4*)(WT + (size_t)(n0 + n) * K + k0 + 8 * c) = o; }
    LDS_WAIT();
}
struct Item8 { const float* src; unsigned char* dst; int N; };
__device__ __forceinline__ void chunk8_load(const Item8& d, int ch, f32x4 (&v)[16], int lane) {
    const float* base = d.src + (size_t)(32 * ch + 4 * (lane >> 5)) * d.N + (lane & 31) * 4;
#pragma unroll
    for (int sl = 0; sl < 4; ++sl)
#pragma unroll
        for (int j = 0; j < 4; ++j) v[4 * sl + j] = __builtin_nontemporal_load((const f32x4*)(base + (size_t)(8 * sl + j) * d.N));
}
__device__ __forceinline__ void chunk8_cvt(int ch, const f32x4 (&v)[16], LAS unsigned* scr, int lane) {
    const int nq = lane & 31, kq0 = lane >> 5, sw = (nq & 7) << 2;
#pragma unroll
    for (int sl = 0; sl < 4; ++sl) { const int kw = 8 * ch + kq0 + 2 * sl;
#pragma unroll
        for (int i = 0; i < 4; ++i) scr[(4 * nq + i) * 32 + (kw ^ sw)] = cvt4_fp8(v[4 * sl][i] * WSCALE, v[4 * sl + 1][i] * WSCALE, v[4 * sl + 2][i] * WSCALE, v[4 * sl + 3][i] * WSCALE); }
}
__device__ __forceinline__ void item8_flush(const Item8& d, const LAS unsigned* scr, int lane) {
    LDS_WAIT();
    const int c16 = lane & 7;
#pragma unroll
    for (int jj = 0; jj < 16; ++jj) { const int n = (lane >> 3) + 8 * jj;
        const u32x4 o = *(const LAS u32x4*)(scr + n * 32 + ((c16 ^ ((n >> 2) & 7)) << 2));
        __builtin_nontemporal_store(o, (u32x4*)(d.dst + (size_t)n * D + 16 * c16)); }
    LDS_WAIT();
}
__device__ __forceinline__ int t5_bucket(int dist) {
    if (dist < 16) return dist;
    const int large = 16 + (int)(logf((float)dist / 16.0f) / 4.852030263919617f * 16.0f);
    return large < 31 ? large : 31;
}
struct In { const float *x, *norm1_g, *w_in, *pool_w, *pool_scale, *rel_bias, *w_out, *norm2_g, *router_w, *router_b, *w_gate_up, *b_gate_up, *w_down, *b_down, *final_g; };

constexpr int N8_ALL = NE * 128 + NE * 64;
__device__ __forceinline__ void convert8_queue(LAS unsigned char* lds, const In& in, unsigned char* ws, unsigned* qword) {
    const int lane = threadIdx.x & 63, wave = __builtin_amdgcn_readfirstlane((int)threadIdx.x >> 6);
    constexpr int IG = 8 * 16, ID = 8 * 8;
    auto desc = [&](int r) -> Item8 { Item8 d;
        if (r < NE * IG) { const int e = r / IG, q = r % IG, kb = q / 16, nb = q % 16;
            d.src = in.w_gate_up + (size_t)e * D * 2 * DFF + (size_t)(kb * 128) * (2 * DFF) + nb * 128; d.N = 2 * DFF; d.dst = ws + WS_WGU + (size_t)e * 2 * DFF * D + (size_t)(nb * 128) * D + kb * 128; }
        else { const int r2 = r - NE * IG, e = r2 / ID, q = r2 % ID, kb = q / 8, nb = q % 8;
            d.src = in.w_down + (size_t)e * DFF * D + (size_t)(kb * 128) * D + nb * 128; d.N = D; d.dst = ws + WS_WD + (size_t)e * D * DFF + (size_t)(nb * 128) * DFF + kb * 128; }
        return d; };
    auto claim = [&]() -> int { unsigned v = 0; if (lane == 0) v = __hip_atomic_fetch_add(qword, 1u, __ATOMIC_RELAXED, __HIP_MEMORY_SCOPE_AGENT); return __builtin_amdgcn_readfirstlane((int)v); };
    LAS unsigned* scr8 = (LAS unsigned*)(lds + wave * 16384);
    f32x4 va[16], vb[16];
    int it = claim();
    if (it < N8_ALL) { const Item8 d0 = desc(it); chunk8_load(d0, 0, va, lane); }
    while (it < N8_ALL) {
        const Item8 d = desc(it);
        const int nx = claim();
        chunk8_load(d, 1, vb, lane); chunk8_cvt(0, va, scr8, lane);
        chunk8_load(d, 2, va, lane); chunk8_cvt(1, vb, scr8, lane);
        chunk8_load(d, 3, vb, lane); chunk8_cvt(2, va, scr8, lane);
        if (nx < N8_ALL) { const Item8 dn = desc(nx); chunk8_load(dn, 0, va, lane); }
        chunk8_cvt(3, vb, scr8, lane);
        item8_flush(d, scr8, lane);
        it = nx;
    }
}
__device__ __forceinline__ void p0_prologue(LAS unsigned char* lds, const In& in, unsigned char* ws, int G, int c) {
    const int tid = threadIdx.x, lane = tid & 63, wave = __builtin_amdgcn_readfirstlane(tid >> 6);
    const int gw = c * 8 + wave, NGW = G * 8;
    LAS float* scr = (LAS float*)(lds + wave * 16640);
    constexpr int I_IN = 16 * 40, I_OUT = 16 * 16, I_GU1 = 16 * 32, I_D1 = 16 * 16;
    for (int it = gw; it < I_IN; it += NGW) tr_item(in.w_in, D, NPROJ, (bf16_t*)(ws + WS_WIN), scr, it / 40, it % 40, lane);
#ifndef MK_DOUBLE
#define MK_DOUBLE 0
#endif
    for (int repr_ = 0; repr_ < (((MK_DOUBLE >> 11) & 1) ? 2 : 1); ++repr_) {
        f32x4 gv[4];
#pragma unroll
        for (int j = 0; j < 4; ++j) gv[j] = *(const f32x4*)(in.norm1_g + 4 * lane + 256 * j);
        bf16_t* H = (bf16_t*)(ws + WS_H);
        f32x4 v[4], vn[4];
        int m = gw;
        if (m < S) {
#pragma unroll
            for (int j = 0; j < 4; ++j) v[j] = __builtin_nontemporal_load((const f32x4*)(in.x + (size_t)m * D + 4 * lane + 256 * j)); }
        for (; m < S; m += NGW) {
            const int mn = m + NGW;
            if (mn < S) {
#pragma unroll
                for (int j = 0; j < 4; ++j) vn[j] = __builtin_nontemporal_load((const f32x4*)(in.x + (size_t)mn * D + 4 * lane + 256 * j)); }
            float s = 0.f;
#pragma unroll
            for (int j = 0; j < 4; ++j) s += (v[j][0] * v[j][0] + v[j][1] * v[j][1]) + (v[j][2] * v[j][2] + v[j][3] * v[j][3]);
            const float rstd = rsqrtf(wave_sum(s) * (1.0f / D) + RMS_EPS);
#pragma unroll
            for (int j = 0; j < 4; ++j) { const f32x4 o = v[j] * rstd * gv[j]; u32x2 w; w.x = cvt_pk_bf16(o[0], o[1]); w.y = cvt_pk_bf16(o[2], o[3]); *(u32x2*)(H + (size_t)m * D + 4 * lane + 256 * j) = w; }
#pragma unroll
            for (int j = 0; j < 4; ++j) v[j] = vn[j];
        }
    }
}
__device__ __forceinline__ void p0_side(LAS unsigned char* lds, const In& in, unsigned char* ws, int n0, int c0) {
    const int tid = threadIdx.x, lane = tid & 63, wave = __builtin_amdgcn_readfirstlane(tid >> 6);
    LAS float* scr = (LAS float*)(lds + wave * 16640);
    for (int it = c0 * 8 + wave; it < 16 * 16; it += n0 * 8) tr_item(in.w_out, D, D, (bf16_t*)(ws + WS_WOUT), scr, it / 16, it % 16, lane);
    const int gt = c0 * 512 + tid, NGT = n0 * 512;
    { float* GWT = (float*)(ws + WS_GWT); for (int i = gt; i < NE * D; i += NGT) { const int e = i >> 10, k = i & 1023; GWT[i] = in.norm2_g[k] * in.router_w[k * NE + e]; } }
    { float* BT = (float*)(ws + WS_BT); for (int i = gt; i < 36 * BT_N; i += NGT) { const int bh = i / BT_N, j = i % BT_N, b = bh / NH, h = bh % NH, dil = (b == 0) ? 1 : (b == 1 ? 4 : 16), d = j - BT_OFF;
        BT[i] = (d >= 0 && d <= 128) ? in.rel_bias[t5_bucket(d * dil) * NH + h] * LOG2E : NEGBIG; } }
    { bf16_t* PWT = (bf16_t*)(ws + WS_PWT); for (int i = gt; i < 4 * 64 * 64; i += NGT) { const int g = i >> 12, d = (i >> 6) & 63, cc = i & 63; PWT[i] = (bf16_t)(cvt_pk_bf16(in.pool_w[g * 4096 + cc * 64 + d], 0.f) & 0xffffu); } }
}

__device__ __forceinline__ s16x4 lds_tr16(const LAS unsigned char* p) { typedef short v4i16_t __attribute__((ext_vector_type(4))); return __builtin_bit_cast(s16x4, __builtin_amdgcn_ds_read_tr16_b64_v4i16((LAS v4i16_t*)p)); }
constexpr int ATT_UNITS = 3 * NH * 64, KV_PITCH = 144, KV_ROWS = 384, ATT_VOFF = KV_ROWS * KV_PITCH, ATT_TOFF = 2 * KV_ROWS * KV_PITCH, ATT_NEGOFF = ATT_TOFF + BT_N * 4;
__device__ __forceinline__ void attn_decode(int uid, int& b, int& h, int& r, int& j, int& dil) {
    const int bh = uid >> 6, x = uid & 63; b = bh / NH; h = bh % NH; dil = (b == 0) ? 1 : (b == 1 ? 4 : 16);
    const int nb = 64 / dil; r = x / nb; j = x % nb;
}
__device__ __forceinline__ void attn_phase(LAS unsigned char* lds, const bf16_t* __restrict__ Qg, const bf16_t* __restrict__ Kg, const bf16_t* __restrict__ Vg, const float* __restrict__ BT,
                                           bf16_t* __restrict__ OP, float* __restrict__ LSE, int G, int c) {
    const int tid = threadIdx.x, lane = tid & 63, w = __builtin_amdgcn_readfirstlane(tid >> 6), ql = lane & 15, g = lane >> 4;
    LAS unsigned char* Ks = lds; LAS unsigned char* Vs = lds + ATT_VOFF; LAS float* Tb = (LAS float*)(lds + ATT_TOFF); LAS float* Tneg = (LAS float*)(lds + ATT_NEGOFF);
    if (tid < 16) Tneg[tid] = NEGBIG;
    u32x4 kpre[6], vpre[6]; bf16x8 qa0, qa1, qb0, qb1; float tpre = 0.f;
#define ATT_PREFETCH(uid_) do { int b_, h_, r_, j_, dil_; attn_decode((uid_), b_, h_, r_, j_, dil_); \
        _Pragma("unroll") for (int cc = 0; cc < 6; ++cc) { const int id = tid + 512 * cc, row = id >> 3, ch = id & 7; int mm = 256 * j_ - 128 + row; if (mm < 0) mm += 128; \
            const size_t off = (size_t)(r_ + dil_ * mm) * AW + h_ * HD + ch * 8; kpre[cc] = *(const u32x4*)(Kg + off); vpre[cc] = *(const u32x4*)(Vg + off); } \
        { const size_t qo = (size_t)(r_ + dil_ * (256 * j_ + 32 * w + ql)) * AW + h_ * HD + 8 * g; const size_t qs = (size_t)16 * dil_ * AW; \
          qa0 = *(const bf16x8*)(Qg + qo); qa1 = *(const bf16x8*)(Qg + qo + 32); qb0 = *(const bf16x8*)(Qg + qo + qs); qb1 = *(const bf16x8*)(Qg + qo + qs + 32); } \
        if (tid < BT_N) tpre = BT[(b_ * NH + h_) * BT_N + tid]; } while (0)
#ifndef ATT_SYNC_LOAD
    if (c < ATT_UNITS) ATT_PREFETCH(c);
#endif
    for (int uid = c; uid < ATT_UNITS; uid += G) {
        int b, h, r, j, dil; attn_decode(uid, b, h, r, j, dil);
#ifdef ATT_SYNC_LOAD
        ATT_PREFETCH(uid);
#endif
#pragma unroll
        for (int cc = 0; cc < 6; ++cc) { const int id = tid + 512 * cc, row = id >> 3, ch = id & 7; *(LAS u32x4*)(Ks + row * KV_PITCH + ch * 16) = kpre[cc]; *(LAS u32x4*)(Vs + row * KV_PITCH + ch * 16) = vpre[cc]; }
        if (tid < BT_N) Tb[tid] = tpre;
        const bf16x8 fa0 = qa0, fa1 = qa1, fb0 = qb0, fb1 = qb1;
        __syncthreads();
#ifndef ATT_SYNC_LOAD
        if (uid + G < ATT_UNITS) ATT_PREFETCH(uid + G);
#endif
        const int kkmin = (j == 0) ? 128 : 0;
        const LAS unsigned char* kb = Ks + (32 * w + ql) * KV_PITCH + g * 16;
        const LAS float* Tq = Tb + (ql + 272 - 4 * g - 3);
        const f32x4 zero4 = (f32x4){0.f, 0.f, 0.f, 0.f};
        f32x4 sA[9], sB[9];
#pragma unroll
        for (int i = 0; i < 10; ++i) {
            const bf16x8 kf0 = *(const LAS bf16x8*)(kb + i * (16 * KV_PITCH)), kf1 = *(const LAS bf16x8*)(kb + i * (16 * KV_PITCH) + 64);
            const bool msk = (32 * w + 16 * i) < kkmin;
            if (i <= 8) { f32x4 st = __builtin_amdgcn_mfma_f32_16x16x32_bf16(kf0, fa0, zero4, 0, 0, 0); st = __builtin_amdgcn_mfma_f32_16x16x32_bf16(kf1, fa1, st, 0, 0, 0);
                const LAS float* tp = msk ? Tneg : (Tq - 16 * i); sA[i] = (f32x4){st[0] + tp[3], st[1] + tp[2], st[2] + tp[1], st[3] + tp[0]}; }
            if (i >= 1) { f32x4 st = __builtin_amdgcn_mfma_f32_16x16x32_bf16(kf0, fb0, zero4, 0, 0, 0); st = __builtin_amdgcn_mfma_f32_16x16x32_bf16(kf1, fb1, st, 0, 0, 0);
                const LAS float* tp = msk ? Tneg : (Tq - 16 * (i - 1)); sB[i - 1] = (f32x4){st[0] + tp[3], st[1] + tp[2], st[2] + tp[1], st[3] + tp[0]}; }
        }
        float mA = NEGBIG, mB = NEGBIG;
#pragma unroll
        for (int i = 0; i < 9; ++i) { mA = fmaxf(mA, fmaxf(fmaxf(sA[i][0], sA[i][1]), fmaxf(sA[i][2], sA[i][3]))); mB = fmaxf(mB, fmaxf(fmaxf(sB[i][0], sB[i][1]), fmaxf(sB[i][2], sB[i][3]))); }
        mA = fmaxf(mA, __shfl_xor(mA, 16)); mA = fmaxf(mA, __shfl_xor(mA, 32)); mB = fmaxf(mB, __shfl_xor(mB, 16)); mB = fmaxf(mB, __shfl_xor(mB, 32));
        f32x4 oA[4], oB[4];
#pragma unroll
        for (int dt = 0; dt < 4; ++dt) { oA[dt] = zero4; oB[dt] = zero4; }
        float lA = 0.f, lB = 0.f;
        const LAS unsigned char* vb = Vs + (32 * w + 4 * g + (ql >> 2)) * KV_PITCH + (ql & 3) * 8;
#pragma unroll
        for (int i = 0; i < 10; ++i) {
            const LAS unsigned char* vt = vb + i * (16 * KV_PITCH);
            const s16x4 v0 = lds_tr16(vt), v1 = lds_tr16(vt + 32), v2 = lds_tr16(vt + 64), v3 = lds_tr16(vt + 96);
            if (i <= 8) { const float p0 = __builtin_amdgcn_exp2f(sA[i][0] - mA), p1 = __builtin_amdgcn_exp2f(sA[i][1] - mA), p2 = __builtin_amdgcn_exp2f(sA[i][2] - mA), p3 = __builtin_amdgcn_exp2f(sA[i][3] - mA);
                lA += (p0 + p1) + (p2 + p3); u32x2 pw; pw.x = cvt_pk_bf16(p0, p1); pw.y = cvt_pk_bf16(p2, p3); const s16x4 pf = __builtin_bit_cast(s16x4, pw);
                oA[0] = __builtin_amdgcn_mfma_f32_16x16x16bf16_1k(v0, pf, oA[0], 0, 0, 0); oA[1] = __builtin_amdgcn_mfma_f32_16x16x16bf16_1k(v1, pf, oA[1], 0, 0, 0);
                oA[2] = __builtin_amdgcn_mfma_f32_16x16x16bf16_1k(v2, pf, oA[2], 0, 0, 0); oA[3] = __builtin_amdgcn_mfma_f32_16x16x16bf16_1k(v3, pf, oA[3], 0, 0, 0); }
            if (i >= 1) { const float p0 = __builtin_amdgcn_exp2f(sB[i - 1][0] - mB), p1 = __builtin_amdgcn_exp2f(sB[i - 1][1] - mB), p2 = __builtin_amdgcn_exp2f(sB[i - 1][2] - mB), p3 = __builtin_amdgcn_exp2f(sB[i - 1][3] - mB);
                lB += (p0 + p1) + (p2 + p3); u32x2 pw; pw.x = cvt_pk_bf16(p0, p1); pw.y = cvt_pk_bf16(p2, p3); const s16x4 pf = __builtin_bit_cast(s16x4, pw);
                oB[0] = __builtin_amdgcn_mfma_f32_16x16x16bf16_1k(v0, pf, oB[0], 0, 0, 0); oB[1] = __builtin_amdgcn_mfma_f32_16x16x16bf16_1k(v1, pf, oB[1], 0, 0, 0);
                oB[2] = __builtin_amdgcn_mfma_f32_16x16x16bf16_1k(v2, pf, oB[2], 0, 0, 0); oB[3] = __builtin_amdgcn_mfma_f32_16x16x16bf16_1k(v3, pf, oB[3], 0, 0, 0); }
        }
        lA += __shfl_xor(lA, 16); lA += __shfl_xor(lA, 32); lB += __shfl_xor(lB, 16); lB += __shfl_xor(lB, 32);
#ifdef ATT_EXP1
        lA = 1.0f; lB = 1.0f; mA = 0.f; mB = 0.f;
#pragma unroll
        for (int dt = 0; dt < 4; ++dt) { oA[dt] = zero4; oB[dt] = zero4; }
#endif
#ifdef ATT_EXP2
        lA = 1.0f; lB = 1.0f;
#pragma unroll
        for (int dt = 0; dt < 4; ++dt) { oA[dt] = zero4; oB[dt] = zero4; }
#endif
        const float iA = 1.0f / lA, iB = 1.0f / lB;
        const int posA = r + dil * (256 * j + 32 * w + ql), posB = posA + 16 * dil;
        bf16_t* dA = OP + ((size_t)b * S + posA) * AW + h * HD + 4 * g; bf16_t* dB = OP + ((size_t)b * S + posB) * AW + h * HD + 4 * g;
#pragma unroll
        for (int dt = 0; dt < 4; ++dt) { u32x2 t; t.x = cvt_pk_bf16(oA[dt][0] * iA, oA[dt][1] * iA); t.y = cvt_pk_bf16(oA[dt][2] * iA, oA[dt][3] * iA); *(u32x2*)(dA + 16 * dt) = t;
            u32x2 t2; t2.x = cvt_pk_bf16(oB[dt][0] * iB, oB[dt][1] * iB); t2.y = cvt_pk_bf16(oB[dt][2] * iB, oB[dt][3] * iB); *(u32x2*)(dB + 16 * dt) = t2; }
        if (g == 0) { LSE[((size_t)b * S + posA) * NH + h] = mA + __builtin_amdgcn_logf(lA); LSE[((size_t)b * S + posB) * NH + h] = mB + __builtin_amdgcn_logf(lB); }
        __syncthreads();
    }
#undef ATT_PREFETCH
}

__device__ __forceinline__ void pool_phase(LAS unsigned char* lds, const bf16_t* __restrict__ U, const bf16_t* __restrict__ PWT, const float* __restrict__ pool_scale, bf16_t* __restrict__ MIX, int G, int c) {
    const int tid = threadIdx.x, lane = tid & 63, w = __builtin_amdgcn_readfirstlane(tid >> 6), ql = lane & 15, g = lane >> 4;
    LAS unsigned char* Us = lds; LAS unsigned char* Pl = lds + 40960;
    for (int pu = c; pu < S / 64; pu += G) {
        const int t0 = pu * 64;
        { u32x4 uv[5];
#pragma unroll
          for (int q = 0; q < 5; ++q) { const int id = tid + 512 * q, row = id >> 5, ch = id & 31, t = t0 - 15 + row; uv[q] = (u32x4){0u, 0u, 0u, 0u};
              if (id < 79 * 32 && t >= 0) uv[q] = *(const u32x4*)(U + (size_t)t * PW + ch * 8); }
#pragma unroll
          for (int q = 0; q < 5; ++q) { const int id = tid + 512 * q, row = id >> 5, ch = id & 31; if (id < 79 * 32) *(LAS u32x4*)(Us + row * 512 + ch * 16) = uv[q]; } }
        __syncthreads();
        { const int cch = tid & 255, th = tid >> 8, gg = cch >> 6, wn = 2 << gg, tl0 = 32 * th;
          const LAS bf16_t* up = (const LAS bf16_t*)Us + cch;
#define UAT(row) __uint_as_float(((unsigned)up[(row) * 256]) << 16)
          float sum = 0.f;
          for (int i = 0; i < wn; ++i) sum += UAT(tl0 + 15 - i);
          for (int tl = tl0; tl < tl0 + 32; ++tl) {
              if (tl > tl0) sum += UAT(tl + 15) - UAT(tl + 15 - wn);
              const int t = t0 + tl; const int cnt = (t + 1 < wn) ? (t + 1) : wn;
              const float val = sum / (float)cnt - UAT(tl + 15);
              ((LAS bf16_t*)(Pl + tl * 528))[cch] = (bf16_t)(cvt_pk_bf16(val, 0.f) & 0xffffu);
          }
#undef UAT
        }
        __syncthreads();
        { const int tt = w & 3, gp = w >> 2;
#pragma unroll
          for (int gi = 0; gi < 2; ++gi) { const int gg = 2 * gp + gi;
              const bf16x8 b0 = *(const LAS bf16x8*)(Pl + (16 * tt + ql) * 528 + (gg * 64 + 8 * g) * 2), b1 = *(const LAS bf16x8*)(Pl + (16 * tt + ql) * 528 + (gg * 64 + 32 + 8 * g) * 2);
#pragma unroll
              for (int nt = 0; nt < 4; ++nt) {
                  const bf16_t* ap = PWT + ((size_t)(gg * 64 + 16 * nt + ql) * 64 + 8 * g);
                  const bf16x8 a0 = *(const bf16x8*)(ap), a1 = *(const bf16x8*)(ap + 32);
                  f32x4 acc = __builtin_amdgcn_mfma_f32_16x16x32_bf16(a0, b0, (f32x4){0.f, 0.f, 0.f, 0.f}, 0, 0, 0);
                  acc = __builtin_amdgcn_mfma_f32_16x16x32_bf16(a1, b1, acc, 0, 0, 0);
                  const f32x4 ps = *(const f32x4*)(pool_scale + gg * 64 + 16 * nt + 4 * g);
                  u32x2 o; o.x = cvt_pk_bf16(acc[0] * ps[0], acc[1] * ps[1]); o.y = cvt_pk_bf16(acc[2] * ps[2], acc[3] * ps[3]);
                  *(u32x2*)(MIX + (size_t)(t0 + 16 * tt + ql) * D + gg * 64 + 16 * nt + 4 * g) = o;
              } }
        }
        __syncthreads();
    }
}

__device__ __forceinline__ void combine_phase(const bf16_t* __restrict__ OP, const float* __restrict__ LSE, bf16_t* __restrict__ MIX, int G, int c) {
    const int gt = c * 512 + threadIdx.x, NGT = G * 512;
    for (int id = gt; id < S * 96; id += NGT) {
        const int t = id / 96, rem = id % 96, h = rem >> 3, c8 = rem & 7;
        const float l0 = LSE[(size_t)t * NH + h], l1 = LSE[((size_t)S + t) * NH + h], l2 = LSE[((size_t)2 * S + t) * NH + h];
        const float mx = fmaxf(l0, fmaxf(l1, l2));
        float w0 = __builtin_amdgcn_exp2f(l0 - mx), w1 = __builtin_amdgcn_exp2f(l1 - mx), w2 = __builtin_amdgcn_exp2f(l2 - mx);
        const float inv = 1.0f / (w0 + w1 + w2); w0 *= inv; w1 *= inv; w2 *= inv;
        const size_t off = (size_t)t * AW + h * HD + c8 * 8;
        const u32x4 a = __builtin_nontemporal_load((const u32x4*)(OP + off)), b = __builtin_nontemporal_load((const u32x4*)(OP + (size_t)S * AW + off)), cc = __builtin_nontemporal_load((const u32x4*)(OP + (size_t)2 * S * AW + off));
        u32x4 o;
#pragma unroll
        for (int k = 0; k < 4; ++k) { const float lo = w0 * bf_lo(a[k]) + w1 * bf_lo(b[k]) + w2 * bf_lo(cc[k]), hi = w0 * bf_hi(a[k]) + w1 * bf_hi(b[k]) + w2 * bf_hi(cc[k]); o[k] = cvt_pk_bf16(lo, hi); }
        *(u32x4*)(MIX + (size_t)t * D + PW + h * HD + c8 * 8) = o;
    }
}

constexpr int GWB_PITCH = 2064;
constexpr int RT_GWL = NE * GWB_PITCH, RT_G2 = 2 * NE * GWB_PITCH, RT_LG = RT_G2 + 4096, RT_RS = RT_LG + 4 * 16 * 33 * 4, RT_CNT = RT_RS + 256, RT_PART = RT_CNT + 256, RT_END = RT_PART + 4 * 64 * 9 * 4;
static_assert(RT_END <= LDS_CTL, "router LDS map");
__device__ __forceinline__ void split_bf16(const f32x4& a0, const f32x4& a1, bf16x8& hi, bf16x8& lo) {
    u32x4 h, l;
    h.x = cvt_pk_bf16(a0[0], a0[1]); h.y = cvt_pk_bf16(a0[2], a0[3]); h.z = cvt_pk_bf16(a1[0], a1[1]); h.w = cvt_pk_bf16(a1[2], a1[3]);
    l.x = cvt_pk_bf16(a0[0] - bf_lo(h.x), a0[1] - bf_hi(h.x)); l.y = cvt_pk_bf16(a0[2] - bf_lo(h.y), a0[3] - bf_hi(h.y));
    l.z = cvt_pk_bf16(a1[0] - bf_lo(h.z), a1[1] - bf_hi(h.z)); l.w = cvt_pk_bf16(a1[2] - bf_lo(h.w), a1[3] - bf_hi(h.w));
    hi = __builtin_bit_cast(bf16x8, h); lo = __builtin_bit_cast(bf16x8, l);
}
__device__ __forceinline__ unsigned trunc_pk(float lo, float hi) { return (__float_as_uint(lo) >> 16) | (__float_as_uint(hi) & 0xffff0000u); }
__device__ __forceinline__ float trunc_res(float x) { return x - __uint_as_float(__float_as_uint(x) & 0xffff0000u); }
__device__ __forceinline__ void split_trunc(const f32x4& a0, const f32x4& a1, bf16x8& hi, bf16x8& lo) {
    u32x4 h, l;
    h.x = trunc_pk(a0[0], a0[1]); h.y = trunc_pk(a0[2], a0[3]); h.z = trunc_pk(a1[0], a1[1]); h.w = trunc_pk(a1[2], a1[3]);
    l.x = trunc_pk(trunc_res(a0[0]), trunc_res(a0[1])); l.y = trunc_pk(trunc_res(a0[2]), trunc_res(a0[3])); l.z = trunc_pk(trunc_res(a1[0]), trunc_res(a1[1])); l.w = trunc_pk(trunc_res(a1[2]), trunc_res(a1[3]));
    hi = __builtin_bit_cast(bf16x8, h); lo = __builtin_bit_cast(bf16x8, l);
}
__device__ __forceinline__ void router_phase(LAS unsigned char* lds, const float* __restrict__ X1, const float* __restrict__ g2, const float* __restrict__ GWT, const float* __restrict__ rb,
                                             unsigned char* __restrict__ H, float* __restrict__ RSTD, float* __restrict__ GATES, int* __restrict__ ROWS, unsigned* __restrict__ COUNTS, int G, int c) {
    const int tid = threadIdx.x, lane = tid & 63, w = __builtin_amdgcn_readfirstlane(tid >> 6), ql = lane & 15, g = lane >> 4;
    const int ts = w & 3, kh = w >> 2;
    LAS unsigned char* GWH = lds; LAS unsigned char* GWL = lds + RT_GWL;
    LAS float* G2 = (LAS float*)(lds + RT_G2);
    LAS float* LG = (LAS float*)(lds + RT_LG) + ts * (16 * 33);
    LAS float* RS = (LAS float*)(lds + RT_RS) + ts * 16;
    LAS int* LCNT = (LAS int*)(lds + RT_CNT);
    LAS int* LBASE = LCNT + 32;
    LAS float* PART = (LAS float*)(lds + RT_PART) + ts * (64 * 9);
    const int nrounds = (S / 16 + 4 * G - 1) / (4 * G);
    for (int rd = 0; rd < nrounds; ++rd) {
        const int tile = (rd * 4 + ts) * G + c;
        const bool active = tile < S / 16;
        const int tok = (active ? tile : 0) * 16 + ql;
        const float* xr = X1 + (size_t)tok * D + kh * 512 + 8 * g;
        f32x4 av[16];
        if (active) {
#pragma unroll
            for (int i = 0; i < 8; ++i) { av[2 * i] = __builtin_nontemporal_load((const f32x4*)(xr + 32 * i)); av[2 * i + 1] = __builtin_nontemporal_load((const f32x4*)(xr + 32 * i + 4)); } }
        if (rd == 0) {
            { f32x4 gx[16];
#pragma unroll
              for (int q = 0; q < 8; ++q) { const int id = tid + 512 * q, e = id >> 7, k8 = id & 127; gx[2 * q] = *(const f32x4*)(GWT + e * D + k8 * 8); gx[2 * q + 1] = *(const f32x4*)(GWT + e * D + k8 * 8 + 4); }
#pragma unroll
              for (int q = 0; q < 8; ++q) { const int id = tid + 512 * q, e = id >> 7, k8 = id & 127;
                bf16x8 hi, lo; split_bf16(gx[2 * q], gx[2 * q + 1], hi, lo); *(LAS bf16x8*)(GWH + e * GWB_PITCH + k8 * 16) = hi; *(LAS bf16x8*)(GWL + e * GWB_PITCH + k8 * 16) = lo; } }
            if (tid < 256) *(LAS f32x4*)(G2 + tid * 4) = *(const f32x4*)(g2 + tid * 4);
        }
        if (tid < 32) LCNT[tid] = 0;
        __syncthreads();
        int ek[4] = {0, 0, 0, 0}, lp[4] = {0, 0, 0, 0}; float gk[4] = {0.f, 0.f, 0.f, 0.f};
        f32x4 acc0 = (f32x4){0.f, 0.f, 0.f, 0.f}, acc1 = acc0; float ss = 0.f;
        if (active) {
            f32x4 accA[6], accB[6];
#pragma unroll
            for (int t = 0; t < 6; ++t) { accA[t] = (f32x4){0.f, 0.f, 0.f, 0.f}; accB[t] = accA[t]; }

            unsigned char* hr = H + (size_t)tok * D + kh * 512 + 8 * g;
            const LAS unsigned char* bh0 = GWH + ql * GWB_PITCH + (kh * 512 + 8 * g) * 2; const LAS unsigned char* bh1 = bh0 + 16 * GWB_PITCH;
            const LAS unsigned char* bl0 = GWL + ql * GWB_PITCH + (kh * 512 + 8 * g) * 2; const LAS unsigned char* bl1 = bl0 + 16 * GWB_PITCH;
            const LAS float* gp = G2 + kh * 512 + 8 * g;
#pragma unroll
            for (int kb = 0; kb < 512; kb += 256) {
                if (kb > 0) {
#pragma unroll
                    for (int i = 0; i < 8; ++i) { av[2 * i] = __builtin_nontemporal_load((const f32x4*)(xr + kb + 32 * i)); av[2 * i + 1] = __builtin_nontemporal_load((const f32x4*)(xr + kb + 32 * i + 4)); } }
#pragma unroll
                for (int i = 0; i < 8; ++i) {
                    const int k0 = kb + 32 * i; const f32x4 a0 = av[2 * i], a1 = av[2 * i + 1];
                    const f32x4 n0 = *(const LAS f32x4*)(gp + k0), n1 = *(const LAS f32x4*)(gp + k0 + 4);
                    const bf16x8 wh0 = *(const LAS bf16x8*)(bh0 + k0 * 2), wh1 = *(const LAS bf16x8*)(bh1 + k0 * 2), wl0 = *(const LAS bf16x8*)(bl0 + k0 * 2), wl1 = *(const LAS bf16x8*)(bl1 + k0 * 2);
                    ss += (a0[0] * a0[0] + a0[1] * a0[1]) + (a0[2] * a0[2] + a0[3] * a0[3]) + (a1[0] * a1[0] + a1[1] * a1[1]) + (a1[2] * a1[2] + a1[3] * a1[3]);
                    u32x2 hv; hv.x = cvt4_fp8(a0[0] * n0[0] * HSCALE, a0[1] * n0[1] * HSCALE, a0[2] * n0[2] * HSCALE, a0[3] * n0[3] * HSCALE);
                    hv.y = cvt4_fp8(a1[0] * n1[0] * HSCALE, a1[1] * n1[1] * HSCALE, a1[2] * n1[2] * HSCALE, a1[3] * n1[3] * HSCALE);
                    *(u32x2*)(hr + k0) = hv;
                    bf16x8 ah, al; split_bf16(a0, a1, ah, al);


                    __builtin_amdgcn_sched_barrier(0); asm volatile("s_nop 7" ::: "memory"); __builtin_amdgcn_sched_barrier(0);
                    f32x4 (&q)[6] = (i & 1) ? accB : accA;
                    q[0] = __builtin_amdgcn_mfma_f32_16x16x32_bf16(ah, wh0, q[0], 0, 0, 0); q[1] = __builtin_amdgcn_mfma_f32_16x16x32_bf16(ah, wh1, q[1], 0, 0, 0);
                    q[2] = __builtin_amdgcn_mfma_f32_16x16x32_bf16(ah, wl0, q[2], 0, 0, 0); q[3] = __builtin_amdgcn_mfma_f32_16x16x32_bf16(ah, wl1, q[3], 0, 0, 0);
                    q[4] = __builtin_amdgcn_mfma_f32_16x16x32_bf16(al, wh0, q[4], 0, 0, 0); q[5] = __builtin_amdgcn_mfma_f32_16x16x32_bf16(al, wh1, q[5], 0, 0, 0);

                    __builtin_amdgcn_sched_barrier(0); asm volatile("s_nop 15\n\ts_nop 15" ::: "memory"); __builtin_amdgcn_sched_barrier(0);

                }
            }

            acc0 = ((accA[0] + accB[0]) + (accA[2] + accB[2])) + (accA[4] + accB[4]); acc1 = ((accA[1] + accB[1]) + (accA[3] + accB[3])) + (accA[5] + accB[5]);


            if (kh == 1) { LAS float* pp = PART + lane * 9;
#pragma unroll
                for (int i = 0; i < 4; ++i) { pp[i] = acc0[i]; pp[4 + i] = acc1[i]; } pp[8] = ss; }
        }
        __syncthreads();
        if (active && kh == 0) {
            { const LAS float* pp = PART + lane * 9;
#pragma unroll
              for (int i = 0; i < 4; ++i) { acc0[i] += pp[i]; acc1[i] += pp[4 + i]; } ss += pp[8]; }
            ss += __shfl_xor(ss, 16); ss += __shfl_xor(ss, 32);
            const float rstd = rsqrtf(ss * (1.0f / D) + RMS_EPS);
            if (g == 0) { RSTD[tok] = rstd; RS[ql] = rstd; }
            LDS_WAIT();
            const float rb0 = rb[ql], rb1 = rb[16 + ql];
#pragma unroll
            for (int rg = 0; rg < 4; ++rg) { const float rr = RS[4 * g + rg]; LG[(4 * g + rg) * 33 + ql] = acc0[rg] * rr + rb0; LG[(4 * g + rg) * 33 + 16 + ql] = acc1[rg] * rr + rb1; }
            LDS_WAIT();
            if (lane < 16) {
                float v[32];
#pragma unroll
                for (int e = 0; e < 32; ++e) v[e] = LG[ql * 33 + e];
                float tv[4];
#pragma unroll
                for (int r = 0; r < 4; ++r) { float best = v[0]; int bi = 0;
#pragma unroll
                    for (int e = 1; e < 32; ++e) { const bool gt = v[e] > best; best = gt ? v[e] : best; bi = gt ? e : bi; }
                    tv[r] = best; ek[r] = bi;
#pragma unroll
                    for (int e = 0; e < 32; ++e) v[e] = (e == bi) ? -INFINITY : v[e]; }
                const float e1 = __expf(tv[1] - tv[0]), e2 = __expf(tv[2] - tv[0]), e3 = __expf(tv[3] - tv[0]); const float inv = 1.0f / (1.0f + e1 + e2 + e3);
                gk[0] = inv; gk[1] = e1 * inv; gk[2] = e2 * inv; gk[3] = e3 * inv;
#pragma unroll
                for (int r = 0; r < 4; ++r) lp[r] = __hip_atomic_fetch_add(LCNT + ek[r], 1, __ATOMIC_RELAXED, __HIP_MEMORY_SCOPE_WORKGROUP);
            }
        }
        __syncthreads();
        if (tid < 32) { const int n = LCNT[tid]; int base = 0; if (n > 0) base = (int)__hip_atomic_fetch_add(COUNTS + tid, (unsigned)n, __ATOMIC_RELAXED, __HIP_MEMORY_SCOPE_AGENT); LBASE[tid] = base; }
        __syncthreads();
        if (active && kh == 0 && lane < 16) {
#pragma unroll
            for (int r = 0; r < 4; ++r) { const int pos = LBASE[ek[r]] + lp[r]; ROWS[(size_t)ek[r] * S + pos] = tok * 4 + r; GATES[tok * 4 + r] = gk[r]; }

        }
        __syncthreads();
    }
}

__device__ __forceinline__ void moe_prefix(LAS int* tpre, LAS int* lcnt, const unsigned* __restrict__ COUNTS) {
    if (threadIdx.x < 32) lcnt[threadIdx.x] = (int)COUNTS[threadIdx.x];
    __syncthreads();
    if (threadIdx.x == 0) { int acc = 0; for (int e = 0; e < NE; ++e) { tpre[e] = acc; acc += (lcnt[e] + 255) >> 8; } tpre[NE] = acc; }
    __syncthreads();
}
template <bool GU, class Prob> __device__ __forceinline__ void moe_table(const Prob& P, LAS int* udesc, LAS int* tab, LAS float* tabf, LAS float* tabb, const LAS int* lcnt, const int* __restrict__ ROWS,
                                                                         const float* __restrict__ rowf, const float* __restrict__ bias) {
    if (threadIdx.x < MAXU) { Unit u0; u0.e = 0; u0.pm = 0; u0.pn = 0; u0.slot = 0; const bool ok = P.search((int)threadIdx.x, u0);
        udesc[4 * threadIdx.x] = u0.e; udesc[4 * threadIdx.x + 1] = u0.pm; udesc[4 * threadIdx.x + 2] = u0.pn; udesc[4 * threadIdx.x + 3] = ok ? 1 : 0; }
    __syncthreads();
    constexpr int NQ = (MAXU * 256 + 511) / 512;
    int idx[NQ]; float fv[NQ], bvv[NQ];
#pragma unroll
    for (int q = 0; q < NQ; ++q) { const int j = (int)threadIdx.x + 512 * q, i = j >> 8, r = j & 255; idx[q] = -2;
        if (i < MAXU && udesc[4 * i + 3]) { const int e = udesc[4 * i], rr = udesc[4 * i + 1] * 256 + r; idx[q] = (rr < lcnt[e]) ? ROWS[(size_t)e * S + rr] : -1; } }
#pragma unroll
    for (int q = 0; q < NQ; ++q) { const int j = (int)threadIdx.x + 512 * q, i = j >> 8, c2 = j & 255; fv[q] = 0.f; bvv[q] = 0.f;
        if (idx[q] != -2) { const int e = udesc[4 * i], pn = udesc[4 * i + 2];
            fv[q] = GU ? rowf[idx[q] < 0 ? 0 : (idx[q] >> 2)] * (1.0f / (HSCALE * WSCALE)) : (idx[q] < 0 ? 0.f : rowf[idx[q]]);
            bvv[q] = GU ? bias[(size_t)e * 2 * DFF + (c2 >> 7) * DFF + pn * 128 + (c2 & 127)] : bias[(size_t)e * D + pn * 256 + c2]; } }
#pragma unroll
    for (int q = 0; q < NQ; ++q) { const int j = (int)threadIdx.x + 512 * q; if (idx[q] != -2) { tab[j] = idx[q]; tabf[j] = fv[q]; tabb[j] = bvv[q]; } }
    __syncthreads();
}

__device__ __forceinline__ void final_phase(const float* __restrict__ X1, const unsigned char* __restrict__ Y, const float* __restrict__ fg, float* __restrict__ out, int G, int c) {
    const int tid = threadIdx.x, lane = tid & 63, wave = tid >> 6; const int gw = c * 8 + wave, NGW = G * 8;
    f32x4 gv[4];
#pragma unroll
    for (int j = 0; j < 4; ++j) gv[j] = *(const f32x4*)(fg + 4 * lane + 256 * j);
    for (int m = gw; m < S; m += NGW) {
        const float* xr = X1 + (size_t)m * D + 4 * lane;
        f32x4 v[4];
#pragma unroll
        for (int j = 0; j < 4; ++j) v[j] = __builtin_nontemporal_load((const f32x4*)(xr + 256 * j));

#pragma unroll
        for (int k = 0; k < 4; ++k) { const unsigned char* yr = Y + ((size_t)m * 4 + k) * D + 4 * lane;
#pragma unroll
            for (int j = 0; j < 4; ++j) { const int t = __builtin_nontemporal_load((const int*)(yr + 256 * j)); const f32x2 lo = __builtin_amdgcn_cvt_pk_f32_fp8(t, false), hi = __builtin_amdgcn_cvt_pk_f32_fp8(t, true);
                v[j][0] += lo[0] * (1.0f / YSCALE); v[j][1] += lo[1] * (1.0f / YSCALE); v[j][2] += hi[0] * (1.0f / YSCALE); v[j][3] += hi[1] * (1.0f / YSCALE); } }
        float s = 0.f;
#pragma unroll
        for (int j = 0; j < 4; ++j) s += (v[j][0] * v[j][0] + v[j][1] * v[j][1]) + (v[j][2] * v[j][2] + v[j][3] * v[j][3]);
        const float rstd = rsqrtf(wave_sum(s) * (1.0f / D) + RMS_EPS);
#pragma unroll
        for (int j = 0; j < 4; ++j) __builtin_nontemporal_store(v[j] * rstd * gv[j], (f32x4*)(out + (size_t)m * D + 4 * lane + 256 * j));
    }
}

constexpr int NPHASE = 9;
struct Args { In in; float* out; unsigned char* ws; int ph_lo, ph_hi; };
__global__ void __launch_bounds__(512, 2) fwd(Args args) {
    extern __shared__ __attribute__((aligned(16))) unsigned char lds_raw[];
    LAS unsigned char* lds = (LAS unsigned char*)lds_raw;
    const int tid = threadIdx.x, G = gridDim.x, c = blockIdx.x;
    unsigned char* ws = args.ws; const In& in = args.in;
    unsigned* ctl = (unsigned*)(ws + WS_CTL);
    LAS int* LCTL = (LAS int*)(lds + LDS_CTL);
    if (tid < 256) LCTL[tid] = 0;
    __syncthreads();
    const int lo = args.ph_lo, hi = args.ph_hi;
    const bool one_launch = (hi - lo) > 1;
    XcdBarrier bar; bar.bar = ctl + CW_BAR; bar.x = 0; bar.st = nullptr;
    if (one_launch) bar = xcd_barrier_post(ctl + CW_BAR, (volatile LAS unsigned*)LCTL);
#define IN(k) (lo <= (k) && (k) < hi)
#ifndef MK_DOUBLE
#define MK_DOUBLE 0
#endif
#define REP(k) for (int rep_ = 0; rep_ < ((((MK_DOUBLE) >> (k)) & 1) ? 2 : 1); ++rep_)
#define SEAM(k) do { if (IN((k) + 1)) xcd_barrier(bar); } while (0)
    bf16_t* Hb = (bf16_t*)(ws + WS_H); bf16_t* Ub = (bf16_t*)(ws + WS_U); bf16_t* Qb = (bf16_t*)(ws + WS_Q); bf16_t* Kb = (bf16_t*)(ws + WS_K); bf16_t* Vb = (bf16_t*)(ws + WS_V);
    bf16_t* OPb = (bf16_t*)(ws + WS_OP); bf16_t* MIXb = (bf16_t*)(ws + WS_MIX); float* X1 = (float*)(ws + WS_X1); unsigned char* ACTb = ws + WS_ACT; unsigned char* Yb = ws + WS_Y; unsigned char* H8 = ws + WS_H8;
    float* LSE = (float*)(ws + WS_LSE); float* RSTD = (float*)(ws + WS_RSTD); float* GATES = (float*)(ws + WS_GATES); int* ROWS = (int*)(ws + WS_ROWS); unsigned* COUNTS = ctl + CW_COUNTS;
    LAS int* TPRE = LCTL + 16; LAS int* LCNT = LCTL + 128; LAS int* UDESC = LCTL + 192; LAS int* TAB = (LAS int*)(lds + LDS_TAB); LAS float* TABF = (LAS float*)(lds + LDS_TAB + MAXU * 1024); LAS float* TABB = (LAS float*)(lds + LDS_TAB + 2 * MAXU * 1024);
    static_assert(LDS_TAB + 3 * MAXU * 1024 <= LDS_CTL, "MoE LDS tables");

    if (IN(0)) { REP(0) p0_prologue(lds, in, ws, G, c); SEAM(0); }
    if (IN(1)) {
        const int NG = (G >= 256) ? 160 : G;
        if (c < NG) {
            pg8::DenseProb P{(const char*)Hb, (const char*)(ws + WS_WIN), D * 2, S / 256, NPROJ / 256, NG, c, (size_t)128 * D * 2};
            EpiQKVU E{ws};
            REP(1) pg8::gemm_phase<EpiQKVU, pg8::DenseProb, true, false>(lds, P, E);
        }
        else p0_side(lds, in, ws, G - NG, c - NG);
        if (NG == G) p0_side(lds, in, ws, G, c);
        convert8_queue(lds, in, ws, ctl + CW_QUEUE);
        SEAM(1);
    }
    if (IN(2)) {
        REP(2) attn_phase(lds, Qb, Kb, Vb, (const float*)(ws + WS_BT), OPb, LSE, G, c);
        REP(9) pool_phase(lds, Ub, (const bf16_t*)(ws + WS_PWT), in.pool_scale, MIXb, G, c);
        SEAM(2);
    }
    if (IN(3)) { REP(3) combine_phase(OPb, LSE, MIXb, G, c); SEAM(3); }
    if (IN(4)) {
        pg8::DenseProb P{(const char*)MIXb, (const char*)(ws + WS_WOUT), D * 2, S / 256, D / 256, G, c, (size_t)128 * D * 2};
        EpiResF32 E{in.x, X1};
        REP(4) pg8::gemm_phase<EpiResF32, pg8::DenseProb, true, false>(lds, P, E);
        SEAM(4);
    }
    if (IN(5)) { router_phase(lds, X1, in.norm2_g, (const float*)(ws + WS_GWT), in.router_b, H8, RSTD, GATES, ROWS, COUNTS, G, c); SEAM(5); }
    if (IN(6)) {
        moe_prefix(TPRE, LCNT, COUNTS);
        pg8::MoeProb<true> P{(const char*)H8, (const char*)(ws + WS_WGU), D, 8, G, c, (size_t)DFF * D, (size_t)2 * DFF * D, 128, TPRE, TAB, UDESC};
        moe_table<true>(P, UDESC, TAB, TABF, TABB, LCNT, ROWS, RSTD, in.b_gate_up);
        EpiGateUp E{ACTb, TPRE, TABF, TABB};
        REP(6) pg8::gemm_phase<EpiGateUp, pg8::MoeProb<true>, true, true>(lds, P, E);
        SEAM(6);
    }
    if (IN(7)) {
        moe_prefix(TPRE, LCNT, COUNTS);
        pg8::MoeProb<false> P{(const char*)ACTb, (const char*)(ws + WS_WD), DFF, 4, G, c, (size_t)128 * DFF, (size_t)D * DFF, 256, TPRE, TAB, UDESC};
        moe_table<false>(P, UDESC, TAB, TABF, TABB, LCNT, ROWS, GATES, in.b_down);
        EpiDown E{Yb, TAB, TABF, TABB};
        REP(7) pg8::gemm_phase<EpiDown, pg8::MoeProb<false>, true, true>(lds, P, E);
        SEAM(7);
    }

    if (IN(8)) REP(8) final_phase(X1, Yb, in.final_g, args.out, G, c);

#undef IN
#undef SEAM
}

#ifndef MK_N_LAUNCHES
#define MK_N_LAUNCHES 1
#endif
#ifndef MK_SEQ
#define MK_SEQ "012345678"
#endif
extern "C" void kernel_launch(void* const* d_in, const int* in_sizes, int n_in, void* d_out, int out_size, void* d_ws, size_t ws_size, hipStream_t stream) {
    static int grid = 0;
    if (grid == 0) {
        if (n_in != 15 || out_size != S * D || ws_size < WS_END) { fprintf(stderr, "kernel_launch: unexpected problem (n_in %d out %d ws %zu)\n", n_in, out_size, ws_size); grid = -1; return; }
        int dev = 0, cus = 0, per_cu = 0;
        if (hipGetDevice(&dev) != hipSuccess || hipDeviceGetAttribute(&cus, hipDeviceAttributeMultiprocessorCount, dev) != hipSuccess) { grid = -1; return; }
        if (hipFuncSetAttribute((const void*)fwd, hipFuncAttributeMaxDynamicSharedMemorySize, LDS_BYTES) != hipSuccess) { fprintf(stderr, "kernel_launch: hipFuncSetAttribute failed\n"); grid = -1; return; }
        if (hipOccupancyMaxActiveBlocksPerMultiprocessor(&per_cu, (const void*)fwd, 512, LDS_BYTES) != hipSuccess || per_cu < 1) { fprintf(stderr, "kernel_launch: occupancy query says %d blocks per CU\n", per_cu); (void)hipGetLastError(); per_cu = 1; }
        grid = cus;
    }
    if (grid < 0) return;
    if (hipMemsetAsync((char*)d_ws + WS_CTL, 0, CTL_ZERO_BYTES, stream) != hipSuccess) { fprintf(stderr, "kernel_launch: memset failed\n"); return; }
    Args a{};
    a.in.x = (const float*)d_in[0]; a.in.norm1_g = (const float*)d_in[1]; a.in.w_in = (const float*)d_in[2]; a.in.pool_w = (const float*)d_in[3]; a.in.pool_scale = (const float*)d_in[4];
    a.in.rel_bias = (const float*)d_in[5]; a.in.w_out = (const float*)d_in[6]; a.in.norm2_g = (const float*)d_in[7]; a.in.router_w = (const float*)d_in[8]; a.in.router_b = (const float*)d_in[9];
    a.in.w_gate_up = (const float*)d_in[10]; a.in.b_gate_up = (const float*)d_in[11]; a.in.w_down = (const float*)d_in[12]; a.in.b_down = (const float*)d_in[13]; a.in.final_g = (const float*)d_in[14];
    a.out = (float*)d_out; a.ws = (unsigned char*)d_ws;
    if (MK_N_LAUNCHES == 1) { a.ph_lo = 0; a.ph_hi = NPHASE; hipLaunchKernelGGL(fwd, dim3(grid), dim3(512), LDS_BYTES, stream, a); }
    else { const char* seq = MK_SEQ; for (int i = 0; seq[i]; ++i) { const int p = seq[i] - '0'; a.ph_lo = p; a.ph_hi = p + 1; if (p == 5) (void)hipMemsetAsync((char*)d_ws + WS_CTL + CW_COUNTS * 4, 0, 128, stream); hipLaunchKernelGGL(fwd, dim3(grid), dim3(512), LDS_BYTES, stream, a); } }
    const hipError_t le = hipPeekAtLastError();
    if (le != hipSuccess) fprintf(stderr, "kernel_launch: launch failed: %s\n", hipGetErrorName(le));
}
```

```cpp
#include <hip/hip_runtime.h>
#include <cstdio>
#include <cstdint>

#define LAS __attribute__((address_space(3)))
#define GAS __attribute__((address_space(1)))
typedef unsigned short bf16_t;
typedef short bf16x8 __attribute__((ext_vector_type(8)));
typedef short s16x4 __attribute__((ext_vector_type(4)));
typedef float f32x4 __attribute__((ext_vector_type(4)));
typedef float f32x2 __attribute__((ext_vector_type(2)));
typedef unsigned u32x4 __attribute__((ext_vector_type(4)));
typedef unsigned u32x2 __attribute__((ext_vector_type(2)));
typedef int i32x4 __attribute__((ext_vector_type(4)));
typedef int i32x8 __attribute__((ext_vector_type(8)));

constexpr int S = 16384, D = 1024, NPROJ = 2560, PW = 256, AW = 768, NH = 12, HD = 64, NE = 32, TOPK = 4, DFF = 1024;
constexpr float RMS_EPS = 1e-5f, LOG2E = 1.4426950408889634f, QSCALE = 0.125f * LOG2E, NEGBIG = -1e30f;
constexpr float WSCALE = 64.0f, HSCALE = 16.0f, ASCALE = 8.0f, YSCALE = 64.0f, FP8MAX = 448.0f;
constexpr int BT_N = 400, BT_OFF = 144;

constexpr size_t MiB = 1u << 20;
constexpr size_t WS_CTL = 0, CTL_ZERO_BYTES = 32 * 1024;
constexpr size_t WS_WIN = 2 * MiB;
constexpr size_t WS_WOUT = 8 * MiB;
constexpr size_t WS_GWT = 10 * MiB;
constexpr size_t WS_BT = 10 * MiB + 512 * 1024;
constexpr size_t WS_PWT = 10 * MiB + 768 * 1024;
constexpr size_t WS_RSTD = 11 * MiB;
constexpr size_t WS_GATES = 11 * MiB + 256 * 1024;
constexpr size_t WS_ROWS = 12 * MiB;
constexpr size_t WS_LSE = 14 * MiB;
constexpr size_t WS_WGU = 32 * MiB;
constexpr size_t WS_WD = 160 * MiB;
constexpr size_t WS_H8 = 200 * MiB;
constexpr size_t WS_H = 224 * MiB;
constexpr size_t WS_U = 256 * MiB;
constexpr size_t WS_Q = 264 * MiB, WS_K = 288 * MiB, WS_V = 312 * MiB;
constexpr size_t WS_OP = 336 * MiB;
constexpr size_t WS_MIX = 408 * MiB;
constexpr size_t WS_X1 = 440 * MiB;
constexpr size_t WS_ACT = 512 * MiB;
constexpr size_t WS_Y = 656 * MiB;
constexpr size_t WS_END = 784 * MiB;
constexpr int ACT_ROWS = 65536 + 32 * 256;
constexpr int CW_COUNTS = 64;
constexpr int CW_QUEUE = 256;
constexpr int CW_BAR = 4096;

constexpr int LDS_BYTES = 163840;
constexpr int LDS_TAB = 131072;
constexpr int LDS_CTL = LDS_BYTES - 1024;
constexpr int MAXU = 9;

typedef __bf16 bf16x2_t __attribute__((ext_vector_type(2)));
__device__ __forceinline__ unsigned cvt_pk_bf16(float lo, float hi) { const f32x2 v = {lo, hi}; const bf16x2_t b = __builtin_convertvector(v, bf16x2_t); return __builtin_bit_cast(unsigned, b); }
__device__ __forceinline__ float clamp8(float v) { return __builtin_amdgcn_fmed3f(v, -FP8MAX, FP8MAX); }
__device__ __forceinline__ unsigned cvt4_fp8(float a, float b, float c, float d) {
    int p = __builtin_amdgcn_cvt_pk_fp8_f32(clamp8(a), clamp8(b), 0, false); p = __builtin_amdgcn_cvt_pk_fp8_f32(clamp8(c), clamp8(d), p, true); return (unsigned)p; }
__device__ __forceinline__ float bf_lo(unsigned w) { return __uint_as_float(w << 16); }
__device__ __forceinline__ float bf_hi(unsigned w) { return __uint_as_float(w & 0xffff0000u); }
__device__ __forceinline__ float wave_sum(float v) {
#pragma unroll
    for (int o = 1; o < 64; o <<= 1) v += __shfl_xor(v, o);
    return v;
}
#define LDS_WAIT() asm volatile("s_waitcnt lgkmcnt(0)" ::: "memory")
#define VM_WAIT() asm volatile("s_waitcnt vmcnt(0)" ::: "memory")

#define XB_TMO      128
#define XB_XCNT(j)  (256  + 64 * (j))
#define XB_XSUB(j)  (1280 + 64 * (j))
#define XB_XGEN(j)  (2304 + 64 * (j))
#define XB_TOP      3328
#define XB_TOPGEN   3392
#define XCD_BAR_WORDS 3456
#define XB_SPIN_CAP (1u << 18)
__device__ __forceinline__ unsigned xb_ld(unsigned* p)              { return __hip_atomic_load(p, __ATOMIC_RELAXED, __HIP_MEMORY_SCOPE_AGENT); }
__device__ __forceinline__ unsigned xb_add(unsigned* p, unsigned v) { return __hip_atomic_fetch_add(p, v, __ATOMIC_RELAXED, __HIP_MEMORY_SCOPE_AGENT); }
__device__ __forceinline__ unsigned xb_xcc_id() { return (unsigned)__builtin_amdgcn_s_getreg((3 << 11) | 20) & 0xFu; }
#define XB_SPIN(cond, bar) do { unsigned _sp = 0; while (cond) { __builtin_amdgcn_s_sleep(1); \
    if ((++_sp & 255u) == 0u) { if (xb_ld(&(bar)[XB_TMO])) break; if (_sp > XB_SPIN_CAP) { atomicAdd(&(bar)[XB_TMO], 1u); break; } } } } while (0)
struct XcdBarrier { unsigned* bar; unsigned x; volatile LAS unsigned* st; };
__device__ __forceinline__ XcdBarrier xcd_barrier_post(unsigned* bar, volatile LAS unsigned* st) {
    XcdBarrier b; b.bar = bar; b.x = xb_xcc_id(); b.st = st;
    if (threadIdx.x == 0) (void)xb_add(&bar[XB_XCNT(b.x)], 1u);
    return b;
}
__device__ __forceinline__ void xcd_barrier_complete(unsigned* bar, unsigned x, unsigned& nloc, unsigned& nx) {
    const unsigned G = gridDim.x * gridDim.y * gridDim.z;
    unsigned sum, cnt, mine, sp = 0u;
    for (;;) {
        sum = 0u; cnt = 0u; mine = 0u;
#pragma unroll
        for (unsigned j = 0; j < 16; ++j) { const unsigned c = xb_ld(&bar[XB_XCNT(j)]); sum += c; cnt += (c > 0u) ? 1u : 0u; mine = (j == x) ? c : mine; }
        if (sum == G) break;
        __builtin_amdgcn_s_sleep(1);
        if ((++sp & 255u) == 0u) { if (xb_ld(&bar[XB_TMO])) break; if (sp > XB_SPIN_CAP) { atomicAdd(&bar[XB_TMO], 1u); break; } }
    }
    nloc = mine > 0u ? mine : 1u; nx = cnt > 0u ? cnt : 1u;
}
__device__ __forceinline__ void xcd_barrier(const XcdBarrier& b) {
    asm volatile("s_waitcnt vmcnt(0)" ::: "memory");
    __syncthreads();
    if (threadIdx.x == 0) {
        unsigned* bar = b.bar;
        __builtin_amdgcn_s_waitcnt(0);
        unsigned nloc = b.st[0], nx = b.st[1];
        if (nloc == 0u) { xcd_barrier_complete(bar, b.x, nloc, nx); b.st[0] = nloc; b.st[1] = nx; }
        const unsigned old = xb_add(&bar[XB_XSUB(b.x)], 1u);
        const unsigned gen = old / nloc;
        if (old + 1u == (gen + 1u) * nloc) {
            __builtin_amdgcn_fence(__ATOMIC_RELEASE, "agent");
            asm volatile("s_waitcnt vmcnt(0)" ::: "memory");
            const unsigned og = xb_add(&bar[XB_TOP], 1u);
            const unsigned tg = og / nx;
            if (og + 1u == (tg + 1u) * nx) xb_add(&bar[XB_TOPGEN], 1u);
            else XB_SPIN(xb_ld(&bar[XB_TOPGEN]) == tg, bar);
            __builtin_amdgcn_fence(__ATOMIC_ACQUIRE, "agent");
            xb_add(&bar[XB_XGEN(b.x)], 1u);
            asm volatile("s_waitcnt vmcnt(0)" ::: "memory");
        } else {
            XB_SPIN(xb_ld(&bar[XB_XGEN(b.x)]) == gen, bar);
            __builtin_amdgcn_fence(__ATOMIC_ACQUIRE, "agent");
            asm volatile("s_waitcnt vmcnt(0)" ::: "memory");
        }
    }
    __syncthreads();
}

namespace pg8 {
constexpr int BM = 256, BK = 64, HALF = 128, HTB = HALF * BK * 2, STAGE_BYTES = 8 * HTB, NXCD = 8, WGM = 8;
__host__ __device__ __forceinline__ int lds_byte(int r, int c) { const int st = (r >> 4) * 2 + (c >> 5), rr = r & 15, cc = c & 31, ob = rr * 64 + cc * 2; return st * 1024 + (ob ^ (((ob >> 9) & 1) << 5)); }
__host__ __device__ __forceinline__ void stage_rc(int b, int& R, int& C) { const int st = b / 1024, sb = b % 1024, swz = sb ^ (((sb >> 9) & 1) << 5); R = (st >> 1) * 16 + swz / 64; C = (st & 1) * 32 + (swz % 64) / 2; }
__host__ __device__ __forceinline__ int perm32(int rho) { const int n = rho >> 4, i = rho & 15; return 8 * (i >> 2) + 4 * n + (i & 3); }

struct Unit { int pm, pn, e, slot; };

template <class Epi, class Prob, bool ALIGN_EPI, bool FP8>
__device__ __forceinline__ void gemm_phase(LAS unsigned char* lds, const Prob& P, const Epi& E) {
    const int tid = threadIdx.x, wid = __builtin_amdgcn_readfirstlane(tid >> 6), lane = tid & 63, wr = wid >> 2, wc = wid & 3, fr = lane & 15, fq = lane >> 4;
    const int rowb = P.rowb, nt = rowb / 128;
    int Rs[2], Cs[2]; unsigned voffB[2];
#pragma unroll
    for (int i = 0; i < 2; ++i) { int R, C; stage_rc(tid * 16 + i * 8192, R, C); const int Rb = Epi::PERM ? ((R & ~31) + perm32(R & 31)) : R;
        Rs[i] = R; Cs[i] = C * 2; voffB[i] = (unsigned)(Rb * rowb + C * 2); }
    const size_t kstep = (size_t)(BK * 2);
    const size_t bhalf = P.b_half;
    const unsigned ldsw = (unsigned)wid * 1024u;
    const int aoff = lds_byte(wr * 64 + fr, fq * 8), boff = lds_byte(wc * 32 + fr, fq * 8);
#define PG8_SA(b, h) (((b) * 2 + (h)) * HTB)
#define PG8_SB(b, h) ((4 + (b) * 2 + (h)) * HTB)
#define PG8_STAGE_B(bufoff, gbase) do { _Pragma("unroll") for (int _i = 0; _i < 2; ++_i) \
        __builtin_amdgcn_global_load_lds((const unsigned*)((const char*)(gbase) + voffB[_i]), (LAS unsigned*)(lds + (bufoff) + ldsw + _i * 8192), 16, 0, 0); } while (0)
#define PG8_STAGE_A(bufoff, kb, o0, o1) do { \
        __builtin_amdgcn_global_load_lds((const unsigned*)(P.A + (size_t)(o0) + (kb)), (LAS unsigned*)(lds + (bufoff) + ldsw), 16, 0, 0); \
        __builtin_amdgcn_global_load_lds((const unsigned*)(P.A + (size_t)(o1) + (kb)), (LAS unsigned*)(lds + (bufoff) + ldsw + 8192), 16, 0, 0); } while (0)
#define PG8_LDA(dst, b, h) do { _Pragma("unroll") for (int m = 0; m < 4; ++m) _Pragma("unroll") for (int k = 0; k < 2; ++k) dst[m][k] = *(const LAS bf16x8*)(lds + PG8_SA(b, h) + aoff + m * 2048 + k * 1024); } while (0)
#define PG8_LDB(dst, b, h) do { _Pragma("unroll") for (int n = 0; n < 2; ++n) _Pragma("unroll") for (int k = 0; k < 2; ++k) dst[n][k] = *(const LAS bf16x8*)(lds + PG8_SB(b, h) + boff + n * 2048 + k * 1024); } while (0)
#define PG8_MMA(ai, bj, At, Bt) do { __builtin_amdgcn_s_setprio(1); _Pragma("unroll") for (int m = 0; m < 4; ++m) _Pragma("unroll") for (int n = 0; n < 2; ++n) { \
        if constexpr (FP8) { const i32x8 fb_ = __builtin_shufflevector(__builtin_bit_cast(i32x4, Bt[n][0]), __builtin_bit_cast(i32x4, Bt[n][1]), 0, 1, 2, 3, 4, 5, 6, 7); \
            const i32x8 fa_ = __builtin_shufflevector(__builtin_bit_cast(i32x4, At[m][0]), __builtin_bit_cast(i32x4, At[m][1]), 0, 1, 2, 3, 4, 5, 6, 7); \
            acc[ai][bj][m][n] = __builtin_amdgcn_mfma_scale_f32_16x16x128_f8f6f4(fb_, fa_, acc[ai][bj][m][n], 0, 0, 0, 0, 0, 0); } \
        else { _Pragma("unroll") for (int k = 0; k < 2; ++k) acc[ai][bj][m][n] = __builtin_amdgcn_mfma_f32_16x16x32_bf16(Bt[n][k], At[m][k], acc[ai][bj][m][n], 0, 0, 0); } } \
        __builtin_amdgcn_s_setprio(0); } while (0)
#define PG8_WAIT_V(n) asm volatile("s_waitcnt vmcnt(" #n ")" ::: "memory")
#define PG8_WAIT_L(n) asm volatile("s_waitcnt lgkmcnt(" #n ")" ::: "memory")
#define PG8_BAR __builtin_amdgcn_s_barrier()
#define PG8_SCHED __builtin_amdgcn_sched_barrier(0)
    Unit cur, nxt; int ui = 0;
    if (!P.next(0, cur)) return;
    f32x4 acc[2][2][4][2];
    E.init(acc, cur, wr, wc, fr, fq);
    bf16x8 At[4][2], B0[2][2], B1[2][2];
    unsigned c00 = P.a_off(cur, Rs[0], Cs[0]), c01 = P.a_off(cur, Rs[1], Cs[1]), c10 = P.a_off(cur, HALF + Rs[0], Cs[0]), c11 = P.a_off(cur, HALF + Rs[1], Cs[1]);
    const char* cB = P.b_base(cur);
    PG8_STAGE_B(PG8_SB(0, 0), cB); PG8_STAGE_B(PG8_SB(0, 1), cB + bhalf); PG8_STAGE_A(PG8_SA(0, 0), 0, c00, c01); PG8_STAGE_A(PG8_SA(0, 1), 0, c10, c11);
    if (wr == 1) PG8_BAR;
    PG8_WAIT_V(2); PG8_BAR;
    PG8_STAGE_B(PG8_SB(1, 0), cB + kstep); PG8_STAGE_A(PG8_SA(1, 0), kstep, c00, c01); PG8_STAGE_B(PG8_SB(1, 1), cB + bhalf + kstep);
    PG8_WAIT_V(6); PG8_BAR;
    for (;;) {
        const bool has_next = P.next(ui + 1, nxt);
        const char* nB = has_next ? P.b_base(nxt) : cB;
        for (int t = 0; t < nt; t += 2) {
            const bool last = (t == nt - 2);
            const size_t k1 = (size_t)(t + 1) * kstep;
            const size_t k2 = last ? 0 : (size_t)(t + 2) * kstep, k3 = k2 + kstep;
            const char* b2 = last ? nB : cB + (size_t)(t + 2) * kstep; const char* b3 = b2 + kstep;
            if (last && has_next) { c00 = P.a_off(nxt, Rs[0], Cs[0]); c01 = P.a_off(nxt, Rs[1], Cs[1]); }
            PG8_LDB(B0, 0, 0); PG8_LDB(B1, 0, 1); PG8_SCHED; PG8_LDA(At, 0, 0); PG8_STAGE_A(PG8_SA(1, 1), k1, c10, c11);
            PG8_WAIT_V(8); PG8_WAIT_L(0); PG8_BAR; PG8_MMA(0, 0, At, B0); PG8_MMA(0, 1, At, B1); PG8_BAR; PG8_SCHED;
            if (last && has_next) { c10 = P.a_off(nxt, HALF + Rs[0], Cs[0]); c11 = P.a_off(nxt, HALF + Rs[1], Cs[1]); }
            PG8_LDA(At, 0, 1); PG8_STAGE_B(PG8_SB(0, 0), b2); PG8_STAGE_B(PG8_SB(0, 1), b2 + bhalf); PG8_STAGE_A(PG8_SA(0, 0), k2, c00, c01);
            PG8_WAIT_V(8); PG8_WAIT_L(0); PG8_BAR; PG8_MMA(1, 0, At, B0); PG8_MMA(1, 1, At, B1); PG8_BAR; PG8_SCHED;
            PG8_LDB(B0, 1, 0); PG8_LDB(B1, 1, 1); PG8_SCHED; PG8_LDA(At, 1, 0); PG8_STAGE_A(PG8_SA(0, 1), k2, c10, c11);
            PG8_WAIT_V(8); PG8_WAIT_L(0); PG8_BAR; PG8_MMA(0, 0, At, B0); PG8_MMA(0, 1, At, B1); PG8_BAR; PG8_SCHED;
            PG8_LDA(At, 1, 1); PG8_STAGE_B(PG8_SB(1, 0), b3); PG8_STAGE_B(PG8_SB(1, 1), b3 + bhalf); PG8_STAGE_A(PG8_SA(1, 0), k3, c00, c01);
            PG8_WAIT_V(8); PG8_WAIT_L(0); PG8_BAR; PG8_MMA(1, 0, At, B0); PG8_MMA(1, 1, At, B1); PG8_BAR; PG8_SCHED;
        }
        if constexpr (ALIGN_EPI) { if (wr == 0) PG8_BAR; }
        E(acc, cur, wr, wc, fr, fq);
#if defined(MK_DOUBLE)
        if constexpr (FP8) { if ((MK_DOUBLE >> 12) & 1) { asm volatile("" ::: "memory"); E(acc, cur, wr, wc, fr, fq); } }
#endif
        if (!has_next) break;
        cur = nxt; cB = nB; ++ui;
        E.init(acc, cur, wr, wc, fr, fq);
        if constexpr (ALIGN_EPI) { if (wr == 1) PG8_BAR; }
    }
    PG8_WAIT_V(0);
    if constexpr (!ALIGN_EPI) { if (wr == 0) PG8_BAR; }
    PG8_BAR;
#undef PG8_SA
#undef PG8_SB
#undef PG8_STAGE_A
#undef PG8_STAGE_B
#undef PG8_LDA
#undef PG8_LDB
#undef PG8_MMA
#undef PG8_WAIT_V
#undef PG8_WAIT_L
#undef PG8_BAR
#undef PG8_SCHED
}

__device__ __forceinline__ bool static_order(int nM, int nN, int G, int c, int i, int& pm, int& pn) {
    const int nwg = nM * nN; const long L = (long)i * G + c; if (L >= nwg) return false;
    int wgid = (int)L; { const int q = nwg / NXCD, r = nwg % NXCD, xcd = wgid % NXCD, off = wgid / NXCD; wgid = (xcd < r ? xcd * (q + 1) : r * (q + 1) + (xcd - r) * q) + off; }
    const int nig = WGM * nN, gid = wgid / nig, fm = gid * WGM, gsz = (nM - fm) < WGM ? (nM - fm) : WGM;
    pm = fm + ((wgid % nig) % gsz); pn = (wgid % nig) / gsz; return true;
}
struct DenseProb {
    const char* A; const char* Bt; int rowb, nM, nN, G, c; size_t b_half;
    __device__ __forceinline__ bool next(int i, Unit& u) const { u.e = 0; u.slot = i; return static_order(nM, nN, G, c, i, u.pm, u.pn); }
    __device__ __forceinline__ unsigned a_off(const Unit& u, int row, int colb) const { return (unsigned)((u.pm * BM + row) * rowb + colb); }
    __device__ __forceinline__ const char* b_base(const Unit& u) const { return Bt + (size_t)u.pn * BM * rowb; }
};
template <bool GATHER> struct MoeProb {
    const char* A; const char* Bt; int rowb, nN, G, c; size_t b_half; size_t b_expert; int b_tile_rows;
    const LAS int* tpre; const LAS int* tab; const LAS int* udesc;
    __device__ __forceinline__ int tp(int j) const { return __builtin_amdgcn_readfirstlane(tpre[j]); }
    __device__ __forceinline__ bool search(int i, Unit& u) const {
        const int total = tpre[NE] * nN; const long L0 = (long)i * G + c; if (L0 >= total) return false;
        int L = (int)L0; { const int q = total / NXCD, r = total % NXCD, xcd = L % NXCD, off = L / NXCD; L = (xcd < r ? xcd * (q + 1) : r * (q + 1) + (xcd - r) * q) + off; }
        int e = 0;
        for (int j = 1; j < NE; ++j) e += (tpre[j] * nN <= L) ? 1 : 0;
        const int first = tpre[e] * nN, tiles = tpre[e + 1] - tpre[e], rem = L - first;
        u.e = e; u.pm = rem % tiles; u.pn = rem / tiles; u.slot = i; return true;
    }
    __device__ __forceinline__ bool next(int i, Unit& u) const {
        if (i >= MAXU) return false;
        const int v = __builtin_amdgcn_readfirstlane(udesc[4 * i + 3]); if (!v) return false;
        u.e = __builtin_amdgcn_readfirstlane(udesc[4 * i]); u.pm = __builtin_amdgcn_readfirstlane(udesc[4 * i + 1]); u.pn = __builtin_amdgcn_readfirstlane(udesc[4 * i + 2]); u.slot = i; return true;
    }
    __device__ __forceinline__ unsigned a_off(const Unit& u, int row, int colb) const {
        if (GATHER) { const int idx = tab[u.slot * 256 + row]; const int tok = idx < 0 ? 0 : (idx >> 2); return (unsigned)(tok * rowb + colb); }
        return (unsigned)(((tp(u.e) + u.pm) * BM + row) * rowb + colb);
    }
    __device__ __forceinline__ const char* b_base(const Unit& u) const { return Bt + (size_t)u.e * b_expert + (size_t)u.pn * b_tile_rows * rowb; }
};
}

using pg8::Unit;
typedef f32x4 AccT[2][2][4][2];
__device__ __forceinline__ void acc_zero(AccT& acc) {
#pragma unroll
    for (int a = 0; a < 2; ++a)
#pragma unroll
        for (int b = 0; b < 2; ++b)
#pragma unroll
            for (int m = 0; m < 4; ++m)
#pragma unroll
                for (int n = 0; n < 2; ++n) acc[a][b][m][n] = (f32x4){0.f, 0.f, 0.f, 0.f};
}

struct EpiQKVU {
    static constexpr bool PERM = true;
    unsigned char* ws;
    __device__ __forceinline__ void init(AccT& acc, const Unit&, int, int, int, int) const { acc_zero(acc); }
    __device__ __forceinline__ void operator()(const AccT& acc, const Unit& u, int wr, int wc, int fr, int fq) const {
        static_assert(WS_K - WS_Q == WS_V - WS_K, "Q, K, V equally spaced");
        const int t = (u.pn - 1) / 3;
        const size_t boff = (u.pn == 0) ? WS_U : (WS_Q + (size_t)t * (WS_K - WS_Q));
        bf16_t* base = (bf16_t*)(ws + boff);
        const int ldc = (u.pn == 0) ? PW : AW, colt = (u.pn == 0) ? 0 : ((u.pn - 1) % 3) * 256;
        const float sc = (u.pn >= 1 && u.pn <= 3) ? QSCALE : 1.f;
        const int row0 = u.pm * 256 + wr * 64 + fr, col0 = colt + wc * 32 + 8 * fq;
#pragma unroll
        for (int ai = 0; ai < 2; ++ai)
#pragma unroll
            for (int m = 0; m < 4; ++m) { bf16_t* rowp = base + (size_t)(row0 + ai * 128 + m * 16) * ldc + col0;
#pragma unroll
                for (int bj = 0; bj < 2; ++bj) { const f32x4 v0 = acc[ai][bj][m][0] * sc, v1 = acc[ai][bj][m][1] * sc;
                    u32x4 w; w.x = cvt_pk_bf16(v0[0], v0[1]); w.y = cvt_pk_bf16(v0[2], v0[3]); w.z = cvt_pk_bf16(v1[0], v1[1]); w.w = cvt_pk_bf16(v1[2], v1[3]);
                    *(u32x4*)(rowp + bj * 128) = w; } }
    }
};
struct EpiResF32 {
    static constexpr bool PERM = false;
    const float* X; float* O;
    __device__ __forceinline__ void init(AccT& acc, const Unit& u, int wr, int wc, int fr, int fq) const {
        const int row0 = u.pm * 256 + wr * 64 + fr, col0 = u.pn * 256 + wc * 32 + 4 * fq;
#pragma unroll
        for (int ai = 0; ai < 2; ++ai)
#pragma unroll
            for (int m = 0; m < 4; ++m) { const size_t off = (size_t)(row0 + ai * 128 + m * 16) * D + col0;
#pragma unroll
                for (int bj = 0; bj < 2; ++bj)
#pragma unroll
                    for (int n = 0; n < 2; ++n) acc[ai][bj][m][n] = __builtin_nontemporal_load((const f32x4*)(X + off + bj * 128 + n * 16)); }
    }
    __device__ __forceinline__ void operator()(const AccT& acc, const Unit& u, int wr, int wc, int fr, int fq) const {
        const int row0 = u.pm * 256 + wr * 64 + fr, col0 = u.pn * 256 + wc * 32 + 4 * fq;
#pragma unroll
        for (int ai = 0; ai < 2; ++ai)
#pragma unroll
            for (int m = 0; m < 4; ++m) { const size_t off = (size_t)(row0 + ai * 128 + m * 16) * D + col0;
#pragma unroll
                for (int bj = 0; bj < 2; ++bj)
#pragma unroll
                    for (int n = 0; n < 2; ++n) *(f32x4*)(O + off + bj * 128 + n * 16) = acc[ai][bj][m][n]; }
    }
};
__device__ __forceinline__ float swiglu1(float g, float u) {
    g = fminf(g, 7.0f); u = fminf(fmaxf(u, -7.0f), 7.0f);
    const float s = __builtin_amdgcn_rcpf(1.0f + __builtin_amdgcn_exp2f(g * (-1.702f * LOG2E)));
    return (u + 1.0f) * (g * s);
}
__device__ __forceinline__ f32x4 swiglu4(f32x4 g, f32x4 u) {
    g = __builtin_elementwise_min(g, (f32x4){7.0f, 7.0f, 7.0f, 7.0f});
    u = __builtin_elementwise_min(__builtin_elementwise_max(u, (f32x4){-7.0f, -7.0f, -7.0f, -7.0f}), (f32x4){7.0f, 7.0f, 7.0f, 7.0f});
    const f32x4 t = g * (-1.702f * LOG2E);
    f32x4 e; e[0] = __builtin_amdgcn_exp2f(t[0]); e[1] = __builtin_amdgcn_exp2f(t[1]); e[2] = __builtin_amdgcn_exp2f(t[2]); e[3] = __builtin_amdgcn_exp2f(t[3]);
    const f32x4 d = e + 1.0f;
    f32x4 r; r[0] = __builtin_amdgcn_rcpf(d[0]); r[1] = __builtin_amdgcn_rcpf(d[1]); r[2] = __builtin_amdgcn_rcpf(d[2]); r[3] = __builtin_amdgcn_rcpf(d[3]);
    return (u * ASCALE + ASCALE) * (g * r);
}
__device__ __forceinline__ unsigned cvt4_fp8_nc(const f32x4& v) {
    int p = __builtin_amdgcn_cvt_pk_fp8_f32(v[0], v[1], 0, false); p = __builtin_amdgcn_cvt_pk_fp8_f32(v[2], v[3], p, true); return (unsigned)p; }
struct EpiGateUp {
    static constexpr bool PERM = true;
    __device__ __forceinline__ void init(AccT& acc, const Unit&, int, int, int, int) const { acc_zero(acc); }
    unsigned char* ACT; const LAS int* tpre; const LAS float* tabf; const LAS float* tabb;
    __device__ __forceinline__ void operator()(const AccT& acc, const Unit& u, int wr, int wc, int fr, int fq) const {
        const int cl = wc * 32 + 8 * fq, colA = u.pn * 128 + cl;
        const LAS float* bp = tabb + u.slot * 256 + cl;
        const f32x4 bg0 = *(const LAS f32x4*)(bp), bg1 = *(const LAS f32x4*)(bp + 4), bu0 = *(const LAS f32x4*)(bp + 128), bu1 = *(const LAS f32x4*)(bp + 132);
        const int srow0 = (__builtin_amdgcn_readfirstlane(tpre[u.e]) + u.pm) * 256;
#pragma unroll
        for (int ai = 0; ai < 2; ++ai)
#pragma unroll
            for (int m = 0; m < 4; ++m) { const int r = ai * 128 + wr * 64 + m * 16 + fr; const float rs = tabf[u.slot * 256 + r];
                const f32x4 g0 = acc[ai][0][m][0] * rs + bg0, g1 = acc[ai][0][m][1] * rs + bg1, u0 = acc[ai][1][m][0] * rs + bu0, u1 = acc[ai][1][m][1] * rs + bu1;
                u32x2 w; w.x = cvt4_fp8_nc(swiglu4(g0, u0)); w.y = cvt4_fp8_nc(swiglu4(g1, u1));
                *(u32x2*)(ACT + (size_t)(srow0 + r) * DFF + colA) = w; }
    }
};
struct EpiDown {
    static constexpr bool PERM = true;
    __device__ __forceinline__ void init(AccT& acc, const Unit&, int, int, int, int) const { acc_zero(acc); }
    unsigned char* Y; const LAS int* tab; const LAS float* tabf; const LAS float* tabb;
    __device__ __forceinline__ void operator()(const AccT& acc, const Unit& u, int wr, int wc, int fr, int fq) const {
        const int cl = wc * 32 + 8 * fq, col0 = u.pn * 256 + cl;
        const LAS float* bp = tabb + u.slot * 256 + cl;
        f32x4 bv[2][2];
#pragma unroll
        for (int bj = 0; bj < 2; ++bj) { bv[bj][0] = *(const LAS f32x4*)(bp + bj * 128); bv[bj][1] = *(const LAS f32x4*)(bp + bj * 128 + 4); }
#pragma unroll
        for (int ai = 0; ai < 2; ++ai)
#pragma unroll
            for (int m = 0; m < 4; ++m) { const int r = ai * 128 + wr * 64 + m * 16 + fr; const int idx = tab[u.slot * 256 + r];
                if (idx >= 0) { const float gv = tabf[u.slot * 256 + r] * YSCALE; unsigned char* rowp = Y + (size_t)idx * D + col0;
#pragma unroll
                    for (int bj = 0; bj < 2; ++bj) { const f32x4 v0 = (acc[ai][bj][m][0] * (1.0f / (ASCALE * WSCALE)) + bv[bj][0]) * gv, v1 = (acc[ai][bj][m][1] * (1.0f / (ASCALE * WSCALE)) + bv[bj][1]) * gv;
                        u32x2 w; w.x = cvt4_fp8(v0[0], v0[1], v0[2], v0[3]); w.y = cvt4_fp8(v1[0], v1[1], v1[2], v1[3]);
                        *(u32x2*)(rowp + bj * 128) = w; } } }
    }
};

__device__ __forceinline__ void tr_item(const float* __restrict__ W, int K, int N, bf16_t* __restrict__ WT, LAS float* scr, int kb, int nb, int lane) {
    const int k0 = kb * 64, n0 = nb * 64;
    const float* src = W + (size_t)(k0 + (lane >> 4)) * N + n0 + (lane & 15) * 4;
    f32x4 v[16];
#pragma unroll
    for (int i = 0; i < 16; ++i) v[i] = *(const f32x4*)(src + (size_t)(4 * i) * N);
#pragma unroll
    for (int i = 0; i < 16; ++i) { LAS float* d = scr + (4 * i + (lane >> 4)) * 65 + (lane & 15) * 4; d[0] = v[i][0]; d[1] = v[i][1]; d[2] = v[i][2]; d[3] = v[i][3]; }
    LDS_WAIT();
    const int c = lane & 7;
#pragma unroll
    for (int j = 0; j < 8; ++j) { const int n = 8 * j + (lane >> 3); const LAS float* s = scr + (8 * c) * 65 + n;
        u32x4 o; o.x = cvt_pk_bf16(s[0], s[65]); o.y = cvt_pk_bf16(s[130], s[195]); o.z = cvt_pk_bf16(s[260], s[325]); o.w = cvt_pk_bf16(s[390], s[455]);
        *(u32x4*)(WT + (size_t)(n0 + n) * K + k0 + 8 * c) = o; }
    LDS_WAIT();
}
struct Item8 { const float* src; unsigned char* dst; int N; };
__device__ __forceinline__ void chunk8_load(const Item8& d, int ch, f32x4 (&v)[16], int lane) {
    const float* base = d.src + (size_t)(32 * ch + 4 * (lane >> 5)) * d.N + (lane & 31) * 4;
#pragma unroll
    for (int sl = 0; sl < 4; ++sl)
#pragma unroll
        for (int j = 0; j < 4; ++j) v[4 * sl + j] = __builtin_nontemporal_load((const f32x4*)(base + (size_t)(8 * sl + j) * d.N));
}
__device__ __forceinline__ void chunk8_cvt(int ch, const f32x4 (&v)[16], LAS unsigned* scr, int lane) {
    const int nq = lane & 31, kq0 = lane >> 5, sw = (nq & 7) << 2;
#pragma unroll
    for (int sl = 0; sl < 4; ++sl) { const int kw = 8 * ch + kq0 + 2 * sl;
#pragma unroll
        for (int i = 0; i < 4; ++i) scr[(4 * nq + i) * 32 + (kw ^ sw)] = cvt4_fp8(v[4 * sl][i] * WSCALE, v[4 * sl + 1][i] * WSCALE, v[4 * sl + 2][i] * WSCALE, v[4 * sl + 3][i] * WSCALE); }
}
__device__ __forceinline__ void item8_flush(const Item8& d, const LAS unsigned* scr, int lane) {
    LDS_WAIT();
    const int c16 = lane & 7;
#pragma unroll
    for (int jj = 0; jj < 16; ++jj) { const int n = (lane >> 3) + 8 * jj;
        const u32x4 o = *(const LAS u32x4*)(scr + n * 32 + ((c16 ^ ((n >> 2) & 7)) << 2));
        __builtin_nontemporal_store(o, (u32x4*)(d.dst + (size_t)n * D + 16 * c16)); }
    LDS_WAIT();
}
__device__ __forceinline__ int t5_bucket(int dist) {
    if (dist < 16) return dist;
    const int large = 16 + (int)(logf((float)dist / 16.0f) / 4.852030263919617f * 16.0f);
    return large < 31 ? large : 31;
}
struct In { const float *x, *norm1_g, *w_in, *pool_w, *pool_scale, *rel_bias, *w_out, *norm2_g, *router_w, *router_b, *w_gate_up, *b_gate_up, *w_down, *b_down, *final_g; };

constexpr int N8_ALL = NE * 128 + NE * 64;
__device__ __forceinline__ void convert8_queue(LAS unsigned char* lds, const In& in, unsigned char* ws, unsigned* qword) {
    const int lane = threadIdx.x & 63, wave = __builtin_amdgcn_readfirstlane((int)threadIdx.x >> 6);
    constexpr int IG = 8 * 16, ID = 8 * 8;
    auto desc = [&](int r) -> Item8 { Item8 d;
        if (r < NE * IG) { const int e = r / IG, q = r % IG, kb = q / 16, nb = q % 16;
            d.src = in.w_gate_up + (size_t)e * D * 2 * DFF + (size_t)(kb * 128) * (2 * DFF) + nb * 128; d.N = 2 * DFF; d.dst = ws + WS_WGU + (size_t)e * 2 * DFF * D + (size_t)(nb * 128) * D + kb * 128; }
        else { const int r2 = r - NE * IG, e = r2 / ID, q = r2 % ID, kb = q / 8, nb = q % 8;
            d.src = in.w_down + (size_t)e * DFF * D + (size_t)(kb * 128) * D + nb * 128; d.N = D; d.dst = ws + WS_WD + (size_t)e * D * DFF + (size_t)(nb * 128) * DFF + kb * 128; }
        return d; };
    auto claim = [&]() -> int { unsigned v = 0; if (lane == 0) v = __hip_atomic_fetch_add(qword, 1u, __ATOMIC_RELAXED, __HIP_MEMORY_SCOPE_AGENT); return __builtin_amdgcn_readfirstlane((int)v); };
    LAS unsigned* scr8 = (LAS unsigned*)(lds + wave * 16384);
    f32x4 va[16], vb[16];
    int it = claim();
    if (it < N8_ALL) { const Item8 d0 = desc(it); chunk8_load(d0, 0, va, lane); }
    while (it < N8_ALL) {
        const Item8 d = desc(it);
        const int nx = claim();
        chunk8_load(d, 1, vb, lane); chunk8_cvt(0, va, scr8, lane);
        chunk8_load(d, 2, va, lane); chunk8_cvt(1, vb, scr8, lane);
        chunk8_load(d, 3, vb, lane); chunk8_cvt(2, va, scr8, lane);
        if (nx < N8_ALL) { const Item8 dn = desc(nx); chunk8_load(dn, 0, va, lane); }
        chunk8_cvt(3, vb, scr8, lane);
        item8_flush(d, scr8, lane);
        it = nx;
    }
}
__device__ __forceinline__ void p0_prologue(LAS unsigned char* lds, const In& in, unsigned char* ws, int G, int c) {
    const int tid = threadIdx.x, lane = tid & 63, wave = __builtin_amdgcn_readfirstlane(tid >> 6);
    const int gw = c * 8 + wave, NGW = G * 8;
    LAS float* scr = (LAS float*)(lds + wave * 16640);
    constexpr int I_IN = 16 * 40, I_OUT = 16 * 16, I_GU1 = 16 * 32, I_D1 = 16 * 16;
    for (int it = gw; it < I_IN; it += NGW) tr_item(in.w_in, D, NPROJ, (bf16_t*)(ws + WS_WIN), scr, it / 40, it % 40, lane);
#ifndef MK_DOUBLE
#define MK_DOUBLE 0
#endif
    for (int repr_ = 0; repr_ < (((MK_DOUBLE >> 11) & 1) ? 2 : 1); ++repr_) {
        f32x4 gv[4];
#pragma unroll
        for (int j = 0; j < 4; ++j) gv[j] = *(const f32x4*)(in.norm1_g + 4 * lane + 256 * j);
        bf16_t* H = (bf16_t*)(ws + WS_H);
        f32x4 v[4], vn[4];
        int m = gw;
        if (m < S) {
#pragma unroll
            for (int j = 0; j < 4; ++j) v[j] = __builtin_nontemporal_load((const f32x4*)(in.x + (size_t)m * D + 4 * lane + 256 * j)); }
        for (; m < S; m += NGW) {
            const int mn = m + NGW;
            if (mn < S) {
#pragma unroll
                for (int j = 0; j < 4; ++j) vn[j] = __builtin_nontemporal_load((const f32x4*)(in.x + (size_t)mn * D + 4 * lane + 256 * j)); }
            float s = 0.f;
#pragma unroll
            for (int j = 0; j < 4; ++j) s += (v[j][0] * v[j][0] + v[j][1] * v[j][1]) + (v[j][2] * v[j][2] + v[j][3] * v[j][3]);
            const float rstd = rsqrtf(wave_sum(s) * (1.0f / D) + RMS_EPS);
#pragma unroll
            for (int j = 0; j < 4; ++j) { const f32x4 o = v[j] * rstd * gv[j]; u32x2 w; w.x = cvt_pk_bf16(o[0], o[1]); w.y = cvt_pk_bf16(o[2], o[3]); *(u32x2*)(H + (size_t)m * D + 4 * lane + 256 * j) = w; }
#pragma unroll
            for (int j = 0; j < 4; ++j) v[j] = vn[j];
        }
    }
}
__device__ __forceinline__ void p0_side(LAS unsigned char* lds, const In& in, unsigned char* ws, int n0, int c0) {
    const int tid = threadIdx.x, lane = tid & 63, wave = __builtin_amdgcn_readfirstlane(tid >> 6);
    LAS float* scr = (LAS float*)(lds + wave * 16640);
    for (int it = c0 * 8 + wave; it < 16 * 16; it += n0 * 8) tr_item(in.w_out, D, D, (bf16_t*)(ws + WS_WOUT), scr, it / 16, it % 16, lane);
    const int gt = c0 * 512 + tid, NGT = n0 * 512;
    { float* GWT = (float*)(ws + WS_GWT); for (int i = gt; i < NE * D; i += NGT) { const int e = i >> 10, k = i & 1023; GWT[i] = in.norm2_g[k] * in.router_w[k * NE + e]; } }
    { float* BT = (float*)(ws + WS_BT); for (int i = gt; i < 36 * BT_N; i += NGT) { const int bh = i / BT_N, j = i % BT_N, b = bh / NH, h = bh % NH, dil = (b == 0) ? 1 : (b == 1 ? 4 : 16), d = j - BT_OFF;
        BT[i] = (d >= 0 && d <= 128) ? in.rel_bias[t5_bucket(d * dil) * NH + h] * LOG2E : NEGBIG; } }
    { bf16_t* PWT = (bf16_t*)(ws + WS_PWT); for (int i = gt; i < 4 * 64 * 64; i += NGT) { const int g = i >> 12, d = (i >> 6) & 63, cc = i & 63; PWT[i] = (bf16_t)(cvt_pk_bf16(in.pool_w[g * 4096 + cc * 64 + d], 0.f) & 0xffffu); } }
}

__device__ __forceinline__ s16x4 lds_tr16(const LAS unsigned char* p) { typedef short v4i16_t __attribute__((ext_vector_type(4))); return __builtin_bit_cast(s16x4, __builtin_amdgcn_ds_read_tr16_b64_v4i16((LAS v4i16_t*)p)); }
constexpr int ATT_UNITS = 3 * NH * 64, KV_PITCH = 144, KV_ROWS = 384, ATT_VOFF = KV_ROWS * KV_PITCH, ATT_TOFF = 2 * KV_ROWS * KV_PITCH, ATT_NEGOFF = ATT_TOFF + BT_N * 4;
__device__ __forceinline__ void attn_decode(int uid, int& b, int& h, int& r, int& j, int& dil) {
    const int bh = uid >> 6, x = uid & 63; b = bh / NH; h = bh % NH; dil = (b == 0) ? 1 : (b == 1 ? 4 : 16);
    const int nb = 64 / dil; r = x / nb; j = x % nb;
}
__device__ __forceinline__ void attn_phase(LAS unsigned char* lds, const bf16_t* __restrict__ Qg, const bf16_t* __restrict__ Kg, const bf16_t* __restrict__ Vg, const float* __restrict__ BT,
                                           bf16_t* __restrict__ OP, float* __restrict__ LSE, int G, int c) {
    const int tid = threadIdx.x, lane = tid & 63, w = __builtin_amdgcn_readfirstlane(tid >> 6), ql = lane & 15, g = lane >> 4;
    LAS unsigned char* Ks = lds; LAS unsigned char* Vs = lds + ATT_VOFF; LAS float* Tb = (LAS float*)(lds + ATT_TOFF); LAS float* Tneg = (LAS float*)(lds + ATT_NEGOFF);
    if (tid < 16) Tneg[tid] = NEGBIG;
    u32x4 kpre[6], vpre[6]; bf16x8 qa0, qa1, qb0, qb1; float tpre = 0.f;
#define ATT_PREFETCH(uid_) do { int b_, h_, r_, j_, dil_; attn_decode((uid_), b_, h_, r_, j_, dil_); \
        _Pragma("unroll") for (int cc = 0; cc < 6; ++cc) { const int id = tid + 512 * cc, row = id >> 3, ch = id & 7; int mm = 256 * j_ - 128 + row; if (mm < 0) mm += 128; \
            const size_t off = (size_t)(r_ + dil_ * mm) * AW + h_ * HD + ch * 8; kpre[cc] = *(const u32x4*)(Kg + off); vpre[cc] = *(const u32x4*)(Vg + off); } \
        { const size_t qo = (size_t)(r_ + dil_ * (256 * j_ + 32 * w + ql)) * AW + h_ * HD + 8 * g; const size_t qs = (size_t)16 * dil_ * AW; \
          qa0 = *(const bf16x8*)(Qg + qo); qa1 = *(const bf16x8*)(Qg + qo + 32); qb0 = *(const bf16x8*)(Qg + qo + qs); qb1 = *(const bf16x8*)(Qg + qo + qs + 32); } \
        if (tid < BT_N) tpre = BT[(b_ * NH + h_) * BT_N + tid]; } while (0)
#ifndef ATT_SYNC_LOAD
    if (c < ATT_UNITS) ATT_PREFETCH(c);
#endif
    for (int uid = c; uid < ATT_UNITS; uid += G) {
        int b, h, r, j, dil; attn_decode(uid, b, h, r, j, dil);
#ifdef ATT_SYNC_LOAD
        ATT_PREFETCH(uid);
#endif
#pragma unroll
        for (int cc = 0; cc < 6; ++cc) { const int id = tid + 512 * cc, row = id >> 3, ch = id & 7; *(LAS u32x4*)(Ks + row * KV_PITCH + ch * 16) = kpre[cc]; *(LAS u32x4*)(Vs + row * KV_PITCH + ch * 16) = vpre[cc]; }
        if (tid < BT_N) Tb[tid] = tpre;
        const bf16x8 fa0 = qa0, fa1 = qa1, fb0 = qb0, fb1 = qb1;
        __syncthreads();
#ifndef ATT_SYNC_LOAD
        if (uid + G < ATT_UNITS) ATT_PREFETCH(uid + G);
#endif
#if defined(MK_DOUBLE)
        for (int repc_ = 0; repc_ < (((MK_DOUBLE >> 13) & 1) ? 2 : 1); ++repc_) {
#else
        {
#endif
        const int kkmin = (j == 0) ? 128 : 0;
        const LAS unsigned char* kb = Ks + (32 * w + ql) * KV_PITCH + g * 16;
        const LAS float* Tq = Tb + (ql + 272 - 4 * g - 3);
        const f32x4 zero4 = (f32x4){0.f, 0.f, 0.f, 0.f};
        f32x4 sA[9], sB[9];
#pragma unroll
        for (int i = 0; i < 10; ++i) {
            const bf16x8 kf0 = *(const LAS bf16x8*)(kb + i * (16 * KV_PITCH)), kf1 = *(const LAS bf16x8*)(kb + i * (16 * KV_PITCH) + 64);
            const bool msk = (32 * w + 16 * i) < kkmin;
            if (i <= 8) { f32x4 st = __builtin_amdgcn_mfma_f32_16x16x32_bf16(kf0, fa0, zero4, 0, 0, 0); st = __builtin_amdgcn_mfma_f32_16x16x32_bf16(kf1, fa1, st, 0, 0, 0);
                const LAS float* tp = msk ? Tneg : (Tq - 16 * i); sA[i] = (f32x4){st[0] + tp[3], st[1] + tp[2], st[2] + tp[1], st[3] + tp[0]}; }
            if (i >= 1) { f32x4 st = __builtin_amdgcn_mfma_f32_16x16x32_bf16(kf0, fb0, zero4, 0, 0, 0); st = __builtin_amdgcn_mfma_f32_16x16x32_bf16(kf1, fb1, st, 0, 0, 0);
                const LAS float* tp = msk ? Tneg : (Tq - 16 * (i - 1)); sB[i - 1] = (f32x4){st[0] + tp[3], st[1] + tp[2], st[2] + tp[1], st[3] + tp[0]}; }
        }
        float mA = NEGBIG, mB = NEGBIG;
#pragma unroll
        for (int i = 0; i < 9; ++i) { mA = fmaxf(mA, fmaxf(fmaxf(sA[i][0], sA[i][1]), fmaxf(sA[i][2], sA[i][3]))); mB = fmaxf(mB, fmaxf(fmaxf(sB[i][0], sB[i][1]), fmaxf(sB[i][2], sB[i][3]))); }
        mA = fmaxf(mA, __shfl_xor(mA, 16)); mA = fmaxf(mA, __shfl_xor(mA, 32)); mB = fmaxf(mB, __shfl_xor(mB, 16)); mB = fmaxf(mB, __shfl_xor(mB, 32));
        f32x4 oA[4], oB[4];
#pragma unroll
        for (int dt = 0; dt < 4; ++dt) { oA[dt] = zero4; oB[dt] = zero4; }
        float lA = 0.f, lB = 0.f;
        const LAS unsigned char* vb = Vs + (32 * w + 4 * g + (ql >> 2)) * KV_PITCH + (ql & 3) * 8;
#pragma unroll
        for (int i = 0; i < 10; ++i) {
            const LAS unsigned char* vt = vb + i * (16 * KV_PITCH);
            const s16x4 v0 = lds_tr16(vt), v1 = lds_tr16(vt + 32), v2 = lds_tr16(vt + 64), v3 = lds_tr16(vt + 96);
            if (i <= 8) { const float p0 = __builtin_amdgcn_exp2f(sA[i][0] - mA), p1 = __builtin_amdgcn_exp2f(sA[i][1] - mA), p2 = __builtin_amdgcn_exp2f(sA[i][2] - mA), p3 = __builtin_amdgcn_exp2f(sA[i][3] - mA);
                lA += (p0 + p1) + (p2 + p3); u32x2 pw; pw.x = cvt_pk_bf16(p0, p1); pw.y = cvt_pk_bf16(p2, p3); const s16x4 pf = __builtin_bit_cast(s16x4, pw);
                oA[0] = __builtin_amdgcn_mfma_f32_16x16x16bf16_1k(v0, pf, oA[0], 0, 0, 0); oA[1] = __builtin_amdgcn_mfma_f32_16x16x16bf16_1k(v1, pf, oA[1], 0, 0, 0);
                oA[2] = __builtin_amdgcn_mfma_f32_16x16x16bf16_1k(v2, pf, oA[2], 0, 0, 0); oA[3] = __builtin_amdgcn_mfma_f32_16x16x16bf16_1k(v3, pf, oA[3], 0, 0, 0); }
            if (i >= 1) { const float p0 = __builtin_amdgcn_exp2f(sB[i - 1][0] - mB), p1 = __builtin_amdgcn_exp2f(sB[i - 1][1] - mB), p2 = __builtin_amdgcn_exp2f(sB[i - 1][2] - mB), p3 = __builtin_amdgcn_exp2f(sB[i - 1][3] - mB);
                lB += (p0 + p1) + (p2 + p3); u32x2 pw; pw.x = cvt_pk_bf16(p0, p1); pw.y = cvt_pk_bf16(p2, p3); const s16x4 pf = __builtin_bit_cast(s16x4, pw);
                oB[0] = __builtin_amdgcn_mfma_f32_16x16x16bf16_1k(v0, pf, oB[0], 0, 0, 0); oB[1] = __builtin_amdgcn_mfma_f32_16x16x16bf16_1k(v1, pf, oB[1], 0, 0, 0);
                oB[2] = __builtin_amdgcn_mfma_f32_16x16x16bf16_1k(v2, pf, oB[2], 0, 0, 0); oB[3] = __builtin_amdgcn_mfma_f32_16x16x16bf16_1k(v3, pf, oB[3], 0, 0, 0); }
        }
        lA += __shfl_xor(lA, 16); lA += __shfl_xor(lA, 32); lB += __shfl_xor(lB, 16); lB += __shfl_xor(lB, 32);
#ifdef ATT_EXP1
        lA = 1.0f; lB = 1.0f; mA = 0.f; mB = 0.f;
#pragma unroll
        for (int dt = 0; dt < 4; ++dt) { oA[dt] = zero4; oB[dt] = zero4; }
#endif
#ifdef ATT_EXP2
        lA = 1.0f; lB = 1.0f;
#pragma unroll
        for (int dt = 0; dt < 4; ++dt) { oA[dt] = zero4; oB[dt] = zero4; }
#endif
        const float iA = 1.0f / lA, iB = 1.0f / lB;
        const int posA = r + dil * (256 * j + 32 * w + ql), posB = posA + 16 * dil;
        bf16_t* dA = OP + ((size_t)b * S + posA) * AW + h * HD + 4 * g; bf16_t* dB = OP + ((size_t)b * S + posB) * AW + h * HD + 4 * g;
#pragma unroll
        for (int dt = 0; dt < 4; ++dt) { u32x2 t; t.x = cvt_pk_bf16(oA[dt][0] * iA, oA[dt][1] * iA); t.y = cvt_pk_bf16(oA[dt][2] * iA, oA[dt][3] * iA); *(u32x2*)(dA + 16 * dt) = t;
            u32x2 t2; t2.x = cvt_pk_bf16(oB[dt][0] * iB, oB[dt][1] * iB); t2.y = cvt_pk_bf16(oB[dt][2] * iB, oB[dt][3] * iB); *(u32x2*)(dB + 16 * dt) = t2; }
        if (g == 0) { LSE[((size_t)b * S + posA) * NH + h] = mA + __builtin_amdgcn_logf(lA); LSE[((size_t)b * S + posB) * NH + h] = mB + __builtin_amdgcn_logf(lB); }
        asm volatile("" ::: "memory");
        }
        __syncthreads();
    }
#undef ATT_PREFETCH
}

__device__ __forceinline__ void pool_phase(LAS unsigned char* lds, const bf16_t* __restrict__ U, const bf16_t* __restrict__ PWT, const float* __restrict__ pool_scale, bf16_t* __restrict__ MIX, int G, int c) {
    const int tid = threadIdx.x, lane = tid & 63, w = __builtin_amdgcn_readfirstlane(tid >> 6), ql = lane & 15, g = lane >> 4;
    LAS unsigned char* Us = lds; LAS unsigned char* Pl = lds + 40960;
    for (int pu = c; pu < S / 64; pu += G) {
        const int t0 = pu * 64;
        { u32x4 uv[5];
#pragma unroll
          for (int q = 0; q < 5; ++q) { const int id = tid + 512 * q, row = id >> 5, ch = id & 31, t = t0 - 15 + row; uv[q] = (u32x4){0u, 0u, 0u, 0u};
              if (id < 79 * 32 && t >= 0) uv[q] = *(const u32x4*)(U + (size_t)t * PW + ch * 8); }
#pragma unroll
          for (int q = 0; q < 5; ++q) { const int id = tid + 512 * q, row = id >> 5, ch = id & 31; if (id < 79 * 32) *(LAS u32x4*)(Us + row * 512 + ch * 16) = uv[q]; } }
        __syncthreads();
        { const int cch = tid & 255, th = tid >> 8, gg = cch >> 6, wn = 2 << gg, tl0 = 32 * th;
          const LAS bf16_t* up = (const LAS bf16_t*)Us + cch;
#define UAT(row) __uint_as_float(((unsigned)up[(row) * 256]) << 16)
          float sum = 0.f;
          for (int i = 0; i < wn; ++i) sum += UAT(tl0 + 15 - i);
          const float rcw = 1.0f / (float)wn;
#pragma unroll 8
          for (int tl = tl0; tl < tl0 + 32; ++tl) {
              const float cur = UAT(tl + 15);
              if (tl > tl0) sum += cur - UAT(tl + 15 - wn);
              const int t = t0 + tl; const float rc = (t + 1 < wn) ? __builtin_amdgcn_rcpf((float)(t + 1)) : rcw;
              const float val = sum * rc - cur;
              ((LAS bf16_t*)(Pl + tl * 528))[cch] = (bf16_t)(cvt_pk_bf16(val, 0.f) & 0xffffu);
          }
#undef UAT
        }
        __syncthreads();
        { const int tt = w & 3, gp = w >> 2;
#pragma unroll
          for (int gi = 0; gi < 2; ++gi) { const int gg = 2 * gp + gi;
              const bf16x8 b0 = *(const LAS bf16x8*)(Pl + (16 * tt + ql) * 528 + (gg * 64 + 8 * g) * 2), b1 = *(const LAS bf16x8*)(Pl + (16 * tt + ql) * 528 + (gg * 64 + 32 + 8 * g) * 2);
#pragma unroll
              for (int nt = 0; nt < 4; ++nt) {
                  const bf16_t* ap = PWT + ((size_t)(gg * 64 + 16 * nt + ql) * 64 + 8 * g);
                  const bf16x8 a0 = *(const bf16x8*)(ap), a1 = *(const bf16x8*)(ap + 32);
                  f32x4 acc = __builtin_amdgcn_mfma_f32_16x16x32_bf16(a0, b0, (f32x4){0.f, 0.f, 0.f, 0.f}, 0, 0, 0);
                  acc = __builtin_amdgcn_mfma_f32_16x16x32_bf16(a1, b1, acc, 0, 0, 0);
                  const f32x4 ps = *(const f32x4*)(pool_scale + gg * 64 + 16 * nt + 4 * g);
                  u32x2 o; o.x = cvt_pk_bf16(acc[0] * ps[0], acc[1] * ps[1]); o.y = cvt_pk_bf16(acc[2] * ps[2], acc[3] * ps[3]);
                  *(u32x2*)(MIX + (size_t)(t0 + 16 * tt + ql) * D + gg * 64 + 16 * nt + 4 * g) = o;
              } }
        }
        __syncthreads();
    }
}

__device__ __forceinline__ void combine_phase(const bf16_t* __restrict__ OP, const float* __restrict__ LSE, bf16_t* __restrict__ MIX, int G, int c) {
    const int gt = c * 512 + threadIdx.x, NGT = G * 512;
    for (int id = gt; id < S * 96; id += NGT) {
        const int t = id / 96, rem = id % 96, h = rem >> 3, c8 = rem & 7;
        const float l0 = LSE[(size_t)t * NH + h], l1 = LSE[((size_t)S + t) * NH + h], l2 = LSE[((size_t)2 * S + t) * NH + h];
        const float mx = fmaxf(l0, fmaxf(l1, l2));
        float w0 = __builtin_amdgcn_exp2f(l0 - mx), w1 = __builtin_amdgcn_exp2f(l1 - mx), w2 = __builtin_amdgcn_exp2f(l2 - mx);
        const float inv = 1.0f / (w0 + w1 + w2); w0 *= inv; w1 *= inv; w2 *= inv;
        const size_t off = (size_t)t * AW + h * HD + c8 * 8;
        const u32x4 a = __builtin_nontemporal_load((const u32x4*)(OP + off)), b = __builtin_nontemporal_load((const u32x4*)(OP + (size_t)S * AW + off)), cc = __builtin_nontemporal_load((const u32x4*)(OP + (size_t)2 * S * AW + off));
        u32x4 o;
#pragma unroll
        for (int k = 0; k < 4; ++k) { const float lo = w0 * bf_lo(a[k]) + w1 * bf_lo(b[k]) + w2 * bf_lo(cc[k]), hi = w0 * bf_hi(a[k]) + w1 * bf_hi(b[k]) + w2 * bf_hi(cc[k]); o[k] = cvt_pk_bf16(lo, hi); }
        *(u32x4*)(MIX + (size_t)t * D + PW + h * HD + c8 * 8) = o;
    }
}

constexpr int GW_PITCH = 1028;
constexpr int RT_G2 = 131584, RT_LG = RT_G2 + 4096, RT_RS = RT_LG + 4 * 16 * 33 * 4, RT_CNT = RT_RS + 256, RT_PART = RT_CNT + 256, RT_END = RT_PART + 4 * 64 * 9 * 4;
static_assert(RT_END <= LDS_CTL, "router LDS map");
__device__ __forceinline__ void router_phase(LAS unsigned char* lds, const float* __restrict__ X1, const float* __restrict__ g2, const float* __restrict__ GWT, const float* __restrict__ rb,
                                             unsigned char* __restrict__ H, float* __restrict__ RSTD, float* __restrict__ GATES, int* __restrict__ ROWS, unsigned* __restrict__ COUNTS, int G, int c) {
    const int tid = threadIdx.x, lane = tid & 63, w = __builtin_amdgcn_readfirstlane(tid >> 6), ql = lane & 15, g = lane >> 4;
    const int ts = w & 3, kh = w >> 2;
    LAS float* GW = (LAS float*)lds;
    LAS float* G2 = (LAS float*)(lds + RT_G2);
    LAS float* LG = (LAS float*)(lds + RT_LG) + ts * (16 * 33);
    LAS float* RS = (LAS float*)(lds + RT_RS) + ts * 16;
    LAS int* LCNT = (LAS int*)(lds + RT_CNT);
    LAS int* LBASE = LCNT + 32;
    LAS float* PART = (LAS float*)(lds + RT_PART) + ts * (64 * 9);
    { f32x4 gx[16];
#pragma unroll
      for (int q = 0; q < 16; ++q) { const int id = tid + 512 * q, e = id >> 8, k4 = id & 255; gx[q] = *(const f32x4*)(GWT + e * D + k4 * 4); }
#pragma unroll
      for (int q = 0; q < 16; ++q) { const int id = tid + 512 * q, e = id >> 8, k4 = id & 255; *(LAS f32x4*)(GW + e * GW_PITCH + k4 * 4) = gx[q]; } }
    if (tid < 256) *(LAS f32x4*)(G2 + tid * 4) = *(const f32x4*)(g2 + tid * 4);
    const int nrounds = (S / 16 + 4 * G - 1) / (4 * G);
    for (int rd = 0; rd < nrounds; ++rd) {
        if (tid < 32) LCNT[tid] = 0;
        __syncthreads();
        const int tile = (rd * 4 + ts) * G + c;
        int ek[4] = {0, 0, 0, 0}, lp[4] = {0, 0, 0, 0}; float gk[4] = {0.f, 0.f, 0.f, 0.f};
        const bool active = tile < S / 16;
        f32x4 acc0 = (f32x4){0.f, 0.f, 0.f, 0.f}, acc1 = acc0; float ss = 0.f;
        const int tok = (active ? tile : 0) * 16 + ql;
        if (active) {
            const float* xr = X1 + (size_t)tok * D + kh * 512 + 8 * g;
            unsigned char* hr = H + (size_t)tok * D + kh * 512 + 8 * g;
            const LAS float* w0p = GW + ql * GW_PITCH + kh * 512 + 8 * g; const LAS float* w1p = GW + (16 + ql) * GW_PITCH + kh * 512 + 8 * g;
            const LAS float* gp = G2 + kh * 512 + 8 * g;
#pragma unroll 1
            for (int kb = 0; kb < 512; kb += 256) {
                f32x4 av[16];
#pragma unroll
                for (int i = 0; i < 8; ++i) { av[2 * i] = __builtin_nontemporal_load((const f32x4*)(xr + kb + 32 * i)); av[2 * i + 1] = __builtin_nontemporal_load((const f32x4*)(xr + kb + 32 * i + 4)); }
#pragma unroll
                for (int i = 0; i < 8; ++i) {
                    const int k0 = kb + 32 * i; const f32x4 a0 = av[2 * i], a1 = av[2 * i + 1];
                    const f32x4 n0 = *(const LAS f32x4*)(gp + k0), n1 = *(const LAS f32x4*)(gp + k0 + 4);
                    const f32x4 b00 = *(const LAS f32x4*)(w0p + k0), b01 = *(const LAS f32x4*)(w0p + k0 + 4), b10 = *(const LAS f32x4*)(w1p + k0), b11 = *(const LAS f32x4*)(w1p + k0 + 4);
                    ss += (a0[0] * a0[0] + a0[1] * a0[1]) + (a0[2] * a0[2] + a0[3] * a0[3]) + (a1[0] * a1[0] + a1[1] * a1[1]) + (a1[2] * a1[2] + a1[3] * a1[3]);
                    u32x2 hv; hv.x = cvt4_fp8(a0[0] * n0[0] * HSCALE, a0[1] * n0[1] * HSCALE, a0[2] * n0[2] * HSCALE, a0[3] * n0[3] * HSCALE);
                    hv.y = cvt4_fp8(a1[0] * n1[0] * HSCALE, a1[1] * n1[1] * HSCALE, a1[2] * n1[2] * HSCALE, a1[3] * n1[3] * HSCALE);
                    *(u32x2*)(hr + k0) = hv;
#pragma unroll
                    for (int jj = 0; jj < 4; ++jj) { acc0 = __builtin_amdgcn_mfma_f32_16x16x4f32(a0[jj], b00[jj], acc0, 0, 0, 0); acc1 = __builtin_amdgcn_mfma_f32_16x16x4f32(a0[jj], b10[jj], acc1, 0, 0, 0); }
#pragma unroll
                    for (int jj = 0; jj < 4; ++jj) { acc0 = __builtin_amdgcn_mfma_f32_16x16x4f32(a1[jj], b01[jj], acc0, 0, 0, 0); acc1 = __builtin_amdgcn_mfma_f32_16x16x4f32(a1[jj], b11[jj], acc1, 0, 0, 0); }
                }
            }
            if (kh == 1) { LAS float* pp = PART + lane * 9;
#pragma unroll
                for (int i = 0; i < 4; ++i) { pp[i] = acc0[i]; pp[4 + i] = acc1[i]; } pp[8] = ss; }
        }
        __syncthreads();
        if (active && kh == 0) {
            { const LAS float* pp = PART + lane * 9;
#pragma unroll
              for (int i = 0; i < 4; ++i) { acc0[i] += pp[i]; acc1[i] += pp[4 + i]; } ss += pp[8]; }
            ss += __shfl_xor(ss, 16); ss += __shfl_xor(ss, 32);
            const float rstd = rsqrtf(ss * (1.0f / D) + RMS_EPS);
            if (g == 0) { RSTD[tok] = rstd; RS[ql] = rstd; }
            LDS_WAIT();
            const float rb0 = rb[ql], rb1 = rb[16 + ql];
#pragma unroll
            for (int rg = 0; rg < 4; ++rg) { const float rr = RS[4 * g + rg]; LG[(4 * g + rg) * 33 + ql] = acc0[rg] * rr + rb0; LG[(4 * g + rg) * 33 + 16 + ql] = acc1[rg] * rr + rb1; }
            LDS_WAIT();
            if (lane < 16) {
                float v[32];
#pragma unroll
                for (int e = 0; e < 32; ++e) v[e] = LG[ql * 33 + e];
                float tv[4];
#pragma unroll
                for (int r = 0; r < 4; ++r) { float best = v[0]; int bi = 0;
#pragma unroll
                    for (int e = 1; e < 32; ++e) { const bool gt = v[e] > best; best = gt ? v[e] : best; bi = gt ? e : bi; }
                    tv[r] = best; ek[r] = bi;
#pragma unroll
                    for (int e = 0; e < 32; ++e) v[e] = (e == bi) ? -INFINITY : v[e]; }
                const float e1 = __expf(tv[1] - tv[0]), e2 = __expf(tv[2] - tv[0]), e3 = __expf(tv[3] - tv[0]); const float inv = 1.0f / (1.0f + e1 + e2 + e3);
                gk[0] = inv; gk[1] = e1 * inv; gk[2] = e2 * inv; gk[3] = e3 * inv;
#pragma unroll
                for (int r = 0; r < 4; ++r) lp[r] = __hip_atomic_fetch_add(LCNT + ek[r], 1, __ATOMIC_RELAXED, __HIP_MEMORY_SCOPE_WORKGROUP);
            }
        }
        __syncthreads();
        if (tid < 32) { const int n = LCNT[tid]; int base = 0; if (n > 0) base = (int)__hip_atomic_fetch_add(COUNTS + tid, (unsigned)n, __ATOMIC_RELAXED, __HIP_MEMORY_SCOPE_AGENT); LBASE[tid] = base; }
        __syncthreads();
        if (active && kh == 0 && lane < 16) {
#pragma unroll
            for (int r = 0; r < 4; ++r) { const int pos = LBASE[ek[r]] + lp[r]; ROWS[(size_t)ek[r] * S + pos] = tok * 4 + r; GATES[tok * 4 + r] = gk[r]; }
#ifdef RT_HASH
            RSTD[S + tok] = gk[0] * (ek[0] + 1) + gk[1] * (ek[1] + 1) + gk[2] * (ek[2] + 1) + gk[3] * (ek[3] + 1);
#endif
        }
        __syncthreads();
    }
}

__device__ __forceinline__ void moe_prefix(LAS int* tpre, LAS int* lcnt, const unsigned* __restrict__ COUNTS) {
    if (threadIdx.x < 32) lcnt[threadIdx.x] = (int)COUNTS[threadIdx.x];
    __syncthreads();
    if (threadIdx.x == 0) { int acc = 0; for (int e = 0; e < NE; ++e) { tpre[e] = acc; acc += (lcnt[e] + 255) >> 8; } tpre[NE] = acc; }
    __syncthreads();
}
template <bool GU, class Prob> __device__ __forceinline__ void moe_table(const Prob& P, LAS int* udesc, LAS int* tab, LAS float* tabf, LAS float* tabb, const LAS int* lcnt, const int* __restrict__ ROWS,
                                                                         const float* __restrict__ rowf, const float* __restrict__ bias) {
    if (threadIdx.x < MAXU) { Unit u0; u0.e = 0; u0.pm = 0; u0.pn = 0; u0.slot = 0; const bool ok = P.search((int)threadIdx.x, u0);
        udesc[4 * threadIdx.x] = u0.e; udesc[4 * threadIdx.x + 1] = u0.pm; udesc[4 * threadIdx.x + 2] = u0.pn; udesc[4 * threadIdx.x + 3] = ok ? 1 : 0; }
    __syncthreads();
    constexpr int NQ = (MAXU * 256 + 511) / 512;
    int idx[NQ]; float fv[NQ], bvv[NQ];
#pragma unroll
    for (int q = 0; q < NQ; ++q) { const int j = (int)threadIdx.x + 512 * q, i = j >> 8, r = j & 255; idx[q] = -2;
        if (i < MAXU && udesc[4 * i + 3]) { const int e = udesc[4 * i], rr = udesc[4 * i + 1] * 256 + r; idx[q] = (rr < lcnt[e]) ? ROWS[(size_t)e * S + rr] : -1; } }
#pragma unroll
    for (int q = 0; q < NQ; ++q) { const int j = (int)threadIdx.x + 512 * q, i = j >> 8, c2 = j & 255; fv[q] = 0.f; bvv[q] = 0.f;
        if (idx[q] != -2) { const int e = udesc[4 * i], pn = udesc[4 * i + 2];
            fv[q] = GU ? rowf[idx[q] < 0 ? 0 : (idx[q] >> 2)] * (1.0f / (HSCALE * WSCALE)) : (idx[q] < 0 ? 0.f : rowf[idx[q]]);
            bvv[q] = GU ? bias[(size_t)e * 2 * DFF + (c2 >> 7) * DFF + pn * 128 + (c2 & 127)] : bias[(size_t)e * D + pn * 256 + c2]; } }
#pragma unroll
    for (int q = 0; q < NQ; ++q) { const int j = (int)threadIdx.x + 512 * q; if (idx[q] != -2) { tab[j] = idx[q]; tabf[j] = fv[q]; tabb[j] = bvv[q]; } }
    __syncthreads();
}

__device__ __forceinline__ void final_phase(const float* __restrict__ X1, const unsigned char* __restrict__ Y, const float* __restrict__ fg, float* __restrict__ out, int G, int c) {
    const int tid = threadIdx.x, lane = tid & 63, wave = tid >> 6; const int gw = c * 8 + wave, NGW = G * 8;
    f32x4 gv[4];
#pragma unroll
    for (int j = 0; j < 4; ++j) gv[j] = *(const f32x4*)(fg + 4 * lane + 256 * j);
    for (int m = gw; m < S; m += NGW) {
        const float* xr = X1 + (size_t)m * D + 4 * lane;
        f32x4 v[4];
#pragma unroll
        for (int j = 0; j < 4; ++j) v[j] = __builtin_nontemporal_load((const f32x4*)(xr + 256 * j));

#ifdef RT_HASH
        { const float extra = ((const float*)Y)[m];
#pragma unroll
          for (int j = 0; j < 4; ++j) { v[j][0] += __sinf(extra * (float)(4 * lane + 256 * j + 1)); v[j][1] += __sinf(extra * (float)(4 * lane + 256 * j + 2)); v[j][2] += __sinf(extra * (float)(4 * lane + 256 * j + 3)); v[j][3] += __sinf(extra * (float)(4 * lane + 256 * j + 4)); } }
#endif
#ifdef FIN_HASH
#pragma unroll
        for (int j = 0; j < 4; ++j) { v[j][0] = __sinf(v[j][0] * 1.0e6f); v[j][1] = __sinf(v[j][1] * 1.0e6f); v[j][2] = __sinf(v[j][2] * 1.0e6f); v[j][3] = __sinf(v[j][3] * 1.0e6f); }
#endif
#pragma unroll
#if defined(FIN_HASH) || defined(RT_HASH)
        for (int k = 0; k < 0; ++k) { const unsigned char* yr = Y + ((size_t)m * 4 + k) * D + 4 * lane;
#else
        for (int k = 0; k < 4; ++k) { const unsigned char* yr = Y + ((size_t)m * 4 + k) * D + 4 * lane;
#endif
#pragma unroll
            for (int j = 0; j < 4; ++j) { const int t = __builtin_nontemporal_load((const int*)(yr + 256 * j)); const f32x2 lo = __builtin_amdgcn_cvt_pk_f32_fp8(t, false), hi = __builtin_amdgcn_cvt_pk_f32_fp8(t, true);
                v[j][0] += lo[0] * (1.0f / YSCALE); v[j][1] += lo[1] * (1.0f / YSCALE); v[j][2] += hi[0] * (1.0f / YSCALE); v[j][3] += hi[1] * (1.0f / YSCALE); } }
#ifdef FIN_HASH2
#pragma unroll
        for (int j = 0; j < 4; ++j) { v[j][0] = __sinf(v[j][0] * 3.0e3f); v[j][1] = __sinf(v[j][1] * 3.0e3f); v[j][2] = __sinf(v[j][2] * 3.0e3f); v[j][3] = __sinf(v[j][3] * 3.0e3f); }
#endif
        float s = 0.f;
#pragma unroll
        for (int j = 0; j < 4; ++j) s += (v[j][0] * v[j][0] + v[j][1] * v[j][1]) + (v[j][2] * v[j][2] + v[j][3] * v[j][3]);
        const float rstd = rsqrtf(wave_sum(s) * (1.0f / D) + RMS_EPS);
#pragma unroll
        for (int j = 0; j < 4; ++j) __builtin_nontemporal_store(v[j] * rstd * gv[j], (f32x4*)(out + (size_t)m * D + 4 * lane + 256 * j));
    }
}

constexpr int NPHASE = 9;
struct Args { In in; float* out; unsigned char* ws; int ph_lo, ph_hi; };
__global__ void __launch_bounds__(512, 2) fwd(Args args) {
    extern __shared__ __attribute__((aligned(16))) unsigned char lds_raw[];
    LAS unsigned char* lds = (LAS unsigned char*)lds_raw;
    const int tid = threadIdx.x, G = gridDim.x, c = blockIdx.x;
    unsigned char* ws = args.ws; const In& in = args.in;
    unsigned* ctl = (unsigned*)(ws + WS_CTL);
    LAS int* LCTL = (LAS int*)(lds + LDS_CTL);
    if (tid < 256) LCTL[tid] = 0;
    __syncthreads();
    const int lo = args.ph_lo, hi = args.ph_hi;
    const bool one_launch = (hi - lo) > 1;
    XcdBarrier bar; bar.bar = ctl + CW_BAR; bar.x = 0; bar.st = nullptr;
    if (one_launch) bar = xcd_barrier_post(ctl + CW_BAR, (volatile LAS unsigned*)LCTL);
#define IN(k) (lo <= (k) && (k) < hi)
#ifndef MK_DOUBLE
#define MK_DOUBLE 0
#endif
#define REP(k) for (int rep_ = 0; rep_ < ((((MK_DOUBLE) >> (k)) & 1) ? 2 : 1); ++rep_)
#define SEAM(k) do { if (IN((k) + 1)) xcd_barrier(bar); } while (0)
    bf16_t* Hb = (bf16_t*)(ws + WS_H); bf16_t* Ub = (bf16_t*)(ws + WS_U); bf16_t* Qb = (bf16_t*)(ws + WS_Q); bf16_t* Kb = (bf16_t*)(ws + WS_K); bf16_t* Vb = (bf16_t*)(ws + WS_V);
    bf16_t* OPb = (bf16_t*)(ws + WS_OP); bf16_t* MIXb = (bf16_t*)(ws + WS_MIX); float* X1 = (float*)(ws + WS_X1); unsigned char* ACTb = ws + WS_ACT; unsigned char* Yb = ws + WS_Y; unsigned char* H8 = ws + WS_H8;
    float* LSE = (float*)(ws + WS_LSE); float* RSTD = (float*)(ws + WS_RSTD); float* GATES = (float*)(ws + WS_GATES); int* ROWS = (int*)(ws + WS_ROWS); unsigned* COUNTS = ctl + CW_COUNTS;
    LAS int* TPRE = LCTL + 16; LAS int* LCNT = LCTL + 128; LAS int* UDESC = LCTL + 192; LAS int* TAB = (LAS int*)(lds + LDS_TAB); LAS float* TABF = (LAS float*)(lds + LDS_TAB + MAXU * 1024); LAS float* TABB = (LAS float*)(lds + LDS_TAB + 2 * MAXU * 1024);
    static_assert(LDS_TAB + 3 * MAXU * 1024 <= LDS_CTL, "MoE LDS tables");

    if (IN(0)) { REP(0) p0_prologue(lds, in, ws, G, c); SEAM(0); }
    if (IN(1)) {
        const int NG = (G >= 256) ? 128 : G;
        if (c < NG) {
            pg8::DenseProb P{(const char*)Hb, (const char*)(ws + WS_WIN), D * 2, S / 256, NPROJ / 256, NG, c, (size_t)128 * D * 2};
            EpiQKVU E{ws};
            REP(1) pg8::gemm_phase<EpiQKVU, pg8::DenseProb, true, false>(lds, P, E);
        }
        else p0_side(lds, in, ws, G - NG, c - NG);
        if (NG == G) p0_side(lds, in, ws, G, c);
        convert8_queue(lds, in, ws, ctl + CW_QUEUE);
        SEAM(1);
    }
    if (IN(2)) {
        REP(2) attn_phase(lds, Qb, Kb, Vb, (const float*)(ws + WS_BT), OPb, LSE, G, c);
        REP(9) pool_phase(lds, Ub, (const bf16_t*)(ws + WS_PWT), in.pool_scale, MIXb, G, c);
        SEAM(2);
    }
    if (IN(3)) { REP(3) combine_phase(OPb, LSE, MIXb, G, c); SEAM(3); }
    if (IN(4)) {
        pg8::DenseProb P{(const char*)MIXb, (const char*)(ws + WS_WOUT), D * 2, S / 256, D / 256, G, c, (size_t)128 * D * 2};
        EpiResF32 E{in.x, X1};
        REP(4) pg8::gemm_phase<EpiResF32, pg8::DenseProb, true, false>(lds, P, E);
        SEAM(4);
    }
    if (IN(5)) { router_phase(lds, X1, in.norm2_g, (const float*)(ws + WS_GWT), in.router_b, H8, RSTD, GATES, ROWS, COUNTS, G, c); SEAM(5); }
    if (IN(6)) {
        moe_prefix(TPRE, LCNT, COUNTS);
        pg8::MoeProb<true> P{(const char*)H8, (const char*)(ws + WS_WGU), D, 8, G, c, (size_t)DFF * D, (size_t)2 * DFF * D, 128, TPRE, TAB, UDESC};
        moe_table<true>(P, UDESC, TAB, TABF, TABB, LCNT, ROWS, RSTD, in.b_gate_up);
        EpiGateUp E{ACTb, TPRE, TABF, TABB};
        REP(6) pg8::gemm_phase<EpiGateUp, pg8::MoeProb<true>, true, true>(lds, P, E);
        SEAM(6);
    }
    if (IN(7)) {
        moe_prefix(TPRE, LCNT, COUNTS);
        pg8::MoeProb<false> P{(const char*)ACTb, (const char*)(ws + WS_WD), DFF, 4, G, c, (size_t)128 * DFF, (size_t)D * DFF, 256, TPRE, TAB, UDESC};
        moe_table<false>(P, UDESC, TAB, TABF, TABB, LCNT, ROWS, GATES, in.b_down);
        EpiDown E{Yb, TAB, TABF, TABB};
        REP(7) pg8::gemm_phase<EpiDown, pg8::MoeProb<false>, true, true>(lds, P, E);
        SEAM(7);
    }

#ifdef RT_HASH
    if (IN(8)) REP(8) final_phase(X1, (const unsigned char*)(RSTD + S), in.final_g, args.out, G, c);
#else
    if (IN(8)) REP(8) final_phase(X1, Yb, in.final_g, args.out, G, c);
#endif

#undef IN
#undef SEAM
}

#ifndef MK_N_LAUNCHES
#define MK_N_LAUNCHES 1
#endif
#ifndef MK_SEQ
#define MK_SEQ "012345678"
#endif
extern "C" void kernel_launch(void* const* d_in, const int* in_sizes, int n_in, void* d_out, int out_size, void* d_ws, size_t ws_size, hipStream_t stream) {
    static int grid = 0;
    if (grid == 0) {
        if (n_in != 15 || out_size != S * D || ws_size < WS_END) { fprintf(stderr, "kernel_launch: unexpected problem (n_in %d out %d ws %zu)\n", n_in, out_size, ws_size); grid = -1; return; }
        int dev = 0, cus = 0, per_cu = 0;
        if (hipGetDevice(&dev) != hipSuccess || hipDeviceGetAttribute(&cus, hipDeviceAttributeMultiprocessorCount, dev) != hipSuccess) { grid = -1; return; }
        if (hipFuncSetAttribute((const void*)fwd, hipFuncAttributeMaxDynamicSharedMemorySize, LDS_BYTES) != hipSuccess) { fprintf(stderr, "kernel_launch: hipFuncSetAttribute failed\n"); grid = -1; return; }
        if (hipOccupancyMaxActiveBlocksPerMultiprocessor(&per_cu, (const void*)fwd, 512, LDS_BYTES) != hipSuccess || per_cu < 1) { fprintf(stderr, "kernel_launch: occupancy query says %d blocks per CU\n", per_cu); (void)hipGetLastError(); per_cu = 1; }
        grid = cus;
    }
    if (grid < 0) return;
    if (hipMemsetAsync((char*)d_ws + WS_CTL, 0, CTL_ZERO_BYTES, stream) != hipSuccess) { fprintf(stderr, "kernel_launch: memset failed\n"); return; }
    Args a{};
    a.in.x = (const float*)d_in[0]; a.in.norm1_g = (const float*)d_in[1]; a.in.w_in = (const float*)d_in[2]; a.in.pool_w = (const float*)d_in[3]; a.in.pool_scale = (const float*)d_in[4];
    a.in.rel_bias = (const float*)d_in[5]; a.in.w_out = (const float*)d_in[6]; a.in.norm2_g = (const float*)d_in[7]; a.in.router_w = (const float*)d_in[8]; a.in.router_b = (const float*)d_in[9];
    a.in.w_gate_up = (const float*)d_in[10]; a.in.b_gate_up = (const float*)d_in[11]; a.in.w_down = (const float*)d_in[12]; a.in.b_down = (const float*)d_in[13]; a.in.final_g = (const float*)d_in[14];
    a.out = (float*)d_out; a.ws = (unsigned char*)d_ws;
    if (MK_N_LAUNCHES == 1) { a.ph_lo = 0; a.ph_hi = NPHASE; hipLaunchKernelGGL(fwd, dim3(grid), dim3(512), LDS_BYTES, stream, a); }
    else { const char* seq = MK_SEQ; for (int i = 0; seq[i]; ++i) { const int p = seq[i] - '0'; a.ph_lo = p; a.ph_hi = p + 1; if (p == 5) (void)hipMemsetAsync((char*)d_ws + WS_CTL + CW_COUNTS * 4, 0, 128, stream); hipLaunchKernelGGL(fwd, dim3(grid), dim3(512), LDS_BYTES, stream, a); } }
    const hipError_t le = hipPeekAtLastError();
    if (le != hipSuccess) fprintf(stderr, "kernel_launch: launch failed: %s\n", hipGetErrorName(le));
}
```

```cpp
#include <hip/hip_runtime.h>
#include <cstdio>
#include <cstdint>

#define LAS __attribute__((address_space(3)))
#define GAS __attribute__((address_space(1)))
typedef unsigned short bf16_t;
typedef short bf16x8 __attribute__((ext_vector_type(8)));
typedef short s16x4 __attribute__((ext_vector_type(4)));
typedef float f32x4 __attribute__((ext_vector_type(4)));
typedef float f32x2 __attribute__((ext_vector_type(2)));
typedef unsigned u32x4 __attribute__((ext_vector_type(4)));
typedef unsigned u32x2 __attribute__((ext_vector_type(2)));
typedef int i32x4 __attribute__((ext_vector_type(4)));
typedef int i32x8 __attribute__((ext_vector_type(8)));

constexpr int S = 16384, D = 1024, NPROJ = 2560, PW = 256, AW = 768, NH = 12, HD = 64, NE = 32, TOPK = 4, DFF = 1024;
constexpr float RMS_EPS = 1e-5f, LOG2E = 1.4426950408889634f, QSCALE = 0.125f * LOG2E, NEGBIG = -1e30f;
constexpr float WSCALE = 64.0f, HSCALE = 16.0f, ASCALE = 8.0f, YSCALE = 64.0f, FP8MAX = 448.0f;
constexpr int BT_N = 400, BT_OFF = 144;

constexpr size_t MiB = 1u << 20;
constexpr size_t WS_CTL = 0, CTL_ZERO_BYTES = 32 * 1024;
constexpr size_t WS_WIN = 2 * MiB;
constexpr size_t WS_WOUT = 8 * MiB;
constexpr size_t WS_GWT = 10 * MiB;
constexpr size_t WS_BT = 10 * MiB + 512 * 1024;
constexpr size_t WS_PWT = 10 * MiB + 768 * 1024;
constexpr size_t WS_RSTD = 11 * MiB;
constexpr size_t WS_GATES = 11 * MiB + 256 * 1024;
constexpr size_t WS_ROWS = 12 * MiB;
constexpr size_t WS_LSE = 14 * MiB;
constexpr size_t WS_WGU = 32 * MiB;
constexpr size_t WS_WD = 160 * MiB;
constexpr size_t WS_H8 = 200 * MiB;
constexpr size_t WS_H = 224 * MiB;
constexpr size_t WS_U = 256 * MiB;
constexpr size_t WS_Q = 264 * MiB, WS_K = 288 * MiB, WS_V = 312 * MiB;
constexpr size_t WS_OP = 336 * MiB;
constexpr size_t WS_MIX = 408 * MiB;
constexpr size_t WS_X1 = 440 * MiB;
constexpr size_t WS_ACT = 512 * MiB;
constexpr size_t WS_Y = 656 * MiB;
constexpr size_t WS_END = 784 * MiB;
constexpr int ACT_ROWS = 65536 + 32 * 256;
constexpr int CW_COUNTS = 64;
constexpr int CW_QUEUE = 256;
constexpr int CW_BAR = 4096;

constexpr int LDS_BYTES = 163840;
constexpr int LDS_TAB = 131072;
constexpr int LDS_CTL = LDS_BYTES - 1024;
constexpr int MAXU = 9;

typedef __bf16 bf16x2_t __attribute__((ext_vector_type(2)));
__device__ __forceinline__ unsigned cvt_pk_bf16(float lo, float hi) { const f32x2 v = {lo, hi}; const bf16x2_t b = __builtin_convertvector(v, bf16x2_t); return __builtin_bit_cast(unsigned, b); }
__device__ __forceinline__ float clamp8(float v) { return __builtin_amdgcn_fmed3f(v, -FP8MAX, FP8MAX); }
__device__ __forceinline__ unsigned cvt4_fp8(float a, float b, float c, float d) {
    int p = __builtin_amdgcn_cvt_pk_fp8_f32(clamp8(a), clamp8(b), 0, false); p = __builtin_amdgcn_cvt_pk_fp8_f32(clamp8(c), clamp8(d), p, true); return (unsigned)p; }
__device__ __forceinline__ float bf_lo(unsigned w) { return __uint_as_float(w << 16); }
__device__ __forceinline__ float bf_hi(unsigned w) { return __uint_as_float(w & 0xffff0000u); }
__device__ __forceinline__ float wave_sum(float v) {
#pragma unroll
    for (int o = 1; o < 64; o <<= 1) v += __shfl_xor(v, o);
    return v;
}
#define LDS_WAIT() asm volatile("s_waitcnt lgkmcnt(0)" ::: "memory")
#define VM_WAIT() asm volatile("s_waitcnt vmcnt(0)" ::: "memory")

#define XB_TMO      128
#define XB_XCNT(j)  (256  + 64 * (j))
#define XB_XSUB(j)  (1280 + 64 * (j))
#define XB_XGEN(j)  (2304 + 64 * (j))
#define XB_TOP      3328
#define XB_TOPGEN   3392
#define XCD_BAR_WORDS 3456
#define XB_SPIN_CAP (1u << 18)
__device__ __forceinline__ unsigned xb_ld(unsigned* p)              { return __hip_atomic_load(p, __ATOMIC_RELAXED, __HIP_MEMORY_SCOPE_AGENT); }
__device__ __forceinline__ unsigned xb_add(unsigned* p, unsigned v) { return __hip_atomic_fetch_add(p, v, __ATOMIC_RELAXED, __HIP_MEMORY_SCOPE_AGENT); }
__device__ __forceinline__ unsigned xb_xcc_id() { return (unsigned)__builtin_amdgcn_s_getreg((3 << 11) | 20) & 0xFu; }
#define XB_SPIN(cond, bar) do { unsigned _sp = 0; while (cond) { __builtin_amdgcn_s_sleep(1); \
    if ((++_sp & 255u) == 0u) { if (xb_ld(&(bar)[XB_TMO])) break; if (_sp > XB_SPIN_CAP) { atomicAdd(&(bar)[XB_TMO], 1u); break; } } } } while (0)
struct XcdBarrier { unsigned* bar; unsigned x; volatile LAS unsigned* st; };
__device__ __forceinline__ XcdBarrier xcd_barrier_post(unsigned* bar, volatile LAS unsigned* st) {
    XcdBarrier b; b.bar = bar; b.x = xb_xcc_id(); b.st = st;
    if (threadIdx.x == 0) (void)xb_add(&bar[XB_XCNT(b.x)], 1u);
    return b;
}
__device__ __forceinline__ void xcd_barrier_complete(unsigned* bar, unsigned x, unsigned& nloc, unsigned& nx) {
    const unsigned G = gridDim.x * gridDim.y * gridDim.z;
    unsigned sum, cnt, mine, sp = 0u;
    for (;;) {
        sum = 0u; cnt = 0u; mine = 0u;
#pragma unroll
        for (unsigned j = 0; j < 16; ++j) { const unsigned c = xb_ld(&bar[XB_XCNT(j)]); sum += c; cnt += (c > 0u) ? 1u : 0u; mine = (j == x) ? c : mine; }
        if (sum == G) break;
        __builtin_amdgcn_s_sleep(1);
        if ((++sp & 255u) == 0u) { if (xb_ld(&bar[XB_TMO])) break; if (sp > XB_SPIN_CAP) { atomicAdd(&bar[XB_TMO], 1u); break; } }
    }
    nloc = mine > 0u ? mine : 1u; nx = cnt > 0u ? cnt : 1u;
}
__device__ __forceinline__ void xcd_barrier(const XcdBarrier& b) {
    asm volatile("s_waitcnt vmcnt(0)" ::: "memory");
    __syncthreads();
    if (threadIdx.x == 0) {
        unsigned* bar = b.bar;
        __builtin_amdgcn_s_waitcnt(0);
        unsigned nloc = b.st[0], nx = b.st[1];
        if (nloc == 0u) { xcd_barrier_complete(bar, b.x, nloc, nx); b.st[0] = nloc; b.st[1] = nx; }
        const unsigned old = xb_add(&bar[XB_XSUB(b.x)], 1u);
        const unsigned gen = old / nloc;
        if (old + 1u == (gen + 1u) * nloc) {
            __builtin_amdgcn_fence(__ATOMIC_RELEASE, "agent");
            asm volatile("s_waitcnt vmcnt(0)" ::: "memory");
            const unsigned og = xb_add(&bar[XB_TOP], 1u);
            const unsigned tg = og / nx;
            if (og + 1u == (tg + 1u) * nx) xb_add(&bar[XB_TOPGEN], 1u);
            else XB_SPIN(xb_ld(&bar[XB_TOPGEN]) == tg, bar);
            __builtin_amdgcn_fence(__ATOMIC_ACQUIRE, "agent");
            xb_add(&bar[XB_XGEN(b.x)], 1u);
            asm volatile("s_waitcnt vmcnt(0)" ::: "memory");
        } else {
            XB_SPIN(xb_ld(&bar[XB_XGEN(b.x)]) == gen, bar);
            __builtin_amdgcn_fence(__ATOMIC_ACQUIRE, "agent");
            asm volatile("s_waitcnt vmcnt(0)" ::: "memory");
        }
    }
    __syncthreads();
}

namespace pg8 {
constexpr int BM = 256, BK = 64, HALF = 128, HTB = HALF * BK * 2, STAGE_BYTES = 8 * HTB, NXCD = 8, WGM = 8;
__host__ __device__ __forceinline__ int lds_byte(int r, int c) { const int st = (r >> 4) * 2 + (c >> 5), rr = r & 15, cc = c & 31, ob = rr * 64 + cc * 2; return st * 1024 + (ob ^ (((ob >> 9) & 1) << 5)); }
__host__ __device__ __forceinline__ void stage_rc(int b, int& R, int& C) { const int st = b / 1024, sb = b % 1024, swz = sb ^ (((sb >> 9) & 1) << 5); R = (st >> 1) * 16 + swz / 64; C = (st & 1) * 32 + (swz % 64) / 2; }
__host__ __device__ __forceinline__ int perm32(int rho) { const int n = rho >> 4, i = rho & 15; return 8 * (i >> 2) + 4 * n + (i & 3); }

struct Unit { int pm, pn, e, slot; };

template <class Epi, class Prob, bool ALIGN_EPI, bool FP8>
__device__ __forceinline__ void gemm_phase(LAS unsigned char* lds, const Prob& P, const Epi& E) {
    const int tid = threadIdx.x, wid = __builtin_amdgcn_readfirstlane(tid >> 6), lane = tid & 63, wr = wid >> 2, wc = wid & 3, fr = lane & 15, fq = lane >> 4;
    const int rowb = P.rowb, nt = rowb / 128;
    int Rs[2], Cs[2]; unsigned voffB[2];
#pragma unroll
    for (int i = 0; i < 2; ++i) { int R, C; stage_rc(tid * 16 + i * 8192, R, C); const int Rb = Epi::PERM ? ((R & ~31) + perm32(R & 31)) : R;
        Rs[i] = R; Cs[i] = C * 2; voffB[i] = (unsigned)(Rb * rowb + C * 2); }
    const size_t kstep = (size_t)(BK * 2);
    const size_t bhalf = P.b_half;
    const unsigned ldsw = (unsigned)wid * 1024u;
    const int aoff = lds_byte(wr * 64 + fr, fq * 8), boff = lds_byte(wc * 32 + fr, fq * 8);
#define PG8_SA(b, h) (((b) * 2 + (h)) * HTB)
#define PG8_SB(b, h) ((4 + (b) * 2 + (h)) * HTB)
#define PG8_STAGE_B(bufoff, gbase) do { _Pragma("unroll") for (int _i = 0; _i < 2; ++_i) \
        __builtin_amdgcn_global_load_lds((const unsigned*)((const char*)(gbase) + voffB[_i]), (LAS unsigned*)(lds + (bufoff) + ldsw + _i * 8192), 16, 0, 0); } while (0)
#define PG8_STAGE_A(bufoff, kb, o0, o1) do { \
        __builtin_amdgcn_global_load_lds((const unsigned*)(P.A + (size_t)(o0) + (kb)), (LAS unsigned*)(lds + (bufoff) + ldsw), 16, 0, 0); \
        __builtin_amdgcn_global_load_lds((const unsigned*)(P.A + (size_t)(o1) + (kb)), (LAS unsigned*)(lds + (bufoff) + ldsw + 8192), 16, 0, 0); } while (0)
#define PG8_LDA(dst, b, h) do { _Pragma("unroll") for (int m = 0; m < 4; ++m) _Pragma("unroll") for (int k = 0; k < 2; ++k) dst[m][k] = *(const LAS bf16x8*)(lds + PG8_SA(b, h) + aoff + m * 2048 + k * 1024); } while (0)
#define PG8_LDB(dst, b, h) do { _Pragma("unroll") for (int n = 0; n < 2; ++n) _Pragma("unroll") for (int k = 0; k < 2; ++k) dst[n][k] = *(const LAS bf16x8*)(lds + PG8_SB(b, h) + boff + n * 2048 + k * 1024); } while (0)
#define PG8_MMA(ai, bj, At, Bt) do { __builtin_amdgcn_s_setprio(1); _Pragma("unroll") for (int m = 0; m < 4; ++m) _Pragma("unroll") for (int n = 0; n < 2; ++n) { \
        if constexpr (FP8) { const i32x8 fb_ = __builtin_shufflevector(__builtin_bit_cast(i32x4, Bt[n][0]), __builtin_bit_cast(i32x4, Bt[n][1]), 0, 1, 2, 3, 4, 5, 6, 7); \
            const i32x8 fa_ = __builtin_shufflevector(__builtin_bit_cast(i32x4, At[m][0]), __builtin_bit_cast(i32x4, At[m][1]), 0, 1, 2, 3, 4, 5, 6, 7); \
            acc[ai][bj][m][n] = __builtin_amdgcn_mfma_scale_f32_16x16x128_f8f6f4(fb_, fa_, acc[ai][bj][m][n], 0, 0, 0, 0, 0, 0); } \
        else { _Pragma("unroll") for (int k = 0; k < 2; ++k) acc[ai][bj][m][n] = __builtin_amdgcn_mfma_f32_16x16x32_bf16(Bt[n][k], At[m][k], acc[ai][bj][m][n], 0, 0, 0); } } \
        __builtin_amdgcn_s_setprio(0); } while (0)
#define PG8_WAIT_V(n) asm volatile("s_waitcnt vmcnt(" #n ")" ::: "memory")
#define PG8_WAIT_L(n) asm volatile("s_waitcnt lgkmcnt(" #n ")" ::: "memory")
#define PG8_BAR __builtin_amdgcn_s_barrier()
#define PG8_SCHED __builtin_amdgcn_sched_barrier(0)
    Unit cur, nxt; int ui = 0;
    if (!P.next(0, cur)) return;
    f32x4 acc[2][2][4][2];
    E.init(acc, cur, wr, wc, fr, fq);
    bf16x8 At[4][2], B0[2][2], B1[2][2];
    unsigned c00 = P.a_off(cur, Rs[0], Cs[0]), c01 = P.a_off(cur, Rs[1], Cs[1]), c10 = P.a_off(cur, HALF + Rs[0], Cs[0]), c11 = P.a_off(cur, HALF + Rs[1], Cs[1]);
    const char* cB = P.b_base(cur);
    PG8_STAGE_B(PG8_SB(0, 0), cB); PG8_STAGE_B(PG8_SB(0, 1), cB + bhalf); PG8_STAGE_A(PG8_SA(0, 0), 0, c00, c01); PG8_STAGE_A(PG8_SA(0, 1), 0, c10, c11);
    if (wr == 1) PG8_BAR;
    PG8_WAIT_V(2); PG8_BAR;
    PG8_STAGE_B(PG8_SB(1, 0), cB + kstep); PG8_STAGE_A(PG8_SA(1, 0), kstep, c00, c01); PG8_STAGE_B(PG8_SB(1, 1), cB + bhalf + kstep);
    PG8_WAIT_V(6); PG8_BAR;
    for (;;) {
        const bool has_next = P.next(ui + 1, nxt);
        const char* nB = has_next ? P.b_base(nxt) : cB;
        for (int t = 0; t < nt; t += 2) {
            const bool last = (t == nt - 2);
            const size_t k1 = (size_t)(t + 1) * kstep;
            const size_t k2 = last ? 0 : (size_t)(t + 2) * kstep, k3 = k2 + kstep;
            const char* b2 = last ? nB : cB + (size_t)(t + 2) * kstep; const char* b3 = b2 + kstep;
            if (last && has_next) { c00 = P.a_off(nxt, Rs[0], Cs[0]); c01 = P.a_off(nxt, Rs[1], Cs[1]); }
            PG8_LDB(B0, 0, 0); PG8_LDB(B1, 0, 1); PG8_SCHED; PG8_LDA(At, 0, 0); PG8_STAGE_A(PG8_SA(1, 1), k1, c10, c11);
            PG8_WAIT_V(8); PG8_WAIT_L(0); PG8_BAR; PG8_MMA(0, 0, At, B0); PG8_MMA(0, 1, At, B1); PG8_BAR; PG8_SCHED;
            if (last && has_next) { c10 = P.a_off(nxt, HALF + Rs[0], Cs[0]); c11 = P.a_off(nxt, HALF + Rs[1], Cs[1]); }
            PG8_LDA(At, 0, 1); PG8_STAGE_B(PG8_SB(0, 0), b2); PG8_STAGE_B(PG8_SB(0, 1), b2 + bhalf); PG8_STAGE_A(PG8_SA(0, 0), k2, c00, c01);
            PG8_WAIT_V(8); PG8_WAIT_L(0); PG8_BAR; PG8_MMA(1, 0, At, B0); PG8_MMA(1, 1, At, B1); PG8_BAR; PG8_SCHED;
            PG8_LDB(B0, 1, 0); PG8_LDB(B1, 1, 1); PG8_SCHED; PG8_LDA(At, 1, 0); PG8_STAGE_A(PG8_SA(0, 1), k2, c10, c11);
            PG8_WAIT_V(8); PG8_WAIT_L(0); PG8_BAR; PG8_MMA(0, 0, At, B0); PG8_MMA(0, 1, At, B1); PG8_BAR; PG8_SCHED;
            PG8_LDA(At, 1, 1); PG8_STAGE_B(PG8_SB(1, 0), b3); PG8_STAGE_B(PG8_SB(1, 1), b3 + bhalf); PG8_STAGE_A(PG8_SA(1, 0), k3, c00, c01);
            PG8_WAIT_V(8); PG8_WAIT_L(0); PG8_BAR; PG8_MMA(1, 0, At, B0); PG8_MMA(1, 1, At, B1); PG8_BAR; PG8_SCHED;
        }
        if constexpr (ALIGN_EPI) { if (wr == 0) PG8_BAR; }
        E(acc, cur, wr, wc, fr, fq);
#if defined(MK_DOUBLE)
        if constexpr (FP8) { if ((MK_DOUBLE >> 12) & 1) { asm volatile("" ::: "memory"); E(acc, cur, wr, wc, fr, fq); } }
#endif
        if (!has_next) break;
        cur = nxt; cB = nB; ++ui;
        E.init(acc, cur, wr, wc, fr, fq);
        if constexpr (ALIGN_EPI) { if (wr == 1) PG8_BAR; }
    }
    PG8_WAIT_V(0);
    if constexpr (!ALIGN_EPI) { if (wr == 0) PG8_BAR; }
    PG8_BAR;
#undef PG8_SA
#undef PG8_SB
#undef PG8_STAGE_A
#undef PG8_STAGE_B
#undef PG8_LDA
#undef PG8_LDB
#undef PG8_MMA
#undef PG8_WAIT_V
#undef PG8_WAIT_L
#undef PG8_BAR
#undef PG8_SCHED
}

__device__ __forceinline__ bool static_order(int nM, int nN, int G, int c, int i, int& pm, int& pn) {
    const int nwg = nM * nN; const long L = (long)i * G + c; if (L >= nwg) return false;
    int wgid = (int)L; { const int q = nwg / NXCD, r = nwg % NXCD, xcd = wgid % NXCD, off = wgid / NXCD; wgid = (xcd < r ? xcd * (q + 1) : r * (q + 1) + (xcd - r) * q) + off; }
    const int nig = WGM * nN, gid = wgid / nig, fm = gid * WGM, gsz = (nM - fm) < WGM ? (nM - fm) : WGM;
    pm = fm + ((wgid % nig) % gsz); pn = (wgid % nig) / gsz; return true;
}
struct DenseProb {
    const char* A; const char* Bt; int rowb, nM, nN, G, c; size_t b_half;
    __device__ __forceinline__ bool next(int i, Unit& u) const { u.e = 0; u.slot = i; return static_order(nM, nN, G, c, i, u.pm, u.pn); }
    __device__ __forceinline__ unsigned a_off(const Unit& u, int row, int colb) const { return (unsigned)((u.pm * BM + row) * rowb + colb); }
    __device__ __forceinline__ const char* b_base(const Unit& u) const { return Bt + (size_t)u.pn * BM * rowb; }
};
template <bool GATHER> struct MoeProb {
    const char* A; const char* Bt; int rowb, nN, G, c; size_t b_half; size_t b_expert; int b_tile_rows;
    const LAS int* tpre; const LAS int* tab; const LAS int* udesc;
    __device__ __forceinline__ int tp(int j) const { return __builtin_amdgcn_readfirstlane(tpre[j]); }
    __device__ __forceinline__ bool search(int i, Unit& u) const {
        const int total = tpre[NE] * nN; const long L0 = (long)i * G + c; if (L0 >= total) return false;
        int L = (int)L0; { const int q = total / NXCD, r = total % NXCD, xcd = L % NXCD, off = L / NXCD; L = (xcd < r ? xcd * (q + 1) : r * (q + 1) + (xcd - r) * q) + off; }
        int e = 0;
        for (int j = 1; j < NE; ++j) e += (tpre[j] * nN <= L) ? 1 : 0;
        const int first = tpre[e] * nN, tiles = tpre[e + 1] - tpre[e], rem = L - first;
        u.e = e; u.pm = rem % tiles; u.pn = rem / tiles; u.slot = i; return true;
    }
    __device__ __forceinline__ bool next(int i, Unit& u) const {
        if (i >= MAXU) return false;
        const int v = __builtin_amdgcn_readfirstlane(udesc[4 * i + 3]); if (!v) return false;
        u.e = __builtin_amdgcn_readfirstlane(udesc[4 * i]); u.pm = __builtin_amdgcn_readfirstlane(udesc[4 * i + 1]); u.pn = __builtin_amdgcn_readfirstlane(udesc[4 * i + 2]); u.slot = i; return true;
    }
    __device__ __forceinline__ unsigned a_off(const Unit& u, int row, int colb) const {
        if (GATHER) { const int idx = tab[u.slot * 256 + row]; const int tok = idx < 0 ? 0 : (idx >> 2); return (unsigned)(tok * rowb + colb); }
        return (unsigned)(((tp(u.e) + u.pm) * BM + row) * rowb + colb);
    }
    __device__ __forceinline__ const char* b_base(const Unit& u) const { return Bt + (size_t)u.e * b_expert + (size_t)u.pn * b_tile_rows * rowb; }
};
}

using pg8::Unit;
typedef f32x4 AccT[2][2][4][2];
__device__ __forceinline__ void acc_zero(AccT& acc) {
#pragma unroll
    for (int a = 0; a < 2; ++a)
#pragma unroll
        for (int b = 0; b < 2; ++b)
#pragma unroll
            for (int m = 0; m < 4; ++m)
#pragma unroll
                for (int n = 0; n < 2; ++n) acc[a][b][m][n] = (f32x4){0.f, 0.f, 0.f, 0.f};
}

struct EpiQKVU {
    static constexpr bool PERM = true;
    unsigned char* ws;
    __device__ __forceinline__ void init(AccT& acc, const Unit&, int, int, int, int) const { acc_zero(acc); }
    __device__ __forceinline__ void operator()(const AccT& acc, const Unit& u, int wr, int wc, int fr, int fq) const {
        static_assert(WS_K - WS_Q == WS_V - WS_K, "Q, K, V equally spaced");
        const int t = (u.pn - 1) / 3;
        const size_t boff = (u.pn == 0) ? WS_U : (WS_Q + (size_t)t * (WS_K - WS_Q));
        bf16_t* base = (bf16_t*)(ws + boff);
        const int ldc = (u.pn == 0) ? PW : AW, colt = (u.pn == 0) ? 0 : ((u.pn - 1) % 3) * 256;
        const float sc = (u.pn >= 1 && u.pn <= 3) ? QSCALE : 1.f;
        const int row0 = u.pm * 256 + wr * 64 + fr, col0 = colt + wc * 32 + 8 * fq;
#pragma unroll
        for (int ai = 0; ai < 2; ++ai)
#pragma unroll
            for (int m = 0; m < 4; ++m) { bf16_t* rowp = base + (size_t)(row0 + ai * 128 + m * 16) * ldc + col0;
#pragma unroll
                for (int bj = 0; bj < 2; ++bj) { const f32x4 v0 = acc[ai][bj][m][0] * sc, v1 = acc[ai][bj][m][1] * sc;
                    u32x4 w; w.x = cvt_pk_bf16(v0[0], v0[1]); w.y = cvt_pk_bf16(v0[2], v0[3]); w.z = cvt_pk_bf16(v1[0], v1[1]); w.w = cvt_pk_bf16(v1[2], v1[3]);
                    *(u32x4*)(rowp + bj * 128) = w; } }
    }
};
struct EpiResF32 {
    static constexpr bool PERM = false;
    const float* X; float* O;
    __device__ __forceinline__ void init(AccT& acc, const Unit& u, int wr, int wc, int fr, int fq) const {
        const int row0 = u.pm * 256 + wr * 64 + fr, col0 = u.pn * 256 + wc * 32 + 4 * fq;
#pragma unroll
        for (int ai = 0; ai < 2; ++ai)
#pragma unroll
            for (int m = 0; m < 4; ++m) { const size_t off = (size_t)(row0 + ai * 128 + m * 16) * D + col0;
#pragma unroll
                for (int bj = 0; bj < 2; ++bj)
#pragma unroll
                    for (int n = 0; n < 2; ++n) acc[ai][bj][m][n] = __builtin_nontemporal_load((const f32x4*)(X + off + bj * 128 + n * 16)); }
    }
    __device__ __forceinline__ void operator()(const AccT& acc, const Unit& u, int wr, int wc, int fr, int fq) const {
        const int row0 = u.pm * 256 + wr * 64 + fr, col0 = u.pn * 256 + wc * 32 + 4 * fq;
#pragma unroll
        for (int ai = 0; ai < 2; ++ai)
#pragma unroll
            for (int m = 0; m < 4; ++m) { const size_t off = (size_t)(row0 + ai * 128 + m * 16) * D + col0;
#pragma unroll
                for (int bj = 0; bj < 2; ++bj)
#pragma unroll
                    for (int n = 0; n < 2; ++n) *(f32x4*)(O + off + bj * 128 + n * 16) = acc[ai][bj][m][n]; }
    }
};
__device__ __forceinline__ float swiglu1(float g, float u) {
    g = fminf(g, 7.0f); u = fminf(fmaxf(u, -7.0f), 7.0f);
    const float s = __builtin_amdgcn_rcpf(1.0f + __builtin_amdgcn_exp2f(g * (-1.702f * LOG2E)));
    return (u + 1.0f) * (g * s);
}
__device__ __forceinline__ f32x4 swiglu4(f32x4 g, f32x4 u) {
    g = __builtin_elementwise_min(g, (f32x4){7.0f, 7.0f, 7.0f, 7.0f});
    u = __builtin_elementwise_min(__builtin_elementwise_max(u, (f32x4){-7.0f, -7.0f, -7.0f, -7.0f}), (f32x4){7.0f, 7.0f, 7.0f, 7.0f});
    const f32x4 t = g * (-1.702f * LOG2E);
    f32x4 e; e[0] = __builtin_amdgcn_exp2f(t[0]); e[1] = __builtin_amdgcn_exp2f(t[1]); e[2] = __builtin_amdgcn_exp2f(t[2]); e[3] = __builtin_amdgcn_exp2f(t[3]);
    const f32x4 d = e + 1.0f;
    f32x4 r; r[0] = __builtin_amdgcn_rcpf(d[0]); r[1] = __builtin_amdgcn_rcpf(d[1]); r[2] = __builtin_amdgcn_rcpf(d[2]); r[3] = __builtin_amdgcn_rcpf(d[3]);
    return (u * ASCALE + ASCALE) * (g * r);
}
__device__ __forceinline__ unsigned cvt4_fp8_nc(const f32x4& v) {
    int p = __builtin_amdgcn_cvt_pk_fp8_f32(v[0], v[1], 0, false); p = __builtin_amdgcn_cvt_pk_fp8_f32(v[2], v[3], p, true); return (unsigned)p; }
struct EpiGateUp {
    static constexpr bool PERM = true;
    __device__ __forceinline__ void init(AccT& acc, const Unit&, int, int, int, int) const { acc_zero(acc); }
    unsigned char* ACT; const LAS int* tpre; const LAS float* tabf; const LAS float* tabb;
    __device__ __forceinline__ void operator()(const AccT& acc, const Unit& u, int wr, int wc, int fr, int fq) const {
        const int cl = wc * 32 + 8 * fq, colA = u.pn * 128 + cl;
        const LAS float* bp = tabb + u.slot * 256 + cl;
        const f32x4 bg0 = *(const LAS f32x4*)(bp), bg1 = *(const LAS f32x4*)(bp + 4), bu0 = *(const LAS f32x4*)(bp + 128), bu1 = *(const LAS f32x4*)(bp + 132);
        const int srow0 = (__builtin_amdgcn_readfirstlane(tpre[u.e]) + u.pm) * 256;
#pragma unroll
        for (int ai = 0; ai < 2; ++ai)
#pragma unroll
            for (int m = 0; m < 4; ++m) { const int r = ai * 128 + wr * 64 + m * 16 + fr; const float rs = tabf[u.slot * 256 + r];
                const f32x4 g0 = acc[ai][0][m][0] * rs + bg0, g1 = acc[ai][0][m][1] * rs + bg1, u0 = acc[ai][1][m][0] * rs + bu0, u1 = acc[ai][1][m][1] * rs + bu1;
                u32x2 w; w.x = cvt4_fp8_nc(swiglu4(g0, u0)); w.y = cvt4_fp8_nc(swiglu4(g1, u1));
                *(u32x2*)(ACT + (size_t)(srow0 + r) * DFF + colA) = w; }
    }
};
struct EpiDown {
    static constexpr bool PERM = true;
    __device__ __forceinline__ void init(AccT& acc, const Unit&, int, int, int, int) const { acc_zero(acc); }
    unsigned char* Y; const LAS int* tab; const LAS float* tabf; const LAS float* tabb;
    __device__ __forceinline__ void operator()(const AccT& acc, const Unit& u, int wr, int wc, int fr, int fq) const {
        const int cl = wc * 32 + 8 * fq, col0 = u.pn * 256 + cl;
        const LAS float* bp = tabb + u.slot * 256 + cl;
        f32x4 bv[2][2];
#pragma unroll
        for (int bj = 0; bj < 2; ++bj) { bv[bj][0] = *(const LAS f32x4*)(bp + bj * 128); bv[bj][1] = *(const LAS f32x4*)(bp + bj * 128 + 4); }
#pragma unroll
        for (int ai = 0; ai < 2; ++ai)
#pragma unroll
            for (int m = 0; m < 4; ++m) { const int r = ai * 128 + wr * 64 + m * 16 + fr; const int idx = tab[u.slot * 256 + r];
                if (idx >= 0) { const float gv = tabf[u.slot * 256 + r] * YSCALE; unsigned char* rowp = Y + (size_t)idx * D + col0;
#pragma unroll
                    for (int bj = 0; bj < 2; ++bj) { const f32x4 v0 = (acc[ai][bj][m][0] * (1.0f / (ASCALE * WSCALE)) + bv[bj][0]) * gv, v1 = (acc[ai][bj][m][1] * (1.0f / (ASCALE * WSCALE)) + bv[bj][1]) * gv;
                        u32x2 w; w.x = cvt4_fp8(v0[0], v0[1], v0[2], v0[3]); w.y = cvt4_fp8(v1[0], v1[1], v1[2], v1[3]);
                        *(u32x2*)(rowp + bj * 128) = w; } } }
    }
};

__device__ __forceinline__ void tr_item(const float* __restrict__ W, int K, int N, bf16_t* __restrict__ WT, LAS float* scr, int kb, int nb, int lane) {
    const int k0 = kb * 64, n0 = nb * 64;
    const float* src = W + (size_t)(k0 + (lane >> 4)) * N + n0 + (lane & 15) * 4;
    f32x4 v[16];
#pragma unroll
    for (int i = 0; i < 16; ++i) v[i] = *(const f32x4*)(src + (size_t)(4 * i) * N);
#pragma unroll
    for (int i = 0; i < 16; ++i) { LAS float* d = scr + (4 * i + (lane >> 4)) * 65 + (lane & 15) * 4; d[0] = v[i][0]; d[1] = v[i][1]; d[2] = v[i][2]; d[3] = v[i][3]; }
    LDS_WAIT();
    const int c = lane & 7;
#pragma unroll
    for (int j = 0; j < 8; ++j) { const int n = 8 * j + (lane >> 3); const LAS float* s = scr + (8 * c) * 65 + n;
        u32x4 o; o.x = cvt_pk_bf16(s[0], s[65]); o.y = cvt_pk_bf16(s[130], s[195]); o.z = cvt_pk_bf16(s[260], s[325]); o.w = cvt_pk_bf16(s[390], s[455]);
        *(u32x4*)(WT + (size_t)(n0 + n) * K + k0 + 8 * c) = o; }
    LDS_WAIT();
}
struct Item8 { const float* src; unsigned char* dst; int N; };
__device__ __forceinline__ void chunk8_load(const Item8& d, int ch, f32x4 (&v)[16], int lane) {
    const float* base = d.src + (size_t)(32 * ch + 4 * (lane >> 5)) * d.N + (lane & 31) * 4;
#pragma unroll
    for (int sl = 0; sl < 4; ++sl)
#pragma unroll
        for (int j = 0; j < 4; ++j) v[4 * sl + j] = __builtin_nontemporal_load((const f32x4*)(base + (size_t)(8 * sl + j) * d.N));
}
__device__ __forceinline__ void chunk8_cvt(int ch, const f32x4 (&v)[16], LAS unsigned* scr, int lane) {
    const int nq = lane & 31, kq0 = lane >> 5, sw = (nq & 7) << 2;
#pragma unroll
    for (int sl = 0; sl < 4; ++sl) { const int kw = 8 * ch + kq0 + 2 * sl;
#pragma unroll
        for (int i = 0; i < 4; ++i) scr[(4 * nq + i) * 32 + (kw ^ sw)] = cvt4_fp8(v[4 * sl][i] * WSCALE, v[4 * sl + 1][i] * WSCALE, v[4 * sl + 2][i] * WSCALE, v[4 * sl + 3][i] * WSCALE); }
}
__device__ __forceinline__ void item8_flush(const Item8& d, const LAS unsigned* scr, int lane) {
    LDS_WAIT();
    const int c16 = lane & 7;
#pragma unroll
    for (int jj = 0; jj < 16; ++jj) { const int n = (lane >> 3) + 8 * jj;
        const u32x4 o = *(const LAS u32x4*)(scr + n * 32 + ((c16 ^ ((n >> 2) & 7)) << 2));
        __builtin_nontemporal_store(o, (u32x4*)(d.dst + (size_t)n * D + 16 * c16)); }
    LDS_WAIT();
}
__device__ __forceinline__ int t5_bucket(int dist) {
    if (dist < 16) return dist;
    const int large = 16 + (int)(logf((float)dist / 16.0f) / 4.852030263919617f * 16.0f);
    return large < 31 ? large : 31;
}
struct In { const float *x, *norm1_g, *w_in, *pool_w, *pool_scale, *rel_bias, *w_out, *norm2_g, *router_w, *router_b, *w_gate_up, *b_gate_up, *w_down, *b_down, *final_g; };

constexpr int N8_ALL = NE * 128 + NE * 64;
__device__ __forceinline__ void convert8_queue(LAS unsigned char* lds, const In& in, unsigned char* ws, unsigned* qword) {
    const int lane = threadIdx.x & 63, wave = __builtin_amdgcn_readfirstlane((int)threadIdx.x >> 6);
    constexpr int IG = 8 * 16, ID = 8 * 8;
    auto desc = [&](int r) -> Item8 { Item8 d;
        if (r < NE * IG) { const int e = r / IG, q = r % IG, kb = q / 16, nb = q % 16;
            d.src = in.w_gate_up + (size_t)e * D * 2 * DFF + (size_t)(kb * 128) * (2 * DFF) + nb * 128; d.N = 2 * DFF; d.dst = ws + WS_WGU + (size_t)e * 2 * DFF * D + (size_t)(nb * 128) * D + kb * 128; }
        else { const int r2 = r - NE * IG, e = r2 / ID, q = r2 % ID, kb = q / 8, nb = q % 8;
            d.src = in.w_down + (size_t)e * DFF * D + (size_t)(kb * 128) * D + nb * 128; d.N = D; d.dst = ws + WS_WD + (size_t)e * D * DFF + (size_t)(nb * 128) * DFF + kb * 128; }
        return d; };
    auto claim = [&]() -> int { unsigned v = 0; if (lane == 0) v = __hip_atomic_fetch_add(qword, 1u, __ATOMIC_RELAXED, __HIP_MEMORY_SCOPE_AGENT); return __builtin_amdgcn_readfirstlane((int)v); };
    LAS unsigned* scr8 = (LAS unsigned*)(lds + wave * 16384);
    f32x4 va[16], vb[16];
    int it = claim();
    if (it < N8_ALL) { const Item8 d0 = desc(it); chunk8_load(d0, 0, va, lane); chunk8_load(d0, 1, vb, lane); }
    while (it < N8_ALL) {
        const Item8 d = desc(it);
        const int nx = claim();
        const bool more = nx < N8_ALL; const Item8 dn = more ? desc(nx) : d;
        chunk8_cvt(0, va, scr8, lane); chunk8_load(d, 2, va, lane);
        chunk8_cvt(1, vb, scr8, lane); chunk8_load(d, 3, vb, lane);
        chunk8_cvt(2, va, scr8, lane); if (more) chunk8_load(dn, 0, va, lane);
        chunk8_cvt(3, vb, scr8, lane); if (more) chunk8_load(dn, 1, vb, lane);
        item8_flush(d, scr8, lane);
        it = nx;
    }
}
__device__ __forceinline__ void p0_prologue(LAS unsigned char* lds, const In& in, unsigned char* ws, int G, int c) {
    const int tid = threadIdx.x, lane = tid & 63, wave = __builtin_amdgcn_readfirstlane(tid >> 6);
    const int gw = c * 8 + wave, NGW = G * 8;
    LAS float* scr = (LAS float*)(lds + wave * 16640);
    constexpr int I_IN = 16 * 40, I_OUT = 16 * 16, I_GU1 = 16 * 32, I_D1 = 16 * 16;
    for (int it = gw; it < I_IN; it += NGW) tr_item(in.w_in, D, NPROJ, (bf16_t*)(ws + WS_WIN), scr, it / 40, it % 40, lane);
#ifndef MK_DOUBLE
#define MK_DOUBLE 0
#endif
    for (int repr_ = 0; repr_ < (((MK_DOUBLE >> 11) & 1) ? 2 : 1); ++repr_) {
        f32x4 gv[4];
#pragma unroll
        for (int j = 0; j < 4; ++j) gv[j] = *(const f32x4*)(in.norm1_g + 4 * lane + 256 * j);
        bf16_t* H = (bf16_t*)(ws + WS_H);
        f32x4 v[4], vn[4];
        int m = gw;
        if (m < S) {
#pragma unroll
            for (int j = 0; j < 4; ++j) v[j] = __builtin_nontemporal_load((const f32x4*)(in.x + (size_t)m * D + 4 * lane + 256 * j)); }
        for (; m < S; m += NGW) {
            const int mn = m + NGW;
            if (mn < S) {
#pragma unroll
                for (int j = 0; j < 4; ++j) vn[j] = __builtin_nontemporal_load((const f32x4*)(in.x + (size_t)mn * D + 4 * lane + 256 * j)); }
            float s = 0.f;
#pragma unroll
            for (int j = 0; j < 4; ++j) s += (v[j][0] * v[j][0] + v[j][1] * v[j][1]) + (v[j][2] * v[j][2] + v[j][3] * v[j][3]);
            const float rstd = rsqrtf(wave_sum(s) * (1.0f / D) + RMS_EPS);
#pragma unroll
            for (int j = 0; j < 4; ++j) { const f32x4 o = v[j] * rstd * gv[j]; u32x2 w; w.x = cvt_pk_bf16(o[0], o[1]); w.y = cvt_pk_bf16(o[2], o[3]); *(u32x2*)(H + (size_t)m * D + 4 * lane + 256 * j) = w; }
#pragma unroll
            for (int j = 0; j < 4; ++j) v[j] = vn[j];
        }
    }
}
__device__ __forceinline__ void p0_side(LAS unsigned char* lds, const In& in, unsigned char* ws, int n0, int c0) {
    const int tid = threadIdx.x, lane = tid & 63, wave = __builtin_amdgcn_readfirstlane(tid >> 6);
    LAS float* scr = (LAS float*)(lds + wave * 16640);
    for (int it = c0 * 8 + wave; it < 16 * 16; it += n0 * 8) tr_item(in.w_out, D, D, (bf16_t*)(ws + WS_WOUT), scr, it / 16, it % 16, lane);
    const int gt = c0 * 512 + tid, NGT = n0 * 512;
    { float* GWT = (float*)(ws + WS_GWT); for (int i = gt; i < NE * D; i += NGT) { const int e = i >> 10, k = i & 1023; GWT[i] = in.norm2_g[k] * in.router_w[k * NE + e]; } }
    { float* BT = (float*)(ws + WS_BT); for (int i = gt; i < 36 * BT_N; i += NGT) { const int bh = i / BT_N, j = i % BT_N, b = bh / NH, h = bh % NH, dil = (b == 0) ? 1 : (b == 1 ? 4 : 16), d = j - BT_OFF;
        BT[i] = (d >= 0 && d <= 128) ? in.rel_bias[t5_bucket(d * dil) * NH + h] * LOG2E : NEGBIG; } }
    { bf16_t* PWT = (bf16_t*)(ws + WS_PWT); for (int i = gt; i < 4 * 64 * 64; i += NGT) { const int g = i >> 12, d = (i >> 6) & 63, cc = i & 63; PWT[i] = (bf16_t)(cvt_pk_bf16(in.pool_w[g * 4096 + cc * 64 + d], 0.f) & 0xffffu); } }
}

__device__ __forceinline__ s16x4 lds_tr16(const LAS unsigned char* p) { typedef short v4i16_t __attribute__((ext_vector_type(4))); return __builtin_bit_cast(s16x4, __builtin_amdgcn_ds_read_tr16_b64_v4i16((LAS v4i16_t*)p)); }
constexpr int ATT_UNITS = 3 * NH * 64, KV_PITCH = 144, KV_ROWS = 384, ATT_VOFF = KV_ROWS * KV_PITCH, ATT_TOFF = 2 * KV_ROWS * KV_PITCH, ATT_NEGOFF = ATT_TOFF + BT_N * 4;
__device__ __forceinline__ void attn_decode(int uid, int& b, int& h, int& r, int& j, int& dil) {
    const int bh = uid >> 6, x = uid & 63; b = bh / NH; h = bh % NH; dil = (b == 0) ? 1 : (b == 1 ? 4 : 16);
    const int nb = 64 / dil; r = x / nb; j = x % nb;
}
__device__ __forceinline__ void attn_phase(LAS unsigned char* lds, const bf16_t* __restrict__ Qg, const bf16_t* __restrict__ Kg, const bf16_t* __restrict__ Vg, const float* __restrict__ BT,
                                           bf16_t* __restrict__ OP, float* __restrict__ LSE, int G, int c) {
    const int tid = threadIdx.x, lane = tid & 63, w = __builtin_amdgcn_readfirstlane(tid >> 6), ql = lane & 15, g = lane >> 4;
    LAS unsigned char* Ks = lds; LAS unsigned char* Vs = lds + ATT_VOFF; LAS float* Tb = (LAS float*)(lds + ATT_TOFF); LAS float* Tneg = (LAS float*)(lds + ATT_NEGOFF);
    if (tid < 16) Tneg[tid] = NEGBIG;
    u32x4 kpre[6], vpre[6]; bf16x8 qa0, qa1, qb0, qb1; float tpre = 0.f;
#define ATT_PREFETCH(uid_) do { int b_, h_, r_, j_, dil_; attn_decode((uid_), b_, h_, r_, j_, dil_); \
        _Pragma("unroll") for (int cc = 0; cc < 6; ++cc) { const int id = tid + 512 * cc, row = id >> 3, ch = id & 7; int mm = 256 * j_ - 128 + row; if (mm < 0) mm += 128; \
            const size_t off = (size_t)(r_ + dil_ * mm) * AW + h_ * HD + ch * 8; kpre[cc] = *(const u32x4*)(Kg + off); vpre[cc] = *(const u32x4*)(Vg + off); } \
        { const size_t qo = (size_t)(r_ + dil_ * (256 * j_ + 32 * w + ql)) * AW + h_ * HD + 8 * g; const size_t qs = (size_t)16 * dil_ * AW; \
          qa0 = *(const bf16x8*)(Qg + qo); qa1 = *(const bf16x8*)(Qg + qo + 32); qb0 = *(const bf16x8*)(Qg + qo + qs); qb1 = *(const bf16x8*)(Qg + qo + qs + 32); } \
        if (tid < BT_N) tpre = BT[(b_ * NH + h_) * BT_N + tid]; } while (0)
#ifndef ATT_SYNC_LOAD
    if (c < ATT_UNITS) ATT_PREFETCH(c);
#endif
    for (int uid = c; uid < ATT_UNITS; uid += G) {
        int b, h, r, j, dil; attn_decode(uid, b, h, r, j, dil);
#ifdef ATT_SYNC_LOAD
        ATT_PREFETCH(uid);
#endif
#pragma unroll
        for (int cc = 0; cc < 6; ++cc) { const int id = tid + 512 * cc, row = id >> 3, ch = id & 7; *(LAS u32x4*)(Ks + row * KV_PITCH + ch * 16) = kpre[cc]; *(LAS u32x4*)(Vs + row * KV_PITCH + ch * 16) = vpre[cc]; }
        if (tid < BT_N) Tb[tid] = tpre;
        const bf16x8 fa0 = qa0, fa1 = qa1, fb0 = qb0, fb1 = qb1;
        __syncthreads();
#ifndef ATT_SYNC_LOAD
        if (uid + G < ATT_UNITS) ATT_PREFETCH(uid + G);
#endif
#if defined(MK_DOUBLE)
        for (int repc_ = 0; repc_ < (((MK_DOUBLE >> 13) & 1) ? 2 : 1); ++repc_) {
#else
        {
#endif
        const int kkmin = (j == 0) ? 128 : 0;
        const LAS unsigned char* kb = Ks + (32 * w + ql) * KV_PITCH + g * 16;
        const LAS float* Tq = Tb + (ql + 272 - 4 * g - 3);
        const f32x4 zero4 = (f32x4){0.f, 0.f, 0.f, 0.f};
        f32x4 sA[9], sB[9];
#pragma unroll
        for (int i = 0; i < 10; ++i) {
            const bf16x8 kf0 = *(const LAS bf16x8*)(kb + i * (16 * KV_PITCH)), kf1 = *(const LAS bf16x8*)(kb + i * (16 * KV_PITCH) + 64);
            const bool msk = (32 * w + 16 * i) < kkmin;
            if (i <= 8) { f32x4 st = __builtin_amdgcn_mfma_f32_16x16x32_bf16(kf0, fa0, zero4, 0, 0, 0); st = __builtin_amdgcn_mfma_f32_16x16x32_bf16(kf1, fa1, st, 0, 0, 0);
                const LAS float* tp = msk ? Tneg : (Tq - 16 * i); sA[i] = (f32x4){st[0] + tp[3], st[1] + tp[2], st[2] + tp[1], st[3] + tp[0]}; }
            if (i >= 1) { f32x4 st = __builtin_amdgcn_mfma_f32_16x16x32_bf16(kf0, fb0, zero4, 0, 0, 0); st = __builtin_amdgcn_mfma_f32_16x16x32_bf16(kf1, fb1, st, 0, 0, 0);
                const LAS float* tp = msk ? Tneg : (Tq - 16 * (i - 1)); sB[i - 1] = (f32x4){st[0] + tp[3], st[1] + tp[2], st[2] + tp[1], st[3] + tp[0]}; }
        }
        float mA = NEGBIG, mB = NEGBIG;
#pragma unroll
        for (int i = 0; i < 9; ++i) { mA = fmaxf(mA, fmaxf(fmaxf(sA[i][0], sA[i][1]), fmaxf(sA[i][2], sA[i][3]))); mB = fmaxf(mB, fmaxf(fmaxf(sB[i][0], sB[i][1]), fmaxf(sB[i][2], sB[i][3]))); }
        mA = fmaxf(mA, __shfl_xor(mA, 16)); mA = fmaxf(mA, __shfl_xor(mA, 32)); mB = fmaxf(mB, __shfl_xor(mB, 16)); mB = fmaxf(mB, __shfl_xor(mB, 32));
        f32x4 oA[4], oB[4];
#pragma unroll
        for (int dt = 0; dt < 4; ++dt) { oA[dt] = zero4; oB[dt] = zero4; }
        float lA = 0.f, lB = 0.f;
        const LAS unsigned char* vb = Vs + (32 * w + 4 * g + (ql >> 2)) * KV_PITCH + (ql & 3) * 8;
#pragma unroll
        for (int i = 0; i < 10; ++i) {
            const LAS unsigned char* vt = vb + i * (16 * KV_PITCH);
            const s16x4 v0 = lds_tr16(vt), v1 = lds_tr16(vt + 32), v2 = lds_tr16(vt + 64), v3 = lds_tr16(vt + 96);
            if (i <= 8) { const float p0 = __builtin_amdgcn_exp2f(sA[i][0] - mA), p1 = __builtin_amdgcn_exp2f(sA[i][1] - mA), p2 = __builtin_amdgcn_exp2f(sA[i][2] - mA), p3 = __builtin_amdgcn_exp2f(sA[i][3] - mA);
                lA += (p0 + p1) + (p2 + p3); u32x2 pw; pw.x = cvt_pk_bf16(p0, p1); pw.y = cvt_pk_bf16(p2, p3); const s16x4 pf = __builtin_bit_cast(s16x4, pw);
                oA[0] = __builtin_amdgcn_mfma_f32_16x16x16bf16_1k(v0, pf, oA[0], 0, 0, 0); oA[1] = __builtin_amdgcn_mfma_f32_16x16x16bf16_1k(v1, pf, oA[1], 0, 0, 0);
                oA[2] = __builtin_amdgcn_mfma_f32_16x16x16bf16_1k(v2, pf, oA[2], 0, 0, 0); oA[3] = __builtin_amdgcn_mfma_f32_16x16x16bf16_1k(v3, pf, oA[3], 0, 0, 0); }
            if (i >= 1) { const float p0 = __builtin_amdgcn_exp2f(sB[i - 1][0] - mB), p1 = __builtin_amdgcn_exp2f(sB[i - 1][1] - mB), p2 = __builtin_amdgcn_exp2f(sB[i - 1][2] - mB), p3 = __builtin_amdgcn_exp2f(sB[i - 1][3] - mB);
                lB += (p0 + p1) + (p2 + p3); u32x2 pw; pw.x = cvt_pk_bf16(p0, p1); pw.y = cvt_pk_bf16(p2, p3); const s16x4 pf = __builtin_bit_cast(s16x4, pw);
                oB[0] = __builtin_amdgcn_mfma_f32_16x16x16bf16_1k(v0, pf, oB[0], 0, 0, 0); oB[1] = __builtin_amdgcn_mfma_f32_16x16x16bf16_1k(v1, pf, oB[1], 0, 0, 0);
                oB[2] = __builtin_amdgcn_mfma_f32_16x16x16bf16_1k(v2, pf, oB[2], 0, 0, 0); oB[3] = __builtin_amdgcn_mfma_f32_16x16x16bf16_1k(v3, pf, oB[3], 0, 0, 0); }
        }
        lA += __shfl_xor(lA, 16); lA += __shfl_xor(lA, 32); lB += __shfl_xor(lB, 16); lB += __shfl_xor(lB, 32);
#ifdef ATT_EXP1
        lA = 1.0f; lB = 1.0f; mA = 0.f; mB = 0.f;
#pragma unroll
        for (int dt = 0; dt < 4; ++dt) { oA[dt] = zero4; oB[dt] = zero4; }
#endif
#ifdef ATT_EXP2
        lA = 1.0f; lB = 1.0f;
#pragma unroll
        for (int dt = 0; dt < 4; ++dt) { oA[dt] = zero4; oB[dt] = zero4; }
#endif
        const float iA = 1.0f / lA, iB = 1.0f / lB;
        const int posA = r + dil * (256 * j + 32 * w + ql), posB = posA + 16 * dil;
        bf16_t* dA = OP + ((size_t)b * S + posA) * AW + h * HD + 4 * g; bf16_t* dB = OP + ((size_t)b * S + posB) * AW + h * HD + 4 * g;
#pragma unroll
        for (int dt = 0; dt < 4; ++dt) { u32x2 t; t.x = cvt_pk_bf16(oA[dt][0] * iA, oA[dt][1] * iA); t.y = cvt_pk_bf16(oA[dt][2] * iA, oA[dt][3] * iA); *(u32x2*)(dA + 16 * dt) = t;
            u32x2 t2; t2.x = cvt_pk_bf16(oB[dt][0] * iB, oB[dt][1] * iB); t2.y = cvt_pk_bf16(oB[dt][2] * iB, oB[dt][3] * iB); *(u32x2*)(dB + 16 * dt) = t2; }
        if (g == 0) { LSE[((size_t)b * S + posA) * NH + h] = mA + __builtin_amdgcn_logf(lA); LSE[((size_t)b * S + posB) * NH + h] = mB + __builtin_amdgcn_logf(lB); }
        asm volatile("" ::: "memory");
        }
        __syncthreads();
    }
#undef ATT_PREFETCH
}

__device__ __forceinline__ void pool_phase(LAS unsigned char* lds, const bf16_t* __restrict__ U, const bf16_t* __restrict__ PWT, const float* __restrict__ pool_scale, bf16_t* __restrict__ MIX, int G, int c) {
    const int tid = threadIdx.x, lane = tid & 63, w = __builtin_amdgcn_readfirstlane(tid >> 6), ql = lane & 15, g = lane >> 4;
    LAS unsigned char* Us = lds; LAS unsigned char* Pl = lds + 40960;
    for (int pu = c; pu < S / 64; pu += G) {
        const int t0 = pu * 64;
        { u32x4 uv[5];
#pragma unroll
          for (int q = 0; q < 5; ++q) { const int id = tid + 512 * q, row = id >> 5, ch = id & 31, t = t0 - 15 + row; uv[q] = (u32x4){0u, 0u, 0u, 0u};
              if (id < 79 * 32 && t >= 0) uv[q] = *(const u32x4*)(U + (size_t)t * PW + ch * 8); }
#pragma unroll
          for (int q = 0; q < 5; ++q) { const int id = tid + 512 * q, row = id >> 5, ch = id & 31; if (id < 79 * 32) *(LAS u32x4*)(Us + row * 512 + ch * 16) = uv[q]; } }
        __syncthreads();
        { const int cch = tid & 255, th = tid >> 8, gg = cch >> 6, wn = 2 << gg, tl0 = 32 * th;
          const LAS bf16_t* up = (const LAS bf16_t*)Us + cch;
#define UAT(row) __uint_as_float(((unsigned)up[(row) * 256]) << 16)
          float sum = 0.f;
          for (int i = 0; i < wn; ++i) sum += UAT(tl0 + 15 - i);
          const float rcw = 1.0f / (float)wn;
#pragma unroll 8
          for (int tl = tl0; tl < tl0 + 32; ++tl) {
              const float cur = UAT(tl + 15);
              if (tl > tl0) sum += cur - UAT(tl + 15 - wn);
              const int t = t0 + tl; const float rc = (t + 1 < wn) ? __builtin_amdgcn_rcpf((float)(t + 1)) : rcw;
              const float val = sum * rc - cur;
              ((LAS bf16_t*)(Pl + tl * 528))[cch] = (bf16_t)(cvt_pk_bf16(val, 0.f) & 0xffffu);
          }
#undef UAT
        }
        __syncthreads();
        { const int tt = w & 3, gp = w >> 2;
#pragma unroll
          for (int gi = 0; gi < 2; ++gi) { const int gg = 2 * gp + gi;
              const bf16x8 b0 = *(const LAS bf16x8*)(Pl + (16 * tt + ql) * 528 + (gg * 64 + 8 * g) * 2), b1 = *(const LAS bf16x8*)(Pl + (16 * tt + ql) * 528 + (gg * 64 + 32 + 8 * g) * 2);
#pragma unroll
              for (int nt = 0; nt < 4; ++nt) {
                  const bf16_t* ap = PWT + ((size_t)(gg * 64 + 16 * nt + ql) * 64 + 8 * g);
                  const bf16x8 a0 = *(const bf16x8*)(ap), a1 = *(const bf16x8*)(ap + 32);
                  f32x4 acc = __builtin_amdgcn_mfma_f32_16x16x32_bf16(a0, b0, (f32x4){0.f, 0.f, 0.f, 0.f}, 0, 0, 0);
                  acc = __builtin_amdgcn_mfma_f32_16x16x32_bf16(a1, b1, acc, 0, 0, 0);
                  const f32x4 ps = *(const f32x4*)(pool_scale + gg * 64 + 16 * nt + 4 * g);
                  u32x2 o; o.x = cvt_pk_bf16(acc[0] * ps[0], acc[1] * ps[1]); o.y = cvt_pk_bf16(acc[2] * ps[2], acc[3] * ps[3]);
                  *(u32x2*)(MIX + (size_t)(t0 + 16 * tt + ql) * D + gg * 64 + 16 * nt + 4 * g) = o;
              } }
        }
        __syncthreads();
    }
}

__device__ __forceinline__ void combine_phase(const bf16_t* __restrict__ OP, const float* __restrict__ LSE, bf16_t* __restrict__ MIX, int G, int c) {
    const int gt = c * 512 + threadIdx.x, NGT = G * 512;
    for (int id = gt; id < S * 96; id += NGT) {
        const int t = id / 96, rem = id % 96, h = rem >> 3, c8 = rem & 7;
        const float l0 = LSE[(size_t)t * NH + h], l1 = LSE[((size_t)S + t) * NH + h], l2 = LSE[((size_t)2 * S + t) * NH + h];
        const float mx = fmaxf(l0, fmaxf(l1, l2));
        float w0 = __builtin_amdgcn_exp2f(l0 - mx), w1 = __builtin_amdgcn_exp2f(l1 - mx), w2 = __builtin_amdgcn_exp2f(l2 - mx);
        const float inv = 1.0f / (w0 + w1 + w2); w0 *= inv; w1 *= inv; w2 *= inv;
        const size_t off = (size_t)t * AW + h * HD + c8 * 8;
        const u32x4 a = __builtin_nontemporal_load((const u32x4*)(OP + off)), b = __builtin_nontemporal_load((const u32x4*)(OP + (size_t)S * AW + off)), cc = __builtin_nontemporal_load((const u32x4*)(OP + (size_t)2 * S * AW + off));
        u32x4 o;
#pragma unroll
        for (int k = 0; k < 4; ++k) { const float lo = w0 * bf_lo(a[k]) + w1 * bf_lo(b[k]) + w2 * bf_lo(cc[k]), hi = w0 * bf_hi(a[k]) + w1 * bf_hi(b[k]) + w2 * bf_hi(cc[k]); o[k] = cvt_pk_bf16(lo, hi); }
        *(u32x4*)(MIX + (size_t)t * D + PW + h * HD + c8 * 8) = o;
    }
}

constexpr int GW_PITCH = 1028;
constexpr int RT_G2 = 131584, RT_LG = RT_G2 + 4096, RT_RS = RT_LG + 4 * 16 * 33 * 4, RT_CNT = RT_RS + 256, RT_PART = RT_CNT + 256, RT_END = RT_PART + 4 * 64 * 9 * 4;
static_assert(RT_END <= LDS_CTL, "router LDS map");
__device__ __forceinline__ void router_phase(LAS unsigned char* lds, const float* __restrict__ X1, const float* __restrict__ g2, const float* __restrict__ GWT, const float* __restrict__ rb,
                                             unsigned char* __restrict__ H, float* __restrict__ RSTD, float* __restrict__ GATES, int* __restrict__ ROWS, unsigned* __restrict__ COUNTS, int G, int c) {
    const int tid = threadIdx.x, lane = tid & 63, w = __builtin_amdgcn_readfirstlane(tid >> 6), ql = lane & 15, g = lane >> 4;
    const int ts = w & 3, kh = w >> 2;
    LAS float* GW = (LAS float*)lds;
    LAS float* G2 = (LAS float*)(lds + RT_G2);
    LAS float* LG = (LAS float*)(lds + RT_LG) + ts * (16 * 33);
    LAS float* RS = (LAS float*)(lds + RT_RS) + ts * 16;
    LAS int* LCNT = (LAS int*)(lds + RT_CNT);
    LAS int* LBASE = LCNT + 32;
    LAS float* PART = (LAS float*)(lds + RT_PART) + ts * (64 * 9);
    const int nrounds = (S / 16 + 4 * G - 1) / (4 * G);
    for (int rd = 0; rd < nrounds; ++rd) {
        const int tile = (rd * 4 + ts) * G + c;
        const bool active = tile < S / 16;
        const int tok = (active ? tile : 0) * 16 + ql;
        const float* xr = X1 + (size_t)tok * D + kh * 512 + 8 * g;
        f32x4 av0[16];
        if (active) {
#pragma unroll
            for (int i = 0; i < 8; ++i) { av0[2 * i] = __builtin_nontemporal_load((const f32x4*)(xr + 32 * i)); av0[2 * i + 1] = __builtin_nontemporal_load((const f32x4*)(xr + 32 * i + 4)); } }
        if (rd == 0) {
            f32x4 gx[16];
#pragma unroll
            for (int q = 0; q < 16; ++q) { const int id = tid + 512 * q, e = id >> 8, k4 = id & 255; gx[q] = *(const f32x4*)(GWT + e * D + k4 * 4); }
#pragma unroll
            for (int q = 0; q < 16; ++q) { const int id = tid + 512 * q, e = id >> 8, k4 = id & 255; *(LAS f32x4*)(GW + e * GW_PITCH + k4 * 4) = gx[q]; }
            if (tid < 256) *(LAS f32x4*)(G2 + tid * 4) = *(const f32x4*)(g2 + tid * 4);
        }
        if (tid < 32) LCNT[tid] = 0;
        __syncthreads();
        int ek[4] = {0, 0, 0, 0}, lp[4] = {0, 0, 0, 0}; float gk[4] = {0.f, 0.f, 0.f, 0.f};
        f32x4 acc0 = (f32x4){0.f, 0.f, 0.f, 0.f}, acc1 = acc0; float ss = 0.f;
        if (active) {
            unsigned char* hr = H + (size_t)tok * D + kh * 512 + 8 * g;
            const LAS float* w0p = GW + ql * GW_PITCH + kh * 512 + 8 * g; const LAS float* w1p = GW + (16 + ql) * GW_PITCH + kh * 512 + 8 * g;
            const LAS float* gp = G2 + kh * 512 + 8 * g;
            f32x4 av1[16];
#pragma unroll
            for (int i = 0; i < 8; ++i) { av1[2 * i] = __builtin_nontemporal_load((const f32x4*)(xr + 256 + 32 * i)); av1[2 * i + 1] = __builtin_nontemporal_load((const f32x4*)(xr + 256 + 32 * i + 4)); }
#define RT_CHUNKS(AV, KB) do { _Pragma("unroll") for (int i = 0; i < 8; ++i) { \
                    const int k0 = (KB) + 32 * i; const f32x4 a0 = AV[2 * i], a1 = AV[2 * i + 1]; \
                    const f32x4 n0 = *(const LAS f32x4*)(gp + k0), n1 = *(const LAS f32x4*)(gp + k0 + 4); \
                    const f32x4 b00 = *(const LAS f32x4*)(w0p + k0), b01 = *(const LAS f32x4*)(w0p + k0 + 4), b10 = *(const LAS f32x4*)(w1p + k0), b11 = *(const LAS f32x4*)(w1p + k0 + 4); \
                    ss += (a0[0] * a0[0] + a0[1] * a0[1]) + (a0[2] * a0[2] + a0[3] * a0[3]) + (a1[0] * a1[0] + a1[1] * a1[1]) + (a1[2] * a1[2] + a1[3] * a1[3]); \
                    u32x2 hv; hv.x = cvt4_fp8(a0[0] * n0[0] * HSCALE, a0[1] * n0[1] * HSCALE, a0[2] * n0[2] * HSCALE, a0[3] * n0[3] * HSCALE); \
                    hv.y = cvt4_fp8(a1[0] * n1[0] * HSCALE, a1[1] * n1[1] * HSCALE, a1[2] * n1[2] * HSCALE, a1[3] * n1[3] * HSCALE); \
                    *(u32x2*)(hr + k0) = hv; \
                    _Pragma("unroll") for (int jj = 0; jj < 4; ++jj) { acc0 = __builtin_amdgcn_mfma_f32_16x16x4f32(a0[jj], b00[jj], acc0, 0, 0, 0); acc1 = __builtin_amdgcn_mfma_f32_16x16x4f32(a0[jj], b10[jj], acc1, 0, 0, 0); } \
                    _Pragma("unroll") for (int jj = 0; jj < 4; ++jj) { acc0 = __builtin_amdgcn_mfma_f32_16x16x4f32(a1[jj], b01[jj], acc0, 0, 0, 0); acc1 = __builtin_amdgcn_mfma_f32_16x16x4f32(a1[jj], b11[jj], acc1, 0, 0, 0); } } } while (0)
            RT_CHUNKS(av0, 0);
            RT_CHUNKS(av1, 256);
#undef RT_CHUNKS
            if (kh == 1) { LAS float* pp = PART + lane * 9;
#pragma unroll
                for (int i = 0; i < 4; ++i) { pp[i] = acc0[i]; pp[4 + i] = acc1[i]; } pp[8] = ss; }
        }
        __syncthreads();
        if (active && kh == 0) {
            { const LAS float* pp = PART + lane * 9;
#pragma unroll
              for (int i = 0; i < 4; ++i) { acc0[i] += pp[i]; acc1[i] += pp[4 + i]; } ss += pp[8]; }
            ss += __shfl_xor(ss, 16); ss += __shfl_xor(ss, 32);
            const float rstd = rsqrtf(ss * (1.0f / D) + RMS_EPS);
            if (g == 0) { RSTD[tok] = rstd; RS[ql] = rstd; }
            LDS_WAIT();
            const float rb0 = rb[ql], rb1 = rb[16 + ql];
#pragma unroll
            for (int rg = 0; rg < 4; ++rg) { const float rr = RS[4 * g + rg]; LG[(4 * g + rg) * 33 + ql] = acc0[rg] * rr + rb0; LG[(4 * g + rg) * 33 + 16 + ql] = acc1[rg] * rr + rb1; }
            LDS_WAIT();
            if (lane < 16) {
                float v[32];
#pragma unroll
                for (int e = 0; e < 32; ++e) v[e] = LG[ql * 33 + e];
                float tv[4];
#pragma unroll
                for (int r = 0; r < 4; ++r) { float best = v[0]; int bi = 0;
#pragma unroll
                    for (int e = 1; e < 32; ++e) { const bool gt = v[e] > best; best = gt ? v[e] : best; bi = gt ? e : bi; }
                    tv[r] = best; ek[r] = bi;
#pragma unroll
                    for (int e = 0; e < 32; ++e) v[e] = (e == bi) ? -INFINITY : v[e]; }
                const float e1 = __expf(tv[1] - tv[0]), e2 = __expf(tv[2] - tv[0]), e3 = __expf(tv[3] - tv[0]); const float inv = 1.0f / (1.0f + e1 + e2 + e3);
                gk[0] = inv; gk[1] = e1 * inv; gk[2] = e2 * inv; gk[3] = e3 * inv;
#pragma unroll
                for (int r = 0; r < 4; ++r) lp[r] = __hip_atomic_fetch_add(LCNT + ek[r], 1, __ATOMIC_RELAXED, __HIP_MEMORY_SCOPE_WORKGROUP);
            }
        }
        __syncthreads();
        if (tid < 32) { const int n = LCNT[tid]; int base = 0; if (n > 0) base = (int)__hip_atomic_fetch_add(COUNTS + tid, (unsigned)n, __ATOMIC_RELAXED, __HIP_MEMORY_SCOPE_AGENT); LBASE[tid] = base; }
        __syncthreads();
        if (active && kh == 0 && lane < 16) {
#pragma unroll
            for (int r = 0; r < 4; ++r) { const int pos = LBASE[ek[r]] + lp[r]; ROWS[(size_t)ek[r] * S + pos] = tok * 4 + r; GATES[tok * 4 + r] = gk[r]; }
#ifdef RT_HASH
            RSTD[S + tok] = gk[0] * (ek[0] + 1) + gk[1] * (ek[1] + 1) + gk[2] * (ek[2] + 1) + gk[3] * (ek[3] + 1);
#endif
        }
        __syncthreads();
    }
}

__device__ __forceinline__ void moe_prefix(LAS int* tpre, LAS int* lcnt, const unsigned* __restrict__ COUNTS) {
    if (threadIdx.x < 32) lcnt[threadIdx.x] = (int)COUNTS[threadIdx.x];
    __syncthreads();
    if (threadIdx.x == 0) { int acc = 0; for (int e = 0; e < NE; ++e) { tpre[e] = acc; acc += (lcnt[e] + 255) >> 8; } tpre[NE] = acc; }
    __syncthreads();
}
template <bool GU, class Prob> __device__ __forceinline__ void moe_table(const Prob& P, LAS int* udesc, LAS int* tab, LAS float* tabf, LAS float* tabb, const LAS int* lcnt, const int* __restrict__ ROWS,
                                                                         const float* __restrict__ rowf, const float* __restrict__ bias) {
    if (threadIdx.x < MAXU) { Unit u0; u0.e = 0; u0.pm = 0; u0.pn = 0; u0.slot = 0; const bool ok = P.search((int)threadIdx.x, u0);
        udesc[4 * threadIdx.x] = u0.e; udesc[4 * threadIdx.x + 1] = u0.pm; udesc[4 * threadIdx.x + 2] = u0.pn; udesc[4 * threadIdx.x + 3] = ok ? 1 : 0; }
    __syncthreads();
    constexpr int NQ = (MAXU * 256 + 511) / 512;
    int idx[NQ]; float fv[NQ], bvv[NQ];
#pragma unroll
    for (int q = 0; q < NQ; ++q) { const int j = (int)threadIdx.x + 512 * q, i = j >> 8, r = j & 255; idx[q] = -2;
        if (i < MAXU && udesc[4 * i + 3]) { const int e = udesc[4 * i], rr = udesc[4 * i + 1] * 256 + r; idx[q] = (rr < lcnt[e]) ? ROWS[(size_t)e * S + rr] : -1; } }
#pragma unroll
    for (int q = 0; q < NQ; ++q) { const int j = (int)threadIdx.x + 512 * q, i = j >> 8, c2 = j & 255; fv[q] = 0.f; bvv[q] = 0.f;
        if (idx[q] != -2) { const int e = udesc[4 * i], pn = udesc[4 * i + 2];
            fv[q] = GU ? rowf[idx[q] < 0 ? 0 : (idx[q] >> 2)] * (1.0f / (HSCALE * WSCALE)) : (idx[q] < 0 ? 0.f : rowf[idx[q]]);
            bvv[q] = GU ? bias[(size_t)e * 2 * DFF + (c2 >> 7) * DFF + pn * 128 + (c2 & 127)] : bias[(size_t)e * D + pn * 256 + c2]; } }
#pragma unroll
    for (int q = 0; q < NQ; ++q) { const int j = (int)threadIdx.x + 512 * q; if (idx[q] != -2) { tab[j] = idx[q]; tabf[j] = fv[q]; tabb[j] = bvv[q]; } }
    __syncthreads();
}

__device__ __forceinline__ void final_phase(const float* __restrict__ X1, const unsigned char* __restrict__ Y, const float* __restrict__ fg, float* __restrict__ out, int G, int c) {
    const int tid = threadIdx.x, lane = tid & 63, wave = tid >> 6; const int gw = c * 8 + wave, NGW = G * 8;
    f32x4 gv[4];
#pragma unroll
    for (int j = 0; j < 4; ++j) gv[j] = *(const f32x4*)(fg + 4 * lane + 256 * j);
    for (int m = gw; m < S; m += NGW) {
        const float* xr = X1 + (size_t)m * D + 4 * lane;
        f32x4 v[4];
#pragma unroll
        for (int j = 0; j < 4; ++j) v[j] = __builtin_nontemporal_load((const f32x4*)(xr + 256 * j));

#ifdef RT_HASH
        { const float extra = ((const float*)Y)[m];
#pragma unroll
          for (int j = 0; j < 4; ++j) { v[j][0] += __sinf(extra * (float)(4 * lane + 256 * j + 1)); v[j][1] += __sinf(extra * (float)(4 * lane + 256 * j + 2)); v[j][2] += __sinf(extra * (float)(4 * lane + 256 * j + 3)); v[j][3] += __sinf(extra * (float)(4 * lane + 256 * j + 4)); } }
#endif
#ifdef FIN_HASH
#pragma unroll
        for (int j = 0; j < 4; ++j) { v[j][0] = __sinf(v[j][0] * 1.0e6f); v[j][1] = __sinf(v[j][1] * 1.0e6f); v[j][2] = __sinf(v[j][2] * 1.0e6f); v[j][3] = __sinf(v[j][3] * 1.0e6f); }
#endif
#pragma unroll
#if defined(FIN_HASH) || defined(RT_HASH)
        for (int k = 0; k < 0; ++k) { const unsigned char* yr = Y + ((size_t)m * 4 + k) * D + 4 * lane;
#else
        for (int k = 0; k < 4; ++k) { const unsigned char* yr = Y + ((size_t)m * 4 + k) * D + 4 * lane;
#endif
#pragma unroll
            for (int j = 0; j < 4; ++j) { const int t = __builtin_nontemporal_load((const int*)(yr + 256 * j)); const f32x2 lo = __builtin_amdgcn_cvt_pk_f32_fp8(t, false), hi = __builtin_amdgcn_cvt_pk_f32_fp8(t, true);
                v[j][0] += lo[0] * (1.0f / YSCALE); v[j][1] += lo[1] * (1.0f / YSCALE); v[j][2] += hi[0] * (1.0f / YSCALE); v[j][3] += hi[1] * (1.0f / YSCALE); } }
#ifdef FIN_HASH2
#pragma unroll
        for (int j = 0; j < 4; ++j) { v[j][0] = __sinf(v[j][0] * 3.0e3f); v[j][1] = __sinf(v[j][1] * 3.0e3f); v[j][2] = __sinf(v[j][2] * 3.0e3f); v[j][3] = __sinf(v[j][3] * 3.0e3f); }
#endif
        float s = 0.f;
#pragma unroll
        for (int j = 0; j < 4; ++j) s += (v[j][0] * v[j][0] + v[j][1] * v[j][1]) + (v[j][2] * v[j][2] + v[j][3] * v[j][3]);
        const float rstd = rsqrtf(wave_sum(s) * (1.0f / D) + RMS_EPS);
#pragma unroll
        for (int j = 0; j < 4; ++j) __builtin_nontemporal_store(v[j] * rstd * gv[j], (f32x4*)(out + (size_t)m * D + 4 * lane + 256 * j));
    }
}

constexpr int NPHASE = 9;
struct Args { In in; float* out; unsigned char* ws; int ph_lo, ph_hi; };
__global__ void __launch_bounds__(512, 2) fwd(Args args) {
    extern __shared__ __attribute__((aligned(16))) unsigned char lds_raw[];
    LAS unsigned char* lds = (LAS unsigned char*)lds_raw;
    const int tid = threadIdx.x, G = gridDim.x, c = blockIdx.x;
    unsigned char* ws = args.ws; const In& in = args.in;
    unsigned* ctl = (unsigned*)(ws + WS_CTL);
    LAS int* LCTL = (LAS int*)(lds + LDS_CTL);
    if (tid < 256) LCTL[tid] = 0;
    __syncthreads();
    const int lo = args.ph_lo, hi = args.ph_hi;
    const bool one_launch = (hi - lo) > 1;
    XcdBarrier bar; bar.bar = ctl + CW_BAR; bar.x = 0; bar.st = nullptr;
    if (one_launch) bar = xcd_barrier_post(ctl + CW_BAR, (volatile LAS unsigned*)LCTL);
#define IN(k) (lo <= (k) && (k) < hi)
#ifndef MK_DOUBLE
#define MK_DOUBLE 0
#endif
#define REP(k) for (int rep_ = 0; rep_ < ((((MK_DOUBLE) >> (k)) & 1) ? 2 : 1); ++rep_)
#define SEAM(k) do { if (IN((k) + 1)) xcd_barrier(bar); } while (0)
    bf16_t* Hb = (bf16_t*)(ws + WS_H); bf16_t* Ub = (bf16_t*)(ws + WS_U); bf16_t* Qb = (bf16_t*)(ws + WS_Q); bf16_t* Kb = (bf16_t*)(ws + WS_K); bf16_t* Vb = (bf16_t*)(ws + WS_V);
    bf16_t* OPb = (bf16_t*)(ws + WS_OP); bf16_t* MIXb = (bf16_t*)(ws + WS_MIX); float* X1 = (float*)(ws + WS_X1); unsigned char* ACTb = ws + WS_ACT; unsigned char* Yb = ws + WS_Y; unsigned char* H8 = ws + WS_H8;
    float* LSE = (float*)(ws + WS_LSE); float* RSTD = (float*)(ws + WS_RSTD); float* GATES = (float*)(ws + WS_GATES); int* ROWS = (int*)(ws + WS_ROWS); unsigned* COUNTS = ctl + CW_COUNTS;
    LAS int* TPRE = LCTL + 16; LAS int* LCNT = LCTL + 128; LAS int* UDESC = LCTL + 192; LAS int* TAB = (LAS int*)(lds + LDS_TAB); LAS float* TABF = (LAS float*)(lds + LDS_TAB + MAXU * 1024); LAS float* TABB = (LAS float*)(lds + LDS_TAB + 2 * MAXU * 1024);
    static_assert(LDS_TAB + 3 * MAXU * 1024 <= LDS_CTL, "MoE LDS tables");

    if (IN(0)) { REP(0) p0_prologue(lds, in, ws, G, c); SEAM(0); }
    if (IN(1)) {
        const int NG = (G >= 256) ? 128 : G;
        if (c < NG) {
            pg8::DenseProb P{(const char*)Hb, (const char*)(ws + WS_WIN), D * 2, S / 256, NPROJ / 256, NG, c, (size_t)128 * D * 2};
            EpiQKVU E{ws};
            REP(1) pg8::gemm_phase<EpiQKVU, pg8::DenseProb, true, false>(lds, P, E);
        }
        else p0_side(lds, in, ws, G - NG, c - NG);
        if (NG == G) p0_side(lds, in, ws, G, c);
        convert8_queue(lds, in, ws, ctl + CW_QUEUE);
        SEAM(1);
    }
    if (IN(2)) {
        REP(2) attn_phase(lds, Qb, Kb, Vb, (const float*)(ws + WS_BT), OPb, LSE, G, c);
        REP(9) pool_phase(lds, Ub, (const bf16_t*)(ws + WS_PWT), in.pool_scale, MIXb, G, c);
        SEAM(2);
    }
    if (IN(3)) { REP(3) combine_phase(OPb, LSE, MIXb, G, c); SEAM(3); }
    if (IN(4)) {
        pg8::DenseProb P{(const char*)MIXb, (const char*)(ws + WS_WOUT), D * 2, S / 256, D / 256, G, c, (size_t)128 * D * 2};
        EpiResF32 E{in.x, X1};
        REP(4) pg8::gemm_phase<EpiResF32, pg8::DenseProb, true, false>(lds, P, E);
        SEAM(4);
    }
    if (IN(5)) { router_phase(lds, X1, in.norm2_g, (const float*)(ws + WS_GWT), in.router_b, H8, RSTD, GATES, ROWS, COUNTS, G, c); SEAM(5); }
    if (IN(6)) {
        moe_prefix(TPRE, LCNT, COUNTS);
        pg8::MoeProb<true> P{(const char*)H8, (const char*)(ws + WS_WGU), D, 8, G, c, (size_t)DFF * D, (size_t)2 * DFF * D, 128, TPRE, TAB, UDESC};
        moe_table<true>(P, UDESC, TAB, TABF, TABB, LCNT, ROWS, RSTD, in.b_gate_up);
        EpiGateUp E{ACTb, TPRE, TABF, TABB};
        REP(6) pg8::gemm_phase<EpiGateUp, pg8::MoeProb<true>, true, true>(lds, P, E);
        SEAM(6);
    }
    if (IN(7)) {
        moe_prefix(TPRE, LCNT, COUNTS);
        pg8::MoeProb<false> P{(const char*)ACTb, (const char*)(ws + WS_WD), DFF, 4, G, c, (size_t)128 * DFF, (size_t)D * DFF, 256, TPRE, TAB, UDESC};
        moe_table<false>(P, UDESC, TAB, TABF, TABB, LCNT, ROWS, GATES, in.b_down);
        EpiDown E{Yb, TAB, TABF, TABB};
        REP(7) pg8::gemm_phase<EpiDown, pg8::MoeProb<false>, true, true>(lds, P, E);
        SEAM(7);
    }

#ifdef RT_HASH
    if (IN(8)) REP(8) final_phase(X1, (const unsigned char*)(RSTD + S), in.final_g, args.out, G, c);
#else
    if (IN(8)) REP(8) final_phase(X1, Yb, in.final_g, args.out, G, c);
#endif

#undef IN
#undef SEAM
}

#ifndef MK_N_LAUNCHES
#define MK_N_LAUNCHES 1
#endif
#ifndef MK_SEQ
#define MK_SEQ "012345678"
#endif
extern "C" void kernel_launch(void* const* d_in, const int* in_sizes, int n_in, void* d_out, int out_size, void* d_ws, size_t ws_size, hipStream_t stream) {
    static int grid = 0;
    if (grid == 0) {
        if (n_in != 15 || out_size != S * D || ws_size < WS_END) { fprintf(stderr, "kernel_launch: unexpected problem (n_in %d out %d ws %zu)\n", n_in, out_size, ws_size); grid = -1; return; }
        int dev = 0, cus = 0, per_cu = 0;
        if (hipGetDevice(&dev) != hipSuccess || hipDeviceGetAttribute(&cus, hipDeviceAttributeMultiprocessorCount, dev) != hipSuccess) { grid = -1; return; }
        if (hipFuncSetAttribute((const void*)fwd, hipFuncAttributeMaxDynamicSharedMemorySize, LDS_BYTES) != hipSuccess) { fprintf(stderr, "kernel_launch: hipFuncSetAttribute failed\n"); grid = -1; return; }
        if (hipOccupancyMaxActiveBlocksPerMultiprocessor(&per_cu, (const void*)fwd, 512, LDS_BYTES) != hipSuccess || per_cu < 1) { fprintf(stderr, "kernel_launch: occupancy query says %d blocks per CU\n", per_cu); (void)hipGetLastError(); per_cu = 1; }
        grid = cus;
    }
    if (grid < 0) return;
    if (hipMemsetAsync((char*)d_ws + WS_CTL, 0, CTL_ZERO_BYTES, stream) != hipSuccess) { fprintf(stderr, "kernel_launch: memset failed\n"); return; }
    Args a{};
    a.in.x = (const float*)d_in[0]; a.in.norm1_g = (const float*)d_in[1]; a.in.w_in = (const float*)d_in[2]; a.in.pool_w = (const float*)d_in[3]; a.in.pool_scale = (const float*)d_in[4];
    a.in.rel_bias = (const float*)d_in[5]; a.in.w_out = (const float*)d_in[6]; a.in.norm2_g = (const float*)d_in[7]; a.in.router_w = (const float*)d_in[8]; a.in.router_b = (const float*)d_in[9];
    a.in.w_gate_up = (const float*)d_in[10]; a.in.b_gate_up = (const float*)d_in[11]; a.in.w_down = (const float*)d_in[12]; a.in.b_down = (const float*)d_in[13]; a.in.final_g = (const float*)d_in[14];
    a.out = (float*)d_out; a.ws = (unsigned char*)d_ws;
    if (MK_N_LAUNCHES == 1) { a.ph_lo = 0; a.ph_hi = NPHASE; hipLaunchKernelGGL(fwd, dim3(grid), dim3(512), LDS_BYTES, stream, a); }
    else { const char* seq = MK_SEQ; for (int i = 0; seq[i]; ++i) { const int p = seq[i] - '0'; a.ph_lo = p; a.ph_hi = p + 1; if (p == 5) (void)hipMemsetAsync((char*)d_ws + WS_CTL + CW_COUNTS * 4, 0, 128, stream); hipLaunchKernelGGL(fwd, dim3(grid), dim3(512), LDS_BYTES, stream, a); } }
    const hipError_t le = hipPeekAtLastError();
    if (le != hipSuccess) fprintf(stderr, "kernel_launch: launch failed: %s\n", hipGetErrorName(le));
}
```

```cpp
#include <hip/hip_runtime.h>
#include <cstdio>
#include <cstdint>

#define LAS __attribute__((address_space(3)))
#define GAS __attribute__((address_space(1)))
typedef unsigned short bf16_t;
typedef short bf16x8 __attribute__((ext_vector_type(8)));
typedef short s16x4 __attribute__((ext_vector_type(4)));
typedef float f32x4 __attribute__((ext_vector_type(4)));
typedef float f32x2 __attribute__((ext_vector_type(2)));
typedef unsigned u32x4 __attribute__((ext_vector_type(4)));
typedef unsigned u32x2 __attribute__((ext_vector_type(2)));
typedef int i32x4 __attribute__((ext_vector_type(4)));
typedef int i32x8 __attribute__((ext_vector_type(8)));

constexpr int S = 16384, D = 1024, NPROJ = 2560, PW = 256, AW = 768, NH = 12, HD = 64, NE = 32, TOPK = 4, DFF = 1024;
constexpr float RMS_EPS = 1e-5f, LOG2E = 1.4426950408889634f, QSCALE = 0.125f * LOG2E, NEGBIG = -1e30f;
constexpr float WSCALE = 64.0f, HSCALE = 16.0f, ASCALE = 8.0f, YSCALE = 64.0f, MSCALE = 16.0f, OSCALE = 64.0f, FP8MAX = 448.0f;
constexpr int BT_N = 400, BT_OFF = 144;

constexpr size_t MiB = 1u << 20;
constexpr size_t WS_CTL = 0, CTL_ZERO_BYTES = 32 * 1024;
constexpr size_t WS_WIN = 2 * MiB;
constexpr size_t WS_WOUT = 8 * MiB;
constexpr size_t WS_GWT = 10 * MiB;
constexpr size_t WS_BT = 10 * MiB + 512 * 1024;
constexpr size_t WS_PWT = 10 * MiB + 768 * 1024;
constexpr size_t WS_RSTD = 11 * MiB;
constexpr size_t WS_GATES = 11 * MiB + 256 * 1024;
constexpr size_t WS_ROWS = 12 * MiB;
constexpr size_t WS_LSE = 14 * MiB;
constexpr size_t WS_WGU = 32 * MiB;
constexpr size_t WS_WD = 160 * MiB;
constexpr size_t WS_H8 = 200 * MiB;
constexpr size_t WS_H = 224 * MiB;
constexpr size_t WS_U = 256 * MiB;
constexpr size_t WS_Q = 264 * MiB, WS_K = 288 * MiB, WS_V = 312 * MiB;
constexpr size_t WS_OP = 336 * MiB;
constexpr size_t WS_MIX = 408 * MiB;
constexpr size_t WS_X1 = 440 * MiB;
constexpr size_t WS_ACT = 512 * MiB;
constexpr size_t WS_Y = 656 * MiB;
constexpr size_t WS_END = 784 * MiB;
constexpr int ACT_ROWS = 65536 + 32 * 256;
constexpr int CW_COUNTS = 64;
constexpr int CW_QUEUE = 256;
constexpr int CW_BAR = 4096;

constexpr int LDS_BYTES = 163840;
constexpr int LDS_TAB = 131072;
constexpr int LDS_CTL = LDS_BYTES - 1024;
constexpr int MAXU = 9;

typedef __bf16 bf16x2_t __attribute__((ext_vector_type(2)));
__device__ __forceinline__ unsigned cvt_pk_bf16(float lo, float hi) { const f32x2 v = {lo, hi}; const bf16x2_t b = __builtin_convertvector(v, bf16x2_t); return __builtin_bit_cast(unsigned, b); }
__device__ __forceinline__ float clamp8(float v) { return __builtin_amdgcn_fmed3f(v, -FP8MAX, FP8MAX); }
__device__ __forceinline__ unsigned cvt4_fp8(float a, float b, float c, float d) {
    int p = __builtin_amdgcn_cvt_pk_fp8_f32(clamp8(a), clamp8(b), 0, false); p = __builtin_amdgcn_cvt_pk_fp8_f32(clamp8(c), clamp8(d), p, true); return (unsigned)p; }
__device__ __forceinline__ float bf_lo(unsigned w) { return __uint_as_float(w << 16); }
__device__ __forceinline__ float bf_hi(unsigned w) { return __uint_as_float(w & 0xffff0000u); }
__device__ __forceinline__ float wave_sum(float v) {
#pragma unroll
    for (int o = 1; o < 64; o <<= 1) v += __shfl_xor(v, o);
    return v;
}
#define LDS_WAIT() asm volatile("s_waitcnt lgkmcnt(0)" ::: "memory")
#define VM_WAIT() asm volatile("s_waitcnt vmcnt(0)" ::: "memory")

#define XB_TMO      128
#define XB_XCNT(j)  (256  + 64 * (j))
#define XB_XSUB(j)  (1280 + 64 * (j))
#define XB_XGEN(j)  (2304 + 64 * (j))
#define XB_TOP      3328
#define XB_TOPGEN   3392
#define XCD_BAR_WORDS 3456
#define XB_SPIN_CAP (1u << 18)
__device__ __forceinline__ unsigned xb_ld(unsigned* p)              { return __hip_atomic_load(p, __ATOMIC_RELAXED, __HIP_MEMORY_SCOPE_AGENT); }
__device__ __forceinline__ unsigned xb_add(unsigned* p, unsigned v) { return __hip_atomic_fetch_add(p, v, __ATOMIC_RELAXED, __HIP_MEMORY_SCOPE_AGENT); }
__device__ __forceinline__ unsigned xb_xcc_id() { return (unsigned)__builtin_amdgcn_s_getreg((3 << 11) | 20) & 0xFu; }
#define XB_SPIN(cond, bar) do { unsigned _sp = 0; while (cond) { __builtin_amdgcn_s_sleep(1); \
    if ((++_sp & 255u) == 0u) { if (xb_ld(&(bar)[XB_TMO])) break; if (_sp > XB_SPIN_CAP) { atomicAdd(&(bar)[XB_TMO], 1u); break; } } } } while (0)
struct XcdBarrier { unsigned* bar; unsigned x; volatile LAS unsigned* st; };
__device__ __forceinline__ XcdBarrier xcd_barrier_post(unsigned* bar, volatile LAS unsigned* st) {
    XcdBarrier b; b.bar = bar; b.x = xb_xcc_id(); b.st = st;
    if (threadIdx.x == 0) (void)xb_add(&bar[XB_XCNT(b.x)], 1u);
    return b;
}
__device__ __forceinline__ void xcd_barrier_complete(unsigned* bar, unsigned x, unsigned& nloc, unsigned& nx) {
    const unsigned G = gridDim.x * gridDim.y * gridDim.z;
    unsigned sum, cnt, mine, sp = 0u;
    for (;;) {
        sum = 0u; cnt = 0u; mine = 0u;
#pragma unroll
        for (unsigned j = 0; j < 16; ++j) { const unsigned c = xb_ld(&bar[XB_XCNT(j)]); sum += c; cnt += (c > 0u) ? 1u : 0u; mine = (j == x) ? c : mine; }
        if (sum == G) break;
        __builtin_amdgcn_s_sleep(1);
        if ((++sp & 255u) == 0u) { if (xb_ld(&bar[XB_TMO])) break; if (sp > XB_SPIN_CAP) { atomicAdd(&bar[XB_TMO], 1u); break; } }
    }
    nloc = mine > 0u ? mine : 1u; nx = cnt > 0u ? cnt : 1u;
}
__device__ __forceinline__ void xcd_barrier(const XcdBarrier& b) {
    asm volatile("s_waitcnt vmcnt(0)" ::: "memory");
    __syncthreads();
    if (threadIdx.x == 0) {
        unsigned* bar = b.bar;
        __builtin_amdgcn_s_waitcnt(0);
        unsigned nloc = b.st[0], nx = b.st[1];
        if (nloc == 0u) { xcd_barrier_complete(bar, b.x, nloc, nx); b.st[0] = nloc; b.st[1] = nx; }
        const unsigned old = xb_add(&bar[XB_XSUB(b.x)], 1u);
        const unsigned gen = old / nloc;
        if (old + 1u == (gen + 1u) * nloc) {
            __builtin_amdgcn_fence(__ATOMIC_RELEASE, "agent");
            asm volatile("s_waitcnt vmcnt(0)" ::: "memory");
            const unsigned og = xb_add(&bar[XB_TOP], 1u);
            const unsigned tg = og / nx;
            if (og + 1u == (tg + 1u) * nx) xb_add(&bar[XB_TOPGEN], 1u);
            else XB_SPIN(xb_ld(&bar[XB_TOPGEN]) == tg, bar);
            __builtin_amdgcn_fence(__ATOMIC_ACQUIRE, "agent");
            xb_add(&bar[XB_XGEN(b.x)], 1u);
            asm volatile("s_waitcnt vmcnt(0)" ::: "memory");
        } else {
            XB_SPIN(xb_ld(&bar[XB_XGEN(b.x)]) == gen, bar);
            __builtin_amdgcn_fence(__ATOMIC_ACQUIRE, "agent");
            asm volatile("s_waitcnt vmcnt(0)" ::: "memory");
        }
    }
    __syncthreads();
}

namespace pg8 {
constexpr int BM = 256, BK = 64, HALF = 128, HTB = HALF * BK * 2, STAGE_BYTES = 8 * HTB, NXCD = 8, WGM = 8;
__host__ __device__ __forceinline__ int lds_byte(int r, int c) { const int st = (r >> 4) * 2 + (c >> 5), rr = r & 15, cc = c & 31, ob = rr * 64 + cc * 2; return st * 1024 + (ob ^ (((ob >> 9) & 1) << 5)); }
__host__ __device__ __forceinline__ void stage_rc(int b, int& R, int& C) { const int st = b / 1024, sb = b % 1024, swz = sb ^ (((sb >> 9) & 1) << 5); R = (st >> 1) * 16 + swz / 64; C = (st & 1) * 32 + (swz % 64) / 2; }
__host__ __device__ __forceinline__ int perm32(int rho) { const int n = rho >> 4, i = rho & 15; return 8 * (i >> 2) + 4 * n + (i & 3); }

struct Unit { int pm, pn, e, slot; };

template <class Epi, class Prob, bool ALIGN_EPI, bool FP8>
__device__ __forceinline__ void gemm_phase(LAS unsigned char* lds, const Prob& P, const Epi& E) {
    int tid_ = threadIdx.x; asm volatile("" : "+v"(tid_));
    const int tid = tid_, wid = __builtin_amdgcn_readfirstlane(tid >> 6), lane = tid & 63, wr = wid >> 2, wc = wid & 3, fr = lane & 15, fq = lane >> 4;
    const int rowb = P.rowb, nt = rowb / 128;
    int R0, C0; stage_rc(tid * 16, R0, C0);
    const int CB = C0 * 2, Rb = Epi::PERM ? ((R0 & ~31) + perm32(R0 & 31)) : R0;
    const unsigned voffB = (unsigned)(Rb * rowb + CB), laneA = (unsigned)(R0 * rowb + CB);
    const unsigned r64 = (unsigned)(64 * rowb);
    const unsigned kstep = (unsigned)(BK * 2);
    const unsigned bhalf = (unsigned)P.b_half;
    const unsigned ldsw = (unsigned)wid * 1024u;
    const int aoff = lds_byte(wr * 64 + fr, fq * 8), boff = lds_byte(wc * 32 + fr, fq * 8);
#define PG8_SA(b, h) (((b) * 2 + (h)) * HTB)
#define PG8_SB(b, h) ((4 + (b) * 2 + (h)) * HTB)
    const __amdgpu_buffer_rsrc_t srdA = __builtin_amdgcn_make_buffer_rsrc((void*)P.A, (short)0, 0x7fffffff, 0x00020000);
    const __amdgpu_buffer_rsrc_t srdB = __builtin_amdgcn_make_buffer_rsrc((void*)P.Bt, (short)0, 0x7fffffff, 0x00020000);
#define PG8_STAGE_B(bufoff, so) do { \
        __builtin_amdgcn_raw_ptr_buffer_load_lds(srdB, (LAS void*)(lds + (bufoff) + ldsw), 16, (int)voffB, (int)(so), 0, 0); \
        __builtin_amdgcn_raw_ptr_buffer_load_lds(srdB, (LAS void*)(lds + (bufoff) + ldsw + 8192), 16, (int)voffB, (int)((so) + r64), 0, 0); } while (0)
#define PG8_STAGE_A(bufoff, kb, h) do { \
        if constexpr (Prob::GATHER_A) { \
            __builtin_amdgcn_raw_ptr_buffer_load_lds(srdA, (LAS void*)(lds + (bufoff) + ldsw), 16, (int)((h) ? c10 : c00), (int)(kb), 0, 0); \
            __builtin_amdgcn_raw_ptr_buffer_load_lds(srdA, (LAS void*)(lds + (bufoff) + ldsw + 8192), 16, (int)((h) ? c11 : c01), (int)(kb), 0, 0); } \
        else { \
            __builtin_amdgcn_raw_ptr_buffer_load_lds(srdA, (LAS void*)(lds + (bufoff) + ldsw), 16, (int)laneA, (int)(aB + (kb) + (h) * 2 * r64), 0, 0); \
            __builtin_amdgcn_raw_ptr_buffer_load_lds(srdA, (LAS void*)(lds + (bufoff) + ldsw + 8192), 16, (int)laneA, (int)(aB + (kb) + (h) * 2 * r64 + r64), 0, 0); } } while (0)
#define PG8_LDA(dst, b, h) do { _Pragma("unroll") for (int m = 0; m < 4; ++m) _Pragma("unroll") for (int k = 0; k < 2; ++k) dst[m][k] = *(const LAS bf16x8*)(lds + PG8_SA(b, h) + aoff + m * 2048 + k * 1024); } while (0)
#define PG8_LDB(dst, b, h) do { _Pragma("unroll") for (int n = 0; n < 2; ++n) _Pragma("unroll") for (int k = 0; k < 2; ++k) dst[n][k] = *(const LAS bf16x8*)(lds + PG8_SB(b, h) + boff + n * 2048 + k * 1024); } while (0)
#define PG8_MMA(ai, bj, At, Bt) do { __builtin_amdgcn_s_setprio(1); _Pragma("unroll") for (int m = 0; m < 4; ++m) _Pragma("unroll") for (int n = 0; n < 2; ++n) { \
        if constexpr (FP8) { const i32x8 fb_ = __builtin_shufflevector(__builtin_bit_cast(i32x4, Bt[n][0]), __builtin_bit_cast(i32x4, Bt[n][1]), 0, 1, 2, 3, 4, 5, 6, 7); \
            const i32x8 fa_ = __builtin_shufflevector(__builtin_bit_cast(i32x4, At[m][0]), __builtin_bit_cast(i32x4, At[m][1]), 0, 1, 2, 3, 4, 5, 6, 7); \
            acc[ai][bj][m][n] = __builtin_amdgcn_mfma_scale_f32_16x16x128_f8f6f4(fb_, fa_, acc[ai][bj][m][n], 0, 0, 0, 0, 0, 0); } \
        else { _Pragma("unroll") for (int k = 0; k < 2; ++k) acc[ai][bj][m][n] = __builtin_amdgcn_mfma_f32_16x16x32_bf16(Bt[n][k], At[m][k], acc[ai][bj][m][n], 0, 0, 0); } } \
        __builtin_amdgcn_s_setprio(0); } while (0)
#define PG8_WAIT_V(n) asm volatile("s_waitcnt vmcnt(" #n ")" ::: "memory")
#define PG8_WAIT_L(n) asm volatile("s_waitcnt lgkmcnt(" #n ")" ::: "memory")
#define PG8_BAR __builtin_amdgcn_s_barrier()
#define PG8_SCHED __builtin_amdgcn_sched_barrier(0)
    Unit cur, nxt; int ui = 0;
    if (!P.next(0, cur)) return;
    f32x4 acc[2][2][4][2];
    E.init(acc, cur, wr, wc, fr, fq);
    bf16x8 At[4][2], B0[2][2], B1[2][2];
    unsigned c00 = 0, c01 = 0, c10 = 0, c11 = 0, aB = 0;
    if constexpr (Prob::GATHER_A) { c00 = P.a_off(cur, R0, CB); c01 = P.a_off(cur, R0 + 64, CB); c10 = P.a_off(cur, HALF + R0, CB); c11 = P.a_off(cur, HALF + R0 + 64, CB); }
    else aB = P.a_base(cur);
    unsigned cB = P.b_off(cur);
    PG8_STAGE_B(PG8_SB(0, 0), cB); PG8_STAGE_B(PG8_SB(0, 1), cB + bhalf); PG8_STAGE_A(PG8_SA(0, 0), 0, 0); PG8_STAGE_A(PG8_SA(0, 1), 0, 1);
    if (wr == 1) PG8_BAR;
    PG8_WAIT_V(2); PG8_BAR;
    PG8_STAGE_B(PG8_SB(1, 0), cB + kstep); PG8_STAGE_A(PG8_SA(1, 0), kstep, 0); PG8_STAGE_B(PG8_SB(1, 1), cB + bhalf + kstep);
    PG8_WAIT_V(6); PG8_BAR;
    for (;;) {
        const bool has_next = P.next(ui + 1, nxt);
        const unsigned nB = has_next ? P.b_off(nxt) : cB;
        for (int t = 0; t < nt; t += 2) {
            const bool last = (t == nt - 2);
            const unsigned k1 = (unsigned)(t + 1) * kstep;
            const unsigned k2 = last ? 0u : (unsigned)(t + 2) * kstep, k3 = k2 + kstep;
            const unsigned b2 = last ? nB : cB + (unsigned)(t + 2) * kstep, b3 = b2 + kstep;
            if constexpr (Prob::GATHER_A) { if (last && has_next) { c00 = P.a_off(nxt, R0, CB); c01 = P.a_off(nxt, R0 + 64, CB); } }
            PG8_LDB(B0, 0, 0); PG8_LDB(B1, 0, 1); PG8_SCHED; PG8_LDA(At, 0, 0); PG8_STAGE_A(PG8_SA(1, 1), k1, 1);
            PG8_WAIT_V(8); PG8_WAIT_L(0); PG8_BAR; PG8_MMA(0, 0, At, B0); PG8_MMA(0, 1, At, B1); PG8_BAR; PG8_SCHED;
            if (last && has_next) { if constexpr (Prob::GATHER_A) { c10 = P.a_off(nxt, HALF + R0, CB); c11 = P.a_off(nxt, HALF + R0 + 64, CB); } else aB = P.a_base(nxt); }
            PG8_LDA(At, 0, 1); PG8_STAGE_B(PG8_SB(0, 0), b2); PG8_STAGE_B(PG8_SB(0, 1), b2 + bhalf); PG8_STAGE_A(PG8_SA(0, 0), k2, 0);
            PG8_WAIT_V(8); PG8_WAIT_L(0); PG8_BAR; PG8_MMA(1, 0, At, B0); PG8_MMA(1, 1, At, B1); PG8_BAR; PG8_SCHED;
            PG8_LDB(B0, 1, 0); PG8_LDB(B1, 1, 1); PG8_SCHED; PG8_LDA(At, 1, 0); PG8_STAGE_A(PG8_SA(0, 1), k2, 1);
            PG8_WAIT_V(8); PG8_WAIT_L(0); PG8_BAR; PG8_MMA(0, 0, At, B0); PG8_MMA(0, 1, At, B1); PG8_BAR; PG8_SCHED;
            PG8_LDA(At, 1, 1); PG8_STAGE_B(PG8_SB(1, 0), b3); PG8_STAGE_B(PG8_SB(1, 1), b3 + bhalf); PG8_STAGE_A(PG8_SA(1, 0), k3, 0);
            PG8_WAIT_V(8); PG8_WAIT_L(0); PG8_BAR; PG8_MMA(1, 0, At, B0); PG8_MMA(1, 1, At, B1); PG8_BAR; PG8_SCHED;
        }
        if constexpr (ALIGN_EPI) { if (wr == 0) PG8_BAR; }
        E(acc, cur, wr, wc, fr, fq);
#if defined(MK_DOUBLE)
        if constexpr (FP8) { if ((MK_DOUBLE >> 12) & 1) { asm volatile("" ::: "memory"); E(acc, cur, wr, wc, fr, fq); } }
#endif
        if (!has_next) break;
        cur = nxt; cB = nB; ++ui;
        E.init(acc, cur, wr, wc, fr, fq);
        if constexpr (ALIGN_EPI) { if (wr == 1) PG8_BAR; }
    }
    PG8_WAIT_V(0);
    if constexpr (!ALIGN_EPI) { if (wr == 0) PG8_BAR; }
    PG8_BAR;
#undef PG8_SA
#undef PG8_SB
#undef PG8_STAGE_A
#undef PG8_STAGE_B
#undef PG8_LDA
#undef PG8_LDB
#undef PG8_MMA
#undef PG8_WAIT_V
#undef PG8_WAIT_L
#undef PG8_BAR
#undef PG8_SCHED
}

__device__ __forceinline__ bool static_order(int nM, int nN, int G, int c, int i, int& pm, int& pn) {
    const int nwg = nM * nN; const long L = (long)i * G + c; if (L >= nwg) return false;
    int wgid = (int)L; { const int q = nwg / NXCD, r = nwg % NXCD, xcd = wgid % NXCD, off = wgid / NXCD; wgid = (xcd < r ? xcd * (q + 1) : r * (q + 1) + (xcd - r) * q) + off; }
    const int nig = WGM * nN, gid = wgid / nig, fm = gid * WGM, gsz = (nM - fm) < WGM ? (nM - fm) : WGM;
    pm = fm + ((wgid % nig) % gsz); pn = (wgid % nig) / gsz; return true;
}
struct DenseProb {
    const char* A; const char* Bt; int rowb, nM, nN, G, c; size_t b_half;
    __device__ __forceinline__ bool next(int i, Unit& u) const { u.e = 0; u.slot = i; return static_order(nM, nN, G, c, i, u.pm, u.pn); }
    static constexpr bool GATHER_A = false;
    __device__ __forceinline__ unsigned a_off(const Unit&, int, int) const { return 0u; }
    __device__ __forceinline__ unsigned a_base(const Unit& u) const { return (unsigned)(u.pm * BM * rowb); }
    __device__ __forceinline__ unsigned b_off(const Unit& u) const { return (unsigned)(u.pn * BM * rowb); }
};
template <bool GATHER> struct MoeProb {
    const char* A; const char* Bt; int rowb, nN, G, c; size_t b_half; size_t b_expert; int b_tile_rows;
    const LAS int* tpre; const LAS int* tab; const LAS int* udesc;
    __device__ __forceinline__ int tp(int j) const { return __builtin_amdgcn_readfirstlane(tpre[j]); }
    __device__ __forceinline__ bool search(int i, Unit& u) const {
        const int total = tpre[NE] * nN; const long L0 = (long)i * G + c; if (L0 >= total) return false;
        int L = (int)L0; { const int q = total / NXCD, r = total % NXCD, xcd = L % NXCD, off = L / NXCD; L = (xcd < r ? xcd * (q + 1) : r * (q + 1) + (xcd - r) * q) + off; }
        int e = 0;
        for (int j = 1; j < NE; ++j) e += (tpre[j] * nN <= L) ? 1 : 0;
        const int first = tpre[e] * nN, tiles = tpre[e + 1] - tpre[e], rem = L - first;
        u.e = e; u.pm = rem % tiles; u.pn = rem / tiles; u.slot = i; return true;
    }
    __device__ __forceinline__ bool next(int i, Unit& u) const {
        if (i >= MAXU) return false;
        const int v = __builtin_amdgcn_readfirstlane(udesc[4 * i + 3]); if (!v) return false;
        u.e = __builtin_amdgcn_readfirstlane(udesc[4 * i]); u.pm = __builtin_amdgcn_readfirstlane(udesc[4 * i + 1]); u.pn = __builtin_amdgcn_readfirstlane(udesc[4 * i + 2]); u.slot = i; return true;
    }
    static constexpr bool GATHER_A = GATHER;
    __device__ __forceinline__ unsigned a_off(const Unit& u, int row, int colb) const { const int idx = tab[u.slot * 256 + row]; const int tok = idx < 0 ? 0 : (idx >> 2); return (unsigned)(tok * rowb + colb); }
    __device__ __forceinline__ unsigned a_base(const Unit& u) const { return (unsigned)((tp(u.e) + u.pm) * BM * rowb); }
    __device__ __forceinline__ unsigned b_off(const Unit& u) const { return (unsigned)u.e * (unsigned)b_expert + (unsigned)(u.pn * b_tile_rows * rowb); }
};
}

using pg8::Unit;
typedef f32x4 AccT[2][2][4][2];
__device__ __forceinline__ void acc_zero(AccT& acc) {
#pragma unroll
    for (int a = 0; a < 2; ++a)
#pragma unroll
        for (int b = 0; b < 2; ++b)
#pragma unroll
            for (int m = 0; m < 4; ++m)
#pragma unroll
                for (int n = 0; n < 2; ++n) acc[a][b][m][n] = (f32x4){0.f, 0.f, 0.f, 0.f};
}

struct EpiQKVU {
    static constexpr bool PERM = true;
    unsigned char* ws;
    __device__ __forceinline__ void init(AccT& acc, const Unit&, int, int, int, int) const { acc_zero(acc); }
    __device__ __forceinline__ void operator()(const AccT& acc, const Unit& u, int wr, int wc, int fr, int fq) const {
        static_assert(WS_K - WS_Q == WS_V - WS_K, "Q, K, V equally spaced");
        const int t = (u.pn - 1) / 3;
        const size_t boff = (u.pn == 0) ? WS_U : (WS_Q + (size_t)t * (WS_K - WS_Q));
        bf16_t* base = (bf16_t*)(ws + boff);
        const int ldc = (u.pn == 0) ? PW : AW, colt = (u.pn == 0) ? 0 : ((u.pn - 1) % 3) * 256;
        const float sc = (u.pn >= 1 && u.pn <= 3) ? QSCALE : 1.f;
        const int row0 = u.pm * 256 + wr * 64 + fr, col0 = colt + wc * 32 + 8 * fq;
#pragma unroll
        for (int ai = 0; ai < 2; ++ai)
#pragma unroll
            for (int m = 0; m < 4; ++m) { bf16_t* rowp = base + (size_t)(row0 + ai * 128 + m * 16) * ldc + col0;
#pragma unroll
                for (int bj = 0; bj < 2; ++bj) { const f32x4 v0 = acc[ai][bj][m][0] * sc, v1 = acc[ai][bj][m][1] * sc;
                    u32x4 w; w.x = cvt_pk_bf16(v0[0], v0[1]); w.y = cvt_pk_bf16(v0[2], v0[3]); w.z = cvt_pk_bf16(v1[0], v1[1]); w.w = cvt_pk_bf16(v1[2], v1[3]);
                    *(u32x4*)(rowp + bj * 128) = w; } }
    }
};
struct EpiResF32 {
    static constexpr bool PERM = false;
    const float* X; float* O;
    __device__ __forceinline__ void init(AccT& acc, const Unit& u, int wr, int wc, int fr, int fq) const {
        const int row0 = u.pm * 256 + wr * 64 + fr, col0 = u.pn * 256 + wc * 32 + 4 * fq;
#pragma unroll
        for (int ai = 0; ai < 2; ++ai)
#pragma unroll
            for (int m = 0; m < 4; ++m) { const unsigned off = (unsigned)((row0 + ai * 128 + m * 16) * D + col0);
#pragma unroll
                for (int bj = 0; bj < 2; ++bj)
#pragma unroll
                    for (int n = 0; n < 2; ++n) acc[ai][bj][m][n] = __builtin_nontemporal_load((const f32x4*)(X + off + bj * 128 + n * 16)) * (MSCALE * OSCALE); }
    }
    __device__ __forceinline__ void operator()(const AccT& acc, const Unit& u, int wr, int wc, int fr, int fq) const {
        const int row0 = u.pm * 256 + wr * 64 + fr, col0 = u.pn * 256 + wc * 32 + 4 * fq;
#pragma unroll
        for (int ai = 0; ai < 2; ++ai)
#pragma unroll
            for (int m = 0; m < 4; ++m) { const unsigned off = (unsigned)((row0 + ai * 128 + m * 16) * D + col0);
#pragma unroll
                for (int bj = 0; bj < 2; ++bj)
#pragma unroll
                    for (int n = 0; n < 2; ++n) *(f32x4*)(O + off + bj * 128 + n * 16) = acc[ai][bj][m][n] * (1.0f / (MSCALE * OSCALE)); }
    }
};
__device__ __forceinline__ float swiglu1(float g, float u) {
    g = fminf(g, 7.0f); u = fminf(fmaxf(u, -7.0f), 7.0f);
    const float s = __builtin_amdgcn_rcpf(1.0f + __builtin_amdgcn_exp2f(g * (-1.702f * LOG2E)));
    return (u + 1.0f) * (g * s);
}
__device__ __forceinline__ f32x4 swiglu4(f32x4 g, f32x4 u) {
    g = __builtin_elementwise_min(g, (f32x4){7.0f, 7.0f, 7.0f, 7.0f});
    u = __builtin_elementwise_min(__builtin_elementwise_max(u, (f32x4){-7.0f, -7.0f, -7.0f, -7.0f}), (f32x4){7.0f, 7.0f, 7.0f, 7.0f});
    const f32x4 t = g * (-1.702f * LOG2E);
    f32x4 e; e[0] = __builtin_amdgcn_exp2f(t[0]); e[1] = __builtin_amdgcn_exp2f(t[1]); e[2] = __builtin_amdgcn_exp2f(t[2]); e[3] = __builtin_amdgcn_exp2f(t[3]);
    const f32x4 d = e + 1.0f;
    f32x4 r; r[0] = __builtin_amdgcn_rcpf(d[0]); r[1] = __builtin_amdgcn_rcpf(d[1]); r[2] = __builtin_amdgcn_rcpf(d[2]); r[3] = __builtin_amdgcn_rcpf(d[3]);
    return (u * ASCALE + ASCALE) * (g * r);
}
__device__ __forceinline__ unsigned cvt4_fp8_nc(const f32x4& v) {
    int p = __builtin_amdgcn_cvt_pk_fp8_f32(v[0], v[1], 0, false); p = __builtin_amdgcn_cvt_pk_fp8_f32(v[2], v[3], p, true); return (unsigned)p; }
struct EpiGateUp {
    static constexpr bool PERM = true;
    __device__ __forceinline__ void init(AccT& acc, const Unit&, int, int, int, int) const { acc_zero(acc); }
    unsigned char* ACT; const LAS int* tpre; const LAS float* tabf; const LAS float* tabb;
    __device__ __forceinline__ void operator()(const AccT& acc, const Unit& u, int wr, int wc, int fr, int fq) const {
        const int cl = wc * 32 + 8 * fq, colA = u.pn * 128 + cl;
        const LAS float* bp = tabb + u.slot * 256 + cl;
        const f32x4 bg0 = *(const LAS f32x4*)(bp), bg1 = *(const LAS f32x4*)(bp + 4), bu0 = *(const LAS f32x4*)(bp + 128), bu1 = *(const LAS f32x4*)(bp + 132);
        const int srow0 = (__builtin_amdgcn_readfirstlane(tpre[u.e]) + u.pm) * 256;
#pragma unroll
        for (int ai = 0; ai < 2; ++ai)
#pragma unroll
            for (int m = 0; m < 4; ++m) { const int r = ai * 128 + wr * 64 + m * 16 + fr; const float rs = tabf[u.slot * 256 + r];
                const f32x4 g0 = acc[ai][0][m][0] * rs + bg0, g1 = acc[ai][0][m][1] * rs + bg1, u0 = acc[ai][1][m][0] * rs + bu0, u1 = acc[ai][1][m][1] * rs + bu1;
                u32x2 w; w.x = cvt4_fp8_nc(swiglu4(g0, u0)); w.y = cvt4_fp8_nc(swiglu4(g1, u1));
                *(u32x2*)(ACT + (size_t)(srow0 + r) * DFF + colA) = w; }
    }
};
struct EpiDown {
    static constexpr bool PERM = true;
    __device__ __forceinline__ void init(AccT& acc, const Unit&, int, int, int, int) const { acc_zero(acc); }
    unsigned char* Y; const LAS int* tab; const LAS float* tabf; const LAS float* tabb;
    __device__ __forceinline__ void operator()(const AccT& acc, const Unit& u, int wr, int wc, int fr, int fq) const {
        const int cl = wc * 32 + 8 * fq, col0 = u.pn * 256 + cl;
        const LAS float* bp = tabb + u.slot * 256 + cl;
        f32x4 bv[2][2];
#pragma unroll
        for (int bj = 0; bj < 2; ++bj) { bv[bj][0] = *(const LAS f32x4*)(bp + bj * 128); bv[bj][1] = *(const LAS f32x4*)(bp + bj * 128 + 4); }
#pragma unroll
        for (int ai = 0; ai < 2; ++ai)
#pragma unroll
            for (int m = 0; m < 4; ++m) { const int r = ai * 128 + wr * 64 + m * 16 + fr; const int idx = tab[u.slot * 256 + r];
                if (idx >= 0) { const float gv = tabf[u.slot * 256 + r] * YSCALE; unsigned char* rowp = Y + (size_t)idx * D + col0;
#pragma unroll
                    for (int bj = 0; bj < 2; ++bj) { const f32x4 v0 = (acc[ai][bj][m][0] * (1.0f / (ASCALE * WSCALE)) + bv[bj][0]) * gv, v1 = (acc[ai][bj][m][1] * (1.0f / (ASCALE * WSCALE)) + bv[bj][1]) * gv;
                        u32x2 w; w.x = cvt4_fp8(v0[0], v0[1], v0[2], v0[3]); w.y = cvt4_fp8(v1[0], v1[1], v1[2], v1[3]);
                        *(u32x2*)(rowp + bj * 128) = w; } } }
    }
};

__device__ __forceinline__ void tr_item(const float* __restrict__ W, int K, int N, bf16_t* __restrict__ WT, LAS float* scr, int kb, int nb, int lane) {
    const int k0 = kb * 64, n0 = nb * 64;
    const float* src = W + (size_t)(k0 + (lane >> 4)) * N + n0 + (lane & 15) * 4;
    f32x4 v[16];
#pragma unroll
    for (int i = 0; i < 16; ++i) v[i] = *(const f32x4*)(src + (size_t)(4 * i) * N);
#pragma unroll
    for (int i = 0; i < 16; ++i) { LAS float* d = scr + (4 * i + (lane >> 4)) * 65 + (lane & 15) * 4; d[0] = v[i][0]; d[1] = v[i][1]; d[2] = v[i][2]; d[3] = v[i][3]; }
    LDS_WAIT();
    const int c = lane & 7;
#pragma unroll
    for (int j = 0; j < 8; ++j) { const int n = 8 * j + (lane >> 3); const LAS float* s = scr + (8 * c) * 65 + n;
        u32x4 o; o.x = cvt_pk_bf16(s[0], s[65]); o.y = cvt_pk_bf16(s[130], s[195]); o.z = cvt_pk_bf16(s[260], s[325]); o.w = cvt_pk_bf16(s[390], s[455]);
        *(u32x4*)(WT + (size_t)(n0 + n) * K + k0 + 8 * c) = o; }
    LDS_WAIT();
}
struct Item8 { const float* src; unsigned char* dst; int N; };
__device__ __forceinline__ void chunk8_load(const Item8& d, int ch, f32x4 (&v)[16], int lane) {
    const float* base = d.src + (size_t)(32 * ch + 4 * (lane >> 5)) * d.N + (lane & 31) * 4;
#pragma unroll
    for (int sl = 0; sl < 4; ++sl)
#pragma unroll
        for (int j = 0; j < 4; ++j) v[4 * sl + j] = __builtin_nontemporal_load((const f32x4*)(base + (size_t)(8 * sl + j) * d.N));
}
template <bool OUTW = false> __device__ __forceinline__ void chunk8_cvt(int ch, const f32x4 (&v)[16], LAS unsigned* scr, int lane) {
    constexpr float sc = OUTW ? OSCALE : WSCALE;
    const int nq = lane & 31, kq0 = lane >> 5, sw = (nq & 7) << 2;
#pragma unroll
    for (int sl = 0; sl < 4; ++sl) { const int kw = 8 * ch + kq0 + 2 * sl;
#pragma unroll
        for (int i = 0; i < 4; ++i) scr[(4 * nq + i) * 32 + (kw ^ sw)] = cvt4_fp8(v[4 * sl][i] * sc, v[4 * sl + 1][i] * sc, v[4 * sl + 2][i] * sc, v[4 * sl + 3][i] * sc); }
}
__device__ __forceinline__ void item8_flush(const Item8& d, const LAS unsigned* scr, int lane) {
    LDS_WAIT();
    const int c16 = lane & 7;
#pragma unroll
    for (int jj = 0; jj < 16; ++jj) { const int n = (lane >> 3) + 8 * jj;
        const u32x4 o = *(const LAS u32x4*)(scr + n * 32 + ((c16 ^ ((n >> 2) & 7)) << 2));
        __builtin_nontemporal_store(o, (u32x4*)(d.dst + (size_t)n * D + 16 * c16)); }
    LDS_WAIT();
}
__device__ __forceinline__ int t5_bucket(int dist) {
    if (dist < 16) return dist;
    const int large = 16 + (int)(logf((float)dist / 16.0f) / 4.852030263919617f * 16.0f);
    return large < 31 ? large : 31;
}
struct In { const float *x, *norm1_g, *w_in, *pool_w, *pool_scale, *rel_bias, *w_out, *norm2_g, *router_w, *router_b, *w_gate_up, *b_gate_up, *w_down, *b_down, *final_g; };

constexpr int N8_ALL = NE * 128 + NE * 64;
__device__ __forceinline__ void convert8_queue(LAS unsigned char* lds, const In& in, unsigned char* ws, unsigned* qword) {
    const int lane = threadIdx.x & 63, wave = __builtin_amdgcn_readfirstlane((int)threadIdx.x >> 6);
    constexpr int IG = 8 * 16, ID = 8 * 8;
    auto desc = [&](int r) -> Item8 { Item8 d;
        if (r < NE * IG) { const int e = r / IG, q = r % IG, kb = q / 16, nb = q % 16;
            d.src = in.w_gate_up + (size_t)e * D * 2 * DFF + (size_t)(kb * 128) * (2 * DFF) + nb * 128; d.N = 2 * DFF; d.dst = ws + WS_WGU + (size_t)e * 2 * DFF * D + (size_t)(nb * 128) * D + kb * 128; }
        else { const int r2 = r - NE * IG, e = r2 / ID, q = r2 % ID, kb = q / 8, nb = q % 8;
            d.src = in.w_down + (size_t)e * DFF * D + (size_t)(kb * 128) * D + nb * 128; d.N = D; d.dst = ws + WS_WD + (size_t)e * D * DFF + (size_t)(nb * 128) * DFF + kb * 128; }
        return d; };
    auto claim = [&]() -> int { unsigned v = 0; if (lane == 0) v = __hip_atomic_fetch_add(qword, 1u, __ATOMIC_RELAXED, __HIP_MEMORY_SCOPE_AGENT); return __builtin_amdgcn_readfirstlane((int)v); };
    LAS unsigned* scr8 = (LAS unsigned*)(lds + wave * 16384);
    f32x4 va[16], vb[16];
    int it = claim();
    if (it < N8_ALL) { const Item8 d0 = desc(it); chunk8_load(d0, 0, va, lane); chunk8_load(d0, 1, vb, lane); }
    while (it < N8_ALL) {
        const Item8 d = desc(it);
        const int nx = claim();
        const bool more = nx < N8_ALL; const Item8 dn = more ? desc(nx) : d;
        chunk8_cvt(0, va, scr8, lane); chunk8_load(d, 2, va, lane);
        chunk8_cvt(1, vb, scr8, lane); chunk8_load(d, 3, vb, lane);
        chunk8_cvt(2, va, scr8, lane); if (more) chunk8_load(dn, 0, va, lane);
        chunk8_cvt(3, vb, scr8, lane); if (more) chunk8_load(dn, 1, vb, lane);
        item8_flush(d, scr8, lane);
        it = nx;
    }
}
__device__ __forceinline__ void p0_prologue(LAS unsigned char* lds, const In& in, unsigned char* ws, int G, int c) {
    const int tid = threadIdx.x, lane = tid & 63, wave = __builtin_amdgcn_readfirstlane(tid >> 6);
    const int gw = c * 8 + wave, NGW = G * 8;
    LAS float* scr = (LAS float*)(lds + wave * 16640);
    constexpr int I_IN = 16 * 40, I_OUT = 16 * 16, I_GU1 = 16 * 32, I_D1 = 16 * 16;
    for (int it = gw; it < I_IN; it += NGW) tr_item(in.w_in, D, NPROJ, (bf16_t*)(ws + WS_WIN), scr, it / 40, it % 40, lane);
#ifndef MK_DOUBLE
#define MK_DOUBLE 0
#endif
    for (int repr_ = 0; repr_ < (((MK_DOUBLE >> 11) & 1) ? 2 : 1); ++repr_) {
        f32x4 gv[4];
#pragma unroll
        for (int j = 0; j < 4; ++j) gv[j] = *(const f32x4*)(in.norm1_g + 4 * lane + 256 * j);
        bf16_t* H = (bf16_t*)(ws + WS_H);
        f32x4 v[4], vn[4];
        int m = gw;
        if (m < S) {
#pragma unroll
            for (int j = 0; j < 4; ++j) v[j] = __builtin_nontemporal_load((const f32x4*)(in.x + (size_t)m * D + 4 * lane + 256 * j)); }
        for (; m < S; m += NGW) {
            const int mn = m + NGW;
            if (mn < S) {
#pragma unroll
                for (int j = 0; j < 4; ++j) vn[j] = __builtin_nontemporal_load((const f32x4*)(in.x + (size_t)mn * D + 4 * lane + 256 * j)); }
            float s = 0.f;
#pragma unroll
            for (int j = 0; j < 4; ++j) s += (v[j][0] * v[j][0] + v[j][1] * v[j][1]) + (v[j][2] * v[j][2] + v[j][3] * v[j][3]);
            const float rstd = rsqrtf(wave_sum(s) * (1.0f / D) + RMS_EPS);
#pragma unroll
            for (int j = 0; j < 4; ++j) { const f32x4 o = v[j] * rstd * gv[j]; u32x2 w; w.x = cvt_pk_bf16(o[0], o[1]); w.y = cvt_pk_bf16(o[2], o[3]); *(u32x2*)(H + (size_t)m * D + 4 * lane + 256 * j) = w; }
#pragma unroll
            for (int j = 0; j < 4; ++j) v[j] = vn[j];
        }
    }
}
__device__ __forceinline__ void p0_side(LAS unsigned char* lds, const In& in, unsigned char* ws, int n0, int c0) {
    const int tid = threadIdx.x, lane = tid & 63, wave = __builtin_amdgcn_readfirstlane(tid >> 6);
    for (int it = c0 * 8 + wave; it < 64; it += n0 * 8) { const int kb = it / 8, nb = it % 8;
        Item8 d; d.src = in.w_out + (size_t)(kb * 128) * D + nb * 128; d.N = D; d.dst = ws + WS_WOUT + (size_t)(nb * 128) * D + kb * 128;
        LAS unsigned* scr8 = (LAS unsigned*)(lds + wave * 16384);
#pragma unroll 1
        for (int ch = 0; ch < 4; ++ch) { f32x4 v[16]; chunk8_load(d, ch, v, lane); chunk8_cvt<true>(ch, v, scr8, lane); }
        item8_flush(d, scr8, lane); }
    const int gt = c0 * 512 + tid, NGT = n0 * 512;
    { float* GWT = (float*)(ws + WS_GWT); for (int i = gt; i < NE * D; i += NGT) { const int e = i >> 10, k = i & 1023; GWT[i] = in.norm2_g[k] * in.router_w[k * NE + e]; } }
    { float* BT = (float*)(ws + WS_BT); for (int i = gt; i < 36 * BT_N; i += NGT) { const int bh = i / BT_N, j = i % BT_N, b = bh / NH, h = bh % NH, dil = (b == 0) ? 1 : (b == 1 ? 4 : 16), d = j - BT_OFF;
        BT[i] = (d >= 0 && d <= 128) ? in.rel_bias[t5_bucket(d * dil) * NH + h] * LOG2E : NEGBIG; } }
    { bf16_t* PWT = (bf16_t*)(ws + WS_PWT); for (int i = gt; i < 4 * 64 * 64; i += NGT) { const int g = i >> 12, d = (i >> 6) & 63, cc = i & 63; PWT[i] = (bf16_t)(cvt_pk_bf16(in.pool_w[g * 4096 + cc * 64 + d], 0.f) & 0xffffu); } }
}

__device__ __forceinline__ s16x4 lds_tr16(const LAS unsigned char* p) { typedef short v4i16_t __attribute__((ext_vector_type(4))); return __builtin_bit_cast(s16x4, __builtin_amdgcn_ds_read_tr16_b64_v4i16((LAS v4i16_t*)p)); }
constexpr int ATT_UNITS = 3 * NH * 64, KV_PITCH = 144, KV_ROWS = 384, ATT_VOFF = KV_ROWS * KV_PITCH, ATT_TOFF = 2 * KV_ROWS * KV_PITCH, ATT_NEGOFF = ATT_TOFF + BT_N * 4;
__device__ __forceinline__ void attn_decode(int uid, int& b, int& h, int& r, int& j, int& dil) {
    const int bh = uid >> 6, x = uid & 63; b = bh / NH; h = bh % NH; dil = (b == 0) ? 1 : (b == 1 ? 4 : 16);
    const int nb = 64 / dil; r = x / nb; j = x % nb;
}
__device__ __forceinline__ void attn_phase(LAS unsigned char* lds, const bf16_t* __restrict__ Qg, const bf16_t* __restrict__ Kg, const bf16_t* __restrict__ Vg, const float* __restrict__ BT,
                                           bf16_t* __restrict__ OP, float* __restrict__ LSE, int G, int c) {
    const int tid = threadIdx.x, lane = tid & 63, w = __builtin_amdgcn_readfirstlane(tid >> 6), ql = lane & 15, g = lane >> 4;
    LAS unsigned char* Ks = lds; LAS unsigned char* Vs = lds + ATT_VOFF; LAS float* Tb = (LAS float*)(lds + ATT_TOFF); LAS float* Tneg = (LAS float*)(lds + ATT_NEGOFF);
    if (tid < 16) Tneg[tid] = NEGBIG;
    u32x4 kpre[6], vpre[6]; bf16x8 qa0, qa1, qb0, qb1; float tpre = 0.f;
#define ATT_PREFETCH(uid_) do { int b_, h_, r_, j_, dil_; attn_decode((uid_), b_, h_, r_, j_, dil_); \
        _Pragma("unroll") for (int cc = 0; cc < 6; ++cc) { const int id = tid + 512 * cc, row = id >> 3, ch = id & 7; int mm = 256 * j_ - 128 + row; if (mm < 0) mm += 128; \
            const size_t off = (size_t)(r_ + dil_ * mm) * AW + h_ * HD + ch * 8; kpre[cc] = *(const u32x4*)(Kg + off); vpre[cc] = *(const u32x4*)(Vg + off); } \
        { const size_t qo = (size_t)(r_ + dil_ * (256 * j_ + 32 * w + ql)) * AW + h_ * HD + 8 * g; const size_t qs = (size_t)16 * dil_ * AW; \
          qa0 = *(const bf16x8*)(Qg + qo); qa1 = *(const bf16x8*)(Qg + qo + 32); qb0 = *(const bf16x8*)(Qg + qo + qs); qb1 = *(const bf16x8*)(Qg + qo + qs + 32); } \
        if (tid < BT_N) tpre = BT[(b_ * NH + h_) * BT_N + tid]; } while (0)
#ifndef ATT_SYNC_LOAD
    if (c < ATT_UNITS) ATT_PREFETCH(c);
#endif
    for (int uid = c; uid < ATT_UNITS; uid += G) {
        int b, h, r, j, dil; attn_decode(uid, b, h, r, j, dil);
#ifdef ATT_SYNC_LOAD
        ATT_PREFETCH(uid);
#endif
#pragma unroll
        for (int cc = 0; cc < 6; ++cc) { const int id = tid + 512 * cc, row = id >> 3, ch = id & 7; *(LAS u32x4*)(Ks + row * KV_PITCH + ch * 16) = kpre[cc]; *(LAS u32x4*)(Vs + row * KV_PITCH + ch * 16) = vpre[cc]; }
        if (tid < BT_N) Tb[tid] = tpre;
        const bf16x8 fa0 = qa0, fa1 = qa1, fb0 = qb0, fb1 = qb1;
        __syncthreads();
#ifndef ATT_SYNC_LOAD
        if (uid + G < ATT_UNITS) ATT_PREFETCH(uid + G);
#endif
#if defined(MK_DOUBLE)
        for (int repc_ = 0; repc_ < (((MK_DOUBLE >> 13) & 1) ? 2 : 1); ++repc_) {
#else
        {
#endif
        const int kkmin = (j == 0) ? 128 : 0;
        const LAS unsigned char* kb = Ks + (32 * w + ql) * KV_PITCH + g * 16;
        const LAS float* Tq = Tb + (ql + 272 - 4 * g - 3);
        const f32x4 zero4 = (f32x4){0.f, 0.f, 0.f, 0.f};
        f32x4 sA[9], sB[9];
#pragma unroll
        for (int i = 0; i < 10; ++i) {
            const bf16x8 kf0 = *(const LAS bf16x8*)(kb + i * (16 * KV_PITCH)), kf1 = *(const LAS bf16x8*)(kb + i * (16 * KV_PITCH) + 64);
            const bool msk = (32 * w + 16 * i) < kkmin;
            if (i <= 8) { f32x4 st = __builtin_amdgcn_mfma_f32_16x16x32_bf16(kf0, fa0, zero4, 0, 0, 0); st = __builtin_amdgcn_mfma_f32_16x16x32_bf16(kf1, fa1, st, 0, 0, 0);
                const LAS float* tp = msk ? Tneg : (Tq - 16 * i); sA[i] = (f32x4){st[0] + tp[3], st[1] + tp[2], st[2] + tp[1], st[3] + tp[0]}; }
            if (i >= 1) { f32x4 st = __builtin_amdgcn_mfma_f32_16x16x32_bf16(kf0, fb0, zero4, 0, 0, 0); st = __builtin_amdgcn_mfma_f32_16x16x32_bf16(kf1, fb1, st, 0, 0, 0);
                const LAS float* tp = msk ? Tneg : (Tq - 16 * (i - 1)); sB[i - 1] = (f32x4){st[0] + tp[3], st[1] + tp[2], st[2] + tp[1], st[3] + tp[0]}; }
        }
        float mA = NEGBIG, mB = NEGBIG;
#pragma unroll
        for (int i = 0; i < 9; ++i) { mA = fmaxf(mA, fmaxf(fmaxf(sA[i][0], sA[i][1]), fmaxf(sA[i][2], sA[i][3]))); mB = fmaxf(mB, fmaxf(fmaxf(sB[i][0], sB[i][1]), fmaxf(sB[i][2], sB[i][3]))); }
        mA = fmaxf(mA, __shfl_xor(mA, 16)); mA = fmaxf(mA, __shfl_xor(mA, 32)); mB = fmaxf(mB, __shfl_xor(mB, 16)); mB = fmaxf(mB, __shfl_xor(mB, 32));
        f32x4 oA[4], oB[4];
#pragma unroll
        for (int dt = 0; dt < 4; ++dt) { oA[dt] = zero4; oB[dt] = zero4; }
        float lA = 0.f, lB = 0.f;
        const LAS unsigned char* vb = Vs + (32 * w + 4 * g + (ql >> 2)) * KV_PITCH + (ql & 3) * 8;
#pragma unroll
        for (int i = 0; i < 10; ++i) {
            const LAS unsigned char* vt = vb + i * (16 * KV_PITCH);
            const s16x4 v0 = lds_tr16(vt), v1 = lds_tr16(vt + 32), v2 = lds_tr16(vt + 64), v3 = lds_tr16(vt + 96);
            if (i <= 8) { const float p0 = __builtin_amdgcn_exp2f(sA[i][0] - mA), p1 = __builtin_amdgcn_exp2f(sA[i][1] - mA), p2 = __builtin_amdgcn_exp2f(sA[i][2] - mA), p3 = __builtin_amdgcn_exp2f(sA[i][3] - mA);
                lA += (p0 + p1) + (p2 + p3); u32x2 pw; pw.x = cvt_pk_bf16(p0, p1); pw.y = cvt_pk_bf16(p2, p3); const s16x4 pf = __builtin_bit_cast(s16x4, pw);
                oA[0] = __builtin_amdgcn_mfma_f32_16x16x16bf16_1k(v0, pf, oA[0], 0, 0, 0); oA[1] = __builtin_amdgcn_mfma_f32_16x16x16bf16_1k(v1, pf, oA[1], 0, 0, 0);
                oA[2] = __builtin_amdgcn_mfma_f32_16x16x16bf16_1k(v2, pf, oA[2], 0, 0, 0); oA[3] = __builtin_amdgcn_mfma_f32_16x16x16bf16_1k(v3, pf, oA[3], 0, 0, 0); }
            if (i >= 1) { const float p0 = __builtin_amdgcn_exp2f(sB[i - 1][0] - mB), p1 = __builtin_amdgcn_exp2f(sB[i - 1][1] - mB), p2 = __builtin_amdgcn_exp2f(sB[i - 1][2] - mB), p3 = __builtin_amdgcn_exp2f(sB[i - 1][3] - mB);
                lB += (p0 + p1) + (p2 + p3); u32x2 pw; pw.x = cvt_pk_bf16(p0, p1); pw.y = cvt_pk_bf16(p2, p3); const s16x4 pf = __builtin_bit_cast(s16x4, pw);
                oB[0] = __builtin_amdgcn_mfma_f32_16x16x16bf16_1k(v0, pf, oB[0], 0, 0, 0); oB[1] = __builtin_amdgcn_mfma_f32_16x16x16bf16_1k(v1, pf, oB[1], 0, 0, 0);
                oB[2] = __builtin_amdgcn_mfma_f32_16x16x16bf16_1k(v2, pf, oB[2], 0, 0, 0); oB[3] = __builtin_amdgcn_mfma_f32_16x16x16bf16_1k(v3, pf, oB[3], 0, 0, 0); }
        }
        lA += __shfl_xor(lA, 16); lA += __shfl_xor(lA, 32); lB += __shfl_xor(lB, 16); lB += __shfl_xor(lB, 32);
#ifdef ATT_EXP1
        lA = 1.0f; lB = 1.0f; mA = 0.f; mB = 0.f;
#pragma unroll
        for (int dt = 0; dt < 4; ++dt) { oA[dt] = zero4; oB[dt] = zero4; }
#endif
#ifdef ATT_EXP2
        lA = 1.0f; lB = 1.0f;
#pragma unroll
        for (int dt = 0; dt < 4; ++dt) { oA[dt] = zero4; oB[dt] = zero4; }
#endif
        const float iA = 1.0f / lA, iB = 1.0f / lB;
        const int posA = r + dil * (256 * j + 32 * w + ql), posB = posA + 16 * dil;
        bf16_t* dA = OP + ((size_t)b * S + posA) * AW + h * HD + 4 * g; bf16_t* dB = OP + ((size_t)b * S + posB) * AW + h * HD + 4 * g;
#pragma unroll
        for (int dt = 0; dt < 4; ++dt) { u32x2 t; t.x = cvt_pk_bf16(oA[dt][0] * iA, oA[dt][1] * iA); t.y = cvt_pk_bf16(oA[dt][2] * iA, oA[dt][3] * iA); *(u32x2*)(dA + 16 * dt) = t;
            u32x2 t2; t2.x = cvt_pk_bf16(oB[dt][0] * iB, oB[dt][1] * iB); t2.y = cvt_pk_bf16(oB[dt][2] * iB, oB[dt][3] * iB); *(u32x2*)(dB + 16 * dt) = t2; }
        if (g == 0) { LSE[((size_t)b * S + posA) * NH + h] = mA + __builtin_amdgcn_logf(lA); LSE[((size_t)b * S + posB) * NH + h] = mB + __builtin_amdgcn_logf(lB); }
        asm volatile("" ::: "memory");
        }
        __syncthreads();
    }
#undef ATT_PREFETCH
}

__device__ __forceinline__ void pool_phase(LAS unsigned char* lds, const bf16_t* __restrict__ U, const bf16_t* __restrict__ PWT, const float* __restrict__ pool_scale, unsigned char* __restrict__ MIX, int G, int c) {
    const int tid = threadIdx.x, lane = tid & 63, w = __builtin_amdgcn_readfirstlane(tid >> 6), ql = lane & 15, g = lane >> 4;
    LAS unsigned char* Us = lds; LAS unsigned char* Pl = lds + 40960;
    for (int pu = c; pu < S / 64; pu += G) {
        const int t0 = pu * 64;
        { u32x4 uv[5];
#pragma unroll
          for (int q = 0; q < 5; ++q) { const int id = tid + 512 * q, row = id >> 5, ch = id & 31, t = t0 - 15 + row; uv[q] = (u32x4){0u, 0u, 0u, 0u};
              if (id < 79 * 32 && t >= 0) uv[q] = *(const u32x4*)(U + (size_t)t * PW + ch * 8); }
#pragma unroll
          for (int q = 0; q < 5; ++q) { const int id = tid + 512 * q, row = id >> 5, ch = id & 31; if (id < 79 * 32) *(LAS u32x4*)(Us + row * 512 + ch * 16) = uv[q]; } }
        __syncthreads();
        { const int cch = tid & 255, th = tid >> 8, gg = cch >> 6, wn = 2 << gg, tl0 = 32 * th;
          const LAS bf16_t* up = (const LAS bf16_t*)Us + cch;
#define UAT(row) __uint_as_float(((unsigned)up[(row) * 256]) << 16)
          float sum = 0.f;
          for (int i = 0; i < wn; ++i) sum += UAT(tl0 + 15 - i);
          const float rcw = 1.0f / (float)wn;
#pragma unroll 8
          for (int tl = tl0; tl < tl0 + 32; ++tl) {
              const float cur = UAT(tl + 15);
              if (tl > tl0) sum += cur - UAT(tl + 15 - wn);
              const int t = t0 + tl; const float rc = (t + 1 < wn) ? __builtin_amdgcn_rcpf((float)(t + 1)) : rcw;
              const float val = sum * rc - cur;
              ((LAS bf16_t*)(Pl + tl * 528))[cch] = (bf16_t)(cvt_pk_bf16(val, 0.f) & 0xffffu);
          }
#undef UAT
        }
        __syncthreads();
        { const int tt = w & 3, gp = w >> 2;
#pragma unroll
          for (int gi = 0; gi < 2; ++gi) { const int gg = 2 * gp + gi;
              const bf16x8 b0 = *(const LAS bf16x8*)(Pl + (16 * tt + ql) * 528 + (gg * 64 + 8 * g) * 2), b1 = *(const LAS bf16x8*)(Pl + (16 * tt + ql) * 528 + (gg * 64 + 32 + 8 * g) * 2);
#pragma unroll
              for (int nt = 0; nt < 4; ++nt) {
                  const bf16_t* ap = PWT + ((size_t)(gg * 64 + 16 * nt + ql) * 64 + 8 * g);
                  const bf16x8 a0 = *(const bf16x8*)(ap), a1 = *(const bf16x8*)(ap + 32);
                  f32x4 acc = __builtin_amdgcn_mfma_f32_16x16x32_bf16(a0, b0, (f32x4){0.f, 0.f, 0.f, 0.f}, 0, 0, 0);
                  acc = __builtin_amdgcn_mfma_f32_16x16x32_bf16(a1, b1, acc, 0, 0, 0);
                  const f32x4 ps = *(const f32x4*)(pool_scale + gg * 64 + 16 * nt + 4 * g) * MSCALE;
                  *(unsigned*)(MIX + (size_t)(t0 + 16 * tt + ql) * D + gg * 64 + 16 * nt + 4 * g) = cvt4_fp8(acc[0] * ps[0], acc[1] * ps[1], acc[2] * ps[2], acc[3] * ps[3]);
              } }
        }
        __syncthreads();
    }
}

__device__ __forceinline__ void combine_phase(const bf16_t* __restrict__ OP, const float* __restrict__ LSE, unsigned char* __restrict__ MIX, int G, int c) {
    const int gt = c * 512 + threadIdx.x, NGT = G * 512;
    for (int id = gt; id < S * 96; id += NGT) {
        const int t = id / 96, rem = id % 96, h = rem >> 3, c8 = rem & 7;
        const float l0 = LSE[(size_t)t * NH + h], l1 = LSE[((size_t)S + t) * NH + h], l2 = LSE[((size_t)2 * S + t) * NH + h];
        const float mx = fmaxf(l0, fmaxf(l1, l2));
        float w0 = __builtin_amdgcn_exp2f(l0 - mx), w1 = __builtin_amdgcn_exp2f(l1 - mx), w2 = __builtin_amdgcn_exp2f(l2 - mx);
        const float inv = MSCALE / (w0 + w1 + w2); w0 *= inv; w1 *= inv; w2 *= inv;
        const size_t off = (size_t)t * AW + h * HD + c8 * 8;
        const u32x4 a = __builtin_nontemporal_load((const u32x4*)(OP + off)), b = __builtin_nontemporal_load((const u32x4*)(OP + (size_t)S * AW + off)), cc = __builtin_nontemporal_load((const u32x4*)(OP + (size_t)2 * S * AW + off));
        float f[8];
#pragma unroll
        for (int k = 0; k < 4; ++k) { f[2 * k] = w0 * bf_lo(a[k]) + w1 * bf_lo(b[k]) + w2 * bf_lo(cc[k]); f[2 * k + 1] = w0 * bf_hi(a[k]) + w1 * bf_hi(b[k]) + w2 * bf_hi(cc[k]); }
        u32x2 o; o.x = cvt4_fp8(f[0], f[1], f[2], f[3]); o.y = cvt4_fp8(f[4], f[5], f[6], f[7]);
        *(u32x2*)(MIX + (size_t)t * D + PW + h * HD + c8 * 8) = o;
    }
}

constexpr int GW_PITCH = 1028;
constexpr int RT_G2 = 131584, RT_LG = RT_G2 + 4096, RT_RS = RT_LG + 4 * 16 * 33 * 4, RT_CNT = RT_RS + 256, RT_PART = RT_CNT + 256, RT_END = RT_PART + 4 * 64 * 9 * 4;
static_assert(RT_END <= LDS_CTL, "router LDS map");
__device__ __forceinline__ void router_phase(LAS unsigned char* lds, const float* __restrict__ X1, const float* __restrict__ g2, const float* __restrict__ GWT, const float* __restrict__ rb,
                                             unsigned char* __restrict__ H, float* __restrict__ RSTD, float* __restrict__ GATES, int* __restrict__ ROWS, unsigned* __restrict__ COUNTS, int G, int c) {
    const int tid = threadIdx.x, lane = tid & 63, w = __builtin_amdgcn_readfirstlane(tid >> 6), ql = lane & 15, g = lane >> 4;
    const int ts = w & 3, kh = w >> 2;
    LAS float* GW = (LAS float*)lds;
    LAS float* G2 = (LAS float*)(lds + RT_G2);
    LAS float* LG = (LAS float*)(lds + RT_LG) + ts * (16 * 33);
    LAS float* RS = (LAS float*)(lds + RT_RS) + ts * 16;
    LAS int* LCNT = (LAS int*)(lds + RT_CNT);
    LAS int* LBASE = LCNT + 32;
    LAS float* PART = (LAS float*)(lds + RT_PART) + ts * (64 * 9);
    const int nrounds = (S / 16 + 4 * G - 1) / (4 * G);
    for (int rd = 0; rd < nrounds; ++rd) {
        const int tile = (rd * 4 + ts) * G + c;
        const bool active = tile < S / 16;
        const int tok = (active ? tile : 0) * 16 + ql;
        const float* xr = X1 + (size_t)tok * D + kh * 512 + 8 * g;
        f32x4 av0[16];
        if (active) {
#pragma unroll
            for (int i = 0; i < 8; ++i) { av0[2 * i] = __builtin_nontemporal_load((const f32x4*)(xr + 32 * i)); av0[2 * i + 1] = __builtin_nontemporal_load((const f32x4*)(xr + 32 * i + 4)); } }
        if (rd == 0) {
            f32x4 gx[16];
#pragma unroll
            for (int q = 0; q < 16; ++q) { const int id = tid + 512 * q, e = id >> 8, k4 = id & 255; gx[q] = *(const f32x4*)(GWT + e * D + k4 * 4); }
#pragma unroll
            for (int q = 0; q < 16; ++q) { const int id = tid + 512 * q, e = id >> 8, k4 = id & 255; *(LAS f32x4*)(GW + e * GW_PITCH + k4 * 4) = gx[q]; }
            if (tid < 256) *(LAS f32x4*)(G2 + tid * 4) = *(const f32x4*)(g2 + tid * 4);
        }
        if (tid < 32) LCNT[tid] = 0;
        __syncthreads();
        int ek[4] = {0, 0, 0, 0}, lp[4] = {0, 0, 0, 0}; float gk[4] = {0.f, 0.f, 0.f, 0.f};
        f32x4 acc0 = (f32x4){0.f, 0.f, 0.f, 0.f}, acc1 = acc0; float ss = 0.f;
        if (active) {
            unsigned char* hr = H + (size_t)tok * D + kh * 512 + 8 * g;
            const LAS float* w0p = GW + ql * GW_PITCH + kh * 512 + 8 * g; const LAS float* w1p = GW + (16 + ql) * GW_PITCH + kh * 512 + 8 * g;
            const LAS float* gp = G2 + kh * 512 + 8 * g;
            f32x4 av1[16];
#pragma unroll
            for (int i = 0; i < 8; ++i) { av1[2 * i] = __builtin_nontemporal_load((const f32x4*)(xr + 256 + 32 * i)); av1[2 * i + 1] = __builtin_nontemporal_load((const f32x4*)(xr + 256 + 32 * i + 4)); }
#define RT_CHUNKS(AV, KB) do { _Pragma("unroll") for (int i = 0; i < 8; ++i) { \
                    const int k0 = (KB) + 32 * i; const f32x4 a0 = AV[2 * i], a1 = AV[2 * i + 1]; \
                    const f32x4 n0 = *(const LAS f32x4*)(gp + k0), n1 = *(const LAS f32x4*)(gp + k0 + 4); \
                    const f32x4 b00 = *(const LAS f32x4*)(w0p + k0), b01 = *(const LAS f32x4*)(w0p + k0 + 4), b10 = *(const LAS f32x4*)(w1p + k0), b11 = *(const LAS f32x4*)(w1p + k0 + 4); \
                    ss += (a0[0] * a0[0] + a0[1] * a0[1]) + (a0[2] * a0[2] + a0[3] * a0[3]) + (a1[0] * a1[0] + a1[1] * a1[1]) + (a1[2] * a1[2] + a1[3] * a1[3]); \
                    u32x2 hv; hv.x = cvt4_fp8(a0[0] * n0[0] * HSCALE, a0[1] * n0[1] * HSCALE, a0[2] * n0[2] * HSCALE, a0[3] * n0[3] * HSCALE); \
                    hv.y = cvt4_fp8(a1[0] * n1[0] * HSCALE, a1[1] * n1[1] * HSCALE, a1[2] * n1[2] * HSCALE, a1[3] * n1[3] * HSCALE); \
                    *(u32x2*)(hr + k0) = hv; \
                    _Pragma("unroll") for (int jj = 0; jj < 4; ++jj) { acc0 = __builtin_amdgcn_mfma_f32_16x16x4f32(a0[jj], b00[jj], acc0, 0, 0, 0); acc1 = __builtin_amdgcn_mfma_f32_16x16x4f32(a0[jj], b10[jj], acc1, 0, 0, 0); } \
                    _Pragma("unroll") for (int jj = 0; jj < 4; ++jj) { acc0 = __builtin_amdgcn_mfma_f32_16x16x4f32(a1[jj], b01[jj], acc0, 0, 0, 0); acc1 = __builtin_amdgcn_mfma_f32_16x16x4f32(a1[jj], b11[jj], acc1, 0, 0, 0); } } } while (0)
            RT_CHUNKS(av0, 0);
            RT_CHUNKS(av1, 256);
#undef RT_CHUNKS
            if (kh == 1) { LAS float* pp = PART + lane * 9;
#pragma unroll
                for (int i = 0; i < 4; ++i) { pp[i] = acc0[i]; pp[4 + i] = acc1[i]; } pp[8] = ss; }
        }
        __syncthreads();
        if (active && kh == 0) {
            { const LAS float* pp = PART + lane * 9;
#pragma unroll
              for (int i = 0; i < 4; ++i) { acc0[i] += pp[i]; acc1[i] += pp[4 + i]; } ss += pp[8]; }
            ss += __shfl_xor(ss, 16); ss += __shfl_xor(ss, 32);
            const float rstd = rsqrtf(ss * (1.0f / D) + RMS_EPS);
            if (g == 0) { RSTD[tok] = rstd; RS[ql] = rstd; }
            LDS_WAIT();
            const float rb0 = rb[ql], rb1 = rb[16 + ql];
#pragma unroll
            for (int rg = 0; rg < 4; ++rg) { const float rr = RS[4 * g + rg]; LG[(4 * g + rg) * 33 + ql] = acc0[rg] * rr + rb0; LG[(4 * g + rg) * 33 + 16 + ql] = acc1[rg] * rr + rb1; }
            LDS_WAIT();
            if (lane < 16) {
                float v[32];
#pragma unroll
                for (int e = 0; e < 32; ++e) v[e] = LG[ql * 33 + e];
                float tv[4];
#pragma unroll
                for (int r = 0; r < 4; ++r) { float best = v[0]; int bi = 0;
#pragma unroll
                    for (int e = 1; e < 32; ++e) { const bool gt = v[e] > best; best = gt ? v[e] : best; bi = gt ? e : bi; }
                    tv[r] = best; ek[r] = bi;
#pragma unroll
                    for (int e = 0; e < 32; ++e) v[e] = (e == bi) ? -INFINITY : v[e]; }
                const float e1 = __expf(tv[1] - tv[0]), e2 = __expf(tv[2] - tv[0]), e3 = __expf(tv[3] - tv[0]); const float inv = 1.0f / (1.0f + e1 + e2 + e3);
                gk[0] = inv; gk[1] = e1 * inv; gk[2] = e2 * inv; gk[3] = e3 * inv;
#pragma unroll
                for (int r = 0; r < 4; ++r) lp[r] = __hip_atomic_fetch_add(LCNT + ek[r], 1, __ATOMIC_RELAXED, __HIP_MEMORY_SCOPE_WORKGROUP);
            }
        }
        __syncthreads();
        if (tid < 32) { const int n = LCNT[tid]; int base = 0; if (n > 0) base = (int)__hip_atomic_fetch_add(COUNTS + tid, (unsigned)n, __ATOMIC_RELAXED, __HIP_MEMORY_SCOPE_AGENT); LBASE[tid] = base; }
        __syncthreads();
        if (active && kh == 0 && lane < 16) {
#pragma unroll
            for (int r = 0; r < 4; ++r) { const int pos = LBASE[ek[r]] + lp[r]; ROWS[(size_t)ek[r] * S + pos] = tok * 4 + r; GATES[tok * 4 + r] = gk[r]; }
#ifdef RT_HASH
            RSTD[S + tok] = gk[0] * (ek[0] + 1) + gk[1] * (ek[1] + 1) + gk[2] * (ek[2] + 1) + gk[3] * (ek[3] + 1);
#endif
        }
        __syncthreads();
    }
}

__device__ __forceinline__ void moe_prefix(LAS int* tpre, LAS int* lcnt, const unsigned* __restrict__ COUNTS) {
    if (threadIdx.x < 32) lcnt[threadIdx.x] = (int)COUNTS[threadIdx.x];
    __syncthreads();
    if (threadIdx.x == 0) { int acc = 0; for (int e = 0; e < NE; ++e) { tpre[e] = acc; acc += (lcnt[e] + 255) >> 8; } tpre[NE] = acc; }
    __syncthreads();
}
template <bool GU, class Prob> __device__ __forceinline__ void moe_table(const Prob& P, LAS int* udesc, LAS int* tab, LAS float* tabf, LAS float* tabb, const LAS int* lcnt, const int* __restrict__ ROWS,
                                                                         const float* __restrict__ rowf, const float* __restrict__ bias) {
    if (threadIdx.x < MAXU) { Unit u0; u0.e = 0; u0.pm = 0; u0.pn = 0; u0.slot = 0; const bool ok = P.search((int)threadIdx.x, u0);
        udesc[4 * threadIdx.x] = u0.e; udesc[4 * threadIdx.x + 1] = u0.pm; udesc[4 * threadIdx.x + 2] = u0.pn; udesc[4 * threadIdx.x + 3] = ok ? 1 : 0; }
    __syncthreads();
    constexpr int NQ = (MAXU * 256 + 511) / 512;
    int idx[NQ]; float fv[NQ], bvv[NQ];
#pragma unroll
    for (int q = 0; q < NQ; ++q) { const int j = (int)threadIdx.x + 512 * q, i = j >> 8, r = j & 255; idx[q] = -2;
        if (i < MAXU && udesc[4 * i + 3]) { const int e = udesc[4 * i], rr = udesc[4 * i + 1] * 256 + r; idx[q] = (rr < lcnt[e]) ? ROWS[(size_t)e * S + rr] : -1; } }
#pragma unroll
    for (int q = 0; q < NQ; ++q) { const int j = (int)threadIdx.x + 512 * q, i = j >> 8, c2 = j & 255; fv[q] = 0.f; bvv[q] = 0.f;
        if (idx[q] != -2) { const int e = udesc[4 * i], pn = udesc[4 * i + 2];
            fv[q] = GU ? rowf[idx[q] < 0 ? 0 : (idx[q] >> 2)] * (1.0f / (HSCALE * WSCALE)) : (idx[q] < 0 ? 0.f : rowf[idx[q]]);
            bvv[q] = GU ? bias[(size_t)e * 2 * DFF + (c2 >> 7) * DFF + pn * 128 + (c2 & 127)] : bias[(size_t)e * D + pn * 256 + c2]; } }
#pragma unroll
    for (int q = 0; q < NQ; ++q) { const int j = (int)threadIdx.x + 512 * q; if (idx[q] != -2) { tab[j] = idx[q]; tabf[j] = fv[q]; tabb[j] = bvv[q]; } }
    __syncthreads();
}

__device__ __forceinline__ void final_phase(const float* __restrict__ X1, const unsigned char* __restrict__ Y, const float* __restrict__ fg, float* __restrict__ out, int G, int c) {
    const int tid = threadIdx.x, lane = tid & 63, wave = tid >> 6; const int gw = c * 8 + wave, NGW = G * 8;
    f32x4 gv[4];
#pragma unroll
    for (int j = 0; j < 4; ++j) gv[j] = *(const f32x4*)(fg + 4 * lane + 256 * j);
    for (int m = gw; m < S; m += NGW) {
        const float* xr = X1 + (size_t)m * D + 4 * lane;
        f32x4 v[4];
#pragma unroll
        for (int j = 0; j < 4; ++j) v[j] = __builtin_nontemporal_load((const f32x4*)(xr + 256 * j));

#ifdef RT_HASH
        { const float extra = ((const float*)Y)[m];
#pragma unroll
          for (int j = 0; j < 4; ++j) { v[j][0] += __sinf(extra * (float)(4 * lane + 256 * j + 1)); v[j][1] += __sinf(extra * (float)(4 * lane + 256 * j + 2)); v[j][2] += __sinf(extra * (float)(4 * lane + 256 * j + 3)); v[j][3] += __sinf(extra * (float)(4 * lane + 256 * j + 4)); } }
#endif
#ifdef FIN_HASH
#pragma unroll
        for (int j = 0; j < 4; ++j) { v[j][0] = __sinf(v[j][0] * 1.0e6f); v[j][1] = __sinf(v[j][1] * 1.0e6f); v[j][2] = __sinf(v[j][2] * 1.0e6f); v[j][3] = __sinf(v[j][3] * 1.0e6f); }
#endif
#pragma unroll
#if defined(FIN_HASH) || defined(RT_HASH)
        for (int k = 0; k < 0; ++k) { const unsigned char* yr = Y + ((size_t)m * 4 + k) * D + 4 * lane;
#else
        for (int k = 0; k < 4; ++k) { const unsigned char* yr = Y + ((size_t)m * 4 + k) * D + 4 * lane;
#endif
#pragma unroll
            for (int j = 0; j < 4; ++j) { const int t = __builtin_nontemporal_load((const int*)(yr + 256 * j)); const f32x2 lo = __builtin_amdgcn_cvt_pk_f32_fp8(t, false), hi = __builtin_amdgcn_cvt_pk_f32_fp8(t, true);
                v[j][0] += lo[0] * (1.0f / YSCALE); v[j][1] += lo[1] * (1.0f / YSCALE); v[j][2] += hi[0] * (1.0f / YSCALE); v[j][3] += hi[1] * (1.0f / YSCALE); } }
#ifdef FIN_HASH2
#pragma unroll
        for (int j = 0; j < 4; ++j) { v[j][0] = __sinf(v[j][0] * 3.0e3f); v[j][1] = __sinf(v[j][1] * 3.0e3f); v[j][2] = __sinf(v[j][2] * 3.0e3f); v[j][3] = __sinf(v[j][3] * 3.0e3f); }
#endif
        float s = 0.f;
#pragma unroll
        for (int j = 0; j < 4; ++j) s += (v[j][0] * v[j][0] + v[j][1] * v[j][1]) + (v[j][2] * v[j][2] + v[j][3] * v[j][3]);
        const float rstd = rsqrtf(wave_sum(s) * (1.0f / D) + RMS_EPS);
#pragma unroll
        for (int j = 0; j < 4; ++j) __builtin_nontemporal_store(v[j] * rstd * gv[j], (f32x4*)(out + (size_t)m * D + 4 * lane + 256 * j));
    }
}

constexpr int NPHASE = 9;
struct Args { In in; float* out; unsigned char* ws; int ph_lo, ph_hi; };
__global__ void __launch_bounds__(512, 2) fwd(Args args) {
    extern __shared__ __attribute__((aligned(16))) unsigned char lds_raw[];
    LAS unsigned char* lds = (LAS unsigned char*)lds_raw;
    const int tid = threadIdx.x, G = gridDim.x, c = blockIdx.x;
    unsigned char* ws = args.ws; const In& in = args.in;
    unsigned* ctl = (unsigned*)(ws + WS_CTL);
    LAS int* LCTL = (LAS int*)(lds + LDS_CTL);
    if (tid < 256) LCTL[tid] = 0;
    __syncthreads();
    const int lo = args.ph_lo, hi = args.ph_hi;
    const bool one_launch = (hi - lo) > 1;
    XcdBarrier bar; bar.bar = ctl + CW_BAR; bar.x = 0; bar.st = nullptr;
    if (one_launch) bar = xcd_barrier_post(ctl + CW_BAR, (volatile LAS unsigned*)LCTL);
#define IN(k) (lo <= (k) && (k) < hi)
#ifndef MK_DOUBLE
#define MK_DOUBLE 0
#endif
#define REP(k) for (int rep_ = 0; rep_ < ((((MK_DOUBLE) >> (k)) & 1) ? 2 : 1); ++rep_)
#define SEAM(k) do { if (IN((k) + 1)) xcd_barrier(bar); } while (0)
    bf16_t* Hb = (bf16_t*)(ws + WS_H); bf16_t* Ub = (bf16_t*)(ws + WS_U); bf16_t* Qb = (bf16_t*)(ws + WS_Q); bf16_t* Kb = (bf16_t*)(ws + WS_K); bf16_t* Vb = (bf16_t*)(ws + WS_V);
    bf16_t* OPb = (bf16_t*)(ws + WS_OP); unsigned char* MIXb = ws + WS_MIX; float* X1 = (float*)(ws + WS_X1); unsigned char* ACTb = ws + WS_ACT; unsigned char* Yb = ws + WS_Y; unsigned char* H8 = ws + WS_H8;
    float* LSE = (float*)(ws + WS_LSE); float* RSTD = (float*)(ws + WS_RSTD); float* GATES = (float*)(ws + WS_GATES); int* ROWS = (int*)(ws + WS_ROWS); unsigned* COUNTS = ctl + CW_COUNTS;
    LAS int* TPRE = LCTL + 16; LAS int* LCNT = LCTL + 128; LAS int* UDESC = LCTL + 192; LAS int* TAB = (LAS int*)(lds + LDS_TAB); LAS float* TABF = (LAS float*)(lds + LDS_TAB + MAXU * 1024); LAS float* TABB = (LAS float*)(lds + LDS_TAB + 2 * MAXU * 1024);
    static_assert(LDS_TAB + 3 * MAXU * 1024 <= LDS_CTL, "MoE LDS tables");

    if (IN(0)) { REP(0) p0_prologue(lds, in, ws, G, c); SEAM(0); }
    if (IN(1)) {
        const int NG = (G >= 256) ? 128 : G;
        if (c < NG) {
            pg8::DenseProb P{(const char*)Hb, (const char*)(ws + WS_WIN), D * 2, S / 256, NPROJ / 256, NG, c, (size_t)128 * D * 2};
            EpiQKVU E{ws};
            REP(1) pg8::gemm_phase<EpiQKVU, pg8::DenseProb, true, false>(lds, P, E);
        }
        else p0_side(lds, in, ws, G - NG, c - NG);
        if (NG == G) p0_side(lds, in, ws, G, c);
        convert8_queue(lds, in, ws, ctl + CW_QUEUE);
        SEAM(1);
    }
    if (IN(2)) {
        REP(2) attn_phase(lds, Qb, Kb, Vb, (const float*)(ws + WS_BT), OPb, LSE, G, c);
        REP(9) pool_phase(lds, Ub, (const bf16_t*)(ws + WS_PWT), in.pool_scale, MIXb, G, c);
        SEAM(2);
    }
    if (IN(3)) { REP(3) combine_phase(OPb, LSE, MIXb, G, c); SEAM(3); }
    if (IN(4)) {
        pg8::DenseProb P{(const char*)MIXb, (const char*)(ws + WS_WOUT), D, S / 256, D / 256, G, c, (size_t)128 * D};
        EpiResF32 E{in.x, X1};
        REP(4) pg8::gemm_phase<EpiResF32, pg8::DenseProb, true, true>(lds, P, E);
        SEAM(4);
    }
    if (IN(5)) { router_phase(lds, X1, in.norm2_g, (const float*)(ws + WS_GWT), in.router_b, H8, RSTD, GATES, ROWS, COUNTS, G, c); SEAM(5); }
    if (IN(6)) {
        moe_prefix(TPRE, LCNT, COUNTS);
        pg8::MoeProb<true> P{(const char*)H8, (const char*)(ws + WS_WGU), D, 8, G, c, (size_t)DFF * D, (size_t)2 * DFF * D, 128, TPRE, TAB, UDESC};
        moe_table<true>(P, UDESC, TAB, TABF, TABB, LCNT, ROWS, RSTD, in.b_gate_up);
        EpiGateUp E{ACTb, TPRE, TABF, TABB};
        REP(6) pg8::gemm_phase<EpiGateUp, pg8::MoeProb<true>, true, true>(lds, P, E);
        SEAM(6);
    }
    if (IN(7)) {
        moe_prefix(TPRE, LCNT, COUNTS);
#ifdef PROBE_HALF7
        pg8::MoeProb<false> P{(const char*)ACTb, (const char*)(ws + WS_WD), DFF, 4, G / 2, (c & 7) | ((c >> 4) << 3), (size_t)128 * DFF, (size_t)D * DFF, 256, TPRE, TAB, UDESC};
        moe_table<false>(P, UDESC, TAB, TABF, TABB, LCNT, ROWS, GATES, in.b_down);
        EpiDown E{Yb, TAB, TABF, TABB};
        if (!((c >> 3) & 1)) pg8::gemm_phase<EpiDown, pg8::MoeProb<false>, true, true>(lds, P, E);
#else
        pg8::MoeProb<false> P{(const char*)ACTb, (const char*)(ws + WS_WD), DFF, 4, G, c, (size_t)128 * DFF, (size_t)D * DFF, 256, TPRE, TAB, UDESC};
        moe_table<false>(P, UDESC, TAB, TABF, TABB, LCNT, ROWS, GATES, in.b_down);
        EpiDown E{Yb, TAB, TABF, TABB};
        REP(7) pg8::gemm_phase<EpiDown, pg8::MoeProb<false>, true, true>(lds, P, E);
#endif
        SEAM(7);
    }

#ifdef RT_HASH
    if (IN(8)) REP(8) final_phase(X1, (const unsigned char*)(RSTD + S), in.final_g, args.out, G, c);
#else
    if (IN(8)) REP(8) final_phase(X1, Yb, in.final_g, args.out, G, c);
#endif

#undef IN
#undef SEAM
}

#ifndef MK_N_LAUNCHES
#define MK_N_LAUNCHES 1
#endif
#ifndef MK_SEQ
#define MK_SEQ "012345678"
#endif
extern "C" void kernel_launch(void* const* d_in, const int* in_sizes, int n_in, void* d_out, int out_size, void* d_ws, size_t ws_size, hipStream_t stream) {
    static int grid = 0;
    if (grid == 0) {
        if (n_in != 15 || out_size != S * D || ws_size < WS_END) { fprintf(stderr, "kernel_launch: unexpected problem (n_in %d out %d ws %zu)\n", n_in, out_size, ws_size); grid = -1; return; }
        int dev = 0, cus = 0, per_cu = 0;
        if (hipGetDevice(&dev) != hipSuccess || hipDeviceGetAttribute(&cus, hipDeviceAttributeMultiprocessorCount, dev) != hipSuccess) { grid = -1; return; }
        if (hipFuncSetAttribute((const void*)fwd, hipFuncAttributeMaxDynamicSharedMemorySize, LDS_BYTES) != hipSuccess) { fprintf(stderr, "kernel_launch: hipFuncSetAttribute failed\n"); grid = -1; return; }
        if (hipOccupancyMaxActiveBlocksPerMultiprocessor(&per_cu, (const void*)fwd, 512, LDS_BYTES) != hipSuccess || per_cu < 1) { fprintf(stderr, "kernel_launch: occupancy query says %d blocks per CU\n", per_cu); (void)hipGetLastError(); per_cu = 1; }
        grid = cus;
    }
    if (grid < 0) return;
    if (hipMemsetAsync((char*)d_ws + WS_CTL, 0, CTL_ZERO_BYTES, stream) != hipSuccess) { fprintf(stderr, "kernel_launch: memset failed\n"); return; }
    Args a{};
    a.in.x = (const float*)d_in[0]; a.in.norm1_g = (const float*)d_in[1]; a.in.w_in = (const float*)d_in[2]; a.in.pool_w = (const float*)d_in[3]; a.in.pool_scale = (const float*)d_in[4];
    a.in.rel_bias = (const float*)d_in[5]; a.in.w_out = (const float*)d_in[6]; a.in.norm2_g = (const float*)d_in[7]; a.in.router_w = (const float*)d_in[8]; a.in.router_b = (const float*)d_in[9];
    a.in.w_gate_up = (const float*)d_in[10]; a.in.b_gate_up = (const float*)d_in[11]; a.in.w_down = (const float*)d_in[12]; a.in.b_down = (const float*)d_in[13]; a.in.final_g = (const float*)d_in[14];
    a.out = (float*)d_out; a.ws = (unsigned char*)d_ws;
    if (MK_N_LAUNCHES == 1) { a.ph_lo = 0; a.ph_hi = NPHASE; hipLaunchKernelGGL(fwd, dim3(grid), dim3(512), LDS_BYTES, stream, a); }
    else { const char* seq = MK_SEQ; for (int i = 0; seq[i]; ++i) { const int p = seq[i] - '0'; a.ph_lo = p; a.ph_hi = p + 1; if (p == 5) (void)hipMemsetAsync((char*)d_ws + WS_CTL + CW_COUNTS * 4, 0, 128, stream); hipLaunchKernelGGL(fwd, dim3(grid), dim3(512), LDS_BYTES, stream, a); } }
    const hipError_t le = hipPeekAtLastError();
    if (le != hipSuccess) fprintf(stderr, "kernel_launch: launch failed: %s\n", hipGetErrorName(le));
}
```

```cpp
#include <hip/hip_runtime.h>
#include <cstdio>
#include <cstdint>

#define LAS __attribute__((address_space(3)))
#define GAS __attribute__((address_space(1)))
typedef unsigned short bf16_t;
typedef short bf16x8 __attribute__((ext_vector_type(8)));
typedef short s16x4 __attribute__((ext_vector_type(4)));
typedef float f32x4 __attribute__((ext_vector_type(4)));
typedef float f32x2 __attribute__((ext_vector_type(2)));
typedef unsigned u32x4 __attribute__((ext_vector_type(4)));
typedef unsigned u32x2 __attribute__((ext_vector_type(2)));
typedef int i32x4 __attribute__((ext_vector_type(4)));
typedef int i32x8 __attribute__((ext_vector_type(8)));

constexpr int S = 16384, D = 1024, NPROJ = 2560, PW = 256, AW = 768, NH = 12, HD = 64, NE = 32, TOPK = 4, DFF = 1024;
constexpr float RMS_EPS = 1e-5f, LOG2E = 1.4426950408889634f, QSCALE = 0.125f * LOG2E, NEGBIG = -1e30f;
constexpr float WSCALE = 64.0f, HSCALE = 16.0f, ASCALE = 8.0f, YSCALE = 64.0f, FP8MAX = 448.0f;
constexpr int BT_N = 400, BT_OFF = 144;

constexpr size_t MiB = 1u << 20;
constexpr size_t WS_CTL = 0, CTL_ZERO_BYTES = 32 * 1024;
constexpr size_t WS_WIN = 2 * MiB;
constexpr size_t WS_WOUT = 8 * MiB;
constexpr size_t WS_GWT = 10 * MiB;
constexpr size_t WS_BT = 10 * MiB + 512 * 1024;
constexpr size_t WS_PWT = 10 * MiB + 768 * 1024;
constexpr size_t WS_RSTD = 11 * MiB;
constexpr size_t WS_GATES = 11 * MiB + 256 * 1024;
constexpr size_t WS_ROWS = 12 * MiB;
constexpr size_t WS_LSE = 14 * MiB;
constexpr size_t WS_WGU = 32 * MiB;
constexpr size_t WS_WD = 160 * MiB;
constexpr size_t WS_H8 = 200 * MiB;
constexpr size_t WS_H = 224 * MiB;
constexpr size_t WS_U = 256 * MiB;
constexpr size_t WS_Q = 264 * MiB, WS_K = 288 * MiB, WS_V = 312 * MiB;
constexpr size_t WS_OP = 336 * MiB;
constexpr size_t WS_MIX = 408 * MiB;
constexpr size_t WS_X1 = 440 * MiB;
constexpr size_t WS_ACT = 512 * MiB;
constexpr size_t WS_Y = 656 * MiB;
constexpr size_t WS_END = 784 * MiB;
constexpr int ACT_ROWS = 65536 + 32 * 256;
constexpr int CW_COUNTS = 64;
constexpr int CW_QUEUE = 256;
constexpr int CW_BAR = 4096;

constexpr int LDS_BYTES = 163840;
constexpr int LDS_TAB = 131072;
constexpr int LDS_CTL = LDS_BYTES - 1024;
constexpr int MAXU = 9;

typedef __bf16 bf16x2_t __attribute__((ext_vector_type(2)));
__device__ __forceinline__ unsigned cvt_pk_bf16(float lo, float hi) { const f32x2 v = {lo, hi}; const bf16x2_t b = __builtin_convertvector(v, bf16x2_t); return __builtin_bit_cast(unsigned, b); }
__device__ __forceinline__ float clamp8(float v) { return __builtin_amdgcn_fmed3f(v, -FP8MAX, FP8MAX); }
__device__ __forceinline__ unsigned cvt4_fp8(float a, float b, float c, float d) {
    int p = __builtin_amdgcn_cvt_pk_fp8_f32(clamp8(a), clamp8(b), 0, false); p = __builtin_amdgcn_cvt_pk_fp8_f32(clamp8(c), clamp8(d), p, true); return (unsigned)p; }
__device__ __forceinline__ float bf_lo(unsigned w) { return __uint_as_float(w << 16); }
__device__ __forceinline__ float bf_hi(unsigned w) { return __uint_as_float(w & 0xffff0000u); }
__device__ __forceinline__ float wave_sum(float v) {
#pragma unroll
    for (int o = 1; o < 64; o <<= 1) v += __shfl_xor(v, o);
    return v;
}
#define LDS_WAIT() asm volatile("s_waitcnt lgkmcnt(0)" ::: "memory")
#define VM_WAIT() asm volatile("s_waitcnt vmcnt(0)" ::: "memory")

#define XB_TMO      128
#define XB_XCNT(j)  (256  + 64 * (j))
#define XB_XSUB(j)  (1280 + 64 * (j))
#define XB_XGEN(j)  (2304 + 64 * (j))
#define XB_TOP      3328
#define XB_TOPGEN   3392
#define XCD_BAR_WORDS 3456
#define XB_SPIN_CAP (1u << 18)
__device__ __forceinline__ unsigned xb_ld(unsigned* p)              { return __hip_atomic_load(p, __ATOMIC_RELAXED, __HIP_MEMORY_SCOPE_AGENT); }
__device__ __forceinline__ unsigned xb_add(unsigned* p, unsigned v) { return __hip_atomic_fetch_add(p, v, __ATOMIC_RELAXED, __HIP_MEMORY_SCOPE_AGENT); }
__device__ __forceinline__ unsigned xb_xcc_id() { return (unsigned)__builtin_amdgcn_s_getreg((3 << 11) | 20) & 0xFu; }
#define XB_SPIN(cond, bar) do { unsigned _sp = 0; while (cond) { __builtin_amdgcn_s_sleep(1); \
    if ((++_sp & 255u) == 0u) { if (xb_ld(&(bar)[XB_TMO])) break; if (_sp > XB_SPIN_CAP) { atomicAdd(&(bar)[XB_TMO], 1u); break; } } } } while (0)
struct XcdBarrier { unsigned* bar; unsigned x; volatile LAS unsigned* st; };
__device__ __forceinline__ XcdBarrier xcd_barrier_post(unsigned* bar, volatile LAS unsigned* st) {
    XcdBarrier b; b.bar = bar; b.x = xb_xcc_id(); b.st = st;
    if (threadIdx.x == 0) (void)xb_add(&bar[XB_XCNT(b.x)], 1u);
    return b;
}
__device__ __forceinline__ void xcd_barrier_complete(unsigned* bar, unsigned x, unsigned& nloc, unsigned& nx) {
    const unsigned G = gridDim.x * gridDim.y * gridDim.z;
    unsigned sum, cnt, mine, sp = 0u;
    for (;;) {
        sum = 0u; cnt = 0u; mine = 0u;
#pragma unroll
        for (unsigned j = 0; j < 16; ++j) { const unsigned c = xb_ld(&bar[XB_XCNT(j)]); sum += c; cnt += (c > 0u) ? 1u : 0u; mine = (j == x) ? c : mine; }
        if (sum == G) break;
        __builtin_amdgcn_s_sleep(1);
        if ((++sp & 255u) == 0u) { if (xb_ld(&bar[XB_TMO])) break; if (sp > XB_SPIN_CAP) { atomicAdd(&bar[XB_TMO], 1u); break; } }
    }
    nloc = mine > 0u ? mine : 1u; nx = cnt > 0u ? cnt : 1u;
}
__device__ __forceinline__ void xcd_barrier(const XcdBarrier& b) {
    asm volatile("s_waitcnt vmcnt(0)" ::: "memory");
    __syncthreads();
    if (threadIdx.x == 0) {
        unsigned* bar = b.bar;
        __builtin_amdgcn_s_waitcnt(0);
        unsigned nloc = b.st[0], nx = b.st[1];
        if (nloc == 0u) { xcd_barrier_complete(bar, b.x, nloc, nx); b.st[0] = nloc; b.st[1] = nx; }
        const unsigned old = xb_add(&bar[XB_XSUB(b.x)], 1u);
        const unsigned gen = old / nloc;
        if (old + 1u == (gen + 1u) * nloc) {
            __builtin_amdgcn_fence(__ATOMIC_RELEASE, "agent");
            asm volatile("s_waitcnt vmcnt(0)" ::: "memory");
            const unsigned og = xb_add(&bar[XB_TOP], 1u);
            const unsigned tg = og / nx;
            if (og + 1u == (tg + 1u) * nx) xb_add(&bar[XB_TOPGEN], 1u);
            else XB_SPIN(xb_ld(&bar[XB_TOPGEN]) == tg, bar);
            __builtin_amdgcn_fence(__ATOMIC_ACQUIRE, "agent");
            xb_add(&bar[XB_XGEN(b.x)], 1u);
            asm volatile("s_waitcnt vmcnt(0)" ::: "memory");
        } else {
            XB_SPIN(xb_ld(&bar[XB_XGEN(b.x)]) == gen, bar);
            __builtin_amdgcn_fence(__ATOMIC_ACQUIRE, "agent");
            asm volatile("s_waitcnt vmcnt(0)" ::: "memory");
        }
    }
    __syncthreads();
}

namespace pg8 {
constexpr int BM = 256, BK = 64, HALF = 128, HTB = HALF * BK * 2, STAGE_BYTES = 8 * HTB, NXCD = 8, WGM = 8;
__host__ __device__ __forceinline__ int lds_byte(int r, int c) { const int st = (r >> 4) * 2 + (c >> 5), rr = r & 15, cc = c & 31, ob = rr * 64 + cc * 2; return st * 1024 + (ob ^ (((ob >> 9) & 1) << 5)); }
__host__ __device__ __forceinline__ void stage_rc(int b, int& R, int& C) { const int st = b / 1024, sb = b % 1024, swz = sb ^ (((sb >> 9) & 1) << 5); R = (st >> 1) * 16 + swz / 64; C = (st & 1) * 32 + (swz % 64) / 2; }
__host__ __device__ __forceinline__ int perm32(int rho) { const int n = rho >> 4, i = rho & 15; return 8 * (i >> 2) + 4 * n + (i & 3); }

struct Unit { int pm, pn, e, slot; };

template <class Epi, class Prob, bool ALIGN_EPI, bool FP8>
__device__ __forceinline__ void gemm_phase(LAS unsigned char* lds, const Prob& P, const Epi& E) {
    int tid_ = threadIdx.x; asm volatile("" : "+v"(tid_));
    const int tid = tid_, wid = __builtin_amdgcn_readfirstlane(tid >> 6), lane = tid & 63, wr = wid >> 2, wc = wid & 3, fr = lane & 15, fq = lane >> 4;
    const int rowb = P.rowb, nt = rowb / 128;
    int R0, C0; stage_rc(tid * 16, R0, C0);
    const int CB = C0 * 2, Rb = Epi::PERM ? ((R0 & ~31) + perm32(R0 & 31)) : R0;
    const unsigned voffB = (unsigned)(Rb * rowb + CB), laneA = (unsigned)(R0 * rowb + CB);
    const unsigned r64 = (unsigned)(64 * rowb);
    const unsigned kstep = (unsigned)(BK * 2);
    const unsigned bhalf = (unsigned)P.b_half;
    const unsigned ldsw = (unsigned)wid * 1024u;
    const int aoff = lds_byte(wr * 64 + fr, fq * 8), boff = lds_byte(wc * 32 + fr, fq * 8);
#define PG8_SA(b, h) (((b) * 2 + (h)) * HTB)
#define PG8_SB(b, h) ((4 + (b) * 2 + (h)) * HTB)
    const __amdgpu_buffer_rsrc_t srdA = __builtin_amdgcn_make_buffer_rsrc((void*)P.A, (short)0, 0x7fffffff, 0x00020000);
    const __amdgpu_buffer_rsrc_t srdB = __builtin_amdgcn_make_buffer_rsrc((void*)P.Bt, (short)0, 0x7fffffff, 0x00020000);
#define PG8_STAGE_B(bufoff, so) do { \
        __builtin_amdgcn_raw_ptr_buffer_load_lds(srdB, (LAS void*)(lds + (bufoff) + ldsw), 16, (int)voffB, (int)(so), 0, 0); \
        __builtin_amdgcn_raw_ptr_buffer_load_lds(srdB, (LAS void*)(lds + (bufoff) + ldsw + 8192), 16, (int)voffB, (int)((so) + r64), 0, 0); } while (0)
#define PG8_STAGE_A(bufoff, kb, h) do { \
        if constexpr (Prob::GATHER_A) { \
            __builtin_amdgcn_raw_ptr_buffer_load_lds(srdA, (LAS void*)(lds + (bufoff) + ldsw), 16, (int)((h) ? c10 : c00), (int)(kb), 0, 0); \
            __builtin_amdgcn_raw_ptr_buffer_load_lds(srdA, (LAS void*)(lds + (bufoff) + ldsw + 8192), 16, (int)((h) ? c11 : c01), (int)(kb), 0, 0); } \
        else { \
            __builtin_amdgcn_raw_ptr_buffer_load_lds(srdA, (LAS void*)(lds + (bufoff) + ldsw), 16, (int)laneA, (int)(aB + (kb) + (h) * 2 * r64), 0, 0); \
            __builtin_amdgcn_raw_ptr_buffer_load_lds(srdA, (LAS void*)(lds + (bufoff) + ldsw + 8192), 16, (int)laneA, (int)(aB + (kb) + (h) * 2 * r64 + r64), 0, 0); } } while (0)
#define PG8_LDA(dst, b, h) do { _Pragma("unroll") for (int m = 0; m < 4; ++m) _Pragma("unroll") for (int k = 0; k < 2; ++k) dst[m][k] = *(const LAS bf16x8*)(lds + PG8_SA(b, h) + aoff + m * 2048 + k * 1024); } while (0)
#define PG8_LDB(dst, b, h) do { _Pragma("unroll") for (int n = 0; n < 2; ++n) _Pragma("unroll") for (int k = 0; k < 2; ++k) dst[n][k] = *(const LAS bf16x8*)(lds + PG8_SB(b, h) + boff + n * 2048 + k * 1024); } while (0)
#define PG8_MMA(ai, bj, At, Bt) do { __builtin_amdgcn_s_setprio(1); _Pragma("unroll") for (int m = 0; m < 4; ++m) _Pragma("unroll") for (int n = 0; n < 2; ++n) { \
        if constexpr (FP8) { const i32x8 fb_ = __builtin_shufflevector(__builtin_bit_cast(i32x4, Bt[n][0]), __builtin_bit_cast(i32x4, Bt[n][1]), 0, 1, 2, 3, 4, 5, 6, 7); \
            const i32x8 fa_ = __builtin_shufflevector(__builtin_bit_cast(i32x4, At[m][0]), __builtin_bit_cast(i32x4, At[m][1]), 0, 1, 2, 3, 4, 5, 6, 7); \
            acc[ai][bj][m][n] = __builtin_amdgcn_mfma_scale_f32_16x16x128_f8f6f4(fb_, fa_, acc[ai][bj][m][n], 0, 0, 0, 0, 0, 0); } \
        else { _Pragma("unroll") for (int k = 0; k < 2; ++k) acc[ai][bj][m][n] = __builtin_amdgcn_mfma_f32_16x16x32_bf16(Bt[n][k], At[m][k], acc[ai][bj][m][n], 0, 0, 0); } } \
        __builtin_amdgcn_s_setprio(0); } while (0)
#define PG8_WAIT_V(n) asm volatile("s_waitcnt vmcnt(" #n ")" ::: "memory")
#define PG8_WAIT_L(n) asm volatile("s_waitcnt lgkmcnt(" #n ")" ::: "memory")
#define PG8_BAR __builtin_amdgcn_s_barrier()
#define PG8_SCHED __builtin_amdgcn_sched_barrier(0)
    Unit cur, nxt; int ui = 0;
    if (!P.next(0, cur)) return;
    f32x4 acc[2][2][4][2];
    E.init(acc, cur, wr, wc, fr, fq);
    bf16x8 At[4][2], B0[2][2], B1[2][2];
    unsigned c00 = 0, c01 = 0, c10 = 0, c11 = 0, aB = 0;
    if constexpr (Prob::GATHER_A) { c00 = P.a_off(cur, R0, CB); c01 = P.a_off(cur, R0 + 64, CB); c10 = P.a_off(cur, HALF + R0, CB); c11 = P.a_off(cur, HALF + R0 + 64, CB); }
    else aB = P.a_base(cur);
    unsigned cB = P.b_off(cur);
    PG8_STAGE_B(PG8_SB(0, 0), cB); PG8_STAGE_B(PG8_SB(0, 1), cB + bhalf); PG8_STAGE_A(PG8_SA(0, 0), 0, 0); PG8_STAGE_A(PG8_SA(0, 1), 0, 1);
    if (wr == 1) PG8_BAR;
    PG8_WAIT_V(2); PG8_BAR;
    PG8_STAGE_B(PG8_SB(1, 0), cB + kstep); PG8_STAGE_A(PG8_SA(1, 0), kstep, 0); PG8_STAGE_B(PG8_SB(1, 1), cB + bhalf + kstep);
    PG8_WAIT_V(6); PG8_BAR;
    for (;;) {
        const bool has_next = P.next(ui + 1, nxt);
        const unsigned nB = has_next ? P.b_off(nxt) : cB;
        for (int t = 0; t < nt; t += 2) {
            const bool last = (t == nt - 2);
            const unsigned k1 = (unsigned)(t + 1) * kstep;
            const unsigned k2 = last ? 0u : (unsigned)(t + 2) * kstep, k3 = k2 + kstep;
            const unsigned b2 = last ? nB : cB + (unsigned)(t + 2) * kstep, b3 = b2 + kstep;
            if constexpr (Prob::GATHER_A) { if (last && has_next) { c00 = P.a_off(nxt, R0, CB); c01 = P.a_off(nxt, R0 + 64, CB); } }
            PG8_LDB(B0, 0, 0); PG8_LDB(B1, 0, 1); PG8_SCHED; PG8_LDA(At, 0, 0); PG8_STAGE_A(PG8_SA(1, 1), k1, 1);
            PG8_WAIT_V(8); PG8_WAIT_L(0); PG8_BAR; PG8_MMA(0, 0, At, B0); PG8_MMA(0, 1, At, B1); PG8_BAR; PG8_SCHED;
            if (last && has_next) { if constexpr (Prob::GATHER_A) { c10 = P.a_off(nxt, HALF + R0, CB); c11 = P.a_off(nxt, HALF + R0 + 64, CB); } else aB = P.a_base(nxt); }
            PG8_LDA(At, 0, 1); PG8_STAGE_B(PG8_SB(0, 0), b2); PG8_STAGE_B(PG8_SB(0, 1), b2 + bhalf); PG8_STAGE_A(PG8_SA(0, 0), k2, 0);
            PG8_WAIT_V(8); PG8_WAIT_L(0); PG8_BAR; PG8_MMA(1, 0, At, B0); PG8_MMA(1, 1, At, B1); PG8_BAR; PG8_SCHED;
            PG8_LDB(B0, 1, 0); PG8_LDB(B1, 1, 1); PG8_SCHED; PG8_LDA(At, 1, 0); PG8_STAGE_A(PG8_SA(0, 1), k2, 1);
            PG8_WAIT_V(8); PG8_WAIT_L(0); PG8_BAR; PG8_MMA(0, 0, At, B0); PG8_MMA(0, 1, At, B1); PG8_BAR; PG8_SCHED;
            PG8_LDA(At, 1, 1); PG8_STAGE_B(PG8_SB(1, 0), b3); PG8_STAGE_B(PG8_SB(1, 1), b3 + bhalf); PG8_STAGE_A(PG8_SA(1, 0), k3, 0);
            PG8_WAIT_V(8); PG8_WAIT_L(0); PG8_BAR; PG8_MMA(1, 0, At, B0); PG8_MMA(1, 1, At, B1); PG8_BAR; PG8_SCHED;
        }
        if constexpr (ALIGN_EPI) { if (wr == 0) PG8_BAR; }
        E(acc, cur, wr, wc, fr, fq);
#if defined(MK_DOUBLE)
        if constexpr (FP8) { if ((MK_DOUBLE >> 12) & 1) { asm volatile("" ::: "memory"); E(acc, cur, wr, wc, fr, fq); } }
#endif
        if (!has_next) break;
        cur = nxt; cB = nB; ++ui;
        E.init(acc, cur, wr, wc, fr, fq);
        if constexpr (ALIGN_EPI) { if (wr == 1) PG8_BAR; }
    }
    PG8_WAIT_V(0);
    if constexpr (!ALIGN_EPI) { if (wr == 0) PG8_BAR; }
    PG8_BAR;
#undef PG8_SA
#undef PG8_SB
#undef PG8_STAGE_A
#undef PG8_STAGE_B
#undef PG8_LDA
#undef PG8_LDB
#undef PG8_MMA
#undef PG8_WAIT_V
#undef PG8_WAIT_L
#undef PG8_BAR
#undef PG8_SCHED
}

__device__ __forceinline__ bool static_order(int nM, int nN, int G, int c, int i, int& pm, int& pn) {
    const int nwg = nM * nN; const long L = (long)i * G + c; if (L >= nwg) return false;
    int wgid = (int)L; { const int q = nwg / NXCD, r = nwg % NXCD, xcd = wgid % NXCD, off = wgid / NXCD; wgid = (xcd < r ? xcd * (q + 1) : r * (q + 1) + (xcd - r) * q) + off; }
    const int nig = WGM * nN, gid = wgid / nig, fm = gid * WGM, gsz = (nM - fm) < WGM ? (nM - fm) : WGM;
    pm = fm + ((wgid % nig) % gsz); pn = (wgid % nig) / gsz; return true;
}
struct DenseProb {
    const char* A; const char* Bt; int rowb, nM, nN, G, c; size_t b_half;
    __device__ __forceinline__ bool next(int i, Unit& u) const { u.e = 0; u.slot = i; return static_order(nM, nN, G, c, i, u.pm, u.pn); }
    static constexpr bool GATHER_A = false;
    __device__ __forceinline__ unsigned a_off(const Unit&, int, int) const { return 0u; }
    __device__ __forceinline__ unsigned a_base(const Unit& u) const { return (unsigned)(u.pm * BM * rowb); }
    __device__ __forceinline__ unsigned b_off(const Unit& u) const { return (unsigned)(u.pn * BM * rowb); }
};
template <bool GATHER> struct MoeProb {
    const char* A; const char* Bt; int rowb, nN, G, c; size_t b_half; size_t b_expert; int b_tile_rows;
    const LAS int* tpre; const LAS int* tab; const LAS int* udesc;
    __device__ __forceinline__ int tp(int j) const { return __builtin_amdgcn_readfirstlane(tpre[j]); }
    __device__ __forceinline__ bool search(int i, Unit& u) const {
        const int total = tpre[NE] * nN; const long L0 = (long)i * G + c; if (L0 >= total) return false;
        int L = (int)L0; { const int q = total / NXCD, r = total % NXCD, xcd = L % NXCD, off = L / NXCD; L = (xcd < r ? xcd * (q + 1) : r * (q + 1) + (xcd - r) * q) + off; }
        int e = 0;
        for (int j = 1; j < NE; ++j) e += (tpre[j] * nN <= L) ? 1 : 0;
        const int first = tpre[e] * nN, tiles = tpre[e + 1] - tpre[e], rem = L - first;
        u.e = e; u.pm = rem % tiles; u.pn = rem / tiles; u.slot = i; return true;
    }
    __device__ __forceinline__ bool next(int i, Unit& u) const {
        if (i >= MAXU) return false;
        const int v = __builtin_amdgcn_readfirstlane(udesc[4 * i + 3]); if (!v) return false;
        u.e = __builtin_amdgcn_readfirstlane(udesc[4 * i]); u.pm = __builtin_amdgcn_readfirstlane(udesc[4 * i + 1]); u.pn = __builtin_amdgcn_readfirstlane(udesc[4 * i + 2]); u.slot = i; return true;
    }
    static constexpr bool GATHER_A = GATHER;
    __device__ __forceinline__ unsigned a_off(const Unit& u, int row, int colb) const { const int idx = tab[u.slot * 256 + row]; const int tok = idx < 0 ? 0 : (idx >> 2); return (unsigned)(tok * rowb + colb); }
    __device__ __forceinline__ unsigned a_base(const Unit& u) const { return (unsigned)((tp(u.e) + u.pm) * BM * rowb); }
    __device__ __forceinline__ unsigned b_off(const Unit& u) const { return (unsigned)u.e * (unsigned)b_expert + (unsigned)(u.pn * b_tile_rows * rowb); }
};
}

using pg8::Unit;
typedef f32x4 AccT[2][2][4][2];
__device__ __forceinline__ void acc_zero(AccT& acc) {
#pragma unroll
    for (int a = 0; a < 2; ++a)
#pragma unroll
        for (int b = 0; b < 2; ++b)
#pragma unroll
            for (int m = 0; m < 4; ++m)
#pragma unroll
                for (int n = 0; n < 2; ++n) acc[a][b][m][n] = (f32x4){0.f, 0.f, 0.f, 0.f};
}

struct EpiQKVU {
    static constexpr bool PERM = true;
    unsigned char* ws;
    __device__ __forceinline__ void init(AccT& acc, const Unit&, int, int, int, int) const { acc_zero(acc); }
    __device__ __forceinline__ void operator()(const AccT& acc, const Unit& u, int wr, int wc, int fr, int fq) const {
        static_assert(WS_K - WS_Q == WS_V - WS_K, "Q, K, V equally spaced");
        const int t = (u.pn - 1) / 3;
        const size_t boff = (u.pn == 0) ? WS_U : (WS_Q + (size_t)t * (WS_K - WS_Q));
        bf16_t* base = (bf16_t*)(ws + boff);
        const int ldc = (u.pn == 0) ? PW : AW, colt = (u.pn == 0) ? 0 : ((u.pn - 1) % 3) * 256;
        const float sc = (u.pn >= 1 && u.pn <= 3) ? QSCALE : 1.f;
        const int row0 = u.pm * 256 + wr * 64 + fr, col0 = colt + wc * 32 + 8 * fq;
#pragma unroll
        for (int ai = 0; ai < 2; ++ai)
#pragma unroll
            for (int m = 0; m < 4; ++m) { bf16_t* rowp = base + (size_t)(row0 + ai * 128 + m * 16) * ldc + col0;
#pragma unroll
                for (int bj = 0; bj < 2; ++bj) { const f32x4 v0 = acc[ai][bj][m][0] * sc, v1 = acc[ai][bj][m][1] * sc;
                    u32x4 w; w.x = cvt_pk_bf16(v0[0], v0[1]); w.y = cvt_pk_bf16(v0[2], v0[3]); w.z = cvt_pk_bf16(v1[0], v1[1]); w.w = cvt_pk_bf16(v1[2], v1[3]);
                    *(u32x4*)(rowp + bj * 128) = w; } }
    }
};
struct EpiResBf16 {
    static constexpr bool PERM = true;
    const float* X; bf16_t* O;
    __device__ __forceinline__ void init(AccT& acc, const Unit& u, int wr, int wc, int fr, int fq) const {
        const int row0 = u.pm * 256 + wr * 64 + fr, col0 = u.pn * 256 + wc * 32 + 8 * fq;
#pragma unroll
        for (int ai = 0; ai < 2; ++ai)
#pragma unroll
            for (int m = 0; m < 4; ++m) { const unsigned off = (unsigned)((row0 + ai * 128 + m * 16) * D + col0);
#pragma unroll
                for (int bj = 0; bj < 2; ++bj)
#pragma unroll
                    for (int n = 0; n < 2; ++n) acc[ai][bj][m][n] = __builtin_nontemporal_load((const f32x4*)(X + off + bj * 128 + n * 4)); }
    }
    __device__ __forceinline__ void operator()(const AccT& acc, const Unit& u, int wr, int wc, int fr, int fq) const {
        const int row0 = u.pm * 256 + wr * 64 + fr, col0 = u.pn * 256 + wc * 32 + 8 * fq;
#pragma unroll
        for (int ai = 0; ai < 2; ++ai)
#pragma unroll
            for (int m = 0; m < 4; ++m) { const unsigned off = (unsigned)((row0 + ai * 128 + m * 16) * D + col0);
#pragma unroll
                for (int bj = 0; bj < 2; ++bj) { const f32x4 v0 = acc[ai][bj][m][0], v1 = acc[ai][bj][m][1];
                    u32x4 w; w.x = cvt_pk_bf16(v0[0], v0[1]); w.y = cvt_pk_bf16(v0[2], v0[3]); w.z = cvt_pk_bf16(v1[0], v1[1]); w.w = cvt_pk_bf16(v1[2], v1[3]);
                    *(u32x4*)(O + off + bj * 128) = w; } }
    }
};
__device__ __forceinline__ float swiglu1(float g, float u) {
    g = fminf(g, 7.0f); u = fminf(fmaxf(u, -7.0f), 7.0f);
    const float s = __builtin_amdgcn_rcpf(1.0f + __builtin_amdgcn_exp2f(g * (-1.702f * LOG2E)));
    return (u + 1.0f) * (g * s);
}
__device__ __forceinline__ f32x4 swiglu4(f32x4 g, f32x4 u) {
    g = __builtin_elementwise_min(g, (f32x4){7.0f, 7.0f, 7.0f, 7.0f});
    u = __builtin_elementwise_min(__builtin_elementwise_max(u, (f32x4){-7.0f, -7.0f, -7.0f, -7.0f}), (f32x4){7.0f, 7.0f, 7.0f, 7.0f});
    const f32x4 t = g * (-1.702f * LOG2E);
    f32x4 e; e[0] = __builtin_amdgcn_exp2f(t[0]); e[1] = __builtin_amdgcn_exp2f(t[1]); e[2] = __builtin_amdgcn_exp2f(t[2]); e[3] = __builtin_amdgcn_exp2f(t[3]);
    const f32x4 d = e + 1.0f;
    f32x4 r; r[0] = __builtin_amdgcn_rcpf(d[0]); r[1] = __builtin_amdgcn_rcpf(d[1]); r[2] = __builtin_amdgcn_rcpf(d[2]); r[3] = __builtin_amdgcn_rcpf(d[3]);
    return (u * ASCALE + ASCALE) * (g * r);
}
__device__ __forceinline__ unsigned cvt4_fp8_nc(const f32x4& v) {
    int p = __builtin_amdgcn_cvt_pk_fp8_f32(v[0], v[1], 0, false); p = __builtin_amdgcn_cvt_pk_fp8_f32(v[2], v[3], p, true); return (unsigned)p; }
struct EpiGateUp {
    static constexpr bool PERM = true;
    __device__ __forceinline__ void init(AccT& acc, const Unit&, int, int, int, int) const { acc_zero(acc); }
    unsigned char* ACT; const LAS int* tpre; const LAS float* tabf; const LAS float* tabb;
    __device__ __forceinline__ void operator()(const AccT& acc, const Unit& u, int wr, int wc, int fr, int fq) const {
        const int cl = wc * 32 + 8 * fq, colA = u.pn * 128 + cl;
        const LAS float* bp = tabb + u.slot * 256 + cl;
        const f32x4 bg0 = *(const LAS f32x4*)(bp), bg1 = *(const LAS f32x4*)(bp + 4), bu0 = *(const LAS f32x4*)(bp + 128), bu1 = *(const LAS f32x4*)(bp + 132);
        const int srow0 = (__builtin_amdgcn_readfirstlane(tpre[u.e]) + u.pm) * 256;
#pragma unroll
        for (int ai = 0; ai < 2; ++ai)
#pragma unroll
            for (int m = 0; m < 4; ++m) { const int r = ai * 128 + wr * 64 + m * 16 + fr; const float rs = tabf[u.slot * 256 + r];
                const f32x4 g0 = acc[ai][0][m][0] * rs + bg0, g1 = acc[ai][0][m][1] * rs + bg1, u0 = acc[ai][1][m][0] * rs + bu0, u1 = acc[ai][1][m][1] * rs + bu1;
                u32x2 w; w.x = cvt4_fp8_nc(swiglu4(g0, u0)); w.y = cvt4_fp8_nc(swiglu4(g1, u1));
                *(u32x2*)(ACT + (size_t)(srow0 + r) * DFF + colA) = w; }
    }
};
struct EpiDown {
    static constexpr bool PERM = true;
    __device__ __forceinline__ void init(AccT& acc, const Unit&, int, int, int, int) const { acc_zero(acc); }
    unsigned char* Y; const LAS int* tab; const LAS float* tabf; const LAS float* tabb;
    __device__ __forceinline__ void operator()(const AccT& acc, const Unit& u, int wr, int wc, int fr, int fq) const {
        const int cl = wc * 32 + 8 * fq, col0 = u.pn * 256 + cl;
        const LAS float* bp = tabb + u.slot * 256 + cl;
        f32x4 bv[2][2];
#pragma unroll
        for (int bj = 0; bj < 2; ++bj) { bv[bj][0] = *(const LAS f32x4*)(bp + bj * 128); bv[bj][1] = *(const LAS f32x4*)(bp + bj * 128 + 4); }
#pragma unroll
        for (int ai = 0; ai < 2; ++ai)
#pragma unroll
            for (int m = 0; m < 4; ++m) { const int r = ai * 128 + wr * 64 + m * 16 + fr; const int idx = tab[u.slot * 256 + r];
                if (idx >= 0) { const float gv = tabf[u.slot * 256 + r] * YSCALE; unsigned char* rowp = Y + (size_t)idx * D + col0;
#pragma unroll
                    for (int bj = 0; bj < 2; ++bj) { const f32x4 v0 = (acc[ai][bj][m][0] * (1.0f / (ASCALE * WSCALE)) + bv[bj][0]) * gv, v1 = (acc[ai][bj][m][1] * (1.0f / (ASCALE * WSCALE)) + bv[bj][1]) * gv;
                        u32x2 w; w.x = cvt4_fp8(v0[0], v0[1], v0[2], v0[3]); w.y = cvt4_fp8(v1[0], v1[1], v1[2], v1[3]);
                        *(u32x2*)(rowp + bj * 128) = w; } } }
    }
};

__device__ __forceinline__ void tr_item(const float* __restrict__ W, int K, int N, bf16_t* __restrict__ WT, LAS float* scr, int kb, int nb, int lane) {
    const int k0 = kb * 64, n0 = nb * 64;
    const float* src = W + (size_t)(k0 + (lane >> 4)) * N + n0 + (lane & 15) * 4;
    f32x4 v[16];
#pragma unroll
    for (int i = 0; i < 16; ++i) v[i] = *(const f32x4*)(src + (size_t)(4 * i) * N);
#pragma unroll
    for (int i = 0; i < 16; ++i) { LAS float* d = scr + (4 * i + (lane >> 4)) * 65 + (lane & 15) * 4; d[0] = v[i][0]; d[1] = v[i][1]; d[2] = v[i][2]; d[3] = v[i][3]; }
    LDS_WAIT();
    const int c = lane & 7;
#pragma unroll
    for (int j = 0; j < 8; ++j) { const int n = 8 * j + (lane >> 3); const LAS float* s = scr + (8 * c) * 65 + n;
        u32x4 o; o.x = cvt_pk_bf16(s[0], s[65]); o.y = cvt_pk_bf16(s[130], s[195]); o.z = cvt_pk_bf16(s[260], s[325]); o.w = cvt_pk_bf16(s[390], s[455]);
        *(u32x4*)(WT + (size_t)(n0 + n) * K + k0 + 8 * c) = o; }
    LDS_WAIT();
}
struct Item8 { const float* src; unsigned char* dst; int N; };
__device__ __forceinline__ void chunk8_load(const Item8& d, int ch, f32x4 (&v)[16], int lane) {
    const float* base = d.src + (size_t)(32 * ch + 4 * (lane >> 5)) * d.N + (lane & 31) * 4;
#pragma unroll
    for (int sl = 0; sl < 4; ++sl)
#pragma unroll
        for (int j = 0; j < 4; ++j) v[4 * sl + j] = __builtin_nontemporal_load((const f32x4*)(base + (size_t)(8 * sl + j) * d.N));
}
__device__ __forceinline__ void chunk8_cvt(int ch, const f32x4 (&v)[16], LAS unsigned* scr, int lane) {
    const int nq = lane & 31, kq0 = lane >> 5, sw = (nq & 7) << 2;
#pragma unroll
    for (int sl = 0; sl < 4; ++sl) { const int kw = 8 * ch + kq0 + 2 * sl;
#pragma unroll
        for (int i = 0; i < 4; ++i) scr[(4 * nq + i) * 32 + (kw ^ sw)] = cvt4_fp8(v[4 * sl][i] * WSCALE, v[4 * sl + 1][i] * WSCALE, v[4 * sl + 2][i] * WSCALE, v[4 * sl + 3][i] * WSCALE); }
}
__device__ __forceinline__ void item8_flush(const Item8& d, const LAS unsigned* scr, int lane, int pf = 0) {
    LDS_WAIT();
    if (pf & 8) return;
    const int c16 = lane & 7;
#pragma unroll
    for (int jj = 0; jj < 16; ++jj) { const int n = (lane >> 3) + 8 * jj;
        const u32x4 o = *(const LAS u32x4*)(scr + n * 32 + ((c16 ^ ((n >> 2) & 7)) << 2));
#ifdef FLUSH_PLAIN
        *(u32x4*)(d.dst + (size_t)n * D + 16 * c16) = o; }
#else
        __builtin_nontemporal_store(o, (u32x4*)(d.dst + (size_t)n * D + 16 * c16)); }
#endif
    LDS_WAIT();
}
__device__ __forceinline__ int t5_bucket(int dist) {
    if (dist < 16) return dist;
    const int large = 16 + (int)(logf((float)dist / 16.0f) / 4.852030263919617f * 16.0f);
    return large < 31 ? large : 31;
}
struct In { const float *x, *norm1_g, *w_in, *pool_w, *pool_scale, *rel_bias, *w_out, *norm2_g, *router_w, *router_b, *w_gate_up, *b_gate_up, *w_down, *b_down, *final_g; };

constexpr int N8_ALL = NE * 128 + NE * 64;
__device__ __forceinline__ void convert8_queue(LAS unsigned char* lds, const In& in, unsigned char* ws, unsigned* qword, int pf = 0) {
    const int lane = threadIdx.x & 63, wave = __builtin_amdgcn_readfirstlane((int)threadIdx.x >> 6);
    constexpr int IG = 8 * 16, ID = 8 * 8;
    auto desc = [&](int r) -> Item8 { Item8 d;
        if (r < NE * IG) { const int e = r / IG, q = r % IG, kb = q / 16, nb = q % 16;
            d.src = in.w_gate_up + (size_t)e * D * 2 * DFF + (size_t)(kb * 128) * (2 * DFF) + nb * 128; d.N = 2 * DFF; d.dst = ws + WS_WGU + (size_t)e * 2 * DFF * D + (size_t)(nb * 128) * D + kb * 128; }
        else { const int r2 = r - NE * IG, e = r2 / ID, q = r2 % ID, kb = q / 8, nb = q % 8;
            d.src = in.w_down + (size_t)e * DFF * D + (size_t)(kb * 128) * D + nb * 128; d.N = D; d.dst = ws + WS_WD + (size_t)e * D * DFF + (size_t)(nb * 128) * DFF + kb * 128; }
        return d; };
    constexpr int NQ8 = 16, QLEN = N8_ALL / NQ8; static_assert(N8_ALL % NQ8 == 0, "queue split");
    const int qi = (int)(blockIdx.x * 8 + wave) & (NQ8 - 1);
    unsigned* qw = qword + 64 * qi;
    auto claim = [&]() -> int { unsigned v = 0; if (lane == 0) v = __hip_atomic_fetch_add(qw, 1u, __ATOMIC_RELAXED, __HIP_MEMORY_SCOPE_AGENT); const int j = __builtin_amdgcn_readfirstlane((int)v); return j < QLEN ? qi + NQ8 * j : N8_ALL; };
    LAS unsigned* scr8 = (LAS unsigned*)(lds + wave * 16384);
    f32x4 va[16], vb[16];
    int it = claim();
    if (it < N8_ALL) { const Item8 d0 = desc(it); chunk8_load(d0, 0, va, lane); chunk8_load(d0, 1, vb, lane); }
    while (it < N8_ALL) {
        const Item8 d = desc(it);
        const int nx = claim();
        const bool more = nx < N8_ALL; const Item8 dn = more ? desc(nx) : d;
        chunk8_cvt(0, va, scr8, lane); chunk8_load(d, 2, va, lane);
        chunk8_cvt(1, vb, scr8, lane); chunk8_load(d, 3, vb, lane);
        chunk8_cvt(2, va, scr8, lane); if (more) chunk8_load(dn, 0, va, lane);
        chunk8_cvt(3, vb, scr8, lane); if (more) chunk8_load(dn, 1, vb, lane);
        item8_flush(d, scr8, lane, pf);
        it = nx;
    }
}
__device__ __forceinline__ void p0_prologue(LAS unsigned char* lds, const In& in, unsigned char* ws, int G, int c) {
    const int tid = threadIdx.x, lane = tid & 63, wave = __builtin_amdgcn_readfirstlane(tid >> 6);
    const int gw = c * 8 + wave, NGW = G * 8;
    LAS float* scr = (LAS float*)(lds + wave * 16640);
    constexpr int I_IN = 16 * 40, I_OUT = 16 * 16, I_GU1 = 16 * 32, I_D1 = 16 * 16;
    for (int it = gw; it < I_IN; it += NGW) tr_item(in.w_in, D, NPROJ, (bf16_t*)(ws + WS_WIN), scr, it / 40, it % 40, lane);
#ifndef MK_DOUBLE
#define MK_DOUBLE 0
#endif
    for (int repr_ = 0; repr_ < (((MK_DOUBLE >> 11) & 1) ? 2 : 1); ++repr_) {
        f32x4 gv[4];
#pragma unroll
        for (int j = 0; j < 4; ++j) gv[j] = *(const f32x4*)(in.norm1_g + 4 * lane + 256 * j);
        bf16_t* H = (bf16_t*)(ws + WS_H);
        f32x4 v[4], vn[4];
        int m = gw;
        if (m < S) {
#pragma unroll
            for (int j = 0; j < 4; ++j) v[j] = __builtin_nontemporal_load((const f32x4*)(in.x + (size_t)m * D + 4 * lane + 256 * j)); }
        for (; m < S; m += NGW) {
            const int mn = m + NGW;
            if (mn < S) {
#pragma unroll
                for (int j = 0; j < 4; ++j) vn[j] = __builtin_nontemporal_load((const f32x4*)(in.x + (size_t)mn * D + 4 * lane + 256 * j)); }
            float s = 0.f;
#pragma unroll
            for (int j = 0; j < 4; ++j) s += (v[j][0] * v[j][0] + v[j][1] * v[j][1]) + (v[j][2] * v[j][2] + v[j][3] * v[j][3]);
            const float rstd = rsqrtf(wave_sum(s) * (1.0f / D) + RMS_EPS);
#pragma unroll
            for (int j = 0; j < 4; ++j) { const f32x4 o = v[j] * rstd * gv[j]; u32x2 w; w.x = cvt_pk_bf16(o[0], o[1]); w.y = cvt_pk_bf16(o[2], o[3]); *(u32x2*)(H + (size_t)m * D + 4 * lane + 256 * j) = w; }
#pragma unroll
            for (int j = 0; j < 4; ++j) v[j] = vn[j];
        }
    }
}
__device__ __forceinline__ void p0_side(LAS unsigned char* lds, const In& in, unsigned char* ws, int n0, int c0) {
    const int tid = threadIdx.x, lane = tid & 63, wave = __builtin_amdgcn_readfirstlane(tid >> 6);
    LAS float* scr = (LAS float*)(lds + wave * 16640);
    for (int it = c0 * 8 + wave; it < 16 * 16; it += n0 * 8) tr_item(in.w_out, D, D, (bf16_t*)(ws + WS_WOUT), scr, it / 16, it % 16, lane);
    const int gt = c0 * 512 + tid, NGT = n0 * 512;
    { bf16_t* GWH = (bf16_t*)(ws + WS_GWT); bf16_t* GWL = GWH + NE * D; for (int i = gt; i < NE * D; i += NGT) { const int e = i >> 10, k = i & 1023; const float v = in.norm2_g[k] * in.router_w[k * NE + e];
        const unsigned hi = cvt_pk_bf16(v, 0.f) & 0xffffu; GWH[i] = (bf16_t)hi; GWL[i] = (bf16_t)(cvt_pk_bf16(v - __uint_as_float(hi << 16), 0.f) & 0xffffu); } }
    { float* BT = (float*)(ws + WS_BT); for (int i = gt; i < 36 * BT_N; i += NGT) { const int bh = i / BT_N, j = i % BT_N, b = bh / NH, h = bh % NH, dil = (b == 0) ? 1 : (b == 1 ? 4 : 16), d = j - BT_OFF;
        BT[i] = (d >= 0 && d <= 128) ? in.rel_bias[t5_bucket(d * dil) * NH + h] * LOG2E : NEGBIG; } }
    { bf16_t* PWT = (bf16_t*)(ws + WS_PWT); for (int i = gt; i < 4 * 64 * 64; i += NGT) { const int g = i >> 12, d = (i >> 6) & 63, cc = i & 63; PWT[i] = (bf16_t)(cvt_pk_bf16(in.pool_w[g * 4096 + cc * 64 + d], 0.f) & 0xffffu); } }
}

__device__ __forceinline__ s16x4 lds_tr16(const LAS unsigned char* p) { typedef short v4i16_t __attribute__((ext_vector_type(4))); return __builtin_bit_cast(s16x4, __builtin_amdgcn_ds_read_tr16_b64_v4i16((LAS v4i16_t*)p)); }
constexpr int ATT_UNITS = 3 * NH * 64, KV_PITCH = 144, KV_ROWS = 384, ATT_VOFF = KV_ROWS * KV_PITCH, ATT_TOFF = 2 * KV_ROWS * KV_PITCH, ATT_NEGOFF = ATT_TOFF + BT_N * 4;
__device__ __forceinline__ void attn_decode(int uid, int& b, int& h, int& r, int& j, int& dil) {
    const int bh = uid >> 6, x = uid & 63; b = bh / NH; h = bh % NH; dil = (b == 0) ? 1 : (b == 1 ? 4 : 16);
    const int nb = 64 / dil; r = x / nb; j = x % nb;
}
__device__ __forceinline__ void attn_phase(LAS unsigned char* lds, const bf16_t* __restrict__ Qg, const bf16_t* __restrict__ Kg, const bf16_t* __restrict__ Vg, const float* __restrict__ BT,
                                           bf16_t* __restrict__ OP, float* __restrict__ LSE, int G, int c) {
    const int tid = threadIdx.x, lane = tid & 63, w = __builtin_amdgcn_readfirstlane(tid >> 6), ql = lane & 15, g = lane >> 4;
    LAS unsigned char* Ks = lds; LAS unsigned char* Vs = lds + ATT_VOFF; LAS float* Tb = (LAS float*)(lds + ATT_TOFF); LAS float* Tneg = (LAS float*)(lds + ATT_NEGOFF);
    if (tid < 16) Tneg[tid] = NEGBIG;
    u32x4 kpre[6], vpre[6]; bf16x8 qa0, qa1, qb0, qb1; float tpre = 0.f;
#define ATT_PREFETCH(uid_) do { int b_, h_, r_, j_, dil_; attn_decode((uid_), b_, h_, r_, j_, dil_); \
        _Pragma("unroll") for (int cc = 0; cc < 6; ++cc) { const int id = tid + 512 * cc, row = id >> 3, ch = id & 7; int mm = 256 * j_ - 128 + row; if (mm < 0) mm += 128; \
            const size_t off = (size_t)(r_ + dil_ * mm) * AW + h_ * HD + ch * 8; kpre[cc] = *(const u32x4*)(Kg + off); vpre[cc] = *(const u32x4*)(Vg + off); } \
        { const size_t qo = (size_t)(r_ + dil_ * (256 * j_ + 32 * w + ql)) * AW + h_ * HD + 8 * g; const size_t qs = (size_t)16 * dil_ * AW; \
          qa0 = *(const bf16x8*)(Qg + qo); qa1 = *(const bf16x8*)(Qg + qo + 32); qb0 = *(const bf16x8*)(Qg + qo + qs); qb1 = *(const bf16x8*)(Qg + qo + qs + 32); } \
        if (tid < BT_N) tpre = BT[(b_ * NH + h_) * BT_N + tid]; } while (0)
#ifndef ATT_SYNC_LOAD
    if (c < ATT_UNITS) ATT_PREFETCH(c);
#endif
    for (int uid = c; uid < ATT_UNITS; uid += G) {
        int b, h, r, j, dil; attn_decode(uid, b, h, r, j, dil);
#ifdef ATT_SYNC_LOAD
        ATT_PREFETCH(uid);
#endif
#pragma unroll
        for (int cc = 0; cc < 6; ++cc) { const int id = tid + 512 * cc, row = id >> 3, ch = id & 7; *(LAS u32x4*)(Ks + row * KV_PITCH + ch * 16) = kpre[cc]; *(LAS u32x4*)(Vs + row * KV_PITCH + ch * 16) = vpre[cc]; }
        if (tid < BT_N) Tb[tid] = tpre;
        const bf16x8 fa0 = qa0, fa1 = qa1, fb0 = qb0, fb1 = qb1;
        __syncthreads();
#ifndef ATT_SYNC_LOAD
        if (uid + G < ATT_UNITS) ATT_PREFETCH(uid + G);
#endif
#if defined(MK_DOUBLE)
        for (int repc_ = 0; repc_ < (((MK_DOUBLE >> 13) & 1) ? 2 : 1); ++repc_) {
#else
        {
#endif
        const int kkmin = (j == 0) ? 128 : 0;
        const LAS unsigned char* kb = Ks + (32 * w + ql) * KV_PITCH + g * 16;
        const LAS float* Tq = Tb + (ql + 272 - 4 * g - 3);
        const f32x4 zero4 = (f32x4){0.f, 0.f, 0.f, 0.f};
        f32x4 sA[9], sB[9];
#pragma unroll
        for (int i = 0; i < 10; ++i) {
            const bf16x8 kf0 = *(const LAS bf16x8*)(kb + i * (16 * KV_PITCH)), kf1 = *(const LAS bf16x8*)(kb + i * (16 * KV_PITCH) + 64);
            const bool msk = (32 * w + 16 * i) < kkmin;
            if (i <= 8) { f32x4 st = __builtin_amdgcn_mfma_f32_16x16x32_bf16(kf0, fa0, zero4, 0, 0, 0); st = __builtin_amdgcn_mfma_f32_16x16x32_bf16(kf1, fa1, st, 0, 0, 0);
                const LAS float* tp = msk ? Tneg : (Tq - 16 * i); sA[i] = (f32x4){st[0] + tp[3], st[1] + tp[2], st[2] + tp[1], st[3] + tp[0]}; }
            if (i >= 1) { f32x4 st = __builtin_amdgcn_mfma_f32_16x16x32_bf16(kf0, fb0, zero4, 0, 0, 0); st = __builtin_amdgcn_mfma_f32_16x16x32_bf16(kf1, fb1, st, 0, 0, 0);
                const LAS float* tp = msk ? Tneg : (Tq - 16 * (i - 1)); sB[i - 1] = (f32x4){st[0] + tp[3], st[1] + tp[2], st[2] + tp[1], st[3] + tp[0]}; }
        }
        float mA = NEGBIG, mB = NEGBIG;
#pragma unroll
        for (int i = 0; i < 9; ++i) { mA = fmaxf(mA, fmaxf(fmaxf(sA[i][0], sA[i][1]), fmaxf(sA[i][2], sA[i][3]))); mB = fmaxf(mB, fmaxf(fmaxf(sB[i][0], sB[i][1]), fmaxf(sB[i][2], sB[i][3]))); }
        mA = fmaxf(mA, __shfl_xor(mA, 16)); mA = fmaxf(mA, __shfl_xor(mA, 32)); mB = fmaxf(mB, __shfl_xor(mB, 16)); mB = fmaxf(mB, __shfl_xor(mB, 32));
        f32x4 oA[4], oB[4];
#pragma unroll
        for (int dt = 0; dt < 4; ++dt) { oA[dt] = zero4; oB[dt] = zero4; }
        float lA = 0.f, lB = 0.f;
        const LAS unsigned char* vb = Vs + (32 * w + 4 * g + (ql >> 2)) * KV_PITCH + (ql & 3) * 8;
#pragma unroll
        for (int i = 0; i < 10; ++i) {
            const LAS unsigned char* vt = vb + i * (16 * KV_PITCH);
            const s16x4 v0 = lds_tr16(vt), v1 = lds_tr16(vt + 32), v2 = lds_tr16(vt + 64), v3 = lds_tr16(vt + 96);
            if (i <= 8) { const float p0 = __builtin_amdgcn_exp2f(sA[i][0] - mA), p1 = __builtin_amdgcn_exp2f(sA[i][1] - mA), p2 = __builtin_amdgcn_exp2f(sA[i][2] - mA), p3 = __builtin_amdgcn_exp2f(sA[i][3] - mA);
                lA += (p0 + p1) + (p2 + p3); u32x2 pw; pw.x = cvt_pk_bf16(p0, p1); pw.y = cvt_pk_bf16(p2, p3); const s16x4 pf = __builtin_bit_cast(s16x4, pw);
                oA[0] = __builtin_amdgcn_mfma_f32_16x16x16bf16_1k(v0, pf, oA[0], 0, 0, 0); oA[1] = __builtin_amdgcn_mfma_f32_16x16x16bf16_1k(v1, pf, oA[1], 0, 0, 0);
                oA[2] = __builtin_amdgcn_mfma_f32_16x16x16bf16_1k(v2, pf, oA[2], 0, 0, 0); oA[3] = __builtin_amdgcn_mfma_f32_16x16x16bf16_1k(v3, pf, oA[3], 0, 0, 0); }
            if (i >= 1) { const float p0 = __builtin_amdgcn_exp2f(sB[i - 1][0] - mB), p1 = __builtin_amdgcn_exp2f(sB[i - 1][1] - mB), p2 = __builtin_amdgcn_exp2f(sB[i - 1][2] - mB), p3 = __builtin_amdgcn_exp2f(sB[i - 1][3] - mB);
                lB += (p0 + p1) + (p2 + p3); u32x2 pw; pw.x = cvt_pk_bf16(p0, p1); pw.y = cvt_pk_bf16(p2, p3); const s16x4 pf = __builtin_bit_cast(s16x4, pw);
                oB[0] = __builtin_amdgcn_mfma_f32_16x16x16bf16_1k(v0, pf, oB[0], 0, 0, 0); oB[1] = __builtin_amdgcn_mfma_f32_16x16x16bf16_1k(v1, pf, oB[1], 0, 0, 0);
                oB[2] = __builtin_amdgcn_mfma_f32_16x16x16bf16_1k(v2, pf, oB[2], 0, 0, 0); oB[3] = __builtin_amdgcn_mfma_f32_16x16x16bf16_1k(v3, pf, oB[3], 0, 0, 0); }
        }
        lA += __shfl_xor(lA, 16); lA += __shfl_xor(lA, 32); lB += __shfl_xor(lB, 16); lB += __shfl_xor(lB, 32);
#ifdef ATT_EXP1
        lA = 1.0f; lB = 1.0f; mA = 0.f; mB = 0.f;
#pragma unroll
        for (int dt = 0; dt < 4; ++dt) { oA[dt] = zero4; oB[dt] = zero4; }
#endif
#ifdef ATT_EXP2
        lA = 1.0f; lB = 1.0f;
#pragma unroll
        for (int dt = 0; dt < 4; ++dt) { oA[dt] = zero4; oB[dt] = zero4; }
#endif
        const float iA = 1.0f / lA, iB = 1.0f / lB;
        const int posA = r + dil * (256 * j + 32 * w + ql), posB = posA + 16 * dil;
        bf16_t* dA = OP + ((size_t)b * S + posA) * AW + h * HD + 4 * g; bf16_t* dB = OP + ((size_t)b * S + posB) * AW + h * HD + 4 * g;
#pragma unroll
        for (int dt = 0; dt < 4; ++dt) { u32x2 t; t.x = cvt_pk_bf16(oA[dt][0] * iA, oA[dt][1] * iA); t.y = cvt_pk_bf16(oA[dt][2] * iA, oA[dt][3] * iA); *(u32x2*)(dA + 16 * dt) = t;
            u32x2 t2; t2.x = cvt_pk_bf16(oB[dt][0] * iB, oB[dt][1] * iB); t2.y = cvt_pk_bf16(oB[dt][2] * iB, oB[dt][3] * iB); *(u32x2*)(dB + 16 * dt) = t2; }
        if (g == 0) { LSE[((size_t)b * S + posA) * NH + h] = mA + __builtin_amdgcn_logf(lA); LSE[((size_t)b * S + posB) * NH + h] = mB + __builtin_amdgcn_logf(lB); }
        asm volatile("" ::: "memory");
        }
        __syncthreads();
    }
#undef ATT_PREFETCH
}

__device__ __forceinline__ void pool_phase(LAS unsigned char* lds, const bf16_t* __restrict__ U, const bf16_t* __restrict__ PWT, const float* __restrict__ pool_scale, bf16_t* __restrict__ MIX, int G, int c) {
    const int tid = threadIdx.x, lane = tid & 63, w = __builtin_amdgcn_readfirstlane(tid >> 6), ql = lane & 15, g = lane >> 4;
    LAS unsigned char* Us = lds; LAS unsigned char* Pl = lds + 40960;
    for (int pu = c; pu < S / 64; pu += G) {
        const int t0 = pu * 64;
        { u32x4 uv[5];
#pragma unroll
          for (int q = 0; q < 5; ++q) { const int id = tid + 512 * q, row = id >> 5, ch = id & 31, t = t0 - 15 + row; uv[q] = (u32x4){0u, 0u, 0u, 0u};
              if (id < 79 * 32 && t >= 0) uv[q] = *(const u32x4*)(U + (size_t)t * PW + ch * 8); }
#pragma unroll
          for (int q = 0; q < 5; ++q) { const int id = tid + 512 * q, row = id >> 5, ch = id & 31; if (id < 79 * 32) *(LAS u32x4*)(Us + row * 512 + ch * 16) = uv[q]; } }
        __syncthreads();
        { const int cch = tid & 255, th = tid >> 8, gg = cch >> 6, wn = 2 << gg, tl0 = 32 * th;
          const LAS bf16_t* up = (const LAS bf16_t*)Us + cch;
#define UAT(row) __uint_as_float(((unsigned)up[(row) * 256]) << 16)
          float sum = 0.f;
          for (int i = 0; i < wn; ++i) sum += UAT(tl0 + 15 - i);
          const float rcw = 1.0f / (float)wn;
#pragma unroll 8
          for (int tl = tl0; tl < tl0 + 32; ++tl) {
              const float cur = UAT(tl + 15);
              if (tl > tl0) sum += cur - UAT(tl + 15 - wn);
              const int t = t0 + tl; const float rc = (t + 1 < wn) ? __builtin_amdgcn_rcpf((float)(t + 1)) : rcw;
              const float val = sum * rc - cur;
              ((LAS bf16_t*)(Pl + tl * 528))[cch] = (bf16_t)(cvt_pk_bf16(val, 0.f) & 0xffffu);
          }
#undef UAT
        }
        __syncthreads();
        { const int tt = w & 3, gp = w >> 2;
#pragma unroll
          for (int gi = 0; gi < 2; ++gi) { const int gg = 2 * gp + gi;
              const bf16x8 b0 = *(const LAS bf16x8*)(Pl + (16 * tt + ql) * 528 + (gg * 64 + 8 * g) * 2), b1 = *(const LAS bf16x8*)(Pl + (16 * tt + ql) * 528 + (gg * 64 + 32 + 8 * g) * 2);
#pragma unroll
              for (int nt = 0; nt < 4; ++nt) {
                  const bf16_t* ap = PWT + ((size_t)(gg * 64 + 16 * nt + ql) * 64 + 8 * g);
                  const bf16x8 a0 = *(const bf16x8*)(ap), a1 = *(const bf16x8*)(ap + 32);
                  f32x4 acc = __builtin_amdgcn_mfma_f32_16x16x32_bf16(a0, b0, (f32x4){0.f, 0.f, 0.f, 0.f}, 0, 0, 0);
                  acc = __builtin_amdgcn_mfma_f32_16x16x32_bf16(a1, b1, acc, 0, 0, 0);
                  const f32x4 ps = *(const f32x4*)(pool_scale + gg * 64 + 16 * nt + 4 * g);
                  u32x2 o; o.x = cvt_pk_bf16(acc[0] * ps[0], acc[1] * ps[1]); o.y = cvt_pk_bf16(acc[2] * ps[2], acc[3] * ps[3]);
                  *(u32x2*)(MIX + (size_t)(t0 + 16 * tt + ql) * D + gg * 64 + 16 * nt + 4 * g) = o;
              } }
        }
        __syncthreads();
    }
}

__device__ __forceinline__ void combine_phase(const bf16_t* __restrict__ OP, const float* __restrict__ LSE, bf16_t* __restrict__ MIX, int G, int c) {
    const int gt = c * 512 + threadIdx.x, NGT = G * 512;
    for (int id = gt; id < S * 96; id += NGT) {
        const int t = id / 96, rem = id % 96, h = rem >> 3, c8 = rem & 7;
        const float l0 = LSE[(size_t)t * NH + h], l1 = LSE[((size_t)S + t) * NH + h], l2 = LSE[((size_t)2 * S + t) * NH + h];
        const float mx = fmaxf(l0, fmaxf(l1, l2));
        float w0 = __builtin_amdgcn_exp2f(l0 - mx), w1 = __builtin_amdgcn_exp2f(l1 - mx), w2 = __builtin_amdgcn_exp2f(l2 - mx);
        const float inv = 1.0f / (w0 + w1 + w2); w0 *= inv; w1 *= inv; w2 *= inv;
        const size_t off = (size_t)t * AW + h * HD + c8 * 8;
        const u32x4 a = __builtin_nontemporal_load((const u32x4*)(OP + off)), b = __builtin_nontemporal_load((const u32x4*)(OP + (size_t)S * AW + off)), cc = __builtin_nontemporal_load((const u32x4*)(OP + (size_t)2 * S * AW + off));
        u32x4 o;
#pragma unroll
        for (int k = 0; k < 4; ++k) { const float lo = w0 * bf_lo(a[k]) + w1 * bf_lo(b[k]) + w2 * bf_lo(cc[k]), hi = w0 * bf_hi(a[k]) + w1 * bf_hi(b[k]) + w2 * bf_hi(cc[k]); o[k] = cvt_pk_bf16(lo, hi); }
        *(u32x4*)(MIX + (size_t)t * D + PW + h * HD + c8 * 8) = o;
    }
}

constexpr int GW_PITCH = 1032;
constexpr int RT_GWL = 32 * GW_PITCH * 2, RT_G2 = 2 * RT_GWL, RT_LG = RT_G2 + 4096, RT_RS = RT_LG + 4 * 16 * 33 * 4, RT_CNT = RT_RS + 256, RT_PART = RT_CNT + 256, RT_END = RT_PART + 4 * 64 * 9 * 4;
static_assert(RT_END <= LDS_CTL, "router LDS map");
__device__ __forceinline__ void router_phase(LAS unsigned char* lds, const bf16_t* __restrict__ X1, const float* __restrict__ g2, const bf16_t* __restrict__ GWT, const float* __restrict__ rb,
                                             unsigned char* __restrict__ H, float* __restrict__ RSTD, float* __restrict__ GATES, int* __restrict__ ROWS, unsigned* __restrict__ COUNTS, int G, int c) {
    const int tid = threadIdx.x, lane = tid & 63, w = __builtin_amdgcn_readfirstlane(tid >> 6), ql = lane & 15, g = lane >> 4;
    const int ts = w & 3, kh = w >> 2;
    LAS bf16_t* GWH = (LAS bf16_t*)lds;
    LAS bf16_t* GWL = (LAS bf16_t*)(lds + RT_GWL);
    LAS float* G2 = (LAS float*)(lds + RT_G2);
    LAS float* LG = (LAS float*)(lds + RT_LG) + ts * (16 * 33);
    LAS float* RS = (LAS float*)(lds + RT_RS) + ts * 16;
    LAS int* LCNT = (LAS int*)(lds + RT_CNT);
    LAS int* LBASE = LCNT + 32;
    LAS float* PART = (LAS float*)(lds + RT_PART) + ts * (64 * 9);
    const int nrounds = (S / 16 + 4 * G - 1) / (4 * G);
    for (int rd = 0; rd < nrounds; ++rd) {
        const int tile = (rd * 4 + ts) * G + c;
        const bool active = tile < S / 16;
        const int tok = (active ? tile : 0) * 16 + ql;
        const bf16_t* xr = X1 + (size_t)tok * D + kh * 512 + 8 * g;
        u32x4 xv[16];
        if (active) {
#pragma unroll
            for (int i = 0; i < 16; ++i) xv[i] = __builtin_nontemporal_load((const u32x4*)(xr + 32 * i)); }
        if (rd == 0) {
            u32x4 gx[16];
#pragma unroll
            for (int q = 0; q < 16; ++q) { const int id = tid + 512 * q; gx[q] = *(const u32x4*)(GWT + (size_t)id * 8); }
#pragma unroll
            for (int q = 0; q < 16; ++q) { const int id = tid + 512 * q, hl = id >> 12, e = (id >> 7) & 31, pc = id & 127; *(LAS u32x4*)(lds + hl * RT_GWL + (e * GW_PITCH + pc * 8) * 2) = gx[q]; }
            if (tid < 256) *(LAS f32x4*)(G2 + tid * 4) = *(const f32x4*)(g2 + tid * 4);
        }
        if (tid < 32) LCNT[tid] = 0;
        __syncthreads();
        int ek[4] = {0, 0, 0, 0}, lp[4] = {0, 0, 0, 0}; float gk[4] = {0.f, 0.f, 0.f, 0.f};
        f32x4 acc0 = (f32x4){0.f, 0.f, 0.f, 0.f}, acc1 = acc0; float ss = 0.f;
        if (active) {
            unsigned char* hr = H + (size_t)tok * D + kh * 512 + 8 * g;
            const int wo = ql * GW_PITCH + kh * 512 + 8 * g;
            const LAS float* gp = G2 + kh * 512 + 8 * g;
            f32x4 a0l = acc0, a1l = acc0;
#pragma unroll
            for (int i = 0; i < 16; ++i) {
                const int k0 = 32 * i; const u32x4 xw = xv[i]; const bf16x8 xa = __builtin_bit_cast(bf16x8, xw);
                const f32x4 n0 = *(const LAS f32x4*)(gp + k0), n1 = *(const LAS f32x4*)(gp + k0 + 4);
                const bf16x8 bh0 = *(const LAS bf16x8*)(GWH + wo + k0), bh1 = *(const LAS bf16x8*)(GWH + wo + 16 * GW_PITCH + k0);
                const bf16x8 bl0 = *(const LAS bf16x8*)(GWL + wo + k0), bl1 = *(const LAS bf16x8*)(GWL + wo + 16 * GW_PITCH + k0);
                const float f0 = bf_lo(xw.x), f1 = bf_hi(xw.x), f2 = bf_lo(xw.y), f3 = bf_hi(xw.y), f4 = bf_lo(xw.z), f5 = bf_hi(xw.z), f6 = bf_lo(xw.w), f7 = bf_hi(xw.w);
                ss += (f0 * f0 + f1 * f1) + (f2 * f2 + f3 * f3) + (f4 * f4 + f5 * f5) + (f6 * f6 + f7 * f7);
                u32x2 hv; hv.x = cvt4_fp8(f0 * n0[0] * HSCALE, f1 * n0[1] * HSCALE, f2 * n0[2] * HSCALE, f3 * n0[3] * HSCALE);
                hv.y = cvt4_fp8(f4 * n1[0] * HSCALE, f5 * n1[1] * HSCALE, f6 * n1[2] * HSCALE, f7 * n1[3] * HSCALE);
                *(u32x2*)(hr + k0) = hv;
                acc0 = __builtin_amdgcn_mfma_f32_16x16x32_bf16(xa, bh0, acc0, 0, 0, 0); acc1 = __builtin_amdgcn_mfma_f32_16x16x32_bf16(xa, bh1, acc1, 0, 0, 0);
                a0l = __builtin_amdgcn_mfma_f32_16x16x32_bf16(xa, bl0, a0l, 0, 0, 0); a1l = __builtin_amdgcn_mfma_f32_16x16x32_bf16(xa, bl1, a1l, 0, 0, 0);
            }
            acc0 += a0l; acc1 += a1l;
            if (kh == 1) { LAS float* pp = PART + lane * 9;
#pragma unroll
                for (int i = 0; i < 4; ++i) { pp[i] = acc0[i]; pp[4 + i] = acc1[i]; } pp[8] = ss; }
        }
        __syncthreads();
        if (active && kh == 0) {
            { const LAS float* pp = PART + lane * 9;
#pragma unroll
              for (int i = 0; i < 4; ++i) { acc0[i] += pp[i]; acc1[i] += pp[4 + i]; } ss += pp[8]; }
            ss += __shfl_xor(ss, 16); ss += __shfl_xor(ss, 32);
            const float rstd = rsqrtf(ss * (1.0f / D) + RMS_EPS);
            if (g == 0) { RSTD[tok] = rstd; RS[ql] = rstd; }
            LDS_WAIT();
            const float rb0 = rb[ql], rb1 = rb[16 + ql];
#pragma unroll
            for (int rg = 0; rg < 4; ++rg) { const float rr = RS[4 * g + rg]; LG[(4 * g + rg) * 33 + ql] = acc0[rg] * rr + rb0; LG[(4 * g + rg) * 33 + 16 + ql] = acc1[rg] * rr + rb1; }
            LDS_WAIT();
            if (lane < 16) {
                float v[32];
#pragma unroll
                for (int e = 0; e < 32; ++e) v[e] = LG[ql * 33 + e];
                float tv[4];
#pragma unroll
                for (int r = 0; r < 4; ++r) { float best = v[0]; int bi = 0;
#pragma unroll
                    for (int e = 1; e < 32; ++e) { const bool gt = v[e] > best; best = gt ? v[e] : best; bi = gt ? e : bi; }
                    tv[r] = best; ek[r] = bi;
#pragma unroll
                    for (int e = 0; e < 32; ++e) v[e] = (e == bi) ? -INFINITY : v[e]; }
                const float e1 = __expf(tv[1] - tv[0]), e2 = __expf(tv[2] - tv[0]), e3 = __expf(tv[3] - tv[0]); const float inv = 1.0f / (1.0f + e1 + e2 + e3);
                gk[0] = inv; gk[1] = e1 * inv; gk[2] = e2 * inv; gk[3] = e3 * inv;
#pragma unroll
                for (int r = 0; r < 4; ++r) lp[r] = __hip_atomic_fetch_add(LCNT + ek[r], 1, __ATOMIC_RELAXED, __HIP_MEMORY_SCOPE_WORKGROUP);
            }
        }
        __syncthreads();
        if (tid < 32) { const int n = LCNT[tid]; int base = 0; if (n > 0) base = (int)__hip_atomic_fetch_add(COUNTS + tid, (unsigned)n, __ATOMIC_RELAXED, __HIP_MEMORY_SCOPE_AGENT); LBASE[tid] = base; }
        __syncthreads();
        if (active && kh == 0 && lane < 16) {
#pragma unroll
            for (int r = 0; r < 4; ++r) { const int pos = LBASE[ek[r]] + lp[r]; ROWS[(size_t)ek[r] * S + pos] = tok * 4 + r; GATES[tok * 4 + r] = gk[r]; }
#ifdef RT_HASH
            RSTD[S + tok] = gk[0] * (ek[0] + 1) + gk[1] * (ek[1] + 1) + gk[2] * (ek[2] + 1) + gk[3] * (ek[3] + 1);
#endif
        }
        __syncthreads();
    }
}

__device__ __forceinline__ void moe_prefix(LAS int* tpre, LAS int* lcnt, const unsigned* __restrict__ COUNTS) {
    if (threadIdx.x < 32) lcnt[threadIdx.x] = (int)COUNTS[threadIdx.x];
    __syncthreads();
    if (threadIdx.x == 0) { int acc = 0; for (int e = 0; e < NE; ++e) { tpre[e] = acc; acc += (lcnt[e] + 255) >> 8; } tpre[NE] = acc; }
    __syncthreads();
}
template <bool GU, class Prob> __device__ __forceinline__ void moe_table(const Prob& P, LAS int* udesc, LAS int* tab, LAS float* tabf, LAS float* tabb, const LAS int* lcnt, const int* __restrict__ ROWS,
                                                                         const float* __restrict__ rowf, const float* __restrict__ bias) {
    if (threadIdx.x < MAXU) { Unit u0; u0.e = 0; u0.pm = 0; u0.pn = 0; u0.slot = 0; const bool ok = P.search((int)threadIdx.x, u0);
        udesc[4 * threadIdx.x] = u0.e; udesc[4 * threadIdx.x + 1] = u0.pm; udesc[4 * threadIdx.x + 2] = u0.pn; udesc[4 * threadIdx.x + 3] = ok ? 1 : 0; }
    __syncthreads();
    constexpr int NQ = (MAXU * 256 + 511) / 512;
    int idx[NQ]; float fv[NQ], bvv[NQ];
#pragma unroll
    for (int q = 0; q < NQ; ++q) { const int j = (int)threadIdx.x + 512 * q, i = j >> 8, r = j & 255; idx[q] = -2;
        if (i < MAXU && udesc[4 * i + 3]) { const int e = udesc[4 * i], rr = udesc[4 * i + 1] * 256 + r; idx[q] = (rr < lcnt[e]) ? ROWS[(size_t)e * S + rr] : -1; } }
#pragma unroll
    for (int q = 0; q < NQ; ++q) { const int j = (int)threadIdx.x + 512 * q, i = j >> 8, c2 = j & 255; fv[q] = 0.f; bvv[q] = 0.f;
        if (idx[q] != -2) { const int e = udesc[4 * i], pn = udesc[4 * i + 2];
            fv[q] = GU ? rowf[idx[q] < 0 ? 0 : (idx[q] >> 2)] * (1.0f / (HSCALE * WSCALE)) : (idx[q] < 0 ? 0.f : rowf[idx[q]]);
            bvv[q] = GU ? bias[(size_t)e * 2 * DFF + (c2 >> 7) * DFF + pn * 128 + (c2 & 127)] : bias[(size_t)e * D + pn * 256 + c2]; } }
#pragma unroll
    for (int q = 0; q < NQ; ++q) { const int j = (int)threadIdx.x + 512 * q; if (idx[q] != -2) { tab[j] = idx[q]; tabf[j] = fv[q]; tabb[j] = bvv[q]; } }
    __syncthreads();
}

__device__ __forceinline__ void final_phase(const bf16_t* __restrict__ X1, const unsigned char* __restrict__ Y, const float* __restrict__ fg, float* __restrict__ out, int G, int c) {
    const int tid = threadIdx.x, lane = tid & 63, wave = tid >> 6; const int gw = c * 8 + wave, NGW = G * 8;
    f32x4 gv[4];
#pragma unroll
    for (int j = 0; j < 4; ++j) gv[j] = *(const f32x4*)(fg + 4 * lane + 256 * j);
    for (int m = gw; m < S; m += NGW) {
        const bf16_t* xr = X1 + (size_t)m * D + 4 * lane;
        f32x4 v[4];
#pragma unroll
        for (int j = 0; j < 4; ++j) { const u32x2 t = __builtin_nontemporal_load((const u32x2*)(xr + 256 * j)); v[j][0] = bf_lo(t.x); v[j][1] = bf_hi(t.x); v[j][2] = bf_lo(t.y); v[j][3] = bf_hi(t.y); }

#ifdef RT_HASH
        { const float extra = ((const float*)Y)[m];
#pragma unroll
          for (int j = 0; j < 4; ++j) { v[j][0] += __sinf(extra * (float)(4 * lane + 256 * j + 1)); v[j][1] += __sinf(extra * (float)(4 * lane + 256 * j + 2)); v[j][2] += __sinf(extra * (float)(4 * lane + 256 * j + 3)); v[j][3] += __sinf(extra * (float)(4 * lane + 256 * j + 4)); } }
#endif
#ifdef FIN_HASH
#pragma unroll
        for (int j = 0; j < 4; ++j) { v[j][0] = __sinf(v[j][0] * 1.0e6f); v[j][1] = __sinf(v[j][1] * 1.0e6f); v[j][2] = __sinf(v[j][2] * 1.0e6f); v[j][3] = __sinf(v[j][3] * 1.0e6f); }
#endif
#pragma unroll
#if defined(FIN_HASH) || defined(RT_HASH)
        for (int k = 0; k < 0; ++k) { const unsigned char* yr = Y + ((size_t)m * 4 + k) * D + 4 * lane;
#else
        for (int k = 0; k < 4; ++k) { const unsigned char* yr = Y + ((size_t)m * 4 + k) * D + 4 * lane;
#endif
#pragma unroll
            for (int j = 0; j < 4; ++j) { const int t = __builtin_nontemporal_load((const int*)(yr + 256 * j)); const f32x2 lo = __builtin_amdgcn_cvt_pk_f32_fp8(t, false), hi = __builtin_amdgcn_cvt_pk_f32_fp8(t, true);
                v[j][0] += lo[0] * (1.0f / YSCALE); v[j][1] += lo[1] * (1.0f / YSCALE); v[j][2] += hi[0] * (1.0f / YSCALE); v[j][3] += hi[1] * (1.0f / YSCALE); } }
#ifdef FIN_HASH2
#pragma unroll
        for (int j = 0; j < 4; ++j) { v[j][0] = __sinf(v[j][0] * 3.0e3f); v[j][1] = __sinf(v[j][1] * 3.0e3f); v[j][2] = __sinf(v[j][2] * 3.0e3f); v[j][3] = __sinf(v[j][3] * 3.0e3f); }
#endif
        float s = 0.f;
#pragma unroll
        for (int j = 0; j < 4; ++j) s += (v[j][0] * v[j][0] + v[j][1] * v[j][1]) + (v[j][2] * v[j][2] + v[j][3] * v[j][3]);
        const float rstd = rsqrtf(wave_sum(s) * (1.0f / D) + RMS_EPS);
#pragma unroll
        for (int j = 0; j < 4; ++j) __builtin_nontemporal_store(v[j] * rstd * gv[j], (f32x4*)(out + (size_t)m * D + 4 * lane + 256 * j));
    }
}

constexpr int NPHASE = 9;
struct Args { In in; float* out; unsigned char* ws; int ph_lo, ph_hi, probe; };
__global__ void __launch_bounds__(512, 2) fwd(Args args) {
    extern __shared__ __attribute__((aligned(16))) unsigned char lds_raw[];
    LAS unsigned char* lds = (LAS unsigned char*)lds_raw;
    const int tid = threadIdx.x, G = gridDim.x, c = blockIdx.x;
    unsigned char* ws = args.ws; const In& in = args.in;
    unsigned* ctl = (unsigned*)(ws + WS_CTL);
    LAS int* LCTL = (LAS int*)(lds + LDS_CTL);
    if (tid < 256) LCTL[tid] = 0;
    __syncthreads();
    const int lo = args.ph_lo, hi = args.ph_hi;
    const bool one_launch = (hi - lo) > 1;
    XcdBarrier bar; bar.bar = ctl + CW_BAR; bar.x = 0; bar.st = nullptr;
    if (one_launch) bar = xcd_barrier_post(ctl + CW_BAR, (volatile LAS unsigned*)LCTL);
#define IN(k) (lo <= (k) && (k) < hi)
#ifndef MK_DOUBLE
#define MK_DOUBLE 0
#endif
#define REP(k) for (int rep_ = 0; rep_ < ((((MK_DOUBLE) >> (k)) & 1) ? 2 : 1); ++rep_)
#define SEAM(k) do { if (IN((k) + 1)) xcd_barrier(bar); } while (0)
    bf16_t* Hb = (bf16_t*)(ws + WS_H); bf16_t* Ub = (bf16_t*)(ws + WS_U); bf16_t* Qb = (bf16_t*)(ws + WS_Q); bf16_t* Kb = (bf16_t*)(ws + WS_K); bf16_t* Vb = (bf16_t*)(ws + WS_V);
    bf16_t* OPb = (bf16_t*)(ws + WS_OP); bf16_t* MIXb = (bf16_t*)(ws + WS_MIX); bf16_t* X1 = (bf16_t*)(ws + WS_X1); unsigned char* ACTb = ws + WS_ACT; unsigned char* Yb = ws + WS_Y; unsigned char* H8 = ws + WS_H8;
    float* LSE = (float*)(ws + WS_LSE); float* RSTD = (float*)(ws + WS_RSTD); float* GATES = (float*)(ws + WS_GATES); int* ROWS = (int*)(ws + WS_ROWS); unsigned* COUNTS = ctl + CW_COUNTS;
    LAS int* TPRE = LCTL + 16; LAS int* LCNT = LCTL + 128; LAS int* UDESC = LCTL + 192; LAS int* TAB = (LAS int*)(lds + LDS_TAB); LAS float* TABF = (LAS float*)(lds + LDS_TAB + MAXU * 1024); LAS float* TABB = (LAS float*)(lds + LDS_TAB + 2 * MAXU * 1024);
    static_assert(LDS_TAB + 3 * MAXU * 1024 <= LDS_CTL, "MoE LDS tables");

    if (args.probe & 6) {
        const int lane = tid & 63, wave = tid >> 6, gw = c * 8 + wave, NGW = G * 8;
        f32x4 accp = (f32x4){0.f, 0.f, 0.f, 0.f};
        if (args.probe & 2) {
            for (int it = gw; it < N8_ALL; it += NGW) {
                const float* src; int N;
                if (it < NE * 128) { const int e = it / 128, q = it % 128, kb = q / 16, nb = q % 16; src = in.w_gate_up + (size_t)e * D * 2 * DFF + (size_t)(kb * 128) * (2 * DFF) + nb * 128; N = 2 * DFF; }
                else { const int r2 = it - NE * 128, e = r2 / 64, q = r2 % 64, kb = q / 8, nb = q % 8; src = in.w_down + (size_t)e * DFF * D + (size_t)(kb * 128) * D + nb * 128; N = D; }
#pragma unroll 1
                for (int ch = 0; ch < 4; ch += 2) { f32x4 va[16], vb[16]; Item8 d; d.src = src; d.N = N; d.dst = nullptr; chunk8_load(d, ch, va, lane); chunk8_load(d, ch + 1, vb, lane);
#pragma unroll
                    for (int i = 0; i < 16; ++i) accp += va[i] + vb[i]; } }
        } else {
            const size_t nrun = (size_t)NE * D * 2 * DFF / 1024 + (size_t)NE * DFF * D / 1024;
            for (size_t r0 = (size_t)gw * 8; r0 < nrun; r0 += (size_t)NGW * 8) {
                f32x4 v[32];
#pragma unroll
                for (int rr = 0; rr < 8; ++rr) { const size_t run = r0 + rr; const float* src = (run < (size_t)NE * D * 2 * DFF / 1024) ? in.w_gate_up + run * 1024 : in.w_down + (run - (size_t)NE * D * 2 * DFF / 1024) * 1024;
#pragma unroll
                    for (int j = 0; j < 4; ++j) v[4 * rr + j] = __builtin_nontemporal_load((const f32x4*)(src + 256 * j + 4 * lane)); }
#pragma unroll
                for (int i = 0; i < 32; ++i) accp += v[i]; }
        }
        if (accp[0] + accp[1] + accp[2] + accp[3] == 123.456f) ((float*)(ws + WS_ROWS))[gw] = 1.f;
        return;
    }
    if (IN(0)) { REP(0) p0_prologue(lds, in, ws, G, c); SEAM(0); }
    if (IN(1)) {
#ifndef MK_NG
#define MK_NG 128
#endif
        const int NG = (G >= 256) ? MK_NG : G;
        if (c < NG) { if (!(args.probe & 1)) {
            pg8::DenseProb P{(const char*)Hb, (const char*)(ws + WS_WIN), D * 2, S / 256, NPROJ / 256, NG, c, (size_t)128 * D * 2};
            EpiQKVU E{ws};
            REP(1) pg8::gemm_phase<EpiQKVU, pg8::DenseProb, true, false>(lds, P, E);
        } }
        else p0_side(lds, in, ws, G - NG, c - NG);
        if (NG == G) p0_side(lds, in, ws, G, c);
        convert8_queue(lds, in, ws, ctl + CW_QUEUE, args.probe);
        SEAM(1);
    }
    if (IN(2)) {
        REP(2) attn_phase(lds, Qb, Kb, Vb, (const float*)(ws + WS_BT), OPb, LSE, G, c);
        REP(9) pool_phase(lds, Ub, (const bf16_t*)(ws + WS_PWT), in.pool_scale, MIXb, G, c);
        SEAM(2);
    }
    if (IN(3)) { REP(3) combine_phase(OPb, LSE, MIXb, G, c); SEAM(3); }
    if (IN(4)) {
        pg8::DenseProb P{(const char*)MIXb, (const char*)(ws + WS_WOUT), D * 2, S / 256, D / 256, G, c, (size_t)128 * D * 2};
        EpiResBf16 E{in.x, X1};
        REP(4) pg8::gemm_phase<EpiResBf16, pg8::DenseProb, true, false>(lds, P, E);
        SEAM(4);
    }
    if (IN(5)) { router_phase(lds, X1, in.norm2_g, (const bf16_t*)(ws + WS_GWT), in.router_b, H8, RSTD, GATES, ROWS, COUNTS, G, c); SEAM(5); }
    if (IN(6)) {
        moe_prefix(TPRE, LCNT, COUNTS);
        pg8::MoeProb<true> P{(const char*)H8, (const char*)(ws + WS_WGU), D, 8, G, c, (size_t)DFF * D, (size_t)2 * DFF * D, 128, TPRE, TAB, UDESC};
        moe_table<true>(P, UDESC, TAB, TABF, TABB, LCNT, ROWS, RSTD, in.b_gate_up);
        EpiGateUp E{ACTb, TPRE, TABF, TABB};
        REP(6) pg8::gemm_phase<EpiGateUp, pg8::MoeProb<true>, true, true>(lds, P, E);
        SEAM(6);
    }
    if (IN(7)) {
        moe_prefix(TPRE, LCNT, COUNTS);
        pg8::MoeProb<false> P{(const char*)ACTb, (const char*)(ws + WS_WD), DFF, 4, G, c, (size_t)128 * DFF, (size_t)D * DFF, 256, TPRE, TAB, UDESC};
        moe_table<false>(P, UDESC, TAB, TABF, TABB, LCNT, ROWS, GATES, in.b_down);
        EpiDown E{Yb, TAB, TABF, TABB};
        REP(7) pg8::gemm_phase<EpiDown, pg8::MoeProb<false>, true, true>(lds, P, E);
        SEAM(7);
    }

#ifdef RT_HASH
    if (IN(8)) REP(8) final_phase(X1, (const unsigned char*)(RSTD + S), in.final_g, args.out, G, c);
#else
    if (IN(8)) REP(8) final_phase(X1, Yb, in.final_g, args.out, G, c);
#endif

#undef IN
#undef SEAM
}

#ifndef MK_N_LAUNCHES
#define MK_N_LAUNCHES 1
#endif
#ifndef MK_SEQ
#define MK_SEQ "012345678"
#endif
extern "C" void kernel_launch(void* const* d_in, const int* in_sizes, int n_in, void* d_out, int out_size, void* d_ws, size_t ws_size, hipStream_t stream) {
    static int grid = 0;
    if (grid == 0) {
        if (n_in != 15 || out_size != S * D || ws_size < WS_END) { fprintf(stderr, "kernel_launch: unexpected problem (n_in %d out %d ws %zu)\n", n_in, out_size, ws_size); grid = -1; return; }
        int dev = 0, cus = 0, per_cu = 0;
        if (hipGetDevice(&dev) != hipSuccess || hipDeviceGetAttribute(&cus, hipDeviceAttributeMultiprocessorCount, dev) != hipSuccess) { grid = -1; return; }
        if (hipFuncSetAttribute((const void*)fwd, hipFuncAttributeMaxDynamicSharedMemorySize, LDS_BYTES) != hipSuccess) { fprintf(stderr, "kernel_launch: hipFuncSetAttribute failed\n"); grid = -1; return; }
        if (hipOccupancyMaxActiveBlocksPerMultiprocessor(&per_cu, (const void*)fwd, 512, LDS_BYTES) != hipSuccess || per_cu < 1) { fprintf(stderr, "kernel_launch: occupancy query says %d blocks per CU\n", per_cu); (void)hipGetLastError(); per_cu = 1; }
        grid = cus;
    }
    if (grid < 0) return;
    if (hipMemsetAsync((char*)d_ws + WS_CTL, 0, CTL_ZERO_BYTES, stream) != hipSuccess) { fprintf(stderr, "kernel_launch: memset failed\n"); return; }
    Args a{};
    a.in.x = (const float*)d_in[0]; a.in.norm1_g = (const float*)d_in[1]; a.in.w_in = (const float*)d_in[2]; a.in.pool_w = (const float*)d_in[3]; a.in.pool_scale = (const float*)d_in[4];
    a.in.rel_bias = (const float*)d_in[5]; a.in.w_out = (const float*)d_in[6]; a.in.norm2_g = (const float*)d_in[7]; a.in.router_w = (const float*)d_in[8]; a.in.router_b = (const float*)d_in[9];
    a.in.w_gate_up = (const float*)d_in[10]; a.in.b_gate_up = (const float*)d_in[11]; a.in.w_down = (const float*)d_in[12]; a.in.b_down = (const float*)d_in[13]; a.in.final_g = (const float*)d_in[14];
    a.out = (float*)d_out; a.ws = (unsigned char*)d_ws;
    if (MK_N_LAUNCHES == 1) { a.ph_lo = 0; a.ph_hi = NPHASE; hipLaunchKernelGGL(fwd, dim3(grid), dim3(512), LDS_BYTES, stream, a); }
    else { const char* seq = MK_SEQ; for (int i = 0; seq[i]; ++i) { int p = seq[i] - '0'; a.probe = 0; if (seq[i] == 'r' || seq[i] == 'c' || seq[i] == 'd' || seq[i] == 'e') (void)hipMemsetAsync((char*)d_ws + WS_CTL + CW_QUEUE * 4, 0, 16 * 256, stream); if (seq[i] == 'r') continue; if (seq[i] == 'c') { p = 1; a.probe = 1; } if (seq[i] == 'd') { p = 1; a.probe = 1 | 8; } if (seq[i] == 'e') { p = 1; a.probe = 1 | 16; } if (seq[i] == 'x') { p = 1; a.probe = 2; } if (seq[i] == 'y') { p = 1; a.probe = 4; } a.ph_lo = p; a.ph_hi = p + 1; if (p == 5) (void)hipMemsetAsync((char*)d_ws + WS_CTL + CW_COUNTS * 4, 0, 128, stream); hipLaunchKernelGGL(fwd, dim3(grid), dim3(512), LDS_BYTES, stream, a); } }
    const hipError_t le = hipPeekAtLastError();
    if (le != hipSuccess) fprintf(stderr, "kernel_launch: launch failed: %s\n", hipGetErrorName(le));
}
```

```cpp
#include <hip/hip_runtime.h>
#include <cstdio>
#include <cstdint>

#define LAS __attribute__((address_space(3)))
#define GAS __attribute__((address_space(1)))
typedef unsigned short bf16_t;
typedef short bf16x8 __attribute__((ext_vector_type(8)));
typedef short s16x4 __attribute__((ext_vector_type(4)));
typedef float f32x4 __attribute__((ext_vector_type(4)));
typedef float f32x2 __attribute__((ext_vector_type(2)));
typedef unsigned u32x4 __attribute__((ext_vector_type(4)));
typedef unsigned u32x2 __attribute__((ext_vector_type(2)));
typedef int i32x4 __attribute__((ext_vector_type(4)));
typedef int i32x8 __attribute__((ext_vector_type(8)));

constexpr int S = 16384, D = 1024, NPROJ = 2560, PW = 256, AW = 768, NH = 12, HD = 64, NE = 32, TOPK = 4, DFF = 1024;
constexpr float RMS_EPS = 1e-5f, LOG2E = 1.4426950408889634f, QSCALE = 0.125f * LOG2E, NEGBIG = -1e30f;
constexpr float WSCALE = 64.0f, HSCALE = 16.0f, ASCALE = 8.0f, YSCALE = 64.0f, FP8MAX = 448.0f;
constexpr int BT_N = 400, BT_OFF = 144;

constexpr size_t MiB = 1u << 20;
constexpr size_t WS_CTL = 0, CTL_ZERO_BYTES = 32 * 1024;
constexpr size_t WS_WIN = 2 * MiB;
constexpr size_t WS_WOUT = 8 * MiB;
constexpr size_t WS_GWT = 10 * MiB;
constexpr size_t WS_BT = 10 * MiB + 512 * 1024;
constexpr size_t WS_PWT = 10 * MiB + 768 * 1024;
constexpr size_t WS_RSTD = 11 * MiB;
constexpr size_t WS_GATES = 11 * MiB + 256 * 1024;
constexpr size_t WS_ROWS = 12 * MiB;
constexpr size_t WS_LSE = 14 * MiB;
constexpr size_t WS_WGU = 32 * MiB;
constexpr size_t WS_WD = 160 * MiB;
constexpr size_t WS_H8 = 200 * MiB;
constexpr size_t WS_H = 224 * MiB;
constexpr size_t WS_U = 256 * MiB;
constexpr size_t WS_Q = 264 * MiB, WS_K = 288 * MiB, WS_V = 312 * MiB;
constexpr size_t WS_OP = 336 * MiB;
constexpr size_t WS_MIX = 408 * MiB;
constexpr size_t WS_X1 = 440 * MiB;
constexpr size_t WS_ACT = 512 * MiB;
constexpr size_t WS_Y = 656 * MiB;
constexpr size_t WS_END = 784 * MiB;
constexpr int ACT_ROWS = 65536 + 32 * 256;
constexpr int CW_COUNTS = 64;
constexpr int CW_QUEUE = 256;
constexpr int CW_BAR = 4096;

constexpr int LDS_BYTES = 163840;
constexpr int LDS_TAB = 131072;
constexpr int LDS_CTL = LDS_BYTES - 1024;
constexpr int MAXU = 9;

typedef __bf16 bf16x2_t __attribute__((ext_vector_type(2)));
__device__ __forceinline__ unsigned cvt_pk_bf16(float lo, float hi) { const f32x2 v = {lo, hi}; const bf16x2_t b = __builtin_convertvector(v, bf16x2_t); return __builtin_bit_cast(unsigned, b); }
__device__ __forceinline__ float clamp8(float v) { return __builtin_amdgcn_fmed3f(v, -FP8MAX, FP8MAX); }
__device__ __forceinline__ unsigned cvt4_fp8(float a, float b, float c, float d) {
    int p = __builtin_amdgcn_cvt_pk_fp8_f32(clamp8(a), clamp8(b), 0, false); p = __builtin_amdgcn_cvt_pk_fp8_f32(clamp8(c), clamp8(d), p, true); return (unsigned)p; }
__device__ __forceinline__ float bf_lo(unsigned w) { return __uint_as_float(w << 16); }
__device__ __forceinline__ float bf_hi(unsigned w) { return __uint_as_float(w & 0xffff0000u); }
__device__ __forceinline__ float wave_sum(float v) {
#pragma unroll
    for (int o = 1; o < 64; o <<= 1) v += __shfl_xor(v, o);
    return v;
}
#ifndef WT_AUX
#define WT_AUX 0
#endif
__device__ __forceinline__ __amdgpu_buffer_rsrc_t wt_rsrc(const void* base) { return __builtin_amdgcn_make_buffer_rsrc((void*)base, (short)0, 0x7fffffff, 0x00020000); }
__device__ __forceinline__ void wt_store128(__amdgpu_buffer_rsrc_t r, unsigned off, u32x4 v) { __builtin_amdgcn_raw_buffer_store_b128(v, r, (int)off, 0, WT_AUX); }
__device__ __forceinline__ void wt_store64(__amdgpu_buffer_rsrc_t r, unsigned off, u32x2 v) { __builtin_amdgcn_raw_buffer_store_b64(v, r, (int)off, 0, WT_AUX); }
#define LDS_WAIT() asm volatile("s_waitcnt lgkmcnt(0)" ::: "memory")
#define VM_WAIT() asm volatile("s_waitcnt vmcnt(0)" ::: "memory")

#define XB_TMO      128
#define XB_XCNT(j)  (256  + 64 * (j))
#define XB_XSUB(j)  (1280 + 64 * (j))
#define XB_XGEN(j)  (2304 + 64 * (j))
#define XB_TOP      3328
#define XB_TOPGEN   3392
#define XCD_BAR_WORDS 3456
#define XB_SPIN_CAP (1u << 18)
__device__ __forceinline__ unsigned xb_ld(unsigned* p)              { return __hip_atomic_load(p, __ATOMIC_RELAXED, __HIP_MEMORY_SCOPE_AGENT); }
__device__ __forceinline__ unsigned xb_add(unsigned* p, unsigned v) { return __hip_atomic_fetch_add(p, v, __ATOMIC_RELAXED, __HIP_MEMORY_SCOPE_AGENT); }
__device__ __forceinline__ unsigned xb_xcc_id() { return (unsigned)__builtin_amdgcn_s_getreg((3 << 11) | 20) & 0xFu; }
#define XB_SPIN(cond, bar) do { unsigned _sp = 0; while (cond) { __builtin_amdgcn_s_sleep(1); \
    if ((++_sp & 255u) == 0u) { if (xb_ld(&(bar)[XB_TMO])) break; if (_sp > XB_SPIN_CAP) { atomicAdd(&(bar)[XB_TMO], 1u); break; } } } } while (0)
struct XcdBarrier { unsigned* bar; unsigned x; volatile LAS unsigned* st; };
__device__ __forceinline__ XcdBarrier xcd_barrier_post(unsigned* bar, volatile LAS unsigned* st) {
    XcdBarrier b; b.bar = bar; b.x = xb_xcc_id(); b.st = st;
    if (threadIdx.x == 0) (void)xb_add(&bar[XB_XCNT(b.x)], 1u);
    return b;
}
__device__ __forceinline__ void xcd_barrier_complete(unsigned* bar, unsigned x, unsigned& nloc, unsigned& nx) {
    const unsigned G = gridDim.x * gridDim.y * gridDim.z;
    unsigned sum, cnt, mine, sp = 0u;
    for (;;) {
        sum = 0u; cnt = 0u; mine = 0u;
#pragma unroll
        for (unsigned j = 0; j < 16; ++j) { const unsigned c = xb_ld(&bar[XB_XCNT(j)]); sum += c; cnt += (c > 0u) ? 1u : 0u; mine = (j == x) ? c : mine; }
        if (sum == G) break;
        __builtin_amdgcn_s_sleep(1);
        if ((++sp & 255u) == 0u) { if (xb_ld(&bar[XB_TMO])) break; if (sp > XB_SPIN_CAP) { atomicAdd(&bar[XB_TMO], 1u); break; } }
    }
    nloc = mine > 0u ? mine : 1u; nx = cnt > 0u ? cnt : 1u;
}
__device__ __forceinline__ void xcd_barrier(const XcdBarrier& b) {
    asm volatile("s_waitcnt vmcnt(0)" ::: "memory");
    __syncthreads();
    if (threadIdx.x == 0) {
        unsigned* bar = b.bar;
        __builtin_amdgcn_s_waitcnt(0);
        unsigned nloc = b.st[0], nx = b.st[1];
        if (nloc == 0u) { xcd_barrier_complete(bar, b.x, nloc, nx); b.st[0] = nloc; b.st[1] = nx; }
        const unsigned old = xb_add(&bar[XB_XSUB(b.x)], 1u);
        const unsigned gen = old / nloc;
        if (old + 1u == (gen + 1u) * nloc) {
            __builtin_amdgcn_fence(__ATOMIC_RELEASE, "agent");
            asm volatile("s_waitcnt vmcnt(0)" ::: "memory");
            const unsigned og = xb_add(&bar[XB_TOP], 1u);
            const unsigned tg = og / nx;
            if (og + 1u == (tg + 1u) * nx) xb_add(&bar[XB_TOPGEN], 1u);
            else XB_SPIN(xb_ld(&bar[XB_TOPGEN]) == tg, bar);
            __builtin_amdgcn_fence(__ATOMIC_ACQUIRE, "agent");
            xb_add(&bar[XB_XGEN(b.x)], 1u);
            asm volatile("s_waitcnt vmcnt(0)" ::: "memory");
        } else {
            XB_SPIN(xb_ld(&bar[XB_XGEN(b.x)]) == gen, bar);
            __builtin_amdgcn_fence(__ATOMIC_ACQUIRE, "agent");
            asm volatile("s_waitcnt vmcnt(0)" ::: "memory");
        }
    }
    __syncthreads();
}

namespace pg8 {
constexpr int BM = 256, BK = 64, HALF = 128, HTB = HALF * BK * 2, STAGE_BYTES = 8 * HTB, NXCD = 8, WGM = 8;
__host__ __device__ __forceinline__ int lds_byte(int r, int c) { const int st = (r >> 4) * 2 + (c >> 5), rr = r & 15, cc = c & 31, ob = rr * 64 + cc * 2; return st * 1024 + (ob ^ (((ob >> 9) & 1) << 5)); }
__host__ __device__ __forceinline__ void stage_rc(int b, int& R, int& C) { const int st = b / 1024, sb = b % 1024, swz = sb ^ (((sb >> 9) & 1) << 5); R = (st >> 1) * 16 + swz / 64; C = (st & 1) * 32 + (swz % 64) / 2; }
__host__ __device__ __forceinline__ int perm32(int rho) { const int n = rho >> 4, i = rho & 15; return 8 * (i >> 2) + 4 * n + (i & 3); }

struct Unit { int pm, pn, e, slot; };

template <class Epi, class Prob, bool ALIGN_EPI, bool FP8>
__device__ __forceinline__ void gemm_phase(LAS unsigned char* lds, const Prob& P, const Epi& E) {
    int tid_ = threadIdx.x; asm volatile("" : "+v"(tid_));
    const int tid = tid_, wid = __builtin_amdgcn_readfirstlane(tid >> 6), lane = tid & 63, wr = wid >> 2, wc = wid & 3, fr = lane & 15, fq = lane >> 4;
    const int rowb = P.rowb, nt = rowb / 128;
    int R0, C0; stage_rc(tid * 16, R0, C0);
    const int CB = C0 * 2, Rb = Epi::PERM ? ((R0 & ~31) + perm32(R0 & 31)) : R0;
    const unsigned voffB = (unsigned)(Rb * rowb + CB), laneA = (unsigned)(R0 * rowb + CB);
    const unsigned r64 = (unsigned)(64 * rowb);
    const unsigned kstep = (unsigned)(BK * 2);
    const unsigned bhalf = (unsigned)P.b_half;
    const unsigned ldsw = (unsigned)wid * 1024u;
    const int aoff = lds_byte(wr * 64 + fr, fq * 8), boff = lds_byte(wc * 32 + fr, fq * 8);
#define PG8_SA(b, h) (((b) * 2 + (h)) * HTB)
#define PG8_SB(b, h) ((4 + (b) * 2 + (h)) * HTB)
    const __amdgpu_buffer_rsrc_t srdA = __builtin_amdgcn_make_buffer_rsrc((void*)P.A, (short)0, 0x7fffffff, 0x00020000);
    const __amdgpu_buffer_rsrc_t srdB = __builtin_amdgcn_make_buffer_rsrc((void*)P.Bt, (short)0, 0x7fffffff, 0x00020000);
#define PG8_STAGE_B(bufoff, so) do { \
        __builtin_amdgcn_raw_ptr_buffer_load_lds(srdB, (LAS void*)(lds + (bufoff) + ldsw), 16, (int)voffB, (int)(so), 0, 0); \
        __builtin_amdgcn_raw_ptr_buffer_load_lds(srdB, (LAS void*)(lds + (bufoff) + ldsw + 8192), 16, (int)voffB, (int)((so) + r64), 0, 0); } while (0)
#define PG8_STAGE_A(bufoff, kb, h) do { \
        if constexpr (Prob::GATHER_A) { \
            __builtin_amdgcn_raw_ptr_buffer_load_lds(srdA, (LAS void*)(lds + (bufoff) + ldsw), 16, (int)((h) ? c10 : c00), (int)(kb), 0, 0); \
            __builtin_amdgcn_raw_ptr_buffer_load_lds(srdA, (LAS void*)(lds + (bufoff) + ldsw + 8192), 16, (int)((h) ? c11 : c01), (int)(kb), 0, 0); } \
        else { \
            __builtin_amdgcn_raw_ptr_buffer_load_lds(srdA, (LAS void*)(lds + (bufoff) + ldsw), 16, (int)laneA, (int)(aB + (kb) + (h) * 2 * r64), 0, 0); \
            __builtin_amdgcn_raw_ptr_buffer_load_lds(srdA, (LAS void*)(lds + (bufoff) + ldsw + 8192), 16, (int)laneA, (int)(aB + (kb) + (h) * 2 * r64 + r64), 0, 0); } } while (0)
#define PG8_LDA(dst, b, h) do { _Pragma("unroll") for (int m = 0; m < 4; ++m) _Pragma("unroll") for (int k = 0; k < 2; ++k) dst[m][k] = *(const LAS bf16x8*)(lds + PG8_SA(b, h) + aoff + m * 2048 + k * 1024); } while (0)
#define PG8_LDB(dst, b, h) do { _Pragma("unroll") for (int n = 0; n < 2; ++n) _Pragma("unroll") for (int k = 0; k < 2; ++k) dst[n][k] = *(const LAS bf16x8*)(lds + PG8_SB(b, h) + boff + n * 2048 + k * 1024); } while (0)
#define PG8_MMA(ai, bj, At, Bt) do { __builtin_amdgcn_s_setprio(1); _Pragma("unroll") for (int m = 0; m < 4; ++m) _Pragma("unroll") for (int n = 0; n < 2; ++n) { \
        if constexpr (FP8) { const i32x8 fb_ = __builtin_shufflevector(__builtin_bit_cast(i32x4, Bt[n][0]), __builtin_bit_cast(i32x4, Bt[n][1]), 0, 1, 2, 3, 4, 5, 6, 7); \
            const i32x8 fa_ = __builtin_shufflevector(__builtin_bit_cast(i32x4, At[m][0]), __builtin_bit_cast(i32x4, At[m][1]), 0, 1, 2, 3, 4, 5, 6, 7); \
            acc[ai][bj][m][n] = __builtin_amdgcn_mfma_scale_f32_16x16x128_f8f6f4(fb_, fa_, acc[ai][bj][m][n], 0, 0, 0, 0, 0, 0); } \
        else { _Pragma("unroll") for (int k = 0; k < 2; ++k) acc[ai][bj][m][n] = __builtin_amdgcn_mfma_f32_16x16x32_bf16(Bt[n][k], At[m][k], acc[ai][bj][m][n], 0, 0, 0); } } \
        __builtin_amdgcn_s_setprio(0); } while (0)
#define PG8_WAIT_V(n) asm volatile("s_waitcnt vmcnt(" #n ")" ::: "memory")
#define PG8_WAIT_L(n) asm volatile("s_waitcnt lgkmcnt(" #n ")" ::: "memory")
#define PG8_BAR __builtin_amdgcn_s_barrier()
#define PG8_SCHED __builtin_amdgcn_sched_barrier(0)
    Unit cur, nxt; int ui = 0;
    if (!P.next(0, cur)) return;
    f32x4 acc[2][2][4][2];
    E.init(acc, cur, wr, wc, fr, fq);
    bf16x8 At[4][2], B0[2][2], B1[2][2];
    unsigned c00 = 0, c01 = 0, c10 = 0, c11 = 0, aB = 0;
    if constexpr (Prob::GATHER_A) { c00 = P.a_off(cur, R0, CB); c01 = P.a_off(cur, R0 + 64, CB); c10 = P.a_off(cur, HALF + R0, CB); c11 = P.a_off(cur, HALF + R0 + 64, CB); }
    else aB = P.a_base(cur);
    unsigned cB = P.b_off(cur);
    PG8_STAGE_B(PG8_SB(0, 0), cB); PG8_STAGE_B(PG8_SB(0, 1), cB + bhalf); PG8_STAGE_A(PG8_SA(0, 0), 0, 0); PG8_STAGE_A(PG8_SA(0, 1), 0, 1);
    if (wr == 1) PG8_BAR;
    PG8_WAIT_V(2); PG8_BAR;
    PG8_STAGE_B(PG8_SB(1, 0), cB + kstep); PG8_STAGE_A(PG8_SA(1, 0), kstep, 0); PG8_STAGE_B(PG8_SB(1, 1), cB + bhalf + kstep);
    PG8_WAIT_V(6); PG8_BAR;
    for (;;) {
        const bool has_next = P.next(ui + 1, nxt);
        const unsigned nB = has_next ? P.b_off(nxt) : cB;
        for (int t = 0; t < nt; t += 2) {
            const bool last = (t == nt - 2);
            const unsigned k1 = (unsigned)(t + 1) * kstep;
            const unsigned k2 = last ? 0u : (unsigned)(t + 2) * kstep, k3 = k2 + kstep;
            const unsigned b2 = last ? nB : cB + (unsigned)(t + 2) * kstep, b3 = b2 + kstep;
            if constexpr (Prob::GATHER_A) { if (last && has_next) { c00 = P.a_off(nxt, R0, CB); c01 = P.a_off(nxt, R0 + 64, CB); } }
            PG8_LDB(B0, 0, 0); PG8_LDB(B1, 0, 1); PG8_SCHED; PG8_LDA(At, 0, 0); PG8_STAGE_A(PG8_SA(1, 1), k1, 1);
            PG8_WAIT_V(8); PG8_WAIT_L(0); PG8_BAR; PG8_MMA(0, 0, At, B0); PG8_MMA(0, 1, At, B1); PG8_BAR; PG8_SCHED;
            if (last && has_next) { if constexpr (Prob::GATHER_A) { c10 = P.a_off(nxt, HALF + R0, CB); c11 = P.a_off(nxt, HALF + R0 + 64, CB); } else aB = P.a_base(nxt); }
            PG8_LDA(At, 0, 1); PG8_STAGE_B(PG8_SB(0, 0), b2); PG8_STAGE_B(PG8_SB(0, 1), b2 + bhalf); PG8_STAGE_A(PG8_SA(0, 0), k2, 0);
            PG8_WAIT_V(8); PG8_WAIT_L(0); PG8_BAR; PG8_MMA(1, 0, At, B0); PG8_MMA(1, 1, At, B1); PG8_BAR; PG8_SCHED;
            PG8_LDB(B0, 1, 0); PG8_LDB(B1, 1, 1); PG8_SCHED; PG8_LDA(At, 1, 0); PG8_STAGE_A(PG8_SA(0, 1), k2, 1);
            PG8_WAIT_V(8); PG8_WAIT_L(0); PG8_BAR; PG8_MMA(0, 0, At, B0); PG8_MMA(0, 1, At, B1); PG8_BAR; PG8_SCHED;
            PG8_LDA(At, 1, 1); PG8_STAGE_B(PG8_SB(1, 0), b3); PG8_STAGE_B(PG8_SB(1, 1), b3 + bhalf); PG8_STAGE_A(PG8_SA(1, 0), k3, 0);
            PG8_WAIT_V(8); PG8_WAIT_L(0); PG8_BAR; PG8_MMA(1, 0, At, B0); PG8_MMA(1, 1, At, B1); PG8_BAR; PG8_SCHED;
        }
        if constexpr (ALIGN_EPI) { if (wr == 0) PG8_BAR; }
        E(acc, cur, wr, wc, fr, fq);
#if defined(MK_DOUBLE)
        if constexpr (FP8) { if ((MK_DOUBLE >> 12) & 1) { asm volatile("" ::: "memory"); E(acc, cur, wr, wc, fr, fq); } }
#endif
        if (!has_next) break;
        cur = nxt; cB = nB; ++ui;
        E.init(acc, cur, wr, wc, fr, fq);
        if constexpr (ALIGN_EPI) { if (wr == 1) PG8_BAR; }
    }
    PG8_WAIT_V(0);
    if constexpr (!ALIGN_EPI) { if (wr == 0) PG8_BAR; }
    PG8_BAR;
#undef PG8_SA
#undef PG8_SB
#undef PG8_STAGE_A
#undef PG8_STAGE_B
#undef PG8_LDA
#undef PG8_LDB
#undef PG8_MMA
#undef PG8_WAIT_V
#undef PG8_WAIT_L
#undef PG8_BAR
#undef PG8_SCHED
}

__device__ __forceinline__ bool static_order(int nM, int nN, int G, int c, int i, int& pm, int& pn) {
    const int nwg = nM * nN; const long L = (long)i * G + c; if (L >= nwg) return false;
    int wgid = (int)L; { const int q = nwg / NXCD, r = nwg % NXCD, xcd = wgid % NXCD, off = wgid / NXCD; wgid = (xcd < r ? xcd * (q + 1) : r * (q + 1) + (xcd - r) * q) + off; }
    const int nig = WGM * nN, gid = wgid / nig, fm = gid * WGM, gsz = (nM - fm) < WGM ? (nM - fm) : WGM;
    pm = fm + ((wgid % nig) % gsz); pn = (wgid % nig) / gsz; return true;
}
struct DenseProb {
    const char* A; const char* Bt; int rowb, nM, nN, G, c; size_t b_half;
    __device__ __forceinline__ bool next(int i, Unit& u) const { u.e = 0; u.slot = i; return static_order(nM, nN, G, c, i, u.pm, u.pn); }
    static constexpr bool GATHER_A = false;
    __device__ __forceinline__ unsigned a_off(const Unit&, int, int) const { return 0u; }
    __device__ __forceinline__ unsigned a_base(const Unit& u) const { return (unsigned)(u.pm * BM * rowb); }
    __device__ __forceinline__ unsigned b_off(const Unit& u) const { return (unsigned)(u.pn * BM * rowb); }
};
template <bool GATHER> struct MoeProb {
    const char* A; const char* Bt; int rowb, nN, G, c; size_t b_half; size_t b_expert; int b_tile_rows;
    const LAS int* tpre; const LAS int* tab; const LAS int* udesc;
    __device__ __forceinline__ int tp(int j) const { return __builtin_amdgcn_readfirstlane(tpre[j]); }
    __device__ __forceinline__ bool search(int i, Unit& u) const {
        const int total = tpre[NE] * nN; const long L0 = (long)i * G + c; if (L0 >= total) return false;
        int L = (int)L0; { const int q = total / NXCD, r = total % NXCD, xcd = L % NXCD, off = L / NXCD; L = (xcd < r ? xcd * (q + 1) : r * (q + 1) + (xcd - r) * q) + off; }
        int e = 0;
        for (int j = 1; j < NE; ++j) e += (tpre[j] * nN <= L) ? 1 : 0;
        const int first = tpre[e] * nN, tiles = tpre[e + 1] - tpre[e], rem = L - first;
        u.e = e; u.pm = rem % tiles; u.pn = rem / tiles; u.slot = i; return true;
    }
    __device__ __forceinline__ bool next(int i, Unit& u) const {
        if (i >= MAXU) return false;
        const int v = __builtin_amdgcn_readfirstlane(udesc[4 * i + 3]); if (!v) return false;
        u.e = __builtin_amdgcn_readfirstlane(udesc[4 * i]); u.pm = __builtin_amdgcn_readfirstlane(udesc[4 * i + 1]); u.pn = __builtin_amdgcn_readfirstlane(udesc[4 * i + 2]); u.slot = i; return true;
    }
    static constexpr bool GATHER_A = GATHER;
    __device__ __forceinline__ unsigned a_off(const Unit& u, int row, int colb) const { const int idx = tab[u.slot * 256 + row]; const int tok = idx < 0 ? 0 : (idx >> 2); return (unsigned)(tok * rowb + colb); }
    __device__ __forceinline__ unsigned a_base(const Unit& u) const { return (unsigned)((tp(u.e) + u.pm) * BM * rowb); }
    __device__ __forceinline__ unsigned b_off(const Unit& u) const { return (unsigned)u.e * (unsigned)b_expert + (unsigned)(u.pn * b_tile_rows * rowb); }
};
}

using pg8::Unit;
typedef f32x4 AccT[2][2][4][2];
__device__ __forceinline__ void acc_zero(AccT& acc) {
#pragma unroll
    for (int a = 0; a < 2; ++a)
#pragma unroll
        for (int b = 0; b < 2; ++b)
#pragma unroll
            for (int m = 0; m < 4; ++m)
#pragma unroll
                for (int n = 0; n < 2; ++n) acc[a][b][m][n] = (f32x4){0.f, 0.f, 0.f, 0.f};
}

struct EpiQKVU {
    static constexpr bool PERM = true;
    unsigned char* ws;
    __device__ __forceinline__ void init(AccT& acc, const Unit&, int, int, int, int) const { acc_zero(acc); }
    __device__ __forceinline__ void operator()(const AccT& acc, const Unit& u, int wr, int wc, int fr, int fq) const {
        static_assert(WS_K - WS_Q == WS_V - WS_K, "Q, K, V equally spaced");
        const int t = (u.pn - 1) / 3;
        const size_t boff = (u.pn == 0) ? WS_U : (WS_Q + (size_t)t * (WS_K - WS_Q));
        const __amdgpu_buffer_rsrc_t rb_ = wt_rsrc(ws + boff);
        const int ldc = (u.pn == 0) ? PW : AW, colt = (u.pn == 0) ? 0 : ((u.pn - 1) % 3) * 256;
        const float sc = (u.pn >= 1 && u.pn <= 3) ? QSCALE : 1.f;
        const int row0 = u.pm * 256 + wr * 64 + fr, col0 = colt + wc * 32 + 8 * fq;
#pragma unroll
        for (int ai = 0; ai < 2; ++ai)
#pragma unroll
            for (int m = 0; m < 4; ++m) { const unsigned rowo = (unsigned)(((row0 + ai * 128 + m * 16) * ldc + col0) * 2);
#pragma unroll
                for (int bj = 0; bj < 2; ++bj) { const f32x4 v0 = acc[ai][bj][m][0] * sc, v1 = acc[ai][bj][m][1] * sc;
                    u32x4 w; w.x = cvt_pk_bf16(v0[0], v0[1]); w.y = cvt_pk_bf16(v0[2], v0[3]); w.z = cvt_pk_bf16(v1[0], v1[1]); w.w = cvt_pk_bf16(v1[2], v1[3]);
                    wt_store128(rb_, rowo + bj * 256, w); } }
    }
};
struct EpiResBf16 {
    static constexpr bool PERM = true;
    const float* X; bf16_t* O;
    __device__ __forceinline__ void init(AccT& acc, const Unit& u, int wr, int wc, int fr, int fq) const {
        const int row0 = u.pm * 256 + wr * 64 + fr, col0 = u.pn * 256 + wc * 32 + 8 * fq;
#pragma unroll
        for (int ai = 0; ai < 2; ++ai)
#pragma unroll
            for (int m = 0; m < 4; ++m) { const unsigned off = (unsigned)((row0 + ai * 128 + m * 16) * D + col0);
#pragma unroll
                for (int bj = 0; bj < 2; ++bj)
#pragma unroll
                    for (int n = 0; n < 2; ++n) acc[ai][bj][m][n] = __builtin_nontemporal_load((const f32x4*)(X + off + bj * 128 + n * 4)); }
    }
    __device__ __forceinline__ void operator()(const AccT& acc, const Unit& u, int wr, int wc, int fr, int fq) const {
        const int row0 = u.pm * 256 + wr * 64 + fr, col0 = u.pn * 256 + wc * 32 + 8 * fq;
        const __amdgpu_buffer_rsrc_t ro_ = wt_rsrc(O);
#pragma unroll
        for (int ai = 0; ai < 2; ++ai)
#pragma unroll
            for (int m = 0; m < 4; ++m) { const unsigned off = (unsigned)((row0 + ai * 128 + m * 16) * D + col0);
#pragma unroll
                for (int bj = 0; bj < 2; ++bj) { const f32x4 v0 = acc[ai][bj][m][0], v1 = acc[ai][bj][m][1];
                    u32x4 w; w.x = cvt_pk_bf16(v0[0], v0[1]); w.y = cvt_pk_bf16(v0[2], v0[3]); w.z = cvt_pk_bf16(v1[0], v1[1]); w.w = cvt_pk_bf16(v1[2], v1[3]);
                    wt_store128(ro_, (off + bj * 128) * 2, w); } }
    }
};
__device__ __forceinline__ float swiglu1(float g, float u) {
    g = fminf(g, 7.0f); u = fminf(fmaxf(u, -7.0f), 7.0f);
    const float s = __builtin_amdgcn_rcpf(1.0f + __builtin_amdgcn_exp2f(g * (-1.702f * LOG2E)));
    return (u + 1.0f) * (g * s);
}
__device__ __forceinline__ f32x4 swiglu4(f32x4 g, f32x4 u) {
    g = __builtin_elementwise_min(g, (f32x4){7.0f, 7.0f, 7.0f, 7.0f});
    u = __builtin_elementwise_min(__builtin_elementwise_max(u, (f32x4){-7.0f, -7.0f, -7.0f, -7.0f}), (f32x4){7.0f, 7.0f, 7.0f, 7.0f});
    const f32x4 t = g * (-1.702f * LOG2E);
    f32x4 e; e[0] = __builtin_amdgcn_exp2f(t[0]); e[1] = __builtin_amdgcn_exp2f(t[1]); e[2] = __builtin_amdgcn_exp2f(t[2]); e[3] = __builtin_amdgcn_exp2f(t[3]);
    const f32x4 d = e + 1.0f;
    f32x4 r; r[0] = __builtin_amdgcn_rcpf(d[0]); r[1] = __builtin_amdgcn_rcpf(d[1]); r[2] = __builtin_amdgcn_rcpf(d[2]); r[3] = __builtin_amdgcn_rcpf(d[3]);
    return (u * ASCALE + ASCALE) * (g * r);
}
__device__ __forceinline__ unsigned cvt4_fp8_nc(const f32x4& v) {
    int p = __builtin_amdgcn_cvt_pk_fp8_f32(v[0], v[1], 0, false); p = __builtin_amdgcn_cvt_pk_fp8_f32(v[2], v[3], p, true); return (unsigned)p; }
struct EpiGateUp {
    static constexpr bool PERM = true;
    __device__ __forceinline__ void init(AccT& acc, const Unit&, int, int, int, int) const { acc_zero(acc); }
    unsigned char* ACT; const LAS int* tpre; const LAS float* tabf; const LAS float* tabb;
    __device__ __forceinline__ void operator()(const AccT& acc, const Unit& u, int wr, int wc, int fr, int fq) const {
        const int cl = wc * 32 + 8 * fq, colA = u.pn * 128 + cl;
        const LAS float* bp = tabb + u.slot * 256 + cl;
        const f32x4 bg0 = *(const LAS f32x4*)(bp), bg1 = *(const LAS f32x4*)(bp + 4), bu0 = *(const LAS f32x4*)(bp + 128), bu1 = *(const LAS f32x4*)(bp + 132);
        const int srow0 = (__builtin_amdgcn_readfirstlane(tpre[u.e]) + u.pm) * 256;
        const __amdgpu_buffer_rsrc_t ra_ = wt_rsrc(ACT);
#pragma unroll
        for (int ai = 0; ai < 2; ++ai)
#pragma unroll
            for (int m = 0; m < 4; ++m) { const int r = ai * 128 + wr * 64 + m * 16 + fr; const float rs = tabf[u.slot * 256 + r];
                const f32x4 g0 = acc[ai][0][m][0] * rs + bg0, g1 = acc[ai][0][m][1] * rs + bg1, u0 = acc[ai][1][m][0] * rs + bu0, u1 = acc[ai][1][m][1] * rs + bu1;
                u32x2 w; w.x = cvt4_fp8_nc(swiglu4(g0, u0)); w.y = cvt4_fp8_nc(swiglu4(g1, u1));
                wt_store64(ra_, (unsigned)((srow0 + r) * DFF + colA), w); }
    }
};
struct EpiDown {
    static constexpr bool PERM = true;
    __device__ __forceinline__ void init(AccT& acc, const Unit&, int, int, int, int) const { acc_zero(acc); }
    unsigned char* Y; const LAS int* tab; const LAS float* tabf; const LAS float* tabb;
    __device__ __forceinline__ void operator()(const AccT& acc, const Unit& u, int wr, int wc, int fr, int fq) const {
        const int cl = wc * 32 + 8 * fq, col0 = u.pn * 256 + cl;
        const LAS float* bp = tabb + u.slot * 256 + cl;
        const __amdgpu_buffer_rsrc_t ry_ = wt_rsrc(Y);
        f32x4 bv[2][2];
#pragma unroll
        for (int bj = 0; bj < 2; ++bj) { bv[bj][0] = *(const LAS f32x4*)(bp + bj * 128); bv[bj][1] = *(const LAS f32x4*)(bp + bj * 128 + 4); }
#pragma unroll
        for (int ai = 0; ai < 2; ++ai)
#pragma unroll
            for (int m = 0; m < 4; ++m) { const int r = ai * 128 + wr * 64 + m * 16 + fr; const int idx = tab[u.slot * 256 + r];
                if (idx >= 0) { const float gv = tabf[u.slot * 256 + r] * YSCALE; const unsigned rowo = (unsigned)(idx * D + col0);
#pragma unroll
                    for (int bj = 0; bj < 2; ++bj) { const f32x4 v0 = (acc[ai][bj][m][0] * (1.0f / (ASCALE * WSCALE)) + bv[bj][0]) * gv, v1 = (acc[ai][bj][m][1] * (1.0f / (ASCALE * WSCALE)) + bv[bj][1]) * gv;
                        u32x2 w; w.x = cvt4_fp8(v0[0], v0[1], v0[2], v0[3]); w.y = cvt4_fp8(v1[0], v1[1], v1[2], v1[3]);
                        wt_store64(ry_, rowo + bj * 128, w); } } }
    }
};

__device__ __forceinline__ void tr_item(const float* __restrict__ W, int K, int N, bf16_t* __restrict__ WT, LAS float* scr, int kb, int nb, int lane) {
    const int k0 = kb * 64, n0 = nb * 64;
    const float* src = W + (size_t)(k0 + (lane >> 4)) * N + n0 + (lane & 15) * 4;
    f32x4 v[16];
#pragma unroll
    for (int i = 0; i < 16; ++i) v[i] = *(const f32x4*)(src + (size_t)(4 * i) * N);
#pragma unroll
    for (int i = 0; i < 16; ++i) { LAS float* d = scr + (4 * i + (lane >> 4)) * 65 + (lane & 15) * 4; d[0] = v[i][0]; d[1] = v[i][1]; d[2] = v[i][2]; d[3] = v[i][3]; }
    LDS_WAIT();
    const int c = lane & 7;
#pragma unroll
    for (int j = 0; j < 8; ++j) { const int n = 8 * j + (lane >> 3); const LAS float* s = scr + (8 * c) * 65 + n;
        u32x4 o; o.x = cvt_pk_bf16(s[0], s[65]); o.y = cvt_pk_bf16(s[130], s[195]); o.z = cvt_pk_bf16(s[260], s[325]); o.w = cvt_pk_bf16(s[390], s[455]);
        *(u32x4*)(WT + (size_t)(n0 + n) * K + k0 + 8 * c) = o; }
    LDS_WAIT();
}
struct Item8 { const float* src; unsigned char* dst; int N; };
__device__ __forceinline__ void chunk8_load(const Item8& d, int ch, f32x4 (&v)[16], int lane) {
    const float* base = d.src + (size_t)(32 * ch + 4 * (lane >> 5)) * d.N + (lane & 31) * 4;
#pragma unroll
    for (int sl = 0; sl < 4; ++sl)
#pragma unroll
        for (int j = 0; j < 4; ++j) v[4 * sl + j] = __builtin_nontemporal_load((const f32x4*)(base + (size_t)(8 * sl + j) * d.N));
}
__device__ __forceinline__ void chunk8_cvt(int ch, const f32x4 (&v)[16], LAS unsigned* scr, int lane) {
    const int nq = lane & 31, kq0 = lane >> 5, sw = (nq & 7) << 2;
#pragma unroll
    for (int sl = 0; sl < 4; ++sl) { const int kw = 8 * ch + kq0 + 2 * sl;
#pragma unroll
        for (int i = 0; i < 4; ++i) scr[(4 * nq + i) * 32 + (kw ^ sw)] = cvt4_fp8(v[4 * sl][i] * WSCALE, v[4 * sl + 1][i] * WSCALE, v[4 * sl + 2][i] * WSCALE, v[4 * sl + 3][i] * WSCALE); }
}
__device__ __forceinline__ void item8_flush(const Item8& d, const LAS unsigned* scr, int lane, int pf = 0) {
    LDS_WAIT();
    if (pf & 8) return;
    const int c16 = lane & 7;
#pragma unroll
    for (int jj = 0; jj < 16; ++jj) { const int n = (lane >> 3) + 8 * jj;
        const u32x4 o = *(const LAS u32x4*)(scr + n * 32 + ((c16 ^ ((n >> 2) & 7)) << 2));
#ifdef FLUSH_PLAIN
        *(u32x4*)(d.dst + (size_t)n * D + 16 * c16) = o; }
#else
        __builtin_nontemporal_store(o, (u32x4*)(d.dst + (size_t)n * D + 16 * c16)); }
#endif
    LDS_WAIT();
}
__device__ __forceinline__ int t5_bucket(int dist) {
    if (dist < 16) return dist;
    const int large = 16 + (int)(logf((float)dist / 16.0f) / 4.852030263919617f * 16.0f);
    return large < 31 ? large : 31;
}
struct In { const float *x, *norm1_g, *w_in, *pool_w, *pool_scale, *rel_bias, *w_out, *norm2_g, *router_w, *router_b, *w_gate_up, *b_gate_up, *w_down, *b_down, *final_g; };

constexpr int N8_ALL = NE * 128 + NE * 64;
__device__ __forceinline__ void convert8_queue(LAS unsigned char* lds, const In& in, unsigned char* ws, unsigned* qword, int pf = 0) {
    const int lane = threadIdx.x & 63, wave = __builtin_amdgcn_readfirstlane((int)threadIdx.x >> 6);
    constexpr int IG = 8 * 16, ID = 8 * 8;
    auto desc = [&](int r) -> Item8 { Item8 d;
        if (r < NE * IG) { const int e = r / IG, q = r % IG, kb = q / 16, nb = q % 16;
            d.src = in.w_gate_up + (size_t)e * D * 2 * DFF + (size_t)(kb * 128) * (2 * DFF) + nb * 128; d.N = 2 * DFF; d.dst = ws + WS_WGU + (size_t)e * 2 * DFF * D + (size_t)(nb * 128) * D + kb * 128; }
        else { const int r2 = r - NE * IG, e = r2 / ID, q = r2 % ID, kb = q / 8, nb = q % 8;
            d.src = in.w_down + (size_t)e * DFF * D + (size_t)(kb * 128) * D + nb * 128; d.N = D; d.dst = ws + WS_WD + (size_t)e * D * DFF + (size_t)(nb * 128) * DFF + kb * 128; }
        return d; };
    constexpr int NQ8 = 16, QLEN = N8_ALL / NQ8; static_assert(N8_ALL % NQ8 == 0, "queue split");
    const int qi = (int)(blockIdx.x * 8 + wave) & (NQ8 - 1);
    unsigned* qw = qword + 64 * qi;
    auto claim = [&]() -> int { unsigned v = 0; if (lane == 0) v = __hip_atomic_fetch_add(qw, 1u, __ATOMIC_RELAXED, __HIP_MEMORY_SCOPE_AGENT); const int j = __builtin_amdgcn_readfirstlane((int)v); return j < QLEN ? qi + NQ8 * j : N8_ALL; };
    LAS unsigned* scr8 = (LAS unsigned*)(lds + wave * 16384);
    f32x4 va[16], vb[16];
    int it = claim();
    if (it < N8_ALL) { const Item8 d0 = desc(it); chunk8_load(d0, 0, va, lane); chunk8_load(d0, 1, vb, lane); }
    while (it < N8_ALL) {
        const Item8 d = desc(it);
        const int nx = claim();
        const bool more = nx < N8_ALL; const Item8 dn = more ? desc(nx) : d;
        chunk8_cvt(0, va, scr8, lane); chunk8_load(d, 2, va, lane);
        chunk8_cvt(1, vb, scr8, lane); chunk8_load(d, 3, vb, lane);
        chunk8_cvt(2, va, scr8, lane); if (more) chunk8_load(dn, 0, va, lane);
        chunk8_cvt(3, vb, scr8, lane); if (more) chunk8_load(dn, 1, vb, lane);
        item8_flush(d, scr8, lane, pf);
        it = nx;
    }
}
__device__ __forceinline__ void p0_prologue(LAS unsigned char* lds, const In& in, unsigned char* ws, int G, int c) {
    const int tid = threadIdx.x, lane = tid & 63, wave = __builtin_amdgcn_readfirstlane(tid >> 6);
    const int gw = c * 8 + wave, NGW = G * 8;
    LAS float* scr = (LAS float*)(lds + wave * 16640);
    constexpr int I_IN = 16 * 40, I_OUT = 16 * 16, I_GU1 = 16 * 32, I_D1 = 16 * 16;
    for (int it = gw; it < I_IN; it += NGW) tr_item(in.w_in, D, NPROJ, (bf16_t*)(ws + WS_WIN), scr, it / 40, it % 40, lane);
#ifndef MK_DOUBLE
#define MK_DOUBLE 0
#endif
    for (int repr_ = 0; repr_ < (((MK_DOUBLE >> 11) & 1) ? 2 : 1); ++repr_) {
        f32x4 gv[4];
#pragma unroll
        for (int j = 0; j < 4; ++j) gv[j] = *(const f32x4*)(in.norm1_g + 4 * lane + 256 * j);
        bf16_t* H = (bf16_t*)(ws + WS_H);
        f32x4 v[4], vn[4];
        int m = gw;
        if (m < S) {
#pragma unroll
            for (int j = 0; j < 4; ++j) v[j] = __builtin_nontemporal_load((const f32x4*)(in.x + (size_t)m * D + 4 * lane + 256 * j)); }
        for (; m < S; m += NGW) {
            const int mn = m + NGW;
            if (mn < S) {
#pragma unroll
                for (int j = 0; j < 4; ++j) vn[j] = __builtin_nontemporal_load((const f32x4*)(in.x + (size_t)mn * D + 4 * lane + 256 * j)); }
            float s = 0.f;
#pragma unroll
            for (int j = 0; j < 4; ++j) s += (v[j][0] * v[j][0] + v[j][1] * v[j][1]) + (v[j][2] * v[j][2] + v[j][3] * v[j][3]);
            const float rstd = rsqrtf(wave_sum(s) * (1.0f / D) + RMS_EPS);
#pragma unroll
            for (int j = 0; j < 4; ++j) { const f32x4 o = v[j] * rstd * gv[j]; u32x2 w; w.x = cvt_pk_bf16(o[0], o[1]); w.y = cvt_pk_bf16(o[2], o[3]); *(u32x2*)(H + (size_t)m * D + 4 * lane + 256 * j) = w; }
#pragma unroll
            for (int j = 0; j < 4; ++j) v[j] = vn[j];
        }
    }
}
__device__ __forceinline__ void p0_side(LAS unsigned char* lds, const In& in, unsigned char* ws, int n0, int c0) {
    const int tid = threadIdx.x, lane = tid & 63, wave = __builtin_amdgcn_readfirstlane(tid >> 6);
    LAS float* scr = (LAS float*)(lds + wave * 16640);
    for (int it = c0 * 8 + wave; it < 16 * 16; it += n0 * 8) tr_item(in.w_out, D, D, (bf16_t*)(ws + WS_WOUT), scr, it / 16, it % 16, lane);
    const int gt = c0 * 512 + tid, NGT = n0 * 512;
    { bf16_t* GWH = (bf16_t*)(ws + WS_GWT); bf16_t* GWL = GWH + NE * D; for (int i = gt; i < NE * D; i += NGT) { const int e = i >> 10, k = i & 1023; const float v = in.norm2_g[k] * in.router_w[k * NE + e];
        const unsigned hi = cvt_pk_bf16(v, 0.f) & 0xffffu; GWH[i] = (bf16_t)hi; GWL[i] = (bf16_t)(cvt_pk_bf16(v - __uint_as_float(hi << 16), 0.f) & 0xffffu); } }
    { float* BT = (float*)(ws + WS_BT); for (int i = gt; i < 36 * BT_N; i += NGT) { const int bh = i / BT_N, j = i % BT_N, b = bh / NH, h = bh % NH, dil = (b == 0) ? 1 : (b == 1 ? 4 : 16), d = j - BT_OFF;
        BT[i] = (d >= 0 && d <= 128) ? in.rel_bias[t5_bucket(d * dil) * NH + h] * LOG2E : NEGBIG; } }
    { bf16_t* PWT = (bf16_t*)(ws + WS_PWT); for (int i = gt; i < 4 * 64 * 64; i += NGT) { const int g = i >> 12, d = (i >> 6) & 63, cc = i & 63; PWT[i] = (bf16_t)(cvt_pk_bf16(in.pool_w[g * 4096 + cc * 64 + d], 0.f) & 0xffffu); } }
}

__device__ __forceinline__ s16x4 lds_tr16(const LAS unsigned char* p) { typedef short v4i16_t __attribute__((ext_vector_type(4))); return __builtin_bit_cast(s16x4, __builtin_amdgcn_ds_read_tr16_b64_v4i16((LAS v4i16_t*)p)); }
constexpr int ATT_UNITS = 3 * NH * 64, KV_PITCH = 144, KV_ROWS = 384, ATT_VOFF = KV_ROWS * KV_PITCH, ATT_TOFF = 2 * KV_ROWS * KV_PITCH, ATT_NEGOFF = ATT_TOFF + BT_N * 4;
__device__ __forceinline__ void attn_decode(int uid, int& b, int& h, int& r, int& j, int& dil) {
    const int bh = uid >> 6, x = uid & 63; b = bh / NH; h = bh % NH; dil = (b == 0) ? 1 : (b == 1 ? 4 : 16);
    const int nb = 64 / dil; r = x / nb; j = x % nb;
}
__device__ __forceinline__ void attn_phase(LAS unsigned char* lds, const bf16_t* __restrict__ Qg, const bf16_t* __restrict__ Kg, const bf16_t* __restrict__ Vg, const float* __restrict__ BT,
                                           bf16_t* __restrict__ OP, float* __restrict__ LSE, int G, int c) {
    const int tid = threadIdx.x, lane = tid & 63, w = __builtin_amdgcn_readfirstlane(tid >> 6), ql = lane & 15, g = lane >> 4;
    LAS unsigned char* Ks = lds; LAS unsigned char* Vs = lds + ATT_VOFF; LAS float* Tb = (LAS float*)(lds + ATT_TOFF); LAS float* Tneg = (LAS float*)(lds + ATT_NEGOFF);
    if (tid < 16) Tneg[tid] = NEGBIG;
    u32x4 kpre[6], vpre[6]; bf16x8 qa0, qa1, qb0, qb1; float tpre = 0.f;
#define ATT_PREFETCH(uid_) do { int b_, h_, r_, j_, dil_; attn_decode((uid_), b_, h_, r_, j_, dil_); \
        _Pragma("unroll") for (int cc = 0; cc < 6; ++cc) { const int id = tid + 512 * cc, row = id >> 3, ch = id & 7; int mm = 256 * j_ - 128 + row; if (mm < 0) mm += 128; \
            const size_t off = (size_t)(r_ + dil_ * mm) * AW + h_ * HD + ch * 8; kpre[cc] = *(const u32x4*)(Kg + off); vpre[cc] = *(const u32x4*)(Vg + off); } \
        { const size_t qo = (size_t)(r_ + dil_ * (256 * j_ + 32 * w + ql)) * AW + h_ * HD + 8 * g; const size_t qs = (size_t)16 * dil_ * AW; \
          qa0 = *(const bf16x8*)(Qg + qo); qa1 = *(const bf16x8*)(Qg + qo + 32); qb0 = *(const bf16x8*)(Qg + qo + qs); qb1 = *(const bf16x8*)(Qg + qo + qs + 32); } \
        if (tid < BT_N) tpre = BT[(b_ * NH + h_) * BT_N + tid]; } while (0)
#ifndef ATT_SYNC_LOAD
    if (c < ATT_UNITS) ATT_PREFETCH(c);
#endif
    for (int uid = c; uid < ATT_UNITS; uid += G) {
        int b, h, r, j, dil; attn_decode(uid, b, h, r, j, dil);
#ifdef ATT_SYNC_LOAD
        ATT_PREFETCH(uid);
#endif
#pragma unroll
        for (int cc = 0; cc < 6; ++cc) { const int id = tid + 512 * cc, row = id >> 3, ch = id & 7; *(LAS u32x4*)(Ks + row * KV_PITCH + ch * 16) = kpre[cc]; *(LAS u32x4*)(Vs + row * KV_PITCH + ch * 16) = vpre[cc]; }
        if (tid < BT_N) Tb[tid] = tpre;
        const bf16x8 fa0 = qa0, fa1 = qa1, fb0 = qb0, fb1 = qb1;
        __syncthreads();
#ifndef ATT_SYNC_LOAD
        if (uid + G < ATT_UNITS) ATT_PREFETCH(uid + G);
#endif
#if defined(MK_DOUBLE)
        for (int repc_ = 0; repc_ < (((MK_DOUBLE >> 13) & 1) ? 2 : 1); ++repc_) {
#else
        {
#endif
        const int kkmin = (j == 0) ? 128 : 0;
        const LAS unsigned char* kb = Ks + (32 * w + ql) * KV_PITCH + g * 16;
        const LAS float* Tq = Tb + (ql + 272 - 4 * g - 3);
        const f32x4 zero4 = (f32x4){0.f, 0.f, 0.f, 0.f};
        f32x4 sA[9], sB[9];
#pragma unroll
        for (int i = 0; i < 10; ++i) {
            const bf16x8 kf0 = *(const LAS bf16x8*)(kb + i * (16 * KV_PITCH)), kf1 = *(const LAS bf16x8*)(kb + i * (16 * KV_PITCH) + 64);
            const bool msk = (32 * w + 16 * i) < kkmin;
            if (i <= 8) { f32x4 st = __builtin_amdgcn_mfma_f32_16x16x32_bf16(kf0, fa0, zero4, 0, 0, 0); st = __builtin_amdgcn_mfma_f32_16x16x32_bf16(kf1, fa1, st, 0, 0, 0);
                const LAS float* tp = msk ? Tneg : (Tq - 16 * i); sA[i] = (f32x4){st[0] + tp[3], st[1] + tp[2], st[2] + tp[1], st[3] + tp[0]}; }
            if (i >= 1) { f32x4 st = __builtin_amdgcn_mfma_f32_16x16x32_bf16(kf0, fb0, zero4, 0, 0, 0); st = __builtin_amdgcn_mfma_f32_16x16x32_bf16(kf1, fb1, st, 0, 0, 0);
                const LAS float* tp = msk ? Tneg : (Tq - 16 * (i - 1)); sB[i - 1] = (f32x4){st[0] + tp[3], st[1] + tp[2], st[2] + tp[1], st[3] + tp[0]}; }
        }
        float mA = NEGBIG, mB = NEGBIG;
#pragma unroll
        for (int i = 0; i < 9; ++i) { mA = fmaxf(mA, fmaxf(fmaxf(sA[i][0], sA[i][1]), fmaxf(sA[i][2], sA[i][3]))); mB = fmaxf(mB, fmaxf(fmaxf(sB[i][0], sB[i][1]), fmaxf(sB[i][2], sB[i][3]))); }
        mA = fmaxf(mA, __shfl_xor(mA, 16)); mA = fmaxf(mA, __shfl_xor(mA, 32)); mB = fmaxf(mB, __shfl_xor(mB, 16)); mB = fmaxf(mB, __shfl_xor(mB, 32));
        f32x4 oA[4], oB[4];
#pragma unroll
        for (int dt = 0; dt < 4; ++dt) { oA[dt] = zero4; oB[dt] = zero4; }
        float lA = 0.f, lB = 0.f;
        const LAS unsigned char* vb = Vs + (32 * w + 4 * g + (ql >> 2)) * KV_PITCH + (ql & 3) * 8;
#pragma unroll
        for (int i = 0; i < 10; ++i) {
            const LAS unsigned char* vt = vb + i * (16 * KV_PITCH);
            const s16x4 v0 = lds_tr16(vt), v1 = lds_tr16(vt + 32), v2 = lds_tr16(vt + 64), v3 = lds_tr16(vt + 96);
            if (i <= 8) { const float p0 = __builtin_amdgcn_exp2f(sA[i][0] - mA), p1 = __builtin_amdgcn_exp2f(sA[i][1] - mA), p2 = __builtin_amdgcn_exp2f(sA[i][2] - mA), p3 = __builtin_amdgcn_exp2f(sA[i][3] - mA);
                lA += (p0 + p1) + (p2 + p3); u32x2 pw; pw.x = cvt_pk_bf16(p0, p1); pw.y = cvt_pk_bf16(p2, p3); const s16x4 pf = __builtin_bit_cast(s16x4, pw);
                oA[0] = __builtin_amdgcn_mfma_f32_16x16x16bf16_1k(v0, pf, oA[0], 0, 0, 0); oA[1] = __builtin_amdgcn_mfma_f32_16x16x16bf16_1k(v1, pf, oA[1], 0, 0, 0);
                oA[2] = __builtin_amdgcn_mfma_f32_16x16x16bf16_1k(v2, pf, oA[2], 0, 0, 0); oA[3] = __builtin_amdgcn_mfma_f32_16x16x16bf16_1k(v3, pf, oA[3], 0, 0, 0); }
            if (i >= 1) { const float p0 = __builtin_amdgcn_exp2f(sB[i - 1][0] - mB), p1 = __builtin_amdgcn_exp2f(sB[i - 1][1] - mB), p2 = __builtin_amdgcn_exp2f(sB[i - 1][2] - mB), p3 = __builtin_amdgcn_exp2f(sB[i - 1][3] - mB);
                lB += (p0 + p1) + (p2 + p3); u32x2 pw; pw.x = cvt_pk_bf16(p0, p1); pw.y = cvt_pk_bf16(p2, p3); const s16x4 pf = __builtin_bit_cast(s16x4, pw);
                oB[0] = __builtin_amdgcn_mfma_f32_16x16x16bf16_1k(v0, pf, oB[0], 0, 0, 0); oB[1] = __builtin_amdgcn_mfma_f32_16x16x16bf16_1k(v1, pf, oB[1], 0, 0, 0);
                oB[2] = __builtin_amdgcn_mfma_f32_16x16x16bf16_1k(v2, pf, oB[2], 0, 0, 0); oB[3] = __builtin_amdgcn_mfma_f32_16x16x16bf16_1k(v3, pf, oB[3], 0, 0, 0); }
        }
        lA += __shfl_xor(lA, 16); lA += __shfl_xor(lA, 32); lB += __shfl_xor(lB, 16); lB += __shfl_xor(lB, 32);
#ifdef ATT_EXP1
        lA = 1.0f; lB = 1.0f; mA = 0.f; mB = 0.f;
#pragma unroll
        for (int dt = 0; dt < 4; ++dt) { oA[dt] = zero4; oB[dt] = zero4; }
#endif
#ifdef ATT_EXP2
        lA = 1.0f; lB = 1.0f;
#pragma unroll
        for (int dt = 0; dt < 4; ++dt) { oA[dt] = zero4; oB[dt] = zero4; }
#endif
        const float iA = 1.0f / lA, iB = 1.0f / lB;
        const int posA = r + dil * (256 * j + 32 * w + ql), posB = posA + 16 * dil;
        bf16_t* dA = OP + ((size_t)b * S + posA) * AW + h * HD + 4 * g; bf16_t* dB = OP + ((size_t)b * S + posB) * AW + h * HD + 4 * g;
#pragma unroll
        for (int dt = 0; dt < 4; ++dt) { u32x2 t; t.x = cvt_pk_bf16(oA[dt][0] * iA, oA[dt][1] * iA); t.y = cvt_pk_bf16(oA[dt][2] * iA, oA[dt][3] * iA); *(u32x2*)(dA + 16 * dt) = t;
            u32x2 t2; t2.x = cvt_pk_bf16(oB[dt][0] * iB, oB[dt][1] * iB); t2.y = cvt_pk_bf16(oB[dt][2] * iB, oB[dt][3] * iB); *(u32x2*)(dB + 16 * dt) = t2; }
        if (g == 0) { LSE[((size_t)b * S + posA) * NH + h] = mA + __builtin_amdgcn_logf(lA); LSE[((size_t)b * S + posB) * NH + h] = mB + __builtin_amdgcn_logf(lB); }
        asm volatile("" ::: "memory");
        }
        __syncthreads();
    }
#undef ATT_PREFETCH
}

__device__ __forceinline__ void pool_phase(LAS unsigned char* lds, const bf16_t* __restrict__ U, const bf16_t* __restrict__ PWT, const float* __restrict__ pool_scale, bf16_t* __restrict__ MIX, int G, int c) {
    const int tid = threadIdx.x, lane = tid & 63, w = __builtin_amdgcn_readfirstlane(tid >> 6), ql = lane & 15, g = lane >> 4;
    LAS unsigned char* Us = lds; LAS unsigned char* Pl = lds + 40960;
    for (int pu = c; pu < S / 64; pu += G) {
        const int t0 = pu * 64;
        { u32x4 uv[5];
#pragma unroll
          for (int q = 0; q < 5; ++q) { const int id = tid + 512 * q, row = id >> 5, ch = id & 31, t = t0 - 15 + row; uv[q] = (u32x4){0u, 0u, 0u, 0u};
              if (id < 79 * 32 && t >= 0) uv[q] = *(const u32x4*)(U + (size_t)t * PW + ch * 8); }
#pragma unroll
          for (int q = 0; q < 5; ++q) { const int id = tid + 512 * q, row = id >> 5, ch = id & 31; if (id < 79 * 32) *(LAS u32x4*)(Us + row * 512 + ch * 16) = uv[q]; } }
        __syncthreads();
        { const int cch = tid & 255, th = tid >> 8, gg = cch >> 6, wn = 2 << gg, tl0 = 32 * th;
          const LAS bf16_t* up = (const LAS bf16_t*)Us + cch;
#define UAT(row) __uint_as_float(((unsigned)up[(row) * 256]) << 16)
          float sum = 0.f;
          for (int i = 0; i < wn; ++i) sum += UAT(tl0 + 15 - i);
          const float rcw = 1.0f / (float)wn;
#pragma unroll 8
          for (int tl = tl0; tl < tl0 + 32; ++tl) {
              const float cur = UAT(tl + 15);
              if (tl > tl0) sum += cur - UAT(tl + 15 - wn);
              const int t = t0 + tl; const float rc = (t + 1 < wn) ? __builtin_amdgcn_rcpf((float)(t + 1)) : rcw;
              const float val = sum * rc - cur;
              ((LAS bf16_t*)(Pl + tl * 528))[cch] = (bf16_t)(cvt_pk_bf16(val, 0.f) & 0xffffu);
          }
#undef UAT
        }
        __syncthreads();
        { const int tt = w & 3, gp = w >> 2;
#pragma unroll
          for (int gi = 0; gi < 2; ++gi) { const int gg = 2 * gp + gi;
              const bf16x8 b0 = *(const LAS bf16x8*)(Pl + (16 * tt + ql) * 528 + (gg * 64 + 8 * g) * 2), b1 = *(const LAS bf16x8*)(Pl + (16 * tt + ql) * 528 + (gg * 64 + 32 + 8 * g) * 2);
#pragma unroll
              for (int nt = 0; nt < 4; ++nt) {
                  const bf16_t* ap = PWT + ((size_t)(gg * 64 + 16 * nt + ql) * 64 + 8 * g);
                  const bf16x8 a0 = *(const bf16x8*)(ap), a1 = *(const bf16x8*)(ap + 32);
                  f32x4 acc = __builtin_amdgcn_mfma_f32_16x16x32_bf16(a0, b0, (f32x4){0.f, 0.f, 0.f, 0.f}, 0, 0, 0);
                  acc = __builtin_amdgcn_mfma_f32_16x16x32_bf16(a1, b1, acc, 0, 0, 0);
                  const f32x4 ps = *(const f32x4*)(pool_scale + gg * 64 + 16 * nt + 4 * g);
                  u32x2 o; o.x = cvt_pk_bf16(acc[0] * ps[0], acc[1] * ps[1]); o.y = cvt_pk_bf16(acc[2] * ps[2], acc[3] * ps[3]);
                  *(u32x2*)(MIX + (size_t)(t0 + 16 * tt + ql) * D + gg * 64 + 16 * nt + 4 * g) = o;
              } }
        }
        __syncthreads();
    }
}

__device__ __forceinline__ void combine_phase(const bf16_t* __restrict__ OP, const float* __restrict__ LSE, bf16_t* __restrict__ MIX, int G, int c) {
    const int gt = c * 512 + threadIdx.x, NGT = G * 512;
    for (int id = gt; id < S * 96; id += NGT) {
        const int t = id / 96, rem = id % 96, h = rem >> 3, c8 = rem & 7;
        const float l0 = LSE[(size_t)t * NH + h], l1 = LSE[((size_t)S + t) * NH + h], l2 = LSE[((size_t)2 * S + t) * NH + h];
        const float mx = fmaxf(l0, fmaxf(l1, l2));
        float w0 = __builtin_amdgcn_exp2f(l0 - mx), w1 = __builtin_amdgcn_exp2f(l1 - mx), w2 = __builtin_amdgcn_exp2f(l2 - mx);
        const float inv = 1.0f / (w0 + w1 + w2); w0 *= inv; w1 *= inv; w2 *= inv;
        const size_t off = (size_t)t * AW + h * HD + c8 * 8;
        const u32x4 a = __builtin_nontemporal_load((const u32x4*)(OP + off)), b = __builtin_nontemporal_load((const u32x4*)(OP + (size_t)S * AW + off)), cc = __builtin_nontemporal_load((const u32x4*)(OP + (size_t)2 * S * AW + off));
        u32x4 o;
#pragma unroll
        for (int k = 0; k < 4; ++k) { const float lo = w0 * bf_lo(a[k]) + w1 * bf_lo(b[k]) + w2 * bf_lo(cc[k]), hi = w0 * bf_hi(a[k]) + w1 * bf_hi(b[k]) + w2 * bf_hi(cc[k]); o[k] = cvt_pk_bf16(lo, hi); }
        *(u32x4*)(MIX + (size_t)t * D + PW + h * HD + c8 * 8) = o;
    }
}

constexpr int GW_PITCH = 1032;
constexpr int RT_GWL = 32 * GW_PITCH * 2, RT_G2 = 2 * RT_GWL, RT_LG = RT_G2 + 4096, RT_RS = RT_LG + 4 * 16 * 33 * 4, RT_CNT = RT_RS + 256, RT_PART = RT_CNT + 256, RT_END = RT_PART + 4 * 64 * 9 * 4;
static_assert(RT_END <= LDS_CTL, "router LDS map");
__device__ __forceinline__ void router_phase(LAS unsigned char* lds, const bf16_t* __restrict__ X1, const float* __restrict__ g2, const bf16_t* __restrict__ GWT, const float* __restrict__ rb,
                                             unsigned char* __restrict__ H, float* __restrict__ RSTD, float* __restrict__ GATES, int* __restrict__ ROWS, unsigned* __restrict__ COUNTS, int G, int c) {
    const int tid = threadIdx.x, lane = tid & 63, w = __builtin_amdgcn_readfirstlane(tid >> 6), ql = lane & 15, g = lane >> 4;
    const int ts = w & 3, kh = w >> 2;
    LAS bf16_t* GWH = (LAS bf16_t*)lds;
    LAS bf16_t* GWL = (LAS bf16_t*)(lds + RT_GWL);
    LAS float* G2 = (LAS float*)(lds + RT_G2);
    LAS float* LG = (LAS float*)(lds + RT_LG) + ts * (16 * 33);
    LAS float* RS = (LAS float*)(lds + RT_RS) + ts * 16;
    LAS int* LCNT = (LAS int*)(lds + RT_CNT);
    LAS int* LBASE = LCNT + 32;
    LAS float* PART = (LAS float*)(lds + RT_PART) + ts * (64 * 9);
    const int nrounds = (S / 16 + 4 * G - 1) / (4 * G);
    for (int rd = 0; rd < nrounds; ++rd) {
        const int tile = (rd * 4 + ts) * G + c;
        const bool active = tile < S / 16;
        const int tok = (active ? tile : 0) * 16 + ql;
        const bf16_t* xr = X1 + (size_t)tok * D + kh * 512 + 8 * g;
        u32x4 xv[16];
        if (active) {
#pragma unroll
            for (int i = 0; i < 16; ++i) xv[i] = __builtin_nontemporal_load((const u32x4*)(xr + 32 * i)); }
        if (rd == 0) {
            u32x4 gx[16];
#pragma unroll
            for (int q = 0; q < 16; ++q) { const int id = tid + 512 * q; gx[q] = *(const u32x4*)(GWT + (size_t)id * 8); }
#pragma unroll
            for (int q = 0; q < 16; ++q) { const int id = tid + 512 * q, hl = id >> 12, e = (id >> 7) & 31, pc = id & 127; *(LAS u32x4*)(lds + hl * RT_GWL + (e * GW_PITCH + pc * 8) * 2) = gx[q]; }
            if (tid < 256) *(LAS f32x4*)(G2 + tid * 4) = *(const f32x4*)(g2 + tid * 4);
        }
        if (tid < 32) LCNT[tid] = 0;
        __syncthreads();
        int ek[4] = {0, 0, 0, 0}, lp[4] = {0, 0, 0, 0}; float gk[4] = {0.f, 0.f, 0.f, 0.f};
        f32x4 acc0 = (f32x4){0.f, 0.f, 0.f, 0.f}, acc1 = acc0; float ss = 0.f;
        if (active) {
            unsigned char* hr = H + (size_t)tok * D + kh * 512 + 8 * g;
            const int wo = ql * GW_PITCH + kh * 512 + 8 * g;
            const LAS float* gp = G2 + kh * 512 + 8 * g;
            f32x4 a0l = acc0, a1l = acc0;
#pragma unroll
            for (int i = 0; i < 16; ++i) {
                const int k0 = 32 * i; const u32x4 xw = xv[i]; const bf16x8 xa = __builtin_bit_cast(bf16x8, xw);
                const f32x4 n0 = *(const LAS f32x4*)(gp + k0), n1 = *(const LAS f32x4*)(gp + k0 + 4);
                const bf16x8 bh0 = *(const LAS bf16x8*)(GWH + wo + k0), bh1 = *(const LAS bf16x8*)(GWH + wo + 16 * GW_PITCH + k0);
                const bf16x8 bl0 = *(const LAS bf16x8*)(GWL + wo + k0), bl1 = *(const LAS bf16x8*)(GWL + wo + 16 * GW_PITCH + k0);
                const float f0 = bf_lo(xw.x), f1 = bf_hi(xw.x), f2 = bf_lo(xw.y), f3 = bf_hi(xw.y), f4 = bf_lo(xw.z), f5 = bf_hi(xw.z), f6 = bf_lo(xw.w), f7 = bf_hi(xw.w);
                ss += (f0 * f0 + f1 * f1) + (f2 * f2 + f3 * f3) + (f4 * f4 + f5 * f5) + (f6 * f6 + f7 * f7);
                u32x2 hv; hv.x = cvt4_fp8(f0 * n0[0] * HSCALE, f1 * n0[1] * HSCALE, f2 * n0[2] * HSCALE, f3 * n0[3] * HSCALE);
                hv.y = cvt4_fp8(f4 * n1[0] * HSCALE, f5 * n1[1] * HSCALE, f6 * n1[2] * HSCALE, f7 * n1[3] * HSCALE);
                *(u32x2*)(hr + k0) = hv;
                acc0 = __builtin_amdgcn_mfma_f32_16x16x32_bf16(xa, bh0, acc0, 0, 0, 0); acc1 = __builtin_amdgcn_mfma_f32_16x16x32_bf16(xa, bh1, acc1, 0, 0, 0);
                a0l = __builtin_amdgcn_mfma_f32_16x16x32_bf16(xa, bl0, a0l, 0, 0, 0); a1l = __builtin_amdgcn_mfma_f32_16x16x32_bf16(xa, bl1, a1l, 0, 0, 0);
            }
            acc0 += a0l; acc1 += a1l;
            if (kh == 1) { LAS float* pp = PART + lane * 9;
#pragma unroll
                for (int i = 0; i < 4; ++i) { pp[i] = acc0[i]; pp[4 + i] = acc1[i]; } pp[8] = ss; }
        }
        __syncthreads();
        if (active && kh == 0) {
            { const LAS float* pp = PART + lane * 9;
#pragma unroll
              for (int i = 0; i < 4; ++i) { acc0[i] += pp[i]; acc1[i] += pp[4 + i]; } ss += pp[8]; }
            ss += __shfl_xor(ss, 16); ss += __shfl_xor(ss, 32);
            const float rstd = rsqrtf(ss * (1.0f / D) + RMS_EPS);
            if (g == 0) { RSTD[tok] = rstd; RS[ql] = rstd; }
            LDS_WAIT();
            const float rb0 = rb[ql], rb1 = rb[16 + ql];
#pragma unroll
            for (int rg = 0; rg < 4; ++rg) { const float rr = RS[4 * g + rg]; LG[(4 * g + rg) * 33 + ql] = acc0[rg] * rr + rb0; LG[(4 * g + rg) * 33 + 16 + ql] = acc1[rg] * rr + rb1; }
            LDS_WAIT();
            if (lane < 16) {
                float v[32];
#pragma unroll
                for (int e = 0; e < 32; ++e) v[e] = LG[ql * 33 + e];
                float tv[4];
#pragma unroll
                for (int r = 0; r < 4; ++r) { float best = v[0]; int bi = 0;
#pragma unroll
                    for (int e = 1; e < 32; ++e) { const bool gt = v[e] > best; best = gt ? v[e] : best; bi = gt ? e : bi; }
                    tv[r] = best; ek[r] = bi;
#pragma unroll
                    for (int e = 0; e < 32; ++e) v[e] = (e == bi) ? -INFINITY : v[e]; }
                const float e1 = __expf(tv[1] - tv[0]), e2 = __expf(tv[2] - tv[0]), e3 = __expf(tv[3] - tv[0]); const float inv = 1.0f / (1.0f + e1 + e2 + e3);
                gk[0] = inv; gk[1] = e1 * inv; gk[2] = e2 * inv; gk[3] = e3 * inv;
#pragma unroll
                for (int r = 0; r < 4; ++r) lp[r] = __hip_atomic_fetch_add(LCNT + ek[r], 1, __ATOMIC_RELAXED, __HIP_MEMORY_SCOPE_WORKGROUP);
            }
        }
        __syncthreads();
        if (tid < 32) { const int n = LCNT[tid]; int base = 0; if (n > 0) base = (int)__hip_atomic_fetch_add(COUNTS + tid, (unsigned)n, __ATOMIC_RELAXED, __HIP_MEMORY_SCOPE_AGENT); LBASE[tid] = base; }
        __syncthreads();
        if (active && kh == 0 && lane < 16) {
#pragma unroll
            for (int r = 0; r < 4; ++r) { const int pos = LBASE[ek[r]] + lp[r]; ROWS[(size_t)ek[r] * S + pos] = tok * 4 + r; GATES[tok * 4 + r] = gk[r]; }
#ifdef RT_HASH
            RSTD[S + tok] = gk[0] * (ek[0] + 1) + gk[1] * (ek[1] + 1) + gk[2] * (ek[2] + 1) + gk[3] * (ek[3] + 1);
#endif
        }
        __syncthreads();
    }
}

__device__ __forceinline__ void moe_prefix(LAS int* tpre, LAS int* lcnt, const unsigned* __restrict__ COUNTS) {
    if (threadIdx.x < 32) lcnt[threadIdx.x] = (int)COUNTS[threadIdx.x];
    __syncthreads();
    if (threadIdx.x == 0) { int acc = 0; for (int e = 0; e < NE; ++e) { tpre[e] = acc; acc += (lcnt[e] + 255) >> 8; } tpre[NE] = acc; }
    __syncthreads();
}
template <bool GU, class Prob> __device__ __forceinline__ void moe_table(const Prob& P, LAS int* udesc, LAS int* tab, LAS float* tabf, LAS float* tabb, const LAS int* lcnt, const int* __restrict__ ROWS,
                                                                         const float* __restrict__ rowf, const float* __restrict__ bias) {
    if (threadIdx.x < MAXU) { Unit u0; u0.e = 0; u0.pm = 0; u0.pn = 0; u0.slot = 0; const bool ok = P.search((int)threadIdx.x, u0);
        udesc[4 * threadIdx.x] = u0.e; udesc[4 * threadIdx.x + 1] = u0.pm; udesc[4 * threadIdx.x + 2] = u0.pn; udesc[4 * threadIdx.x + 3] = ok ? 1 : 0; }
    __syncthreads();
    constexpr int NQ = (MAXU * 256 + 511) / 512;
    int idx[NQ]; float fv[NQ], bvv[NQ];
#pragma unroll
    for (int q = 0; q < NQ; ++q) { const int j = (int)threadIdx.x + 512 * q, i = j >> 8, r = j & 255; idx[q] = -2;
        if (i < MAXU && udesc[4 * i + 3]) { const int e = udesc[4 * i], rr = udesc[4 * i + 1] * 256 + r; idx[q] = (rr < lcnt[e]) ? ROWS[(size_t)e * S + rr] : -1; } }
#pragma unroll
    for (int q = 0; q < NQ; ++q) { const int j = (int)threadIdx.x + 512 * q, i = j >> 8, c2 = j & 255; fv[q] = 0.f; bvv[q] = 0.f;
        if (idx[q] != -2) { const int e = udesc[4 * i], pn = udesc[4 * i + 2];
            fv[q] = GU ? rowf[idx[q] < 0 ? 0 : (idx[q] >> 2)] * (1.0f / (HSCALE * WSCALE)) : (idx[q] < 0 ? 0.f : rowf[idx[q]]);
            bvv[q] = GU ? bias[(size_t)e * 2 * DFF + (c2 >> 7) * DFF + pn * 128 + (c2 & 127)] : bias[(size_t)e * D + pn * 256 + c2]; } }
#pragma unroll
    for (int q = 0; q < NQ; ++q) { const int j = (int)threadIdx.x + 512 * q; if (idx[q] != -2) { tab[j] = idx[q]; tabf[j] = fv[q]; tabb[j] = bvv[q]; } }
    __syncthreads();
}

__device__ __forceinline__ void final_phase(const bf16_t* __restrict__ X1, const unsigned char* __restrict__ Y, const float* __restrict__ fg, float* __restrict__ out, int G, int c) {
    const int tid = threadIdx.x, lane = tid & 63, wave = tid >> 6; const int gw = c * 8 + wave, NGW = G * 8;
    f32x4 gv[4];
#pragma unroll
    for (int j = 0; j < 4; ++j) gv[j] = *(const f32x4*)(fg + 4 * lane + 256 * j);
    for (int m = gw; m < S; m += NGW) {
        const bf16_t* xr = X1 + (size_t)m * D + 4 * lane;
        f32x4 v[4];
#pragma unroll
        for (int j = 0; j < 4; ++j) { const u32x2 t = __builtin_nontemporal_load((const u32x2*)(xr + 256 * j)); v[j][0] = bf_lo(t.x); v[j][1] = bf_hi(t.x); v[j][2] = bf_lo(t.y); v[j][3] = bf_hi(t.y); }

#ifdef RT_HASH
        { const float extra = ((const float*)Y)[m];
#pragma unroll
          for (int j = 0; j < 4; ++j) { v[j][0] += __sinf(extra * (float)(4 * lane + 256 * j + 1)); v[j][1] += __sinf(extra * (float)(4 * lane + 256 * j + 2)); v[j][2] += __sinf(extra * (float)(4 * lane + 256 * j + 3)); v[j][3] += __sinf(extra * (float)(4 * lane + 256 * j + 4)); } }
#endif
#ifdef FIN_HASH
#pragma unroll
        for (int j = 0; j < 4; ++j) { v[j][0] = __sinf(v[j][0] * 1.0e6f); v[j][1] = __sinf(v[j][1] * 1.0e6f); v[j][2] = __sinf(v[j][2] * 1.0e6f); v[j][3] = __sinf(v[j][3] * 1.0e6f); }
#endif
#pragma unroll
#if defined(FIN_HASH) || defined(RT_HASH)
        for (int k = 0; k < 0; ++k) { const unsigned char* yr = Y + ((size_t)m * 4 + k) * D + 4 * lane;
#else
        for (int k = 0; k < 4; ++k) { const unsigned char* yr = Y + ((size_t)m * 4 + k) * D + 4 * lane;
#endif
#pragma unroll
            for (int j = 0; j < 4; ++j) { const int t = __builtin_nontemporal_load((const int*)(yr + 256 * j)); const f32x2 lo = __builtin_amdgcn_cvt_pk_f32_fp8(t, false), hi = __builtin_amdgcn_cvt_pk_f32_fp8(t, true);
                v[j][0] += lo[0] * (1.0f / YSCALE); v[j][1] += lo[1] * (1.0f / YSCALE); v[j][2] += hi[0] * (1.0f / YSCALE); v[j][3] += hi[1] * (1.0f / YSCALE); } }
#ifdef FIN_HASH2
#pragma unroll
        for (int j = 0; j < 4; ++j) { v[j][0] = __sinf(v[j][0] * 3.0e3f); v[j][1] = __sinf(v[j][1] * 3.0e3f); v[j][2] = __sinf(v[j][2] * 3.0e3f); v[j][3] = __sinf(v[j][3] * 3.0e3f); }
#endif
        float s = 0.f;
#pragma unroll
        for (int j = 0; j < 4; ++j) s += (v[j][0] * v[j][0] + v[j][1] * v[j][1]) + (v[j][2] * v[j][2] + v[j][3] * v[j][3]);
        const float rstd = rsqrtf(wave_sum(s) * (1.0f / D) + RMS_EPS);
#pragma unroll
        for (int j = 0; j < 4; ++j) __builtin_nontemporal_store(v[j] * rstd * gv[j], (f32x4*)(out + (size_t)m * D + 4 * lane + 256 * j));
    }
}

constexpr int NPHASE = 9;
struct Args { In in; float* out; unsigned char* ws; int ph_lo, ph_hi, probe; };
__global__ void __launch_bounds__(512, 2) fwd(Args args) {
    extern __shared__ __attribute__((aligned(16))) unsigned char lds_raw[];
    LAS unsigned char* lds = (LAS unsigned char*)lds_raw;
    const int tid = threadIdx.x, G = gridDim.x, c = blockIdx.x;
    unsigned char* ws = args.ws; const In& in = args.in;
    unsigned* ctl = (unsigned*)(ws + WS_CTL);
    LAS int* LCTL = (LAS int*)(lds + LDS_CTL);
    if (tid < 256) LCTL[tid] = 0;
    __syncthreads();
    const int lo = args.ph_lo, hi = args.ph_hi;
    const bool one_launch = (hi - lo) > 1;
    XcdBarrier bar; bar.bar = ctl + CW_BAR; bar.x = 0; bar.st = nullptr;
    if (one_launch) bar = xcd_barrier_post(ctl + CW_BAR, (volatile LAS unsigned*)LCTL);
#define IN(k) (lo <= (k) && (k) < hi)
#ifndef MK_DOUBLE
#define MK_DOUBLE 0
#endif
#define REP(k) for (int rep_ = 0; rep_ < ((((MK_DOUBLE) >> (k)) & 1) ? 2 : 1); ++rep_)
#define SEAM(k) do { if (IN((k) + 1)) xcd_barrier(bar); } while (0)
    bf16_t* Hb = (bf16_t*)(ws + WS_H); bf16_t* Ub = (bf16_t*)(ws + WS_U); bf16_t* Qb = (bf16_t*)(ws + WS_Q); bf16_t* Kb = (bf16_t*)(ws + WS_K); bf16_t* Vb = (bf16_t*)(ws + WS_V);
    bf16_t* OPb = (bf16_t*)(ws + WS_OP); bf16_t* MIXb = (bf16_t*)(ws + WS_MIX); bf16_t* X1 = (bf16_t*)(ws + WS_X1); unsigned char* ACTb = ws + WS_ACT; unsigned char* Yb = ws + WS_Y; unsigned char* H8 = ws + WS_H8;
    float* LSE = (float*)(ws + WS_LSE); float* RSTD = (float*)(ws + WS_RSTD); float* GATES = (float*)(ws + WS_GATES); int* ROWS = (int*)(ws + WS_ROWS); unsigned* COUNTS = ctl + CW_COUNTS;
    LAS int* TPRE = LCTL + 16; LAS int* LCNT = LCTL + 128; LAS int* UDESC = LCTL + 192; LAS int* TAB = (LAS int*)(lds + LDS_TAB); LAS float* TABF = (LAS float*)(lds + LDS_TAB + MAXU * 1024); LAS float* TABB = (LAS float*)(lds + LDS_TAB + 2 * MAXU * 1024);
    static_assert(LDS_TAB + 3 * MAXU * 1024 <= LDS_CTL, "MoE LDS tables");

    if (args.probe & 6) {
        const int lane = tid & 63, wave = tid >> 6, gw = c * 8 + wave, NGW = G * 8;
        f32x4 accp = (f32x4){0.f, 0.f, 0.f, 0.f};
        if (args.probe & 2) {
            for (int it = gw; it < N8_ALL; it += NGW) {
                const float* src; int N;
                if (it < NE * 128) { const int e = it / 128, q = it % 128, kb = q / 16, nb = q % 16; src = in.w_gate_up + (size_t)e * D * 2 * DFF + (size_t)(kb * 128) * (2 * DFF) + nb * 128; N = 2 * DFF; }
                else { const int r2 = it - NE * 128, e = r2 / 64, q = r2 % 64, kb = q / 8, nb = q % 8; src = in.w_down + (size_t)e * DFF * D + (size_t)(kb * 128) * D + nb * 128; N = D; }
#pragma unroll 1
                for (int ch = 0; ch < 4; ch += 2) { f32x4 va[16], vb[16]; Item8 d; d.src = src; d.N = N; d.dst = nullptr; chunk8_load(d, ch, va, lane); chunk8_load(d, ch + 1, vb, lane);
#pragma unroll
                    for (int i = 0; i < 16; ++i) accp += va[i] + vb[i]; } }
        } else {
            const size_t nrun = (size_t)NE * D * 2 * DFF / 1024 + (size_t)NE * DFF * D / 1024;
            for (size_t r0 = (size_t)gw * 8; r0 < nrun; r0 += (size_t)NGW * 8) {
                f32x4 v[32];
#pragma unroll
                for (int rr = 0; rr < 8; ++rr) { const size_t run = r0 + rr; const float* src = (run < (size_t)NE * D * 2 * DFF / 1024) ? in.w_gate_up + run * 1024 : in.w_down + (run - (size_t)NE * D * 2 * DFF / 1024) * 1024;
#pragma unroll
                    for (int j = 0; j < 4; ++j) v[4 * rr + j] = __builtin_nontemporal_load((const f32x4*)(src + 256 * j + 4 * lane)); }
#pragma unroll
                for (int i = 0; i < 32; ++i) accp += v[i]; }
        }
        if (accp[0] + accp[1] + accp[2] + accp[3] == 123.456f) ((float*)(ws + WS_ROWS))[gw] = 1.f;
        return;
    }
    if (IN(0)) { REP(0) p0_prologue(lds, in, ws, G, c); SEAM(0); }
    if (IN(1)) {
#ifndef MK_NG
#define MK_NG 128
#endif
        const int NG = (G >= 256) ? MK_NG : G;
        if (c < NG) { if (!(args.probe & 1)) {
            pg8::DenseProb P{(const char*)Hb, (const char*)(ws + WS_WIN), D * 2, S / 256, NPROJ / 256, NG, c, (size_t)128 * D * 2};
            EpiQKVU E{ws};
            REP(1) pg8::gemm_phase<EpiQKVU, pg8::DenseProb, true, false>(lds, P, E);
        } }
        else p0_side(lds, in, ws, G - NG, c - NG);
        if (NG == G) p0_side(lds, in, ws, G, c);
        convert8_queue(lds, in, ws, ctl + CW_QUEUE, args.probe);
        SEAM(1);
    }
    if (IN(2)) {
        REP(2) attn_phase(lds, Qb, Kb, Vb, (const float*)(ws + WS_BT), OPb, LSE, G, c);
        REP(9) pool_phase(lds, Ub, (const bf16_t*)(ws + WS_PWT), in.pool_scale, MIXb, G, c);
        SEAM(2);
    }
    if (IN(3)) { REP(3) combine_phase(OPb, LSE, MIXb, G, c); SEAM(3); }
    if (IN(4)) {
        pg8::DenseProb P{(const char*)MIXb, (const char*)(ws + WS_WOUT), D * 2, S / 256, D / 256, G, c, (size_t)128 * D * 2};
        EpiResBf16 E{in.x, X1};
        REP(4) pg8::gemm_phase<EpiResBf16, pg8::DenseProb, true, false>(lds, P, E);
        SEAM(4);
    }
    if (IN(5)) { router_phase(lds, X1, in.norm2_g, (const bf16_t*)(ws + WS_GWT), in.router_b, H8, RSTD, GATES, ROWS, COUNTS, G, c); SEAM(5); }
    if (IN(6)) {
        moe_prefix(TPRE, LCNT, COUNTS);
        pg8::MoeProb<true> P{(const char*)H8, (const char*)(ws + WS_WGU), D, 8, G, c, (size_t)DFF * D, (size_t)2 * DFF * D, 128, TPRE, TAB, UDESC};
        moe_table<true>(P, UDESC, TAB, TABF, TABB, LCNT, ROWS, RSTD, in.b_gate_up);
        EpiGateUp E{ACTb, TPRE, TABF, TABB};
        REP(6) pg8::gemm_phase<EpiGateUp, pg8::MoeProb<true>, true, true>(lds, P, E);
        SEAM(6);
    }
    if (IN(7)) {
        moe_prefix(TPRE, LCNT, COUNTS);
        pg8::MoeProb<false> P{(const char*)ACTb, (const char*)(ws + WS_WD), DFF, 4, G, c, (size_t)128 * DFF, (size_t)D * DFF, 256, TPRE, TAB, UDESC};
        moe_table<false>(P, UDESC, TAB, TABF, TABB, LCNT, ROWS, GATES, in.b_down);
        EpiDown E{Yb, TAB, TABF, TABB};
        REP(7) pg8::gemm_phase<EpiDown, pg8::MoeProb<false>, true, true>(lds, P, E);
        SEAM(7);
    }

#ifdef RT_HASH
    if (IN(8)) REP(8) final_phase(X1, (const unsigned char*)(RSTD + S), in.final_g, args.out, G, c);
#else
    if (IN(8)) REP(8) final_phase(X1, Yb, in.final_g, args.out, G, c);
#endif

#undef IN
#undef SEAM
}

#ifndef MK_N_LAUNCHES
#define MK_N_LAUNCHES 1
#endif
#ifndef MK_SEQ
#define MK_SEQ "012345678"
#endif
extern "C" void kernel_launch(void* const* d_in, const int* in_sizes, int n_in, void* d_out, int out_size, void* d_ws, size_t ws_size, hipStream_t stream) {
    static int grid = 0;
    if (grid == 0) {
        if (n_in != 15 || out_size != S * D || ws_size < WS_END) { fprintf(stderr, "kernel_launch: unexpected problem (n_in %d out %d ws %zu)\n", n_in, out_size, ws_size); grid = -1; return; }
        int dev = 0, cus = 0, per_cu = 0;
        if (hipGetDevice(&dev) != hipSuccess || hipDeviceGetAttribute(&cus, hipDeviceAttributeMultiprocessorCount, dev) != hipSuccess) { grid = -1; return; }
        if (hipFuncSetAttribute((const void*)fwd, hipFuncAttributeMaxDynamicSharedMemorySize, LDS_BYTES) != hipSuccess) { fprintf(stderr, "kernel_launch: hipFuncSetAttribute failed\n"); grid = -1; return; }
        if (hipOccupancyMaxActiveBlocksPerMultiprocessor(&per_cu, (const void*)fwd, 512, LDS_BYTES) != hipSuccess || per_cu < 1) { fprintf(stderr, "kernel_launch: occupancy query says %d blocks per CU\n", per_cu); (void)hipGetLastError(); per_cu = 1; }
        grid = cus;
    }
    if (grid < 0) return;
    if (hipMemsetAsync((char*)d_ws + WS_CTL, 0, CTL_ZERO_BYTES, stream) != hipSuccess) { fprintf(stderr, "kernel_launch: memset failed\n"); return; }
    Args a{};
    a.in.x = (const float*)d_in[0]; a.in.norm1_g = (const float*)d_in[1]; a.in.w_in = (const float*)d_in[2]; a.in.pool_w = (const float*)d_in[3]; a.in.pool_scale = (const float*)d_in[4];
    a.in.rel_bias = (const float*)d_in[5]; a.in.w_out = (const float*)d_in[6]; a.in.norm2_g = (const float*)d_in[7]; a.in.router_w = (const float*)d_in[8]; a.in.router_b = (const float*)d_in[9];
    a.in.w_gate_up = (const float*)d_in[10]; a.in.b_gate_up = (const float*)d_in[11]; a.in.w_down = (const float*)d_in[12]; a.in.b_down = (const float*)d_in[13]; a.in.final_g = (const float*)d_in[14];
    a.out = (float*)d_out; a.ws = (unsigned char*)d_ws;
    if (MK_N_LAUNCHES == 1) { a.ph_lo = 0; a.ph_hi = NPHASE; hipLaunchKernelGGL(fwd, dim3(grid), dim3(512), LDS_BYTES, stream, a); }
    else { const char* seq = MK_SEQ; for (int i = 0; seq[i]; ++i) { int p = seq[i] - '0'; a.probe = 0; if (seq[i] == 'r' || seq[i] == 'c' || seq[i] == 'd' || seq[i] == 'e') (void)hipMemsetAsync((char*)d_ws + WS_CTL + CW_QUEUE * 4, 0, 16 * 256, stream); if (seq[i] == 'r') continue; if (seq[i] == 'c') { p = 1; a.probe = 1; } if (seq[i] == 'd') { p = 1; a.probe = 1 | 8; } if (seq[i] == 'e') { p = 1; a.probe = 1 | 16; } if (seq[i] == 'x') { p = 1; a.probe = 2; } if (seq[i] == 'y') { p = 1; a.probe = 4; } a.ph_lo = p; a.ph_hi = p + 1; if (p == 5) (void)hipMemsetAsync((char*)d_ws + WS_CTL + CW_COUNTS * 4, 0, 128, stream); hipLaunchKernelGGL(fwd, dim3(grid), dim3(512), LDS_BYTES, stream, a); } }
    const hipError_t le = hipPeekAtLastError();
    if (le != hipSuccess) fprintf(stderr, "kernel_launch: launch failed: %s\n", hipGetErrorName(le));
}
```
